# Optimizing an MI355X kernel written in HIP

```python
import math
import jax, jax.numpy as jnp
from jax import lax
import numpy as np

D_MODEL = 1024
BATCH = 8
SEQ = 2048
DEPTH = 4

GRID_W = 64
CTX_LEN = 256
D_MIX = D_MODEL
ML_HEADS = 4
ML_HEAD_DIM = 96
ML_WIDTH = ML_HEADS * ML_HEAD_DIM
ML_CHUNK = 128
ML_M_INIT = -1e30
ML_GATE_COLS = 2 * 2 * ML_HEADS
RG_BLOCKS = 6
RG_BLOCK_DIM = 64
RG_WIDTH = RG_BLOCKS * RG_BLOCK_DIM
RG_CONV = 4
RG_C = 8.0
S5_GROUPS = 16
S5_GROUP = 16
S5_WIDTH = S5_GROUPS * S5_GROUP
S5_STATE = 64
A_COLS = 4 * ML_WIDTH + ML_GATE_COLS
B_COLS = 2 * RG_WIDTH
C_COLS = S5_WIDTH
D_IN = A_COLS + B_COLS + C_COLS
N_EXPERTS = 32
TOP_K = 4
D_EXPERT = D_MODEL
SWIGLU_LIMIT = 7.0
SWIGLU_ALPHA = 1.702
MOE_BLOCK = 128
EPS = 1e-6

kernel_name = 'hybrid_mlstm_rglru_s5_moe_dit'


def _maybe_flip(t, d, axis):
    return jnp.flip(t, axis=axis) if d else t


def rmsnorm(x, w):
    xf = x.astype(jnp.float32)
    y = xf * lax.rsqrt(jnp.mean(xf * xf, axis=-1, keepdims=True) + EPS)
    return (y * w.astype(jnp.float32)).astype(x.dtype)


def group_rmsnorm(y, n_groups):
    shp = y.shape
    yg = y.astype(jnp.float32).reshape(*shp[:-1], n_groups, shp[-1] // n_groups)
    yg = yg * lax.rsqrt(jnp.mean(yg * yg, axis=-1, keepdims=True) + EPS)
    return yg.reshape(shp)


def modulate(h, shift, scale):
    return h * (1.0 + scale) + shift


def mlstm_chunkwise(q, k, v, ig, lf, state, with_out):
    Bb, H, S, dh = q.shape
    nc, L = S // ML_CHUNK, ML_CHUNK
    q, k, v = [t.reshape(Bb, H, nc, L, dh) for t in (q, k, v)]
    ig, lf = [t.reshape(Bb, H, nc, L) for t in (ig, lf)]
    b = jnp.cumsum(lf, axis=-1)
    b_last = b[..., -1]
    w = b_last[..., None] - b + ig
    m_loc = jnp.max(w, axis=-1)
    e = jnp.exp(w - m_loc[..., None])
    c_loc = jnp.einsum('bhcs,bhcsd,bhcse->bhcde', e, v, k)
    n_loc = jnp.einsum('bhcs,bhcse->bhce', e, k)

    def step(carry, xs):
        c_st, n_st, m_st = carry
        c_l, n_l, m_l, b_l = xs
        m_new = jnp.maximum(b_l + m_st, m_l)
        a = jnp.exp(b_l + m_st - m_new)
        s = jnp.exp(m_l - m_new)
        c_new = a[..., None, None] * c_st + s[..., None, None] * c_l
        n_new = a[..., None] * n_st + s[..., None] * n_l
        return (c_new, n_new, m_new), (c_st, n_st, m_st)

    xs = tuple(jnp.moveaxis(t, 2, 0) for t in (c_loc, n_loc, m_loc, b_last))
    final, starts = lax.scan(step, state, xs)
    if not with_out:
        return None, final
    c0, n0, m0 = [jnp.moveaxis(t, 0, 2) for t in starts]
    tri = jnp.tril(jnp.ones((L, L), dtype=bool))
    dmat = jnp.where(tri, b[..., :, None] - b[..., None, :] + ig[..., None, :], -jnp.inf)
    g = b + m0[..., None]
    m_t = jnp.maximum(jnp.max(dmat, axis=-1), g)
    s_qk = jnp.einsum('bhctd,bhcsd->bhcts', q, k) * jnp.exp(dmat - m_t[..., None])
    inter = jnp.exp(g - m_t)
    num = jnp.einsum('bhcts,bhcsd->bhctd', s_qk, v) + inter[..., None] * jnp.einsum('bhcde,bhcte->bhctd', c0, q)
    den = jnp.sum(s_qk, axis=-1) + inter * jnp.einsum('bhce,bhcte->bhct', n0, q)
    h = num / jnp.maximum(jnp.abs(den), jnp.exp(-m_t))[..., None]
    return h.reshape(Bb, H, S, dh), final


def mlstm_mixer(p_ctx, p_lat, with_ctx):
    def prep(p):
        Bb, S = p.shape[:2]
        p = p.astype(jnp.float32)
        qkvo = p[..., :4 * ML_WIDTH].reshape(Bb, S, 4, ML_HEADS, ML_HEAD_DIM).transpose(2, 0, 3, 1, 4)
        g = p[..., 4 * ML_WIDTH:].reshape(Bb, S, 2, 2, ML_HEADS).transpose(2, 3, 0, 4, 1)
        qkv = (qkvo[0], qkvo[1] * ML_HEAD_DIM ** -0.5, qkvo[2])
        return qkv, qkvo[3], g[0], jax.nn.log_sigmoid(g[1])

    qkv_c, o_c, ig_c, lf_c = prep(p_ctx)
    qkv_l, o_l, ig_l, lf_l = prep(p_lat)
    Bb = p_lat.shape[0]
    zero = (jnp.zeros((Bb, ML_HEADS, ML_HEAD_DIM, ML_HEAD_DIM), jnp.float32),
            jnp.zeros((Bb, ML_HEADS, ML_HEAD_DIM), jnp.float32),
            jnp.full((Bb, ML_HEADS), ML_M_INIT, jnp.float32))
    h_c, h_l = [], []
    for d in range(2):
        hc, st = mlstm_chunkwise(*[_maybe_flip(t, d, 2) for t in qkv_c], _maybe_flip(ig_c[d], d, 2),
                                 _maybe_flip(lf_c[d], d, 2), zero, with_ctx)
        hl, _ = mlstm_chunkwise(*[_maybe_flip(t, d, 2) for t in qkv_l], _maybe_flip(ig_l[d], d, 2),
                                _maybe_flip(lf_l[d], d, 2), st, True)
        h_l.append(_maybe_flip(hl, d, 2))
        if with_ctx:
            h_c.append(_maybe_flip(hc, d, 2))

    def finish(hs, o):
        h = hs[0] + hs[1]
        h = h * lax.rsqrt(jnp.mean(h * h, axis=-1, keepdims=True) + EPS)
        y = jax.nn.sigmoid(o) * h
        Bb2, H, S, dh = y.shape
        return y.transpose(0, 2, 1, 3).reshape(Bb2, S, H * dh)

    y_c = finish(h_c, o_c) if with_ctx else None
    return y_c, finish(h_l, o_l)


def dwconv_centred(x, w, b):
    S = x.shape[1]
    left = RG_CONV // 2
    xp = jnp.pad(x, ((0, 0), (left, RG_CONV - 1 - left), (0, 0)))
    return sum(xp[:, j:j + S] * w[j] for j in range(RG_CONV)) + b


def linear_scan(a, b, h0):
    b = b.at[:, 0].add(a[:, 0] * h0)

    def comb(l, r):
        return (l[0] * r[0], r[0] * l[1] + r[1])
    _, h = lax.associative_scan(comb, (a, b), axis=1)
    return h


def rglru_gates(x, wa, ba, wx, bx, lam):
    Bb, S, W = x.shape
    xg = x.reshape(Bb, S, RG_BLOCKS, RG_BLOCK_DIM)
    r = jax.nn.sigmoid(jnp.einsum('bsgi,gij->bsgj', xg, wa).reshape(Bb, S, W) + ba)
    i = jax.nn.sigmoid(jnp.einsum('bsgi,gij->bsgj', xg, wx).reshape(Bb, S, W) + bx)
    log_a = -RG_C * r * jax.nn.softplus(-lam)
    a = jnp.exp(log_a)
    b = jnp.sqrt(-jnp.expm1(2.0 * log_a)) * (i * x)
    return a, b


def rglru_mixer(p_ctx, p_lat, conv_w, conv_b, wa, ba, wx, bx, lam, with_ctx):
    def prep(p):
        p = p.astype(jnp.float32)
        return dwconv_centred(p[..., :RG_WIDTH], conv_w, conv_b), jax.nn.gelu(p[..., RG_WIDTH:])

    xc, gc = prep(p_ctx)
    xl, gl = prep(p_lat)
    h_c, h_l = [], []
    for d in range(2):
        ac, bc = rglru_gates(xc, wa[d], ba[d], wx[d], bx[d], lam[d])
        sc = linear_scan(_maybe_flip(ac, d, 1), _maybe_flip(bc, d, 1), jnp.zeros_like(xc[:, 0]))
        al, bl = rglru_gates(xl, wa[d], ba[d], wx[d], bx[d], lam[d])
        sl = linear_scan(_maybe_flip(al, d, 1), _maybe_flip(bl, d, 1), sc[:, -1])
        h_l.append(_maybe_flip(sl, d, 1))
        if with_ctx:
            h_c.append(_maybe_flip(sc, d, 1))
    y_l = gl * group_rmsnorm(h_l[0] + h_l[1], RG_BLOCKS)
    y_c = gc * group_rmsnorm(h_c[0] + h_c[1], RG_BLOCKS) if with_ctx else None
    return y_c, y_l


def to_colmajor(x, rows):
    Bb, S, C = x.shape
    return x.reshape(Bb, rows, GRID_W, C).transpose(0, 2, 1, 3).reshape(Bb, S, C)


def from_colmajor(x, rows):
    Bb, S, C = x.shape
    return x.reshape(Bb, GRID_W, rows, C).transpose(0, 2, 1, 3).reshape(Bb, S, C)


def s5_discretise(lam_re, lam_im, log_dt, b_re, b_im):
    lr, li = lam_re.astype(jnp.float32), lam_im.astype(jnp.float32)
    dt = jnp.exp(log_dt.astype(jnp.float32))[:, None]
    mag = jnp.exp(lr * dt)
    ar, ai = mag * jnp.cos(li * dt), mag * jnp.sin(li * dt)
    den = lr * lr + li * li
    cr = ((ar - 1.0) * lr + ai * li) / den
    ci = (ai * lr - (ar - 1.0) * li) / den
    br, bi = b_re.astype(jnp.float32), b_im.astype(jnp.float32)
    bbr = cr[..., None] * br - ci[..., None] * bi
    bbi = cr[..., None] * bi + ci[..., None] * br
    return ar, ai, bbr, bbi


def complex_scan(ar, ai, ur, ui, h0r, h0i):
    a_r = jnp.broadcast_to(ar, ur.shape)
    a_i = jnp.broadcast_to(ai, ur.shape)
    ur = ur.at[:, 0].add(ar * h0r - ai * h0i)
    ui = ui.at[:, 0].add(ar * h0i + ai * h0r)

    def comb(l, r):
        l_ar, l_ai, l_br, l_bi = l
        r_ar, r_ai, r_br, r_bi = r
        return (r_ar * l_ar - r_ai * l_ai, r_ar * l_ai + r_ai * l_ar,
                r_ar * l_br - r_ai * l_bi + r_br, r_ar * l_bi + r_ai * l_br + r_bi)
    _, _, hr, hi = lax.associative_scan(comb, (a_r, a_i, ur, ui), axis=1)
    return hr, hi


def s5_mixer(p_ctx, p_lat, rows, lam_re, lam_im, log_dt, b_re, b_im, c_re, c_im, d_skip, glu_w, glu_b, with_ctx):
    uc = p_ctx.astype(jnp.float32)
    ul = to_colmajor(p_lat.astype(jnp.float32), rows)
    grp = lambda u: u.reshape(*u.shape[:2], S5_GROUPS, S5_GROUP)
    ucg, ulg = grp(uc), grp(ul)
    cr, cim = c_re.astype(jnp.float32), c_im.astype(jnp.float32)

    def readout(hr, hi):
        y = jnp.einsum('bsgn,gpn->bsgp', hr, cr) - jnp.einsum('bsgn,gpn->bsgp', hi, cim)
        return y.reshape(*y.shape[:2], S5_WIDTH)

    y_c, y_l = [], []
    for d in range(2):
        ar, ai, bbr, bbi = s5_discretise(lam_re[d], lam_im[d], log_dt[d], b_re, b_im)
        ur = _maybe_flip(jnp.einsum('bsgp,gnp->bsgn', ucg, bbr), d, 1)
        ui = _maybe_flip(jnp.einsum('bsgp,gnp->bsgn', ucg, bbi), d, 1)
        zc = jnp.zeros_like(ur[:, 0])
        hr, hi = complex_scan(ar, ai, ur, ui, zc, zc)
        if with_ctx:
            y_c.append(_maybe_flip(readout(hr, hi), d, 1))
        vr = _maybe_flip(jnp.einsum('bsgp,gnp->bsgn', ulg, bbr), d, 1)
        vi = _maybe_flip(jnp.einsum('bsgp,gnp->bsgn', ulg, bbi), d, 1)
        gr, gi = complex_scan(ar, ai, vr, vi, hr[:, -1], hi[:, -1])
        y_l.append(_maybe_flip(readout(gr, gi), d, 1))

    def finish(ys, u):
        y = ys[0] + ys[1] + d_skip * u
        g = jax.nn.gelu(y)
        out = g * jax.nn.sigmoid(g @ glu_w + glu_b)
        return group_rmsnorm(out, S5_GROUPS)

    out_l = from_colmajor(finish(y_l, ul), rows)
    out_c = finish(y_c, uc) if with_ctx else None
    return out_c, out_l


def expert_ffn(xb, e, wgu, bgu, wd, bd):
    gu = xb @ wgu[e] + bgu[e]
    gate = jnp.minimum(gu[:, :D_EXPERT], SWIGLU_LIMIT)
    up = jnp.clip(gu[:, D_EXPERT:], -SWIGLU_LIMIT, SWIGLU_LIMIT)
    glu = gate * jax.nn.sigmoid(SWIGLU_ALPHA * gate)
    return ((up + 1.0) * glu) @ wd[e] + bd[e]


def moe(h, router_w, router_b, wgu, bgu, wd, bd):
    T, Dm = h.shape
    logits = (h @ router_w + router_b).astype(jnp.float32)
    top_val, top_idx = lax.top_k(logits, TOP_K)
    gates = jax.nn.softmax(top_val, axis=-1)
    M = T * TOP_K
    flat_e = top_idx.reshape(-1)
    order = jnp.argsort(flat_e)
    e_sorted = flat_e[order]
    tok_sorted = order // TOP_K
    g_sorted = gates.reshape(-1)[order]
    counts = jnp.bincount(flat_e, length=N_EXPERTS)
    starts = jnp.cumsum(counts) - counts
    padded = (counts + MOE_BLOCK - 1) // MOE_BLOCK * MOE_BLOCK
    pad_ends = jnp.cumsum(padded)
    pad_starts = pad_ends - padded
    dest = pad_starts[e_sorted] + (jnp.arange(M) - starts[e_sorted])
    n_blocks = -(-M // MOE_BLOCK) + N_EXPERTS
    P = n_blocks * MOE_BLOCK
    pad_tok = jnp.full((P,), T, jnp.int32).at[dest].set(tok_sorted.astype(jnp.int32))
    pad_g = jnp.zeros((P,), jnp.float32).at[dest].set(g_sorted)
    block_e = jnp.minimum(jnp.searchsorted(pad_ends, jnp.arange(n_blocks) * MOE_BLOCK, side='right'), N_EXPERTS - 1)
    h_pad = jnp.concatenate([h, jnp.zeros((1, Dm), h.dtype)], axis=0)[pad_tok].reshape(n_blocks, MOE_BLOCK, Dm)
    y = lax.map(lambda args: expert_ffn(args[0], args[1], wgu, bgu, wd, bd), (h_pad, block_e))
    y = y.reshape(P, Dm) * pad_g[:, None]
    out = jax.ops.segment_sum(y, pad_tok, num_segments=T + 1)[:T]
    return out.astype(h.dtype)


def setup_inputs(seed: int = 0) -> dict:
    key = jax.random.key(seed)
    ks = jax.random.split(key, 40)
    L = DEPTH

    def nrm(i, shape, scale):
        return scale * jax.random.normal(ks[i], shape, jnp.float32)

    f0 = 4 * ML_WIDTH + 2 * ML_HEADS
    b_in = nrm(8, (L, D_IN), 0.02).at[:, f0:f0 + 2 * ML_HEADS].add(jnp.tile(jnp.linspace(3.0, 6.0, ML_HEADS), 2))
    u = jax.random.uniform(ks[15], (L, 2, RG_WIDTH), jnp.float32, 0.9, 0.999)
    s = u ** (1.0 / RG_C)
    return {
        'x': nrm(0, (BATCH, SEQ, D_MODEL), 1.0),
        'c': nrm(1, (BATCH, D_MODEL), 1.0),
        'ctx': nrm(2, (BATCH, CTX_LEN, D_MODEL), 1.0),
        'c_ctx': nrm(3, (D_MODEL,), 1.0),
        'ada_w': nrm(4, (L, D_MODEL, 6 * D_MODEL), 0.5 * D_MODEL ** -0.5),
        'ada_b': nrm(5, (L, 6 * D_MODEL), 0.02),
        'norm1_w': 1.0 + nrm(6, (L, D_MODEL), 0.02),
        'w_in': nrm(7, (L, D_MODEL, D_IN), D_MODEL ** -0.5),
        'b_in': b_in,
        'rg_conv_w': nrm(9, (L, RG_CONV, RG_WIDTH), RG_CONV ** -0.5),
        'rg_conv_b': nrm(10, (L, RG_WIDTH), 0.02),
        'rg_wa': nrm(11, (L, 2, RG_BLOCKS, RG_BLOCK_DIM, RG_BLOCK_DIM), RG_BLOCK_DIM ** -0.5),
        'rg_ba': nrm(12, (L, 2, RG_WIDTH), 0.02),
        'rg_wx': nrm(13, (L, 2, RG_BLOCKS, RG_BLOCK_DIM, RG_BLOCK_DIM), RG_BLOCK_DIM ** -0.5),
        'rg_bx': nrm(14, (L, 2, RG_WIDTH), 0.02),
        'rg_lambda': jnp.log(s) - jnp.log1p(-s),
        's5_lambda_re': -0.5 + nrm(16, (L, 2, S5_GROUPS, S5_STATE), 0.01),
        's5_lambda_im': jnp.pi * jnp.arange(S5_STATE, dtype=jnp.float32) + nrm(17, (L, 2, S5_GROUPS, S5_STATE), 0.01),
        's5_log_dt': jax.random.uniform(ks[18], (L, 2, S5_GROUPS), jnp.float32, math.log(1e-3), math.log(1e-1)),
        's5_b_re': nrm(19, (L, S5_GROUPS, S5_STATE, S5_GROUP), (2 * S5_GROUP) ** -0.5),
        's5_b_im': nrm(20, (L, S5_GROUPS, S5_STATE, S5_GROUP), (2 * S5_GROUP) ** -0.5),
        's5_c_re': nrm(21, (L, S5_GROUPS, S5_GROUP, S5_STATE), (2 * S5_STATE) ** -0.5),
        's5_c_im': nrm(22, (L, S5_GROUPS, S5_GROUP, S5_STATE), (2 * S5_STATE) ** -0.5),
        's5_d': nrm(23, (L, S5_WIDTH), 1.0),
        's5_glu_w': nrm(24, (L, S5_WIDTH, S5_WIDTH), S5_WIDTH ** -0.5),
        's5_glu_b': nrm(25, (L, S5_WIDTH), 0.02),
        'mix_norm_w': 1.0 + nrm(26, (L, D_MIX), 0.02),
        'w_out': nrm(27, (L, D_MIX, D_MODEL), D_MIX ** -0.5),
        'norm2_w': 1.0 + nrm(28, (L, D_MODEL), 0.02),
        'router_w': nrm(29, (L, D_MODEL, N_EXPERTS), D_MODEL ** -0.5),
        'router_b': nrm(30, (L, N_EXPERTS), 0.01),
        'moe_w_gate_up': nrm(31, (L, N_EXPERTS, D_MODEL, 2 * D_EXPERT), D_MODEL ** -0.5),
        'moe_b_gate_up': nrm(32, (L, N_EXPERTS, 2 * D_EXPERT), 0.02),
        'moe_w_down': nrm(33, (L, N_EXPERTS, D_EXPERT, D_MODEL), D_EXPERT ** -0.5),
        'moe_b_down': nrm(34, (L, N_EXPERTS, D_MODEL), 0.02),
        'final_norm_w': 1.0 + nrm(35, (D_MODEL,), 0.02),
    }


def reference(x, c, ctx, c_ctx, ada_w, ada_b, norm1_w, w_in, b_in, rg_conv_w, rg_conv_b, rg_wa, rg_ba,
              rg_wx, rg_bx, rg_lambda, s5_lambda_re, s5_lambda_im, s5_log_dt, s5_b_re, s5_b_im, s5_c_re,
              s5_c_im, s5_d, s5_glu_w, s5_glu_b, mix_norm_w, w_out, norm2_w, router_w, router_b,
              moe_w_gate_up, moe_b_gate_up, moe_w_down, moe_b_down, final_norm_w):
    Bb, S, Dm = x.shape
    Sc = ctx.shape[1]
    ROWS = S // GRID_W
    xl, xc = x, ctx
    sil_c = jax.nn.silu(c)
    sil_cc = jax.nn.silu(c_ctx)
    for l in range(DEPTH):
        with_ctx = l < DEPTH - 1
        mod_l = (sil_c @ ada_w[l] + ada_b[l])[:, None, :]
        mod_c = sil_cc @ ada_w[l] + ada_b[l]
        sh1_l, sc1_l, g1_l, sh2_l, sc2_l, g2_l = jnp.split(mod_l, 6, axis=-1)
        sh1_c, sc1_c, g1_c, sh2_c, sc2_c, g2_c = jnp.split(mod_c, 6, axis=-1)

        hl = modulate(rmsnorm(xl, norm1_w[l]), sh1_l, sc1_l)
        hc = modulate(rmsnorm(xc, norm1_w[l]), sh1_c, sc1_c)
        pl = hl @ w_in[l] + b_in[l]
        pc = hc @ w_in[l] + b_in[l]
        pl_a, pl_b, pl_c = jnp.split(pl, [A_COLS, A_COLS + B_COLS], axis=-1)
        pc_a, pc_b, pc_c = jnp.split(pc, [A_COLS, A_COLS + B_COLS], axis=-1)
        ya_c, ya_l = mlstm_mixer(pc_a, pl_a, with_ctx)
        yb_c, yb_l = rglru_mixer(pc_b, pl_b, rg_conv_w[l], rg_conv_b[l], rg_wa[l], rg_ba[l],
                                 rg_wx[l], rg_bx[l], rg_lambda[l], with_ctx)
        yc_c, yc_l = s5_mixer(pc_c, pl_c, ROWS, s5_lambda_re[l], s5_lambda_im[l], s5_log_dt[l], s5_b_re[l],
                              s5_b_im[l], s5_c_re[l], s5_c_im[l], s5_d[l], s5_glu_w[l], s5_glu_b[l], with_ctx)
        merged_l = (jnp.concatenate([ya_l, yb_l, yc_l], axis=-1) * mix_norm_w[l]).astype(x.dtype)
        xl = xl + g1_l * (merged_l @ w_out[l])
        if with_ctx:
            merged_c = (jnp.concatenate([ya_c, yb_c, yc_c], axis=-1) * mix_norm_w[l]).astype(x.dtype)
            xc = xc + g1_c * (merged_c @ w_out[l])

        hl = modulate(rmsnorm(xl, norm2_w[l]), sh2_l, sc2_l)
        if with_ctx:
            hc = modulate(rmsnorm(xc, norm2_w[l]), sh2_c, sc2_c)
            tokens = jnp.concatenate([hc.reshape(-1, Dm), hl.reshape(-1, Dm)], axis=0)
        else:
            tokens = hl.reshape(-1, Dm)
        f_out = moe(tokens, router_w[l], router_b[l], moe_w_gate_up[l], moe_b_gate_up[l],
                    moe_w_down[l], moe_b_down[l])
        if with_ctx:
            xc = xc + g2_c * f_out[:Bb * Sc].reshape(xc.shape)
            f_lat = f_out[Bb * Sc:]
        else:
            f_lat = f_out
        xl = xl + g2_l * f_lat.reshape(xl.shape)
    return rmsnorm(xl, final_norm_w)
```

```cpp
#include <hip/hip_runtime.h>
#include <stdint.h>
#include <stdio.h>

#ifndef MK_FUSED
#define MK_FUSED 0
#endif

typedef unsigned short bf16_t;
typedef short bf16x8 __attribute__((ext_vector_type(8)));
typedef float f32x4 __attribute__((ext_vector_type(4)));
typedef float f32x2 __attribute__((ext_vector_type(2)));
typedef unsigned u32x4 __attribute__((ext_vector_type(4)));
typedef unsigned u32x2 __attribute__((ext_vector_type(2)));
#define LAS __attribute__((address_space(3)))
#define DEVI __device__ __forceinline__

constexpr int DM = 1024, NB = 8, SEQ = 2048, CTXL = 256, DEPTH = 4;
constexpr int TCTX = NB * CTXL, TLAT = NB * SEQ, TT = TCTX + TLAT;
constexpr int DIN = 2576, NP = 2560;
constexpr int NE = 32;
constexpr int PMAX = 81920;
constexpr int NTHR = 512;
constexpr int LDS_BYTES = 152 * 1024;
constexpr float EPS = 1e-6f;
constexpr int PC_Q = 0, PC_K = 384, PC_V = 768, PC_O = 1152, PC_RX = 1536, PC_RG = 1920, PC_S5 = 2304;
constexpr int MLC = 18;
constexpr int RGC = 36;
constexpr int S5C = 72, S5R = NB * S5C;

constexpr size_t al256(size_t x) { return (x + 255) & ~(size_t)255; }
constexpr size_t WS_CTL   = 0;
constexpr size_t CTL_BYTES = 65536;
constexpr size_t CW_BAR = 0;
constexpr size_t CW_CNT = 4096;
constexpr size_t WS_WIN   = al256(WS_CTL + CTL_BYTES);
constexpr size_t WS_WOUT  = al256(WS_WIN + (size_t)DEPTH * NP * 1024 * 2);
constexpr size_t WS_WGU   = al256(WS_WOUT + (size_t)DEPTH * 1024 * 1024 * 2);
constexpr size_t WS_WD    = al256(WS_WGU + (size_t)DEPTH * NE * 2048 * 1024 * 2);
constexpr size_t WS_MOD   = al256(WS_WD + (size_t)DEPTH * NE * 1024 * 1024 * 2);
constexpr size_t WS_PW    = al256(WS_MOD + (size_t)DEPTH * 9 * 6144 * 4);
constexpr size_t WS_BB    = al256(WS_PW + (size_t)DEPTH * 16 * 2 * 64 * 33 * 8);
constexpr size_t WS_KT    = al256(WS_BB + (size_t)DEPTH * 16 * 2 * 64 * 16 * 8);
constexpr size_t WS_WY    = al256(WS_KT + (size_t)DEPTH * 16 * 2 * 32 * 256 * 4);
constexpr size_t WS_WE    = al256(WS_WY + (size_t)DEPTH * 16 * 512 * 768 * 2);
constexpr size_t WS_WRG   = al256(WS_WE + (size_t)DEPTH * 16 * 256 * 512 * 2);
constexpr size_t WS_WGLU  = al256(WS_WRG + (size_t)DEPTH * 6 * 256 * 64 * 2);
constexpr size_t WS_XS    = al256(WS_WGLU + (size_t)DEPTH * 256 * 256 * 2);
constexpr size_t WS_XMID  = al256(WS_XS + (size_t)TT * 1024 * 4);
constexpr size_t WS_H     = al256(WS_XMID + (size_t)TT * 1024 * 4);
constexpr size_t WS_GT    = al256(WS_H + (size_t)TT * 1024 * 2);
constexpr size_t WS_P     = al256(WS_GT + (size_t)TT * 16 * 4);
constexpr size_t WS_GB    = al256(WS_P + (size_t)TT * NP * 2);
constexpr size_t WS_GU    = al256(WS_GB + (size_t)TT * 8 * 4);
constexpr size_t WS_GCM   = al256(WS_GU + (size_t)TT * 8 * 4);
constexpr size_t WS_MSC   = al256(WS_GCM + (size_t)TT * 8 * 4);
constexpr size_t WS_CLOC  = al256(WS_MSC + (size_t)8 * 4 * 18 * 2 * 2 * 4);
constexpr size_t WS_NLOC  = al256(WS_CLOC + (size_t)8 * 4 * 18 * 2 * 9216 * 4);
constexpr size_t WS_C0    = al256(WS_NLOC + (size_t)8 * 4 * 18 * 2 * 96 * 4);
constexpr size_t WS_N0    = al256(WS_C0 + (size_t)8 * 4 * 18 * 2 * 9216 * 2);
constexpr size_t WS_M0    = al256(WS_N0 + (size_t)8 * 4 * 18 * 2 * 96 * 4);
constexpr size_t WS_RGA   = al256(WS_M0 + (size_t)8 * 4 * 18 * 2 * 4);
constexpr size_t WS_RGB   = al256(WS_RGA + (size_t)8 * 36 * 2 * 384 * 4);
constexpr size_t WS_RGC   = al256(WS_RGB + (size_t)8 * 36 * 2 * 384 * 4);
constexpr size_t WS_SLOC  = al256(WS_RGC + (size_t)8 * 36 * 2 * 384 * 4);
constexpr size_t WS_SIN   = al256(WS_SLOC + (size_t)16 * 576 * 256 * 4);
constexpr size_t WS_GS    = al256(WS_SIN + (size_t)16 * 576 * 256 * 2);
constexpr size_t WS_MRG   = al256(WS_GS + (size_t)TT * 256 * 2);
constexpr size_t WS_ELIST = al256(WS_MRG + (size_t)TT * 1024 * 2);
constexpr size_t WS_GLIST = al256(WS_ELIST + (size_t)NE * TT * 4);
constexpr size_t WS_TINFO = al256(WS_GLIST + (size_t)NE * TT * 4);
constexpr size_t WS_ACT   = al256(WS_TINFO + (size_t)TT * 4 * 4);
constexpr size_t WS_YPAD  = al256(WS_ACT + (size_t)PMAX * 1024 * 2);
constexpr size_t WS_BIN2  = al256(WS_YPAD + (size_t)PMAX * 1024 * 2);
constexpr size_t WS_END   = al256(WS_BIN2 + (size_t)DEPTH * NP * 4);

struct Params { const float* in[36]; float* out; unsigned char* ws; int lo, hi; };

enum { I_X = 0, I_C, I_CTX, I_CCTX, I_ADAW, I_ADAB, I_N1W, I_WIN, I_BIN, I_RGCW, I_RGCB, I_RGWA, I_RGBA, I_RGWX, I_RGBX, I_RGLAM,
       I_S5LRE, I_S5LIM, I_S5LDT, I_S5BRE, I_S5BIM, I_S5CRE, I_S5CIM, I_S5D, I_S5GW, I_S5GB, I_MIXW, I_WOUT, I_N2W, I_RW, I_RB,
       I_WGU, I_BGU, I_WD, I_BD, I_FNW };

DEVI bf16_t f2bf(float f) { unsigned u = __float_as_uint(f); u += 0x7FFFu + ((u >> 16) & 1u); return (bf16_t)(u >> 16); }
DEVI float bf2f(bf16_t b) { return __uint_as_float(((unsigned)b) << 16); }
DEVI unsigned pk_bf16(float lo, float hi) { return (unsigned)f2bf(lo) | ((unsigned)f2bf(hi) << 16); }
DEVI float sigmoidf_(float x) { return 1.0f / (1.0f + __expf(-x)); }
DEVI float gelu_tanh(float x) { const float u = 0.7978845608f * (x + 0.044715f * x * x * x); return x / (1.0f + __expf(-2.0f * u)); }
template <int M> DEVI float shx(float v, int lane) {
    if constexpr (M < 32) return __int_as_float(__builtin_amdgcn_ds_swizzle(__float_as_int(v), 0x1F | (M << 10)));
    else return __int_as_float(__builtin_amdgcn_ds_bpermute((lane ^ 32) << 2, __float_as_int(v)));
}
DEVI float shxr(float v, int m, int lane) {
    switch (m) { case 1: return shx<1>(v, lane); case 2: return shx<2>(v, lane); case 4: return shx<4>(v, lane); case 8: return shx<8>(v, lane); case 16: return shx<16>(v, lane); default: return shx<32>(v, lane); }
}
DEVI int shxri(int v, int m, int lane) { return __float_as_int(shxr(__int_as_float(v), m, lane)); }
template <int CTRL, int ROWMASK> DEVI float dpp_(float v) { return __int_as_float(__builtin_amdgcn_update_dpp(0, __float_as_int(v), CTRL, ROWMASK, 0xF, false)); }
DEVI float wave_sum(float v, int) {
    v += dpp_<0xB1, 0xF>(v); v += dpp_<0x4E, 0xF>(v); v += dpp_<0x141, 0xF>(v); v += dpp_<0x140, 0xF>(v);
    v += dpp_<0x142, 0xA>(v); v += dpp_<0x143, 0xC>(v);
    return __int_as_float(__builtin_amdgcn_readlane(__float_as_int(v), 63));
}
DEVI float log1p_(float e) { return e < 0.06f ? e * (1.0f - e * (0.5f - e * (0.33333334f - e * 0.25f))) : __logf(1.0f + e); }
DEVI int mod_row(int row) { return row < TCTX ? 8 : (row - TCTX) / SEQ; }

#define XB_TMO      128
#define XB_XCNT(j)  (256  + 64 * (j))
#define XB_XSUB(j)  (1280 + 64 * (j))
#define XB_XGEN(j)  (2304 + 64 * (j))
#define XB_TOP      3328
#define XB_TOPGEN   3392
#define XCD_BAR_WORDS 3456
#define XB_SPIN_CAP (1u << 18)
__device__ __forceinline__ unsigned xb_ld(unsigned* p)              { return __hip_atomic_load(p, __ATOMIC_RELAXED, __HIP_MEMORY_SCOPE_AGENT); }
__device__ __forceinline__ unsigned xb_add(unsigned* p, unsigned v) { return __hip_atomic_fetch_add(p, v, __ATOMIC_RELAXED, __HIP_MEMORY_SCOPE_AGENT); }
__device__ __forceinline__ unsigned xb_xcc_id() { return (unsigned)__builtin_amdgcn_s_getreg((3 << 11) | 20) & 0xFu; }
#define XB_SPIN(cond, bar) do { unsigned _sp = 0; while (cond) { __builtin_amdgcn_s_sleep(1); \
    if ((++_sp & 255u) == 0u) { if (xb_ld(&(bar)[XB_TMO])) break; if (_sp > XB_SPIN_CAP) { atomicAdd(&(bar)[XB_TMO], 1u); break; } } } } while (0)
struct XcdBarrier { unsigned* bar; unsigned x; volatile LAS unsigned* st; };
__device__ __forceinline__ XcdBarrier xcd_barrier_post(unsigned* bar, volatile LAS unsigned* st) {
    XcdBarrier b; b.bar = bar; b.x = xb_xcc_id(); b.st = st;
    if (threadIdx.x == 0) (void)xb_add(&bar[XB_XCNT(b.x)], 1u);
    return b;
}
__device__ __forceinline__ void xcd_barrier_complete(unsigned* bar, unsigned x, unsigned& nloc, unsigned& nx) {
    const unsigned G = gridDim.x * gridDim.y * gridDim.z;
    unsigned sum, cnt, mine, sp = 0u;
    for (;;) {
        sum = 0u; cnt = 0u; mine = 0u;
#pragma unroll
        for (unsigned j = 0; j < 16; ++j) { const unsigned c = xb_ld(&bar[XB_XCNT(j)]); sum += c; cnt += (c > 0u) ? 1u : 0u; mine = (j == x) ? c : mine; }
        if (sum == G) break;
        __builtin_amdgcn_s_sleep(1);
        if ((++sp & 255u) == 0u) { if (xb_ld(&bar[XB_TMO])) break; if (sp > XB_SPIN_CAP) { atomicAdd(&bar[XB_TMO], 1u); break; } }
    }
    nloc = mine > 0u ? mine : 1u; nx = cnt > 0u ? cnt : 1u;
}
__device__ __forceinline__ void xcd_barrier(const XcdBarrier& b) {
    asm volatile("s_waitcnt vmcnt(0)" ::: "memory");
    __syncthreads();
    if (threadIdx.x == 0) {
        unsigned* bar = b.bar;
        __builtin_amdgcn_s_waitcnt(0);
        unsigned nloc = b.st[0], nx = b.st[1];
        if (nloc == 0u) { xcd_barrier_complete(bar, b.x, nloc, nx); b.st[0] = nloc; b.st[1] = nx; }
        const unsigned old = xb_add(&bar[XB_XSUB(b.x)], 1u);
        const unsigned gen = old / nloc;
        if (old + 1u == (gen + 1u) * nloc) {
            __builtin_amdgcn_fence(__ATOMIC_RELEASE, "agent");
            asm volatile("s_waitcnt vmcnt(0)" ::: "memory");
            const unsigned og = xb_add(&bar[XB_TOP], 1u);
            const unsigned tg = og / nx;
            if (og + 1u == (tg + 1u) * nx) xb_add(&bar[XB_TOPGEN], 1u);
            else XB_SPIN(xb_ld(&bar[XB_TOPGEN]) == tg, bar);
            __builtin_amdgcn_fence(__ATOMIC_ACQUIRE, "agent");
            xb_add(&bar[XB_XGEN(b.x)], 1u);
            asm volatile("s_waitcnt vmcnt(0)" ::: "memory");
        } else {
            XB_SPIN(xb_ld(&bar[XB_XGEN(b.x)]) == gen, bar);
            __builtin_amdgcn_fence(__ATOMIC_ACQUIRE, "agent");
            asm volatile("s_waitcnt vmcnt(0)" ::: "memory");
        }
    }
    __syncthreads();
}

namespace g1 {
constexpr int BM = 256, BK = 64, HALF = 128, HTB = HALF * BK * 2, STAGE_BYTES = 8 * HTB, K = 1024, NT = K / BK;
DEVI int lds_byte(int r, int c) { const int st = (r >> 4) * 2 + (c >> 5), rr = r & 15, cc = c & 31, ob = rr * 64 + cc * 2; return st * 1024 + (ob ^ (((ob >> 9) & 1) << 5)); }
DEVI void stage_rc(int b, int& R, int& C) { const int st = b / 1024, sb = b % 1024, swz = sb ^ (((sb >> 9) & 1) << 5); R = (st >> 1) * 16 + swz / 64; C = (st & 1) * 32 + (swz % 64) / 2; }
DEVI int perm32(int rho) { const int n = rho >> 4, i = rho & 15; return 8 * (i >> 2) + 4 * n + (i & 3); }

struct Unit {
    const char* A;
    const int* list;
    int nvalid;
    const char* B;
    int pm, pn, e;
};

template <bool GATHER>
DEVI void a_offsets(const Unit& u, const int (&R)[2], const int (&C)[2], unsigned (&v)[2][2]) {
#pragma unroll
    for (int h = 0; h < 2; ++h)
#pragma unroll
        for (int i = 0; i < 2; ++i) {
            const int r = h * HALF + R[i];
            int src = r;
            if (GATHER) { src = (r < u.nvalid) ? u.list[r] : 0; }
            v[h][i] = (unsigned)src * (unsigned)(K * 2) + (unsigned)(C[i] * 2);
        }
}

template <class Sched, class Epi, bool GATHER>
DEVI void gemm_phase(LAS unsigned char* lds, const int tid, const Sched& S, const Epi& E) {
    const int wid = __builtin_amdgcn_readfirstlane(tid >> 6), lane = tid & 63, wr = wid >> 2, wc = wid & 3, fr = lane & 15, fq = lane >> 4;
    int R[2], C[2]; unsigned voffB[2];
#pragma unroll
    for (int i = 0; i < 2; ++i) { stage_rc(tid * 16 + i * 8192, R[i], C[i]); const int Rb = Epi::PERM ? ((R[i] & ~31) + perm32(R[i] & 31)) : R[i]; voffB[i] = (unsigned)(Rb * K + C[i]) * 2u; }
    constexpr size_t kstep = (size_t)(BK * 2);
    constexpr size_t hstep = (size_t)HALF * K * 2;
    const unsigned ldsw = (unsigned)wid * 1024u;
    const int aoff = lds_byte(wr * 64 + fr, fq * 8), boff = lds_byte(wc * 32 + fr, fq * 8);
#define G1_SA(b, h) (((b) * 2 + (h)) * HTB)
#define G1_SB(b, h) ((4 + (b) * 2 + (h)) * HTB)
#define G1_STAGE2(bufoff, gbase, v0, v1) do { \
        __builtin_amdgcn_global_load_lds((const unsigned*)((const char*)(gbase) + (v0)), (LAS unsigned*)(lds + (bufoff) + ldsw), 16, 0, 0); \
        __builtin_amdgcn_global_load_lds((const unsigned*)((const char*)(gbase) + (v1)), (LAS unsigned*)(lds + (bufoff) + ldsw + 8192), 16, 0, 0); } while (0)
#define G1_LDA(dst, b, h) do { _Pragma("unroll") for (int m = 0; m < 4; ++m) _Pragma("unroll") for (int k = 0; k < 2; ++k) dst[m][k] = *(const LAS bf16x8*)(lds + G1_SA(b, h) + aoff + m * 2048 + k * 1024); } while (0)
#define G1_LDB(dst, b, h) do { _Pragma("unroll") for (int n = 0; n < 2; ++n) _Pragma("unroll") for (int k = 0; k < 2; ++k) dst[n][k] = *(const LAS bf16x8*)(lds + G1_SB(b, h) + boff + n * 2048 + k * 1024); } while (0)
#define G1_MMA(ai, bj, At, Bt) do { __builtin_amdgcn_s_setprio(1); _Pragma("unroll") for (int m = 0; m < 4; ++m) _Pragma("unroll") for (int n = 0; n < 2; ++n) _Pragma("unroll") for (int k = 0; k < 2; ++k) \
        acc[ai][bj][m][n] = __builtin_amdgcn_mfma_f32_16x16x32_bf16(Bt[n][k], At[m][k], acc[ai][bj][m][n], 0, 0, 0); __builtin_amdgcn_s_setprio(0); } while (0)
#define G1_WAIT_V(n) asm volatile("s_waitcnt vmcnt(" #n ")" ::: "memory")
#define G1_WAIT_L(n) asm volatile("s_waitcnt lgkmcnt(" #n ")" ::: "memory")
#define G1_BAR __builtin_amdgcn_s_barrier()
#define G1_SCHED __builtin_amdgcn_sched_barrier(0)
    Unit cur, nxt; int ui = 0;
    if (!S.get(0, cur)) return;
    f32x4 acc[2][2][4][2];
#pragma unroll
    for (int a = 0; a < 2; ++a)
#pragma unroll
        for (int b = 0; b < 2; ++b)
#pragma unroll
            for (int m = 0; m < 4; ++m)
#pragma unroll
                for (int n = 0; n < 2; ++n) acc[a][b][m][n] = (f32x4){0.f, 0.f, 0.f, 0.f};
    bf16x8 At[4][2], B0[2][2], B1[2][2];
    unsigned vc[2][2], vn[2][2];
    a_offsets<GATHER>(cur, R, C, vc);
    const char* cA = cur.A; const char* cB = cur.B;
    G1_STAGE2(G1_SB(0, 0), cB, voffB[0], voffB[1]); G1_STAGE2(G1_SA(0, 0), cA, vc[0][0], vc[0][1]);
    G1_STAGE2(G1_SB(0, 1), cB + hstep, voffB[0], voffB[1]); G1_STAGE2(G1_SA(0, 1), cA, vc[1][0], vc[1][1]);
    if (wr == 1) G1_BAR;
    G1_WAIT_V(4); G1_BAR;
    G1_STAGE2(G1_SB(1, 0), cB + kstep, voffB[0], voffB[1]); G1_STAGE2(G1_SA(1, 0), cA + kstep, vc[0][0], vc[0][1]);
    G1_STAGE2(G1_SB(1, 1), cB + hstep + kstep, voffB[0], voffB[1]);
    G1_WAIT_V(6); G1_BAR;
    for (;;) {
        const bool has_next = S.get(ui + 1, nxt);
        if (has_next) { a_offsets<GATHER>(nxt, R, C, vn); }
        else {
#pragma unroll
            for (int h = 0; h < 2; ++h)
#pragma unroll
                for (int i = 0; i < 2; ++i) vn[h][i] = vc[h][i];
        }
        const char* nA = has_next ? nxt.A : cA; const char* nB = has_next ? nxt.B : cB;
        for (int t = 0; t < NT; t += 2) {
            const bool last = (t == NT - 2);
            const char* a1 = cA + (size_t)(t + 1) * kstep;
            const char* a2 = last ? nA : cA + (size_t)(t + 2) * kstep; const char* b2 = last ? nB : cB + (size_t)(t + 2) * kstep;
            const char* a3 = a2 + kstep; const char* b3 = b2 + kstep;
            const unsigned w00 = last ? vn[0][0] : vc[0][0], w01 = last ? vn[0][1] : vc[0][1], w10 = last ? vn[1][0] : vc[1][0], w11 = last ? vn[1][1] : vc[1][1];
            G1_LDB(B0, 0, 0); G1_SCHED; G1_LDA(At, 0, 0); G1_STAGE2(G1_SA(1, 1), a1, vc[1][0], vc[1][1]);
            G1_WAIT_L(8); G1_BAR; G1_WAIT_L(0); G1_MMA(0, 0, At, B0); G1_BAR; G1_SCHED;
            G1_LDB(B1, 0, 1); G1_STAGE2(G1_SB(0, 0), b2, voffB[0], voffB[1]);
            G1_BAR; G1_WAIT_L(0); G1_MMA(0, 1, At, B1); G1_BAR;
            G1_LDA(At, 0, 1); G1_STAGE2(G1_SA(0, 0), a2, w00, w01);
            G1_BAR; G1_WAIT_L(0); G1_MMA(1, 0, At, B0); G1_BAR; G1_SCHED;
            G1_STAGE2(G1_SB(0, 1), b2 + hstep, voffB[0], voffB[1]);
            G1_WAIT_V(6); G1_BAR; G1_MMA(1, 1, At, B1); G1_BAR;
            G1_LDB(B0, 1, 0); G1_SCHED; G1_LDA(At, 1, 0); G1_STAGE2(G1_SA(0, 1), a2, w10, w11);
            G1_WAIT_L(8); G1_BAR; G1_WAIT_L(0); G1_MMA(0, 0, At, B0); G1_BAR; G1_SCHED;
            G1_LDB(B1, 1, 1); G1_STAGE2(G1_SB(1, 0), b3, voffB[0], voffB[1]);
            G1_BAR; G1_WAIT_L(0); G1_MMA(0, 1, At, B1); G1_BAR;
            G1_LDA(At, 1, 1); G1_STAGE2(G1_SA(1, 0), a3, w00, w01);
            G1_BAR; G1_WAIT_L(0); G1_MMA(1, 0, At, B0); G1_BAR; G1_SCHED;
            G1_STAGE2(G1_SB(1, 1), b3 + hstep, voffB[0], voffB[1]);
            G1_WAIT_V(6); G1_BAR; G1_MMA(1, 1, At, B1); G1_BAR;
        }
        E(acc, cur, wr, wc, fr, fq);
        if (!has_next) break;
#pragma unroll
        for (int a = 0; a < 2; ++a)
#pragma unroll
            for (int b = 0; b < 2; ++b)
#pragma unroll
                for (int m = 0; m < 4; ++m)
#pragma unroll
                    for (int n = 0; n < 2; ++n) acc[a][b][m][n] = (f32x4){0.f, 0.f, 0.f, 0.f};
        cur = nxt; cA = nA; cB = nB; ++ui;
#pragma unroll
        for (int h = 0; h < 2; ++h)
#pragma unroll
            for (int i = 0; i < 2; ++i) vc[h][i] = vn[h][i];
    }
    G1_WAIT_V(0);
    if (wr == 0) G1_BAR;
    G1_BAR;
}
}

template <int MT, int NT_, class AF, class BF>
DEVI void wave_gemm(const int lane, int Kdim, const AF& af, const BF& bf, f32x4 (&acc)[MT][NT_]) {
    const int fr = lane & 15, fq = lane >> 4;
#pragma unroll
    for (int m = 0; m < MT; ++m)
#pragma unroll
        for (int n = 0; n < NT_; ++n) acc[m][n] = (f32x4){0.f, 0.f, 0.f, 0.f};
#pragma unroll 1
    for (int k0 = 0; k0 < Kdim; k0 += 32) {
        bf16x8 a[MT], b[NT_];
#pragma unroll
        for (int m = 0; m < MT; ++m) a[m] = af(m * 16 + fr, k0 + fq * 8);
#pragma unroll
        for (int n = 0; n < NT_; ++n) b[n] = bf(n * 16 + fr, k0 + fq * 8);
#pragma unroll
        for (int m = 0; m < MT; ++m)
#pragma unroll
            for (int n = 0; n < NT_; ++n) acc[m][n] = __builtin_amdgcn_mfma_f32_16x16x32_bf16(b[n], a[m], acc[m][n], 0, 0, 0);
    }
}
DEVI bf16x8 ldg8(const bf16_t* p) { return *(const bf16x8*)p; }

template <int N> struct Log2 { static constexpr int v = 1 + Log2<N / 2>::v; };
template <> struct Log2<1> { static constexpr int v = 0; };
template <int N>
DEVI float reduce_scatter(const int lane, float (&v)[N]) {
    constexpr int LG = Log2<N>::v;
#pragma unroll
    for (int st = 0; st < LG; ++st) {
        const int s = (N / 2) >> st, mask = 32 >> st;
        const bool up = (lane & mask) != 0;
#pragma unroll
        for (int i = 0; i < N / 2; ++i) if (i < s) {
            const float send = up ? v[i] : v[i + s];
            const float keep = up ? v[i + s] : v[i];
            v[i] = keep + shxr(send, mask, lane);
        }
    }
    float r = v[0];
#pragma unroll
    for (int st = LG; st < 6; ++st) r += shxr(r, 32 >> st, lane);
    return r;
}
template <int N>
DEVI int rs_index(int lane) {
    constexpr int LG = Log2<N>::v;
    int idx = 0;
#pragma unroll
    for (int st = 0; st < LG; ++st) if (lane & (32 >> st)) idx += (N / 2) >> st;
    return idx;
}

struct Ctx {
    const Params* p; unsigned char* ws; LAS unsigned char* lds; int tid, lane, wave, G, bid;
};
#define WSP(T, off) ((T*)(cx.ws + (off)))
DEVI Ctx relaunder(const Ctx& c) { Ctx r = c; int ln, td;
    asm volatile("v_mbcnt_lo_u32_b32 %0, -1, 0\n\tv_mbcnt_hi_u32_b32 %0, -1, %0\n\tv_lshl_add_u32 %1, %2, 6, %0" : "=&v"(ln), "=v"(td) : "s"(c.wave));
    r.lane = ln; r.tid = td; return r; }

DEVI void cvt_tile(const Ctx& cx, const float* src, int ld, bf16_t* dst, int n0, int k0, int kind) {
    LAS bf16_t* tile = (LAS bf16_t*)cx.lds;
    const int nn = cx.tid & 63, kk0 = (cx.tid >> 6) * 8, n = n0 + nn;
    int sc; float scale = 1.0f;
    if (kind == 0) { sc = n < 1536 ? n : n + 16; if (n >= 384 && n < 768) scale = 0.10206207261596577f; }
    else if (kind == 2) { const int pn = n >> 8, w = n & 255; sc = w < 128 ? pn * 128 + w : 1024 + pn * 128 + (w - 128); }
    else sc = n;
    float v[8];
#pragma unroll
    for (int j = 0; j < 8; ++j) v[j] = src[(size_t)(k0 + kk0 + j) * ld + sc] * scale;
    u32x4 w; w.x = pk_bf16(v[0], v[1]); w.y = pk_bf16(v[2], v[3]); w.z = pk_bf16(v[4], v[5]); w.w = pk_bf16(v[6], v[7]);
    *(LAS u32x4*)(tile + nn * 72 + kk0) = w;
    __syncthreads();
    const int row = cx.tid >> 3, ch = cx.tid & 7;
    const u32x4 o = *(const LAS u32x4*)(tile + row * 72 + ch * 8);
    *(u32x4*)(dst + (size_t)(n0 + row) * 1024 + k0 + ch * 8) = o;
    __syncthreads();
}

DEVI void ph_pro_a(const Ctx& cx) {
    const Params& P = *cx.p;
    {
        constexpr int n_in = DEPTH * 40 * 16, n_out = DEPTH * 16 * 16, n_gu = DEPTH * NE * 32 * 16, n_dn = DEPTH * NE * 16 * 16;
        constexpr int total = n_in + n_out + n_gu + n_dn;
        for (int job = cx.bid; job < total; job += cx.G) {
            int j = job;
            if (j < n_in) { const int l = j / 640, r = j % 640, nt = r / 16, kt = r % 16;
                cvt_tile(cx, P.in[I_WIN] + (size_t)l * 1024 * DIN, DIN, WSP(bf16_t, WS_WIN) + (size_t)l * NP * 1024, nt * 64, kt * 64, 0); continue; }
            j -= n_in;
            if (j < n_out) { const int l = j / 256, r = j % 256, nt = r / 16, kt = r % 16;
                cvt_tile(cx, P.in[I_WOUT] + (size_t)l * 1024 * 1024, 1024, WSP(bf16_t, WS_WOUT) + (size_t)l * 1024 * 1024, nt * 64, kt * 64, 1); continue; }
            j -= n_out;
            if (j < n_gu) { const int le = j / 512, r = j % 512, nt = r / 16, kt = r % 16;
                cvt_tile(cx, P.in[I_WGU] + (size_t)le * 1024 * 2048, 2048, WSP(bf16_t, WS_WGU) + (size_t)le * 2048 * 1024, nt * 64, kt * 64, 2); continue; }
            j -= n_gu;
            { const int le = j / 256, r = j % 256, nt = r / 16, kt = r % 16;
                cvt_tile(cx, P.in[I_WD] + (size_t)le * 1024 * 1024, 1024, WSP(bf16_t, WS_WD) + (size_t)le * 1024 * 1024, nt * 64, kt * 64, 1); }
        }
    }
    __syncthreads();
    {
        LAS float* sv = (LAS float*)cx.lds;
        LAS float* red = sv + 9 * 1024;
        constexpr int units = DEPTH * 6144 / 64;
        if (cx.bid < units) {
            for (int i = cx.tid; i < 9 * 1024; i += NTHR) { const int r = i >> 10, k = i & 1023; const float c = r < 8 ? P.in[I_C][r * 1024 + k] : P.in[I_CCTX][k]; sv[i] = c / (1.0f + __expf(-c)); }
            __syncthreads();
            for (int u = cx.bid; u < units; u += cx.G) {
                const int l = u / 96, n = (u % 96) * 64 + cx.lane;
                const float* w = P.in[I_ADAW] + (size_t)l * 1024 * 6144 + n;
                float acc[9];
#pragma unroll
                for (int r = 0; r < 9; ++r) acc[r] = 0.f;
                const int kb = cx.wave * 128;
#pragma unroll 4
                for (int k = 0; k < 128; ++k) { const float wv = w[(size_t)(kb + k) * 6144];
#pragma unroll
                    for (int r = 0; r < 9; ++r) acc[r] += sv[r * 1024 + kb + k] * wv; }
#pragma unroll
                for (int r = 0; r < 9; ++r) red[(cx.wave * 9 + r) * 64 + cx.lane] = acc[r];
                __syncthreads();
                for (int i = cx.tid; i < 9 * 64; i += NTHR) { const int r = i >> 6, ln = i & 63; float s = 0.f;
#pragma unroll
                    for (int w8 = 0; w8 < 8; ++w8) s += red[(w8 * 9 + r) * 64 + ln];
                    const int nn = (u % 96) * 64 + ln;
                    WSP(float, WS_MOD)[((size_t)l * 9 + r) * 6144 + nn] = s + P.in[I_ADAB][l * 6144 + nn]; }
                __syncthreads();
            }
        }
    }
    for (int gt = cx.bid * NTHR + cx.tid; gt < DEPTH * 16 * 2 * 64; gt += cx.G * NTHR) {
        const int n = gt & 63, d = (gt >> 6) & 1, g = (gt >> 7) & 15, l = gt >> 11;
        const float dt = expf(P.in[I_S5LDT][(l * 2 + d) * 16 + g]);
        const float lr = P.in[I_S5LRE][((l * 2 + d) * 16 + g) * 64 + n], li = P.in[I_S5LIM][((l * 2 + d) * 16 + g) * 64 + n];
        f32x2* pw = WSP(f32x2, WS_PW) + (size_t)gt * 33;
        float ar = 0.f, ai = 0.f;
        for (int k = 0; k <= 32; ++k) { const float mag = expf(lr * dt * (float)k); float s, c; sincosf(li * dt * (float)k, &s, &c); pw[k] = (f32x2){mag * c, mag * s}; if (k == 1) { ar = mag * c; ai = mag * s; } }
        const float den = lr * lr + li * li;
        const float cr = ((ar - 1.0f) * lr + ai * li) / den, ci = (ai * lr - (ar - 1.0f) * li) / den;
        f32x2* bb = WSP(f32x2, WS_BB) + (size_t)gt * 16;
        for (int q = 0; q < 16; ++q) { const float br = P.in[I_S5BRE][((l * 16 + g) * 64 + n) * 16 + q], bi = P.in[I_S5BIM][((l * 16 + g) * 64 + n) * 16 + q];
            bb[q] = (f32x2){cr * br - ci * bi, cr * bi + ci * br}; }
    }
    for (int i = cx.bid * NTHR + cx.tid; i < DEPTH * 6 * 256 * 64; i += cx.G * NTHR) {
        const int k = i & 63, n = (i >> 6) & 255, g = (i >> 14) % 6, l = (i >> 14) / 6;
        const int j = n & 63, type = (n >> 6) & 1, dir = n >> 7;
        const float* w = type ? P.in[I_RGWX] : P.in[I_RGWA];
        WSP(bf16_t, WS_WRG)[i] = f2bf(w[((((size_t)l * 2 + dir) * 6 + g) * 64 + k) * 64 + j]);
    }
    for (int i = cx.bid * NTHR + cx.tid; i < DEPTH * NP; i += cx.G * NTHR) {
        const int n = i % NP, l = i / NP; const int sc = n < 1536 ? n : n + 16;
        WSP(float, WS_BIN2)[i] = P.in[I_BIN][l * DIN + sc] * ((n >= 384 && n < 768) ? 0.10206207261596577f : 1.0f);
    }
    for (int i = cx.bid * NTHR + cx.tid; i < DEPTH * 256 * 256; i += cx.G * NTHR) {
        const int k = i & 255, n = (i >> 8) & 255, l = i >> 16;
        WSP(bf16_t, WS_WGLU)[i] = f2bf(P.in[I_S5GW][((size_t)l * 256 + k) * 256 + n]);
    }
}

DEVI void ph_pro_b(const Ctx& cx) {
    const Params& P = *cx.p;
    for (int i = cx.bid * NTHR + cx.tid; i < DEPTH * 16 * 2 * 32 * 256; i += cx.G * NTHR) {
        const int q = i & 15, p = (i >> 4) & 15, tau = (i >> 8) & 31, d = (i >> 13) & 1, g = (i >> 14) & 15, l = i >> 18;
        const f32x2* pw = WSP(f32x2, WS_PW) + (size_t)(((l * 16 + g) * 2 + d) * 64) * 33 + tau;
        const f32x2* bb = WSP(f32x2, WS_BB) + (size_t)(((l * 16 + g) * 2 + d) * 64) * 16 + q;
        const float* cre = P.in[I_S5CRE] + ((size_t)(l * 16 + g) * 16 + p) * 64;
        const float* cim = P.in[I_S5CIM] + ((size_t)(l * 16 + g) * 16 + p) * 64;
        float s = 0.f;
        for (int n = 0; n < 64; ++n) { const f32x2 a = pw[n * 33], b = bb[n * 16]; const float cr = cre[n], ci = cim[n];
            const float xr = cr * a.x - ci * a.y, xi = cr * a.y + ci * a.x; s += xr * b.x - xi * b.y; }
        WSP(float, WS_KT)[i] = s;
    }
}

DEVI void ph_pro_c(const Ctx& cx) {
    const Params& P = *cx.p;
    for (size_t i = (size_t)cx.bid * NTHR + cx.tid; i < (size_t)DEPTH * 16 * 512 * 768; i += (size_t)cx.G * NTHR) {
        const int k = (int)(i % 768), tp = (int)((i / 768) % 512), lg = (int)(i / (768 * 512));
        const int t = tp >> 4, p = tp & 15, l = lg >> 4, g = lg & 15;
        float v;
        if (k < 512) { const int s = k >> 4, q = k & 15; v = 0.f;
            const float* kt = WSP(float, WS_KT) + (size_t)lg * 2 * 32 * 256;
            if (s <= t) v += kt[((0 * 32) + (t - s)) * 256 + p * 16 + q];
            if (s >= t) v += kt[((1 * 32) + (s - t)) * 256 + p * 16 + q];
            if (s == t && p == q) v += P.in[I_S5D][l * 256 + g * 16 + p];
        } else { const int kk = k - 512, d = kk >> 7, im = (kk >> 6) & 1, n = kk & 63;
            const int pwr = d == 0 ? t + 1 : 32 - t;
            const f32x2 a = WSP(f32x2, WS_PW)[(size_t)((lg * 2 + d) * 64 + n) * 33 + pwr];
            const float cr = P.in[I_S5CRE][((size_t)lg * 16 + p) * 64 + n], ci = P.in[I_S5CIM][((size_t)lg * 16 + p) * 64 + n];
            v = im ? -(cr * a.y + ci * a.x) : (cr * a.x - ci * a.y);
        }
        WSP(bf16_t, WS_WY)[i] = f2bf(v);
    }
    for (size_t i = (size_t)cx.bid * NTHR + cx.tid; i < (size_t)DEPTH * 16 * 256 * 512; i += (size_t)cx.G * NTHR) {
        const int k = (int)(i & 511), no = (int)((i >> 9) & 255), lg = (int)(i >> 17);
        const int s = k >> 4, q = k & 15, d = no >> 7, im = (no >> 6) & 1, n = no & 63;
        const int pwr = d == 0 ? 31 - s : s;
        const f32x2 a = WSP(f32x2, WS_PW)[(size_t)((lg * 2 + d) * 64 + n) * 33 + pwr];
        const f32x2 b = WSP(f32x2, WS_BB)[(size_t)((lg * 2 + d) * 64 + n) * 16 + q];
        const float v = im ? (a.x * b.y + a.y * b.x) : (a.x * b.x - a.y * b.y);
        WSP(bf16_t, WS_WE)[i] = f2bf(v);
    }
}

DEVI void moe_info(const Ctx& cx, int l, LAS int* info) {
    if (cx.tid < 64) {
        const unsigned* cnt = (const unsigned*)(cx.ws + WS_CTL) + CW_CNT + l * 32;
        const int c = cx.lane < 32 ? (int)__hip_atomic_load(cnt + (cx.lane & 31), __ATOMIC_RELAXED, __HIP_MEMORY_SCOPE_AGENT) : 0;
        const int nt = (c + 255) >> 8;
        if (cx.lane < 32) { info[72 + cx.lane] = nt; info[40 + cx.lane] = c; }
        if (cx.lane == 0) { int run = 0; info[0] = 0; for (int e = 0; e < 32; ++e) { run += info[72 + e]; info[e + 1] = run; } }
    }
    __syncthreads();
}

DEVI void ph_norm1(const Ctx& cx, int l) {
    const Params& P = *cx.p;
    LAS float* wg = (LAS float*)cx.lds;
    LAS int* info = (LAS int*)(cx.lds + 1024 * 20 * 4);
    if (l < DEPTH) {
        for (int i = cx.tid; i < 1024 * 4; i += NTHR) { const int k = i >> 2, c4 = i & 3;
            *(LAS f32x4*)(wg + k * 20 + c4 * 4) = *(const f32x4*)(P.in[I_WIN] + ((size_t)l * 1024 + k) * DIN + 1536 + c4 * 4); }
    }
    if (l > 0) moe_info(cx, l - 1, info);
    __syncthreads();
    const int rbeg = (l == DEPTH) ? TCTX : 0;
    const float* modp = WSP(float, WS_MOD);
    for (int row = rbeg + cx.bid * 8 + cx.wave; row < TT; row += cx.G * 8) {
        asm volatile("" ::: "memory");
        float x[16];
        if (l == 0) {
            const float* src = row < TCTX ? P.in[I_CTX] + (size_t)row * 1024 : P.in[I_X] + (size_t)(row - TCTX) * 1024;
#pragma unroll
            for (int i = 0; i < 16; ++i) x[i] = src[cx.lane + 64 * i];
        } else {
            const float* src = WSP(float, WS_XMID) + (size_t)row * 1024;
            const float* g2 = modp + ((size_t)(l - 1) * 9 + mod_row(row)) * 6144 + 5120;
            const int* ti = WSP(int, WS_TINFO) + (size_t)row * 4;
            float y[16];
#pragma unroll
            for (int i = 0; i < 16; ++i) y[i] = 0.f;
#pragma unroll
            for (int k = 0; k < 4; ++k) { const int t = ti[k]; const int e = t >> 20, slot = t & 0xFFFFF;
                const bf16_t* yp = WSP(bf16_t, WS_YPAD) + ((size_t)info[e] * 256 + slot) * 1024;
#pragma unroll
                for (int i = 0; i < 16; ++i) y[i] += bf2f(yp[cx.lane + 64 * i]); }
#pragma unroll
            for (int i = 0; i < 16; ++i) x[i] = src[cx.lane + 64 * i] + g2[cx.lane + 64 * i] * y[i];
        }
        float ss = 0.f;
#pragma unroll
        for (int i = 0; i < 16; ++i) ss += x[i] * x[i];
        ss = wave_sum(ss, cx.lane);
        const float rstd = rsqrtf(ss * (1.0f / 1024.0f) + EPS);
        if (l == DEPTH) {
            float* o = P.out + (size_t)(row - TCTX) * 1024;
#pragma unroll
            for (int i = 0; i < 16; ++i) o[cx.lane + 64 * i] = x[i] * rstd * P.in[I_FNW][cx.lane + 64 * i];
            continue;
        }
        float* xs = WSP(float, WS_XS) + (size_t)row * 1024;
        const float* md = modp + ((size_t)l * 9 + mod_row(row)) * 6144;
        bf16_t* hp = WSP(bf16_t, WS_H) + (size_t)row * 1024;
        float ga[16];
#pragma unroll
        for (int j = 0; j < 16; ++j) ga[j] = 0.f;
#pragma unroll
        for (int i = 0; i < 16; ++i) {
            const int c = cx.lane + 64 * i;
            xs[c] = x[i];
            const float h = x[i] * rstd * P.in[I_N1W][l * 1024 + c] * (1.0f + md[1024 + c]) + md[c];
            hp[c] = f2bf(h);
#pragma unroll
            for (int q4 = 0; q4 < 4; ++q4) { const f32x4 w = *(const LAS f32x4*)(wg + c * 20 + q4 * 4);
                ga[q4 * 4 + 0] += h * w[0]; ga[q4 * 4 + 1] += h * w[1]; ga[q4 * 4 + 2] += h * w[2]; ga[q4 * 4 + 3] += h * w[3]; }
            if (i & 1) asm volatile("" ::: "memory");
        }
        float gsel = 0.f;
#pragma unroll
        for (int j = 0; j < 16; ++j) { const float tj = wave_sum(ga[j], 0); gsel = (cx.lane == j) ? tj : gsel; }
        if (cx.lane < 16) WSP(float, WS_GT)[(size_t)row * 16 + cx.lane] = gsel + P.in[I_BIN][l * DIN + 1536 + cx.lane];
    }
}

DEVI void ph_norm2(const Ctx& cx, int l) {
    const Params& P = *cx.p;
    LAS float* rw = (LAS float*)cx.lds;
    LAS int* hist = (LAS int*)(cx.lds + 1024 * 36 * 4);
    LAS int* pend = hist + 64;
    for (int i = cx.tid; i < 1024 * 8; i += NTHR) { const int k = i >> 3, c4 = i & 7;
        *(LAS f32x4*)(rw + k * 36 + c4 * 4) = *(const f32x4*)(P.in[I_RW] + ((size_t)l * 1024 + k) * 32 + c4 * 4); }
    if (cx.tid < 64) hist[cx.tid] = 0;
    __syncthreads();
    const int r0 = (l == DEPTH - 1) ? TCTX : 0, nr = TT - r0;
    const int rpb = (nr + cx.G - 1) / cx.G;
    const int rb = cx.bid * rpb, re = min(nr, rb + rpb);
    const float* modp = WSP(float, WS_MOD);
    for (int rl = rb + cx.wave; rl < re; rl += 8) {
        const int row = r0 + rl;
        const float* src = WSP(float, WS_XMID) + (size_t)row * 1024;
        const float* md = modp + ((size_t)l * 9 + mod_row(row)) * 6144;
        bf16_t* hp = WSP(bf16_t, WS_H) + (size_t)row * 1024;
        float x[16]; float ss = 0.f;
#pragma unroll
        for (int i = 0; i < 16; ++i) { x[i] = src[cx.lane + 64 * i]; ss += x[i] * x[i]; }
        ss = wave_sum(ss, cx.lane);
        const float rstd = rsqrtf(ss * (1.0f / 1024.0f) + EPS);
#pragma unroll
        for (int i = 0; i < 16; ++i) {
            const int c = cx.lane + 64 * i;
            x[i] = x[i] * rstd * P.in[I_N2W][l * 1024 + c] * (1.0f + md[4096 + c]) + md[3072 + c];
            hp[c] = f2bf(x[i]);
        }
        float lgt[32];
#pragma unroll
        for (int half = 0; half < 2; ++half) {
            float lg[16];
#pragma unroll
            for (int j = 0; j < 16; ++j) lg[j] = 0.f;
#pragma unroll
            for (int i = 0; i < 16; ++i) {
                const int c = cx.lane + 64 * i; const float h = x[i];
#pragma unroll
                for (int q4 = 0; q4 < 4; ++q4) { const f32x4 w = *(const LAS f32x4*)(rw + c * 36 + half * 16 + q4 * 4);
                    lg[q4 * 4 + 0] += h * w[0]; lg[q4 * 4 + 1] += h * w[1]; lg[q4 * 4 + 2] += h * w[2]; lg[q4 * 4 + 3] += h * w[3]; }
            }
#pragma unroll
            for (int j = 0; j < 16; ++j) lgt[half * 16 + j] = wave_sum(lg[j], 0) + P.in[I_RB][l * 32 + half * 16 + j];
        }
        float tv[4]; int tix[4]; unsigned taken = 0u;
#pragma unroll
        for (int k = 0; k < 4; ++k) {
            float bv = -3.0e38f; int bi = 0;
#pragma unroll
            for (int e = 0; e < 32; ++e) { const bool better = (lgt[e] > bv) && !((taken >> e) & 1u); bv = better ? lgt[e] : bv; bi = better ? e : bi; }
            tv[k] = bv; tix[k] = bi; taken |= 1u << bi;
        }
        const float e1 = __expf(tv[1] - tv[0]), e2 = __expf(tv[2] - tv[0]), e3 = __expf(tv[3] - tv[0]);
        const float inv = 1.0f / (1.0f + e1 + e2 + e3);
        const float gk[4] = {inv, e1 * inv, e2 * inv, e3 * inv};
        if (cx.lane < 4) {
            const int k = cx.lane; const int e = k == 0 ? tix[0] : k == 1 ? tix[1] : k == 2 ? tix[2] : tix[3];
            const float g = k == 0 ? gk[0] : k == 1 ? gk[1] : k == 2 ? gk[2] : gk[3];
            const int ls = __hip_atomic_fetch_add((LAS int*)(hist + e), 1, __ATOMIC_RELAXED, __HIP_MEMORY_SCOPE_WORKGROUP);
            pend[((rl - rb) * 4 + k) * 2 + 0] = (e << 20) | ls;
            pend[((rl - rb) * 4 + k) * 2 + 1] = __float_as_int(g);
        }
    }
    __syncthreads();
    if (cx.tid < 32) { unsigned* cnt = (unsigned*)(cx.ws + WS_CTL) + CW_CNT + l * 32;
        hist[32 + cx.tid] = hist[cx.tid] > 0 ? (int)__hip_atomic_fetch_add(cnt + cx.tid, (unsigned)hist[cx.tid], __ATOMIC_RELAXED, __HIP_MEMORY_SCOPE_AGENT) : 0; }
    __syncthreads();
    for (int i = cx.tid; i < (re - rb) * 4; i += NTHR) {
        const int t = pend[i * 2], e = t >> 20, slot = hist[32 + e] + (t & 0xFFFFF), row = r0 + rb + (i >> 2);
        WSP(int, WS_ELIST)[(size_t)e * TT + slot] = row;
        WSP(float, WS_GLIST)[(size_t)e * TT + slot] = __int_as_float(pend[i * 2 + 1]);
        WSP(int, WS_TINFO)[(size_t)row * 4 + (i & 3)] = (e << 20) | slot;
    }
}

DEVI int xcd_contig(int bid, int G) { return (G % 8 == 0) ? (bid % 8) * (G / 8) + bid / 8 : bid; }

struct DenseSched {
    const char* A; const char* B; int nM, nN, pm0, G, c;
    DEVI bool get(int i, g1::Unit& u) const {
        const int L = i * G + c; if (L >= nM * nN) return false;
        const int pm = L / nN, pn = L % nN;
        u.A = A + (size_t)(pm0 + pm) * 256 * 2048; u.list = nullptr; u.nvalid = 256; u.B = B + (size_t)pn * 256 * 2048; u.pm = pm0 + pm; u.pn = pn; u.e = 0;
        return true;
    }
};
struct MoeSched {
    const char* A; const char* B; const int* elist; const LAS int* info; int NPN, gather, G, c; size_t bstride;
    DEVI bool get(int i, g1::Unit& u) const {
        const int L = i * G + c; const int total = info[32] * NPN; if (L >= total) return false;
        int e = 0;
#pragma unroll 1
        for (int k = 1; k < 32; ++k) if (L >= info[k] * NPN) e = k;
        const int nt = info[e + 1] - info[e], ue = L - info[e] * NPN, pn = ue / nt, j = ue % nt;
        u.pm = info[e] + j; u.pn = pn; u.e = e;
        u.B = B + (size_t)e * bstride + (size_t)pn * 256 * 2048;
        if (gather) { u.A = A; u.list = elist + (size_t)e * TT + j * 256; u.nvalid = info[40 + e] - j * 256; }
        else { u.A = A + (size_t)u.pm * 256 * 2048; u.list = nullptr; u.nvalid = 256; }
        return true;
    }
};

struct EpiIn {
    static constexpr bool PERM = true;
    bf16_t* Pout; const float* bias;
    DEVI void operator()(const f32x4 (&acc)[2][2][4][2], const g1::Unit& u, int wr, int wc, int fr, int fq) const {
        const int row0 = u.pm * 256 + wr * 64 + fr;
#pragma unroll
        for (int bj = 0; bj < 2; ++bj) {
            const int col0 = u.pn * 256 + bj * 128 + wc * 32 + 8 * fq;
            const int seg = u.pn * 2 + bj; const bool gl = (seg >= 15 && seg < 18);
            const f32x4 b0 = *(const f32x4*)(bias + col0), b1 = *(const f32x4*)(bias + col0 + 4);
#pragma unroll
            for (int ai = 0; ai < 2; ++ai)
#pragma unroll
                for (int m = 0; m < 4; ++m) {
                    f32x4 v0 = acc[ai][bj][m][0] + b0, v1 = acc[ai][bj][m][1] + b1;
                    if (gl) {
#pragma unroll
                        for (int j = 0; j < 4; ++j) { v0[j] = gelu_tanh(v0[j]); v1[j] = gelu_tanh(v1[j]); } }
                    u32x4 w; w.x = pk_bf16(v0[0], v0[1]); w.y = pk_bf16(v0[2], v0[3]); w.z = pk_bf16(v1[0], v1[1]); w.w = pk_bf16(v1[2], v1[3]);
                    *(u32x4*)(Pout + (size_t)(row0 + ai * 128 + m * 16) * NP + col0) = w;
                }
        }
    }
};
struct EpiOut {
    static constexpr bool PERM = false;
    const float* xs; float* xmid; const float* mod;
    DEVI void operator()(const f32x4 (&acc)[2][2][4][2], const g1::Unit& u, int wr, int wc, int fr, int fq) const {
        const int row0 = u.pm * 256 + wr * 64 + fr;
        const float* g1p = mod + (size_t)mod_row(u.pm * 256) * 6144 + 2048;
#pragma unroll
        for (int bj = 0; bj < 2; ++bj)
#pragma unroll
            for (int n = 0; n < 2; ++n) {
                const int col = u.pn * 256 + bj * 128 + wc * 32 + 16 * n + 4 * fq;
                const f32x4 gv = *(const f32x4*)(g1p + col);
#pragma unroll
                for (int ai = 0; ai < 2; ++ai)
#pragma unroll
                    for (int m = 0; m < 4; ++m) {
                        const size_t off = (size_t)(row0 + ai * 128 + m * 16) * 1024 + col;
                        const f32x4 xv = *(const f32x4*)(xs + off);
                        *(f32x4*)(xmid + off) = xv + gv * acc[ai][bj][m][n];
                    }
            }
    }
};
struct EpiGU {
    static constexpr bool PERM = true;
    bf16_t* act; const float* bgu;
    DEVI void operator()(const f32x4 (&acc)[2][2][4][2], const g1::Unit& u, int wr, int wc, int fr, int fq) const {
        const int row0 = u.pm * 256 + wr * 64 + fr, colh = u.pn * 128 + wc * 32 + 8 * fq;
        const float* bg = bgu + (size_t)u.e * 2048 + colh; const float* bu = bg + 1024;
        const f32x4 bg0 = *(const f32x4*)bg, bg1 = *(const f32x4*)(bg + 4), bu0 = *(const f32x4*)bu, bu1 = *(const f32x4*)(bu + 4);
#pragma unroll
        for (int ai = 0; ai < 2; ++ai)
#pragma unroll
            for (int m = 0; m < 4; ++m) {
                float o[8];
#pragma unroll
                for (int n = 0; n < 2; ++n)
#pragma unroll
                    for (int j = 0; j < 4; ++j) {
                        const float g = fminf(acc[ai][0][m][n][j] + (n ? bg1[j] : bg0[j]), 7.0f);
                        const float up = fminf(fmaxf(acc[ai][1][m][n][j] + (n ? bu1[j] : bu0[j]), -7.0f), 7.0f);
                        o[n * 4 + j] = (up + 1.0f) * g / (1.0f + __expf(-1.702f * g));
                    }
                u32x4 w; w.x = pk_bf16(o[0], o[1]); w.y = pk_bf16(o[2], o[3]); w.z = pk_bf16(o[4], o[5]); w.w = pk_bf16(o[6], o[7]);
                *(u32x4*)(act + (size_t)(row0 + ai * 128 + m * 16) * 1024 + colh) = w;
            }
    }
};
struct EpiDown {
    static constexpr bool PERM = true;
    bf16_t* ypad; const float* bd; const float* glist; const LAS int* info;
    DEVI void operator()(const f32x4 (&acc)[2][2][4][2], const g1::Unit& u, int wr, int wc, int fr, int fq) const {
        const int j256 = (u.pm - info[u.e]) * 256, cnt = info[40 + u.e];
        const int rl0 = wr * 64 + fr;
#pragma unroll
        for (int ai = 0; ai < 2; ++ai)
#pragma unroll
            for (int m = 0; m < 4; ++m) {
                const int rl = rl0 + ai * 128 + m * 16, slot = j256 + rl;
                const float gt = slot < cnt ? glist[(size_t)u.e * TT + slot] : 0.f;
#pragma unroll
                for (int bj = 0; bj < 2; ++bj) {
                    const int col0 = u.pn * 256 + bj * 128 + wc * 32 + 8 * fq;
                    const f32x4 b0 = *(const f32x4*)(bd + (size_t)u.e * 1024 + col0), b1 = *(const f32x4*)(bd + (size_t)u.e * 1024 + col0 + 4);
                    const f32x4 v0 = (acc[ai][bj][m][0] + b0) * gt, v1 = (acc[ai][bj][m][1] + b1) * gt;
                    u32x4 w; w.x = pk_bf16(v0[0], v0[1]); w.y = pk_bf16(v0[2], v0[3]); w.z = pk_bf16(v1[0], v1[1]); w.w = pk_bf16(v1[2], v1[3]);
                    *(u32x4*)(ypad + (size_t)(u.pm * 256 + rl) * 1024 + col0) = w;
                }
            }
    }
};

DEVI void ph_inproj(const Ctx& cx, int l) {
    DenseSched S{(const char*)WSP(bf16_t, WS_H), (const char*)(WSP(bf16_t, WS_WIN) + (size_t)l * NP * 1024), TT / 256, NP / 256, 0, cx.G, xcd_contig(cx.bid, cx.G)};
    EpiIn E{WSP(bf16_t, WS_P), WSP(float, WS_BIN2) + (size_t)l * NP};
    g1::gemm_phase<DenseSched, EpiIn, false>(cx.lds, cx.tid, S, E);
}
DEVI void ph_outproj(const Ctx& cx, int l) {
    const int pm0 = (l == DEPTH - 1) ? TCTX / 256 : 0;
    DenseSched S{(const char*)WSP(bf16_t, WS_MRG), (const char*)(WSP(bf16_t, WS_WOUT) + (size_t)l * 1024 * 1024), TT / 256 - pm0, 4, pm0, cx.G, xcd_contig(cx.bid, cx.G)};
    EpiOut E{WSP(float, WS_XS), WSP(float, WS_XMID), WSP(float, WS_MOD) + (size_t)l * 9 * 6144};
    g1::gemm_phase<DenseSched, EpiOut, false>(cx.lds, cx.tid, S, E);
}
DEVI void ph_moe_gu(const Ctx& cx, int l) {
    LAS int* info = (LAS int*)(cx.lds + g1::STAGE_BYTES);
    moe_info(cx, l, info);
    MoeSched S{(const char*)WSP(bf16_t, WS_H), (const char*)(WSP(bf16_t, WS_WGU) + (size_t)l * NE * 2048 * 1024), WSP(int, WS_ELIST), info, 8, 1, cx.G, xcd_contig(cx.bid, cx.G), (size_t)2048 * 1024 * 2};
    EpiGU E{WSP(bf16_t, WS_ACT), cx.p->in[I_BGU] + (size_t)l * NE * 2048};
    g1::gemm_phase<MoeSched, EpiGU, true>(cx.lds, cx.tid, S, E);
}
DEVI void ph_moe_dn(const Ctx& cx, int l) {
    LAS int* info = (LAS int*)(cx.lds + g1::STAGE_BYTES);
    moe_info(cx, l, info);
    MoeSched S{(const char*)WSP(bf16_t, WS_ACT), (const char*)(WSP(bf16_t, WS_WD) + (size_t)l * NE * 1024 * 1024), nullptr, info, 4, 0, cx.G, xcd_contig(cx.bid, cx.G), (size_t)1024 * 1024 * 2};
    EpiDown E{WSP(bf16_t, WS_YPAD), cx.p->in[I_BD] + (size_t)l * NE * 1024, WSP(float, WS_GLIST), info};
    g1::gemm_phase<MoeSched, EpiDown, false>(cx.lds, cx.tid, S, E);
}

DEVI int ml_row0(int b, int c) { return c < 2 ? b * CTXL + c * 128 : TCTX + b * SEQ + (c - 2) * 128; }
DEVI unsigned short lds_u16(const LAS bf16_t* p) { return *p; }

DEVI void ml_local_unit(const Ctx& cx, int l, int b, int h, int c) {
    LAS float* sg = (LAS float*)cx.lds;
    LAS float* se = sg + 256;
    LAS float* red = se + 256;
    LAS bf16_t* Ks = (LAS bf16_t*)(cx.lds + 4352);
    LAS bf16_t* Ve = Ks + 128 * 104;
    const int row0 = ml_row0(b, c), tid = cx.tid;
    const int dir = (tid >> 7) & 1, i = tid & 127, p = dir ? 127 - i : i;
    const bool act = tid < 256;
    float gi = 0.f, bval = 0.f, u = 0.f;
    if (act) { const float* gt = WSP(float, WS_GT) + (size_t)(row0 + i) * 16; gi = gt[dir * 4 + h]; const float gf = gt[8 + dir * 4 + h];
        sg[dir * 128 + p] = fminf(gf, 0.f) - log1p_(__expf(-fabsf(gf))); }
    __syncthreads();
#pragma unroll 1
    for (int off = 1; off < 128; off <<= 1) { float v = 0.f; if (act) { v = sg[dir * 128 + p]; if (p >= off) v += sg[dir * 128 + p - off]; } __syncthreads(); if (act) sg[dir * 128 + p] = v; __syncthreads(); }
    if (act) { bval = sg[dir * 128 + p]; u = gi - bval; if (p == 127) red[dir] = bval; }
    __syncthreads();
    if (act) sg[dir * 128 + p] = u;
    __syncthreads();
#pragma unroll 1
    for (int off = 1; off < 128; off <<= 1) { float v = 0.f; if (act) { v = sg[dir * 128 + p]; if (p >= off) v = fmaxf(v, sg[dir * 128 + p - off]); } __syncthreads(); if (act) sg[dir * 128 + p] = v; __syncthreads(); }
    if (act) { const float cm = sg[dir * 128 + p]; if (p == 127) red[2 + dir] = cm;
        const size_t gix = (size_t)(row0 + i) * 8 + dir * 4 + h;
        WSP(float, WS_GB)[gix] = bval; WSP(float, WS_GU)[gix] = u; WSP(float, WS_GCM)[gix] = cm; }
    __syncthreads();
    if (act) se[dir * 128 + i] = expf(u - red[2 + dir]);
    if (tid < 2) { float* msc = WSP(float, WS_MSC) + ((size_t)((b * 4 + h) * MLC + c) * 2 + tid) * 2; msc[0] = red[tid]; msc[1] = red[tid] + red[2 + tid]; }
    __syncthreads();
    const bf16_t* Pp = WSP(bf16_t, WS_P);
#pragma unroll
    for (int it = 0; it < 3; ++it) { const int idx = tid + NTHR * it, r = idx / 12, ch = idx % 12;
        const u32x4 kv = *(const u32x4*)(Pp + (size_t)(row0 + r) * NP + PC_K + h * 96 + ch * 8);
        *(LAS u32x4*)(Ks + r * 104 + ch * 8) = kv;
        const u32x4 vv = *(const u32x4*)(Pp + (size_t)(row0 + r) * NP + PC_V + h * 96 + ch * 8);
        const float e0 = se[r], e1 = se[128 + r];
        u32x4 o0, o1;
#pragma unroll
        for (int q = 0; q < 4; ++q) { const float lo = __uint_as_float(vv[q] << 16), hi = __uint_as_float(vv[q] & 0xFFFF0000u);
            o0[q] = pk_bf16(lo * e0, hi * e0); o1[q] = pk_bf16(lo * e1, hi * e1); }
        *(LAS u32x4*)(Ve + r * 104 + ch * 8) = o0; *(LAS u32x4*)(Ve + (128 + r) * 104 + ch * 8) = o1; }
    __syncthreads();
    {
        const int wd = cx.wave >> 2, q9 = (cx.wave & 3) * 9, fr = cx.lane & 15, fq = cx.lane >> 4;
        float* cl = WSP(float, WS_CLOC) + ((size_t)((b * 4 + h) * MLC + c) * 2 + wd) * 9216;
        const LAS bf16_t* V = Ve + wd * 128 * 104;
#pragma unroll 1
        for (int pi = q9; pi < q9 + 9; ++pi) { const int dt = pi / 6, et = pi % 6;
            f32x4 acc = (f32x4){0.f, 0.f, 0.f, 0.f};
#pragma unroll
            for (int kk = 0; kk < 4; ++kk) { bf16x8 a, bb;
#pragma unroll
                for (int j = 0; j < 8; ++j) { const int s = kk * 32 + fq * 8 + j; a[j] = (short)lds_u16(V + s * 104 + dt * 16 + fr); bb[j] = (short)lds_u16(Ks + s * 104 + et * 16 + fr); }
                acc = __builtin_amdgcn_mfma_f32_16x16x32_bf16(a, bb, acc, 0, 0, 0); }
#pragma unroll
            for (int r = 0; r < 4; ++r) cl[(dt * 16 + fq * 4 + r) * 96 + et * 16 + fr] = acc[r]; }
    }
    if (tid < 192) { const int d2 = tid / 96, e = tid % 96; float s = 0.f;
        for (int t = 0; t < 128; ++t) s += se[d2 * 128 + t] * bf2f(Ks[t * 104 + e]);
        WSP(float, WS_NLOC)[((size_t)((b * 4 + h) * MLC + c) * 2 + d2) * 96 + e] = s; }
    __syncthreads();
}

DEVI void ml_carry(const Ctx& cx) {
    for (int idx = cx.bid * NTHR + cx.tid; idx < 64 * 9312; idx += cx.G * NTHR) {
        const int combo = idx / 9312, el = idx % 9312, dir = combo & 1, bh = combo >> 1;
        float Cv = 0.f, m = -1e30f;
#pragma unroll 1
        for (int s = 0; s < MLC; ++s) {
            const int c = dir == 0 ? s : (s < 2 ? 1 - s : 19 - s);
            const size_t cb = (size_t)(bh * MLC + c) * 2 + dir;
            const float bl = WSP(float, WS_MSC)[cb * 2], ml = WSP(float, WS_MSC)[cb * 2 + 1];
            float loc;
            if (el < 9216) { WSP(bf16_t, WS_C0)[cb * 9216 + el] = f2bf(Cv); loc = WSP(float, WS_CLOC)[cb * 9216 + el]; }
            else { WSP(float, WS_N0)[cb * 96 + el - 9216] = Cv; loc = WSP(float, WS_NLOC)[cb * 96 + el - 9216]; }
            if (el == 0) WSP(float, WS_M0)[cb] = m;
            const float mn = fmaxf(bl + m, ml), a = expf(bl + m - mn), sc = expf(ml - mn);
            Cv = a * Cv + sc * loc; m = mn;
        }
    }
}

DEVI void ml_out_unit(const Ctx& cx, int l, int b, int h, int c) {
    LAS bf16_t* Qs = (LAS bf16_t*)cx.lds;
    LAS bf16_t* Ks = Qs + 128 * 104;
    LAS bf16_t* Vs = Ks + 128 * 104;
    LAS bf16_t* C0s = Vs + 128 * 104;
    LAS float* gb = (LAS float*)(cx.lds + 119808);
    LAS float* gu = gb + 256;
    LAS float* gM = gu + 256;
    LAS float* n0s = gM + 256;
    LAS float* m0s = n0s + 192;
    const int row0 = ml_row0(b, c), tid = cx.tid;
    const bf16_t* Pp = WSP(bf16_t, WS_P);
    const size_t cb0 = (size_t)((b * 4 + h) * MLC + c) * 2;
#pragma unroll
    for (int it = 0; it < 3; ++it) { const int idx = tid + NTHR * it, r = idx / 12, ch = idx % 12;
        const bf16_t* rp = Pp + (size_t)(row0 + r) * NP + h * 96 + ch * 8;
        *(LAS u32x4*)(Qs + r * 104 + ch * 8) = *(const u32x4*)(rp + PC_Q);
        *(LAS u32x4*)(Ks + r * 104 + ch * 8) = *(const u32x4*)(rp + PC_K);
        *(LAS u32x4*)(Vs + r * 104 + ch * 8) = *(const u32x4*)(rp + PC_V); }
    for (int idx = tid; idx < 2 * 96 * 12; idx += NTHR) { const int d2 = idx / 1152, r = (idx % 1152) / 12, ch = idx % 12;
        *(LAS u32x4*)(C0s + (d2 * 96 + r) * 104 + ch * 8) = *(const u32x4*)(WSP(bf16_t, WS_C0) + (cb0 + d2) * 9216 + r * 96 + ch * 8); }
    if (tid < 256) { const int d2 = tid >> 7, i = tid & 127; const size_t gix = (size_t)(row0 + i) * 8 + d2 * 4 + h;
        gb[tid] = WSP(float, WS_GB)[gix]; gu[tid] = WSP(float, WS_GU)[gix];
        gM[tid] = fmaxf(WSP(float, WS_M0)[cb0 + d2], WSP(float, WS_GCM)[gix]); }
    if (tid >= 256 && tid < 448) { const int k = tid - 256; n0s[k] = WSP(float, WS_N0)[(cb0 + k / 96) * 96 + k % 96]; }
    if (tid >= 448 && tid < 450) m0s[tid - 448] = WSP(float, WS_M0)[cb0 + tid - 448];
    __syncthreads();
    const int w = cx.wave, fr = cx.lane & 15, fq = cx.lane >> 4, t = 16 * w + fr;
    bf16x8 qf[3];
#pragma unroll
    for (int kk = 0; kk < 3; ++kk) qf[kk] = *(const LAS bf16x8*)(Qs + t * 104 + kk * 32 + fq * 8);
    f32x4 hs[6];
#pragma unroll
    for (int n = 0; n < 6; ++n) hs[n] = (f32x4){0.f, 0.f, 0.f, 0.f};
#pragma unroll
    for (int dir = 0; dir < 2; ++dir) {
        const float Mt = gM[dir * 128 + t], bt = gb[dir * 128 + t], inter = expf(m0s[dir] - Mt);
        f32x4 an[6];
#pragma unroll
        for (int n = 0; n < 6; ++n) an[n] = (f32x4){0.f, 0.f, 0.f, 0.f};
        float den = 0.f;
        const int Jlo = dir == 0 ? 0 : (w >> 1), Jhi = dir == 0 ? (w >> 1) : 3;
#pragma unroll 1
        for (int J = Jlo; J <= Jhi; ++J) {
            bf16x8 pf;
#pragma unroll
            for (int half = 0; half < 2; ++half) {
                const int j = 2 * J + half;
                f32x4 D = (f32x4){0.f, 0.f, 0.f, 0.f};
                const bool need = dir == 0 ? (j <= w) : (j >= w);
                if (need) {
#pragma unroll
                    for (int kk = 0; kk < 3; ++kk) { const bf16x8 kf = *(const LAS bf16x8*)(Ks + (16 * j + fr) * 104 + kk * 32 + fq * 8);
                        D = __builtin_amdgcn_mfma_f32_16x16x32_bf16(kf, qf[kk], D, 0, 0, 0); }
                }
                const f32x4 us = *(const LAS f32x4*)(gu + dir * 128 + 16 * j + 4 * fq);
                float pv[4];
#pragma unroll
                for (int r = 0; r < 4; ++r) { const int s = 16 * j + 4 * fq + r; const bool valid = need && (dir == 0 ? (s <= t) : (s >= t));
                    pv[r] = valid ? D[r] * expf(us[r] - Mt) : 0.f; den += pv[r]; }
                pf[half * 4 + 0] = (short)f2bf(pv[0]); pf[half * 4 + 1] = (short)f2bf(pv[1]); pf[half * 4 + 2] = (short)f2bf(pv[2]); pf[half * 4 + 3] = (short)f2bf(pv[3]);
            }
#pragma unroll
            for (int n = 0; n < 6; ++n) { bf16x8 vf;
#pragma unroll
                for (int jj = 0; jj < 8; ++jj) { const int s = 32 * J + (jj < 4 ? 4 * fq + jj : 16 + 4 * fq + (jj - 4)); vf[jj] = (short)lds_u16(Vs + s * 104 + 16 * n + fr); }
                an[n] = __builtin_amdgcn_mfma_f32_16x16x32_bf16(vf, pf, an[n], 0, 0, 0); }
        }
        float nq = 0.f;
#pragma unroll
        for (int kk = 0; kk < 3; ++kk)
#pragma unroll
            for (int j = 0; j < 8; ++j) nq += n0s[dir * 96 + kk * 32 + fq * 8 + j] * bf2f((bf16_t)qf[kk][j]);
        nq += shx<16>(nq, cx.lane); nq += shx<32>(nq, cx.lane);
        den += shx<16>(den, cx.lane); den += shx<32>(den, cx.lane);
        const float dtot = den + inter * nq;
        const float inv = 1.0f / fmaxf(fabsf(dtot), expf(-(Mt + bt)));
#pragma unroll
        for (int n = 0; n < 6; ++n) { f32x4 ac = (f32x4){0.f, 0.f, 0.f, 0.f};
#pragma unroll
            for (int kk = 0; kk < 3; ++kk) { const bf16x8 cf = *(const LAS bf16x8*)(C0s + (dir * 96 + 16 * n + fr) * 104 + kk * 32 + fq * 8);
                ac = __builtin_amdgcn_mfma_f32_16x16x32_bf16(cf, qf[kk], ac, 0, 0, 0); }
            hs[n] += (an[n] + ac * inter) * inv; }
    }
    float ss = 0.f;
#pragma unroll
    for (int n = 0; n < 6; ++n) ss += hs[n][0] * hs[n][0] + hs[n][1] * hs[n][1] + hs[n][2] * hs[n][2] + hs[n][3] * hs[n][3];
    ss += shx<16>(ss, cx.lane); ss += shx<32>(ss, cx.lane);
    const float rstd = rsqrtf(ss * (1.0f / 96.0f) + EPS);
    const size_t prow = (size_t)(row0 + t);
#pragma unroll
    for (int n = 0; n < 6; ++n) { const int d = 16 * n + 4 * fq;
        const u32x2 ov = *(const u32x2*)(Pp + prow * NP + PC_O + h * 96 + d);
        const f32x4 mw = *(const f32x4*)(cx.p->in[I_MIXW] + l * 1024 + h * 96 + d);
        const float o0 = __uint_as_float(ov.x << 16), o1 = __uint_as_float(ov.x & 0xFFFF0000u), o2 = __uint_as_float(ov.y << 16), o3 = __uint_as_float(ov.y & 0xFFFF0000u);
        u32x2 wv; wv.x = pk_bf16(sigmoidf_(o0) * hs[n][0] * rstd * mw[0], sigmoidf_(o1) * hs[n][1] * rstd * mw[1]);
        wv.y = pk_bf16(sigmoidf_(o2) * hs[n][2] * rstd * mw[2], sigmoidf_(o3) * hs[n][3] * rstd * mw[3]);
        *(u32x2*)(WSP(bf16_t, WS_MRG) + prow * 1024 + h * 96 + d) = wv; }
    __syncthreads();
}

DEVI void rg_unit(const Ctx& cx, int l, int b, int ck, int g, int mode) {
    const Params& P = *cx.p;
    LAS float* xraw = (LAS float*)cx.lds;
    LAS float* xc = (LAS float*)(cx.lds + 17408);
    LAS bf16_t* xcb = (LAS bf16_t*)(cx.lds + 33792);
    LAS float* ab = (LAS float*)(cx.lds + 43008);
    const int tid = cx.tid;
    const int t0 = ck < 4 ? ck * 64 : (ck - 4) * 64, seglen = ck < 4 ? CTXL : SEQ, rowbase = ck < 4 ? b * CTXL : TCTX + b * SEQ;
    const bf16_t* Pp = WSP(bf16_t, WS_P);
    for (int idx = tid; idx < 67 * 8; idx += NTHR) { const int r = idx >> 3, c8 = idx & 7, tt = t0 - 2 + r;
        u32x4 v = (u32x4){0u, 0u, 0u, 0u};
        if (tt >= 0 && tt < seglen) v = *(const u32x4*)(Pp + (size_t)(rowbase + tt) * NP + PC_RX + g * 64 + c8 * 8);
#pragma unroll
        for (int q = 0; q < 4; ++q) { xraw[r * 64 + c8 * 8 + 2 * q] = __uint_as_float(v[q] << 16); xraw[r * 64 + c8 * 8 + 2 * q + 1] = __uint_as_float(v[q] & 0xFFFF0000u); } }
    __syncthreads();
#pragma unroll
    for (int it = 0; it < 8; ++it) { const int idx = tid + NTHR * it, t = idx >> 6, ch = idx & 63, cg = g * 64 + ch;
        float v = P.in[I_RGCB][l * 384 + cg];
#pragma unroll
        for (int j = 0; j < 4; ++j) v += P.in[I_RGCW][(l * 4 + j) * 384 + cg] * xraw[(t + j) * 64 + ch];
        xc[t * 64 + ch] = v; xcb[t * 72 + ch] = f2bf(v); }
    __syncthreads();
    {
        const int dir = cx.wave >> 2, cg4 = cx.wave & 3, fr = cx.lane & 15, fq = cx.lane >> 4;
        const bf16_t* wrg = WSP(bf16_t, WS_WRG) + (size_t)(l * 6 + g) * 256 * 64;
        f32x4 ar[4], ai[4];
#pragma unroll
        for (int m = 0; m < 4; ++m) { ar[m] = (f32x4){0.f, 0.f, 0.f, 0.f}; ai[m] = (f32x4){0.f, 0.f, 0.f, 0.f}; }
#pragma unroll
        for (int kk = 0; kk < 2; ++kk) {
            const bf16x8 br = ldg8(wrg + (size_t)((dir * 2 + 0) * 64 + cg4 * 16 + fr) * 64 + kk * 32 + fq * 8);
            const bf16x8 bi = ldg8(wrg + (size_t)((dir * 2 + 1) * 64 + cg4 * 16 + fr) * 64 + kk * 32 + fq * 8);
#pragma unroll
            for (int m = 0; m < 4; ++m) { const bf16x8 a = *(const LAS bf16x8*)(xcb + (m * 16 + fr) * 72 + kk * 32 + fq * 8);
                ar[m] = __builtin_amdgcn_mfma_f32_16x16x32_bf16(br, a, ar[m], 0, 0, 0); ai[m] = __builtin_amdgcn_mfma_f32_16x16x32_bf16(bi, a, ai[m], 0, 0, 0); }
        }
        const int ch0 = cg4 * 16 + 4 * fq, cgl = g * 64 + ch0;
        const f32x4 ba = *(const f32x4*)(P.in[I_RGBA] + (l * 2 + dir) * 384 + cgl), bx = *(const f32x4*)(P.in[I_RGBX] + (l * 2 + dir) * 384 + cgl);
        const f32x4 lam = *(const f32x4*)(P.in[I_RGLAM] + (l * 2 + dir) * 384 + cgl);
        float sp[4];
#pragma unroll
        for (int j = 0; j < 4; ++j) sp[j] = lam[j] > 0.f ? log1p_(__expf(-lam[j])) : -lam[j] + log1p_(__expf(lam[j]));
#pragma unroll
        for (int m = 0; m < 4; ++m) { const int t = m * 16 + fr; const f32x4 xv = *(const LAS f32x4*)(xc + t * 64 + ch0);
            f32x4 av, bv;
#pragma unroll
            for (int j = 0; j < 4; ++j) { const float r = 1.0f / (1.0f + __expf(-(ar[m][j] + ba[j]))), ii = 1.0f / (1.0f + __expf(-(ai[m][j] + bx[j])));
                const float la = -8.0f * r * sp[j], y = 2.0f * la; av[j] = __expf(la);
                const float nem1 = y > -0.3f ? -y * (1.0f + y * (0.5f + y * (0.16666667f + y * (0.041666668f + y * 0.0083333338f)))) : 1.0f - __expf(y);
                bv[j] = sqrtf(nem1) * (ii * xv[j]); }
            *(LAS f32x4*)(ab + ((dir * 2 + 0) * 64 + t) * 64 + ch0) = av; *(LAS f32x4*)(ab + ((dir * 2 + 1) * 64 + t) * 64 + ch0) = bv; }
    }
    __syncthreads();
    if (tid < 128) { const int dir = tid >> 6, ch = tid & 63; const size_t ix = ((size_t)(b * RGC + ck) * 2 + dir) * 384 + g * 64 + ch;
        float hc = mode ? WSP(float, WS_RGC)[ix] : 0.f, ap = 1.0f;
        LAS float* A = ab + (dir * 2 + 0) * 4096 + ch; LAS float* B = ab + (dir * 2 + 1) * 4096 + ch;
#pragma unroll 8
        for (int s = 0; s < 64; ++s) { const int t = dir ? 63 - s : s; const float a = A[t * 64]; hc = a * hc + B[t * 64]; ap *= a; if (mode) B[t * 64] = hc; }
        if (!mode) { WSP(float, WS_RGA)[ix] = ap; WSP(float, WS_RGB)[ix] = hc; } }
    __syncthreads();
    if (mode) { const int t = tid >> 3, ch0 = (tid & 7) * 8; float hv[8]; float ss = 0.f;
#pragma unroll
        for (int j = 0; j < 8; ++j) { hv[j] = ab[(1 * 64 + t) * 64 + ch0 + j] + ab[(3 * 64 + t) * 64 + ch0 + j]; ss += hv[j] * hv[j]; }
        ss += dpp_<0xB1, 0xF>(ss); ss += dpp_<0x4E, 0xF>(ss); ss += dpp_<0x141, 0xF>(ss);
        const float rstd = rsqrtf(ss * (1.0f / 64.0f) + EPS);
        const size_t row = (size_t)(rowbase + t0 + t);
        const u32x4 gv = *(const u32x4*)(Pp + row * NP + PC_RG + g * 64 + ch0);
        const float* mw = P.in[I_MIXW] + l * 1024 + 384 + g * 64 + ch0;
        u32x4 o;
#pragma unroll
        for (int q = 0; q < 4; ++q) { const float g0 = __uint_as_float(gv[q] << 16), g1v = __uint_as_float(gv[q] & 0xFFFF0000u);
            o[q] = pk_bf16(g0 * hv[2 * q] * rstd * mw[2 * q], g1v * hv[2 * q + 1] * rstd * mw[2 * q + 1]); }
        *(u32x4*)(WSP(bf16_t, WS_MRG) + row * 1024 + 384 + g * 64 + ch0) = o;
        __syncthreads(); }
}
DEVI void rg_carry(const Ctx& cx) {
    for (int idx = cx.bid * NTHR + cx.tid; idx < NB * 2 * 384; idx += cx.G * NTHR) {
        const int ch = idx % 384, dir = (idx / 384) & 1, b = idx / 768; float h = 0.f;
#pragma unroll 1
        for (int s = 0; s < RGC; ++s) { const int ck = dir == 0 ? s : (s < 4 ? 3 - s : 39 - s);
            const size_t ix = ((size_t)(b * RGC + ck) * 2 + dir) * 384 + ch;
            WSP(float, WS_RGC)[ix] = h; h = WSP(float, WS_RGA)[ix] * h + WSP(float, WS_RGB)[ix]; }
    }
}

DEVI int s5_trow(int rowi, int s) { const int b = rowi / S5C, c = rowi % S5C; return c < 8 ? b * CTXL + c * 32 + s : TCTX + b * SEQ + s * 64 + (c - 8); }
DEVI void s5_local_wave(const Ctx& cx, int l, int wu) {
    const int g = wu / 36, mt = (wu % 36) / 4, nt = wu % 4;
    const bf16_t* Pp = WSP(bf16_t, WS_P) + PC_S5 + g * 16;
    const bf16_t* we = WSP(bf16_t, WS_WE) + (size_t)(l * 16 + g) * 256 * 512 + (size_t)nt * 64 * 512;
    f32x4 acc[4][4];
    wave_gemm<4, 4>(cx.lane, 512, [&](int row, int k) { return ldg8(Pp + (size_t)s5_trow(mt * 64 + row, k >> 4) * NP + (k & 15)); },
                         [&](int row, int k) { return ldg8(we + (size_t)row * 512 + k); }, acc);
    const int fr = cx.lane & 15, fq = cx.lane >> 4;
#pragma unroll
    for (int m = 0; m < 4; ++m)
#pragma unroll
        for (int n = 0; n < 4; ++n) *(f32x4*)(WSP(float, WS_SLOC) + ((size_t)g * S5R + mt * 64 + m * 16 + fr) * 256 + nt * 64 + n * 16 + 4 * fq) = acc[m][n];
}
DEVI void s5_carry(const Ctx& cx, int l) {
    for (int idx = cx.bid * NTHR + cx.tid; idx < NB * 16 * 2 * 64; idx += cx.G * NTHR) {
        const int n = idx & 63, d = (idx >> 6) & 1, g = (idx >> 7) & 15, b = idx >> 11;
        const f32x2 a32 = WSP(f32x2, WS_PW)[(size_t)(((l * 16 + g) * 2 + d) * 64 + n) * 33 + 32];
        float sr = 0.f, si = 0.f;
#pragma unroll 1
        for (int s = 0; s < S5C; ++s) { const int c = d == 0 ? s : (s < 8 ? 7 - s : 79 - s);
            const size_t ix = ((size_t)g * S5R + b * S5C + c) * 256 + d * 128 + n;
            WSP(bf16_t, WS_SIN)[ix] = f2bf(sr); WSP(bf16_t, WS_SIN)[ix + 64] = f2bf(si);
            const float lr = WSP(float, WS_SLOC)[ix], li = WSP(float, WS_SLOC)[ix + 64];
            const float nr = a32.x * sr - a32.y * si + lr, ni = a32.x * si + a32.y * sr + li; sr = nr; si = ni; }
    }
}
DEVI void s5_out_wave(const Ctx& cx, int l, int wu) {
    const int g = wu / 72, mt = (wu % 72) / 8, nt = wu % 8;
    const bf16_t* Pp = WSP(bf16_t, WS_P) + PC_S5 + g * 16;
    const bf16_t* sin_ = WSP(bf16_t, WS_SIN) + (size_t)g * S5R * 256;
    const bf16_t* wy = WSP(bf16_t, WS_WY) + (size_t)(l * 16 + g) * 512 * 768 + (size_t)nt * 64 * 768;
    f32x4 acc[4][4];
    wave_gemm<4, 4>(cx.lane, 768, [&](int row, int k) { return k < 512 ? ldg8(Pp + (size_t)s5_trow(mt * 64 + row, k >> 4) * NP + (k & 15)) : ldg8(sin_ + (size_t)(mt * 64 + row) * 256 + (k - 512)); },
                         [&](int row, int k) { return ldg8(wy + (size_t)row * 768 + k); }, acc);
    const int fr = cx.lane & 15, fq = cx.lane >> 4;
#pragma unroll
    for (int m = 0; m < 4; ++m)
#pragma unroll
        for (int n = 0; n < 4; ++n) { const int trow = s5_trow(mt * 64 + m * 16 + fr, nt * 4 + n);
            u32x2 w; w.x = pk_bf16(gelu_tanh(acc[m][n][0]), gelu_tanh(acc[m][n][1])); w.y = pk_bf16(gelu_tanh(acc[m][n][2]), gelu_tanh(acc[m][n][3]));
            *(u32x2*)(WSP(bf16_t, WS_GS) + (size_t)trow * 256 + g * 16 + 4 * fq) = w; }
}
DEVI void s5_glu_wave(const Ctx& cx, int l, int wu) {
    const int mt = wu / 4, nt = wu % 4;
    const bf16_t* gs = WSP(bf16_t, WS_GS) + (size_t)mt * 64 * 256;
    const bf16_t* wg = WSP(bf16_t, WS_WGLU) + (size_t)l * 65536 + (size_t)nt * 64 * 256;
    f32x4 acc[4][4];
    wave_gemm<4, 4>(cx.lane, 256, [&](int row, int k) { return ldg8(gs + (size_t)row * 256 + k); }, [&](int row, int k) { return ldg8(wg + (size_t)row * 256 + k); }, acc);
    const int fr = cx.lane & 15, fq = cx.lane >> 4;
#pragma unroll
    for (int n = 0; n < 4; ++n) { const int col = nt * 64 + n * 16 + 4 * fq;
        const f32x4 gb = *(const f32x4*)(cx.p->in[I_S5GB] + l * 256 + col), mw = *(const f32x4*)(cx.p->in[I_MIXW] + l * 1024 + 768 + col);
#pragma unroll
        for (int m = 0; m < 4; ++m) { const size_t trow = (size_t)mt * 64 + m * 16 + fr;
            const u32x2 gv = *(const u32x2*)(WSP(bf16_t, WS_GS) + trow * 256 + col);
            const float gq[4] = {__uint_as_float(gv.x << 16), __uint_as_float(gv.x & 0xFFFF0000u), __uint_as_float(gv.y << 16), __uint_as_float(gv.y & 0xFFFF0000u)};
            float o[4]; float ss = 0.f;
#pragma unroll
            for (int j = 0; j < 4; ++j) { o[j] = gq[j] / (1.0f + __expf(-(acc[m][n][j] + gb[j]))); ss += o[j] * o[j]; }
            ss += shx<16>(ss, cx.lane); ss += shx<32>(ss, cx.lane);
            const float rstd = rsqrtf(ss * (1.0f / 16.0f) + EPS);
            u32x2 w; w.x = pk_bf16(o[0] * rstd * mw[0], o[1] * rstd * mw[1]); w.y = pk_bf16(o[2] * rstd * mw[2], o[3] * rstd * mw[3]);
            *(u32x2*)(WSP(bf16_t, WS_MRG) + trow * 1024 + 768 + col) = w; } }
}

DEVI void ph_mix_local(const Ctx& cx, int l) {
    for (int u = cx.bid; u < NB * 4 * MLC; u += cx.G) ml_local_unit(cx, l, u / (4 * MLC), (u / MLC) % 4, u % MLC);
    { const int off = (NB * 4 * MLC) % cx.G; const int first = (cx.bid - off + cx.G) % cx.G;
      for (int u = first; u < NB * RGC * 6; u += cx.G) rg_unit(cx, l, u / (RGC * 6), (u / 6) % RGC, u % 6, 0); }
    { const int off = (NB * 4 * MLC + NB * RGC * 6) % cx.G; const int first = (cx.bid - off + cx.G) % cx.G;
      for (int wu = first * 8 + cx.wave; wu < 16 * 36; wu += cx.G * 8) s5_local_wave(cx, l, wu); }
}
DEVI void ph_mix_carry(const Ctx& cx, int l) { ml_carry(cx); rg_carry(cx); s5_carry(cx, l); }
DEVI void ph_mix_out(const Ctx& cx, int l) {
    const bool last = (l == DEPTH - 1);
    for (int u = cx.bid; u < NB * 4 * MLC; u += cx.G) { const int c = u % MLC; if (last && c < 2) continue; ml_out_unit(cx, l, u / (4 * MLC), (u / MLC) % 4, c); }
    { const int off = (NB * 4 * MLC) % cx.G; const int first = (cx.bid - off + cx.G) % cx.G;
      for (int u = first; u < NB * RGC * 6; u += cx.G) { const int ck = (u / 6) % RGC; if (last && ck < 4) continue; rg_unit(cx, l, u / (RGC * 6), ck, u % 6, 1); } }
    { const int off = (NB * 4 * MLC + NB * RGC * 6) % cx.G; const int first = (cx.bid - off + cx.G) % cx.G;
      for (int wu = first * 8 + cx.wave; wu < 16 * 72; wu += cx.G * 8) s5_out_wave(cx, l, wu); }
}
DEVI void ph_glu(const Ctx& cx, int l) {
    for (int wu = cx.bid * 8 + cx.wave; wu < (TT / 64) * 4; wu += cx.G * 8) s5_glu_wave(cx, l, wu);
}

DEVI unsigned st_launder(unsigned s_addr) { unsigned a; asm volatile("v_mov_b32 %0, %1" : "=v"(a) : "s"(s_addr)); return a; }
constexpr int N_STEPS = 3 + 10 * DEPTH + 1;
__global__ void __launch_bounds__(NTHR, 2) mk_fwd(Params p) {
    extern __shared__ __attribute__((aligned(16))) unsigned char lds_raw[];
    Ctx cx; cx.p = &p; cx.ws = p.ws; cx.lds = (LAS unsigned char*)lds_raw; cx.tid = threadIdx.x; cx.lane = cx.tid & 63;
    cx.wave = __builtin_amdgcn_readfirstlane((int)threadIdx.x >> 6); cx.G = gridDim.x; cx.bid = blockIdx.x;
    volatile LAS unsigned* st = (volatile LAS unsigned*)(cx.lds + LDS_BYTES - 16);
    const unsigned st_s = (unsigned)__builtin_amdgcn_readfirstlane((int)(unsigned)(size_t)(LAS unsigned*)(cx.lds + LDS_BYTES - 16));
#define ST_P ((volatile LAS unsigned*)(size_t)st_launder(st_s))
    if (cx.tid == 0) { st[0] = 0u; st[1] = 0u; st[2] = (unsigned)p.lo; st[3] = (unsigned)p.hi; }
    __syncthreads();
    (void)xcd_barrier_post((unsigned*)(p.ws + WS_CTL) + CW_BAR, st);
#define GRID_BAR() do { XcdBarrier b_; b_.bar = (unsigned*)(p.ws + WS_CTL) + CW_BAR; b_.x = (unsigned)__builtin_amdgcn_readfirstlane((int)xb_xcc_id()); b_.st = ST_P; xcd_barrier(b_); } while (0)
#ifndef PH_MASK
#define PH_MASK 0xFFFF
#endif
#define STEP_(id, k, call) do { const int lo_ = __builtin_amdgcn_readfirstlane((int)ST_P[2]), hi_ = __builtin_amdgcn_readfirstlane((int)ST_P[3]); if (lo_ <= (k) && (k) < hi_) { if ((PH_MASK >> (id)) & 1) { const Ctx cl = relaunder(cx); call; } if ((k) + 1 < hi_) GRID_BAR(); } } while (0)
    STEP_(0, 0, ph_pro_a(cl));
    STEP_(1, 1, ph_pro_b(cl));
    STEP_(2, 2, ph_pro_c(cl));
#pragma unroll 1
    for (int l = 0; l < DEPTH; ++l) {
        const int s0 = 3 + 10 * l;
        STEP_(3, s0 + 0, ph_norm1(cl, l));
        STEP_(4, s0 + 1, ph_inproj(cl, l));
        STEP_(5, s0 + 2, ph_mix_local(cl, l));
        STEP_(6, s0 + 3, ph_mix_carry(cl, l));
        STEP_(7, s0 + 4, ph_mix_out(cl, l));
        STEP_(8, s0 + 5, ph_glu(cl, l));
        STEP_(9, s0 + 6, ph_outproj(cl, l));
        STEP_(10, s0 + 7, ph_norm2(cl, l));
        STEP_(11, s0 + 8, ph_moe_gu(cl, l));
        STEP_(12, s0 + 9, ph_moe_dn(cl, l));
    }
    STEP_(13, N_STEPS - 1, ph_norm1(cl, DEPTH));
#undef STEP_
}

extern "C" void kernel_launch(void* const* d_in, const int* in_sizes, int n_in, void* d_out, int out_size, void* d_ws, size_t ws_size, hipStream_t stream) {
    static int grid = 0;
    if (grid == 0) {
        if (n_in != 36 || out_size != TLAT * DM || ws_size < WS_END) { fprintf(stderr, "kernel_launch: unexpected problem (n_in %d, out %d, ws %zu < %zu)\n", n_in, out_size, ws_size, (size_t)WS_END); grid = -1; return; }
        int dev = 0, cus = 0, per_cu = 0;
        if (hipGetDevice(&dev) != hipSuccess || hipDeviceGetAttribute(&cus, hipDeviceAttributeMultiprocessorCount, dev) != hipSuccess) { grid = -1; return; }
        if (hipFuncSetAttribute((const void*)mk_fwd, hipFuncAttributeMaxDynamicSharedMemorySize, LDS_BYTES) != hipSuccess) { fprintf(stderr, "kernel_launch: hipFuncSetAttribute failed\n"); grid = -1; return; }
        if (hipOccupancyMaxActiveBlocksPerMultiprocessor(&per_cu, (const void*)mk_fwd, NTHR, LDS_BYTES) != hipSuccess || per_cu < 1) { fprintf(stderr, "kernel_launch: occupancy query says %d blocks per CU\n", per_cu); }
        (void)hipGetLastError();
        grid = cus;
    }
    if (grid < 0) return;
    (void)hipMemsetAsync((char*)d_ws + WS_CTL, 0, CTL_BYTES, stream);
    Params p{};
    for (int i = 0; i < 36; ++i) p.in[i] = (const float*)d_in[i];
    p.out = (float*)d_out; p.ws = (unsigned char*)d_ws;
#if MK_FUSED
    p.lo = 0; p.hi = N_STEPS;
    hipLaunchKernelGGL(mk_fwd, dim3(grid), dim3(NTHR), LDS_BYTES, stream, p);
#else
    for (int k = 0; k < N_STEPS; ++k) { p.lo = k; p.hi = k + 1; hipLaunchKernelGGL(mk_fwd, dim3(grid), dim3(NTHR), LDS_BYTES, stream, p); }
#endif
}
```

```cpp
#include <hip/hip_runtime.h>
#include <stdint.h>
#include <stdio.h>

#ifndef MK_FUSED
#define MK_FUSED 1
#endif

typedef unsigned short bf16_t;
typedef short bf16x8 __attribute__((ext_vector_type(8)));
typedef float f32x4 __attribute__((ext_vector_type(4)));
typedef float f32x2 __attribute__((ext_vector_type(2)));
typedef unsigned u32x4 __attribute__((ext_vector_type(4)));
typedef unsigned u32x2 __attribute__((ext_vector_type(2)));
#define LAS __attribute__((address_space(3)))
#define DEVI __device__ __forceinline__

constexpr int DM = 1024, NB = 8, SEQ = 2048, CTXL = 256, DEPTH = 4;
constexpr int TCTX = NB * CTXL, TLAT = NB * SEQ, TT = TCTX + TLAT;
constexpr int DIN = 2576, NP = 2560;
constexpr int NE = 32;
constexpr int PMAX = 81920;
constexpr int NTHR = 512;
constexpr int LDS_BYTES = 152 * 1024;
constexpr float EPS = 1e-6f;
constexpr int PC_Q = 0, PC_K = 384, PC_V = 768, PC_O = 1152, PC_RX = 1536, PC_RG = 1920, PC_S5 = 2304;
constexpr int MLC = 18;
constexpr int RGC = 36;
constexpr int S5C = 72, S5R = NB * S5C;

constexpr size_t al256(size_t x) { return (x + 255) & ~(size_t)255; }
constexpr size_t WS_CTL   = 0;
constexpr size_t CTL_BYTES = 65536;
constexpr size_t CW_BAR = 0;
constexpr size_t CW_CNT = 4096;
constexpr size_t WS_WIN   = al256(WS_CTL + CTL_BYTES);
constexpr size_t WS_WOUT  = al256(WS_WIN + (size_t)DEPTH * NP * 1024 * 2);
constexpr size_t WS_WGU   = al256(WS_WOUT + (size_t)DEPTH * 1024 * 1024 * 2);
constexpr size_t WS_WD    = al256(WS_WGU + (size_t)DEPTH * NE * 2048 * 1024 * 2);
constexpr size_t WS_MOD   = al256(WS_WD + (size_t)DEPTH * NE * 1024 * 1024 * 2);
constexpr size_t WS_PW    = al256(WS_MOD + (size_t)DEPTH * 9 * 6144 * 4);
constexpr size_t WS_BB    = al256(WS_PW + (size_t)DEPTH * 16 * 2 * 64 * 33 * 8);
constexpr size_t WS_KT    = al256(WS_BB + (size_t)DEPTH * 16 * 2 * 64 * 16 * 8);
constexpr size_t WS_WY    = al256(WS_KT + (size_t)DEPTH * 16 * 2 * 32 * 256 * 4);
constexpr size_t WS_WE    = al256(WS_WY + (size_t)DEPTH * 16 * 512 * 768 * 2);
constexpr size_t WS_WRG   = al256(WS_WE + (size_t)DEPTH * 16 * 256 * 512 * 2);
constexpr size_t WS_WGLU  = al256(WS_WRG + (size_t)DEPTH * 6 * 256 * 64 * 2);
constexpr size_t WS_XS    = al256(WS_WGLU + (size_t)DEPTH * 256 * 256 * 2);
constexpr size_t WS_XMID  = al256(WS_XS + (size_t)TT * 1024 * 4);
constexpr size_t WS_H     = al256(WS_XMID + (size_t)TT * 1024 * 4);
constexpr size_t WS_GT    = al256(WS_H + (size_t)TT * 1024 * 2);
constexpr size_t WS_P     = al256(WS_GT + (size_t)TT * 16 * 4);
constexpr size_t WS_GB    = al256(WS_P + (size_t)TT * NP * 2);
constexpr size_t WS_GU    = al256(WS_GB + (size_t)TT * 8 * 4);
constexpr size_t WS_GCM   = al256(WS_GU + (size_t)TT * 8 * 4);
constexpr size_t WS_MSC   = al256(WS_GCM + (size_t)TT * 8 * 4);
constexpr size_t WS_CLOC  = al256(WS_MSC + (size_t)8 * 4 * 18 * 2 * 2 * 4);
constexpr size_t WS_NLOC  = al256(WS_CLOC + (size_t)8 * 4 * 18 * 2 * 9216 * 4);
constexpr size_t WS_C0    = al256(WS_NLOC + (size_t)8 * 4 * 18 * 2 * 96 * 4);
constexpr size_t WS_N0    = al256(WS_C0 + (size_t)8 * 4 * 18 * 2 * 9216 * 2);
constexpr size_t WS_M0    = al256(WS_N0 + (size_t)8 * 4 * 18 * 2 * 96 * 4);
constexpr size_t WS_RGA   = al256(WS_M0 + (size_t)8 * 4 * 18 * 2 * 4);
constexpr size_t WS_RGB   = al256(WS_RGA + (size_t)8 * 36 * 2 * 384 * 4);
constexpr size_t WS_RGC   = al256(WS_RGB + (size_t)8 * 36 * 2 * 384 * 4);
constexpr size_t WS_SLOC  = al256(WS_RGC + (size_t)8 * 36 * 2 * 384 * 4);
constexpr size_t WS_SIN   = al256(WS_SLOC + (size_t)16 * 576 * 256 * 4);
constexpr size_t WS_GS    = al256(WS_SIN + (size_t)16 * 576 * 256 * 2);
constexpr size_t WS_MRG   = al256(WS_GS + (size_t)TT * 256 * 2);
constexpr size_t WS_ELIST = al256(WS_MRG + (size_t)TT * 1024 * 2);
constexpr size_t WS_GLIST = al256(WS_ELIST + (size_t)NE * TT * 4);
constexpr size_t WS_TINFO = al256(WS_GLIST + (size_t)NE * TT * 4);
constexpr size_t WS_ACT   = al256(WS_TINFO + (size_t)TT * 4 * 4);
constexpr size_t WS_YPAD  = al256(WS_ACT + (size_t)PMAX * 1024 * 2);
constexpr size_t WS_BIN2  = al256(WS_YPAD + (size_t)PMAX * 1024 * 2);
constexpr size_t WS_END   = al256(WS_BIN2 + (size_t)DEPTH * NP * 4);

struct Params { const float* in[36]; float* out; unsigned char* ws; int lo, hi; };

enum { I_X = 0, I_C, I_CTX, I_CCTX, I_ADAW, I_ADAB, I_N1W, I_WIN, I_BIN, I_RGCW, I_RGCB, I_RGWA, I_RGBA, I_RGWX, I_RGBX, I_RGLAM,
       I_S5LRE, I_S5LIM, I_S5LDT, I_S5BRE, I_S5BIM, I_S5CRE, I_S5CIM, I_S5D, I_S5GW, I_S5GB, I_MIXW, I_WOUT, I_N2W, I_RW, I_RB,
       I_WGU, I_BGU, I_WD, I_BD, I_FNW };

DEVI bf16_t f2bf(float f) { unsigned u = __float_as_uint(f); u += 0x7FFFu + ((u >> 16) & 1u); return (bf16_t)(u >> 16); }
DEVI float bf2f(bf16_t b) { return __uint_as_float(((unsigned)b) << 16); }
DEVI unsigned pk_bf16(float lo, float hi) { return (unsigned)f2bf(lo) | ((unsigned)f2bf(hi) << 16); }
DEVI float sigmoidf_(float x) { return 1.0f / (1.0f + __expf(-x)); }
DEVI float gelu_tanh(float x) { const float u = 0.7978845608f * (x + 0.044715f * x * x * x); return x / (1.0f + __expf(-2.0f * u)); }
template <int M> DEVI float shx(float v, int lane) {
    if constexpr (M < 32) return __int_as_float(__builtin_amdgcn_ds_swizzle(__float_as_int(v), 0x1F | (M << 10)));
    else return __int_as_float(__builtin_amdgcn_ds_bpermute((lane ^ 32) << 2, __float_as_int(v)));
}
DEVI float shxr(float v, int m, int lane) {
    switch (m) { case 1: return shx<1>(v, lane); case 2: return shx<2>(v, lane); case 4: return shx<4>(v, lane); case 8: return shx<8>(v, lane); case 16: return shx<16>(v, lane); default: return shx<32>(v, lane); }
}
DEVI int shxri(int v, int m, int lane) { return __float_as_int(shxr(__int_as_float(v), m, lane)); }
template <int CTRL, int ROWMASK> DEVI float dpp_(float v) { return __int_as_float(__builtin_amdgcn_update_dpp(0, __float_as_int(v), CTRL, ROWMASK, 0xF, false)); }
DEVI float wave_sum(float v, int) {
    v += dpp_<0xB1, 0xF>(v); v += dpp_<0x4E, 0xF>(v); v += dpp_<0x141, 0xF>(v); v += dpp_<0x140, 0xF>(v);
    v += dpp_<0x142, 0xA>(v); v += dpp_<0x143, 0xC>(v);
    return __int_as_float(__builtin_amdgcn_readlane(__float_as_int(v), 63));
}
DEVI float log1p_(float e) { return e < 0.06f ? e * (1.0f - e * (0.5f - e * (0.33333334f - e * 0.25f))) : __logf(1.0f + e); }
DEVI int mod_row(int row) { return row < TCTX ? 8 : (row - TCTX) / SEQ; }

#define XB_TMO      128
#define XB_XCNT(j)  (256  + 64 * (j))
#define XB_XSUB(j)  (1280 + 64 * (j))
#define XB_XGEN(j)  (2304 + 64 * (j))
#define XB_TOP      3328
#define XB_TOPGEN   3392
#define XCD_BAR_WORDS 3456
#define XB_SPIN_CAP (1u << 18)
__device__ __forceinline__ unsigned xb_ld(unsigned* p)              { return __hip_atomic_load(p, __ATOMIC_RELAXED, __HIP_MEMORY_SCOPE_AGENT); }
__device__ __forceinline__ unsigned xb_add(unsigned* p, unsigned v) { return __hip_atomic_fetch_add(p, v, __ATOMIC_RELAXED, __HIP_MEMORY_SCOPE_AGENT); }
__device__ __forceinline__ unsigned xb_xcc_id() { return (unsigned)__builtin_amdgcn_s_getreg((3 << 11) | 20) & 0xFu; }
#define XB_SPIN(cond, bar) do { unsigned _sp = 0; while (cond) { __builtin_amdgcn_s_sleep(1); \
    if ((++_sp & 255u) == 0u) { if (xb_ld(&(bar)[XB_TMO])) break; if (_sp > XB_SPIN_CAP) { atomicAdd(&(bar)[XB_TMO], 1u); break; } } } } while (0)
struct XcdBarrier { unsigned* bar; unsigned x; volatile LAS unsigned* st; };
__device__ __forceinline__ XcdBarrier xcd_barrier_post(unsigned* bar, volatile LAS unsigned* st) {
    XcdBarrier b; b.bar = bar; b.x = xb_xcc_id(); b.st = st;
    if (threadIdx.x == 0) (void)xb_add(&bar[XB_XCNT(b.x)], 1u);
    return b;
}
__device__ __forceinline__ void xcd_barrier_complete(unsigned* bar, unsigned x, unsigned& nloc, unsigned& nx) {
    const unsigned G = gridDim.x * gridDim.y * gridDim.z;
    unsigned sum, cnt, mine, sp = 0u;
    for (;;) {
        sum = 0u; cnt = 0u; mine = 0u;
#pragma unroll
        for (unsigned j = 0; j < 16; ++j) { const unsigned c = xb_ld(&bar[XB_XCNT(j)]); sum += c; cnt += (c > 0u) ? 1u : 0u; mine = (j == x) ? c : mine; }
        if (sum == G) break;
        __builtin_amdgcn_s_sleep(1);
        if ((++sp & 255u) == 0u) { if (xb_ld(&bar[XB_TMO])) break; if (sp > XB_SPIN_CAP) { atomicAdd(&bar[XB_TMO], 1u); break; } }
    }
    nloc = mine > 0u ? mine : 1u; nx = cnt > 0u ? cnt : 1u;
}
__device__ __forceinline__ void xcd_barrier(const XcdBarrier& b) {
    asm volatile("s_waitcnt vmcnt(0)" ::: "memory");
    __syncthreads();
    if (threadIdx.x == 0) {
        unsigned* bar = b.bar;
        __builtin_amdgcn_s_waitcnt(0);
        unsigned nloc = b.st[0], nx = b.st[1];
        if (nloc == 0u) { xcd_barrier_complete(bar, b.x, nloc, nx); b.st[0] = nloc; b.st[1] = nx; }
        const unsigned old = xb_add(&bar[XB_XSUB(b.x)], 1u);
        const unsigned gen = old / nloc;
        if (old + 1u == (gen + 1u) * nloc) {
            __builtin_amdgcn_fence(__ATOMIC_RELEASE, "agent");
            asm volatile("s_waitcnt vmcnt(0)" ::: "memory");
            const unsigned og = xb_add(&bar[XB_TOP], 1u);
            const unsigned tg = og / nx;
            if (og + 1u == (tg + 1u) * nx) xb_add(&bar[XB_TOPGEN], 1u);
            else XB_SPIN(xb_ld(&bar[XB_TOPGEN]) == tg, bar);
            __builtin_amdgcn_fence(__ATOMIC_ACQUIRE, "agent");
            xb_add(&bar[XB_XGEN(b.x)], 1u);
            asm volatile("s_waitcnt vmcnt(0)" ::: "memory");
        } else {
            XB_SPIN(xb_ld(&bar[XB_XGEN(b.x)]) == gen, bar);
            __builtin_amdgcn_fence(__ATOMIC_ACQUIRE, "agent");
            asm volatile("s_waitcnt vmcnt(0)" ::: "memory");
        }
    }
    __syncthreads();
}

namespace g1 {
constexpr int BM = 256, BK = 64, HALF = 128, HTB = HALF * BK * 2, STAGE_BYTES = 8 * HTB, K = 1024, NT = K / BK;
DEVI int lds_byte(int r, int c) { const int st = (r >> 4) * 2 + (c >> 5), rr = r & 15, cc = c & 31, ob = rr * 64 + cc * 2; return st * 1024 + (ob ^ (((ob >> 9) & 1) << 5)); }
DEVI void stage_rc(int b, int& R, int& C) { const int st = b / 1024, sb = b % 1024, swz = sb ^ (((sb >> 9) & 1) << 5); R = (st >> 1) * 16 + swz / 64; C = (st & 1) * 32 + (swz % 64) / 2; }
DEVI int perm32(int rho) { const int n = rho >> 4, i = rho & 15; return 8 * (i >> 2) + 4 * n + (i & 3); }

struct Unit {
    const char* A;
    const int* list;
    int nvalid;
    const char* B;
    int pm, pn, e;
};

template <bool GATHER>
DEVI void a_offsets(const Unit& u, const int (&R)[2], const int (&C)[2], unsigned (&v)[2][2]) {
#pragma unroll
    for (int h = 0; h < 2; ++h)
#pragma unroll
        for (int i = 0; i < 2; ++i) {
            const int r = h * HALF + R[i];
            int src = r;
            if (GATHER) { src = (r < u.nvalid) ? u.list[r] : 0; }
            v[h][i] = (unsigned)src * (unsigned)(K * 2) + (unsigned)(C[i] * 2);
        }
}

template <class Sched, class Epi, bool GATHER>
DEVI void gemm_phase(LAS unsigned char* lds, const int tid, const Sched& S, const Epi& E) {
    const int wid = __builtin_amdgcn_readfirstlane(tid >> 6), lane = tid & 63, wr = wid >> 2, wc = wid & 3, fr = lane & 15, fq = lane >> 4;
    int R[2], C[2]; unsigned voffB[2];
#pragma unroll
    for (int i = 0; i < 2; ++i) { stage_rc(tid * 16 + i * 8192, R[i], C[i]); const int Rb = Epi::PERM ? ((R[i] & ~31) + perm32(R[i] & 31)) : R[i]; voffB[i] = (unsigned)(Rb * K + C[i]) * 2u; }
    constexpr size_t kstep = (size_t)(BK * 2);
    constexpr size_t hstep = (size_t)HALF * K * 2;
    const unsigned ldsw = (unsigned)wid * 1024u;
    const int aoff = lds_byte(wr * 64 + fr, fq * 8), boff = lds_byte(wc * 32 + fr, fq * 8);
#define G1_SA(b, h) (((b) * 2 + (h)) * HTB)
#define G1_SB(b, h) ((4 + (b) * 2 + (h)) * HTB)
#define G1_STAGE2(bufoff, gbase, v0, v1) do { \
        __builtin_amdgcn_global_load_lds((const unsigned*)((const char*)(gbase) + (v0)), (LAS unsigned*)(lds + (bufoff) + ldsw), 16, 0, 0); \
        __builtin_amdgcn_global_load_lds((const unsigned*)((const char*)(gbase) + (v1)), (LAS unsigned*)(lds + (bufoff) + ldsw + 8192), 16, 0, 0); } while (0)
#define G1_LDA(dst, b, h) do { _Pragma("unroll") for (int m = 0; m < 4; ++m) _Pragma("unroll") for (int k = 0; k < 2; ++k) dst[m][k] = *(const LAS bf16x8*)(lds + G1_SA(b, h) + aoff + m * 2048 + k * 1024); } while (0)
#define G1_LDB(dst, b, h) do { _Pragma("unroll") for (int n = 0; n < 2; ++n) _Pragma("unroll") for (int k = 0; k < 2; ++k) dst[n][k] = *(const LAS bf16x8*)(lds + G1_SB(b, h) + boff + n * 2048 + k * 1024); } while (0)
#define G1_MMA(ai, bj, At, Bt) do { __builtin_amdgcn_s_setprio(1); _Pragma("unroll") for (int m = 0; m < 4; ++m) _Pragma("unroll") for (int n = 0; n < 2; ++n) _Pragma("unroll") for (int k = 0; k < 2; ++k) \
        acc[ai][bj][m][n] = __builtin_amdgcn_mfma_f32_16x16x32_bf16(Bt[n][k], At[m][k], acc[ai][bj][m][n], 0, 0, 0); __builtin_amdgcn_s_setprio(0); } while (0)
#define G1_WAIT_V(n) asm volatile("s_waitcnt vmcnt(" #n ")" ::: "memory")
#define G1_WAIT_L(n) asm volatile("s_waitcnt lgkmcnt(" #n ")" ::: "memory")
#define G1_BAR __builtin_amdgcn_s_barrier()
#define G1_SCHED __builtin_amdgcn_sched_barrier(0)
    Unit cur, nxt; int ui = 0;
    if (!S.get(0, cur)) return;
    f32x4 acc[2][2][4][2];
#pragma unroll
    for (int a = 0; a < 2; ++a)
#pragma unroll
        for (int b = 0; b < 2; ++b)
#pragma unroll
            for (int m = 0; m < 4; ++m)
#pragma unroll
                for (int n = 0; n < 2; ++n) acc[a][b][m][n] = (f32x4){0.f, 0.f, 0.f, 0.f};
    bf16x8 At[4][2], B0[2][2], B1[2][2];
    unsigned vc[2][2], vn[2][2];
    a_offsets<GATHER>(cur, R, C, vc);
    const char* cA = cur.A; const char* cB = cur.B;
    G1_STAGE2(G1_SB(0, 0), cB, voffB[0], voffB[1]); G1_STAGE2(G1_SA(0, 0), cA, vc[0][0], vc[0][1]);
    G1_STAGE2(G1_SB(0, 1), cB + hstep, voffB[0], voffB[1]); G1_STAGE2(G1_SA(0, 1), cA, vc[1][0], vc[1][1]);
    if (wr == 1) G1_BAR;
    G1_WAIT_V(4); G1_BAR;
    G1_STAGE2(G1_SB(1, 0), cB + kstep, voffB[0], voffB[1]); G1_STAGE2(G1_SA(1, 0), cA + kstep, vc[0][0], vc[0][1]);
    G1_STAGE2(G1_SB(1, 1), cB + hstep + kstep, voffB[0], voffB[1]);
    G1_WAIT_V(6); G1_BAR;
    for (;;) {
        const bool has_next = S.get(ui + 1, nxt);
        if (has_next) { a_offsets<GATHER>(nxt, R, C, vn); }
        else {
#pragma unroll
            for (int h = 0; h < 2; ++h)
#pragma unroll
                for (int i = 0; i < 2; ++i) vn[h][i] = vc[h][i];
        }
        const char* nA = has_next ? nxt.A : cA; const char* nB = has_next ? nxt.B : cB;
        for (int t = 0; t < NT; t += 2) {
            const bool last = (t == NT - 2);
            const char* a1 = cA + (size_t)(t + 1) * kstep;
            const char* a2 = last ? nA : cA + (size_t)(t + 2) * kstep; const char* b2 = last ? nB : cB + (size_t)(t + 2) * kstep;
            const char* a3 = a2 + kstep; const char* b3 = b2 + kstep;
            const unsigned w00 = last ? vn[0][0] : vc[0][0], w01 = last ? vn[0][1] : vc[0][1], w10 = last ? vn[1][0] : vc[1][0], w11 = last ? vn[1][1] : vc[1][1];
            G1_LDB(B0, 0, 0); G1_SCHED; G1_LDA(At, 0, 0); G1_STAGE2(G1_SA(1, 1), a1, vc[1][0], vc[1][1]);
            G1_WAIT_L(8); G1_BAR; G1_WAIT_L(0); G1_MMA(0, 0, At, B0); G1_BAR; G1_SCHED;
            G1_LDB(B1, 0, 1); G1_STAGE2(G1_SB(0, 0), b2, voffB[0], voffB[1]);
            G1_BAR; G1_WAIT_L(0); G1_MMA(0, 1, At, B1); G1_BAR;
            G1_LDA(At, 0, 1); G1_STAGE2(G1_SA(0, 0), a2, w00, w01);
            G1_BAR; G1_WAIT_L(0); G1_MMA(1, 0, At, B0); G1_BAR; G1_SCHED;
            G1_STAGE2(G1_SB(0, 1), b2 + hstep, voffB[0], voffB[1]);
            G1_WAIT_V(6); G1_BAR; G1_MMA(1, 1, At, B1); G1_BAR;
            G1_LDB(B0, 1, 0); G1_SCHED; G1_LDA(At, 1, 0); G1_STAGE2(G1_SA(0, 1), a2, w10, w11);
            G1_WAIT_L(8); G1_BAR; G1_WAIT_L(0); G1_MMA(0, 0, At, B0); G1_BAR; G1_SCHED;
            G1_LDB(B1, 1, 1); G1_STAGE2(G1_SB(1, 0), b3, voffB[0], voffB[1]);
            G1_BAR; G1_WAIT_L(0); G1_MMA(0, 1, At, B1); G1_BAR;
            G1_LDA(At, 1, 1); G1_STAGE2(G1_SA(1, 0), a3, w00, w01);
            G1_BAR; G1_WAIT_L(0); G1_MMA(1, 0, At, B0); G1_BAR; G1_SCHED;
            G1_STAGE2(G1_SB(1, 1), b3 + hstep, voffB[0], voffB[1]);
            G1_WAIT_V(6); G1_BAR; G1_MMA(1, 1, At, B1); G1_BAR;
        }
        E(acc, cur, wr, wc, fr, fq);
        if (!has_next) break;
#pragma unroll
        for (int a = 0; a < 2; ++a)
#pragma unroll
            for (int b = 0; b < 2; ++b)
#pragma unroll
                for (int m = 0; m < 4; ++m)
#pragma unroll
                    for (int n = 0; n < 2; ++n) acc[a][b][m][n] = (f32x4){0.f, 0.f, 0.f, 0.f};
        cur = nxt; cA = nA; cB = nB; ++ui;
#pragma unroll
        for (int h = 0; h < 2; ++h)
#pragma unroll
            for (int i = 0; i < 2; ++i) vc[h][i] = vn[h][i];
    }
    G1_WAIT_V(0);
    if (wr == 0) G1_BAR;
    G1_BAR;
}
}

template <int MT, int NT_, class AF, class BF>
DEVI void wave_gemm(const int lane, int Kdim, const AF& af, const BF& bf, f32x4 (&acc)[MT][NT_]) {
    const int fr = lane & 15, fq = lane >> 4;
#pragma unroll
    for (int m = 0; m < MT; ++m)
#pragma unroll
        for (int n = 0; n < NT_; ++n) acc[m][n] = (f32x4){0.f, 0.f, 0.f, 0.f};
#pragma unroll 1
    for (int k0 = 0; k0 < Kdim; k0 += 32) {
        bf16x8 a[MT], b[NT_];
#pragma unroll
        for (int m = 0; m < MT; ++m) a[m] = af(m * 16 + fr, k0 + fq * 8);
#pragma unroll
        for (int n = 0; n < NT_; ++n) b[n] = bf(n * 16 + fr, k0 + fq * 8);
#pragma unroll
        for (int m = 0; m < MT; ++m)
#pragma unroll
            for (int n = 0; n < NT_; ++n) acc[m][n] = __builtin_amdgcn_mfma_f32_16x16x32_bf16(b[n], a[m], acc[m][n], 0, 0, 0);
    }
}
DEVI bf16x8 ldg8(const bf16_t* p) { return *(const bf16x8*)p; }

template <int N> struct Log2 { static constexpr int v = 1 + Log2<N / 2>::v; };
template <> struct Log2<1> { static constexpr int v = 0; };
template <int N>
DEVI float reduce_scatter(const int lane, float (&v)[N]) {
    constexpr int LG = Log2<N>::v;
#pragma unroll
    for (int st = 0; st < LG; ++st) {
        const int s = (N / 2) >> st, mask = 32 >> st;
        const bool up = (lane & mask) != 0;
#pragma unroll
        for (int i = 0; i < N / 2; ++i) if (i < s) {
            const float send = up ? v[i] : v[i + s];
            const float keep = up ? v[i + s] : v[i];
            v[i] = keep + shxr(send, mask, lane);
        }
    }
    float r = v[0];
#pragma unroll
    for (int st = LG; st < 6; ++st) r += shxr(r, 32 >> st, lane);
    return r;
}
template <int N>
DEVI int rs_index(int lane) {
    constexpr int LG = Log2<N>::v;
    int idx = 0;
#pragma unroll
    for (int st = 0; st < LG; ++st) if (lane & (32 >> st)) idx += (N / 2) >> st;
    return idx;
}

struct Ctx {
    const Params* p; unsigned char* ws; LAS unsigned char* lds; int tid, lane, wave, G, bid;
};
#define WSP(T, off) ((T*)(cx.ws + (off)))
DEVI Ctx relaunder(const Ctx& c) { Ctx r = c; int ln, td;
    asm volatile("v_mbcnt_lo_u32_b32 %0, -1, 0\n\tv_mbcnt_hi_u32_b32 %0, -1, %0\n\tv_lshl_add_u32 %1, %2, 6, %0" : "=&v"(ln), "=v"(td) : "s"(c.wave));
    r.lane = ln; r.tid = td; return r; }

DEVI void cvt_tile(const Ctx& cx, const float* src, int ld, bf16_t* dst, int n0, int k0, int kind) {
    LAS bf16_t* tile = (LAS bf16_t*)cx.lds;
    const int nn = cx.tid & 63, kk0 = (cx.tid >> 6) * 8, n = n0 + nn;
    int sc; float scale = 1.0f;
    if (kind == 0) { sc = n < 1536 ? n : n + 16; if (n >= 384 && n < 768) scale = 0.10206207261596577f; }
    else if (kind == 2) { const int pn = n >> 8, w = n & 255; sc = w < 128 ? pn * 128 + w : 1024 + pn * 128 + (w - 128); }
    else sc = n;
    float v[8];
#pragma unroll
    for (int j = 0; j < 8; ++j) v[j] = src[(size_t)(k0 + kk0 + j) * ld + sc] * scale;
    u32x4 w; w.x = pk_bf16(v[0], v[1]); w.y = pk_bf16(v[2], v[3]); w.z = pk_bf16(v[4], v[5]); w.w = pk_bf16(v[6], v[7]);
    *(LAS u32x4*)(tile + nn * 72 + kk0) = w;
    __syncthreads();
    const int row = cx.tid >> 3, ch = cx.tid & 7;
    const u32x4 o = *(const LAS u32x4*)(tile + row * 72 + ch * 8);
    *(u32x4*)(dst + (size_t)(n0 + row) * 1024 + k0 + ch * 8) = o;
    __syncthreads();
}

DEVI void ph_pro_a(const Ctx& cx) {
    const Params& P = *cx.p;
    {
        constexpr int n_in = DEPTH * 40 * 16, n_out = DEPTH * 16 * 16, n_gu = DEPTH * NE * 32 * 16, n_dn = DEPTH * NE * 16 * 16;
        constexpr int total = n_in + n_out + n_gu + n_dn;
        for (int job = cx.bid; job < total; job += cx.G) {
            int j = job;
            if (j < n_in) { const int l = j / 640, r = j % 640, nt = r / 16, kt = r % 16;
                cvt_tile(cx, P.in[I_WIN] + (size_t)l * 1024 * DIN, DIN, WSP(bf16_t, WS_WIN) + (size_t)l * NP * 1024, nt * 64, kt * 64, 0); continue; }
            j -= n_in;
            if (j < n_out) { const int l = j / 256, r = j % 256, nt = r / 16, kt = r % 16;
                cvt_tile(cx, P.in[I_WOUT] + (size_t)l * 1024 * 1024, 1024, WSP(bf16_t, WS_WOUT) + (size_t)l * 1024 * 1024, nt * 64, kt * 64, 1); continue; }
            j -= n_out;
            if (j < n_gu) { const int le = j / 512, r = j % 512, nt = r / 16, kt = r % 16;
                cvt_tile(cx, P.in[I_WGU] + (size_t)le * 1024 * 2048, 2048, WSP(bf16_t, WS_WGU) + (size_t)le * 2048 * 1024, nt * 64, kt * 64, 2); continue; }
            j -= n_gu;
            { const int le = j / 256, r = j % 256, nt = r / 16, kt = r % 16;
                cvt_tile(cx, P.in[I_WD] + (size_t)le * 1024 * 1024, 1024, WSP(bf16_t, WS_WD) + (size_t)le * 1024 * 1024, nt * 64, kt * 64, 1); }
        }
    }
    __syncthreads();
    {
        LAS float* sv = (LAS float*)cx.lds;
        LAS float* red = sv + 9 * 1024;
        constexpr int units = DEPTH * 6144 / 64;
        if (cx.bid < units) {
            for (int i = cx.tid; i < 9 * 1024; i += NTHR) { const int r = i >> 10, k = i & 1023; const float c = r < 8 ? P.in[I_C][r * 1024 + k] : P.in[I_CCTX][k]; sv[i] = c / (1.0f + __expf(-c)); }
            __syncthreads();
            for (int u = cx.bid; u < units; u += cx.G) {
                const int l = u / 96, n = (u % 96) * 64 + cx.lane;
                const float* w = P.in[I_ADAW] + (size_t)l * 1024 * 6144 + n;
                float acc[9];
#pragma unroll
                for (int r = 0; r < 9; ++r) acc[r] = 0.f;
                const int kb = cx.wave * 128;
#pragma unroll 4
                for (int k = 0; k < 128; ++k) { const float wv = w[(size_t)(kb + k) * 6144];
#pragma unroll
                    for (int r = 0; r < 9; ++r) acc[r] += sv[r * 1024 + kb + k] * wv; }
#pragma unroll
                for (int r = 0; r < 9; ++r) red[(cx.wave * 9 + r) * 64 + cx.lane] = acc[r];
                __syncthreads();
                for (int i = cx.tid; i < 9 * 64; i += NTHR) { const int r = i >> 6, ln = i & 63; float s = 0.f;
#pragma unroll
                    for (int w8 = 0; w8 < 8; ++w8) s += red[(w8 * 9 + r) * 64 + ln];
                    const int nn = (u % 96) * 64 + ln;
                    WSP(float, WS_MOD)[((size_t)l * 9 + r) * 6144 + nn] = s + P.in[I_ADAB][l * 6144 + nn]; }
                __syncthreads();
            }
        }
    }
    for (int gt = cx.bid * NTHR + cx.tid; gt < DEPTH * 16 * 2 * 64; gt += cx.G * NTHR) {
        const int n = gt & 63, d = (gt >> 6) & 1, g = (gt >> 7) & 15, l = gt >> 11;
        const float dt = expf(P.in[I_S5LDT][(l * 2 + d) * 16 + g]);
        const float lr = P.in[I_S5LRE][((l * 2 + d) * 16 + g) * 64 + n], li = P.in[I_S5LIM][((l * 2 + d) * 16 + g) * 64 + n];
        f32x2* pw = WSP(f32x2, WS_PW) + (size_t)gt * 33;
        float ar = 0.f, ai = 0.f;
        for (int k = 0; k <= 32; ++k) { const float mag = expf(lr * dt * (float)k); float s, c; sincosf(li * dt * (float)k, &s, &c); pw[k] = (f32x2){mag * c, mag * s}; if (k == 1) { ar = mag * c; ai = mag * s; } }
        const float den = lr * lr + li * li;
        const float cr = ((ar - 1.0f) * lr + ai * li) / den, ci = (ai * lr - (ar - 1.0f) * li) / den;
        f32x2* bb = WSP(f32x2, WS_BB) + (size_t)gt * 16;
        for (int q = 0; q < 16; ++q) { const float br = P.in[I_S5BRE][((l * 16 + g) * 64 + n) * 16 + q], bi = P.in[I_S5BIM][((l * 16 + g) * 64 + n) * 16 + q];
            bb[q] = (f32x2){cr * br - ci * bi, cr * bi + ci * br}; }
    }
    for (int i = cx.bid * NTHR + cx.tid; i < DEPTH * 6 * 256 * 64; i += cx.G * NTHR) {
        const int k = i & 63, n = (i >> 6) & 255, g = (i >> 14) % 6, l = (i >> 14) / 6;
        const int j = n & 63, type = (n >> 6) & 1, dir = n >> 7;
        const float* w = type ? P.in[I_RGWX] : P.in[I_RGWA];
        WSP(bf16_t, WS_WRG)[i] = f2bf(w[((((size_t)l * 2 + dir) * 6 + g) * 64 + k) * 64 + j]);
    }
    for (int i = cx.bid * NTHR + cx.tid; i < DEPTH * NP; i += cx.G * NTHR) {
        const int n = i % NP, l = i / NP; const int sc = n < 1536 ? n : n + 16;
        WSP(float, WS_BIN2)[i] = P.in[I_BIN][l * DIN + sc] * ((n >= 384 && n < 768) ? 0.10206207261596577f : 1.0f);
    }
    for (int i = cx.bid * NTHR + cx.tid; i < DEPTH * 256 * 256; i += cx.G * NTHR) {
        const int k = i & 255, n = (i >> 8) & 255, l = i >> 16;
        WSP(bf16_t, WS_WGLU)[i] = f2bf(P.in[I_S5GW][((size_t)l * 256 + k) * 256 + n]);
    }
}

DEVI void ph_pro_b(const Ctx& cx) {
    const Params& P = *cx.p;
    for (int i = cx.bid * NTHR + cx.tid; i < DEPTH * 16 * 2 * 32 * 256; i += cx.G * NTHR) {
        const int q = i & 15, p = (i >> 4) & 15, tau = (i >> 8) & 31, d = (i >> 13) & 1, g = (i >> 14) & 15, l = i >> 18;
        const f32x2* pw = WSP(f32x2, WS_PW) + (size_t)(((l * 16 + g) * 2 + d) * 64) * 33 + tau;
        const f32x2* bb = WSP(f32x2, WS_BB) + (size_t)(((l * 16 + g) * 2 + d) * 64) * 16 + q;
        const float* cre = P.in[I_S5CRE] + ((size_t)(l * 16 + g) * 16 + p) * 64;
        const float* cim = P.in[I_S5CIM] + ((size_t)(l * 16 + g) * 16 + p) * 64;
        float s = 0.f;
        for (int n = 0; n < 64; ++n) { const f32x2 a = pw[n * 33], b = bb[n * 16]; const float cr = cre[n], ci = cim[n];
            const float xr = cr * a.x - ci * a.y, xi = cr * a.y + ci * a.x; s += xr * b.x - xi * b.y; }
        WSP(float, WS_KT)[i] = s;
    }
}

DEVI void ph_pro_c(const Ctx& cx) {
    const Params& P = *cx.p;
    for (size_t i = (size_t)cx.bid * NTHR + cx.tid; i < (size_t)DEPTH * 16 * 512 * 768; i += (size_t)cx.G * NTHR) {
        const int k = (int)(i % 768), tp = (int)((i / 768) % 512), lg = (int)(i / (768 * 512));
        const int t = tp >> 4, p = tp & 15, l = lg >> 4, g = lg & 15;
        float v;
        if (k < 512) { const int s = k >> 4, q = k & 15; v = 0.f;
            const float* kt = WSP(float, WS_KT) + (size_t)lg * 2 * 32 * 256;
            if (s <= t) v += kt[((0 * 32) + (t - s)) * 256 + p * 16 + q];
            if (s >= t) v += kt[((1 * 32) + (s - t)) * 256 + p * 16 + q];
            if (s == t && p == q) v += P.in[I_S5D][l * 256 + g * 16 + p];
        } else { const int kk = k - 512, d = kk >> 7, im = (kk >> 6) & 1, n = kk & 63;
            const int pwr = d == 0 ? t + 1 : 32 - t;
            const f32x2 a = WSP(f32x2, WS_PW)[(size_t)((lg * 2 + d) * 64 + n) * 33 + pwr];
            const float cr = P.in[I_S5CRE][((size_t)lg * 16 + p) * 64 + n], ci = P.in[I_S5CIM][((size_t)lg * 16 + p) * 64 + n];
            v = im ? -(cr * a.y + ci * a.x) : (cr * a.x - ci * a.y);
        }
        WSP(bf16_t, WS_WY)[i] = f2bf(v);
    }
    for (size_t i = (size_t)cx.bid * NTHR + cx.tid; i < (size_t)DEPTH * 16 * 256 * 512; i += (size_t)cx.G * NTHR) {
        const int k = (int)(i & 511), no = (int)((i >> 9) & 255), lg = (int)(i >> 17);
        const int s = k >> 4, q = k & 15, d = no >> 7, im = (no >> 6) & 1, n = no & 63;
        const int pwr = d == 0 ? 31 - s : s;
        const f32x2 a = WSP(f32x2, WS_PW)[(size_t)((lg * 2 + d) * 64 + n) * 33 + pwr];
        const f32x2 b = WSP(f32x2, WS_BB)[(size_t)((lg * 2 + d) * 64 + n) * 16 + q];
        const float v = im ? (a.x * b.y + a.y * b.x) : (a.x * b.x - a.y * b.y);
        WSP(bf16_t, WS_WE)[i] = f2bf(v);
    }
}

DEVI void moe_info(const Ctx& cx, int l, LAS int* info) {
    if (cx.tid < 64) {
        const unsigned* cnt = (const unsigned*)(cx.ws + WS_CTL) + CW_CNT + l * 32;
        const int c = cx.lane < 32 ? (int)__hip_atomic_load(cnt + (cx.lane & 31), __ATOMIC_RELAXED, __HIP_MEMORY_SCOPE_AGENT) : 0;
        const int nt = (c + 255) >> 8;
        if (cx.lane < 32) { info[72 + cx.lane] = nt; info[40 + cx.lane] = c; }
        if (cx.lane == 0) { int run = 0; info[0] = 0; for (int e = 0; e < 32; ++e) { run += info[72 + e]; info[e + 1] = run; } }
    }
    __syncthreads();
}

DEVI void ph_norm1(const Ctx& cx, int l) {
    const Params& P = *cx.p;
    LAS float* wg = (LAS float*)cx.lds;
    LAS int* info = (LAS int*)(cx.lds + 1024 * 20 * 4);
    if (l < DEPTH) {
        for (int i = cx.tid; i < 1024 * 4; i += NTHR) { const int k = i >> 2, c4 = i & 3;
            *(LAS f32x4*)(wg + k * 20 + c4 * 4) = *(const f32x4*)(P.in[I_WIN] + ((size_t)l * 1024 + k) * DIN + 1536 + c4 * 4); }
    }
    if (l > 0) moe_info(cx, l - 1, info);
    __syncthreads();
    const int rbeg = (l == DEPTH) ? TCTX : 0;
    const float* modp = WSP(float, WS_MOD);
    for (int row = rbeg + cx.bid * 8 + cx.wave; row < TT; row += cx.G * 8) {
        asm volatile("" ::: "memory");
        float x[16];
        if (l == 0) {
            const float* src = row < TCTX ? P.in[I_CTX] + (size_t)row * 1024 : P.in[I_X] + (size_t)(row - TCTX) * 1024;
#pragma unroll
            for (int i = 0; i < 16; ++i) x[i] = src[cx.lane + 64 * i];
        } else {
            const float* src = WSP(float, WS_XMID) + (size_t)row * 1024;
            const float* g2 = modp + ((size_t)(l - 1) * 9 + mod_row(row)) * 6144 + 5120;
            const int* ti = WSP(int, WS_TINFO) + (size_t)row * 4;
            float y[16];
#pragma unroll
            for (int i = 0; i < 16; ++i) y[i] = 0.f;
#pragma unroll
            for (int k = 0; k < 4; ++k) { const int t = ti[k]; const int e = t >> 20, slot = t & 0xFFFFF;
                const bf16_t* yp = WSP(bf16_t, WS_YPAD) + ((size_t)info[e] * 256 + slot) * 1024;
#pragma unroll
                for (int i = 0; i < 16; ++i) y[i] += bf2f(yp[cx.lane + 64 * i]); }
#pragma unroll
            for (int i = 0; i < 16; ++i) x[i] = src[cx.lane + 64 * i] + g2[cx.lane + 64 * i] * y[i];
        }
        float ss = 0.f;
#pragma unroll
        for (int i = 0; i < 16; ++i) ss += x[i] * x[i];
        ss = wave_sum(ss, cx.lane);
        const float rstd = rsqrtf(ss * (1.0f / 1024.0f) + EPS);
        if (l == DEPTH) {
            float* o = P.out + (size_t)(row - TCTX) * 1024;
#pragma unroll
            for (int i = 0; i < 16; ++i) o[cx.lane + 64 * i] = x[i] * rstd * P.in[I_FNW][cx.lane + 64 * i];
            continue;
        }
        float* xs = WSP(float, WS_XS) + (size_t)row * 1024;
        const float* md = modp + ((size_t)l * 9 + mod_row(row)) * 6144;
        bf16_t* hp = WSP(bf16_t, WS_H) + (size_t)row * 1024;
        float ga[16];
#pragma unroll
        for (int j = 0; j < 16; ++j) ga[j] = 0.f;
#pragma unroll
        for (int i = 0; i < 16; ++i) {
            const int c = cx.lane + 64 * i;
            xs[c] = x[i];
            const float h = x[i] * rstd * P.in[I_N1W][l * 1024 + c] * (1.0f + md[1024 + c]) + md[c];
            hp[c] = f2bf(h);
#pragma unroll
            for (int q4 = 0; q4 < 4; ++q4) { const f32x4 w = *(const LAS f32x4*)(wg + c * 20 + q4 * 4);
                ga[q4 * 4 + 0] += h * w[0]; ga[q4 * 4 + 1] += h * w[1]; ga[q4 * 4 + 2] += h * w[2]; ga[q4 * 4 + 3] += h * w[3]; }
            if (i & 1) asm volatile("" ::: "memory");
        }
        float gsel = 0.f;
#pragma unroll
        for (int j = 0; j < 16; ++j) { const float tj = wave_sum(ga[j], 0); gsel = (cx.lane == j) ? tj : gsel; }
        if (cx.lane < 16) WSP(float, WS_GT)[(size_t)row * 16 + cx.lane] = gsel + P.in[I_BIN][l * DIN + 1536 + cx.lane];
    }
}

DEVI void ph_norm2(const Ctx& cx, int l) {
    const Params& P = *cx.p;
    LAS float* rw = (LAS float*)cx.lds;
    LAS int* hist = (LAS int*)(cx.lds + 1024 * 36 * 4);
    LAS int* pend = hist + 64;
    for (int i = cx.tid; i < 1024 * 8; i += NTHR) { const int k = i >> 3, c4 = i & 7;
        *(LAS f32x4*)(rw + k * 36 + c4 * 4) = *(const f32x4*)(P.in[I_RW] + ((size_t)l * 1024 + k) * 32 + c4 * 4); }
    if (cx.tid < 64) hist[cx.tid] = 0;
    __syncthreads();
    const int r0 = (l == DEPTH - 1) ? TCTX : 0, nr = TT - r0;
    const int rpb = (nr + cx.G - 1) / cx.G;
    const int rb = cx.bid * rpb, re = min(nr, rb + rpb);
    const float* modp = WSP(float, WS_MOD);
    for (int rl = rb + cx.wave; rl < re; rl += 8) {
        const int row = r0 + rl;
        const float* src = WSP(float, WS_XMID) + (size_t)row * 1024;
        const float* md = modp + ((size_t)l * 9 + mod_row(row)) * 6144;
        bf16_t* hp = WSP(bf16_t, WS_H) + (size_t)row * 1024;
        float x[16]; float ss = 0.f;
#pragma unroll
        for (int i = 0; i < 16; ++i) { x[i] = src[cx.lane + 64 * i]; ss += x[i] * x[i]; }
        ss = wave_sum(ss, cx.lane);
        const float rstd = rsqrtf(ss * (1.0f / 1024.0f) + EPS);
#pragma unroll
        for (int i = 0; i < 16; ++i) {
            const int c = cx.lane + 64 * i;
            x[i] = x[i] * rstd * P.in[I_N2W][l * 1024 + c] * (1.0f + md[4096 + c]) + md[3072 + c];
            hp[c] = f2bf(x[i]);
        }
        float lgt[32];
#pragma unroll
        for (int half = 0; half < 2; ++half) {
            float lg[16];
#pragma unroll
            for (int j = 0; j < 16; ++j) lg[j] = 0.f;
#pragma unroll
            for (int i = 0; i < 16; ++i) {
                const int c = cx.lane + 64 * i; const float h = x[i];
#pragma unroll
                for (int q4 = 0; q4 < 4; ++q4) { const f32x4 w = *(const LAS f32x4*)(rw + c * 36 + half * 16 + q4 * 4);
                    lg[q4 * 4 + 0] += h * w[0]; lg[q4 * 4 + 1] += h * w[1]; lg[q4 * 4 + 2] += h * w[2]; lg[q4 * 4 + 3] += h * w[3]; }
            }
#pragma unroll
            for (int j = 0; j < 16; ++j) lgt[half * 16 + j] = wave_sum(lg[j], 0) + P.in[I_RB][l * 32 + half * 16 + j];
        }
        float tv[4]; int tix[4]; unsigned taken = 0u;
#pragma unroll
        for (int k = 0; k < 4; ++k) {
            float bv = -3.0e38f; int bi = 0;
#pragma unroll
            for (int e = 0; e < 32; ++e) { const bool better = (lgt[e] > bv) && !((taken >> e) & 1u); bv = better ? lgt[e] : bv; bi = better ? e : bi; }
            tv[k] = bv; tix[k] = bi; taken |= 1u << bi;
        }
        const float e1 = __expf(tv[1] - tv[0]), e2 = __expf(tv[2] - tv[0]), e3 = __expf(tv[3] - tv[0]);
        const float inv = 1.0f / (1.0f + e1 + e2 + e3);
        const float gk[4] = {inv, e1 * inv, e2 * inv, e3 * inv};
        if (cx.lane < 4) {
            const int k = cx.lane; const int e = k == 0 ? tix[0] : k == 1 ? tix[1] : k == 2 ? tix[2] : tix[3];
            const float g = k == 0 ? gk[0] : k == 1 ? gk[1] : k == 2 ? gk[2] : gk[3];
            const int ls = __hip_atomic_fetch_add((LAS int*)(hist + e), 1, __ATOMIC_RELAXED, __HIP_MEMORY_SCOPE_WORKGROUP);
            pend[((rl - rb) * 4 + k) * 2 + 0] = (e << 20) | ls;
            pend[((rl - rb) * 4 + k) * 2 + 1] = __float_as_int(g);
        }
    }
    __syncthreads();
    if (cx.tid < 32) { unsigned* cnt = (unsigned*)(cx.ws + WS_CTL) + CW_CNT + l * 32;
        hist[32 + cx.tid] = hist[cx.tid] > 0 ? (int)__hip_atomic_fetch_add(cnt + cx.tid, (unsigned)hist[cx.tid], __ATOMIC_RELAXED, __HIP_MEMORY_SCOPE_AGENT) : 0; }
    __syncthreads();
    for (int i = cx.tid; i < (re - rb) * 4; i += NTHR) {
        const int t = pend[i * 2], e = t >> 20, slot = hist[32 + e] + (t & 0xFFFFF), row = r0 + rb + (i >> 2);
        WSP(int, WS_ELIST)[(size_t)e * TT + slot] = row;
        WSP(float, WS_GLIST)[(size_t)e * TT + slot] = __int_as_float(pend[i * 2 + 1]);
        WSP(int, WS_TINFO)[(size_t)row * 4 + (i & 3)] = (e << 20) | slot;
    }
}

DEVI int xcd_contig(int bid, int G) { return (G % 8 == 0) ? (bid % 8) * (G / 8) + bid / 8 : bid; }

struct DenseSched {
    const char* A; const char* B; int nM, nN, pm0, G, c;
    DEVI bool get(int i, g1::Unit& u) const {
        const int L = i * G + c; if (L >= nM * nN) return false;
        const int pm = L / nN, pn = L % nN;
        u.A = A + (size_t)(pm0 + pm) * 256 * 2048; u.list = nullptr; u.nvalid = 256; u.B = B + (size_t)pn * 256 * 2048; u.pm = pm0 + pm; u.pn = pn; u.e = 0;
        return true;
    }
};
struct MoeSched {
    const char* A; const char* B; const int* elist; const LAS int* info; int NPN, gather, G, c; size_t bstride;
    DEVI bool get(int i, g1::Unit& u) const {
        const int L = i * G + c; const int total = info[32] * NPN; if (L >= total) return false;
        int e = 0;
#pragma unroll 1
        for (int k = 1; k < 32; ++k) if (L >= info[k] * NPN) e = k;
        const int nt = info[e + 1] - info[e], ue = L - info[e] * NPN, pn = ue / nt, j = ue % nt;
        u.pm = info[e] + j; u.pn = pn; u.e = e;
        u.B = B + (size_t)e * bstride + (size_t)pn * 256 * 2048;
        if (gather) { u.A = A; u.list = elist + (size_t)e * TT + j * 256; u.nvalid = info[40 + e] - j * 256; }
        else { u.A = A + (size_t)u.pm * 256 * 2048; u.list = nullptr; u.nvalid = 256; }
        return true;
    }
};

struct EpiIn {
    static constexpr bool PERM = true;
    bf16_t* Pout; const float* bias;
    DEVI void operator()(const f32x4 (&acc)[2][2][4][2], const g1::Unit& u, int wr, int wc, int fr, int fq) const {
        const int row0 = u.pm * 256 + wr * 64 + fr;
#pragma unroll
        for (int bj = 0; bj < 2; ++bj) {
            const int col0 = u.pn * 256 + bj * 128 + wc * 32 + 8 * fq;
            const int seg = u.pn * 2 + bj; const bool gl = (seg >= 15 && seg < 18);
            const f32x4 b0 = *(const f32x4*)(bias + col0), b1 = *(const f32x4*)(bias + col0 + 4);
#pragma unroll
            for (int ai = 0; ai < 2; ++ai)
#pragma unroll
                for (int m = 0; m < 4; ++m) {
                    f32x4 v0 = acc[ai][bj][m][0] + b0, v1 = acc[ai][bj][m][1] + b1;
                    if (gl) {
#pragma unroll
                        for (int j = 0; j < 4; ++j) { v0[j] = gelu_tanh(v0[j]); v1[j] = gelu_tanh(v1[j]); } }
                    u32x4 w; w.x = pk_bf16(v0[0], v0[1]); w.y = pk_bf16(v0[2], v0[3]); w.z = pk_bf16(v1[0], v1[1]); w.w = pk_bf16(v1[2], v1[3]);
                    *(u32x4*)(Pout + (size_t)(row0 + ai * 128 + m * 16) * NP + col0) = w;
                }
        }
    }
};
struct EpiOut {
    static constexpr bool PERM = false;
    const float* xs; float* xmid; const float* mod;
    DEVI void operator()(const f32x4 (&acc)[2][2][4][2], const g1::Unit& u, int wr, int wc, int fr, int fq) const {
        const int row0 = u.pm * 256 + wr * 64 + fr;
        const float* g1p = mod + (size_t)mod_row(u.pm * 256) * 6144 + 2048;
#pragma unroll
        for (int bj = 0; bj < 2; ++bj)
#pragma unroll
            for (int n = 0; n < 2; ++n) {
                const int col = u.pn * 256 + bj * 128 + wc * 32 + 16 * n + 4 * fq;
                const f32x4 gv = *(const f32x4*)(g1p + col);
#pragma unroll
                for (int ai = 0; ai < 2; ++ai)
#pragma unroll
                    for (int m = 0; m < 4; ++m) {
                        const size_t off = (size_t)(row0 + ai * 128 + m * 16) * 1024 + col;
                        const f32x4 xv = *(const f32x4*)(xs + off);
                        *(f32x4*)(xmid + off) = xv + gv * acc[ai][bj][m][n];
                    }
            }
    }
};
struct EpiGU {
    static constexpr bool PERM = true;
    bf16_t* act; const float* bgu;
    DEVI void operator()(const f32x4 (&acc)[2][2][4][2], const g1::Unit& u, int wr, int wc, int fr, int fq) const {
        const int row0 = u.pm * 256 + wr * 64 + fr, colh = u.pn * 128 + wc * 32 + 8 * fq;
        const float* bg = bgu + (size_t)u.e * 2048 + colh; const float* bu = bg + 1024;
        const f32x4 bg0 = *(const f32x4*)bg, bg1 = *(const f32x4*)(bg + 4), bu0 = *(const f32x4*)bu, bu1 = *(const f32x4*)(bu + 4);
#pragma unroll
        for (int ai = 0; ai < 2; ++ai)
#pragma unroll
            for (int m = 0; m < 4; ++m) {
                float o[8];
#pragma unroll
                for (int n = 0; n < 2; ++n)
#pragma unroll
                    for (int j = 0; j < 4; ++j) {
                        const float g = fminf(acc[ai][0][m][n][j] + (n ? bg1[j] : bg0[j]), 7.0f);
                        const float up = fminf(fmaxf(acc[ai][1][m][n][j] + (n ? bu1[j] : bu0[j]), -7.0f), 7.0f);
                        o[n * 4 + j] = (up + 1.0f) * g / (1.0f + __expf(-1.702f * g));
                    }
                u32x4 w; w.x = pk_bf16(o[0], o[1]); w.y = pk_bf16(o[2], o[3]); w.z = pk_bf16(o[4], o[5]); w.w = pk_bf16(o[6], o[7]);
                *(u32x4*)(act + (size_t)(row0 + ai * 128 + m * 16) * 1024 + colh) = w;
            }
    }
};
struct EpiDown {
    static constexpr bool PERM = true;
    bf16_t* ypad; const float* bd; const float* glist; const LAS int* info;
    DEVI void operator()(const f32x4 (&acc)[2][2][4][2], const g1::Unit& u, int wr, int wc, int fr, int fq) const {
        const int j256 = (u.pm - info[u.e]) * 256, cnt = info[40 + u.e];
        const int rl0 = wr * 64 + fr;
#pragma unroll
        for (int ai = 0; ai < 2; ++ai)
#pragma unroll
            for (int m = 0; m < 4; ++m) {
                const int rl = rl0 + ai * 128 + m * 16, slot = j256 + rl;
                const float gt = slot < cnt ? glist[(size_t)u.e * TT + slot] : 0.f;
#pragma unroll
                for (int bj = 0; bj < 2; ++bj) {
                    const int col0 = u.pn * 256 + bj * 128 + wc * 32 + 8 * fq;
                    const f32x4 b0 = *(const f32x4*)(bd + (size_t)u.e * 1024 + col0), b1 = *(const f32x4*)(bd + (size_t)u.e * 1024 + col0 + 4);
                    const f32x4 v0 = (acc[ai][bj][m][0] + b0) * gt, v1 = (acc[ai][bj][m][1] + b1) * gt;
                    u32x4 w; w.x = pk_bf16(v0[0], v0[1]); w.y = pk_bf16(v0[2], v0[3]); w.z = pk_bf16(v1[0], v1[1]); w.w = pk_bf16(v1[2], v1[3]);
                    *(u32x4*)(ypad + (size_t)(u.pm * 256 + rl) * 1024 + col0) = w;
                }
            }
    }
};

DEVI void ph_inproj(const Ctx& cx, int l) {
    DenseSched S{(const char*)WSP(bf16_t, WS_H), (const char*)(WSP(bf16_t, WS_WIN) + (size_t)l * NP * 1024), TT / 256, NP / 256, 0, cx.G, xcd_contig(cx.bid, cx.G)};
    EpiIn E{WSP(bf16_t, WS_P), WSP(float, WS_BIN2) + (size_t)l * NP};
    g1::gemm_phase<DenseSched, EpiIn, false>(cx.lds, cx.tid, S, E);
}
DEVI void ph_outproj(const Ctx& cx, int l) {
    const int pm0 = (l == DEPTH - 1) ? TCTX / 256 : 0;
    DenseSched S{(const char*)WSP(bf16_t, WS_MRG), (const char*)(WSP(bf16_t, WS_WOUT) + (size_t)l * 1024 * 1024), TT / 256 - pm0, 4, pm0, cx.G, xcd_contig(cx.bid, cx.G)};
    EpiOut E{WSP(float, WS_XS), WSP(float, WS_XMID), WSP(float, WS_MOD) + (size_t)l * 9 * 6144};
    g1::gemm_phase<DenseSched, EpiOut, false>(cx.lds, cx.tid, S, E);
}
DEVI void ph_moe_gu(const Ctx& cx, int l) {
    LAS int* info = (LAS int*)(cx.lds + g1::STAGE_BYTES);
    moe_info(cx, l, info);
    MoeSched S{(const char*)WSP(bf16_t, WS_H), (const char*)(WSP(bf16_t, WS_WGU) + (size_t)l * NE * 2048 * 1024), WSP(int, WS_ELIST), info, 8, 1, cx.G, xcd_contig(cx.bid, cx.G), (size_t)2048 * 1024 * 2};
    EpiGU E{WSP(bf16_t, WS_ACT), cx.p->in[I_BGU] + (size_t)l * NE * 2048};
    g1::gemm_phase<MoeSched, EpiGU, true>(cx.lds, cx.tid, S, E);
}
DEVI void ph_moe_dn(const Ctx& cx, int l) {
    LAS int* info = (LAS int*)(cx.lds + g1::STAGE_BYTES);
    moe_info(cx, l, info);
    MoeSched S{(const char*)WSP(bf16_t, WS_ACT), (const char*)(WSP(bf16_t, WS_WD) + (size_t)l * NE * 1024 * 1024), nullptr, info, 4, 0, cx.G, xcd_contig(cx.bid, cx.G), (size_t)1024 * 1024 * 2};
    EpiDown E{WSP(bf16_t, WS_YPAD), cx.p->in[I_BD] + (size_t)l * NE * 1024, WSP(float, WS_GLIST), info};
    g1::gemm_phase<MoeSched, EpiDown, false>(cx.lds, cx.tid, S, E);
}

DEVI int ml_row0(int b, int c) { return c < 2 ? b * CTXL + c * 128 : TCTX + b * SEQ + (c - 2) * 128; }
DEVI unsigned short lds_u16(const LAS bf16_t* p) { return *p; }

DEVI void ml_local_unit(const Ctx& cx, int l, int b, int h, int c) {
    LAS float* sg = (LAS float*)cx.lds;
    LAS float* se = sg + 256;
    LAS float* red = se + 256;
    LAS bf16_t* Ks = (LAS bf16_t*)(cx.lds + 4352);
    LAS bf16_t* Ve = Ks + 128 * 104;
    const int row0 = ml_row0(b, c), tid = cx.tid;
    const int dir = (tid >> 7) & 1, i = tid & 127, p = dir ? 127 - i : i;
    const bool act = tid < 256;
    float gi = 0.f, bval = 0.f, u = 0.f;
    if (act) { const float* gt = WSP(float, WS_GT) + (size_t)(row0 + i) * 16; gi = gt[dir * 4 + h]; const float gf = gt[8 + dir * 4 + h];
        sg[dir * 128 + p] = fminf(gf, 0.f) - log1p_(__expf(-fabsf(gf))); }
    __syncthreads();
#pragma unroll 1
    for (int off = 1; off < 128; off <<= 1) { float v = 0.f; if (act) { v = sg[dir * 128 + p]; if (p >= off) v += sg[dir * 128 + p - off]; } __syncthreads(); if (act) sg[dir * 128 + p] = v; __syncthreads(); }
    if (act) { bval = sg[dir * 128 + p]; u = gi - bval; if (p == 127) red[dir] = bval; }
    __syncthreads();
    if (act) sg[dir * 128 + p] = u;
    __syncthreads();
#pragma unroll 1
    for (int off = 1; off < 128; off <<= 1) { float v = 0.f; if (act) { v = sg[dir * 128 + p]; if (p >= off) v = fmaxf(v, sg[dir * 128 + p - off]); } __syncthreads(); if (act) sg[dir * 128 + p] = v; __syncthreads(); }
    if (act) { const float cm = sg[dir * 128 + p]; if (p == 127) red[2 + dir] = cm;
        const size_t gix = (size_t)(row0 + i) * 8 + dir * 4 + h;
        WSP(float, WS_GB)[gix] = bval; WSP(float, WS_GU)[gix] = u; WSP(float, WS_GCM)[gix] = cm; }
    __syncthreads();
    if (act) se[dir * 128 + i] = expf(u - red[2 + dir]);
    if (tid < 2) { float* msc = WSP(float, WS_MSC) + ((size_t)((b * 4 + h) * MLC + c) * 2 + tid) * 2; msc[0] = red[tid]; msc[1] = red[tid] + red[2 + tid]; }
    __syncthreads();
    const bf16_t* Pp = WSP(bf16_t, WS_P);
#pragma unroll
    for (int it = 0; it < 3; ++it) { const int idx = tid + NTHR * it, r = idx / 12, ch = idx % 12;
        const u32x4 kv = *(const u32x4*)(Pp + (size_t)(row0 + r) * NP + PC_K + h * 96 + ch * 8);
        *(LAS u32x4*)(Ks + r * 104 + ch * 8) = kv;
        const u32x4 vv = *(const u32x4*)(Pp + (size_t)(row0 + r) * NP + PC_V + h * 96 + ch * 8);
        const float e0 = se[r], e1 = se[128 + r];
        u32x4 o0, o1;
#pragma unroll
        for (int q = 0; q < 4; ++q) { const float lo = __uint_as_float(vv[q] << 16), hi = __uint_as_float(vv[q] & 0xFFFF0000u);
            o0[q] = pk_bf16(lo * e0, hi * e0); o1[q] = pk_bf16(lo * e1, hi * e1); }
        *(LAS u32x4*)(Ve + r * 104 + ch * 8) = o0; *(LAS u32x4*)(Ve + (128 + r) * 104 + ch * 8) = o1; }
    __syncthreads();
    {
        const int wd = cx.wave >> 2, q9 = (cx.wave & 3) * 9, fr = cx.lane & 15, fq = cx.lane >> 4;
        float* cl = WSP(float, WS_CLOC) + ((size_t)((b * 4 + h) * MLC + c) * 2 + wd) * 9216;
        const LAS bf16_t* V = Ve + wd * 128 * 104;
#pragma unroll 1
        for (int pi = q9; pi < q9 + 9; ++pi) { const int dt = pi / 6, et = pi % 6;
            f32x4 acc = (f32x4){0.f, 0.f, 0.f, 0.f};
#pragma unroll
            for (int kk = 0; kk < 4; ++kk) { bf16x8 a, bb;
#pragma unroll
                for (int j = 0; j < 8; ++j) { const int s = kk * 32 + fq * 8 + j; a[j] = (short)lds_u16(V + s * 104 + dt * 16 + fr); bb[j] = (short)lds_u16(Ks + s * 104 + et * 16 + fr); }
                acc = __builtin_amdgcn_mfma_f32_16x16x32_bf16(a, bb, acc, 0, 0, 0); }
#pragma unroll
            for (int r = 0; r < 4; ++r) cl[(dt * 16 + fq * 4 + r) * 96 + et * 16 + fr] = acc[r]; }
    }
    if (tid < 192) { const int d2 = tid / 96, e = tid % 96; float s = 0.f;
        for (int t = 0; t < 128; ++t) s += se[d2 * 128 + t] * bf2f(Ks[t * 104 + e]);
        WSP(float, WS_NLOC)[((size_t)((b * 4 + h) * MLC + c) * 2 + d2) * 96 + e] = s; }
    __syncthreads();
}

DEVI void ml_carry(const Ctx& cx) {
    for (int idx = cx.bid * NTHR + cx.tid; idx < 64 * 9312; idx += cx.G * NTHR) {
        const int combo = idx / 9312, el = idx % 9312, dir = combo & 1, bh = combo >> 1;
        float Cv = 0.f, m = -1e30f;
#pragma unroll 1
        for (int s = 0; s < MLC; ++s) {
            const int c = dir == 0 ? s : (s < 2 ? 1 - s : 19 - s);
            const size_t cb = (size_t)(bh * MLC + c) * 2 + dir;
            const float bl = WSP(float, WS_MSC)[cb * 2], ml = WSP(float, WS_MSC)[cb * 2 + 1];
            float loc;
            if (el < 9216) { WSP(bf16_t, WS_C0)[cb * 9216 + el] = f2bf(Cv); loc = WSP(float, WS_CLOC)[cb * 9216 + el]; }
            else { WSP(float, WS_N0)[cb * 96 + el - 9216] = Cv; loc = WSP(float, WS_NLOC)[cb * 96 + el - 9216]; }
            if (el == 0) WSP(float, WS_M0)[cb] = m;
            const float mn = fmaxf(bl + m, ml), a = expf(bl + m - mn), sc = expf(ml - mn);
            Cv = a * Cv + sc * loc; m = mn;
        }
    }
}

DEVI void ml_out_unit(const Ctx& cx, int l, int b, int h, int c) {
    LAS bf16_t* Qs = (LAS bf16_t*)cx.lds;
    LAS bf16_t* Ks = Qs + 128 * 104;
    LAS bf16_t* Vs = Ks + 128 * 104;
    LAS bf16_t* C0s = Vs + 128 * 104;
    LAS float* gb = (LAS float*)(cx.lds + 119808);
    LAS float* gu = gb + 256;
    LAS float* gM = gu + 256;
    LAS float* n0s = gM + 256;
    LAS float* m0s = n0s + 192;
    const int row0 = ml_row0(b, c), tid = cx.tid;
    const bf16_t* Pp = WSP(bf16_t, WS_P);
    const size_t cb0 = (size_t)((b * 4 + h) * MLC + c) * 2;
#pragma unroll
    for (int it = 0; it < 3; ++it) { const int idx = tid + NTHR * it, r = idx / 12, ch = idx % 12;
        const bf16_t* rp = Pp + (size_t)(row0 + r) * NP + h * 96 + ch * 8;
        *(LAS u32x4*)(Qs + r * 104 + ch * 8) = *(const u32x4*)(rp + PC_Q);
        *(LAS u32x4*)(Ks + r * 104 + ch * 8) = *(const u32x4*)(rp + PC_K);
        *(LAS u32x4*)(Vs + r * 104 + ch * 8) = *(const u32x4*)(rp + PC_V); }
    for (int idx = tid; idx < 2 * 96 * 12; idx += NTHR) { const int d2 = idx / 1152, r = (idx % 1152) / 12, ch = idx % 12;
        *(LAS u32x4*)(C0s + (d2 * 96 + r) * 104 + ch * 8) = *(const u32x4*)(WSP(bf16_t, WS_C0) + (cb0 + d2) * 9216 + r * 96 + ch * 8); }
    if (tid < 256) { const int d2 = tid >> 7, i = tid & 127; const size_t gix = (size_t)(row0 + i) * 8 + d2 * 4 + h;
        gb[tid] = WSP(float, WS_GB)[gix]; gu[tid] = WSP(float, WS_GU)[gix];
        gM[tid] = fmaxf(WSP(float, WS_M0)[cb0 + d2], WSP(float, WS_GCM)[gix]); }
    if (tid >= 256 && tid < 448) { const int k = tid - 256; n0s[k] = WSP(float, WS_N0)[(cb0 + k / 96) * 96 + k % 96]; }
    if (tid >= 448 && tid < 450) m0s[tid - 448] = WSP(float, WS_M0)[cb0 + tid - 448];
    __syncthreads();
    const int w = cx.wave, fr = cx.lane & 15, fq = cx.lane >> 4, t = 16 * w + fr;
    bf16x8 qf[3];
#pragma unroll
    for (int kk = 0; kk < 3; ++kk) qf[kk] = *(const LAS bf16x8*)(Qs + t * 104 + kk * 32 + fq * 8);
    f32x4 hs[6];
#pragma unroll
    for (int n = 0; n < 6; ++n) hs[n] = (f32x4){0.f, 0.f, 0.f, 0.f};
#pragma unroll
    for (int dir = 0; dir < 2; ++dir) {
        const float Mt = gM[dir * 128 + t], bt = gb[dir * 128 + t], inter = expf(m0s[dir] - Mt);
        f32x4 an[6];
#pragma unroll
        for (int n = 0; n < 6; ++n) an[n] = (f32x4){0.f, 0.f, 0.f, 0.f};
        float den = 0.f;
        const int Jlo = dir == 0 ? 0 : (w >> 1), Jhi = dir == 0 ? (w >> 1) : 3;
#pragma unroll 1
        for (int J = Jlo; J <= Jhi; ++J) {
            bf16x8 pf;
#pragma unroll
            for (int half = 0; half < 2; ++half) {
                const int j = 2 * J + half;
                f32x4 D = (f32x4){0.f, 0.f, 0.f, 0.f};
                const bool need = dir == 0 ? (j <= w) : (j >= w);
                if (need) {
#pragma unroll
                    for (int kk = 0; kk < 3; ++kk) { const bf16x8 kf = *(const LAS bf16x8*)(Ks + (16 * j + fr) * 104 + kk * 32 + fq * 8);
                        D = __builtin_amdgcn_mfma_f32_16x16x32_bf16(kf, qf[kk], D, 0, 0, 0); }
                }
                const f32x4 us = *(const LAS f32x4*)(gu + dir * 128 + 16 * j + 4 * fq);
                float pv[4];
#pragma unroll
                for (int r = 0; r < 4; ++r) { const int s = 16 * j + 4 * fq + r; const bool valid = need && (dir == 0 ? (s <= t) : (s >= t));
                    pv[r] = valid ? D[r] * expf(us[r] - Mt) : 0.f; den += pv[r]; }
                pf[half * 4 + 0] = (short)f2bf(pv[0]); pf[half * 4 + 1] = (short)f2bf(pv[1]); pf[half * 4 + 2] = (short)f2bf(pv[2]); pf[half * 4 + 3] = (short)f2bf(pv[3]);
            }
#pragma unroll
            for (int n = 0; n < 6; ++n) { bf16x8 vf;
#pragma unroll
                for (int jj = 0; jj < 8; ++jj) { const int s = 32 * J + (jj < 4 ? 4 * fq + jj : 16 + 4 * fq + (jj - 4)); vf[jj] = (short)lds_u16(Vs + s * 104 + 16 * n + fr); }
                an[n] = __builtin_amdgcn_mfma_f32_16x16x32_bf16(vf, pf, an[n], 0, 0, 0); }
        }
        float nq = 0.f;
#pragma unroll
        for (int kk = 0; kk < 3; ++kk)
#pragma unroll
            for (int j = 0; j < 8; ++j) nq += n0s[dir * 96 + kk * 32 + fq * 8 + j] * bf2f((bf16_t)qf[kk][j]);
        nq += shx<16>(nq, cx.lane); nq += shx<32>(nq, cx.lane);
        den += shx<16>(den, cx.lane); den += shx<32>(den, cx.lane);
        const float dtot = den + inter * nq;
        const float inv = 1.0f / fmaxf(fabsf(dtot), expf(-(Mt + bt)));
#pragma unroll
        for (int n = 0; n < 6; ++n) { f32x4 ac = (f32x4){0.f, 0.f, 0.f, 0.f};
#pragma unroll
            for (int kk = 0; kk < 3; ++kk) { const bf16x8 cf = *(const LAS bf16x8*)(C0s + (dir * 96 + 16 * n + fr) * 104 + kk * 32 + fq * 8);
                ac = __builtin_amdgcn_mfma_f32_16x16x32_bf16(cf, qf[kk], ac, 0, 0, 0); }
            hs[n] += (an[n] + ac * inter) * inv; }
    }
    float ss = 0.f;
#pragma unroll
    for (int n = 0; n < 6; ++n) ss += hs[n][0] * hs[n][0] + hs[n][1] * hs[n][1] + hs[n][2] * hs[n][2] + hs[n][3] * hs[n][3];
    ss += shx<16>(ss, cx.lane); ss += shx<32>(ss, cx.lane);
    const float rstd = rsqrtf(ss * (1.0f / 96.0f) + EPS);
    const size_t prow = (size_t)(row0 + t);
#pragma unroll
    for (int n = 0; n < 6; ++n) { const int d = 16 * n + 4 * fq;
        const u32x2 ov = *(const u32x2*)(Pp + prow * NP + PC_O + h * 96 + d);
        const f32x4 mw = *(const f32x4*)(cx.p->in[I_MIXW] + l * 1024 + h * 96 + d);
        const float o0 = __uint_as_float(ov.x << 16), o1 = __uint_as_float(ov.x & 0xFFFF0000u), o2 = __uint_as_float(ov.y << 16), o3 = __uint_as_float(ov.y & 0xFFFF0000u);
        u32x2 wv; wv.x = pk_bf16(sigmoidf_(o0) * hs[n][0] * rstd * mw[0], sigmoidf_(o1) * hs[n][1] * rstd * mw[1]);
        wv.y = pk_bf16(sigmoidf_(o2) * hs[n][2] * rstd * mw[2], sigmoidf_(o3) * hs[n][3] * rstd * mw[3]);
        *(u32x2*)(WSP(bf16_t, WS_MRG) + prow * 1024 + h * 96 + d) = wv; }
    __syncthreads();
}

DEVI void rg_unit(const Ctx& cx, int l, int b, int ck, int g, int mode) {
    const Params& P = *cx.p;
    LAS float* xraw = (LAS float*)cx.lds;
    LAS float* xc = (LAS float*)(cx.lds + 17408);
    LAS bf16_t* xcb = (LAS bf16_t*)(cx.lds + 33792);
    LAS float* ab = (LAS float*)(cx.lds + 43008);
    const int tid = cx.tid;
    const int t0 = ck < 4 ? ck * 64 : (ck - 4) * 64, seglen = ck < 4 ? CTXL : SEQ, rowbase = ck < 4 ? b * CTXL : TCTX + b * SEQ;
    const bf16_t* Pp = WSP(bf16_t, WS_P);
    for (int idx = tid; idx < 67 * 8; idx += NTHR) { const int r = idx >> 3, c8 = idx & 7, tt = t0 - 2 + r;
        u32x4 v = (u32x4){0u, 0u, 0u, 0u};
        if (tt >= 0 && tt < seglen) v = *(const u32x4*)(Pp + (size_t)(rowbase + tt) * NP + PC_RX + g * 64 + c8 * 8);
#pragma unroll
        for (int q = 0; q < 4; ++q) { xraw[r * 64 + c8 * 8 + 2 * q] = __uint_as_float(v[q] << 16); xraw[r * 64 + c8 * 8 + 2 * q + 1] = __uint_as_float(v[q] & 0xFFFF0000u); } }
    __syncthreads();
#pragma unroll
    for (int it = 0; it < 8; ++it) { const int idx = tid + NTHR * it, t = idx >> 6, ch = idx & 63, cg = g * 64 + ch;
        float v = P.in[I_RGCB][l * 384 + cg];
#pragma unroll
        for (int j = 0; j < 4; ++j) v += P.in[I_RGCW][(l * 4 + j) * 384 + cg] * xraw[(t + j) * 64 + ch];
        xc[t * 64 + ch] = v; xcb[t * 72 + ch] = f2bf(v); }
    __syncthreads();
    {
        const int dir = cx.wave >> 2, cg4 = cx.wave & 3, fr = cx.lane & 15, fq = cx.lane >> 4;
        const bf16_t* wrg = WSP(bf16_t, WS_WRG) + (size_t)(l * 6 + g) * 256 * 64;
        f32x4 ar[4], ai[4];
#pragma unroll
        for (int m = 0; m < 4; ++m) { ar[m] = (f32x4){0.f, 0.f, 0.f, 0.f}; ai[m] = (f32x4){0.f, 0.f, 0.f, 0.f}; }
#pragma unroll
        for (int kk = 0; kk < 2; ++kk) {
            const bf16x8 br = ldg8(wrg + (size_t)((dir * 2 + 0) * 64 + cg4 * 16 + fr) * 64 + kk * 32 + fq * 8);
            const bf16x8 bi = ldg8(wrg + (size_t)((dir * 2 + 1) * 64 + cg4 * 16 + fr) * 64 + kk * 32 + fq * 8);
#pragma unroll
            for (int m = 0; m < 4; ++m) { const bf16x8 a = *(const LAS bf16x8*)(xcb + (m * 16 + fr) * 72 + kk * 32 + fq * 8);
                ar[m] = __builtin_amdgcn_mfma_f32_16x16x32_bf16(br, a, ar[m], 0, 0, 0); ai[m] = __builtin_amdgcn_mfma_f32_16x16x32_bf16(bi, a, ai[m], 0, 0, 0); }
        }
        const int ch0 = cg4 * 16 + 4 * fq, cgl = g * 64 + ch0;
        const f32x4 ba = *(const f32x4*)(P.in[I_RGBA] + (l * 2 + dir) * 384 + cgl), bx = *(const f32x4*)(P.in[I_RGBX] + (l * 2 + dir) * 384 + cgl);
        const f32x4 lam = *(const f32x4*)(P.in[I_RGLAM] + (l * 2 + dir) * 384 + cgl);
        float sp[4];
#pragma unroll
        for (int j = 0; j < 4; ++j) sp[j] = lam[j] > 0.f ? log1p_(__expf(-lam[j])) : -lam[j] + log1p_(__expf(lam[j]));
#pragma unroll
        for (int m = 0; m < 4; ++m) { const int t = m * 16 + fr; const f32x4 xv = *(const LAS f32x4*)(xc + t * 64 + ch0);
            f32x4 av, bv;
#pragma unroll
            for (int j = 0; j < 4; ++j) { const float r = 1.0f / (1.0f + __expf(-(ar[m][j] + ba[j]))), ii = 1.0f / (1.0f + __expf(-(ai[m][j] + bx[j])));
                const float la = -8.0f * r * sp[j], y = 2.0f * la; av[j] = __expf(la);
                const float nem1 = y > -0.3f ? -y * (1.0f + y * (0.5f + y * (0.16666667f + y * (0.041666668f + y * 0.0083333338f)))) : 1.0f - __expf(y);
                bv[j] = sqrtf(nem1) * (ii * xv[j]); }
            *(LAS f32x4*)(ab + ((dir * 2 + 0) * 64 + t) * 64 + ch0) = av; *(LAS f32x4*)(ab + ((dir * 2 + 1) * 64 + t) * 64 + ch0) = bv; }
    }
    __syncthreads();
    if (tid < 128) { const int dir = tid >> 6, ch = tid & 63; const size_t ix = ((size_t)(b * RGC + ck) * 2 + dir) * 384 + g * 64 + ch;
        float hc = mode ? WSP(float, WS_RGC)[ix] : 0.f, ap = 1.0f;
        LAS float* A = ab + (dir * 2 + 0) * 4096 + ch; LAS float* B = ab + (dir * 2 + 1) * 4096 + ch;
#pragma unroll 8
        for (int s = 0; s < 64; ++s) { const int t = dir ? 63 - s : s; const float a = A[t * 64]; hc = a * hc + B[t * 64]; ap *= a; if (mode) B[t * 64] = hc; }
        if (!mode) { WSP(float, WS_RGA)[ix] = ap; WSP(float, WS_RGB)[ix] = hc; } }
    __syncthreads();
    if (mode) { const int t = tid >> 3, ch0 = (tid & 7) * 8; float hv[8]; float ss = 0.f;
#pragma unroll
        for (int j = 0; j < 8; ++j) { hv[j] = ab[(1 * 64 + t) * 64 + ch0 + j] + ab[(3 * 64 + t) * 64 + ch0 + j]; ss += hv[j] * hv[j]; }
        ss += dpp_<0xB1, 0xF>(ss); ss += dpp_<0x4E, 0xF>(ss); ss += dpp_<0x141, 0xF>(ss);
        const float rstd = rsqrtf(ss * (1.0f / 64.0f) + EPS);
        const size_t row = (size_t)(rowbase + t0 + t);
        const u32x4 gv = *(const u32x4*)(Pp + row * NP + PC_RG + g * 64 + ch0);
        const float* mw = P.in[I_MIXW] + l * 1024 + 384 + g * 64 + ch0;
        u32x4 o;
#pragma unroll
        for (int q = 0; q < 4; ++q) { const float g0 = __uint_as_float(gv[q] << 16), g1v = __uint_as_float(gv[q] & 0xFFFF0000u);
            o[q] = pk_bf16(g0 * hv[2 * q] * rstd * mw[2 * q], g1v * hv[2 * q + 1] * rstd * mw[2 * q + 1]); }
        *(u32x4*)(WSP(bf16_t, WS_MRG) + row * 1024 + 384 + g * 64 + ch0) = o;
        __syncthreads(); }
}
DEVI void rg_carry(const Ctx& cx) {
    for (int idx = cx.bid * NTHR + cx.tid; idx < NB * 2 * 384; idx += cx.G * NTHR) {
        const int ch = idx % 384, dir = (idx / 384) & 1, b = idx / 768; float h = 0.f;
#pragma unroll 1
        for (int s = 0; s < RGC; ++s) { const int ck = dir == 0 ? s : (s < 4 ? 3 - s : 39 - s);
            const size_t ix = ((size_t)(b * RGC + ck) * 2 + dir) * 384 + ch;
            WSP(float, WS_RGC)[ix] = h; h = WSP(float, WS_RGA)[ix] * h + WSP(float, WS_RGB)[ix]; }
    }
}

DEVI int s5_trow(int rowi, int s) { const int b = rowi / S5C, c = rowi % S5C; return c < 8 ? b * CTXL + c * 32 + s : TCTX + b * SEQ + s * 64 + (c - 8); }
DEVI void s5_local_wave(const Ctx& cx, int l, int wu) {
    const int g = wu / 36, mt = (wu % 36) / 4, nt = wu % 4;
    const bf16_t* Pp = WSP(bf16_t, WS_P) + PC_S5 + g * 16;
    const bf16_t* we = WSP(bf16_t, WS_WE) + (size_t)(l * 16 + g) * 256 * 512 + (size_t)nt * 64 * 512;
    f32x4 acc[4][4];
    wave_gemm<4, 4>(cx.lane, 512, [&](int row, int k) { return ldg8(Pp + (size_t)s5_trow(mt * 64 + row, k >> 4) * NP + (k & 15)); },
                         [&](int row, int k) { return ldg8(we + (size_t)row * 512 + k); }, acc);
    const int fr = cx.lane & 15, fq = cx.lane >> 4;
#pragma unroll
    for (int m = 0; m < 4; ++m)
#pragma unroll
        for (int n = 0; n < 4; ++n) *(f32x4*)(WSP(float, WS_SLOC) + ((size_t)g * S5R + mt * 64 + m * 16 + fr) * 256 + nt * 64 + n * 16 + 4 * fq) = acc[m][n];
}
DEVI void s5_carry(const Ctx& cx, int l) {
    for (int idx = cx.bid * NTHR + cx.tid; idx < NB * 16 * 2 * 64; idx += cx.G * NTHR) {
        const int n = idx & 63, d = (idx >> 6) & 1, g = (idx >> 7) & 15, b = idx >> 11;
        const f32x2 a32 = WSP(f32x2, WS_PW)[(size_t)(((l * 16 + g) * 2 + d) * 64 + n) * 33 + 32];
        float sr = 0.f, si = 0.f;
#pragma unroll 1
        for (int s = 0; s < S5C; ++s) { const int c = d == 0 ? s : (s < 8 ? 7 - s : 79 - s);
            const size_t ix = ((size_t)g * S5R + b * S5C + c) * 256 + d * 128 + n;
            WSP(bf16_t, WS_SIN)[ix] = f2bf(sr); WSP(bf16_t, WS_SIN)[ix + 64] = f2bf(si);
            const float lr = WSP(float, WS_SLOC)[ix], li = WSP(float, WS_SLOC)[ix + 64];
            const float nr = a32.x * sr - a32.y * si + lr, ni = a32.x * si + a32.y * sr + li; sr = nr; si = ni; }
    }
}
DEVI void s5_out_wave(const Ctx& cx, int l, int wu) {
    const int g = wu / 72, mt = (wu % 72) / 8, nt = wu % 8;
    const bf16_t* Pp = WSP(bf16_t, WS_P) + PC_S5 + g * 16;
    const bf16_t* sin_ = WSP(bf16_t, WS_SIN) + (size_t)g * S5R * 256;
    const bf16_t* wy = WSP(bf16_t, WS_WY) + (size_t)(l * 16 + g) * 512 * 768 + (size_t)nt * 64 * 768;
    f32x4 acc[4][4];
    wave_gemm<4, 4>(cx.lane, 768, [&](int row, int k) { return k < 512 ? ldg8(Pp + (size_t)s5_trow(mt * 64 + row, k >> 4) * NP + (k & 15)) : ldg8(sin_ + (size_t)(mt * 64 + row) * 256 + (k - 512)); },
                         [&](int row, int k) { return ldg8(wy + (size_t)row * 768 + k); }, acc);
    const int fr = cx.lane & 15, fq = cx.lane >> 4;
#pragma unroll
    for (int m = 0; m < 4; ++m)
#pragma unroll
        for (int n = 0; n < 4; ++n) { const int trow = s5_trow(mt * 64 + m * 16 + fr, nt * 4 + n);
            u32x2 w; w.x = pk_bf16(gelu_tanh(acc[m][n][0]), gelu_tanh(acc[m][n][1])); w.y = pk_bf16(gelu_tanh(acc[m][n][2]), gelu_tanh(acc[m][n][3]));
            *(u32x2*)(WSP(bf16_t, WS_GS) + (size_t)trow * 256 + g * 16 + 4 * fq) = w; }
}
DEVI void s5_glu_wave(const Ctx& cx, int l, int wu) {
    const int mt = wu / 4, nt = wu % 4;
    const bf16_t* gs = WSP(bf16_t, WS_GS) + (size_t)mt * 64 * 256;
    const bf16_t* wg = WSP(bf16_t, WS_WGLU) + (size_t)l * 65536 + (size_t)nt * 64 * 256;
    f32x4 acc[4][4];
    wave_gemm<4, 4>(cx.lane, 256, [&](int row, int k) { return ldg8(gs + (size_t)row * 256 + k); }, [&](int row, int k) { return ldg8(wg + (size_t)row * 256 + k); }, acc);
    const int fr = cx.lane & 15, fq = cx.lane >> 4;
#pragma unroll
    for (int n = 0; n < 4; ++n) { const int col = nt * 64 + n * 16 + 4 * fq;
        const f32x4 gb = *(const f32x4*)(cx.p->in[I_S5GB] + l * 256 + col), mw = *(const f32x4*)(cx.p->in[I_MIXW] + l * 1024 + 768 + col);
#pragma unroll
        for (int m = 0; m < 4; ++m) { const size_t trow = (size_t)mt * 64 + m * 16 + fr;
            const u32x2 gv = *(const u32x2*)(WSP(bf16_t, WS_GS) + trow * 256 + col);
            const float gq[4] = {__uint_as_float(gv.x << 16), __uint_as_float(gv.x & 0xFFFF0000u), __uint_as_float(gv.y << 16), __uint_as_float(gv.y & 0xFFFF0000u)};
            float o[4]; float ss = 0.f;
#pragma unroll
            for (int j = 0; j < 4; ++j) { o[j] = gq[j] / (1.0f + __expf(-(acc[m][n][j] + gb[j]))); ss += o[j] * o[j]; }
            ss += shx<16>(ss, cx.lane); ss += shx<32>(ss, cx.lane);
            const float rstd = rsqrtf(ss * (1.0f / 16.0f) + EPS);
            u32x2 w; w.x = pk_bf16(o[0] * rstd * mw[0], o[1] * rstd * mw[1]); w.y = pk_bf16(o[2] * rstd * mw[2], o[3] * rstd * mw[3]);
            *(u32x2*)(WSP(bf16_t, WS_MRG) + trow * 1024 + 768 + col) = w; } }
}

DEVI void ph_mix_local(const Ctx& cx, int l) {
    for (int u = cx.bid; u < NB * 4 * MLC; u += cx.G) ml_local_unit(cx, l, u / (4 * MLC), (u / MLC) % 4, u % MLC);
    { const int off = (NB * 4 * MLC) % cx.G; const int first = (cx.bid - off + cx.G) % cx.G;
      for (int u = first; u < NB * RGC * 6; u += cx.G) rg_unit(cx, l, u / (RGC * 6), (u / 6) % RGC, u % 6, 0); }
    { const int off = (NB * 4 * MLC + NB * RGC * 6) % cx.G; const int first = (cx.bid - off + cx.G) % cx.G;
      for (int wu = first * 8 + cx.wave; wu < 16 * 36; wu += cx.G * 8) s5_local_wave(cx, l, wu); }
}
DEVI void ph_mix_carry(const Ctx& cx, int l) { ml_carry(cx); rg_carry(cx); s5_carry(cx, l); }
DEVI void ph_mix_out(const Ctx& cx, int l) {
    const bool last = (l == DEPTH - 1);
    for (int u = cx.bid; u < NB * 4 * MLC; u += cx.G) { const int c = u % MLC; if (last && c < 2) continue; ml_out_unit(cx, l, u / (4 * MLC), (u / MLC) % 4, c); }
    { const int off = (NB * 4 * MLC) % cx.G; const int first = (cx.bid - off + cx.G) % cx.G;
      for (int u = first; u < NB * RGC * 6; u += cx.G) { const int ck = (u / 6) % RGC; if (last && ck < 4) continue; rg_unit(cx, l, u / (RGC * 6), ck, u % 6, 1); } }
    { const int off = (NB * 4 * MLC + NB * RGC * 6) % cx.G; const int first = (cx.bid - off + cx.G) % cx.G;
      for (int wu = first * 8 + cx.wave; wu < 16 * 72; wu += cx.G * 8) s5_out_wave(cx, l, wu); }
}
DEVI void ph_glu(const Ctx& cx, int l) {
    for (int wu = cx.bid * 8 + cx.wave; wu < (TT / 64) * 4; wu += cx.G * 8) s5_glu_wave(cx, l, wu);
}

DEVI unsigned st_launder(unsigned s_addr) { unsigned a; asm volatile("v_mov_b32 %0, %1" : "=v"(a) : "s"(s_addr)); return a; }
constexpr int N_STEPS = 3 + 10 * DEPTH + 1;
__global__ void __launch_bounds__(NTHR, 2) mk_fwd(Params p) {
    extern __shared__ __attribute__((aligned(16))) unsigned char lds_raw[];
    Ctx cx; cx.p = &p; cx.ws = p.ws; cx.lds = (LAS unsigned char*)lds_raw; cx.tid = threadIdx.x; cx.lane = cx.tid & 63;
    cx.wave = __builtin_amdgcn_readfirstlane((int)threadIdx.x >> 6); cx.G = gridDim.x; cx.bid = blockIdx.x;
    volatile LAS unsigned* st = (volatile LAS unsigned*)(cx.lds + LDS_BYTES - 16);
    const unsigned st_s = (unsigned)__builtin_amdgcn_readfirstlane((int)(unsigned)(size_t)(LAS unsigned*)(cx.lds + LDS_BYTES - 16));
#define ST_P ((volatile LAS unsigned*)(size_t)st_launder(st_s))
    if (cx.tid == 0) { st[0] = 0u; st[1] = 0u; st[2] = (unsigned)p.lo; st[3] = (unsigned)p.hi; }
    __syncthreads();
    (void)xcd_barrier_post((unsigned*)(p.ws + WS_CTL) + CW_BAR, st);
#define GRID_BAR() do { XcdBarrier b_; b_.bar = (unsigned*)(p.ws + WS_CTL) + CW_BAR; b_.x = (unsigned)__builtin_amdgcn_readfirstlane((int)xb_xcc_id()); b_.st = ST_P; xcd_barrier(b_); } while (0)
#ifndef PH_MASK
#define PH_MASK 0xFFFF
#endif
#define STEP_(id, k, call) do { const int lo_ = __builtin_amdgcn_readfirstlane((int)ST_P[2]), hi_ = __builtin_amdgcn_readfirstlane((int)ST_P[3]); if (lo_ <= (k) && (k) < hi_) { if ((PH_MASK >> (id)) & 1) { const Ctx cl = relaunder(cx); call; } if ((k) + 1 < hi_) GRID_BAR(); } } while (0)
    STEP_(0, 0, ph_pro_a(cl));
    STEP_(1, 1, ph_pro_b(cl));
    STEP_(2, 2, ph_pro_c(cl));
#pragma unroll 1
    for (int l = 0; l < DEPTH; ++l) {
        const int s0 = 3 + 10 * l;
        STEP_(3, s0 + 0, ph_norm1(cl, l));
        STEP_(4, s0 + 1, ph_inproj(cl, l));
        STEP_(5, s0 + 2, ph_mix_local(cl, l));
        STEP_(6, s0 + 3, ph_mix_carry(cl, l));
        STEP_(7, s0 + 4, ph_mix_out(cl, l));
        STEP_(8, s0 + 5, ph_glu(cl, l));
        STEP_(9, s0 + 6, ph_outproj(cl, l));
        STEP_(10, s0 + 7, ph_norm2(cl, l));
        STEP_(11, s0 + 8, ph_moe_gu(cl, l));
        STEP_(12, s0 + 9, ph_moe_dn(cl, l));
    }
    STEP_(13, N_STEPS - 1, ph_norm1(cl, DEPTH));
#undef STEP_
}

extern "C" void kernel_launch(void* const* d_in, const int* in_sizes, int n_in, void* d_out, int out_size, void* d_ws, size_t ws_size, hipStream_t stream) {
    static int grid = 0;
    if (grid == 0) {
        if (n_in != 36 || out_size != TLAT * DM || ws_size < WS_END) { fprintf(stderr, "kernel_launch: unexpected problem (n_in %d, out %d, ws %zu < %zu)\n", n_in, out_size, ws_size, (size_t)WS_END); grid = -1; return; }
        int dev = 0, cus = 0, per_cu = 0;
        if (hipGetDevice(&dev) != hipSuccess || hipDeviceGetAttribute(&cus, hipDeviceAttributeMultiprocessorCount, dev) != hipSuccess) { grid = -1; return; }
        if (hipFuncSetAttribute((const void*)mk_fwd, hipFuncAttributeMaxDynamicSharedMemorySize, LDS_BYTES) != hipSuccess) { fprintf(stderr, "kernel_launch: hipFuncSetAttribute failed\n"); grid = -1; return; }
        if (hipOccupancyMaxActiveBlocksPerMultiprocessor(&per_cu, (const void*)mk_fwd, NTHR, LDS_BYTES) != hipSuccess || per_cu < 1) { fprintf(stderr, "kernel_launch: occupancy query says %d blocks per CU\n", per_cu); }
        (void)hipGetLastError();
        grid = cus;
    }
    if (grid < 0) return;
    (void)hipMemsetAsync((char*)d_ws + WS_CTL, 0, CTL_BYTES, stream);
    Params p{};
    for (int i = 0; i < 36; ++i) p.in[i] = (const float*)d_in[i];
    p.out = (float*)d_out; p.ws = (unsigned char*)d_ws;
#if MK_FUSED
    p.lo = 0; p.hi = N_STEPS;
    hipLaunchKernelGGL(mk_fwd, dim3(grid), dim3(NTHR), LDS_BYTES, stream, p);
#else
    for (int k = 0; k < N_STEPS; ++k) { p.lo = k; p.hi = k + 1; hipLaunchKernelGGL(mk_fwd, dim3(grid), dim3(NTHR), LDS_BYTES, stream, p); }
#endif
}
```

```cpp
#include <hip/hip_runtime.h>
#include <stdint.h>
#include <stdio.h>

#ifndef MK_FUSED
#define MK_FUSED 1
#endif

typedef unsigned short bf16_t;
typedef short bf16x8 __attribute__((ext_vector_type(8)));
typedef float f32x4 __attribute__((ext_vector_type(4)));
typedef float f32x2 __attribute__((ext_vector_type(2)));
typedef unsigned u32x4 __attribute__((ext_vector_type(4)));
typedef unsigned u32x2 __attribute__((ext_vector_type(2)));
#define LAS __attribute__((address_space(3)))
#define DEVI __device__ __forceinline__

constexpr int DM = 1024, NB = 8, SEQ = 2048, CTXL = 256, DEPTH = 4;
constexpr int TCTX = NB * CTXL, TLAT = NB * SEQ, TT = TCTX + TLAT;
constexpr int DIN = 2576, NP = 2560;
constexpr int NE = 32;
constexpr int PMAX = 81920;
constexpr int NTHR = 512;
constexpr int LDS_BYTES = 152 * 1024;
constexpr float EPS = 1e-6f;
constexpr int PC_Q = 0, PC_K = 384, PC_V = 768, PC_O = 1152, PC_RX = 1536, PC_RG = 1920, PC_S5 = 2304;
constexpr int MLC = 18;
constexpr int RGC = 36;
constexpr int S5C = 72, S5R = NB * S5C;

constexpr size_t al256(size_t x) { return (x + 255) & ~(size_t)255; }
constexpr size_t WS_CTL   = 0;
constexpr size_t CTL_BYTES = 65536;
constexpr size_t CW_BAR = 0;
constexpr size_t CW_CNT = 4096;
constexpr size_t WS_WIN   = al256(WS_CTL + CTL_BYTES);
constexpr size_t WS_WOUT  = al256(WS_WIN + (size_t)DEPTH * NP * 1024 * 2);
constexpr size_t WS_WGU   = al256(WS_WOUT + (size_t)DEPTH * 1024 * 1024 * 2);
constexpr size_t WS_WD    = al256(WS_WGU + (size_t)DEPTH * NE * 2048 * 1024 * 2);
constexpr size_t WS_MOD   = al256(WS_WD + (size_t)DEPTH * NE * 1024 * 1024 * 2);
constexpr size_t WS_PW    = al256(WS_MOD + (size_t)DEPTH * 9 * 6144 * 4);
constexpr size_t WS_BB    = al256(WS_PW + (size_t)DEPTH * 16 * 2 * 64 * 33 * 8);
constexpr size_t WS_KT    = al256(WS_BB + (size_t)DEPTH * 16 * 2 * 64 * 16 * 8);
constexpr size_t WS_WY    = al256(WS_KT + (size_t)DEPTH * 16 * 2 * 32 * 256 * 4);
constexpr size_t WS_WE    = al256(WS_WY + (size_t)DEPTH * 16 * 512 * 768 * 2);
constexpr size_t WS_WRG   = al256(WS_WE + (size_t)DEPTH * 16 * 256 * 512 * 2);
constexpr size_t WS_WGLU  = al256(WS_WRG + (size_t)DEPTH * 6 * 256 * 64 * 2);
constexpr size_t WS_XS    = al256(WS_WGLU + (size_t)DEPTH * 256 * 256 * 2);
constexpr size_t WS_XMID  = al256(WS_XS + (size_t)TT * 1024 * 4);
constexpr size_t WS_H     = al256(WS_XMID + (size_t)TT * 1024 * 4);
constexpr size_t WS_GT    = al256(WS_H + (size_t)TT * 1024 * 2);
constexpr size_t WS_P     = al256(WS_GT + (size_t)TT * 16 * 4);
constexpr size_t WS_GB    = al256(WS_P + (size_t)TT * NP * 2);
constexpr size_t WS_GU    = al256(WS_GB + (size_t)TT * 8 * 4);
constexpr size_t WS_GCM   = al256(WS_GU + (size_t)TT * 8 * 4);
constexpr size_t WS_MSC   = al256(WS_GCM + (size_t)TT * 8 * 4);
constexpr size_t WS_CLOC  = al256(WS_MSC + (size_t)8 * 4 * 18 * 2 * 2 * 4);
constexpr size_t WS_NLOC  = al256(WS_CLOC + (size_t)8 * 4 * 18 * 2 * 9216 * 4);
constexpr size_t WS_C0    = al256(WS_NLOC + (size_t)8 * 4 * 18 * 2 * 96 * 4);
constexpr size_t WS_N0    = al256(WS_C0 + (size_t)8 * 4 * 18 * 2 * 9216 * 2);
constexpr size_t WS_M0    = al256(WS_N0 + (size_t)8 * 4 * 18 * 2 * 96 * 4);
constexpr size_t WS_RGA   = al256(WS_M0 + (size_t)8 * 4 * 18 * 2 * 4);
constexpr size_t WS_RGB   = al256(WS_RGA + (size_t)8 * 36 * 2 * 384 * 4);
constexpr size_t WS_RGC   = al256(WS_RGB + (size_t)8 * 36 * 2 * 384 * 4);
constexpr size_t WS_SLOC  = al256(WS_RGC + (size_t)8 * 36 * 2 * 384 * 4);
constexpr size_t WS_SIN   = al256(WS_SLOC + (size_t)16 * 576 * 256 * 4);
constexpr size_t WS_GS    = al256(WS_SIN + (size_t)16 * 576 * 256 * 2);
constexpr size_t WS_MRG   = al256(WS_GS + (size_t)TT * 256 * 2);
constexpr size_t WS_ELIST = al256(WS_MRG + (size_t)TT * 1024 * 2);
constexpr size_t WS_GLIST = al256(WS_ELIST + (size_t)NE * TT * 4);
constexpr size_t WS_TINFO = al256(WS_GLIST + (size_t)NE * TT * 4);
constexpr size_t WS_ACT   = al256(WS_TINFO + (size_t)TT * 4 * 4);
constexpr size_t WS_YPAD  = al256(WS_ACT + (size_t)PMAX * 1024 * 2);
constexpr size_t WS_BIN2  = al256(WS_YPAD + (size_t)PMAX * 1024 * 2);
constexpr size_t WS_HLO   = al256(WS_BIN2 + (size_t)DEPTH * NP * 4);
constexpr size_t WS_WGT   = al256(WS_HLO + (size_t)TT * 1024 * 2);
constexpr size_t WS_RWH   = al256(WS_WGT + (size_t)DEPTH * 16 * 1024 * 2);
constexpr size_t WS_RWL   = al256(WS_RWH + (size_t)DEPTH * 32 * 1024 * 2);
constexpr size_t WS_END   = al256(WS_RWL + (size_t)DEPTH * 32 * 1024 * 2);

struct Params { const float* in[36]; float* out; unsigned char* ws; int lo, hi; };

enum { I_X = 0, I_C, I_CTX, I_CCTX, I_ADAW, I_ADAB, I_N1W, I_WIN, I_BIN, I_RGCW, I_RGCB, I_RGWA, I_RGBA, I_RGWX, I_RGBX, I_RGLAM,
       I_S5LRE, I_S5LIM, I_S5LDT, I_S5BRE, I_S5BIM, I_S5CRE, I_S5CIM, I_S5D, I_S5GW, I_S5GB, I_MIXW, I_WOUT, I_N2W, I_RW, I_RB,
       I_WGU, I_BGU, I_WD, I_BD, I_FNW };

DEVI bf16_t f2bf(float f) { unsigned u = __float_as_uint(f); u += 0x7FFFu + ((u >> 16) & 1u); return (bf16_t)(u >> 16); }
DEVI float bf2f(bf16_t b) { return __uint_as_float(((unsigned)b) << 16); }
DEVI unsigned pk_bf16(float lo, float hi) { unsigned r; asm("v_cvt_pk_bf16_f32 %0, %1, %2" : "=v"(r) : "v"(lo), "v"(hi)); return r; }
DEVI float frcp(float x) { return __builtin_amdgcn_rcpf(x); }
DEVI float sigmoidf_(float x) { return frcp(1.0f + __expf(-x)); }
DEVI float gelu_tanh(float x) { const float u = 0.7978845608f * (x + 0.044715f * x * x * x); return x * frcp(1.0f + __expf(-2.0f * u)); }
template <int M> DEVI float shx(float v, int lane) {
    if constexpr (M < 32) return __int_as_float(__builtin_amdgcn_ds_swizzle(__float_as_int(v), 0x1F | (M << 10)));
    else return __int_as_float(__builtin_amdgcn_ds_bpermute((lane ^ 32) << 2, __float_as_int(v)));
}
DEVI float shxr(float v, int m, int lane) {
    switch (m) { case 1: return shx<1>(v, lane); case 2: return shx<2>(v, lane); case 4: return shx<4>(v, lane); case 8: return shx<8>(v, lane); case 16: return shx<16>(v, lane); default: return shx<32>(v, lane); }
}
DEVI int shxri(int v, int m, int lane) { return __float_as_int(shxr(__int_as_float(v), m, lane)); }
template <int CTRL, int ROWMASK> DEVI float dpp_(float v) { return __int_as_float(__builtin_amdgcn_update_dpp(0, __float_as_int(v), CTRL, ROWMASK, 0xF, false)); }
DEVI float wave_sum(float v, int) {
    v += dpp_<0xB1, 0xF>(v); v += dpp_<0x4E, 0xF>(v); v += dpp_<0x141, 0xF>(v); v += dpp_<0x140, 0xF>(v);
    v += dpp_<0x142, 0xA>(v); v += dpp_<0x143, 0xC>(v);
    return __int_as_float(__builtin_amdgcn_readlane(__float_as_int(v), 63));
}
DEVI float log1p_(float e) { return e < 0.06f ? e * (1.0f - e * (0.5f - e * (0.33333334f - e * 0.25f))) : __logf(1.0f + e); }
DEVI int mod_row(int row) { return row < TCTX ? 8 : (row - TCTX) / SEQ; }

#define XB_TMO      128
#define XB_XCNT(j)  (256  + 64 * (j))
#define XB_XSUB(j)  (1280 + 64 * (j))
#define XB_XGEN(j)  (2304 + 64 * (j))
#define XB_TOP      3328
#define XB_TOPGEN   3392
#define XCD_BAR_WORDS 3456
#define XB_SPIN_CAP (1u << 18)
__device__ __forceinline__ unsigned xb_ld(unsigned* p)              { return __hip_atomic_load(p, __ATOMIC_RELAXED, __HIP_MEMORY_SCOPE_AGENT); }
__device__ __forceinline__ unsigned xb_add(unsigned* p, unsigned v) { return __hip_atomic_fetch_add(p, v, __ATOMIC_RELAXED, __HIP_MEMORY_SCOPE_AGENT); }
__device__ __forceinline__ unsigned xb_xcc_id() { return (unsigned)__builtin_amdgcn_s_getreg((3 << 11) | 20) & 0xFu; }
#define XB_SPIN(cond, bar) do { unsigned _sp = 0; while (cond) { __builtin_amdgcn_s_sleep(1); \
    if ((++_sp & 255u) == 0u) { if (xb_ld(&(bar)[XB_TMO])) break; if (_sp > XB_SPIN_CAP) { atomicAdd(&(bar)[XB_TMO], 1u); break; } } } } while (0)
struct XcdBarrier { unsigned* bar; unsigned x; volatile LAS unsigned* st; };
__device__ __forceinline__ XcdBarrier xcd_barrier_post(unsigned* bar, volatile LAS unsigned* st) {
    XcdBarrier b; b.bar = bar; b.x = xb_xcc_id(); b.st = st;
    if (threadIdx.x == 0) (void)xb_add(&bar[XB_XCNT(b.x)], 1u);
    return b;
}
__device__ __forceinline__ void xcd_barrier_complete(unsigned* bar, unsigned x, unsigned& nloc, unsigned& nx) {
    const unsigned G = gridDim.x * gridDim.y * gridDim.z;
    unsigned sum, cnt, mine, sp = 0u;
    for (;;) {
        sum = 0u; cnt = 0u; mine = 0u;
#pragma unroll
        for (unsigned j = 0; j < 16; ++j) { const unsigned c = xb_ld(&bar[XB_XCNT(j)]); sum += c; cnt += (c > 0u) ? 1u : 0u; mine = (j == x) ? c : mine; }
        if (sum == G) break;
        __builtin_amdgcn_s_sleep(1);
        if ((++sp & 255u) == 0u) { if (xb_ld(&bar[XB_TMO])) break; if (sp > XB_SPIN_CAP) { atomicAdd(&bar[XB_TMO], 1u); break; } }
    }
    nloc = mine > 0u ? mine : 1u; nx = cnt > 0u ? cnt : 1u;
}
__device__ __forceinline__ void xcd_barrier(const XcdBarrier& b) {
    asm volatile("s_waitcnt vmcnt(0)" ::: "memory");
    __syncthreads();
    if (threadIdx.x == 0) {
        unsigned* bar = b.bar;
        __builtin_amdgcn_s_waitcnt(0);
        unsigned nloc = b.st[0], nx = b.st[1];
        if (nloc == 0u) { xcd_barrier_complete(bar, b.x, nloc, nx); b.st[0] = nloc; b.st[1] = nx; }
        const unsigned old = xb_add(&bar[XB_XSUB(b.x)], 1u);
        const unsigned gen = old / nloc;
        if (old + 1u == (gen + 1u) * nloc) {
            __builtin_amdgcn_fence(__ATOMIC_RELEASE, "agent");
            asm volatile("s_waitcnt vmcnt(0)" ::: "memory");
            const unsigned og = xb_add(&bar[XB_TOP], 1u);
            const unsigned tg = og / nx;
            if (og + 1u == (tg + 1u) * nx) xb_add(&bar[XB_TOPGEN], 1u);
            else XB_SPIN(xb_ld(&bar[XB_TOPGEN]) == tg, bar);
            __builtin_amdgcn_fence(__ATOMIC_ACQUIRE, "agent");
            xb_add(&bar[XB_XGEN(b.x)], 1u);
            asm volatile("s_waitcnt vmcnt(0)" ::: "memory");
        } else {
            XB_SPIN(xb_ld(&bar[XB_XGEN(b.x)]) == gen, bar);
            __builtin_amdgcn_fence(__ATOMIC_ACQUIRE, "agent");
            asm volatile("s_waitcnt vmcnt(0)" ::: "memory");
        }
    }
    __syncthreads();
}

namespace g1 {
constexpr int BM = 256, BK = 64, HALF = 128, HTB = HALF * BK * 2, STAGE_BYTES = 8 * HTB, K = 1024, NT = K / BK;
DEVI int lds_byte(int r, int c) { const int st = (r >> 4) * 2 + (c >> 5), rr = r & 15, cc = c & 31, ob = rr * 64 + cc * 2; return st * 1024 + (ob ^ (((ob >> 9) & 1) << 5)); }
DEVI void stage_rc(int b, int& R, int& C) { const int st = b / 1024, sb = b % 1024, swz = sb ^ (((sb >> 9) & 1) << 5); R = (st >> 1) * 16 + swz / 64; C = (st & 1) * 32 + (swz % 64) / 2; }
DEVI int perm32(int rho) { const int n = rho >> 4, i = rho & 15; return 8 * (i >> 2) + 4 * n + (i & 3); }

struct Unit {
    const char* A;
    const int* list;
    int nvalid;
    const char* B;
    int pm, pn, e;
};

template <bool GATHER>
DEVI void a_offsets(const Unit& u, const int (&R)[2], const int (&C)[2], unsigned (&v)[2][2]) {
#pragma unroll
    for (int h = 0; h < 2; ++h)
#pragma unroll
        for (int i = 0; i < 2; ++i) {
            const int r = h * HALF + R[i];
            int src = r;
            if (GATHER) { src = (r < u.nvalid) ? u.list[r] : 0; }
            v[h][i] = (unsigned)src * (unsigned)(K * 2) + (unsigned)(C[i] * 2);
        }
}

template <class Sched, class Epi, bool GATHER>
DEVI void gemm_phase(LAS unsigned char* lds, const int tid, const Sched& S, const Epi& E) {
    const int wid = __builtin_amdgcn_readfirstlane(tid >> 6), lane = tid & 63, wr = wid >> 2, wc = wid & 3, fr = lane & 15, fq = lane >> 4;
    int R[2], C[2]; unsigned voffB[2];
#pragma unroll
    for (int i = 0; i < 2; ++i) { stage_rc(tid * 16 + i * 8192, R[i], C[i]); const int Rb = Epi::PERM ? ((R[i] & ~31) + perm32(R[i] & 31)) : R[i]; voffB[i] = (unsigned)(Rb * K + C[i]) * 2u; }
    constexpr size_t kstep = (size_t)(BK * 2);
    constexpr size_t hstep = (size_t)HALF * K * 2;
    const unsigned ldsw = (unsigned)wid * 1024u;
    const int aoff = lds_byte(wr * 64 + fr, fq * 8), boff = lds_byte(wc * 32 + fr, fq * 8);
#define G1_SA(b, h) (((b) * 2 + (h)) * HTB)
#define G1_SB(b, h) ((4 + (b) * 2 + (h)) * HTB)
#define G1_STAGE2(bufoff, gbase, v0, v1) do { \
        __builtin_amdgcn_global_load_lds((const unsigned*)((const char*)(gbase) + (v0)), (LAS unsigned*)(lds + (bufoff) + ldsw), 16, 0, 0); \
        __builtin_amdgcn_global_load_lds((const unsigned*)((const char*)(gbase) + (v1)), (LAS unsigned*)(lds + (bufoff) + ldsw + 8192), 16, 0, 0); } while (0)
#define G1_LDA(dst, b, h) do { _Pragma("unroll") for (int m = 0; m < 4; ++m) _Pragma("unroll") for (int k = 0; k < 2; ++k) dst[m][k] = *(const LAS bf16x8*)(lds + G1_SA(b, h) + aoff + m * 2048 + k * 1024); } while (0)
#define G1_LDB(dst, b, h) do { _Pragma("unroll") for (int n = 0; n < 2; ++n) _Pragma("unroll") for (int k = 0; k < 2; ++k) dst[n][k] = *(const LAS bf16x8*)(lds + G1_SB(b, h) + boff + n * 2048 + k * 1024); } while (0)
#define G1_MMA(ai, bj, At, Bt) do { __builtin_amdgcn_s_setprio(1); _Pragma("unroll") for (int m = 0; m < 4; ++m) _Pragma("unroll") for (int n = 0; n < 2; ++n) _Pragma("unroll") for (int k = 0; k < 2; ++k) \
        acc[ai][bj][m][n] = __builtin_amdgcn_mfma_f32_16x16x32_bf16(Bt[n][k], At[m][k], acc[ai][bj][m][n], 0, 0, 0); __builtin_amdgcn_s_setprio(0); } while (0)
#define G1_WAIT_V(n) asm volatile("s_waitcnt vmcnt(" #n ")" ::: "memory")
#define G1_WAIT_L(n) asm volatile("s_waitcnt lgkmcnt(" #n ")" ::: "memory")
#define G1_BAR __builtin_amdgcn_s_barrier()
#define G1_SCHED __builtin_amdgcn_sched_barrier(0)
    Unit cur, nxt; int ui = 0;
    if (!S.get(0, cur)) return;
    f32x4 acc[2][2][4][2];
#pragma unroll
    for (int a = 0; a < 2; ++a)
#pragma unroll
        for (int b = 0; b < 2; ++b)
#pragma unroll
            for (int m = 0; m < 4; ++m)
#pragma unroll
                for (int n = 0; n < 2; ++n) acc[a][b][m][n] = (f32x4){0.f, 0.f, 0.f, 0.f};
    bf16x8 At[4][2], B0[2][2], B1[2][2];
    unsigned vc[2][2], vn[2][2];
    a_offsets<GATHER>(cur, R, C, vc);
    const char* cA = cur.A; const char* cB = cur.B;
    G1_STAGE2(G1_SB(0, 0), cB, voffB[0], voffB[1]); G1_STAGE2(G1_SA(0, 0), cA, vc[0][0], vc[0][1]);
    G1_STAGE2(G1_SB(0, 1), cB + hstep, voffB[0], voffB[1]); G1_STAGE2(G1_SA(0, 1), cA, vc[1][0], vc[1][1]);
    if (wr == 1) G1_BAR;
    G1_WAIT_V(4); G1_BAR;
    G1_STAGE2(G1_SB(1, 0), cB + kstep, voffB[0], voffB[1]); G1_STAGE2(G1_SA(1, 0), cA + kstep, vc[0][0], vc[0][1]);
    G1_STAGE2(G1_SB(1, 1), cB + hstep + kstep, voffB[0], voffB[1]);
    G1_WAIT_V(6); G1_BAR;
    for (;;) {
        const bool has_next = S.get(ui + 1, nxt);
        if (has_next) { a_offsets<GATHER>(nxt, R, C, vn); }
        else {
#pragma unroll
            for (int h = 0; h < 2; ++h)
#pragma unroll
                for (int i = 0; i < 2; ++i) vn[h][i] = vc[h][i];
        }
        const char* nA = has_next ? nxt.A : cA; const char* nB = has_next ? nxt.B : cB;
        for (int t = 0; t < NT; t += 2) {
            const bool last = (t == NT - 2);
            const char* a1 = cA + (size_t)(t + 1) * kstep;
            const char* a2 = last ? nA : cA + (size_t)(t + 2) * kstep; const char* b2 = last ? nB : cB + (size_t)(t + 2) * kstep;
            const char* a3 = a2 + kstep; const char* b3 = b2 + kstep;
            const unsigned w00 = last ? vn[0][0] : vc[0][0], w01 = last ? vn[0][1] : vc[0][1], w10 = last ? vn[1][0] : vc[1][0], w11 = last ? vn[1][1] : vc[1][1];
            G1_LDB(B0, 0, 0); G1_SCHED; G1_LDA(At, 0, 0); G1_STAGE2(G1_SA(1, 1), a1, vc[1][0], vc[1][1]);
            G1_WAIT_L(8); G1_BAR; G1_WAIT_L(0); G1_MMA(0, 0, At, B0); G1_BAR; G1_SCHED;
            G1_LDB(B1, 0, 1); G1_STAGE2(G1_SB(0, 0), b2, voffB[0], voffB[1]);
            G1_BAR; G1_WAIT_L(0); G1_MMA(0, 1, At, B1); G1_BAR;
            G1_LDA(At, 0, 1); G1_STAGE2(G1_SA(0, 0), a2, w00, w01);
            G1_BAR; G1_WAIT_L(0); G1_MMA(1, 0, At, B0); G1_BAR; G1_SCHED;
            G1_STAGE2(G1_SB(0, 1), b2 + hstep, voffB[0], voffB[1]);
            G1_WAIT_V(6); G1_BAR; G1_MMA(1, 1, At, B1); G1_BAR;
            G1_LDB(B0, 1, 0); G1_SCHED; G1_LDA(At, 1, 0); G1_STAGE2(G1_SA(0, 1), a2, w10, w11);
            G1_WAIT_L(8); G1_BAR; G1_WAIT_L(0); G1_MMA(0, 0, At, B0); G1_BAR; G1_SCHED;
            G1_LDB(B1, 1, 1); G1_STAGE2(G1_SB(1, 0), b3, voffB[0], voffB[1]);
            G1_BAR; G1_WAIT_L(0); G1_MMA(0, 1, At, B1); G1_BAR;
            G1_LDA(At, 1, 1); G1_STAGE2(G1_SA(1, 0), a3, w00, w01);
            G1_BAR; G1_WAIT_L(0); G1_MMA(1, 0, At, B0); G1_BAR; G1_SCHED;
            G1_STAGE2(G1_SB(1, 1), b3 + hstep, voffB[0], voffB[1]);
            G1_WAIT_V(6); G1_BAR; G1_MMA(1, 1, At, B1); G1_BAR;
        }
        E(acc, cur, wr, wc, fr, fq);
        if (!has_next) break;
#pragma unroll
        for (int a = 0; a < 2; ++a)
#pragma unroll
            for (int b = 0; b < 2; ++b)
#pragma unroll
                for (int m = 0; m < 4; ++m)
#pragma unroll
                    for (int n = 0; n < 2; ++n) acc[a][b][m][n] = (f32x4){0.f, 0.f, 0.f, 0.f};
        cur = nxt; cA = nA; cB = nB; ++ui;
#pragma unroll
        for (int h = 0; h < 2; ++h)
#pragma unroll
            for (int i = 0; i < 2; ++i) vc[h][i] = vn[h][i];
    }
    G1_WAIT_V(0);
    if (wr == 0) G1_BAR;
    G1_BAR;
}
}

template <int MT, int NT_, class AF, class BF>
DEVI void wave_gemm(const int lane, int Kdim, const AF& af, const BF& bf, f32x4 (&acc)[MT][NT_]) {
    const int fr = lane & 15, fq = lane >> 4;
#pragma unroll
    for (int m = 0; m < MT; ++m)
#pragma unroll
        for (int n = 0; n < NT_; ++n) acc[m][n] = (f32x4){0.f, 0.f, 0.f, 0.f};
    bf16x8 fa[4][MT], fb[4][NT_];
#define WG_LOAD(S, KK) do { _Pragma("unroll") for (int m = 0; m < MT; ++m) fa[S][m] = af(m * 16 + fr, (KK) + fq * 8); _Pragma("unroll") for (int n = 0; n < NT_; ++n) fb[S][n] = bf(n * 16 + fr, (KK) + fq * 8); } while (0)
#define WG_MMA(S) do { _Pragma("unroll") for (int m = 0; m < MT; ++m) _Pragma("unroll") for (int n = 0; n < NT_; ++n) acc[m][n] = __builtin_amdgcn_mfma_f32_16x16x32_bf16(fb[S][n], fa[S][m], acc[m][n], 0, 0, 0); } while (0)
    WG_LOAD(0, 0); WG_LOAD(1, 32); WG_LOAD(2, 64);
#pragma unroll 1
    for (int k0 = 0; k0 < Kdim; k0 += 128) {
        const bool more = k0 + 128 < Kdim;
        WG_LOAD(3, k0 + 96); WG_MMA(0);
        if (more) WG_LOAD(0, k0 + 128);
        WG_MMA(1);
        if (more) WG_LOAD(1, k0 + 160);
        WG_MMA(2);
        if (more) WG_LOAD(2, k0 + 192);
        WG_MMA(3);
    }
#undef WG_LOAD
#undef WG_MMA
}
DEVI bf16x8 ldg8(const bf16_t* p) { return *(const bf16x8*)p; }

template <int N> struct Log2 { static constexpr int v = 1 + Log2<N / 2>::v; };
template <> struct Log2<1> { static constexpr int v = 0; };
template <int N>
DEVI float reduce_scatter(const int lane, float (&v)[N]) {
    constexpr int LG = Log2<N>::v;
#pragma unroll
    for (int st = 0; st < LG; ++st) {
        const int s = (N / 2) >> st, mask = 32 >> st;
        const bool up = (lane & mask) != 0;
#pragma unroll
        for (int i = 0; i < N / 2; ++i) if (i < s) {
            const float send = up ? v[i] : v[i + s];
            const float keep = up ? v[i + s] : v[i];
            v[i] = keep + shxr(send, mask, lane);
        }
    }
    float r = v[0];
#pragma unroll
    for (int st = LG; st < 6; ++st) r += shxr(r, 32 >> st, lane);
    return r;
}
template <int N>
DEVI int rs_index(int lane) {
    constexpr int LG = Log2<N>::v;
    int idx = 0;
#pragma unroll
    for (int st = 0; st < LG; ++st) if (lane & (32 >> st)) idx += (N / 2) >> st;
    return idx;
}

struct Ctx {
    const Params* p; unsigned char* ws; LAS unsigned char* lds; int tid, lane, wave, G, bid;
};
#define WSP(T, off) ((T*)(cx.ws + (off)))
DEVI Ctx relaunder(const Ctx& c) { Ctx r = c; int ln, td;
    asm volatile("v_mbcnt_lo_u32_b32 %0, -1, 0\n\tv_mbcnt_hi_u32_b32 %0, -1, %0\n\tv_lshl_add_u32 %1, %2, 6, %0" : "=&v"(ln), "=v"(td) : "s"(c.wave));
    r.lane = ln; r.tid = td; return r; }

DEVI void cvt_tile(const Ctx& cx, const float* src, int ld, bf16_t* dst, int n0, int k0, int kind) {
    LAS bf16_t* tile = (LAS bf16_t*)cx.lds;
    const int n4 = (cx.tid & 63) * 4, w8 = (cx.tid >> 6) * 8, n = n0 + n4;
    int sc; float scale = 1.0f;
    if (kind == 0) { sc = n < 1536 ? n : n + 16; if (n >= 384 && n < 768) scale = 0.10206207261596577f; }
    else if (kind == 2) { const int pn = n >> 8, w = n & 255; sc = w < 128 ? pn * 128 + w : 1024 + pn * 128 + (w - 128); }
    else sc = n;
#pragma unroll 1
    for (int sub = 0; sub < 4; sub += 2) {
        f32x4 v[2][8];
#pragma unroll
        for (int s2 = 0; s2 < 2; ++s2)
#pragma unroll
            for (int p = 0; p < 8; ++p) v[s2][p] = *(const f32x4*)(src + (size_t)(k0 + (sub + s2) * 64 + w8 + p) * ld + sc);
#pragma unroll
        for (int s2 = 0; s2 < 2; ++s2)
#pragma unroll
            for (int j = 0; j < 4; ++j) { u32x4 w;
                w.x = pk_bf16(v[s2][0][j] * scale, v[s2][1][j] * scale); w.y = pk_bf16(v[s2][2][j] * scale, v[s2][3][j] * scale);
                w.z = pk_bf16(v[s2][4][j] * scale, v[s2][5][j] * scale); w.w = pk_bf16(v[s2][6][j] * scale, v[s2][7][j] * scale);
                *(LAS u32x4*)(tile + (n4 + j) * 264 + (sub + s2) * 64 + w8) = w; }
    }
    __syncthreads();
#pragma unroll
    for (int i = 0; i < 16; ++i) { const int idx = cx.tid + NTHR * i, row = idx >> 5, ch = idx & 31;
        const u32x4 o = *(const LAS u32x4*)(tile + row * 264 + ch * 8);
        *(u32x4*)(dst + (size_t)(n0 + row) * 1024 + k0 + ch * 8) = o; }
    __syncthreads();
}

DEVI void ph_pro_a(const Ctx& cx) {
    const Params& P = *cx.p;
    {
        constexpr int n_in = DEPTH * 10 * 4, n_out = DEPTH * 4 * 4, n_gu = DEPTH * NE * 8 * 4, n_dn = DEPTH * NE * 4 * 4;
        constexpr int total = n_in + n_out + n_gu + n_dn;
        for (int job = cx.bid; job < total; job += cx.G) {
            int j = job;
            if (j < n_in) { const int l = j / 40, r = j % 40, nt = r / 4, kt = r % 4;
                cvt_tile(cx, P.in[I_WIN] + (size_t)l * 1024 * DIN, DIN, WSP(bf16_t, WS_WIN) + (size_t)l * NP * 1024, nt * 256, kt * 256, 0); continue; }
            j -= n_in;
            if (j < n_out) { const int l = j / 16, r = j % 16, nt = r / 4, kt = r % 4;
                cvt_tile(cx, P.in[I_WOUT] + (size_t)l * 1024 * 1024, 1024, WSP(bf16_t, WS_WOUT) + (size_t)l * 1024 * 1024, nt * 256, kt * 256, 1); continue; }
            j -= n_out;
            if (j < n_gu) { const int le = j / 32, r = j % 32, nt = r / 4, kt = r % 4;
                cvt_tile(cx, P.in[I_WGU] + (size_t)le * 1024 * 2048, 2048, WSP(bf16_t, WS_WGU) + (size_t)le * 2048 * 1024, nt * 256, kt * 256, 2); continue; }
            j -= n_gu;
            { const int le = j / 16, r = j % 16, nt = r / 4, kt = r % 4;
                cvt_tile(cx, P.in[I_WD] + (size_t)le * 1024 * 1024, 1024, WSP(bf16_t, WS_WD) + (size_t)le * 1024 * 1024, nt * 256, kt * 256, 1); }
        }
    }
    __syncthreads();
    {
        LAS float* sv = (LAS float*)cx.lds;
        LAS float* red = sv + 9 * 1024;
        constexpr int units = DEPTH * 6144 / 64;
        if (cx.bid < units) {
            for (int i = cx.tid; i < 9 * 1024; i += NTHR) { const int r = i >> 10, k = i & 1023; const float c = r < 8 ? P.in[I_C][r * 1024 + k] : P.in[I_CCTX][k]; sv[i] = c / (1.0f + __expf(-c)); }
            __syncthreads();
            for (int u = cx.bid; u < units; u += cx.G) {
                const int l = u / 96, n = (u % 96) * 64 + cx.lane;
                const float* w = P.in[I_ADAW] + (size_t)l * 1024 * 6144 + n;
                float acc[9];
#pragma unroll
                for (int r = 0; r < 9; ++r) acc[r] = 0.f;
                const int kb = cx.wave * 128;
#pragma unroll 4
                for (int k = 0; k < 128; ++k) { const float wv = w[(size_t)(kb + k) * 6144];
#pragma unroll
                    for (int r = 0; r < 9; ++r) acc[r] += sv[r * 1024 + kb + k] * wv; }
#pragma unroll
                for (int r = 0; r < 9; ++r) red[(cx.wave * 9 + r) * 64 + cx.lane] = acc[r];
                __syncthreads();
                for (int i = cx.tid; i < 9 * 64; i += NTHR) { const int r = i >> 6, ln = i & 63; float s = 0.f;
#pragma unroll
                    for (int w8 = 0; w8 < 8; ++w8) s += red[(w8 * 9 + r) * 64 + ln];
                    const int nn = (u % 96) * 64 + ln;
                    WSP(float, WS_MOD)[((size_t)l * 9 + r) * 6144 + nn] = s + P.in[I_ADAB][l * 6144 + nn]; }
                __syncthreads();
            }
        }
    }
    for (int gt = cx.bid * NTHR + cx.tid; gt < DEPTH * 16 * 2 * 64; gt += cx.G * NTHR) {
        const int n = gt & 63, d = (gt >> 6) & 1, g = (gt >> 7) & 15, l = gt >> 11;
        const float dt = expf(P.in[I_S5LDT][(l * 2 + d) * 16 + g]);
        const float lr = P.in[I_S5LRE][((l * 2 + d) * 16 + g) * 64 + n], li = P.in[I_S5LIM][((l * 2 + d) * 16 + g) * 64 + n];
        f32x2* pw = WSP(f32x2, WS_PW) + (size_t)gt * 33;
        float ar = 0.f, ai = 0.f;
        for (int k = 0; k <= 32; ++k) { const float mag = expf(lr * dt * (float)k); float s, c; sincosf(li * dt * (float)k, &s, &c); pw[k] = (f32x2){mag * c, mag * s}; if (k == 1) { ar = mag * c; ai = mag * s; } }
        const float den = lr * lr + li * li;
        const float cr = ((ar - 1.0f) * lr + ai * li) / den, ci = (ai * lr - (ar - 1.0f) * li) / den;
        f32x2* bb = WSP(f32x2, WS_BB) + (size_t)gt * 16;
        for (int q = 0; q < 16; ++q) { const float br = P.in[I_S5BRE][((l * 16 + g) * 64 + n) * 16 + q], bi = P.in[I_S5BIM][((l * 16 + g) * 64 + n) * 16 + q];
            bb[q] = (f32x2){cr * br - ci * bi, cr * bi + ci * br}; }
    }
    for (int i = cx.bid * NTHR + cx.tid; i < DEPTH * 6 * 256 * 64; i += cx.G * NTHR) {
        const int k = i & 63, n = (i >> 6) & 255, g = (i >> 14) % 6, l = (i >> 14) / 6;
        const int j = n & 63, type = (n >> 6) & 1, dir = n >> 7;
        const float* w = type ? P.in[I_RGWX] : P.in[I_RGWA];
        WSP(bf16_t, WS_WRG)[i] = f2bf(w[((((size_t)l * 2 + dir) * 6 + g) * 64 + k) * 64 + j]);
    }
    for (int i = cx.bid * NTHR + cx.tid; i < DEPTH * NP; i += cx.G * NTHR) {
        const int n = i % NP, l = i / NP; const int sc = n < 1536 ? n : n + 16;
        WSP(float, WS_BIN2)[i] = P.in[I_BIN][l * DIN + sc] * ((n >= 384 && n < 768) ? 0.10206207261596577f : 1.0f);
    }
    for (int i = cx.bid * NTHR + cx.tid; i < DEPTH * 16 * 1024; i += cx.G * NTHR) { const int k = i & 1023, n = (i >> 10) & 15, l = i >> 14;
        WSP(bf16_t, WS_WGT)[i] = f2bf(P.in[I_WIN][((size_t)l * 1024 + k) * DIN + 1536 + n]); }
    for (int i = cx.bid * NTHR + cx.tid; i < DEPTH * 32 * 1024; i += cx.G * NTHR) { const int k = i & 1023, n = (i >> 10) & 31, l = i >> 15;
        const float w = P.in[I_RW][((size_t)l * 1024 + k) * 32 + n]; const bf16_t hi = f2bf(w);
        WSP(bf16_t, WS_RWH)[i] = hi; WSP(bf16_t, WS_RWL)[i] = f2bf(w - bf2f(hi)); }
    for (int i = cx.bid * NTHR + cx.tid; i < DEPTH * 256 * 256; i += cx.G * NTHR) {
        const int k = i & 255, n = (i >> 8) & 255, l = i >> 16;
        WSP(bf16_t, WS_WGLU)[i] = f2bf(P.in[I_S5GW][((size_t)l * 256 + k) * 256 + n]);
    }
}

DEVI void ph_pro_b(const Ctx& cx) {
    const Params& P = *cx.p;
    for (int i = cx.bid * NTHR + cx.tid; i < DEPTH * 16 * 2 * 32 * 256; i += cx.G * NTHR) {
        const int q = i & 15, p = (i >> 4) & 15, tau = (i >> 8) & 31, d = (i >> 13) & 1, g = (i >> 14) & 15, l = i >> 18;
        const f32x2* pw = WSP(f32x2, WS_PW) + (size_t)(((l * 16 + g) * 2 + d) * 64) * 33 + tau;
        const f32x2* bb = WSP(f32x2, WS_BB) + (size_t)(((l * 16 + g) * 2 + d) * 64) * 16 + q;
        const float* cre = P.in[I_S5CRE] + ((size_t)(l * 16 + g) * 16 + p) * 64;
        const float* cim = P.in[I_S5CIM] + ((size_t)(l * 16 + g) * 16 + p) * 64;
        float s = 0.f;
        for (int n = 0; n < 64; ++n) { const f32x2 a = pw[n * 33], b = bb[n * 16]; const float cr = cre[n], ci = cim[n];
            const float xr = cr * a.x - ci * a.y, xi = cr * a.y + ci * a.x; s += xr * b.x - xi * b.y; }
        WSP(float, WS_KT)[i] = s;
    }
}

DEVI void ph_pro_c(const Ctx& cx) {
    const Params& P = *cx.p;
    for (size_t i = (size_t)cx.bid * NTHR + cx.tid; i < (size_t)DEPTH * 16 * 512 * 768; i += (size_t)cx.G * NTHR) {
        const int k = (int)(i % 768), tp = (int)((i / 768) % 512), lg = (int)(i / (768 * 512));
        const int t = tp >> 4, p = tp & 15, l = lg >> 4, g = lg & 15;
        float v;
        if (k < 512) { const int s = k >> 4, q = k & 15; v = 0.f;
            const float* kt = WSP(float, WS_KT) + (size_t)lg * 2 * 32 * 256;
            if (s <= t) v += kt[((0 * 32) + (t - s)) * 256 + p * 16 + q];
            if (s >= t) v += kt[((1 * 32) + (s - t)) * 256 + p * 16 + q];
            if (s == t && p == q) v += P.in[I_S5D][l * 256 + g * 16 + p];
        } else { const int kk = k - 512, d = kk >> 7, im = (kk >> 6) & 1, n = kk & 63;
            const int pwr = d == 0 ? t + 1 : 32 - t;
            const f32x2 a = WSP(f32x2, WS_PW)[(size_t)((lg * 2 + d) * 64 + n) * 33 + pwr];
            const float cr = P.in[I_S5CRE][((size_t)lg * 16 + p) * 64 + n], ci = P.in[I_S5CIM][((size_t)lg * 16 + p) * 64 + n];
            v = im ? -(cr * a.y + ci * a.x) : (cr * a.x - ci * a.y);
        }
        WSP(bf16_t, WS_WY)[i] = f2bf(v);
    }
    for (size_t i = (size_t)cx.bid * NTHR + cx.tid; i < (size_t)DEPTH * 16 * 256 * 512; i += (size_t)cx.G * NTHR) {
        const int k = (int)(i & 511), no = (int)((i >> 9) & 255), lg = (int)(i >> 17);
        const int s = k >> 4, q = k & 15, d = no >> 7, im = (no >> 6) & 1, n = no & 63;
        const int pwr = d == 0 ? 31 - s : s;
        const f32x2 a = WSP(f32x2, WS_PW)[(size_t)((lg * 2 + d) * 64 + n) * 33 + pwr];
        const f32x2 b = WSP(f32x2, WS_BB)[(size_t)((lg * 2 + d) * 64 + n) * 16 + q];
        const float v = im ? (a.x * b.y + a.y * b.x) : (a.x * b.x - a.y * b.y);
        WSP(bf16_t, WS_WE)[i] = f2bf(v);
    }
}

DEVI void moe_info(const Ctx& cx, int l, LAS int* info) {
    if (cx.tid < 64) {
        const unsigned* cnt = (const unsigned*)(cx.ws + WS_CTL) + CW_CNT + l * 32;
        const int c = cx.lane < 32 ? (int)__hip_atomic_load(cnt + (cx.lane & 31), __ATOMIC_RELAXED, __HIP_MEMORY_SCOPE_AGENT) : 0;
        const int nt = (c + 255) >> 8;
        if (cx.lane < 32) { info[72 + cx.lane] = nt; info[40 + cx.lane] = c; }
        if (cx.lane == 0) { int run = 0; info[0] = 0; for (int e = 0; e < 32; ++e) { run += info[72 + e]; info[e + 1] = run; } }
    }
    __syncthreads();
}

DEVI void block_rows_visible() {
    asm volatile("s_waitcnt vmcnt(0)" ::: "memory");
    __syncthreads();
    __builtin_amdgcn_fence(__ATOMIC_ACQUIRE, "agent");
    asm volatile("s_waitcnt vmcnt(0)" ::: "memory");
}
DEVI void ph_norm1(const Ctx& cx, int l) {
    const Params& P = *cx.p;
    LAS int* info = (LAS int*)cx.lds;
    if (l > 0) moe_info(cx, l - 1, info);
    const int rbeg = (l == DEPTH) ? TCTX : 0, nr = TT - rbeg;
    const int rpb = (nr + cx.G - 1) / cx.G, rb = rbeg + cx.bid * rpb, re = min(TT, rb + rpb);
    const float* modp = WSP(float, WS_MOD);
    const int c0 = 2 * cx.lane;
    for (int r2 = rb + cx.wave; r2 < re; r2 += 16) {
        f32x2 x[2][8]; bool ok[2];
#pragma unroll
        for (int u = 0; u < 2; ++u) { const int row = r2 + 8 * u; ok[u] = row < re; const int rw_ = ok[u] ? row : r2;
            if (l == 0) { const float* src = rw_ < TCTX ? P.in[I_CTX] + (size_t)rw_ * 1024 : P.in[I_X] + (size_t)(rw_ - TCTX) * 1024;
#pragma unroll
                for (int i = 0; i < 8; ++i) x[u][i] = *(const f32x2*)(src + c0 + 128 * i);
            } else {
                const float* src = WSP(float, WS_XMID) + (size_t)rw_ * 1024;
                const float* g2 = modp + ((size_t)(l - 1) * 9 + mod_row(rw_)) * 6144 + 5120;
                const int* ti = WSP(int, WS_TINFO) + (size_t)rw_ * 4;
                f32x2 y[8];
#pragma unroll
                for (int i = 0; i < 8; ++i) y[i] = (f32x2){0.f, 0.f};
#pragma unroll
                for (int k = 0; k < 4; ++k) { const int t = ti[k]; const int e = t >> 20, slot = t & 0xFFFFF;
                    const bf16_t* yp = WSP(bf16_t, WS_YPAD) + ((size_t)info[e] * 256 + slot) * 1024;
#pragma unroll
                    for (int i = 0; i < 8; ++i) { const unsigned w = *(const unsigned*)(yp + c0 + 128 * i); y[i].x += __uint_as_float(w << 16); y[i].y += __uint_as_float(w & 0xFFFF0000u); } }
#pragma unroll
                for (int i = 0; i < 8; ++i) { const f32x2 xv = *(const f32x2*)(src + c0 + 128 * i), gv = *(const f32x2*)(g2 + c0 + 128 * i); x[u][i] = xv + gv * y[i]; }
            }
        }
#pragma unroll
        for (int u = 0; u < 2; ++u) {
            const int row = r2 + 8 * u;
            float ss = 0.f;
#pragma unroll
            for (int i = 0; i < 8; ++i) ss += x[u][i].x * x[u][i].x + x[u][i].y * x[u][i].y;
            ss = wave_sum(ss, 0);
            const float rstd = rsqrtf(ss * (1.0f / 1024.0f) + EPS);
            if (!ok[u]) continue;
            if (l == DEPTH) { float* o = P.out + (size_t)(row - TCTX) * 1024;
#pragma unroll
                for (int i = 0; i < 8; ++i) { const f32x2 fw = *(const f32x2*)(P.in[I_FNW] + c0 + 128 * i); *(f32x2*)(o + c0 + 128 * i) = x[u][i] * rstd * fw; }
                continue; }
            float* xs = WSP(float, WS_XS) + (size_t)row * 1024;
            const float* md = modp + ((size_t)l * 9 + mod_row(row)) * 6144;
            bf16_t* hp = WSP(bf16_t, WS_H) + (size_t)row * 1024;
#pragma unroll
            for (int i = 0; i < 8; ++i) { const int c = c0 + 128 * i;
                *(f32x2*)(xs + c) = x[u][i];
                const f32x2 nw = *(const f32x2*)(P.in[I_N1W] + l * 1024 + c), sc = *(const f32x2*)(md + 1024 + c), sh = *(const f32x2*)(md + c);
                const f32x2 h = x[u][i] * rstd * nw * (sc + 1.0f) + sh;
                *(unsigned*)(hp + c) = pk_bf16(h.x, h.y); }
        }
    }
    if (l == DEPTH) return;
    block_rows_visible();
    const int ntile = (re - rb + 15) / 16;
    for (int t = cx.wave; t < ntile; t += 8) {
        const int fr = cx.lane & 15, fq = cx.lane >> 4; const int row = min(rb + t * 16 + fr, re - 1);
        const bf16_t* hp = WSP(bf16_t, WS_H) + (size_t)row * 1024 + fq * 8;
        const bf16_t* wp = WSP(bf16_t, WS_WGT) + ((size_t)l * 16 + fr) * 1024 + fq * 8;
        f32x4 acc = (f32x4){0.f, 0.f, 0.f, 0.f};
#pragma unroll 8
        for (int k0 = 0; k0 < 1024; k0 += 32) acc = __builtin_amdgcn_mfma_f32_16x16x32_bf16(ldg8(wp + k0), ldg8(hp + k0), acc, 0, 0, 0);
        if (rb + t * 16 + fr < re) { const f32x4 bi = *(const f32x4*)(P.in[I_BIN] + l * DIN + 1536 + 4 * fq); *(f32x4*)(WSP(float, WS_GT) + (size_t)row * 16 + 4 * fq) = acc + bi; }
    }
}

DEVI void ph_norm2(const Ctx& cx, int l) {
    const Params& P = *cx.p;
    LAS float* lgs = (LAS float*)cx.lds;
    LAS int* hist = (LAS int*)(cx.lds + 128 * 33 * 4);
    LAS int* pend = hist + 64;
    if (cx.tid < 64) hist[cx.tid] = 0;
    const int r0 = (l == DEPTH - 1) ? TCTX : 0, nr = TT - r0;
    const int rpb = (nr + cx.G - 1) / cx.G;
    const int rb = r0 + cx.bid * rpb, re = min(TT, rb + rpb);
    const float* modp = WSP(float, WS_MOD);
    const int c0 = 2 * cx.lane;
    for (int r2 = rb + cx.wave; r2 < re; r2 += 16) {
        f32x2 x[2][8]; bool ok[2];
#pragma unroll
        for (int u = 0; u < 2; ++u) { const int row = r2 + 8 * u; ok[u] = row < re; const float* src = WSP(float, WS_XMID) + (size_t)(ok[u] ? row : r2) * 1024;
#pragma unroll
            for (int i = 0; i < 8; ++i) x[u][i] = *(const f32x2*)(src + c0 + 128 * i); }
#pragma unroll
        for (int u = 0; u < 2; ++u) {
            const int row = r2 + 8 * u;
            float ss = 0.f;
#pragma unroll
            for (int i = 0; i < 8; ++i) ss += x[u][i].x * x[u][i].x + x[u][i].y * x[u][i].y;
            ss = wave_sum(ss, 0);
            const float rstd = rsqrtf(ss * (1.0f / 1024.0f) + EPS);
            if (!ok[u]) continue;
            const float* md = modp + ((size_t)l * 9 + mod_row(row)) * 6144;
            bf16_t* hp = WSP(bf16_t, WS_H) + (size_t)row * 1024; bf16_t* hl = WSP(bf16_t, WS_HLO) + (size_t)row * 1024;
#pragma unroll
            for (int i = 0; i < 8; ++i) { const int c = c0 + 128 * i;
                const f32x2 nw = *(const f32x2*)(P.in[I_N2W] + l * 1024 + c), sc = *(const f32x2*)(md + 4096 + c), sh = *(const f32x2*)(md + 3072 + c);
                const f32x2 h = x[u][i] * rstd * nw * (sc + 1.0f) + sh;
                const bf16_t h0 = f2bf(h.x), h1 = f2bf(h.y);
                *(unsigned*)(hp + c) = (unsigned)h0 | ((unsigned)h1 << 16);
                *(unsigned*)(hl + c) = pk_bf16(h.x - bf2f(h0), h.y - bf2f(h1)); }
        }
    }
    block_rows_visible();
    const int nrow = re - rb, ntile = (nrow + 15) / 16;
    for (int t2 = cx.wave; t2 < ntile * 2; t2 += 8) {
        const int t = t2 >> 1, nt = t2 & 1, fr = cx.lane & 15, fq = cx.lane >> 4; const int row = min(rb + t * 16 + fr, re - 1);
        const bf16_t* hp = WSP(bf16_t, WS_H) + (size_t)row * 1024 + fq * 8; const bf16_t* hl = WSP(bf16_t, WS_HLO) + (size_t)row * 1024 + fq * 8;
        const bf16_t* wh = WSP(bf16_t, WS_RWH) + ((size_t)l * 32 + nt * 16 + fr) * 1024 + fq * 8; const bf16_t* wl = WSP(bf16_t, WS_RWL) + ((size_t)l * 32 + nt * 16 + fr) * 1024 + fq * 8;
        f32x4 acc = (f32x4){0.f, 0.f, 0.f, 0.f}, acc2 = (f32x4){0.f, 0.f, 0.f, 0.f};
#pragma unroll 8
        for (int k0 = 0; k0 < 1024; k0 += 32) { const bf16x8 ah = ldg8(hp + k0), al = ldg8(hl + k0), bh = ldg8(wh + k0), bl = ldg8(wl + k0);
            acc = __builtin_amdgcn_mfma_f32_16x16x32_bf16(bh, ah, acc, 0, 0, 0);
            acc2 = __builtin_amdgcn_mfma_f32_16x16x32_bf16(bl, ah, acc2, 0, 0, 0);
            acc2 = __builtin_amdgcn_mfma_f32_16x16x32_bf16(bh, al, acc2, 0, 0, 0); }
        const int rl = t * 16 + fr;
        if (rl < nrow) {
#pragma unroll
            for (int j = 0; j < 4; ++j) { const int e = nt * 16 + 4 * fq + j; lgs[rl * 33 + e] = acc[j] + acc2[j] + P.in[I_RB][l * 32 + e]; } }
    }
    __syncthreads();
    if (cx.tid < nrow) {
        const LAS float* lp = lgs + cx.tid * 33;
        float tv[4]; int tix[4]; unsigned taken = 0u;
#pragma unroll
        for (int k = 0; k < 4; ++k) { float bv = -3.0e38f; int bi = 0;
            for (int e = 0; e < 32; ++e) { const float v = lp[e]; const bool better = (v > bv) && !((taken >> e) & 1u); bv = better ? v : bv; bi = better ? e : bi; }
            tv[k] = bv; tix[k] = bi; taken |= 1u << bi; }
        const float e1 = __expf(tv[1] - tv[0]), e2 = __expf(tv[2] - tv[0]), e3 = __expf(tv[3] - tv[0]);
        const float inv = 1.0f / (1.0f + e1 + e2 + e3);
        const float gk[4] = {inv, e1 * inv, e2 * inv, e3 * inv};
#pragma unroll
        for (int k = 0; k < 4; ++k) {
            const int ls = __hip_atomic_fetch_add((LAS int*)(hist + tix[k]), 1, __ATOMIC_RELAXED, __HIP_MEMORY_SCOPE_WORKGROUP);
            pend[(cx.tid * 4 + k) * 2 + 0] = (tix[k] << 20) | ls;
            pend[(cx.tid * 4 + k) * 2 + 1] = __float_as_int(gk[k]); }
    }
    __syncthreads();
    if (cx.tid < 32) { unsigned* cnt = (unsigned*)(cx.ws + WS_CTL) + CW_CNT + l * 32;
        hist[32 + cx.tid] = hist[cx.tid] > 0 ? (int)__hip_atomic_fetch_add(cnt + cx.tid, (unsigned)hist[cx.tid], __ATOMIC_RELAXED, __HIP_MEMORY_SCOPE_AGENT) : 0; }
    __syncthreads();
    for (int i = cx.tid; i < nrow * 4; i += NTHR) {
        const int t = pend[i * 2], e = t >> 20, slot = hist[32 + e] + (t & 0xFFFFF), row = rb + (i >> 2);
        WSP(int, WS_ELIST)[(size_t)e * TT + slot] = row;
        WSP(float, WS_GLIST)[(size_t)e * TT + slot] = __int_as_float(pend[i * 2 + 1]);
        WSP(int, WS_TINFO)[(size_t)row * 4 + (i & 3)] = (e << 20) | slot;
    }
}

DEVI int xcd_contig(int bid, int G) { return (G % 8 == 0) ? (bid % 8) * (G / 8) + bid / 8 : bid; }

struct DenseSched {
    const char* A; const char* B; int nM, nN, pm0, G, c;
    DEVI bool get(int i, g1::Unit& u) const {
        const int L = i * G + c; if (L >= nM * nN) return false;
        const int pm = L / nN, pn = L % nN;
        u.A = A + (size_t)(pm0 + pm) * 256 * 2048; u.list = nullptr; u.nvalid = 256; u.B = B + (size_t)pn * 256 * 2048; u.pm = pm0 + pm; u.pn = pn; u.e = 0;
        return true;
    }
};
struct MoeSched {
    const char* A; const char* B; const int* elist; const LAS int* info; int NPN, gather, G, c; size_t bstride;
    DEVI bool get(int i, g1::Unit& u) const {
        const int L = i * G + c; const int total = info[32] * NPN; if (L >= total) return false;
        int e = 0;
#pragma unroll 1
        for (int k = 1; k < 32; ++k) if (L >= info[k] * NPN) e = k;
        const int nt = info[e + 1] - info[e], ue = L - info[e] * NPN, pn = ue / nt, j = ue % nt;
        u.pm = info[e] + j; u.pn = pn; u.e = e;
        u.B = B + (size_t)e * bstride + (size_t)pn * 256 * 2048;
        if (gather) { u.A = A; u.list = elist + (size_t)e * TT + j * 256; u.nvalid = info[40 + e] - j * 256; }
        else { u.A = A + (size_t)u.pm * 256 * 2048; u.list = nullptr; u.nvalid = 256; }
        return true;
    }
};

struct EpiIn {
    static constexpr bool PERM = true;
    bf16_t* Pout; const float* bias;
    DEVI void operator()(const f32x4 (&acc)[2][2][4][2], const g1::Unit& u, int wr, int wc, int fr, int fq) const {
        const int row0 = u.pm * 256 + wr * 64 + fr;
#pragma unroll
        for (int bj = 0; bj < 2; ++bj) {
            const int col0 = u.pn * 256 + bj * 128 + wc * 32 + 8 * fq;
            const int seg = u.pn * 2 + bj; const bool gl = (seg >= 15 && seg < 18);
            const f32x4 b0 = *(const f32x4*)(bias + col0), b1 = *(const f32x4*)(bias + col0 + 4);
#pragma unroll
            for (int ai = 0; ai < 2; ++ai)
#pragma unroll
                for (int m = 0; m < 4; ++m) {
                    f32x4 v0 = acc[ai][bj][m][0] + b0, v1 = acc[ai][bj][m][1] + b1;
                    if (gl) {
#pragma unroll
                        for (int j = 0; j < 4; ++j) { v0[j] = gelu_tanh(v0[j]); v1[j] = gelu_tanh(v1[j]); } }
                    u32x4 w; w.x = pk_bf16(v0[0], v0[1]); w.y = pk_bf16(v0[2], v0[3]); w.z = pk_bf16(v1[0], v1[1]); w.w = pk_bf16(v1[2], v1[3]);
                    *(u32x4*)(Pout + (size_t)(row0 + ai * 128 + m * 16) * NP + col0) = w;
                }
        }
    }
};
struct EpiOut {
    static constexpr bool PERM = false;
    const float* xs; float* xmid; const float* mod;
    DEVI void operator()(const f32x4 (&acc)[2][2][4][2], const g1::Unit& u, int wr, int wc, int fr, int fq) const {
        const int row0 = u.pm * 256 + wr * 64 + fr;
        const float* g1p = mod + (size_t)mod_row(u.pm * 256) * 6144 + 2048;
#pragma unroll
        for (int bj = 0; bj < 2; ++bj)
#pragma unroll
            for (int n = 0; n < 2; ++n) {
                const int col = u.pn * 256 + bj * 128 + wc * 32 + 16 * n + 4 * fq;
                const f32x4 gv = *(const f32x4*)(g1p + col);
#pragma unroll
                for (int ai = 0; ai < 2; ++ai)
#pragma unroll
                    for (int m = 0; m < 4; ++m) {
                        const size_t off = (size_t)(row0 + ai * 128 + m * 16) * 1024 + col;
                        const f32x4 xv = *(const f32x4*)(xs + off);
                        *(f32x4*)(xmid + off) = xv + gv * acc[ai][bj][m][n];
                    }
            }
    }
};
struct EpiGU {
    static constexpr bool PERM = true;
    bf16_t* act; const float* bgu;
    DEVI void operator()(const f32x4 (&acc)[2][2][4][2], const g1::Unit& u, int wr, int wc, int fr, int fq) const {
        const int row0 = u.pm * 256 + wr * 64 + fr, colh = u.pn * 128 + wc * 32 + 8 * fq;
        const float* bg = bgu + (size_t)u.e * 2048 + colh; const float* bu = bg + 1024;
        const f32x4 bg0 = *(const f32x4*)bg, bg1 = *(const f32x4*)(bg + 4), bu0 = *(const f32x4*)bu, bu1 = *(const f32x4*)(bu + 4);
#pragma unroll
        for (int ai = 0; ai < 2; ++ai)
#pragma unroll
            for (int m = 0; m < 4; ++m) {
                float o[8];
#pragma unroll
                for (int n = 0; n < 2; ++n)
#pragma unroll
                    for (int j = 0; j < 4; ++j) {
                        const float g = fminf(acc[ai][0][m][n][j] + (n ? bg1[j] : bg0[j]), 7.0f);
                        const float up = fminf(fmaxf(acc[ai][1][m][n][j] + (n ? bu1[j] : bu0[j]), -7.0f), 7.0f);
                        o[n * 4 + j] = (up + 1.0f) * g * frcp(1.0f + __expf(-1.702f * g));
                    }
                u32x4 w; w.x = pk_bf16(o[0], o[1]); w.y = pk_bf16(o[2], o[3]); w.z = pk_bf16(o[4], o[5]); w.w = pk_bf16(o[6], o[7]);
                *(u32x4*)(act + (size_t)(row0 + ai * 128 + m * 16) * 1024 + colh) = w;
            }
    }
};
struct EpiDown {
    static constexpr bool PERM = true;
    bf16_t* ypad; const float* bd; const float* glist; const LAS int* info;
    DEVI void operator()(const f32x4 (&acc)[2][2][4][2], const g1::Unit& u, int wr, int wc, int fr, int fq) const {
        const int j256 = (u.pm - info[u.e]) * 256, cnt = info[40 + u.e];
        const int rl0 = wr * 64 + fr;
#pragma unroll
        for (int ai = 0; ai < 2; ++ai)
#pragma unroll
            for (int m = 0; m < 4; ++m) {
                const int rl = rl0 + ai * 128 + m * 16, slot = j256 + rl;
                const float gt = slot < cnt ? glist[(size_t)u.e * TT + slot] : 0.f;
#pragma unroll
                for (int bj = 0; bj < 2; ++bj) {
                    const int col0 = u.pn * 256 + bj * 128 + wc * 32 + 8 * fq;
                    const f32x4 b0 = *(const f32x4*)(bd + (size_t)u.e * 1024 + col0), b1 = *(const f32x4*)(bd + (size_t)u.e * 1024 + col0 + 4);
                    const f32x4 v0 = (acc[ai][bj][m][0] + b0) * gt, v1 = (acc[ai][bj][m][1] + b1) * gt;
                    u32x4 w; w.x = pk_bf16(v0[0], v0[1]); w.y = pk_bf16(v0[2], v0[3]); w.z = pk_bf16(v1[0], v1[1]); w.w = pk_bf16(v1[2], v1[3]);
                    *(u32x4*)(ypad + (size_t)(u.pm * 256 + rl) * 1024 + col0) = w;
                }
            }
    }
};

DEVI void ph_inproj(const Ctx& cx, int l) {
    DenseSched S{(const char*)WSP(bf16_t, WS_H), (const char*)(WSP(bf16_t, WS_WIN) + (size_t)l * NP * 1024), TT / 256, NP / 256, 0, cx.G, xcd_contig(cx.bid, cx.G)};
    EpiIn E{WSP(bf16_t, WS_P), WSP(float, WS_BIN2) + (size_t)l * NP};
    g1::gemm_phase<DenseSched, EpiIn, false>(cx.lds, cx.tid, S, E);
}
DEVI void ph_outproj(const Ctx& cx, int l) {
    const int pm0 = (l == DEPTH - 1) ? TCTX / 256 : 0;
    DenseSched S{(const char*)WSP(bf16_t, WS_MRG), (const char*)(WSP(bf16_t, WS_WOUT) + (size_t)l * 1024 * 1024), TT / 256 - pm0, 4, pm0, cx.G, xcd_contig(cx.bid, cx.G)};
    EpiOut E{WSP(float, WS_XS), WSP(float, WS_XMID), WSP(float, WS_MOD) + (size_t)l * 9 * 6144};
    g1::gemm_phase<DenseSched, EpiOut, false>(cx.lds, cx.tid, S, E);
}
DEVI void ph_moe_gu(const Ctx& cx, int l) {
    LAS int* info = (LAS int*)(cx.lds + g1::STAGE_BYTES);
    moe_info(cx, l, info);
    MoeSched S{(const char*)WSP(bf16_t, WS_H), (const char*)(WSP(bf16_t, WS_WGU) + (size_t)l * NE * 2048 * 1024), WSP(int, WS_ELIST), info, 8, 1, cx.G, xcd_contig(cx.bid, cx.G), (size_t)2048 * 1024 * 2};
    EpiGU E{WSP(bf16_t, WS_ACT), cx.p->in[I_BGU] + (size_t)l * NE * 2048};
    g1::gemm_phase<MoeSched, EpiGU, true>(cx.lds, cx.tid, S, E);
}
DEVI void ph_moe_dn(const Ctx& cx, int l) {
    LAS int* info = (LAS int*)(cx.lds + g1::STAGE_BYTES);
    moe_info(cx, l, info);
    MoeSched S{(const char*)WSP(bf16_t, WS_ACT), (const char*)(WSP(bf16_t, WS_WD) + (size_t)l * NE * 1024 * 1024), nullptr, info, 4, 0, cx.G, xcd_contig(cx.bid, cx.G), (size_t)1024 * 1024 * 2};
    EpiDown E{WSP(bf16_t, WS_YPAD), cx.p->in[I_BD] + (size_t)l * NE * 1024, WSP(float, WS_GLIST), info};
    g1::gemm_phase<MoeSched, EpiDown, false>(cx.lds, cx.tid, S, E);
}

DEVI int ml_row0(int b, int c) { return c < 2 ? b * CTXL + c * 128 : TCTX + b * SEQ + (c - 2) * 128; }
DEVI unsigned short lds_u16(const LAS bf16_t* p) { return *p; }

DEVI void ml_local_unit(const Ctx& cx, int l, int b, int h, int c) {
    LAS float* sg = (LAS float*)cx.lds;
    LAS float* se = sg + 256;
    LAS float* red = se + 256;
    LAS bf16_t* Ks = (LAS bf16_t*)(cx.lds + 4352);
    LAS bf16_t* Ve = Ks + 128 * 104;
    const int row0 = ml_row0(b, c), tid = cx.tid;
    const int dir = (tid >> 7) & 1, i = tid & 127, p = dir ? 127 - i : i;
    const bool act = tid < 256;
    float gi = 0.f, bval = 0.f, u = 0.f;
    if (act) { const float* gt = WSP(float, WS_GT) + (size_t)(row0 + i) * 16; gi = gt[dir * 4 + h]; const float gf = gt[8 + dir * 4 + h];
        sg[dir * 128 + p] = fminf(gf, 0.f) - log1p_(__expf(-fabsf(gf))); }
    __syncthreads();
#pragma unroll 1
    for (int off = 1; off < 128; off <<= 1) { float v = 0.f; if (act) { v = sg[dir * 128 + p]; if (p >= off) v += sg[dir * 128 + p - off]; } __syncthreads(); if (act) sg[dir * 128 + p] = v; __syncthreads(); }
    if (act) { bval = sg[dir * 128 + p]; u = gi - bval; if (p == 127) red[dir] = bval; }
    __syncthreads();
    if (act) sg[dir * 128 + p] = u;
    __syncthreads();
#pragma unroll 1
    for (int off = 1; off < 128; off <<= 1) { float v = 0.f; if (act) { v = sg[dir * 128 + p]; if (p >= off) v = fmaxf(v, sg[dir * 128 + p - off]); } __syncthreads(); if (act) sg[dir * 128 + p] = v; __syncthreads(); }
    if (act) { const float cm = sg[dir * 128 + p]; if (p == 127) red[2 + dir] = cm;
        const size_t gix = (size_t)(row0 + i) * 8 + dir * 4 + h;
        WSP(float, WS_GB)[gix] = bval; WSP(float, WS_GU)[gix] = u; WSP(float, WS_GCM)[gix] = cm; }
    __syncthreads();
    if (act) se[dir * 128 + i] = expf(u - red[2 + dir]);
    if (tid < 2) { float* msc = WSP(float, WS_MSC) + ((size_t)((b * 4 + h) * MLC + c) * 2 + tid) * 2; msc[0] = red[tid]; msc[1] = red[tid] + red[2 + tid]; }
    __syncthreads();
    const bf16_t* Pp = WSP(bf16_t, WS_P);
#pragma unroll
    for (int it = 0; it < 3; ++it) { const int idx = tid + NTHR * it, r = idx / 12, ch = idx % 12;
        const u32x4 kv = *(const u32x4*)(Pp + (size_t)(row0 + r) * NP + PC_K + h * 96 + ch * 8);
        *(LAS u32x4*)(Ks + r * 104 + ch * 8) = kv;
        const u32x4 vv = *(const u32x4*)(Pp + (size_t)(row0 + r) * NP + PC_V + h * 96 + ch * 8);
        const float e0 = se[r], e1 = se[128 + r];
        u32x4 o0, o1;
#pragma unroll
        for (int q = 0; q < 4; ++q) { const float lo = __uint_as_float(vv[q] << 16), hi = __uint_as_float(vv[q] & 0xFFFF0000u);
            o0[q] = pk_bf16(lo * e0, hi * e0); o1[q] = pk_bf16(lo * e1, hi * e1); }
        *(LAS u32x4*)(Ve + r * 104 + ch * 8) = o0; *(LAS u32x4*)(Ve + (128 + r) * 104 + ch * 8) = o1; }
    __syncthreads();
    {
        const int wd = cx.wave >> 2, q9 = (cx.wave & 3) * 9, fr = cx.lane & 15, fq = cx.lane >> 4;
        float* cl = WSP(float, WS_CLOC) + ((size_t)((b * 4 + h) * MLC + c) * 2 + wd) * 9216;
        const LAS bf16_t* V = Ve + wd * 128 * 104;
#pragma unroll 1
        for (int pi = q9; pi < q9 + 9; ++pi) { const int dt = pi / 6, et = pi % 6;
            f32x4 acc = (f32x4){0.f, 0.f, 0.f, 0.f};
#pragma unroll
            for (int kk = 0; kk < 4; ++kk) { bf16x8 a, bb;
#pragma unroll
                for (int j = 0; j < 8; ++j) { const int s = kk * 32 + fq * 8 + j; a[j] = (short)lds_u16(V + s * 104 + dt * 16 + fr); bb[j] = (short)lds_u16(Ks + s * 104 + et * 16 + fr); }
                acc = __builtin_amdgcn_mfma_f32_16x16x32_bf16(a, bb, acc, 0, 0, 0); }
#pragma unroll
            for (int r = 0; r < 4; ++r) cl[(dt * 16 + fq * 4 + r) * 96 + et * 16 + fr] = acc[r]; }
    }
    if (tid < 192) { const int d2 = tid / 96, e = tid % 96; float s = 0.f;
        for (int t = 0; t < 128; ++t) s += se[d2 * 128 + t] * bf2f(Ks[t * 104 + e]);
        WSP(float, WS_NLOC)[((size_t)((b * 4 + h) * MLC + c) * 2 + d2) * 96 + e] = s; }
    __syncthreads();
}

DEVI void ml_carry(const Ctx& cx) {
    for (int idx = cx.bid * NTHR + cx.tid; idx < 64 * 9312; idx += cx.G * NTHR) {
        const int combo = idx / 9312, el = idx % 9312, dir = combo & 1, bh = combo >> 1;
        float loc[MLC], bl[MLC], ml[MLC];
#pragma unroll
        for (int s = 0; s < MLC; ++s) {
            const int c = dir == 0 ? s : (s < 2 ? 1 - s : 19 - s);
            const size_t cb = (size_t)(bh * MLC + c) * 2 + dir;
            bl[s] = WSP(float, WS_MSC)[cb * 2]; ml[s] = WSP(float, WS_MSC)[cb * 2 + 1];
            loc[s] = el < 9216 ? WSP(float, WS_CLOC)[cb * 9216 + el] : WSP(float, WS_NLOC)[cb * 96 + el - 9216];
        }
        float Cv = 0.f, m = -1e30f;
#pragma unroll
        for (int s = 0; s < MLC; ++s) {
            const int c = dir == 0 ? s : (s < 2 ? 1 - s : 19 - s);
            const size_t cb = (size_t)(bh * MLC + c) * 2 + dir;
            if (el < 9216) WSP(bf16_t, WS_C0)[cb * 9216 + el] = f2bf(Cv); else WSP(float, WS_N0)[cb * 96 + el - 9216] = Cv;
            if (el == 0) WSP(float, WS_M0)[cb] = m;
            const float mn = fmaxf(bl[s] + m, ml[s]), a = __expf(bl[s] + m - mn), sc = __expf(ml[s] - mn);
            Cv = a * Cv + sc * loc[s]; m = mn;
        }
    }
}

DEVI void ml_out_unit(const Ctx& cx, int l, int b, int h, int c) {
    LAS bf16_t* Qs = (LAS bf16_t*)cx.lds;
    LAS bf16_t* Ks = Qs + 128 * 104;
    LAS bf16_t* Vs = Ks + 128 * 104;
    LAS bf16_t* C0s = Vs + 128 * 104;
    LAS float* gb = (LAS float*)(cx.lds + 119808);
    LAS float* gu = gb + 256;
    LAS float* gM = gu + 256;
    LAS float* n0s = gM + 256;
    LAS float* m0s = n0s + 192;
    const int row0 = ml_row0(b, c), tid = cx.tid;
    const bf16_t* Pp = WSP(bf16_t, WS_P);
    const size_t cb0 = (size_t)((b * 4 + h) * MLC + c) * 2;
#pragma unroll
    for (int it = 0; it < 3; ++it) { const int idx = tid + NTHR * it, r = idx / 12, ch = idx % 12;
        const bf16_t* rp = Pp + (size_t)(row0 + r) * NP + h * 96 + ch * 8;
        *(LAS u32x4*)(Qs + r * 104 + ch * 8) = *(const u32x4*)(rp + PC_Q);
        *(LAS u32x4*)(Ks + r * 104 + ch * 8) = *(const u32x4*)(rp + PC_K);
        *(LAS u32x4*)(Vs + r * 104 + ch * 8) = *(const u32x4*)(rp + PC_V); }
    for (int idx = tid; idx < 2 * 96 * 12; idx += NTHR) { const int d2 = idx / 1152, r = (idx % 1152) / 12, ch = idx % 12;
        *(LAS u32x4*)(C0s + (d2 * 96 + r) * 104 + ch * 8) = *(const u32x4*)(WSP(bf16_t, WS_C0) + (cb0 + d2) * 9216 + r * 96 + ch * 8); }
    if (tid < 256) { const int d2 = tid >> 7, i = tid & 127; const size_t gix = (size_t)(row0 + i) * 8 + d2 * 4 + h;
        gb[tid] = WSP(float, WS_GB)[gix]; gu[tid] = WSP(float, WS_GU)[gix];
        gM[tid] = fmaxf(WSP(float, WS_M0)[cb0 + d2], WSP(float, WS_GCM)[gix]); }
    if (tid >= 256 && tid < 448) { const int k = tid - 256; n0s[k] = WSP(float, WS_N0)[(cb0 + k / 96) * 96 + k % 96]; }
    if (tid >= 448 && tid < 450) m0s[tid - 448] = WSP(float, WS_M0)[cb0 + tid - 448];
    __syncthreads();
    const int w = cx.wave, fr = cx.lane & 15, fq = cx.lane >> 4, t = 16 * w + fr;
    bf16x8 qf[3];
#pragma unroll
    for (int kk = 0; kk < 3; ++kk) qf[kk] = *(const LAS bf16x8*)(Qs + t * 104 + kk * 32 + fq * 8);
    f32x4 hs[6];
#pragma unroll
    for (int n = 0; n < 6; ++n) hs[n] = (f32x4){0.f, 0.f, 0.f, 0.f};
#pragma unroll
    for (int dir = 0; dir < 2; ++dir) {
        const float Mt = gM[dir * 128 + t], bt = gb[dir * 128 + t], inter = __expf(m0s[dir] - Mt);
        f32x4 an[6];
#pragma unroll
        for (int n = 0; n < 6; ++n) an[n] = (f32x4){0.f, 0.f, 0.f, 0.f};
        float den = 0.f;
        const int Jlo = dir == 0 ? 0 : (w >> 1), Jhi = dir == 0 ? (w >> 1) : 3;
#pragma unroll 1
        for (int J = Jlo; J <= Jhi; ++J) {
            bf16x8 pf;
#pragma unroll
            for (int half = 0; half < 2; ++half) {
                const int j = 2 * J + half;
                f32x4 D = (f32x4){0.f, 0.f, 0.f, 0.f};
                const bool need = dir == 0 ? (j <= w) : (j >= w);
                if (need) {
#pragma unroll
                    for (int kk = 0; kk < 3; ++kk) { const bf16x8 kf = *(const LAS bf16x8*)(Ks + (16 * j + fr) * 104 + kk * 32 + fq * 8);
                        D = __builtin_amdgcn_mfma_f32_16x16x32_bf16(kf, qf[kk], D, 0, 0, 0); }
                }
                const f32x4 us = *(const LAS f32x4*)(gu + dir * 128 + 16 * j + 4 * fq);
                float pv[4];
#pragma unroll
                for (int r = 0; r < 4; ++r) { const int s = 16 * j + 4 * fq + r; const bool valid = need && (dir == 0 ? (s <= t) : (s >= t));
                    pv[r] = valid ? D[r] * __expf(us[r] - Mt) : 0.f; den += pv[r]; }
                pf[half * 4 + 0] = (short)f2bf(pv[0]); pf[half * 4 + 1] = (short)f2bf(pv[1]); pf[half * 4 + 2] = (short)f2bf(pv[2]); pf[half * 4 + 3] = (short)f2bf(pv[3]);
            }
#pragma unroll
            for (int n = 0; n < 6; ++n) { bf16x8 vf;
#pragma unroll
                for (int jj = 0; jj < 8; ++jj) { const int s = 32 * J + (jj < 4 ? 4 * fq + jj : 16 + 4 * fq + (jj - 4)); vf[jj] = (short)lds_u16(Vs + s * 104 + 16 * n + fr); }
                an[n] = __builtin_amdgcn_mfma_f32_16x16x32_bf16(vf, pf, an[n], 0, 0, 0); }
        }
        float nq = 0.f;
#pragma unroll
        for (int kk = 0; kk < 3; ++kk)
#pragma unroll
            for (int j = 0; j < 8; ++j) nq += n0s[dir * 96 + kk * 32 + fq * 8 + j] * bf2f((bf16_t)qf[kk][j]);
        nq += shx<16>(nq, cx.lane); nq += shx<32>(nq, cx.lane);
        den += shx<16>(den, cx.lane); den += shx<32>(den, cx.lane);
        const float dtot = den + inter * nq;
        const float inv = frcp(fmaxf(fabsf(dtot), __expf(-(Mt + bt))));
#pragma unroll
        for (int n = 0; n < 6; ++n) { f32x4 ac = (f32x4){0.f, 0.f, 0.f, 0.f};
#pragma unroll
            for (int kk = 0; kk < 3; ++kk) { const bf16x8 cf = *(const LAS bf16x8*)(C0s + (dir * 96 + 16 * n + fr) * 104 + kk * 32 + fq * 8);
                ac = __builtin_amdgcn_mfma_f32_16x16x32_bf16(cf, qf[kk], ac, 0, 0, 0); }
            hs[n] += (an[n] + ac * inter) * inv; }
    }
    float ss = 0.f;
#pragma unroll
    for (int n = 0; n < 6; ++n) ss += hs[n][0] * hs[n][0] + hs[n][1] * hs[n][1] + hs[n][2] * hs[n][2] + hs[n][3] * hs[n][3];
    ss += shx<16>(ss, cx.lane); ss += shx<32>(ss, cx.lane);
    const float rstd = rsqrtf(ss * (1.0f / 96.0f) + EPS);
    const size_t prow = (size_t)(row0 + t);
#pragma unroll
    for (int n = 0; n < 6; ++n) { const int d = 16 * n + 4 * fq;
        const u32x2 ov = *(const u32x2*)(Pp + prow * NP + PC_O + h * 96 + d);
        const f32x4 mw = *(const f32x4*)(cx.p->in[I_MIXW] + l * 1024 + h * 96 + d);
        const float o0 = __uint_as_float(ov.x << 16), o1 = __uint_as_float(ov.x & 0xFFFF0000u), o2 = __uint_as_float(ov.y << 16), o3 = __uint_as_float(ov.y & 0xFFFF0000u);
        u32x2 wv; wv.x = pk_bf16(sigmoidf_(o0) * hs[n][0] * rstd * mw[0], sigmoidf_(o1) * hs[n][1] * rstd * mw[1]);
        wv.y = pk_bf16(sigmoidf_(o2) * hs[n][2] * rstd * mw[2], sigmoidf_(o3) * hs[n][3] * rstd * mw[3]);
        *(u32x2*)(WSP(bf16_t, WS_MRG) + prow * 1024 + h * 96 + d) = wv; }
    __syncthreads();
}

DEVI void rg_unit(const Ctx& cx, int l, int b, int ck, int g, int mode) {
    const Params& P = *cx.p;
    LAS float* xraw = (LAS float*)cx.lds;
    LAS float* xc = (LAS float*)(cx.lds + 17408);
    LAS bf16_t* xcb = (LAS bf16_t*)(cx.lds + 33792);
    LAS float* ab = (LAS float*)(cx.lds + 43008);
    const int tid = cx.tid;
    const int t0 = ck < 4 ? ck * 64 : (ck - 4) * 64, seglen = ck < 4 ? CTXL : SEQ, rowbase = ck < 4 ? b * CTXL : TCTX + b * SEQ;
    const bf16_t* Pp = WSP(bf16_t, WS_P);
    for (int idx = tid; idx < 67 * 8; idx += NTHR) { const int r = idx >> 3, c8 = idx & 7, tt = t0 - 2 + r;
        u32x4 v = (u32x4){0u, 0u, 0u, 0u};
        if (tt >= 0 && tt < seglen) v = *(const u32x4*)(Pp + (size_t)(rowbase + tt) * NP + PC_RX + g * 64 + c8 * 8);
#pragma unroll
        for (int q = 0; q < 4; ++q) { xraw[r * 64 + c8 * 8 + 2 * q] = __uint_as_float(v[q] << 16); xraw[r * 64 + c8 * 8 + 2 * q + 1] = __uint_as_float(v[q] & 0xFFFF0000u); } }
    __syncthreads();
#pragma unroll
    for (int it = 0; it < 8; ++it) { const int idx = tid + NTHR * it, t = idx >> 6, ch = idx & 63, cg = g * 64 + ch;
        float v = P.in[I_RGCB][l * 384 + cg];
#pragma unroll
        for (int j = 0; j < 4; ++j) v += P.in[I_RGCW][(l * 4 + j) * 384 + cg] * xraw[(t + j) * 64 + ch];
        xc[t * 64 + ch] = v; xcb[t * 72 + ch] = f2bf(v); }
    __syncthreads();
    {
        const int dir = cx.wave >> 2, cg4 = cx.wave & 3, fr = cx.lane & 15, fq = cx.lane >> 4;
        const bf16_t* wrg = WSP(bf16_t, WS_WRG) + (size_t)(l * 6 + g) * 256 * 64;
        f32x4 ar[4], ai[4];
#pragma unroll
        for (int m = 0; m < 4; ++m) { ar[m] = (f32x4){0.f, 0.f, 0.f, 0.f}; ai[m] = (f32x4){0.f, 0.f, 0.f, 0.f}; }
#pragma unroll
        for (int kk = 0; kk < 2; ++kk) {
            const bf16x8 br = ldg8(wrg + (size_t)((dir * 2 + 0) * 64 + cg4 * 16 + fr) * 64 + kk * 32 + fq * 8);
            const bf16x8 bi = ldg8(wrg + (size_t)((dir * 2 + 1) * 64 + cg4 * 16 + fr) * 64 + kk * 32 + fq * 8);
#pragma unroll
            for (int m = 0; m < 4; ++m) { const bf16x8 a = *(const LAS bf16x8*)(xcb + (m * 16 + fr) * 72 + kk * 32 + fq * 8);
                ar[m] = __builtin_amdgcn_mfma_f32_16x16x32_bf16(br, a, ar[m], 0, 0, 0); ai[m] = __builtin_amdgcn_mfma_f32_16x16x32_bf16(bi, a, ai[m], 0, 0, 0); }
        }
        const int ch0 = cg4 * 16 + 4 * fq, cgl = g * 64 + ch0;
        const f32x4 ba = *(const f32x4*)(P.in[I_RGBA] + (l * 2 + dir) * 384 + cgl), bx = *(const f32x4*)(P.in[I_RGBX] + (l * 2 + dir) * 384 + cgl);
        const f32x4 lam = *(const f32x4*)(P.in[I_RGLAM] + (l * 2 + dir) * 384 + cgl);
        float sp[4];
#pragma unroll
        for (int j = 0; j < 4; ++j) sp[j] = lam[j] > 0.f ? log1p_(__expf(-lam[j])) : -lam[j] + log1p_(__expf(lam[j]));
#pragma unroll
        for (int m = 0; m < 4; ++m) { const int t = m * 16 + fr; const f32x4 xv = *(const LAS f32x4*)(xc + t * 64 + ch0);
            f32x4 av, bv;
#pragma unroll
            for (int j = 0; j < 4; ++j) { const float r = frcp(1.0f + __expf(-(ar[m][j] + ba[j]))), ii = frcp(1.0f + __expf(-(ai[m][j] + bx[j])));
                const float la = -8.0f * r * sp[j], y = 2.0f * la; av[j] = __expf(la);
                const float nem1 = y > -0.3f ? -y * (1.0f + y * (0.5f + y * (0.16666667f + y * (0.041666668f + y * 0.0083333338f)))) : 1.0f - __expf(y);
                bv[j] = sqrtf(nem1) * (ii * xv[j]); }
            *(LAS f32x4*)(ab + ((dir * 2 + 0) * 64 + t) * 64 + ch0) = av; *(LAS f32x4*)(ab + ((dir * 2 + 1) * 64 + t) * 64 + ch0) = bv; }
    }
    __syncthreads();
    if (tid < 128) { const int dir = tid >> 6, ch = tid & 63; const size_t ix = ((size_t)(b * RGC + ck) * 2 + dir) * 384 + g * 64 + ch;
        float hc = mode ? WSP(float, WS_RGC)[ix] : 0.f, ap = 1.0f;
        LAS float* A = ab + (dir * 2 + 0) * 4096 + ch; LAS float* B = ab + (dir * 2 + 1) * 4096 + ch;
#pragma unroll 8
        for (int s = 0; s < 64; ++s) { const int t = dir ? 63 - s : s; const float a = A[t * 64]; hc = a * hc + B[t * 64]; ap *= a; if (mode) B[t * 64] = hc; }
        if (!mode) { WSP(float, WS_RGA)[ix] = ap; WSP(float, WS_RGB)[ix] = hc; } }
    __syncthreads();
    if (mode) { const int t = tid >> 3, ch0 = (tid & 7) * 8; float hv[8]; float ss = 0.f;
#pragma unroll
        for (int j = 0; j < 8; ++j) { hv[j] = ab[(1 * 64 + t) * 64 + ch0 + j] + ab[(3 * 64 + t) * 64 + ch0 + j]; ss += hv[j] * hv[j]; }
        ss += dpp_<0xB1, 0xF>(ss); ss += dpp_<0x4E, 0xF>(ss); ss += dpp_<0x141, 0xF>(ss);
        const float rstd = rsqrtf(ss * (1.0f / 64.0f) + EPS);
        const size_t row = (size_t)(rowbase + t0 + t);
        const u32x4 gv = *(const u32x4*)(Pp + row * NP + PC_RG + g * 64 + ch0);
        const float* mw = P.in[I_MIXW] + l * 1024 + 384 + g * 64 + ch0;
        u32x4 o;
#pragma unroll
        for (int q = 0; q < 4; ++q) { const float g0 = __uint_as_float(gv[q] << 16), g1v = __uint_as_float(gv[q] & 0xFFFF0000u);
            o[q] = pk_bf16(g0 * hv[2 * q] * rstd * mw[2 * q], g1v * hv[2 * q + 1] * rstd * mw[2 * q + 1]); }
        *(u32x4*)(WSP(bf16_t, WS_MRG) + row * 1024 + 384 + g * 64 + ch0) = o;
        __syncthreads(); }
}
DEVI void rg_carry(const Ctx& cx) {
    for (int idx = (cx.G - 1 - cx.bid) * NTHR + cx.tid; idx < NB * 2 * 384; idx += cx.G * NTHR) {
        const int ch = idx % 384, dir = (idx / 384) & 1, b = idx / 768;
        float A[RGC], B[RGC];
#pragma unroll
        for (int s = 0; s < RGC; ++s) { const int ck = dir == 0 ? s : (s < 4 ? 3 - s : 39 - s);
            const size_t ix = ((size_t)(b * RGC + ck) * 2 + dir) * 384 + ch; A[s] = WSP(float, WS_RGA)[ix]; B[s] = WSP(float, WS_RGB)[ix]; }
        float h = 0.f;
#pragma unroll
        for (int s = 0; s < RGC; ++s) { const int ck = dir == 0 ? s : (s < 4 ? 3 - s : 39 - s);
            const size_t ix = ((size_t)(b * RGC + ck) * 2 + dir) * 384 + ch; WSP(float, WS_RGC)[ix] = h; h = A[s] * h + B[s]; }
    }
}

DEVI int s5_trow(int rowi, int s) { const int b = rowi / S5C, c = rowi % S5C; return c < 8 ? b * CTXL + c * 32 + s : TCTX + b * SEQ + s * 64 + (c - 8); }
DEVI void s5_local_wave(const Ctx& cx, int l, int wu) {
    const int g = wu / 36, mt = (wu % 36) / 4, nt = wu % 4;
    const bf16_t* Pp = WSP(bf16_t, WS_P) + PC_S5 + g * 16;
    const bf16_t* we = WSP(bf16_t, WS_WE) + (size_t)(l * 16 + g) * 256 * 512 + (size_t)nt * 64 * 512;
    f32x4 acc[4][4];
    wave_gemm<4, 4>(cx.lane, 512, [&](int row, int k) { return ldg8(Pp + (size_t)s5_trow(mt * 64 + row, k >> 4) * NP + (k & 15)); },
                         [&](int row, int k) { return ldg8(we + (size_t)row * 512 + k); }, acc);
    const int fr = cx.lane & 15, fq = cx.lane >> 4;
#pragma unroll
    for (int m = 0; m < 4; ++m)
#pragma unroll
        for (int n = 0; n < 4; ++n) *(f32x4*)(WSP(float, WS_SLOC) + ((size_t)g * S5R + mt * 64 + m * 16 + fr) * 256 + nt * 64 + n * 16 + 4 * fq) = acc[m][n];
}
DEVI void s5_carry(const Ctx& cx, int l) {
    for (int idx = cx.bid * NTHR + cx.tid; idx < NB * 16 * 2 * 64; idx += cx.G * NTHR) {
        const int n = idx & 63, d = (idx >> 6) & 1, g = (idx >> 7) & 15, b = idx >> 11;
        const f32x2 a32 = WSP(f32x2, WS_PW)[(size_t)(((l * 16 + g) * 2 + d) * 64 + n) * 33 + 32];
        float sr = 0.f, si = 0.f;
#pragma unroll 1
        for (int s0 = 0; s0 < S5C; s0 += 24) {
            float lr[24], li[24];
#pragma unroll
            for (int j = 0; j < 24; ++j) { const int s = s0 + j, c = d == 0 ? s : (s < 8 ? 7 - s : 79 - s);
                const size_t ix = ((size_t)g * S5R + b * S5C + c) * 256 + d * 128 + n; lr[j] = WSP(float, WS_SLOC)[ix]; li[j] = WSP(float, WS_SLOC)[ix + 64]; }
#pragma unroll
            for (int j = 0; j < 24; ++j) { const int s = s0 + j, c = d == 0 ? s : (s < 8 ? 7 - s : 79 - s);
                const size_t ix = ((size_t)g * S5R + b * S5C + c) * 256 + d * 128 + n;
                WSP(bf16_t, WS_SIN)[ix] = f2bf(sr); WSP(bf16_t, WS_SIN)[ix + 64] = f2bf(si);
                const float nr = a32.x * sr - a32.y * si + lr[j], ni = a32.x * si + a32.y * sr + li[j]; sr = nr; si = ni; }
        }
    }
}
DEVI void s5_out_wave(const Ctx& cx, int l, int wu) {
    const int g = wu / 72, mt = (wu % 72) / 8, nt = wu % 8;
    const bf16_t* Pp = WSP(bf16_t, WS_P) + PC_S5 + g * 16;
    const bf16_t* sin_ = WSP(bf16_t, WS_SIN) + (size_t)g * S5R * 256;
    const bf16_t* wy = WSP(bf16_t, WS_WY) + (size_t)(l * 16 + g) * 512 * 768 + (size_t)nt * 64 * 768;
    f32x4 acc[4][4];
    wave_gemm<4, 4>(cx.lane, 768, [&](int row, int k) { return k < 512 ? ldg8(Pp + (size_t)s5_trow(mt * 64 + row, k >> 4) * NP + (k & 15)) : ldg8(sin_ + (size_t)(mt * 64 + row) * 256 + (k - 512)); },
                         [&](int row, int k) { return ldg8(wy + (size_t)row * 768 + k); }, acc);
    const int fr = cx.lane & 15, fq = cx.lane >> 4;
#pragma unroll
    for (int m = 0; m < 4; ++m)
#pragma unroll
        for (int n = 0; n < 4; ++n) { const int trow = s5_trow(mt * 64 + m * 16 + fr, nt * 4 + n);
            u32x2 w; w.x = pk_bf16(gelu_tanh(acc[m][n][0]), gelu_tanh(acc[m][n][1])); w.y = pk_bf16(gelu_tanh(acc[m][n][2]), gelu_tanh(acc[m][n][3]));
            *(u32x2*)(WSP(bf16_t, WS_GS) + (size_t)trow * 256 + g * 16 + 4 * fq) = w; }
}
DEVI void s5_glu_wave(const Ctx& cx, int l, int wu) {
    const int mt = wu / 4, nt = wu % 4;
    const bf16_t* gs = WSP(bf16_t, WS_GS) + (size_t)mt * 64 * 256;
    const bf16_t* wg = WSP(bf16_t, WS_WGLU) + (size_t)l * 65536 + (size_t)nt * 64 * 256;
    f32x4 acc[4][4];
    wave_gemm<4, 4>(cx.lane, 256, [&](int row, int k) { return ldg8(gs + (size_t)row * 256 + k); }, [&](int row, int k) { return ldg8(wg + (size_t)row * 256 + k); }, acc);
    const int fr = cx.lane & 15, fq = cx.lane >> 4;
#pragma unroll
    for (int n = 0; n < 4; ++n) { const int col = nt * 64 + n * 16 + 4 * fq;
        const f32x4 gb = *(const f32x4*)(cx.p->in[I_S5GB] + l * 256 + col), mw = *(const f32x4*)(cx.p->in[I_MIXW] + l * 1024 + 768 + col);
#pragma unroll
        for (int m = 0; m < 4; ++m) { const size_t trow = (size_t)mt * 64 + m * 16 + fr;
            const u32x2 gv = *(const u32x2*)(WSP(bf16_t, WS_GS) + trow * 256 + col);
            const float gq[4] = {__uint_as_float(gv.x << 16), __uint_as_float(gv.x & 0xFFFF0000u), __uint_as_float(gv.y << 16), __uint_as_float(gv.y & 0xFFFF0000u)};
            float o[4]; float ss = 0.f;
#pragma unroll
            for (int j = 0; j < 4; ++j) { o[j] = gq[j] * frcp(1.0f + __expf(-(acc[m][n][j] + gb[j]))); ss += o[j] * o[j]; }
            ss += shx<16>(ss, cx.lane); ss += shx<32>(ss, cx.lane);
            const float rstd = rsqrtf(ss * (1.0f / 16.0f) + EPS);
            u32x2 w; w.x = pk_bf16(o[0] * rstd * mw[0], o[1] * rstd * mw[1]); w.y = pk_bf16(o[2] * rstd * mw[2], o[3] * rstd * mw[3]);
            *(u32x2*)(WSP(bf16_t, WS_MRG) + trow * 1024 + 768 + col) = w; } }
}

#ifndef PH_DUP2
#define PH_DUP2 0
#endif
#define REP_(k) for (int rep_ = 0; rep_ < 1 + ((PH_DUP2 >> (k)) & 1); ++rep_)
DEVI void ph_mix_local(const Ctx& cx, int l) {
    REP_(0) for (int u = cx.bid; u < NB * 4 * MLC; u += cx.G) ml_local_unit(cx, l, u / (4 * MLC), (u / MLC) % 4, u % MLC);
    REP_(1) { const int off = (NB * 4 * MLC) % cx.G; const int first = (cx.bid - off + cx.G) % cx.G;
      for (int u = first; u < NB * RGC * 6; u += cx.G) rg_unit(cx, l, u / (RGC * 6), (u / 6) % RGC, u % 6, 0); }
    REP_(2) { const int off = (NB * 4 * MLC + NB * RGC * 6) % cx.G; const int first = (cx.bid - off + cx.G) % cx.G;
      for (int wu = first * 8 + cx.wave; wu < 16 * 36; wu += cx.G * 8) s5_local_wave(cx, l, wu); }
}
DEVI void ph_mix_carry(const Ctx& cx, int l) { ml_carry(cx); rg_carry(cx); s5_carry(cx, l); }
DEVI void ph_mix_out(const Ctx& cx, int l) {
    const bool last = (l == DEPTH - 1);
    REP_(3) for (int u = cx.bid; u < NB * 4 * MLC; u += cx.G) { const int c = u % MLC; if (last && c < 2) continue; ml_out_unit(cx, l, u / (4 * MLC), (u / MLC) % 4, c); }
    REP_(4) { const int off = (NB * 4 * MLC) % cx.G; const int first = (cx.bid - off + cx.G) % cx.G;
      for (int u = first; u < NB * RGC * 6; u += cx.G) { const int ck = (u / 6) % RGC; if (last && ck < 4) continue; rg_unit(cx, l, u / (RGC * 6), ck, u % 6, 1); } }
    REP_(5) { const int off = (NB * 4 * MLC + NB * RGC * 6) % cx.G; const int first = (cx.bid - off + cx.G) % cx.G;
      for (int wu = first * 8 + cx.wave; wu < 16 * 72; wu += cx.G * 8) s5_out_wave(cx, l, wu); }
}
DEVI void ph_glu(const Ctx& cx, int l) {
    for (int wu = cx.bid * 8 + cx.wave; wu < (TT / 64) * 4; wu += cx.G * 8) s5_glu_wave(cx, l, wu);
}

DEVI unsigned st_launder(unsigned s_addr) { unsigned a; asm volatile("v_mov_b32 %0, %1" : "=v"(a) : "s"(s_addr)); return a; }
constexpr int N_STEPS = 3 + 10 * DEPTH + 1;
__global__ void __launch_bounds__(NTHR, 2) mk_fwd(Params p) {
    extern __shared__ __attribute__((aligned(16))) unsigned char lds_raw[];
    Ctx cx; cx.p = &p; cx.ws = p.ws; cx.lds = (LAS unsigned char*)lds_raw; cx.tid = threadIdx.x; cx.lane = cx.tid & 63;
    cx.wave = __builtin_amdgcn_readfirstlane((int)threadIdx.x >> 6); cx.G = gridDim.x; cx.bid = blockIdx.x;
    volatile LAS unsigned* st = (volatile LAS unsigned*)(cx.lds + LDS_BYTES - 16);
    const unsigned st_s = (unsigned)__builtin_amdgcn_readfirstlane((int)(unsigned)(size_t)(LAS unsigned*)(cx.lds + LDS_BYTES - 16));
#define ST_P ((volatile LAS unsigned*)(size_t)st_launder(st_s))
    if (cx.tid == 0) { st[0] = 0u; st[1] = 0u; st[2] = (unsigned)p.lo; st[3] = (unsigned)p.hi; }
    __syncthreads();
    (void)xcd_barrier_post((unsigned*)(p.ws + WS_CTL) + CW_BAR, st);
#define GRID_BAR() do { XcdBarrier b_; b_.bar = (unsigned*)(p.ws + WS_CTL) + CW_BAR; b_.x = (unsigned)__builtin_amdgcn_readfirstlane((int)xb_xcc_id()); b_.st = ST_P; xcd_barrier(b_); } while (0)
#ifndef PH_MASK
#define PH_MASK 0xFFFF
#endif
#ifndef PH_DUP
#define PH_DUP 0
#endif
#define STEP_(id, k, call) do { const int lo_ = __builtin_amdgcn_readfirstlane((int)ST_P[2]), hi_ = __builtin_amdgcn_readfirstlane((int)ST_P[3]); if (lo_ <= (k) && (k) < hi_) { if ((PH_MASK >> (id)) & 1) { const Ctx cl = relaunder(cx); call; } if ((PH_DUP >> (id)) & 1) { GRID_BAR(); const Ctx cl = relaunder(cx); call; } if ((k) + 1 < hi_) GRID_BAR(); } } while (0)
    STEP_(0, 0, ph_pro_a(cl));
    STEP_(1, 1, ph_pro_b(cl));
    STEP_(2, 2, ph_pro_c(cl));
#pragma unroll 1
    for (int l = 0; l < DEPTH; ++l) {
        const int s0 = 3 + 10 * l;
        STEP_(3, s0 + 0, ph_norm1(cl, l));
        STEP_(4, s0 + 1, ph_inproj(cl, l));
        STEP_(5, s0 + 2, ph_mix_local(cl, l));
        STEP_(6, s0 + 3, ph_mix_carry(cl, l));
        STEP_(7, s0 + 4, ph_mix_out(cl, l));
        STEP_(8, s0 + 5, ph_glu(cl, l));
        STEP_(9, s0 + 6, ph_outproj(cl, l));
        STEP_(10, s0 + 7, ph_norm2(cl, l));
        STEP_(11, s0 + 8, ph_moe_gu(cl, l));
        STEP_(12, s0 + 9, ph_moe_dn(cl, l));
    }
    STEP_(13, N_STEPS - 1, ph_norm1(cl, DEPTH));
#undef STEP_
}

extern "C" void kernel_launch(void* const* d_in, const int* in_sizes, int n_in, void* d_out, int out_size, void* d_ws, size_t ws_size, hipStream_t stream) {
    static int grid = 0;
    if (grid == 0) {
        if (n_in != 36 || out_size != TLAT * DM || ws_size < WS_END) { fprintf(stderr, "kernel_launch: unexpected problem (n_in %d, out %d, ws %zu < %zu)\n", n_in, out_size, ws_size, (size_t)WS_END); grid = -1; return; }
        int dev = 0, cus = 0, per_cu = 0;
        if (hipGetDevice(&dev) != hipSuccess || hipDeviceGetAttribute(&cus, hipDeviceAttributeMultiprocessorCount, dev) != hipSuccess) { grid = -1; return; }
        if (hipFuncSetAttribute((const void*)mk_fwd, hipFuncAttributeMaxDynamicSharedMemorySize, LDS_BYTES) != hipSuccess) { fprintf(stderr, "kernel_launch: hipFuncSetAttribute failed\n"); grid = -1; return; }
        if (hipOccupancyMaxActiveBlocksPerMultiprocessor(&per_cu, (const void*)mk_fwd, NTHR, LDS_BYTES) != hipSuccess || per_cu < 1) { fprintf(stderr, "kernel_launch: occupancy query says %d blocks per CU\n", per_cu); }
        (void)hipGetLastError();
        grid = cus;
    }
    if (grid < 0) return;
    (void)hipMemsetAsync((char*)d_ws + WS_CTL, 0, CTL_BYTES, stream);
    Params p{};
    for (int i = 0; i < 36; ++i) p.in[i] = (const float*)d_in[i];
    p.out = (float*)d_out; p.ws = (unsigned char*)d_ws;
#if MK_FUSED
    p.lo = 0; p.hi = N_STEPS;
    hipLaunchKernelGGL(mk_fwd, dim3(grid), dim3(NTHR), LDS_BYTES, stream, p);
#else
    for (int k = 0; k < N_STEPS; ++k) { p.lo = k; p.hi = k + 1; hipLaunchKernelGGL(mk_fwd, dim3(grid), dim3(NTHR), LDS_BYTES, stream, p); }
#endif
}
```

```cpp
#include <hip/hip_runtime.h>
#include <stdint.h>
#include <stdio.h>

#ifndef MK_FUSED
#define MK_FUSED 1
#endif

typedef unsigned short bf16_t;
typedef short bf16x8 __attribute__((ext_vector_type(8)));
typedef float f32x4 __attribute__((ext_vector_type(4)));
typedef float f32x2 __attribute__((ext_vector_type(2)));
typedef unsigned u32x4 __attribute__((ext_vector_type(4)));
typedef unsigned u32x2 __attribute__((ext_vector_type(2)));
#define LAS __attribute__((address_space(3)))
#define DEVI __device__ __forceinline__

constexpr int DM = 1024, NB = 8, SEQ = 2048, CTXL = 256, DEPTH = 4;
constexpr int TCTX = NB * CTXL, TLAT = NB * SEQ, TT = TCTX + TLAT;
constexpr int DIN = 2576, NP = 2560;
constexpr int NE = 32;
constexpr int PMAX = 81920;
constexpr int NTHR = 512;
constexpr int LDS_BYTES = 152 * 1024;
constexpr float EPS = 1e-6f;
constexpr int PC_Q = 0, PC_K = 384, PC_V = 768, PC_O = 1152, PC_RX = 1536, PC_RG = 1920, PC_S5 = 2304;
constexpr int MLC = 18;
constexpr int RGC = 36;
constexpr int S5C = 72, S5R = NB * S5C;

constexpr size_t al256(size_t x) { return (x + 255) & ~(size_t)255; }
constexpr size_t WS_CTL   = 0;
constexpr size_t CTL_BYTES = 65536;
constexpr size_t CW_BAR = 0;
constexpr size_t CW_CNT = 4096;
constexpr size_t WS_WIN   = al256(WS_CTL + CTL_BYTES);
constexpr size_t WS_WOUT  = al256(WS_WIN + (size_t)DEPTH * NP * 1024 * 2);
constexpr size_t WS_WGU   = al256(WS_WOUT + (size_t)DEPTH * 1024 * 1024 * 2);
constexpr size_t WS_WD    = al256(WS_WGU + (size_t)DEPTH * NE * 2048 * 1024 * 2);
constexpr size_t WS_MOD   = al256(WS_WD + (size_t)DEPTH * NE * 1024 * 1024 * 2);
constexpr size_t WS_PW    = al256(WS_MOD + (size_t)DEPTH * 9 * 6144 * 4);
constexpr size_t WS_BB    = al256(WS_PW + (size_t)DEPTH * 16 * 2 * 64 * 33 * 8);
constexpr size_t WS_KT    = al256(WS_BB + (size_t)DEPTH * 16 * 2 * 64 * 16 * 8);
constexpr size_t WS_WY    = al256(WS_KT + (size_t)DEPTH * 16 * 2 * 32 * 256 * 4);
constexpr size_t WS_WE    = al256(WS_WY + (size_t)DEPTH * 16 * 512 * 768 * 2);
constexpr size_t WS_WRG   = al256(WS_WE + (size_t)DEPTH * 16 * 256 * 512 * 2);
constexpr size_t WS_WGLU  = al256(WS_WRG + (size_t)DEPTH * 6 * 256 * 64 * 2);
constexpr size_t WS_XS    = al256(WS_WGLU + (size_t)DEPTH * 256 * 256 * 2);
constexpr size_t WS_XMID  = al256(WS_XS + (size_t)TT * 1024 * 4);
constexpr size_t WS_H     = al256(WS_XMID + (size_t)TT * 1024 * 4);
constexpr size_t WS_GT    = al256(WS_H + (size_t)TT * 1024 * 2);
constexpr size_t WS_P     = al256(WS_GT + (size_t)TT * 16 * 4);
constexpr size_t WS_GB    = al256(WS_P + (size_t)TT * NP * 2);
constexpr size_t WS_GU    = al256(WS_GB + (size_t)TT * 8 * 4);
constexpr size_t WS_GCM   = al256(WS_GU + (size_t)TT * 8 * 4);
constexpr size_t WS_MSC   = al256(WS_GCM + (size_t)TT * 8 * 4);
constexpr size_t WS_CLOC  = al256(WS_MSC + (size_t)8 * 4 * 18 * 2 * 2 * 4);
constexpr size_t WS_NLOC  = al256(WS_CLOC + (size_t)8 * 4 * 18 * 2 * 9216 * 4);
constexpr size_t WS_C0    = al256(WS_NLOC + (size_t)8 * 4 * 18 * 2 * 96 * 4);
constexpr size_t WS_N0    = al256(WS_C0 + (size_t)8 * 4 * 18 * 2 * 9216 * 2);
constexpr size_t WS_M0    = al256(WS_N0 + (size_t)8 * 4 * 18 * 2 * 96 * 4);
constexpr size_t WS_RGA   = al256(WS_M0 + (size_t)8 * 4 * 18 * 2 * 4);
constexpr size_t WS_RGB   = al256(WS_RGA + (size_t)8 * 36 * 2 * 384 * 4);
constexpr size_t WS_RGC   = al256(WS_RGB + (size_t)8 * 36 * 2 * 384 * 4);
constexpr size_t WS_SLOC  = al256(WS_RGC + (size_t)8 * 36 * 2 * 384 * 4);
constexpr size_t WS_SIN   = al256(WS_SLOC + (size_t)16 * 576 * 256 * 4);
constexpr size_t WS_GS    = al256(WS_SIN + (size_t)16 * 576 * 256 * 2);
constexpr size_t WS_MRG   = al256(WS_GS + (size_t)TT * 256 * 2);
constexpr size_t WS_ELIST = al256(WS_MRG + (size_t)TT * 1024 * 2);
constexpr size_t WS_GLIST = al256(WS_ELIST + (size_t)NE * TT * 4);
constexpr size_t WS_TINFO = al256(WS_GLIST + (size_t)NE * TT * 4);
constexpr size_t WS_ACT   = al256(WS_TINFO + (size_t)TT * 4 * 4);
constexpr size_t WS_YPAD  = al256(WS_ACT + (size_t)PMAX * 1024 * 2);
constexpr size_t WS_BIN2  = al256(WS_YPAD + (size_t)PMAX * 1024 * 2);
constexpr size_t WS_HLO   = al256(WS_BIN2 + (size_t)DEPTH * NP * 4);
constexpr size_t WS_WGT   = al256(WS_HLO + (size_t)TT * 1024 * 2);
constexpr size_t WS_RWH   = al256(WS_WGT + (size_t)DEPTH * 16 * 1024 * 2);
constexpr size_t WS_RWL   = al256(WS_RWH + (size_t)DEPTH * 32 * 1024 * 2);
constexpr size_t WS_END   = al256(WS_RWL + (size_t)DEPTH * 32 * 1024 * 2);

struct Params { const float* in[36]; float* out; unsigned char* ws; int lo, hi; };

enum { I_X = 0, I_C, I_CTX, I_CCTX, I_ADAW, I_ADAB, I_N1W, I_WIN, I_BIN, I_RGCW, I_RGCB, I_RGWA, I_RGBA, I_RGWX, I_RGBX, I_RGLAM,
       I_S5LRE, I_S5LIM, I_S5LDT, I_S5BRE, I_S5BIM, I_S5CRE, I_S5CIM, I_S5D, I_S5GW, I_S5GB, I_MIXW, I_WOUT, I_N2W, I_RW, I_RB,
       I_WGU, I_BGU, I_WD, I_BD, I_FNW };

DEVI bf16_t f2bf(float f) { unsigned u = __float_as_uint(f); u += 0x7FFFu + ((u >> 16) & 1u); return (bf16_t)(u >> 16); }
DEVI float bf2f(bf16_t b) { return __uint_as_float(((unsigned)b) << 16); }
DEVI unsigned pk_bf16(float lo, float hi) { unsigned r; asm("v_cvt_pk_bf16_f32 %0, %1, %2" : "=v"(r) : "v"(lo), "v"(hi)); return r; }
DEVI float frcp(float x) { return __builtin_amdgcn_rcpf(x); }
DEVI float sigmoidf_(float x) { return frcp(1.0f + __expf(-x)); }
DEVI float gelu_tanh(float x) { const float u = 0.7978845608f * (x + 0.044715f * x * x * x); return x * frcp(1.0f + __expf(-2.0f * u)); }
template <int M> DEVI float shx(float v, int lane) {
    if constexpr (M < 32) return __int_as_float(__builtin_amdgcn_ds_swizzle(__float_as_int(v), 0x1F | (M << 10)));
    else return __int_as_float(__builtin_amdgcn_ds_bpermute((lane ^ 32) << 2, __float_as_int(v)));
}
DEVI float shxr(float v, int m, int lane) {
    switch (m) { case 1: return shx<1>(v, lane); case 2: return shx<2>(v, lane); case 4: return shx<4>(v, lane); case 8: return shx<8>(v, lane); case 16: return shx<16>(v, lane); default: return shx<32>(v, lane); }
}
DEVI int shxri(int v, int m, int lane) { return __float_as_int(shxr(__int_as_float(v), m, lane)); }
template <int CTRL, int ROWMASK> DEVI float dpp_(float v) { return __int_as_float(__builtin_amdgcn_update_dpp(0, __float_as_int(v), CTRL, ROWMASK, 0xF, false)); }
DEVI float wave_sum(float v, int) {
    v += dpp_<0xB1, 0xF>(v); v += dpp_<0x4E, 0xF>(v); v += dpp_<0x141, 0xF>(v); v += dpp_<0x140, 0xF>(v);
    v += dpp_<0x142, 0xA>(v); v += dpp_<0x143, 0xC>(v);
    return __int_as_float(__builtin_amdgcn_readlane(__float_as_int(v), 63));
}
DEVI float log1p_(float e) { return e < 0.06f ? e * (1.0f - e * (0.5f - e * (0.33333334f - e * 0.25f))) : __logf(1.0f + e); }
#define LDS_SYNC() do { asm volatile("s_waitcnt lgkmcnt(0)" ::: "memory"); __builtin_amdgcn_s_barrier(); asm volatile("" ::: "memory"); } while (0)
DEVI int mod_row(int row) { return row < TCTX ? 8 : (row - TCTX) / SEQ; }

#define XB_TMO      128
#define XB_XCNT(j)  (256  + 64 * (j))
#define XB_XSUB(j)  (1280 + 64 * (j))
#define XB_XGEN(j)  (2304 + 64 * (j))
#define XB_TOP      3328
#define XB_TOPGEN   3392
#define XCD_BAR_WORDS 3456
#define XB_SPIN_CAP (1u << 18)
__device__ __forceinline__ unsigned xb_ld(unsigned* p)              { return __hip_atomic_load(p, __ATOMIC_RELAXED, __HIP_MEMORY_SCOPE_AGENT); }
__device__ __forceinline__ unsigned xb_add(unsigned* p, unsigned v) { return __hip_atomic_fetch_add(p, v, __ATOMIC_RELAXED, __HIP_MEMORY_SCOPE_AGENT); }
__device__ __forceinline__ unsigned xb_xcc_id() { return (unsigned)__builtin_amdgcn_s_getreg((3 << 11) | 20) & 0xFu; }
#define XB_SPIN(cond, bar) do { unsigned _sp = 0; while (cond) { __builtin_amdgcn_s_sleep(1); \
    if ((++_sp & 255u) == 0u) { if (xb_ld(&(bar)[XB_TMO])) break; if (_sp > XB_SPIN_CAP) { atomicAdd(&(bar)[XB_TMO], 1u); break; } } } } while (0)
struct XcdBarrier { unsigned* bar; unsigned x; volatile LAS unsigned* st; };
__device__ __forceinline__ XcdBarrier xcd_barrier_post(unsigned* bar, volatile LAS unsigned* st) {
    XcdBarrier b; b.bar = bar; b.x = xb_xcc_id(); b.st = st;
    if (threadIdx.x == 0) (void)xb_add(&bar[XB_XCNT(b.x)], 1u);
    return b;
}
__device__ __forceinline__ void xcd_barrier_complete(unsigned* bar, unsigned x, unsigned& nloc, unsigned& nx) {
    const unsigned G = gridDim.x * gridDim.y * gridDim.z;
    unsigned sum, cnt, mine, sp = 0u;
    for (;;) {
        sum = 0u; cnt = 0u; mine = 0u;
#pragma unroll
        for (unsigned j = 0; j < 16; ++j) { const unsigned c = xb_ld(&bar[XB_XCNT(j)]); sum += c; cnt += (c > 0u) ? 1u : 0u; mine = (j == x) ? c : mine; }
        if (sum == G) break;
        __builtin_amdgcn_s_sleep(1);
        if ((++sp & 255u) == 0u) { if (xb_ld(&bar[XB_TMO])) break; if (sp > XB_SPIN_CAP) { atomicAdd(&bar[XB_TMO], 1u); break; } }
    }
    nloc = mine > 0u ? mine : 1u; nx = cnt > 0u ? cnt : 1u;
}
__device__ __forceinline__ void xcd_barrier(const XcdBarrier& b) {
    asm volatile("s_waitcnt vmcnt(0)" ::: "memory");
    __syncthreads();
    if (threadIdx.x == 0) {
        unsigned* bar = b.bar;
        __builtin_amdgcn_s_waitcnt(0);
        unsigned nloc = b.st[0], nx = b.st[1];
        if (nloc == 0u) { xcd_barrier_complete(bar, b.x, nloc, nx); b.st[0] = nloc; b.st[1] = nx; }
        const unsigned old = xb_add(&bar[XB_XSUB(b.x)], 1u);
        const unsigned gen = old / nloc;
        if (old + 1u == (gen + 1u) * nloc) {
            __builtin_amdgcn_fence(__ATOMIC_RELEASE, "agent");
            asm volatile("s_waitcnt vmcnt(0)" ::: "memory");
            const unsigned og = xb_add(&bar[XB_TOP], 1u);
            const unsigned tg = og / nx;
            if (og + 1u == (tg + 1u) * nx) xb_add(&bar[XB_TOPGEN], 1u);
            else XB_SPIN(xb_ld(&bar[XB_TOPGEN]) == tg, bar);
            __builtin_amdgcn_fence(__ATOMIC_ACQUIRE, "agent");
            xb_add(&bar[XB_XGEN(b.x)], 1u);
            asm volatile("s_waitcnt vmcnt(0)" ::: "memory");
        } else {
            XB_SPIN(xb_ld(&bar[XB_XGEN(b.x)]) == gen, bar);
            __builtin_amdgcn_fence(__ATOMIC_ACQUIRE, "agent");
            asm volatile("s_waitcnt vmcnt(0)" ::: "memory");
        }
    }
    __syncthreads();
}

namespace g1 {
constexpr int BM = 256, BK = 64, HALF = 128, HTB = HALF * BK * 2, STAGE_BYTES = 8 * HTB, K = 1024, NT = K / BK;
DEVI int lds_byte(int r, int c) { const int st = (r >> 4) * 2 + (c >> 5), rr = r & 15, cc = c & 31, ob = rr * 64 + cc * 2; return st * 1024 + (ob ^ (((ob >> 9) & 1) << 5)); }
DEVI void stage_rc(int b, int& R, int& C) { const int st = b / 1024, sb = b % 1024, swz = sb ^ (((sb >> 9) & 1) << 5); R = (st >> 1) * 16 + swz / 64; C = (st & 1) * 32 + (swz % 64) / 2; }
DEVI int perm32(int rho) { const int n = rho >> 4, i = rho & 15; return 8 * (i >> 2) + 4 * n + (i & 3); }

struct Unit {
    const char* A;
    const int* list;
    int nvalid;
    const char* B;
    int pm, pn, e;
};

template <bool GATHER>
DEVI void a_offsets(const Unit& u, const int (&R)[2], const int (&C)[2], unsigned (&v)[2][2]) {
#pragma unroll
    for (int h = 0; h < 2; ++h)
#pragma unroll
        for (int i = 0; i < 2; ++i) {
            const int r = h * HALF + R[i];
            int src = r;
            if (GATHER) { src = (r < u.nvalid) ? u.list[r] : 0; }
            v[h][i] = (unsigned)src * (unsigned)(K * 2) + (unsigned)(C[i] * 2);
        }
}

template <class Sched, class Epi, bool GATHER>
DEVI void gemm_phase(LAS unsigned char* lds, const int tid, const Sched& S, const Epi& E) {
    const int wid = __builtin_amdgcn_readfirstlane(tid >> 6), lane = tid & 63, wr = wid >> 2, wc = wid & 3, fr = lane & 15, fq = lane >> 4;
    int R[2], C[2]; unsigned voffB[2];
#pragma unroll
    for (int i = 0; i < 2; ++i) { stage_rc(tid * 16 + i * 8192, R[i], C[i]); const int Rb = Epi::PERM ? ((R[i] & ~31) + perm32(R[i] & 31)) : R[i]; voffB[i] = (unsigned)(Rb * K + C[i]) * 2u; }
    constexpr size_t kstep = (size_t)(BK * 2);
    constexpr size_t hstep = (size_t)HALF * K * 2;
    const unsigned ldsw = (unsigned)wid * 1024u;
    const int aoff = lds_byte(wr * 64 + fr, fq * 8), boff = lds_byte(wc * 32 + fr, fq * 8);
#define G1_SA(b, h) (((b) * 2 + (h)) * HTB)
#define G1_SB(b, h) ((4 + (b) * 2 + (h)) * HTB)
#define G1_STAGE2(bufoff, gbase, v0, v1) do { \
        __builtin_amdgcn_global_load_lds((const unsigned*)((const char*)(gbase) + (v0)), (LAS unsigned*)(lds + (bufoff) + ldsw), 16, 0, 0); \
        __builtin_amdgcn_global_load_lds((const unsigned*)((const char*)(gbase) + (v1)), (LAS unsigned*)(lds + (bufoff) + ldsw + 8192), 16, 0, 0); } while (0)
#define G1_LDA(dst, b, h) do { _Pragma("unroll") for (int m = 0; m < 4; ++m) _Pragma("unroll") for (int k = 0; k < 2; ++k) dst[m][k] = *(const LAS bf16x8*)(lds + G1_SA(b, h) + aoff + m * 2048 + k * 1024); } while (0)
#define G1_LDB(dst, b, h) do { _Pragma("unroll") for (int n = 0; n < 2; ++n) _Pragma("unroll") for (int k = 0; k < 2; ++k) dst[n][k] = *(const LAS bf16x8*)(lds + G1_SB(b, h) + boff + n * 2048 + k * 1024); } while (0)
#define G1_MMA(ai, bj, At, Bt) do { __builtin_amdgcn_s_setprio(1); _Pragma("unroll") for (int m = 0; m < 4; ++m) _Pragma("unroll") for (int n = 0; n < 2; ++n) _Pragma("unroll") for (int k = 0; k < 2; ++k) \
        acc[ai][bj][m][n] = __builtin_amdgcn_mfma_f32_16x16x32_bf16(Bt[n][k], At[m][k], acc[ai][bj][m][n], 0, 0, 0); __builtin_amdgcn_s_setprio(0); } while (0)
#define G1_WAIT_V(n) asm volatile("s_waitcnt vmcnt(" #n ")" ::: "memory")
#define G1_WAIT_L(n) asm volatile("s_waitcnt lgkmcnt(" #n ")" ::: "memory")
#define G1_BAR __builtin_amdgcn_s_barrier()
#define G1_SCHED __builtin_amdgcn_sched_barrier(0)
    Unit cur, nxt; int ui = 0;
    if (!S.get(0, cur)) return;
    f32x4 acc[2][2][4][2];
#pragma unroll
    for (int a = 0; a < 2; ++a)
#pragma unroll
        for (int b = 0; b < 2; ++b)
#pragma unroll
            for (int m = 0; m < 4; ++m)
#pragma unroll
                for (int n = 0; n < 2; ++n) acc[a][b][m][n] = (f32x4){0.f, 0.f, 0.f, 0.f};
    bf16x8 At[4][2], B0[2][2], B1[2][2];
    unsigned vc[2][2], vn[2][2];
    a_offsets<GATHER>(cur, R, C, vc);
    const char* cA = cur.A; const char* cB = cur.B;
    G1_STAGE2(G1_SB(0, 0), cB, voffB[0], voffB[1]); G1_STAGE2(G1_SA(0, 0), cA, vc[0][0], vc[0][1]);
    G1_STAGE2(G1_SB(0, 1), cB + hstep, voffB[0], voffB[1]); G1_STAGE2(G1_SA(0, 1), cA, vc[1][0], vc[1][1]);
    if (wr == 1) G1_BAR;
    G1_WAIT_V(4); G1_BAR;
    G1_STAGE2(G1_SB(1, 0), cB + kstep, voffB[0], voffB[1]); G1_STAGE2(G1_SA(1, 0), cA + kstep, vc[0][0], vc[0][1]);
    G1_STAGE2(G1_SB(1, 1), cB + hstep + kstep, voffB[0], voffB[1]);
    G1_WAIT_V(6); G1_BAR;
    for (;;) {
        const bool has_next = S.get(ui + 1, nxt);
        if (has_next) { a_offsets<GATHER>(nxt, R, C, vn); }
        else {
#pragma unroll
            for (int h = 0; h < 2; ++h)
#pragma unroll
                for (int i = 0; i < 2; ++i) vn[h][i] = vc[h][i];
        }
        const char* nA = has_next ? nxt.A : cA; const char* nB = has_next ? nxt.B : cB;
        for (int t = 0; t < NT; t += 2) {
            const bool last = (t == NT - 2);
            const char* a1 = cA + (size_t)(t + 1) * kstep;
            const char* a2 = last ? nA : cA + (size_t)(t + 2) * kstep; const char* b2 = last ? nB : cB + (size_t)(t + 2) * kstep;
            const char* a3 = a2 + kstep; const char* b3 = b2 + kstep;
            const unsigned w00 = last ? vn[0][0] : vc[0][0], w01 = last ? vn[0][1] : vc[0][1], w10 = last ? vn[1][0] : vc[1][0], w11 = last ? vn[1][1] : vc[1][1];
            G1_LDB(B0, 0, 0); G1_SCHED; G1_LDA(At, 0, 0); G1_STAGE2(G1_SA(1, 1), a1, vc[1][0], vc[1][1]);
            G1_WAIT_L(8); G1_BAR; G1_WAIT_L(0); G1_MMA(0, 0, At, B0); G1_BAR; G1_SCHED;
            G1_LDB(B1, 0, 1); G1_STAGE2(G1_SB(0, 0), b2, voffB[0], voffB[1]);
            G1_BAR; G1_WAIT_L(0); G1_MMA(0, 1, At, B1); G1_BAR;
            G1_LDA(At, 0, 1); G1_STAGE2(G1_SA(0, 0), a2, w00, w01);
            G1_BAR; G1_WAIT_L(0); G1_MMA(1, 0, At, B0); G1_BAR; G1_SCHED;
            G1_STAGE2(G1_SB(0, 1), b2 + hstep, voffB[0], voffB[1]);
            G1_WAIT_V(6); G1_BAR; G1_MMA(1, 1, At, B1); G1_BAR;
            G1_LDB(B0, 1, 0); G1_SCHED; G1_LDA(At, 1, 0); G1_STAGE2(G1_SA(0, 1), a2, w10, w11);
            G1_WAIT_L(8); G1_BAR; G1_WAIT_L(0); G1_MMA(0, 0, At, B0); G1_BAR; G1_SCHED;
            G1_LDB(B1, 1, 1); G1_STAGE2(G1_SB(1, 0), b3, voffB[0], voffB[1]);
            G1_BAR; G1_WAIT_L(0); G1_MMA(0, 1, At, B1); G1_BAR;
            G1_LDA(At, 1, 1); G1_STAGE2(G1_SA(1, 0), a3, w00, w01);
            G1_BAR; G1_WAIT_L(0); G1_MMA(1, 0, At, B0); G1_BAR; G1_SCHED;
            G1_STAGE2(G1_SB(1, 1), b3 + hstep, voffB[0], voffB[1]);
            G1_WAIT_V(6); G1_BAR; G1_MMA(1, 1, At, B1); G1_BAR;
        }
        E(acc, cur, wr, wc, fr, fq);
        if (!has_next) break;
#pragma unroll
        for (int a = 0; a < 2; ++a)
#pragma unroll
            for (int b = 0; b < 2; ++b)
#pragma unroll
                for (int m = 0; m < 4; ++m)
#pragma unroll
                    for (int n = 0; n < 2; ++n) acc[a][b][m][n] = (f32x4){0.f, 0.f, 0.f, 0.f};
        cur = nxt; cA = nA; cB = nB; ++ui;
#pragma unroll
        for (int h = 0; h < 2; ++h)
#pragma unroll
            for (int i = 0; i < 2; ++i) vc[h][i] = vn[h][i];
    }
    G1_WAIT_V(0);
    if (wr == 0) G1_BAR;
    G1_BAR;
}
}

template <int MT, int NT_, class AF, class BF>
DEVI void wave_gemm(const int lane, int Kdim, const AF& af, const BF& bf, f32x4 (&acc)[MT][NT_]) {
    const int fr = lane & 15, fq = lane >> 4;
#pragma unroll
    for (int m = 0; m < MT; ++m)
#pragma unroll
        for (int n = 0; n < NT_; ++n) acc[m][n] = (f32x4){0.f, 0.f, 0.f, 0.f};
    bf16x8 fa[4][MT], fb[4][NT_];
#define WG_LOAD(S, KK) do { _Pragma("unroll") for (int m = 0; m < MT; ++m) fa[S][m] = af(m * 16 + fr, (KK) + fq * 8); _Pragma("unroll") for (int n = 0; n < NT_; ++n) fb[S][n] = bf(n * 16 + fr, (KK) + fq * 8); } while (0)
#define WG_MMA(S) do { _Pragma("unroll") for (int m = 0; m < MT; ++m) _Pragma("unroll") for (int n = 0; n < NT_; ++n) acc[m][n] = __builtin_amdgcn_mfma_f32_16x16x32_bf16(fb[S][n], fa[S][m], acc[m][n], 0, 0, 0); } while (0)
    WG_LOAD(0, 0); WG_LOAD(1, 32); WG_LOAD(2, 64);
#pragma unroll 1
    for (int k0 = 0; k0 < Kdim; k0 += 128) {
        const bool more = k0 + 128 < Kdim;
        WG_LOAD(3, k0 + 96); WG_MMA(0);
        if (more) WG_LOAD(0, k0 + 128);
        WG_MMA(1);
        if (more) WG_LOAD(1, k0 + 160);
        WG_MMA(2);
        if (more) WG_LOAD(2, k0 + 192);
        WG_MMA(3);
    }
#undef WG_LOAD
#undef WG_MMA
}
DEVI bf16x8 ldg8(const bf16_t* p) { return *(const bf16x8*)p; }

template <int N> struct Log2 { static constexpr int v = 1 + Log2<N / 2>::v; };
template <> struct Log2<1> { static constexpr int v = 0; };
template <int N>
DEVI float reduce_scatter(const int lane, float (&v)[N]) {
    constexpr int LG = Log2<N>::v;
#pragma unroll
    for (int st = 0; st < LG; ++st) {
        const int s = (N / 2) >> st, mask = 32 >> st;
        const bool up = (lane & mask) != 0;
#pragma unroll
        for (int i = 0; i < N / 2; ++i) if (i < s) {
            const float send = up ? v[i] : v[i + s];
            const float keep = up ? v[i + s] : v[i];
            v[i] = keep + shxr(send, mask, lane);
        }
    }
    float r = v[0];
#pragma unroll
    for (int st = LG; st < 6; ++st) r += shxr(r, 32 >> st, lane);
    return r;
}
template <int N>
DEVI int rs_index(int lane) {
    constexpr int LG = Log2<N>::v;
    int idx = 0;
#pragma unroll
    for (int st = 0; st < LG; ++st) if (lane & (32 >> st)) idx += (N / 2) >> st;
    return idx;
}

struct Ctx {
    const Params* p; unsigned char* ws; LAS unsigned char* lds; int tid, lane, wave, G, bid;
};
#define WSP(T, off) ((T*)(cx.ws + (off)))
DEVI Ctx relaunder(const Ctx& c) { Ctx r = c; int ln, td;
    asm volatile("v_mbcnt_lo_u32_b32 %0, -1, 0\n\tv_mbcnt_hi_u32_b32 %0, -1, %0\n\tv_lshl_add_u32 %1, %2, 6, %0" : "=&v"(ln), "=v"(td) : "s"(c.wave));
    r.lane = ln; r.tid = td; return r; }

DEVI void cvt_tile(const Ctx& cx, const float* src, int ld, bf16_t* dst, int n0, int k0, int kind) {
    LAS bf16_t* tile = (LAS bf16_t*)cx.lds;
    const int n4 = (cx.tid & 63) * 4, w8 = (cx.tid >> 6) * 8, n = n0 + n4;
    int sc; float scale = 1.0f;
    if (kind == 0) { sc = n < 1536 ? n : n + 16; if (n >= 384 && n < 768) scale = 0.10206207261596577f; }
    else if (kind == 2) { const int pn = n >> 8, w = n & 255; sc = w < 128 ? pn * 128 + w : 1024 + pn * 128 + (w - 128); }
    else sc = n;
#pragma unroll 1
    for (int sub = 0; sub < 4; sub += 2) {
        f32x4 v[2][8];
#pragma unroll
        for (int s2 = 0; s2 < 2; ++s2)
#pragma unroll
            for (int p = 0; p < 8; ++p) v[s2][p] = __builtin_nontemporal_load((const f32x4*)(src + (size_t)(k0 + (sub + s2) * 64 + w8 + p) * ld + sc));
#pragma unroll
        for (int s2 = 0; s2 < 2; ++s2)
#pragma unroll
            for (int j = 0; j < 4; ++j) { u32x4 w;
                w.x = pk_bf16(v[s2][0][j] * scale, v[s2][1][j] * scale); w.y = pk_bf16(v[s2][2][j] * scale, v[s2][3][j] * scale);
                w.z = pk_bf16(v[s2][4][j] * scale, v[s2][5][j] * scale); w.w = pk_bf16(v[s2][6][j] * scale, v[s2][7][j] * scale);
                *(LAS u32x4*)(tile + (n4 + j) * 264 + (sub + s2) * 64 + w8) = w; }
    }
    LDS_SYNC();
#pragma unroll
    for (int i = 0; i < 16; ++i) { const int idx = cx.tid + NTHR * i, row = idx >> 5, ch = idx & 31;
        const u32x4 o = *(const LAS u32x4*)(tile + row * 264 + ch * 8);
        *(u32x4*)(dst + (size_t)(n0 + row) * 1024 + k0 + ch * 8) = o; }
    LDS_SYNC();
}

DEVI void ph_pro_a(const Ctx& cx) {
    const Params& P = *cx.p;
    {
        constexpr int n_in = DEPTH * 10 * 4, n_out = DEPTH * 4 * 4, n_gu = DEPTH * NE * 8 * 4, n_dn = DEPTH * NE * 4 * 4;
        constexpr int total = n_in + n_out + n_gu + n_dn;
        for (int job = cx.bid; job < total; job += cx.G) {
            int j = job;
            if (j < n_in) { const int l = j / 40, r = j % 40, nt = r / 4, kt = r % 4;
                cvt_tile(cx, P.in[I_WIN] + (size_t)l * 1024 * DIN, DIN, WSP(bf16_t, WS_WIN) + (size_t)l * NP * 1024, nt * 256, kt * 256, 0); continue; }
            j -= n_in;
            if (j < n_out) { const int l = j / 16, r = j % 16, nt = r / 4, kt = r % 4;
                cvt_tile(cx, P.in[I_WOUT] + (size_t)l * 1024 * 1024, 1024, WSP(bf16_t, WS_WOUT) + (size_t)l * 1024 * 1024, nt * 256, kt * 256, 1); continue; }
            j -= n_out;
            if (j < n_gu) { const int le = j / 32, r = j % 32, nt = r / 4, kt = r % 4;
                cvt_tile(cx, P.in[I_WGU] + (size_t)le * 1024 * 2048, 2048, WSP(bf16_t, WS_WGU) + (size_t)le * 2048 * 1024, nt * 256, kt * 256, 2); continue; }
            j -= n_gu;
            { const int le = j / 16, r = j % 16, nt = r / 4, kt = r % 4;
                cvt_tile(cx, P.in[I_WD] + (size_t)le * 1024 * 1024, 1024, WSP(bf16_t, WS_WD) + (size_t)le * 1024 * 1024, nt * 256, kt * 256, 1); }
        }
    }
    __syncthreads();
    {
        LAS float* sv = (LAS float*)cx.lds;
        LAS float* red = sv + 9 * 1024;
        constexpr int units = DEPTH * 6144 / 64;
        if (cx.bid < units) {
            for (int i = cx.tid; i < 9 * 1024; i += NTHR) { const int r = i >> 10, k = i & 1023; const float c = r < 8 ? P.in[I_C][r * 1024 + k] : P.in[I_CCTX][k]; sv[i] = c / (1.0f + __expf(-c)); }
            __syncthreads();
            for (int u = cx.bid; u < units; u += cx.G) {
                const int l = u / 96, n = (u % 96) * 64 + cx.lane;
                const float* w = P.in[I_ADAW] + (size_t)l * 1024 * 6144 + n;
                float acc[9];
#pragma unroll
                for (int r = 0; r < 9; ++r) acc[r] = 0.f;
                const int kb = cx.wave * 128;
#pragma unroll 4
                for (int k = 0; k < 128; ++k) { const float wv = w[(size_t)(kb + k) * 6144];
#pragma unroll
                    for (int r = 0; r < 9; ++r) acc[r] += sv[r * 1024 + kb + k] * wv; }
#pragma unroll
                for (int r = 0; r < 9; ++r) red[(cx.wave * 9 + r) * 64 + cx.lane] = acc[r];
                __syncthreads();
                for (int i = cx.tid; i < 9 * 64; i += NTHR) { const int r = i >> 6, ln = i & 63; float s = 0.f;
#pragma unroll
                    for (int w8 = 0; w8 < 8; ++w8) s += red[(w8 * 9 + r) * 64 + ln];
                    const int nn = (u % 96) * 64 + ln;
                    WSP(float, WS_MOD)[((size_t)l * 9 + r) * 6144 + nn] = s + P.in[I_ADAB][l * 6144 + nn]; }
                __syncthreads();
            }
        }
    }
    for (int gt = cx.bid * NTHR + cx.tid; gt < DEPTH * 16 * 2 * 64; gt += cx.G * NTHR) {
        const int n = gt & 63, d = (gt >> 6) & 1, g = (gt >> 7) & 15, l = gt >> 11;
        const float dt = expf(P.in[I_S5LDT][(l * 2 + d) * 16 + g]);
        const float lr = P.in[I_S5LRE][((l * 2 + d) * 16 + g) * 64 + n], li = P.in[I_S5LIM][((l * 2 + d) * 16 + g) * 64 + n];
        f32x2* pw = WSP(f32x2, WS_PW) + (size_t)gt * 33;
        float ar = 0.f, ai = 0.f;
        for (int k = 0; k <= 32; ++k) { const float mag = expf(lr * dt * (float)k); float s, c; sincosf(li * dt * (float)k, &s, &c); pw[k] = (f32x2){mag * c, mag * s}; if (k == 1) { ar = mag * c; ai = mag * s; } }
        const float den = lr * lr + li * li;
        const float cr = ((ar - 1.0f) * lr + ai * li) / den, ci = (ai * lr - (ar - 1.0f) * li) / den;
        f32x2* bb = WSP(f32x2, WS_BB) + (size_t)gt * 16;
        for (int q = 0; q < 16; ++q) { const float br = P.in[I_S5BRE][((l * 16 + g) * 64 + n) * 16 + q], bi = P.in[I_S5BIM][((l * 16 + g) * 64 + n) * 16 + q];
            bb[q] = (f32x2){cr * br - ci * bi, cr * bi + ci * br}; }
    }
    for (int i = cx.bid * NTHR + cx.tid; i < DEPTH * 6 * 256 * 64; i += cx.G * NTHR) {
        const int k = i & 63, n = (i >> 6) & 255, g = (i >> 14) % 6, l = (i >> 14) / 6;
        const int j = n & 63, type = (n >> 6) & 1, dir = n >> 7;
        const float* w = type ? P.in[I_RGWX] : P.in[I_RGWA];
        WSP(bf16_t, WS_WRG)[i] = f2bf(w[((((size_t)l * 2 + dir) * 6 + g) * 64 + k) * 64 + j]);
    }
    for (int i = cx.bid * NTHR + cx.tid; i < DEPTH * NP; i += cx.G * NTHR) {
        const int n = i % NP, l = i / NP; const int sc = n < 1536 ? n : n + 16;
        WSP(float, WS_BIN2)[i] = P.in[I_BIN][l * DIN + sc] * ((n >= 384 && n < 768) ? 0.10206207261596577f : 1.0f);
    }
    for (int i = cx.bid * NTHR + cx.tid; i < DEPTH * 16 * 1024; i += cx.G * NTHR) { const int k = i & 1023, n = (i >> 10) & 15, l = i >> 14;
        WSP(bf16_t, WS_WGT)[i] = f2bf(P.in[I_WIN][((size_t)l * 1024 + k) * DIN + 1536 + n]); }
    for (int i = cx.bid * NTHR + cx.tid; i < DEPTH * 32 * 1024; i += cx.G * NTHR) { const int k = i & 1023, n = (i >> 10) & 31, l = i >> 15;
        const float w = P.in[I_RW][((size_t)l * 1024 + k) * 32 + n]; const bf16_t hi = f2bf(w);
        WSP(bf16_t, WS_RWH)[i] = hi; WSP(bf16_t, WS_RWL)[i] = f2bf(w - bf2f(hi)); }
    for (int i = cx.bid * NTHR + cx.tid; i < DEPTH * 256 * 256; i += cx.G * NTHR) {
        const int k = i & 255, n = (i >> 8) & 255, l = i >> 16;
        WSP(bf16_t, WS_WGLU)[i] = f2bf(P.in[I_S5GW][((size_t)l * 256 + k) * 256 + n]);
    }
}

DEVI void ph_pro_b(const Ctx& cx) {
    const Params& P = *cx.p;
    for (int i = cx.bid * NTHR + cx.tid; i < DEPTH * 16 * 2 * 32 * 256; i += cx.G * NTHR) {
        const int q = i & 15, p = (i >> 4) & 15, tau = (i >> 8) & 31, d = (i >> 13) & 1, g = (i >> 14) & 15, l = i >> 18;
        const f32x2* pw = WSP(f32x2, WS_PW) + (size_t)(((l * 16 + g) * 2 + d) * 64) * 33 + tau;
        const f32x2* bb = WSP(f32x2, WS_BB) + (size_t)(((l * 16 + g) * 2 + d) * 64) * 16 + q;
        const float* cre = P.in[I_S5CRE] + ((size_t)(l * 16 + g) * 16 + p) * 64;
        const float* cim = P.in[I_S5CIM] + ((size_t)(l * 16 + g) * 16 + p) * 64;
        float s = 0.f;
        for (int n = 0; n < 64; ++n) { const f32x2 a = pw[n * 33], b = bb[n * 16]; const float cr = cre[n], ci = cim[n];
            const float xr = cr * a.x - ci * a.y, xi = cr * a.y + ci * a.x; s += xr * b.x - xi * b.y; }
        WSP(float, WS_KT)[i] = s;
    }
}

DEVI void ph_pro_c(const Ctx& cx) {
    const Params& P = *cx.p;
    for (size_t i = (size_t)cx.bid * NTHR + cx.tid; i < (size_t)DEPTH * 16 * 512 * 768; i += (size_t)cx.G * NTHR) {
        const int k = (int)(i % 768), tp = (int)((i / 768) % 512), lg = (int)(i / (768 * 512));
        const int t = tp >> 4, p = tp & 15, l = lg >> 4, g = lg & 15;
        float v;
        if (k < 512) { const int s = k >> 4, q = k & 15; v = 0.f;
            const float* kt = WSP(float, WS_KT) + (size_t)lg * 2 * 32 * 256;
            if (s <= t) v += kt[((0 * 32) + (t - s)) * 256 + p * 16 + q];
            if (s >= t) v += kt[((1 * 32) + (s - t)) * 256 + p * 16 + q];
            if (s == t && p == q) v += P.in[I_S5D][l * 256 + g * 16 + p];
        } else { const int kk = k - 512, d = kk >> 7, im = (kk >> 6) & 1, n = kk & 63;
            const int pwr = d == 0 ? t + 1 : 32 - t;
            const f32x2 a = WSP(f32x2, WS_PW)[(size_t)((lg * 2 + d) * 64 + n) * 33 + pwr];
            const float cr = P.in[I_S5CRE][((size_t)lg * 16 + p) * 64 + n], ci = P.in[I_S5CIM][((size_t)lg * 16 + p) * 64 + n];
            v = im ? -(cr * a.y + ci * a.x) : (cr * a.x - ci * a.y);
        }
        WSP(bf16_t, WS_WY)[i] = f2bf(v);
    }
    for (size_t i = (size_t)cx.bid * NTHR + cx.tid; i < (size_t)DEPTH * 16 * 256 * 512; i += (size_t)cx.G * NTHR) {
        const int k = (int)(i & 511), no = (int)((i >> 9) & 255), lg = (int)(i >> 17);
        const int s = k >> 4, q = k & 15, d = no >> 7, im = (no >> 6) & 1, n = no & 63;
        const int pwr = d == 0 ? 31 - s : s;
        const f32x2 a = WSP(f32x2, WS_PW)[(size_t)((lg * 2 + d) * 64 + n) * 33 + pwr];
        const f32x2 b = WSP(f32x2, WS_BB)[(size_t)((lg * 2 + d) * 64 + n) * 16 + q];
        const float v = im ? (a.x * b.y + a.y * b.x) : (a.x * b.x - a.y * b.y);
        WSP(bf16_t, WS_WE)[i] = f2bf(v);
    }
}

DEVI void moe_info(const Ctx& cx, int l, LAS int* info) {
    if (cx.tid < 64) {
        const unsigned* cnt = (const unsigned*)(cx.ws + WS_CTL) + CW_CNT + l * 32;
        const int c = cx.lane < 32 ? (int)__hip_atomic_load(cnt + (cx.lane & 31), __ATOMIC_RELAXED, __HIP_MEMORY_SCOPE_AGENT) : 0;
        const int nt = (c + 255) >> 8;
        if (cx.lane < 32) { info[72 + cx.lane] = nt; info[40 + cx.lane] = c; }
        if (cx.lane == 0) { int run = 0; info[0] = 0; for (int e = 0; e < 32; ++e) { run += info[72 + e]; info[e + 1] = run; } }
    }
    __syncthreads();
    if (cx.tid < 32) { const int lo = info[cx.tid], hi = info[cx.tid + 1]; for (int t = lo; t < hi; ++t) info[112 + t] = cx.tid;
    }
    __syncthreads();
}

DEVI void block_rows_visible() {
    asm volatile("s_waitcnt vmcnt(0)" ::: "memory");
    __syncthreads();
    __builtin_amdgcn_fence(__ATOMIC_ACQUIRE, "agent");
    asm volatile("s_waitcnt vmcnt(0)" ::: "memory");
}
DEVI void ph_norm1(const Ctx& cx, int l) {
    const Params& P = *cx.p;
    LAS int* info = (LAS int*)cx.lds;
    if (l > 0) moe_info(cx, l - 1, info);
    const int rbeg = (l == DEPTH) ? TCTX : 0, nr = TT - rbeg;
    const int rpb = (nr + cx.G - 1) / cx.G, rb = rbeg + cx.bid * rpb, re = min(TT, rb + rpb);
    const float* modp = WSP(float, WS_MOD);
    const int c0 = 2 * cx.lane;
    for (int r2 = rb + cx.wave; r2 < re; r2 += 16) {
        f32x2 x[2][8]; bool ok[2];
#pragma unroll
        for (int u = 0; u < 2; ++u) { const int row = r2 + 8 * u; ok[u] = row < re; const int rw_ = ok[u] ? row : r2;
            if (l == 0) { const float* src = rw_ < TCTX ? P.in[I_CTX] + (size_t)rw_ * 1024 : P.in[I_X] + (size_t)(rw_ - TCTX) * 1024;
#pragma unroll
                for (int i = 0; i < 8; ++i) x[u][i] = *(const f32x2*)(src + c0 + 128 * i);
            } else {
                const float* src = WSP(float, WS_XMID) + (size_t)rw_ * 1024;
                const float* g2 = modp + ((size_t)(l - 1) * 9 + mod_row(rw_)) * 6144 + 5120;
                const int* ti = WSP(int, WS_TINFO) + (size_t)rw_ * 4;
                f32x2 y[8];
#pragma unroll
                for (int i = 0; i < 8; ++i) y[i] = (f32x2){0.f, 0.f};
#pragma unroll
                for (int k = 0; k < 4; ++k) { const int t = ti[k]; const int e = t >> 20, slot = t & 0xFFFFF;
                    const bf16_t* yp = WSP(bf16_t, WS_YPAD) + ((size_t)info[e] * 256 + slot) * 1024;
#pragma unroll
                    for (int i = 0; i < 8; ++i) { const unsigned w = *(const unsigned*)(yp + c0 + 128 * i); y[i].x += __uint_as_float(w << 16); y[i].y += __uint_as_float(w & 0xFFFF0000u); } }
#pragma unroll
                for (int i = 0; i < 8; ++i) { const f32x2 xv = *(const f32x2*)(src + c0 + 128 * i), gv = *(const f32x2*)(g2 + c0 + 128 * i); x[u][i] = xv + gv * y[i]; }
            }
        }
#pragma unroll
        for (int u = 0; u < 2; ++u) {
            const int row = r2 + 8 * u;
            float ss = 0.f;
#pragma unroll
            for (int i = 0; i < 8; ++i) ss += x[u][i].x * x[u][i].x + x[u][i].y * x[u][i].y;
            ss = wave_sum(ss, 0);
            const float rstd = rsqrtf(ss * (1.0f / 1024.0f) + EPS);
            if (!ok[u]) continue;
            if (l == DEPTH) { float* o = P.out + (size_t)(row - TCTX) * 1024;
#pragma unroll
                for (int i = 0; i < 8; ++i) { const f32x2 fw = *(const f32x2*)(P.in[I_FNW] + c0 + 128 * i); *(f32x2*)(o + c0 + 128 * i) = x[u][i] * rstd * fw; }
                continue; }
            float* xs = WSP(float, WS_XS) + (size_t)row * 1024;
            const float* md = modp + ((size_t)l * 9 + mod_row(row)) * 6144;
            bf16_t* hp = WSP(bf16_t, WS_H) + (size_t)row * 1024;
#pragma unroll
            for (int i = 0; i < 8; ++i) { const int c = c0 + 128 * i;
                *(f32x2*)(xs + c) = x[u][i];
                const f32x2 nw = *(const f32x2*)(P.in[I_N1W] + l * 1024 + c), sc = *(const f32x2*)(md + 1024 + c), sh = *(const f32x2*)(md + c);
                const f32x2 h = x[u][i] * rstd * nw * (sc + 1.0f) + sh;
                *(unsigned*)(hp + c) = pk_bf16(h.x, h.y); }
        }
    }
    if (l == DEPTH) return;
    block_rows_visible();
    const int ntile = (re - rb + 15) / 16;
    for (int t = cx.wave; t < ntile; t += 8) {
        const int fr = cx.lane & 15, fq = cx.lane >> 4; const int row = min(rb + t * 16 + fr, re - 1);
        const bf16_t* hp = WSP(bf16_t, WS_H) + (size_t)row * 1024 + fq * 8;
        const bf16_t* wp = WSP(bf16_t, WS_WGT) + ((size_t)l * 16 + fr) * 1024 + fq * 8;
        f32x4 acc = (f32x4){0.f, 0.f, 0.f, 0.f};
#pragma unroll 8
        for (int k0 = 0; k0 < 1024; k0 += 32) acc = __builtin_amdgcn_mfma_f32_16x16x32_bf16(ldg8(wp + k0), ldg8(hp + k0), acc, 0, 0, 0);
        if (rb + t * 16 + fr < re) { const f32x4 bi = *(const f32x4*)(P.in[I_BIN] + l * DIN + 1536 + 4 * fq); *(f32x4*)(WSP(float, WS_GT) + (size_t)row * 16 + 4 * fq) = acc + bi; }
    }
}

DEVI void ph_norm2(const Ctx& cx, int l) {
    const Params& P = *cx.p;
    LAS float* lgs = (LAS float*)cx.lds;
    LAS int* hist = (LAS int*)(cx.lds + 128 * 33 * 4);
    LAS int* pend = hist + 64;
    if (cx.tid < 64) hist[cx.tid] = 0;
    const int r0 = (l == DEPTH - 1) ? TCTX : 0, nr = TT - r0;
    const int rpb = (nr + cx.G - 1) / cx.G;
    const int rb = r0 + cx.bid * rpb, re = min(TT, rb + rpb);
    const float* modp = WSP(float, WS_MOD);
    const int c0 = 2 * cx.lane;
    for (int r2 = rb + cx.wave; r2 < re; r2 += 16) {
        f32x2 x[2][8]; bool ok[2];
#pragma unroll
        for (int u = 0; u < 2; ++u) { const int row = r2 + 8 * u; ok[u] = row < re; const float* src = WSP(float, WS_XMID) + (size_t)(ok[u] ? row : r2) * 1024;
#pragma unroll
            for (int i = 0; i < 8; ++i) x[u][i] = *(const f32x2*)(src + c0 + 128 * i); }
#pragma unroll
        for (int u = 0; u < 2; ++u) {
            const int row = r2 + 8 * u;
            float ss = 0.f;
#pragma unroll
            for (int i = 0; i < 8; ++i) ss += x[u][i].x * x[u][i].x + x[u][i].y * x[u][i].y;
            ss = wave_sum(ss, 0);
            const float rstd = rsqrtf(ss * (1.0f / 1024.0f) + EPS);
            if (!ok[u]) continue;
            const float* md = modp + ((size_t)l * 9 + mod_row(row)) * 6144;
            bf16_t* hp = WSP(bf16_t, WS_H) + (size_t)row * 1024; bf16_t* hl = WSP(bf16_t, WS_HLO) + (size_t)row * 1024;
#pragma unroll
            for (int i = 0; i < 8; ++i) { const int c = c0 + 128 * i;
                const f32x2 nw = *(const f32x2*)(P.in[I_N2W] + l * 1024 + c), sc = *(const f32x2*)(md + 4096 + c), sh = *(const f32x2*)(md + 3072 + c);
                const f32x2 h = x[u][i] * rstd * nw * (sc + 1.0f) + sh;
                const bf16_t h0 = f2bf(h.x), h1 = f2bf(h.y);
                *(unsigned*)(hp + c) = (unsigned)h0 | ((unsigned)h1 << 16);
                *(unsigned*)(hl + c) = pk_bf16(h.x - bf2f(h0), h.y - bf2f(h1)); }
        }
    }
    block_rows_visible();
    const int nrow = re - rb, ntile = (nrow + 15) / 16;
    for (int t2 = cx.wave; t2 < ntile * 2; t2 += 8) {
        const int t = t2 >> 1, nt = t2 & 1, fr = cx.lane & 15, fq = cx.lane >> 4; const int row = min(rb + t * 16 + fr, re - 1);
        const bf16_t* hp = WSP(bf16_t, WS_H) + (size_t)row * 1024 + fq * 8; const bf16_t* hl = WSP(bf16_t, WS_HLO) + (size_t)row * 1024 + fq * 8;
        const bf16_t* wh = WSP(bf16_t, WS_RWH) + ((size_t)l * 32 + nt * 16 + fr) * 1024 + fq * 8; const bf16_t* wl = WSP(bf16_t, WS_RWL) + ((size_t)l * 32 + nt * 16 + fr) * 1024 + fq * 8;
        f32x4 acc = (f32x4){0.f, 0.f, 0.f, 0.f}, acc2 = (f32x4){0.f, 0.f, 0.f, 0.f};
#pragma unroll 8
        for (int k0 = 0; k0 < 1024; k0 += 32) { const bf16x8 ah = ldg8(hp + k0), al = ldg8(hl + k0), bh = ldg8(wh + k0), bl = ldg8(wl + k0);
            acc = __builtin_amdgcn_mfma_f32_16x16x32_bf16(bh, ah, acc, 0, 0, 0);
            acc2 = __builtin_amdgcn_mfma_f32_16x16x32_bf16(bl, ah, acc2, 0, 0, 0);
            acc2 = __builtin_amdgcn_mfma_f32_16x16x32_bf16(bh, al, acc2, 0, 0, 0); }
        const int rl = t * 16 + fr;
        if (rl < nrow) {
#pragma unroll
            for (int j = 0; j < 4; ++j) { const int e = nt * 16 + 4 * fq + j; lgs[rl * 33 + e] = acc[j] + acc2[j] + P.in[I_RB][l * 32 + e]; } }
    }
    __syncthreads();
    if (cx.tid < nrow) {
        const LAS float* lp = lgs + cx.tid * 33;
        float tv[4]; int tix[4]; unsigned taken = 0u;
#pragma unroll
        for (int k = 0; k < 4; ++k) { float bv = -3.0e38f; int bi = 0;
            for (int e = 0; e < 32; ++e) { const float v = lp[e]; const bool better = (v > bv) && !((taken >> e) & 1u); bv = better ? v : bv; bi = better ? e : bi; }
            tv[k] = bv; tix[k] = bi; taken |= 1u << bi; }
        const float e1 = __expf(tv[1] - tv[0]), e2 = __expf(tv[2] - tv[0]), e3 = __expf(tv[3] - tv[0]);
        const float inv = 1.0f / (1.0f + e1 + e2 + e3);
        const float gk[4] = {inv, e1 * inv, e2 * inv, e3 * inv};
#pragma unroll
        for (int k = 0; k < 4; ++k) {
            const int ls = __hip_atomic_fetch_add((LAS int*)(hist + tix[k]), 1, __ATOMIC_RELAXED, __HIP_MEMORY_SCOPE_WORKGROUP);
            pend[(cx.tid * 4 + k) * 2 + 0] = (tix[k] << 20) | ls;
            pend[(cx.tid * 4 + k) * 2 + 1] = __float_as_int(gk[k]); }
    }
    __syncthreads();
    if (cx.tid < 32) { unsigned* cnt = (unsigned*)(cx.ws + WS_CTL) + CW_CNT + l * 32;
        hist[32 + cx.tid] = hist[cx.tid] > 0 ? (int)__hip_atomic_fetch_add(cnt + cx.tid, (unsigned)hist[cx.tid], __ATOMIC_RELAXED, __HIP_MEMORY_SCOPE_AGENT) : 0; }
    __syncthreads();
    for (int i = cx.tid; i < nrow * 4; i += NTHR) {
        const int t = pend[i * 2], e = t >> 20, slot = hist[32 + e] + (t & 0xFFFFF), row = rb + (i >> 2);
        WSP(int, WS_ELIST)[(size_t)e * TT + slot] = row;
        WSP(float, WS_GLIST)[(size_t)e * TT + slot] = __int_as_float(pend[i * 2 + 1]);
        WSP(int, WS_TINFO)[(size_t)row * 4 + (i & 3)] = (e << 20) | slot;
    }
}

DEVI int xcd_contig(int bid, int G) { return (G % 8 == 0) ? (bid % 8) * (G / 8) + bid / 8 : bid; }

struct DenseSched {
    const char* A; const char* B; int nM, nN, pm0, G, bid;
    DEVI bool get(int i, g1::Unit& u) const {
        int pm, pn;
        if (G % 8 == 0) { const int x = bid & 7, r = bid >> 3, nx = G >> 3, lo = (nM * x) >> 3, hi = (nM * (x + 1)) >> 3, nr = hi - lo;
            const int q = i * nx + r; if (nr <= 0 || q >= nr * nN) return false; pm = lo + q % nr; pn = q / nr; }
        else { const int L = i * G + bid; if (L >= nM * nN) return false; pm = L / nN; pn = L % nN; }
        u.A = A + (size_t)(pm0 + pm) * 256 * 2048; u.list = nullptr; u.nvalid = 256; u.B = B + (size_t)pn * 256 * 2048; u.pm = pm0 + pm; u.pn = pn; u.e = 0;
        return true;
    }
};
struct MoeSched {
    const char* A; const char* B; const int* elist; const LAS int* info; int NPN, gather, G, bid; size_t bstride;
    DEVI bool get(int i, g1::Unit& u) const {
        const int NTt = info[32]; int T, pn;
        if (G % 8 == 0 && (G >> 3) % NPN == 0) { const int x = bid & 7, r = bid >> 3, nx = G >> 3, RT = nx / NPN, lo = (NTt * x) >> 3, hi = (NTt * (x + 1)) >> 3;
            T = lo + i * RT + r % RT; pn = r / RT; if (T >= hi) return false; }
        else { const int L = i * G + bid; if (L >= NTt * NPN) return false; T = L / NPN; pn = L % NPN; }
        const int e = info[112 + T], j = T - info[e];
        u.pm = T; u.pn = pn; u.e = e;
        u.B = B + (size_t)e * bstride + (size_t)pn * 256 * 2048;
        if (gather) { u.A = A; u.list = elist + (size_t)e * TT + j * 256; u.nvalid = info[40 + e] - j * 256; }
        else { u.A = A + (size_t)T * 256 * 2048; u.list = nullptr; u.nvalid = 256; }
        return true;
    }
};

struct EpiIn {
    static constexpr bool PERM = true;
    bf16_t* Pout; const float* bias;
    DEVI void operator()(const f32x4 (&acc)[2][2][4][2], const g1::Unit& u, int wr, int wc, int fr, int fq) const {
        const int row0 = u.pm * 256 + wr * 64 + fr;
#pragma unroll
        for (int bj = 0; bj < 2; ++bj) {
            const int col0 = u.pn * 256 + bj * 128 + wc * 32 + 8 * fq;
            const int seg = u.pn * 2 + bj; const bool gl = (seg >= 15 && seg < 18);
            const f32x4 b0 = *(const f32x4*)(bias + col0), b1 = *(const f32x4*)(bias + col0 + 4);
#pragma unroll
            for (int ai = 0; ai < 2; ++ai)
#pragma unroll
                for (int m = 0; m < 4; ++m) {
                    f32x4 v0 = acc[ai][bj][m][0] + b0, v1 = acc[ai][bj][m][1] + b1;
                    if (gl) {
#pragma unroll
                        for (int j = 0; j < 4; ++j) { v0[j] = gelu_tanh(v0[j]); v1[j] = gelu_tanh(v1[j]); } }
                    u32x4 w; w.x = pk_bf16(v0[0], v0[1]); w.y = pk_bf16(v0[2], v0[3]); w.z = pk_bf16(v1[0], v1[1]); w.w = pk_bf16(v1[2], v1[3]);
                    *(u32x4*)(Pout + (size_t)(row0 + ai * 128 + m * 16) * NP + col0) = w;
                }
        }
    }
};
struct EpiOut {
    static constexpr bool PERM = false;
    const float* xs; float* xmid; const float* mod;
    DEVI void operator()(const f32x4 (&acc)[2][2][4][2], const g1::Unit& u, int wr, int wc, int fr, int fq) const {
        const int row0 = u.pm * 256 + wr * 64 + fr;
        const float* g1p = mod + (size_t)mod_row(u.pm * 256) * 6144 + 2048;
#pragma unroll
        for (int bj = 0; bj < 2; ++bj)
#pragma unroll
            for (int n = 0; n < 2; ++n) {
                const int col = u.pn * 256 + bj * 128 + wc * 32 + 16 * n + 4 * fq;
                const f32x4 gv = *(const f32x4*)(g1p + col);
#pragma unroll
                for (int ai = 0; ai < 2; ++ai)
#pragma unroll
                    for (int m = 0; m < 4; ++m) {
                        const size_t off = (size_t)(row0 + ai * 128 + m * 16) * 1024 + col;
                        const f32x4 xv = *(const f32x4*)(xs + off);
                        *(f32x4*)(xmid + off) = xv + gv * acc[ai][bj][m][n];
                    }
            }
    }
};
struct EpiGU {
    static constexpr bool PERM = true;
    bf16_t* act; const float* bgu;
    DEVI void operator()(const f32x4 (&acc)[2][2][4][2], const g1::Unit& u, int wr, int wc, int fr, int fq) const {
        const int row0 = u.pm * 256 + wr * 64 + fr, colh = u.pn * 128 + wc * 32 + 8 * fq;
        const float* bg = bgu + (size_t)u.e * 2048 + colh; const float* bu = bg + 1024;
        const f32x4 bg0 = *(const f32x4*)bg, bg1 = *(const f32x4*)(bg + 4), bu0 = *(const f32x4*)bu, bu1 = *(const f32x4*)(bu + 4);
#pragma unroll
        for (int ai = 0; ai < 2; ++ai)
#pragma unroll
            for (int m = 0; m < 4; ++m) {
                float o[8];
#pragma unroll
                for (int n = 0; n < 2; ++n)
#pragma unroll
                    for (int j = 0; j < 4; ++j) {
                        const float g = fminf(acc[ai][0][m][n][j] + (n ? bg1[j] : bg0[j]), 7.0f);
                        const float up = fminf(fmaxf(acc[ai][1][m][n][j] + (n ? bu1[j] : bu0[j]), -7.0f), 7.0f);
                        o[n * 4 + j] = (up + 1.0f) * g * frcp(1.0f + __expf(-1.702f * g));
                    }
                u32x4 w; w.x = pk_bf16(o[0], o[1]); w.y = pk_bf16(o[2], o[3]); w.z = pk_bf16(o[4], o[5]); w.w = pk_bf16(o[6], o[7]);
                *(u32x4*)(act + (size_t)(row0 + ai * 128 + m * 16) * 1024 + colh) = w;
            }
    }
};
struct EpiDown {
    static constexpr bool PERM = true;
    bf16_t* ypad; const float* bd; const float* glist; const LAS int* info;
    DEVI void operator()(const f32x4 (&acc)[2][2][4][2], const g1::Unit& u, int wr, int wc, int fr, int fq) const {
        const int j256 = (u.pm - info[u.e]) * 256, cnt = info[40 + u.e];
        const int rl0 = wr * 64 + fr;
#pragma unroll
        for (int ai = 0; ai < 2; ++ai)
#pragma unroll
            for (int m = 0; m < 4; ++m) {
                const int rl = rl0 + ai * 128 + m * 16, slot = j256 + rl;
                const float gt = slot < cnt ? glist[(size_t)u.e * TT + slot] : 0.f;
#pragma unroll
                for (int bj = 0; bj < 2; ++bj) {
                    const int col0 = u.pn * 256 + bj * 128 + wc * 32 + 8 * fq;
                    const f32x4 b0 = *(const f32x4*)(bd + (size_t)u.e * 1024 + col0), b1 = *(const f32x4*)(bd + (size_t)u.e * 1024 + col0 + 4);
                    const f32x4 v0 = (acc[ai][bj][m][0] + b0) * gt, v1 = (acc[ai][bj][m][1] + b1) * gt;
                    u32x4 w; w.x = pk_bf16(v0[0], v0[1]); w.y = pk_bf16(v0[2], v0[3]); w.z = pk_bf16(v1[0], v1[1]); w.w = pk_bf16(v1[2], v1[3]);
                    *(u32x4*)(ypad + (size_t)(u.pm * 256 + rl) * 1024 + col0) = w;
                }
            }
    }
};

DEVI void ph_inproj(const Ctx& cx, int l) {
    DenseSched S{(const char*)WSP(bf16_t, WS_H), (const char*)(WSP(bf16_t, WS_WIN) + (size_t)l * NP * 1024), TT / 256, NP / 256, 0, cx.G, cx.bid};
    EpiIn E{WSP(bf16_t, WS_P), WSP(float, WS_BIN2) + (size_t)l * NP};
    g1::gemm_phase<DenseSched, EpiIn, false>(cx.lds, cx.tid, S, E);
}
DEVI void ph_outproj(const Ctx& cx, int l) {
    const int pm0 = (l == DEPTH - 1) ? TCTX / 256 : 0;
    DenseSched S{(const char*)WSP(bf16_t, WS_MRG), (const char*)(WSP(bf16_t, WS_WOUT) + (size_t)l * 1024 * 1024), TT / 256 - pm0, 4, pm0, cx.G, cx.bid};
    EpiOut E{WSP(float, WS_XS), WSP(float, WS_XMID), WSP(float, WS_MOD) + (size_t)l * 9 * 6144};
    g1::gemm_phase<DenseSched, EpiOut, false>(cx.lds, cx.tid, S, E);
}
DEVI void ph_moe_gu(const Ctx& cx, int l) {
    LAS int* info = (LAS int*)(cx.lds + g1::STAGE_BYTES);
    moe_info(cx, l, info);
    MoeSched S{(const char*)WSP(bf16_t, WS_H), (const char*)(WSP(bf16_t, WS_WGU) + (size_t)l * NE * 2048 * 1024), WSP(int, WS_ELIST), info, 8, 1, cx.G, cx.bid, (size_t)2048 * 1024 * 2};
    EpiGU E{WSP(bf16_t, WS_ACT), cx.p->in[I_BGU] + (size_t)l * NE * 2048};
    g1::gemm_phase<MoeSched, EpiGU, true>(cx.lds, cx.tid, S, E);
}
DEVI void ph_moe_dn(const Ctx& cx, int l) {
    LAS int* info = (LAS int*)(cx.lds + g1::STAGE_BYTES);
    moe_info(cx, l, info);
    MoeSched S{(const char*)WSP(bf16_t, WS_ACT), (const char*)(WSP(bf16_t, WS_WD) + (size_t)l * NE * 1024 * 1024), nullptr, info, 4, 0, cx.G, cx.bid, (size_t)1024 * 1024 * 2};
    EpiDown E{WSP(bf16_t, WS_YPAD), cx.p->in[I_BD] + (size_t)l * NE * 1024, WSP(float, WS_GLIST), info};
    g1::gemm_phase<MoeSched, EpiDown, false>(cx.lds, cx.tid, S, E);
}

DEVI int ml_row0(int b, int c) { return c < 2 ? b * CTXL + c * 128 : TCTX + b * SEQ + (c - 2) * 128; }
DEVI unsigned short lds_u16(const LAS bf16_t* p) { return *p; }

DEVI void ml_local_unit(const Ctx& cx, int l, int b, int h, int c) {
    LAS float* sg = (LAS float*)cx.lds;
    LAS float* se = sg + 256;
    LAS float* red = se + 256;
    LAS bf16_t* Ks = (LAS bf16_t*)(cx.lds + 4352);
    LAS bf16_t* Ve = Ks + 128 * 104;
    const int row0 = ml_row0(b, c), tid = cx.tid;
    const int dir = (tid >> 7) & 1, i = tid & 127, p = dir ? 127 - i : i;
    const bool act = tid < 256;
    float gi = 0.f, bval = 0.f, u = 0.f;
    if (act) { const float* gt = WSP(float, WS_GT) + (size_t)(row0 + i) * 16; gi = gt[dir * 4 + h]; const float gf = gt[8 + dir * 4 + h];
        sg[dir * 128 + p] = fminf(gf, 0.f) - log1p_(__expf(-fabsf(gf))); }
    LDS_SYNC();
#pragma unroll 1
    for (int off = 1; off < 128; off <<= 1) { float v = 0.f; if (act) { v = sg[dir * 128 + p]; if (p >= off) v += sg[dir * 128 + p - off]; } LDS_SYNC(); if (act) sg[dir * 128 + p] = v; LDS_SYNC(); }
    if (act) { bval = sg[dir * 128 + p]; u = gi - bval; if (p == 127) red[dir] = bval; }
    LDS_SYNC();
    if (act) sg[dir * 128 + p] = u;
    LDS_SYNC();
#pragma unroll 1
    for (int off = 1; off < 128; off <<= 1) { float v = 0.f; if (act) { v = sg[dir * 128 + p]; if (p >= off) v = fmaxf(v, sg[dir * 128 + p - off]); } LDS_SYNC(); if (act) sg[dir * 128 + p] = v; LDS_SYNC(); }
    if (act) { const float cm = sg[dir * 128 + p]; if (p == 127) red[2 + dir] = cm;
        const size_t gix = (size_t)(row0 + i) * 8 + dir * 4 + h;
        WSP(float, WS_GB)[gix] = bval; WSP(float, WS_GU)[gix] = u; WSP(float, WS_GCM)[gix] = cm; }
    LDS_SYNC();
    if (act) se[dir * 128 + i] = expf(u - red[2 + dir]);
    if (tid < 2) { float* msc = WSP(float, WS_MSC) + ((size_t)((b * 4 + h) * MLC + c) * 2 + tid) * 2; msc[0] = red[tid]; msc[1] = red[tid] + red[2 + tid]; }
    LDS_SYNC();
    const bf16_t* Pp = WSP(bf16_t, WS_P);
#pragma unroll
    for (int it = 0; it < 3; ++it) { const int idx = tid + NTHR * it, r = idx / 12, ch = idx % 12;
        const u32x4 kv = *(const u32x4*)(Pp + (size_t)(row0 + r) * NP + PC_K + h * 96 + ch * 8);
        *(LAS u32x4*)(Ks + r * 104 + ch * 8) = kv;
        const u32x4 vv = *(const u32x4*)(Pp + (size_t)(row0 + r) * NP + PC_V + h * 96 + ch * 8);
        const float e0 = se[r], e1 = se[128 + r];
        u32x4 o0, o1;
#pragma unroll
        for (int q = 0; q < 4; ++q) { const float lo = __uint_as_float(vv[q] << 16), hi = __uint_as_float(vv[q] & 0xFFFF0000u);
            o0[q] = pk_bf16(lo * e0, hi * e0); o1[q] = pk_bf16(lo * e1, hi * e1); }
        *(LAS u32x4*)(Ve + r * 104 + ch * 8) = o0; *(LAS u32x4*)(Ve + (128 + r) * 104 + ch * 8) = o1; }
    LDS_SYNC();
    {
        const int wd = cx.wave >> 2, q9 = (cx.wave & 3) * 9, fr = cx.lane & 15, fq = cx.lane >> 4;
        float* cl = WSP(float, WS_CLOC) + ((size_t)((b * 4 + h) * MLC + c) * 2 + wd) * 9216;
        const LAS bf16_t* V = Ve + wd * 128 * 104;
#pragma unroll 1
        for (int pi = q9; pi < q9 + 9; ++pi) { const int dt = pi / 6, et = pi % 6;
            f32x4 acc = (f32x4){0.f, 0.f, 0.f, 0.f};
#pragma unroll
            for (int kk = 0; kk < 4; ++kk) { bf16x8 a, bb;
#pragma unroll
                for (int j = 0; j < 8; ++j) { const int s = kk * 32 + fq * 8 + j; a[j] = (short)lds_u16(V + s * 104 + dt * 16 + fr); bb[j] = (short)lds_u16(Ks + s * 104 + et * 16 + fr); }
                acc = __builtin_amdgcn_mfma_f32_16x16x32_bf16(a, bb, acc, 0, 0, 0); }
#pragma unroll
            for (int r = 0; r < 4; ++r) cl[(dt * 16 + fq * 4 + r) * 96 + et * 16 + fr] = acc[r]; }
    }
    if (tid < 192) { const int d2 = tid / 96, e = tid % 96; float s = 0.f;
        for (int t = 0; t < 128; ++t) s += se[d2 * 128 + t] * bf2f(Ks[t * 104 + e]);
        WSP(float, WS_NLOC)[((size_t)((b * 4 + h) * MLC + c) * 2 + d2) * 96 + e] = s; }
    LDS_SYNC();
}

DEVI void ml_carry(const Ctx& cx) {
    for (int idx = cx.bid * NTHR + cx.tid; idx < 64 * 9312; idx += cx.G * NTHR) {
        const int combo = idx / 9312, el = idx % 9312, dir = combo & 1, bh = combo >> 1;
        float loc[MLC], bl[MLC], ml[MLC];
#pragma unroll
        for (int s = 0; s < MLC; ++s) {
            const int c = dir == 0 ? s : (s < 2 ? 1 - s : 19 - s);
            const size_t cb = (size_t)(bh * MLC + c) * 2 + dir;
            bl[s] = WSP(float, WS_MSC)[cb * 2]; ml[s] = WSP(float, WS_MSC)[cb * 2 + 1];
            loc[s] = el < 9216 ? WSP(float, WS_CLOC)[cb * 9216 + el] : WSP(float, WS_NLOC)[cb * 96 + el - 9216];
        }
        float Cv = 0.f, m = -1e30f;
#pragma unroll
        for (int s = 0; s < MLC; ++s) {
            const int c = dir == 0 ? s : (s < 2 ? 1 - s : 19 - s);
            const size_t cb = (size_t)(bh * MLC + c) * 2 + dir;
            if (el < 9216) WSP(bf16_t, WS_C0)[cb * 9216 + el] = f2bf(Cv); else WSP(float, WS_N0)[cb * 96 + el - 9216] = Cv;
            if (el == 0) WSP(float, WS_M0)[cb] = m;
            const float mn = fmaxf(bl[s] + m, ml[s]), a = __expf(bl[s] + m - mn), sc = __expf(ml[s] - mn);
            Cv = a * Cv + sc * loc[s]; m = mn;
        }
    }
}

DEVI void ml_out_unit(const Ctx& cx, int l, int b, int h, int c) {
    LAS bf16_t* Qs = (LAS bf16_t*)cx.lds;
    LAS bf16_t* Ks = Qs + 128 * 104;
    LAS bf16_t* Vs = Ks + 128 * 104;
    LAS bf16_t* C0s = Vs + 128 * 104;
    LAS float* gb = (LAS float*)(cx.lds + 119808);
    LAS float* gu = gb + 256;
    LAS float* gM = gu + 256;
    LAS float* n0s = gM + 256;
    LAS float* m0s = n0s + 192;
    const int row0 = ml_row0(b, c), tid = cx.tid;
    const bf16_t* Pp = WSP(bf16_t, WS_P);
    const size_t cb0 = (size_t)((b * 4 + h) * MLC + c) * 2;
#pragma unroll
    for (int it = 0; it < 3; ++it) { const int idx = tid + NTHR * it, r = idx / 12, ch = idx % 12;
        const bf16_t* rp = Pp + (size_t)(row0 + r) * NP + h * 96 + ch * 8;
        *(LAS u32x4*)(Qs + r * 104 + ch * 8) = *(const u32x4*)(rp + PC_Q);
        *(LAS u32x4*)(Ks + r * 104 + ch * 8) = *(const u32x4*)(rp + PC_K);
        *(LAS u32x4*)(Vs + r * 104 + ch * 8) = *(const u32x4*)(rp + PC_V); }
    for (int idx = tid; idx < 2 * 96 * 12; idx += NTHR) { const int d2 = idx / 1152, r = (idx % 1152) / 12, ch = idx % 12;
        *(LAS u32x4*)(C0s + (d2 * 96 + r) * 104 + ch * 8) = *(const u32x4*)(WSP(bf16_t, WS_C0) + (cb0 + d2) * 9216 + r * 96 + ch * 8); }
    if (tid < 256) { const int d2 = tid >> 7, i = tid & 127; const size_t gix = (size_t)(row0 + i) * 8 + d2 * 4 + h;
        gb[tid] = WSP(float, WS_GB)[gix]; gu[tid] = WSP(float, WS_GU)[gix];
        gM[tid] = fmaxf(WSP(float, WS_M0)[cb0 + d2], WSP(float, WS_GCM)[gix]); }
    if (tid >= 256 && tid < 448) { const int k = tid - 256; n0s[k] = WSP(float, WS_N0)[(cb0 + k / 96) * 96 + k % 96]; }
    if (tid >= 448 && tid < 450) m0s[tid - 448] = WSP(float, WS_M0)[cb0 + tid - 448];
    LDS_SYNC();
    const int w = cx.wave, fr = cx.lane & 15, fq = cx.lane >> 4, t = 16 * w + fr;
    bf16x8 qf[3];
#pragma unroll
    for (int kk = 0; kk < 3; ++kk) qf[kk] = *(const LAS bf16x8*)(Qs + t * 104 + kk * 32 + fq * 8);
    f32x4 hs[6];
#pragma unroll
    for (int n = 0; n < 6; ++n) hs[n] = (f32x4){0.f, 0.f, 0.f, 0.f};
#pragma unroll
    for (int dir = 0; dir < 2; ++dir) {
        const float Mt = gM[dir * 128 + t], bt = gb[dir * 128 + t], inter = __expf(m0s[dir] - Mt);
        f32x4 an[6];
#pragma unroll
        for (int n = 0; n < 6; ++n) an[n] = (f32x4){0.f, 0.f, 0.f, 0.f};
        float den = 0.f;
        const int Jlo = dir == 0 ? 0 : (w >> 1), Jhi = dir == 0 ? (w >> 1) : 3;
#pragma unroll 1
        for (int J = Jlo; J <= Jhi; ++J) {
            bf16x8 pf;
#pragma unroll
            for (int half = 0; half < 2; ++half) {
                const int j = 2 * J + half;
                f32x4 D = (f32x4){0.f, 0.f, 0.f, 0.f};
                const bool need = dir == 0 ? (j <= w) : (j >= w);
                if (need) {
#pragma unroll
                    for (int kk = 0; kk < 3; ++kk) { const bf16x8 kf = *(const LAS bf16x8*)(Ks + (16 * j + fr) * 104 + kk * 32 + fq * 8);
                        D = __builtin_amdgcn_mfma_f32_16x16x32_bf16(kf, qf[kk], D, 0, 0, 0); }
                }
                const f32x4 us = *(const LAS f32x4*)(gu + dir * 128 + 16 * j + 4 * fq);
                float pv[4];
#pragma unroll
                for (int r = 0; r < 4; ++r) { const int s = 16 * j + 4 * fq + r; const bool valid = need && (dir == 0 ? (s <= t) : (s >= t));
                    pv[r] = valid ? D[r] * __expf(us[r] - Mt) : 0.f; den += pv[r]; }
                pf[half * 4 + 0] = (short)f2bf(pv[0]); pf[half * 4 + 1] = (short)f2bf(pv[1]); pf[half * 4 + 2] = (short)f2bf(pv[2]); pf[half * 4 + 3] = (short)f2bf(pv[3]);
            }
#pragma unroll
            for (int n = 0; n < 6; ++n) { bf16x8 vf;
#pragma unroll
                for (int jj = 0; jj < 8; ++jj) { const int s = 32 * J + (jj < 4 ? 4 * fq + jj : 16 + 4 * fq + (jj - 4)); vf[jj] = (short)lds_u16(Vs + s * 104 + 16 * n + fr); }
                an[n] = __builtin_amdgcn_mfma_f32_16x16x32_bf16(vf, pf, an[n], 0, 0, 0); }
        }
        float nq = 0.f;
#pragma unroll
        for (int kk = 0; kk < 3; ++kk)
#pragma unroll
            for (int j = 0; j < 8; ++j) nq += n0s[dir * 96 + kk * 32 + fq * 8 + j] * bf2f((bf16_t)qf[kk][j]);
        nq += shx<16>(nq, cx.lane); nq += shx<32>(nq, cx.lane);
        den += shx<16>(den, cx.lane); den += shx<32>(den, cx.lane);
        const float dtot = den + inter * nq;
        const float inv = frcp(fmaxf(fabsf(dtot), __expf(-(Mt + bt))));
#pragma unroll
        for (int n = 0; n < 6; ++n) { f32x4 ac = (f32x4){0.f, 0.f, 0.f, 0.f};
#pragma unroll
            for (int kk = 0; kk < 3; ++kk) { const bf16x8 cf = *(const LAS bf16x8*)(C0s + (dir * 96 + 16 * n + fr) * 104 + kk * 32 + fq * 8);
                ac = __builtin_amdgcn_mfma_f32_16x16x32_bf16(cf, qf[kk], ac, 0, 0, 0); }
            hs[n] += (an[n] + ac * inter) * inv; }
    }
    float ss = 0.f;
#pragma unroll
    for (int n = 0; n < 6; ++n) ss += hs[n][0] * hs[n][0] + hs[n][1] * hs[n][1] + hs[n][2] * hs[n][2] + hs[n][3] * hs[n][3];
    ss += shx<16>(ss, cx.lane); ss += shx<32>(ss, cx.lane);
    const float rstd = rsqrtf(ss * (1.0f / 96.0f) + EPS);
    const size_t prow = (size_t)(row0 + t);
#pragma unroll
    for (int n = 0; n < 6; ++n) { const int d = 16 * n + 4 * fq;
        const u32x2 ov = *(const u32x2*)(Pp + prow * NP + PC_O + h * 96 + d);
        const f32x4 mw = *(const f32x4*)(cx.p->in[I_MIXW] + l * 1024 + h * 96 + d);
        const float o0 = __uint_as_float(ov.x << 16), o1 = __uint_as_float(ov.x & 0xFFFF0000u), o2 = __uint_as_float(ov.y << 16), o3 = __uint_as_float(ov.y & 0xFFFF0000u);
        u32x2 wv; wv.x = pk_bf16(sigmoidf_(o0) * hs[n][0] * rstd * mw[0], sigmoidf_(o1) * hs[n][1] * rstd * mw[1]);
        wv.y = pk_bf16(sigmoidf_(o2) * hs[n][2] * rstd * mw[2], sigmoidf_(o3) * hs[n][3] * rstd * mw[3]);
        *(u32x2*)(WSP(bf16_t, WS_MRG) + prow * 1024 + h * 96 + d) = wv; }
    LDS_SYNC();
}

DEVI void rg_unit(const Ctx& cx, int l, int b, int ck, int g, int mode) {
    const Params& P = *cx.p;
    LAS float* xraw = (LAS float*)cx.lds;
    LAS float* xc = (LAS float*)(cx.lds + 17408);
    LAS bf16_t* xcb = (LAS bf16_t*)(cx.lds + 33792);
    LAS float* ab = (LAS float*)(cx.lds + 43008);
    const int tid = cx.tid;
    const int t0 = ck < 4 ? ck * 64 : (ck - 4) * 64, seglen = ck < 4 ? CTXL : SEQ, rowbase = ck < 4 ? b * CTXL : TCTX + b * SEQ;
    const bf16_t* Pp = WSP(bf16_t, WS_P);
    for (int idx = tid; idx < 67 * 8; idx += NTHR) { const int r = idx >> 3, c8 = idx & 7, tt = t0 - 2 + r;
        u32x4 v = (u32x4){0u, 0u, 0u, 0u};
        if (tt >= 0 && tt < seglen) v = *(const u32x4*)(Pp + (size_t)(rowbase + tt) * NP + PC_RX + g * 64 + c8 * 8);
#pragma unroll
        for (int q = 0; q < 4; ++q) { xraw[r * 64 + c8 * 8 + 2 * q] = __uint_as_float(v[q] << 16); xraw[r * 64 + c8 * 8 + 2 * q + 1] = __uint_as_float(v[q] & 0xFFFF0000u); } }
    LDS_SYNC();
#pragma unroll
    for (int it = 0; it < 8; ++it) { const int idx = tid + NTHR * it, t = idx >> 6, ch = idx & 63, cg = g * 64 + ch;
        float v = P.in[I_RGCB][l * 384 + cg];
#pragma unroll
        for (int j = 0; j < 4; ++j) v += P.in[I_RGCW][(l * 4 + j) * 384 + cg] * xraw[(t + j) * 64 + ch];
        xc[t * 64 + ch] = v; xcb[t * 72 + ch] = f2bf(v); }
    LDS_SYNC();
    {
        const int dir = cx.wave >> 2, cg4 = cx.wave & 3, fr = cx.lane & 15, fq = cx.lane >> 4;
        const bf16_t* wrg = WSP(bf16_t, WS_WRG) + (size_t)(l * 6 + g) * 256 * 64;
        f32x4 ar[4], ai[4];
#pragma unroll
        for (int m = 0; m < 4; ++m) { ar[m] = (f32x4){0.f, 0.f, 0.f, 0.f}; ai[m] = (f32x4){0.f, 0.f, 0.f, 0.f}; }
#pragma unroll
        for (int kk = 0; kk < 2; ++kk) {
            const bf16x8 br = ldg8(wrg + (size_t)((dir * 2 + 0) * 64 + cg4 * 16 + fr) * 64 + kk * 32 + fq * 8);
            const bf16x8 bi = ldg8(wrg + (size_t)((dir * 2 + 1) * 64 + cg4 * 16 + fr) * 64 + kk * 32 + fq * 8);
#pragma unroll
            for (int m = 0; m < 4; ++m) { const bf16x8 a = *(const LAS bf16x8*)(xcb + (m * 16 + fr) * 72 + kk * 32 + fq * 8);
                ar[m] = __builtin_amdgcn_mfma_f32_16x16x32_bf16(br, a, ar[m], 0, 0, 0); ai[m] = __builtin_amdgcn_mfma_f32_16x16x32_bf16(bi, a, ai[m], 0, 0, 0); }
        }
        const int ch0 = cg4 * 16 + 4 * fq, cgl = g * 64 + ch0;
        const f32x4 ba = *(const f32x4*)(P.in[I_RGBA] + (l * 2 + dir) * 384 + cgl), bx = *(const f32x4*)(P.in[I_RGBX] + (l * 2 + dir) * 384 + cgl);
        const f32x4 lam = *(const f32x4*)(P.in[I_RGLAM] + (l * 2 + dir) * 384 + cgl);
        float sp[4];
#pragma unroll
        for (int j = 0; j < 4; ++j) sp[j] = lam[j] > 0.f ? log1p_(__expf(-lam[j])) : -lam[j] + log1p_(__expf(lam[j]));
#pragma unroll
        for (int m = 0; m < 4; ++m) { const int t = m * 16 + fr; const f32x4 xv = *(const LAS f32x4*)(xc + t * 64 + ch0);
            f32x4 av, bv;
#pragma unroll
            for (int j = 0; j < 4; ++j) { const float r = frcp(1.0f + __expf(-(ar[m][j] + ba[j]))), ii = frcp(1.0f + __expf(-(ai[m][j] + bx[j])));
                const float la = -8.0f * r * sp[j], y = 2.0f * la; av[j] = __expf(la);
                const float nem1 = y > -0.3f ? -y * (1.0f + y * (0.5f + y * (0.16666667f + y * (0.041666668f + y * 0.0083333338f)))) : 1.0f - __expf(y);
                bv[j] = sqrtf(nem1) * (ii * xv[j]); }
            *(LAS f32x4*)(ab + ((dir * 2 + 0) * 64 + t) * 64 + ch0) = av; *(LAS f32x4*)(ab + ((dir * 2 + 1) * 64 + t) * 64 + ch0) = bv; }
    }
    LDS_SYNC();
    if (tid < 128) { const int dir = tid >> 6, ch = tid & 63; const size_t ix = ((size_t)(b * RGC + ck) * 2 + dir) * 384 + g * 64 + ch;
        float hc = mode ? WSP(float, WS_RGC)[ix] : 0.f, ap = 1.0f;
        LAS float* A = ab + (dir * 2 + 0) * 4096 + ch; LAS float* B = ab + (dir * 2 + 1) * 4096 + ch;
#pragma unroll 8
        for (int s = 0; s < 64; ++s) { const int t = dir ? 63 - s : s; const float a = A[t * 64]; hc = a * hc + B[t * 64]; ap *= a; if (mode) B[t * 64] = hc; }
        if (!mode) { WSP(float, WS_RGA)[ix] = ap; WSP(float, WS_RGB)[ix] = hc; } }
    LDS_SYNC();
    if (mode) { const int t = tid >> 3, ch0 = (tid & 7) * 8; float hv[8]; float ss = 0.f;
#pragma unroll
        for (int j = 0; j < 8; ++j) { hv[j] = ab[(1 * 64 + t) * 64 + ch0 + j] + ab[(3 * 64 + t) * 64 + ch0 + j]; ss += hv[j] * hv[j]; }
        ss += dpp_<0xB1, 0xF>(ss); ss += dpp_<0x4E, 0xF>(ss); ss += dpp_<0x141, 0xF>(ss);
        const float rstd = rsqrtf(ss * (1.0f / 64.0f) + EPS);
        const size_t row = (size_t)(rowbase + t0 + t);
        const u32x4 gv = *(const u32x4*)(Pp + row * NP + PC_RG + g * 64 + ch0);
        const float* mw = P.in[I_MIXW] + l * 1024 + 384 + g * 64 + ch0;
        u32x4 o;
#pragma unroll
        for (int q = 0; q < 4; ++q) { const float g0 = __uint_as_float(gv[q] << 16), g1v = __uint_as_float(gv[q] & 0xFFFF0000u);
            o[q] = pk_bf16(g0 * hv[2 * q] * rstd * mw[2 * q], g1v * hv[2 * q + 1] * rstd * mw[2 * q + 1]); }
        *(u32x4*)(WSP(bf16_t, WS_MRG) + row * 1024 + 384 + g * 64 + ch0) = o;
        LDS_SYNC(); }
}
DEVI void rg_carry(const Ctx& cx) {
    for (int idx = (cx.G - 1 - cx.bid) * NTHR + cx.tid; idx < NB * 2 * 384; idx += cx.G * NTHR) {
        const int ch = idx % 384, dir = (idx / 384) & 1, b = idx / 768;
        float A[RGC], B[RGC];
#pragma unroll
        for (int s = 0; s < RGC; ++s) { const int ck = dir == 0 ? s : (s < 4 ? 3 - s : 39 - s);
            const size_t ix = ((size_t)(b * RGC + ck) * 2 + dir) * 384 + ch; A[s] = WSP(float, WS_RGA)[ix]; B[s] = WSP(float, WS_RGB)[ix]; }
        float h = 0.f;
#pragma unroll
        for (int s = 0; s < RGC; ++s) { const int ck = dir == 0 ? s : (s < 4 ? 3 - s : 39 - s);
            const size_t ix = ((size_t)(b * RGC + ck) * 2 + dir) * 384 + ch; WSP(float, WS_RGC)[ix] = h; h = A[s] * h + B[s]; }
    }
}

DEVI int s5_trow(int rowi, int s) { const int b = rowi / S5C, c = rowi % S5C; return c < 8 ? b * CTXL + c * 32 + s : TCTX + b * SEQ + s * 64 + (c - 8); }
DEVI void s5_local_wave(const Ctx& cx, int l, int wu) {
    const int g = wu / 36, mt = (wu % 36) / 4, nt = wu % 4;
    const bf16_t* Pp = WSP(bf16_t, WS_P) + PC_S5 + g * 16;
    const bf16_t* we = WSP(bf16_t, WS_WE) + (size_t)(l * 16 + g) * 256 * 512 + (size_t)nt * 64 * 512;
    f32x4 acc[4][4];
    wave_gemm<4, 4>(cx.lane, 512, [&](int row, int k) { return ldg8(Pp + (size_t)s5_trow(mt * 64 + row, k >> 4) * NP + (k & 15)); },
                         [&](int row, int k) { return ldg8(we + (size_t)row * 512 + k); }, acc);
    const int fr = cx.lane & 15, fq = cx.lane >> 4;
#pragma unroll
    for (int m = 0; m < 4; ++m)
#pragma unroll
        for (int n = 0; n < 4; ++n) *(f32x4*)(WSP(float, WS_SLOC) + ((size_t)g * S5R + mt * 64 + m * 16 + fr) * 256 + nt * 64 + n * 16 + 4 * fq) = acc[m][n];
}
DEVI void s5_carry(const Ctx& cx, int l) {
    for (int idx = cx.bid * NTHR + cx.tid; idx < NB * 16 * 2 * 64; idx += cx.G * NTHR) {
        const int n = idx & 63, d = (idx >> 6) & 1, g = (idx >> 7) & 15, b = idx >> 11;
        const f32x2 a32 = WSP(f32x2, WS_PW)[(size_t)(((l * 16 + g) * 2 + d) * 64 + n) * 33 + 32];
        float sr = 0.f, si = 0.f;
#pragma unroll 1
        for (int s0 = 0; s0 < S5C; s0 += 24) {
            float lr[24], li[24];
#pragma unroll
            for (int j = 0; j < 24; ++j) { const int s = s0 + j, c = d == 0 ? s : (s < 8 ? 7 - s : 79 - s);
                const size_t ix = ((size_t)g * S5R + b * S5C + c) * 256 + d * 128 + n; lr[j] = WSP(float, WS_SLOC)[ix]; li[j] = WSP(float, WS_SLOC)[ix + 64]; }
#pragma unroll
            for (int j = 0; j < 24; ++j) { const int s = s0 + j, c = d == 0 ? s : (s < 8 ? 7 - s : 79 - s);
                const size_t ix = ((size_t)g * S5R + b * S5C + c) * 256 + d * 128 + n;
                WSP(bf16_t, WS_SIN)[ix] = f2bf(sr); WSP(bf16_t, WS_SIN)[ix + 64] = f2bf(si);
                const float nr = a32.x * sr - a32.y * si + lr[j], ni = a32.x * si + a32.y * sr + li[j]; sr = nr; si = ni; }
        }
    }
}
DEVI void s5_out_wave(const Ctx& cx, int l, int wu) {
    const int g = wu / 72, mt = (wu % 72) / 8, nt = wu % 8;
    const bf16_t* Pp = WSP(bf16_t, WS_P) + PC_S5 + g * 16;
    const bf16_t* sin_ = WSP(bf16_t, WS_SIN) + (size_t)g * S5R * 256;
    const bf16_t* wy = WSP(bf16_t, WS_WY) + (size_t)(l * 16 + g) * 512 * 768 + (size_t)nt * 64 * 768;
    f32x4 acc[4][4];
    wave_gemm<4, 4>(cx.lane, 768, [&](int row, int k) { return k < 512 ? ldg8(Pp + (size_t)s5_trow(mt * 64 + row, k >> 4) * NP + (k & 15)) : ldg8(sin_ + (size_t)(mt * 64 + row) * 256 + (k - 512)); },
                         [&](int row, int k) { return ldg8(wy + (size_t)row * 768 + k); }, acc);
    const int fr = cx.lane & 15, fq = cx.lane >> 4;
#pragma unroll
    for (int m = 0; m < 4; ++m)
#pragma unroll
        for (int n = 0; n < 4; ++n) { const int trow = s5_trow(mt * 64 + m * 16 + fr, nt * 4 + n);
            u32x2 w; w.x = pk_bf16(gelu_tanh(acc[m][n][0]), gelu_tanh(acc[m][n][1])); w.y = pk_bf16(gelu_tanh(acc[m][n][2]), gelu_tanh(acc[m][n][3]));
            *(u32x2*)(WSP(bf16_t, WS_GS) + (size_t)trow * 256 + g * 16 + 4 * fq) = w; }
}
DEVI void s5_glu_wave(const Ctx& cx, int l, int wu) {
    const int mt = wu / 4, nt = wu % 4;
    const bf16_t* gs = WSP(bf16_t, WS_GS) + (size_t)mt * 64 * 256;
    const bf16_t* wg = WSP(bf16_t, WS_WGLU) + (size_t)l * 65536 + (size_t)nt * 64 * 256;
    f32x4 acc[4][4];
    wave_gemm<4, 4>(cx.lane, 256, [&](int row, int k) { return ldg8(gs + (size_t)row * 256 + k); }, [&](int row, int k) { return ldg8(wg + (size_t)row * 256 + k); }, acc);
    const int fr = cx.lane & 15, fq = cx.lane >> 4;
#pragma unroll
    for (int n = 0; n < 4; ++n) { const int col = nt * 64 + n * 16 + 4 * fq;
        const f32x4 gb = *(const f32x4*)(cx.p->in[I_S5GB] + l * 256 + col), mw = *(const f32x4*)(cx.p->in[I_MIXW] + l * 1024 + 768 + col);
#pragma unroll
        for (int m = 0; m < 4; ++m) { const size_t trow = (size_t)mt * 64 + m * 16 + fr;
            const u32x2 gv = *(const u32x2*)(WSP(bf16_t, WS_GS) + trow * 256 + col);
            const float gq[4] = {__uint_as_float(gv.x << 16), __uint_as_float(gv.x & 0xFFFF0000u), __uint_as_float(gv.y << 16), __uint_as_float(gv.y & 0xFFFF0000u)};
            float o[4]; float ss = 0.f;
#pragma unroll
            for (int j = 0; j < 4; ++j) { o[j] = gq[j] * frcp(1.0f + __expf(-(acc[m][n][j] + gb[j]))); ss += o[j] * o[j]; }
            ss += shx<16>(ss, cx.lane); ss += shx<32>(ss, cx.lane);
            const float rstd = rsqrtf(ss * (1.0f / 16.0f) + EPS);
            u32x2 w; w.x = pk_bf16(o[0] * rstd * mw[0], o[1] * rstd * mw[1]); w.y = pk_bf16(o[2] * rstd * mw[2], o[3] * rstd * mw[3]);
            *(u32x2*)(WSP(bf16_t, WS_MRG) + trow * 1024 + 768 + col) = w; } }
}

#ifndef PH_DUP2
#define PH_DUP2 0
#endif
#define REP_(k) for (int rep_ = 0; rep_ < 1 + ((PH_DUP2 >> (k)) & 1); ++rep_)
DEVI void ph_mix_local(const Ctx& cx, int l) {
    REP_(0) for (int u = cx.bid; u < NB * 4 * MLC; u += cx.G) ml_local_unit(cx, l, u / (4 * MLC), (u / MLC) % 4, u % MLC);
    REP_(1) { const int off = (NB * 4 * MLC) % cx.G; const int first = (cx.bid - off + cx.G) % cx.G;
      for (int u = first; u < NB * RGC * 6; u += cx.G) rg_unit(cx, l, u / (RGC * 6), (u / 6) % RGC, u % 6, 0); }
    REP_(2) { const int off = (NB * 4 * MLC + NB * RGC * 6) % cx.G; const int first = (cx.bid - off + cx.G) % cx.G;
      for (int wu = first * 8 + cx.wave; wu < 16 * 36; wu += cx.G * 8) s5_local_wave(cx, l, wu); }
}
DEVI void ph_mix_carry(const Ctx& cx, int l) { ml_carry(cx); rg_carry(cx); s5_carry(cx, l); }
DEVI void ph_mix_out(const Ctx& cx, int l) {
    const bool last = (l == DEPTH - 1);
    REP_(3) for (int u = cx.bid; u < NB * 4 * MLC; u += cx.G) { const int c = u % MLC; if (last && c < 2) continue; ml_out_unit(cx, l, u / (4 * MLC), (u / MLC) % 4, c); }
    REP_(4) { const int off = (NB * 4 * MLC) % cx.G; const int first = (cx.bid - off + cx.G) % cx.G;
      for (int u = first; u < NB * RGC * 6; u += cx.G) { const int ck = (u / 6) % RGC; if (last && ck < 4) continue; rg_unit(cx, l, u / (RGC * 6), ck, u % 6, 1); } }
    REP_(5) { const int off = (NB * 4 * MLC + NB * RGC * 6) % cx.G; const int first = (cx.bid - off + cx.G) % cx.G;
      for (int wu = first * 8 + cx.wave; wu < 16 * 72; wu += cx.G * 8) s5_out_wave(cx, l, wu); }
}
DEVI void ph_glu(const Ctx& cx, int l) {
    for (int wu = cx.bid * 8 + cx.wave; wu < (TT / 64) * 4; wu += cx.G * 8) s5_glu_wave(cx, l, wu);
}

DEVI unsigned st_launder(unsigned s_addr) { unsigned a; asm volatile("v_mov_b32 %0, %1" : "=v"(a) : "s"(s_addr)); return a; }
constexpr int N_STEPS = 3 + 10 * DEPTH + 1;
__global__ void __launch_bounds__(NTHR, 2) mk_fwd(Params p) {
    extern __shared__ __attribute__((aligned(16))) unsigned char lds_raw[];
    Ctx cx; cx.p = &p; cx.ws = p.ws; cx.lds = (LAS unsigned char*)lds_raw; cx.tid = threadIdx.x; cx.lane = cx.tid & 63;
    cx.wave = __builtin_amdgcn_readfirstlane((int)threadIdx.x >> 6); cx.G = gridDim.x; cx.bid = blockIdx.x;
    volatile LAS unsigned* st = (volatile LAS unsigned*)(cx.lds + LDS_BYTES - 16);
    const unsigned st_s = (unsigned)__builtin_amdgcn_readfirstlane((int)(unsigned)(size_t)(LAS unsigned*)(cx.lds + LDS_BYTES - 16));
#define ST_P ((volatile LAS unsigned*)(size_t)st_launder(st_s))
    if (cx.tid == 0) { st[0] = 0u; st[1] = 0u; st[2] = (unsigned)p.lo; st[3] = (unsigned)p.hi; }
    __syncthreads();
    (void)xcd_barrier_post((unsigned*)(p.ws + WS_CTL) + CW_BAR, st);
#define GRID_BAR() do { XcdBarrier b_; b_.bar = (unsigned*)(p.ws + WS_CTL) + CW_BAR; b_.x = (unsigned)__builtin_amdgcn_readfirstlane((int)xb_xcc_id()); b_.st = ST_P; xcd_barrier(b_); } while (0)
#ifndef PH_MASK
#define PH_MASK 0xFFFF
#endif
#ifndef PH_DUP
#define PH_DUP 0
#endif
#define STEP_(id, k, call) do { const int lo_ = __builtin_amdgcn_readfirstlane((int)ST_P[2]), hi_ = __builtin_amdgcn_readfirstlane((int)ST_P[3]); if (lo_ <= (k) && (k) < hi_) { if ((PH_MASK >> (id)) & 1) { const Ctx cl = relaunder(cx); call; } if ((PH_DUP >> (id)) & 1) { GRID_BAR(); const Ctx cl = relaunder(cx); call; } if ((k) + 1 < hi_) GRID_BAR(); } } while (0)
    STEP_(0, 0, ph_pro_a(cl));
    STEP_(1, 1, ph_pro_b(cl));
    STEP_(2, 2, ph_pro_c(cl));
#pragma unroll 1
    for (int l = 0; l < DEPTH; ++l) {
        const int s0 = 3 + 10 * l;
        STEP_(3, s0 + 0, ph_norm1(cl, l));
        STEP_(4, s0 + 1, ph_inproj(cl, l));
        STEP_(5, s0 + 2, ph_mix_local(cl, l));
        STEP_(6, s0 + 3, ph_mix_carry(cl, l));
        STEP_(7, s0 + 4, ph_mix_out(cl, l));
        STEP_(8, s0 + 5, ph_glu(cl, l));
        STEP_(9, s0 + 6, ph_outproj(cl, l));
        STEP_(10, s0 + 7, ph_norm2(cl, l));
        STEP_(11, s0 + 8, ph_moe_gu(cl, l));
        STEP_(12, s0 + 9, ph_moe_dn(cl, l));
    }
    STEP_(13, N_STEPS - 1, ph_norm1(cl, DEPTH));
#undef STEP_
}

extern "C" void kernel_launch(void* const* d_in, const int* in_sizes, int n_in, void* d_out, int out_size, void* d_ws, size_t ws_size, hipStream_t stream) {
    static int grid = 0;
    if (grid == 0) {
        if (n_in != 36 || out_size != TLAT * DM || ws_size < WS_END) { fprintf(stderr, "kernel_launch: unexpected problem (n_in %d, out %d, ws %zu < %zu)\n", n_in, out_size, ws_size, (size_t)WS_END); grid = -1; return; }
        int dev = 0, cus = 0, per_cu = 0;
        if (hipGetDevice(&dev) != hipSuccess || hipDeviceGetAttribute(&cus, hipDeviceAttributeMultiprocessorCount, dev) != hipSuccess) { grid = -1; return; }
        if (hipFuncSetAttribute((const void*)mk_fwd, hipFuncAttributeMaxDynamicSharedMemorySize, LDS_BYTES) != hipSuccess) { fprintf(stderr, "kernel_launch: hipFuncSetAttribute failed\n"); grid = -1; return; }
        if (hipOccupancyMaxActiveBlocksPerMultiprocessor(&per_cu, (const void*)mk_fwd, NTHR, LDS_BYTES) != hipSuccess || per_cu < 1) { fprintf(stderr, "kernel_launch: occupancy query says %d blocks per CU\n", per_cu); }
        (void)hipGetLastError();
        grid = cus;
    }
    if (grid < 0) return;
    (void)hipMemsetAsync((char*)d_ws + WS_CTL, 0, CTL_BYTES, stream);
    Params p{};
    for (int i = 0; i < 36; ++i) p.in[i] = (const float*)d_in[i];
    p.out = (float*)d_out; p.ws = (unsigned char*)d_ws;
#if MK_FUSED
    p.lo = 0; p.hi = N_STEPS;
    hipLaunchKernelGGL(mk_fwd, dim3(grid), dim3(NTHR), LDS_BYTES, stream, p);
#else
    for (int k = 0; k < N_STEPS; ++k) { p.lo = k; p.hi = k + 1; hipLaunchKernelGGL(mk_fwd, dim3(grid), dim3(NTHR), LDS_BYTES, stream, p); }
#endif
}
```

```cpp
#include <hip/hip_runtime.h>
#include <stdint.h>
#include <stdio.h>

#ifndef MK_FUSED
#define MK_FUSED 1
#endif

typedef unsigned short bf16_t;
typedef short bf16x8 __attribute__((ext_vector_type(8)));
typedef float f32x4 __attribute__((ext_vector_type(4)));
typedef float f32x2 __attribute__((ext_vector_type(2)));
typedef unsigned u32x4 __attribute__((ext_vector_type(4)));
typedef unsigned u32x2 __attribute__((ext_vector_type(2)));
typedef int i32x4 __attribute__((ext_vector_type(4)));
typedef int i32x8 __attribute__((ext_vector_type(8)));
#define LAS __attribute__((address_space(3)))
#define DEVI __device__ __forceinline__

constexpr int DM = 1024, NB = 8, SEQ = 2048, CTXL = 256, DEPTH = 4;
constexpr int TCTX = NB * CTXL, TLAT = NB * SEQ, TT = TCTX + TLAT;
constexpr int DIN = 2576, NP = 2560;
constexpr int NE = 32;
constexpr int PMAX = 81920;
constexpr int NTHR = 512;
constexpr int LDS_BYTES = 152 * 1024;
constexpr float EPS = 1e-6f;
constexpr float W8_SCALE = 32.0f, W8_INV = 0.03125f;
constexpr int PC_Q = 0, PC_K = 384, PC_V = 768, PC_O = 1152, PC_RX = 1536, PC_RG = 1920, PC_S5 = 2304;
constexpr int MLC = 18;
constexpr int RGC = 36;
constexpr int S5C = 72, S5R = NB * S5C;

constexpr size_t al256(size_t x) { return (x + 255) & ~(size_t)255; }
constexpr size_t WS_CTL   = 0;
constexpr size_t CTL_BYTES = 65536;
constexpr size_t CW_BAR = 0;
constexpr size_t CW_CNT = 4096;
constexpr size_t WS_WIN   = al256(WS_CTL + CTL_BYTES);
constexpr size_t WS_WOUT  = al256(WS_WIN + (size_t)DEPTH * NP * 1024 * 2);
constexpr size_t WS_WGU   = al256(WS_WOUT + (size_t)DEPTH * 1024 * 1024 * 2);
constexpr size_t WS_WD    = al256(WS_WGU + (size_t)DEPTH * NE * 2048 * 1024 * 2);
constexpr size_t WS_MOD   = al256(WS_WD + (size_t)DEPTH * NE * 1024 * 1024 * 2);
constexpr size_t WS_PW    = al256(WS_MOD + (size_t)DEPTH * 9 * 6144 * 4);
constexpr size_t WS_BB    = al256(WS_PW + (size_t)DEPTH * 16 * 2 * 64 * 33 * 8);
constexpr size_t WS_KT    = al256(WS_BB + (size_t)DEPTH * 16 * 2 * 64 * 16 * 8);
constexpr size_t WS_WY    = al256(WS_KT + (size_t)DEPTH * 16 * 2 * 32 * 256 * 4);
constexpr size_t WS_WE    = al256(WS_WY + (size_t)DEPTH * 16 * 512 * 768 * 2);
constexpr size_t WS_WRG   = al256(WS_WE + (size_t)DEPTH * 16 * 256 * 512 * 2);
constexpr size_t WS_WGLU  = al256(WS_WRG + (size_t)DEPTH * 6 * 256 * 64 * 2);
constexpr size_t WS_XS    = al256(WS_WGLU + (size_t)DEPTH * 256 * 256 * 2);
constexpr size_t WS_XMID  = al256(WS_XS + (size_t)TT * 1024 * 4);
constexpr size_t WS_H     = al256(WS_XMID + (size_t)TT * 1024 * 4);
constexpr size_t WS_GT    = al256(WS_H + (size_t)TT * 1024 * 2);
constexpr size_t WS_P     = al256(WS_GT + (size_t)TT * 16 * 4);
constexpr size_t WS_GB    = al256(WS_P + (size_t)TT * NP * 2);
constexpr size_t WS_GU    = al256(WS_GB + (size_t)TT * 8 * 4);
constexpr size_t WS_GCM   = al256(WS_GU + (size_t)TT * 8 * 4);
constexpr size_t WS_MSC   = al256(WS_GCM + (size_t)TT * 8 * 4);
constexpr size_t WS_CLOC  = al256(WS_MSC + (size_t)8 * 4 * 18 * 2 * 2 * 4);
constexpr size_t WS_NLOC  = al256(WS_CLOC + (size_t)8 * 4 * 18 * 2 * 9216 * 4);
constexpr size_t WS_C0    = al256(WS_NLOC + (size_t)8 * 4 * 18 * 2 * 96 * 4);
constexpr size_t WS_N0    = al256(WS_C0 + (size_t)8 * 4 * 18 * 2 * 9216 * 2);
constexpr size_t WS_M0    = al256(WS_N0 + (size_t)8 * 4 * 18 * 2 * 96 * 4);
constexpr size_t WS_RGA   = al256(WS_M0 + (size_t)8 * 4 * 18 * 2 * 4);
constexpr size_t WS_RGB   = al256(WS_RGA + (size_t)8 * 36 * 2 * 384 * 4);
constexpr size_t WS_RGC   = al256(WS_RGB + (size_t)8 * 36 * 2 * 384 * 4);
constexpr size_t WS_SLOC  = al256(WS_RGC + (size_t)8 * 36 * 2 * 384 * 4);
constexpr size_t WS_SIN   = al256(WS_SLOC + (size_t)16 * 576 * 256 * 4);
constexpr size_t WS_GS    = al256(WS_SIN + (size_t)16 * 576 * 256 * 2);
constexpr size_t WS_MRG   = al256(WS_GS + (size_t)TT * 256 * 2);
constexpr size_t WS_ELIST = al256(WS_MRG + (size_t)TT * 1024 * 2);
constexpr size_t WS_GLIST = al256(WS_ELIST + (size_t)NE * TT * 4);
constexpr size_t WS_TINFO = al256(WS_GLIST + (size_t)NE * TT * 4);
constexpr size_t WS_ACT   = al256(WS_TINFO + (size_t)TT * 4 * 4);
constexpr size_t WS_YPAD  = al256(WS_ACT + (size_t)PMAX * 1024 * 2);
constexpr size_t WS_BIN2  = al256(WS_YPAD + (size_t)PMAX * 1024 * 2);
constexpr size_t WS_HLO   = al256(WS_BIN2 + (size_t)DEPTH * NP * 4);
constexpr size_t WS_WGT   = al256(WS_HLO + (size_t)TT * 1024 * 2);
constexpr size_t WS_RWH   = al256(WS_WGT + (size_t)DEPTH * 16 * 1024 * 2);
constexpr size_t WS_RWL   = al256(WS_RWH + (size_t)DEPTH * 32 * 1024 * 2);
constexpr size_t WS_H8    = al256(WS_RWL + (size_t)DEPTH * 32 * 1024 * 2);
constexpr size_t WS_END   = al256(WS_H8 + (size_t)TT * 1024);

struct Params { const float* in[36]; float* out; unsigned char* ws; int lo, hi; };

enum { I_X = 0, I_C, I_CTX, I_CCTX, I_ADAW, I_ADAB, I_N1W, I_WIN, I_BIN, I_RGCW, I_RGCB, I_RGWA, I_RGBA, I_RGWX, I_RGBX, I_RGLAM,
       I_S5LRE, I_S5LIM, I_S5LDT, I_S5BRE, I_S5BIM, I_S5CRE, I_S5CIM, I_S5D, I_S5GW, I_S5GB, I_MIXW, I_WOUT, I_N2W, I_RW, I_RB,
       I_WGU, I_BGU, I_WD, I_BD, I_FNW };

DEVI bf16_t f2bf(float f) { unsigned u = __float_as_uint(f); u += 0x7FFFu + ((u >> 16) & 1u); return (bf16_t)(u >> 16); }
DEVI float bf2f(bf16_t b) { return __uint_as_float(((unsigned)b) << 16); }
DEVI unsigned pk_bf16(float lo, float hi) { unsigned r; asm("v_cvt_pk_bf16_f32 %0, %1, %2" : "=v"(r) : "v"(lo), "v"(hi)); return r; }
DEVI unsigned pk4_fp8(float a, float b, float c, float d) { int p = __builtin_amdgcn_cvt_pk_fp8_f32(a, b, 0, false); p = __builtin_amdgcn_cvt_pk_fp8_f32(c, d, p, true); return (unsigned)p; }
DEVI float q8(float x) { const int p = __builtin_amdgcn_cvt_pk_fp8_f32(x, x, 0, false); return __builtin_amdgcn_cvt_f32_fp8(p, 0); }
DEVI float frcp(float x) { return __builtin_amdgcn_rcpf(x); }
DEVI float sigmoidf_(float x) { return frcp(1.0f + __expf(-x)); }
DEVI float gelu_tanh(float x) { const float u = 0.7978845608f * (x + 0.044715f * x * x * x); return x * frcp(1.0f + __expf(-2.0f * u)); }
template <int M> DEVI float shx(float v, int lane) {
    if constexpr (M < 32) return __int_as_float(__builtin_amdgcn_ds_swizzle(__float_as_int(v), 0x1F | (M << 10)));
    else return __int_as_float(__builtin_amdgcn_ds_bpermute((lane ^ 32) << 2, __float_as_int(v)));
}
DEVI float shxr(float v, int m, int lane) {
    switch (m) { case 1: return shx<1>(v, lane); case 2: return shx<2>(v, lane); case 4: return shx<4>(v, lane); case 8: return shx<8>(v, lane); case 16: return shx<16>(v, lane); default: return shx<32>(v, lane); }
}
DEVI int shxri(int v, int m, int lane) { return __float_as_int(shxr(__int_as_float(v), m, lane)); }
template <int CTRL, int ROWMASK> DEVI float dpp_(float v) { return __int_as_float(__builtin_amdgcn_update_dpp(0, __float_as_int(v), CTRL, ROWMASK, 0xF, false)); }
DEVI float wave_sum(float v, int) {
    v += dpp_<0xB1, 0xF>(v); v += dpp_<0x4E, 0xF>(v); v += dpp_<0x141, 0xF>(v); v += dpp_<0x140, 0xF>(v);
    v += dpp_<0x142, 0xA>(v); v += dpp_<0x143, 0xC>(v);
    return __int_as_float(__builtin_amdgcn_readlane(__float_as_int(v), 63));
}
DEVI float log1p_(float e) { return e < 0.06f ? e * (1.0f - e * (0.5f - e * (0.33333334f - e * 0.25f))) : __logf(1.0f + e); }
#define LDS_SYNC() do { asm volatile("s_waitcnt lgkmcnt(0)" ::: "memory"); __builtin_amdgcn_s_barrier(); asm volatile("" ::: "memory"); } while (0)
DEVI int mod_row(int row) { return row < TCTX ? 8 : (row - TCTX) / SEQ; }

#define XB_TMO      128
#define XB_XCNT(j)  (256  + 64 * (j))
#define XB_XSUB(j)  (1280 + 64 * (j))
#define XB_XGEN(j)  (2304 + 64 * (j))
#define XB_TOP      3328
#define XB_TOPGEN   3392
#define XCD_BAR_WORDS 3456
#define XB_SPIN_CAP (1u << 18)
__device__ __forceinline__ unsigned xb_ld(unsigned* p)              { return __hip_atomic_load(p, __ATOMIC_RELAXED, __HIP_MEMORY_SCOPE_AGENT); }
__device__ __forceinline__ unsigned xb_add(unsigned* p, unsigned v) { return __hip_atomic_fetch_add(p, v, __ATOMIC_RELAXED, __HIP_MEMORY_SCOPE_AGENT); }
__device__ __forceinline__ unsigned xb_xcc_id() { return (unsigned)__builtin_amdgcn_s_getreg((3 << 11) | 20) & 0xFu; }
#define XB_SPIN(cond, bar) do { unsigned _sp = 0; while (cond) { __builtin_amdgcn_s_sleep(1); \
    if ((++_sp & 255u) == 0u) { if (xb_ld(&(bar)[XB_TMO])) break; if (_sp > XB_SPIN_CAP) { atomicAdd(&(bar)[XB_TMO], 1u); break; } } } } while (0)
struct XcdBarrier { unsigned* bar; unsigned x; volatile LAS unsigned* st; };
__device__ __forceinline__ XcdBarrier xcd_barrier_post(unsigned* bar, volatile LAS unsigned* st) {
    XcdBarrier b; b.bar = bar; b.x = xb_xcc_id(); b.st = st;
    if (threadIdx.x == 0) (void)xb_add(&bar[XB_XCNT(b.x)], 1u);
    return b;
}
__device__ __forceinline__ void xcd_barrier_complete(unsigned* bar, unsigned x, unsigned& nloc, unsigned& nx) {
    const unsigned G = gridDim.x * gridDim.y * gridDim.z;
    unsigned sum, cnt, mine, sp = 0u;
    for (;;) {
        sum = 0u; cnt = 0u; mine = 0u;
#pragma unroll
        for (unsigned j = 0; j < 16; ++j) { const unsigned c = xb_ld(&bar[XB_XCNT(j)]); sum += c; cnt += (c > 0u) ? 1u : 0u; mine = (j == x) ? c : mine; }
        if (sum == G) break;
        __builtin_amdgcn_s_sleep(1);
        if ((++sp & 255u) == 0u) { if (xb_ld(&bar[XB_TMO])) break; if (sp > XB_SPIN_CAP) { atomicAdd(&bar[XB_TMO], 1u); break; } }
    }
    nloc = mine > 0u ? mine : 1u; nx = cnt > 0u ? cnt : 1u;
}
__device__ __forceinline__ void xcd_barrier(const XcdBarrier& b) {
    asm volatile("s_waitcnt vmcnt(0)" ::: "memory");
    __syncthreads();
    if (threadIdx.x == 0) {
        unsigned* bar = b.bar;
        __builtin_amdgcn_s_waitcnt(0);
        unsigned nloc = b.st[0], nx = b.st[1];
        if (nloc == 0u) { xcd_barrier_complete(bar, b.x, nloc, nx); b.st[0] = nloc; b.st[1] = nx; }
        const unsigned old = xb_add(&bar[XB_XSUB(b.x)], 1u);
        const unsigned gen = old / nloc;
        if (old + 1u == (gen + 1u) * nloc) {
            __builtin_amdgcn_fence(__ATOMIC_RELEASE, "agent");
            asm volatile("s_waitcnt vmcnt(0)" ::: "memory");
            const unsigned og = xb_add(&bar[XB_TOP], 1u);
            const unsigned tg = og / nx;
            if (og + 1u == (tg + 1u) * nx) xb_add(&bar[XB_TOPGEN], 1u);
            else XB_SPIN(xb_ld(&bar[XB_TOPGEN]) == tg, bar);
            __builtin_amdgcn_fence(__ATOMIC_ACQUIRE, "agent");
            xb_add(&bar[XB_XGEN(b.x)], 1u);
            asm volatile("s_waitcnt vmcnt(0)" ::: "memory");
        } else {
            XB_SPIN(xb_ld(&bar[XB_XGEN(b.x)]) == gen, bar);
            __builtin_amdgcn_fence(__ATOMIC_ACQUIRE, "agent");
            asm volatile("s_waitcnt vmcnt(0)" ::: "memory");
        }
    }
    __syncthreads();
}

namespace g1 {
constexpr int BM = 256, BK = 64, HALF = 128, HTB = HALF * BK * 2, STAGE_BYTES = 8 * HTB, K = 1024, NT = K / BK;
DEVI int lds_byte(int r, int c) { const int st = (r >> 4) * 2 + (c >> 5), rr = r & 15, cc = c & 31, ob = rr * 64 + cc * 2; return st * 1024 + (ob ^ (((ob >> 9) & 1) << 5)); }
DEVI void stage_rc(int b, int& R, int& C) { const int st = b / 1024, sb = b % 1024, swz = sb ^ (((sb >> 9) & 1) << 5); R = (st >> 1) * 16 + swz / 64; C = (st & 1) * 32 + (swz % 64) / 2; }
DEVI int perm32(int rho) { const int n = rho >> 4, i = rho & 15; return 8 * (i >> 2) + 4 * n + (i & 3); }

struct Unit {
    const char* A;
    const int* list;
    int nvalid;
    const char* B;
    int pm, pn, e;
};

template <bool F8> struct FragT { typedef bf16x8 T; static constexpr int NK = 2; };
template <> struct FragT<true> { typedef i32x8 T; static constexpr int NK = 1; };
template <bool GATHER, int KB>
DEVI void a_offsets(const Unit& u, const int (&R)[2], const int (&C)[2], unsigned (&v)[2][2]) {
#pragma unroll
    for (int h = 0; h < 2; ++h)
#pragma unroll
        for (int i = 0; i < 2; ++i) {
            const int r = h * HALF + R[i];
            int src = r;
            if (GATHER) { src = (r < u.nvalid) ? u.list[r] : 0; }
            v[h][i] = (unsigned)src * (unsigned)KB + (unsigned)(C[i] * 2);
        }
}

template <class Sched, class Epi, bool GATHER, bool FP8 = false>
DEVI void gemm_phase(LAS unsigned char* lds, const int tid, const Sched& S, const Epi& E) {
    constexpr int KB = FP8 ? 1024 : 2048, NTK = KB / 128, NK = FragT<FP8>::NK;
    typedef typename FragT<FP8>::T frag_t;
    int sc1 = 0x7F7F7F7F; asm volatile("" : "+v"(sc1));
    const int wid = __builtin_amdgcn_readfirstlane(tid >> 6), lane = tid & 63, wr = wid >> 2, wc = wid & 3, fr = lane & 15, fq = lane >> 4;
    int R[2], C[2]; unsigned voffB[2];
#pragma unroll
    for (int i = 0; i < 2; ++i) { stage_rc(tid * 16 + i * 8192, R[i], C[i]); const int Rb = Epi::PERM ? ((R[i] & ~31) + perm32(R[i] & 31)) : R[i]; voffB[i] = (unsigned)(Rb * KB + C[i] * 2); }
    constexpr size_t kstep = (size_t)(BK * 2);
    constexpr size_t hstep = (size_t)HALF * KB;
    const unsigned ldsw = (unsigned)wid * 1024u;
    const int aoff = FP8 ? lds_byte(wr * 64 + fr, fq * 16) : lds_byte(wr * 64 + fr, fq * 8), boff = FP8 ? lds_byte(wc * 32 + fr, fq * 16) : lds_byte(wc * 32 + fr, fq * 8);
#define G1_SA(b, h) (((b) * 2 + (h)) * HTB)
#define G1_SB(b, h) ((4 + (b) * 2 + (h)) * HTB)
#define G1_STAGE2(bufoff, gbase, v0, v1) do { \
        __builtin_amdgcn_global_load_lds((const unsigned*)((const char*)(gbase) + (v0)), (LAS unsigned*)(lds + (bufoff) + ldsw), 16, 0, 0); \
        __builtin_amdgcn_global_load_lds((const unsigned*)((const char*)(gbase) + (v1)), (LAS unsigned*)(lds + (bufoff) + ldsw + 8192), 16, 0, 0); } while (0)
#define G1_LDFRAG(dst, off) do { dst = *(const LAS frag_t*)(lds + (off)); } while (0)
#define G1_LDA(dst, b, h) do { _Pragma("unroll") for (int m = 0; m < 4; ++m) _Pragma("unroll") for (int k = 0; k < NK; ++k) G1_LDFRAG(dst[m][k], G1_SA(b, h) + aoff + m * 2048 + k * 1024); } while (0)
#define G1_LDB(dst, b, h) do { _Pragma("unroll") for (int n = 0; n < 2; ++n) _Pragma("unroll") for (int k = 0; k < NK; ++k) G1_LDFRAG(dst[n][k], G1_SB(b, h) + boff + n * 2048 + k * 1024); } while (0)
#define G1_MFMA(c_, b_, a_) do { if constexpr (FP8) asm volatile("v_mfma_scale_f32_16x16x128_f8f6f4 %0, %1, %2, %0, %3, %3 op_sel_hi:[0,0,0]" : "+v"(c_) : "v"(b_), "v"(a_), "v"(sc1)); \
        else c_ = __builtin_amdgcn_mfma_f32_16x16x32_bf16(b_, a_, c_, 0, 0, 0); } while (0)
#define G1_MMA(ai, bj, At, Bt) do { __builtin_amdgcn_s_setprio(1); _Pragma("unroll") for (int m = 0; m < 4; ++m) _Pragma("unroll") for (int n = 0; n < 2; ++n) _Pragma("unroll") for (int k = 0; k < NK; ++k) \
        G1_MFMA(acc[ai][bj][m][n], Bt[n][k], At[m][k]); __builtin_amdgcn_s_setprio(0); } while (0)
#define G1_WAIT_V(n) asm volatile("s_waitcnt vmcnt(" #n ")" ::: "memory")
#define G1_WAIT_L(n) asm volatile("s_waitcnt lgkmcnt(" #n ")" ::: "memory")
#define G1_BAR __builtin_amdgcn_s_barrier()
#define G1_SCHED __builtin_amdgcn_sched_barrier(0)
    Unit cur, nxt; int ui = 0;
    if (!S.get(0, cur)) return;
    f32x4 acc[2][2][4][2];
#pragma unroll
    for (int a = 0; a < 2; ++a)
#pragma unroll
        for (int b = 0; b < 2; ++b)
#pragma unroll
            for (int m = 0; m < 4; ++m)
#pragma unroll
                for (int n = 0; n < 2; ++n) acc[a][b][m][n] = (f32x4){0.f, 0.f, 0.f, 0.f};
    frag_t At[4][NK], B0[2][NK], B1[2][NK];
    unsigned vc[2][2], vn[2][2];
    a_offsets<GATHER, KB>(cur, R, C, vc);
    const char* cA = cur.A; const char* cB = cur.B;
    G1_STAGE2(G1_SB(0, 0), cB, voffB[0], voffB[1]); G1_STAGE2(G1_SA(0, 0), cA, vc[0][0], vc[0][1]);
    G1_STAGE2(G1_SB(0, 1), cB + hstep, voffB[0], voffB[1]); G1_STAGE2(G1_SA(0, 1), cA, vc[1][0], vc[1][1]);
    if (wr == 1) G1_BAR;
    G1_WAIT_V(4); G1_BAR;
    G1_STAGE2(G1_SB(1, 0), cB + kstep, voffB[0], voffB[1]); G1_STAGE2(G1_SA(1, 0), cA + kstep, vc[0][0], vc[0][1]);
    G1_STAGE2(G1_SB(1, 1), cB + hstep + kstep, voffB[0], voffB[1]);
    G1_WAIT_V(6); G1_BAR;
    for (;;) {
        const bool has_next = S.get(ui + 1, nxt);
        if (has_next) { a_offsets<GATHER, KB>(nxt, R, C, vn); }
        else {
#pragma unroll
            for (int h = 0; h < 2; ++h)
#pragma unroll
                for (int i = 0; i < 2; ++i) vn[h][i] = vc[h][i];
        }
        const char* nA = has_next ? nxt.A : cA; const char* nB = has_next ? nxt.B : cB;
#pragma unroll 1
        for (int t = 0; t < NTK; t += 2) {
            const bool last = (t == NTK - 2);
            const char* a1 = cA + (size_t)(t + 1) * kstep;
            const char* a2 = last ? nA : cA + (size_t)(t + 2) * kstep; const char* b2 = last ? nB : cB + (size_t)(t + 2) * kstep;
            const char* a3 = a2 + kstep; const char* b3 = b2 + kstep;
            const unsigned w00 = last ? vn[0][0] : vc[0][0], w01 = last ? vn[0][1] : vc[0][1], w10 = last ? vn[1][0] : vc[1][0], w11 = last ? vn[1][1] : vc[1][1];
            G1_LDB(B0, 0, 0); G1_SCHED; G1_LDA(At, 0, 0); G1_STAGE2(G1_SA(1, 1), a1, vc[1][0], vc[1][1]);
            G1_WAIT_L(8); G1_BAR; G1_WAIT_L(0); G1_MMA(0, 0, At, B0); G1_BAR; G1_SCHED;
            G1_LDB(B1, 0, 1); G1_STAGE2(G1_SB(0, 0), b2, voffB[0], voffB[1]);
            G1_BAR; G1_WAIT_L(0); G1_MMA(0, 1, At, B1); G1_BAR;
            G1_LDA(At, 0, 1); G1_STAGE2(G1_SA(0, 0), a2, w00, w01);
            G1_BAR; G1_WAIT_L(0); G1_MMA(1, 0, At, B0); G1_BAR; G1_SCHED;
            G1_STAGE2(G1_SB(0, 1), b2 + hstep, voffB[0], voffB[1]);
            G1_WAIT_V(6); G1_BAR; G1_MMA(1, 1, At, B1); G1_BAR;
            G1_LDB(B0, 1, 0); G1_SCHED; G1_LDA(At, 1, 0); G1_STAGE2(G1_SA(0, 1), a2, w10, w11);
            G1_WAIT_L(8); G1_BAR; G1_WAIT_L(0); G1_MMA(0, 0, At, B0); G1_BAR; G1_SCHED;
            G1_LDB(B1, 1, 1); G1_STAGE2(G1_SB(1, 0), b3, voffB[0], voffB[1]);
            G1_BAR; G1_WAIT_L(0); G1_MMA(0, 1, At, B1); G1_BAR;
            G1_LDA(At, 1, 1); G1_STAGE2(G1_SA(1, 0), a3, w00, w01);
            G1_BAR; G1_WAIT_L(0); G1_MMA(1, 0, At, B0); G1_BAR; G1_SCHED;
            G1_STAGE2(G1_SB(1, 1), b3 + hstep, voffB[0], voffB[1]);
            G1_WAIT_V(6); G1_BAR; G1_MMA(1, 1, At, B1); G1_BAR;
        }
        if constexpr (FP8) asm volatile("s_nop 15\n\ts_nop 15" ::: "memory");
        E(acc, cur, wr, wc, fr, fq);
        if (!has_next) break;
#pragma unroll
        for (int a = 0; a < 2; ++a)
#pragma unroll
            for (int b = 0; b < 2; ++b)
#pragma unroll
                for (int m = 0; m < 4; ++m)
#pragma unroll
                    for (int n = 0; n < 2; ++n) acc[a][b][m][n] = (f32x4){0.f, 0.f, 0.f, 0.f};
        cur = nxt; cA = nA; cB = nB; ++ui;
#pragma unroll
        for (int h = 0; h < 2; ++h)
#pragma unroll
            for (int i = 0; i < 2; ++i) vc[h][i] = vn[h][i];
    }
    G1_WAIT_V(0);
    if (wr == 0) G1_BAR;
    G1_BAR;
}
}

template <int MT, int NT_, class AF, class BF>
DEVI void wave_gemm(const int lane, int Kdim, const AF& af, const BF& bf, f32x4 (&acc)[MT][NT_]) {
    const int fr = lane & 15, fq = lane >> 4;
#pragma unroll
    for (int m = 0; m < MT; ++m)
#pragma unroll
        for (int n = 0; n < NT_; ++n) acc[m][n] = (f32x4){0.f, 0.f, 0.f, 0.f};
    bf16x8 fa[4][MT], fb[4][NT_];
#define WG_LOAD(S, KK) do { _Pragma("unroll") for (int m = 0; m < MT; ++m) fa[S][m] = af(m * 16 + fr, (KK) + fq * 8); _Pragma("unroll") for (int n = 0; n < NT_; ++n) fb[S][n] = bf(n * 16 + fr, (KK) + fq * 8); } while (0)
#define WG_MMA(S) do { _Pragma("unroll") for (int m = 0; m < MT; ++m) _Pragma("unroll") for (int n = 0; n < NT_; ++n) acc[m][n] = __builtin_amdgcn_mfma_f32_16x16x32_bf16(fb[S][n], fa[S][m], acc[m][n], 0, 0, 0); } while (0)
    WG_LOAD(0, 0); WG_LOAD(1, 32); WG_LOAD(2, 64);
#pragma unroll 1
    for (int k0 = 0; k0 < Kdim; k0 += 128) {
        const bool more = k0 + 128 < Kdim;
        WG_LOAD(3, k0 + 96); WG_MMA(0);
        if (more) WG_LOAD(0, k0 + 128);
        WG_MMA(1);
        if (more) WG_LOAD(1, k0 + 160);
        WG_MMA(2);
        if (more) WG_LOAD(2, k0 + 192);
        WG_MMA(3);
    }
#undef WG_LOAD
#undef WG_MMA
}
DEVI bf16x8 ldg8(const bf16_t* p) { return *(const bf16x8*)p; }

template <int N> struct Log2 { static constexpr int v = 1 + Log2<N / 2>::v; };
template <> struct Log2<1> { static constexpr int v = 0; };
template <int N>
DEVI float reduce_scatter(const int lane, float (&v)[N]) {
    constexpr int LG = Log2<N>::v;
#pragma unroll
    for (int st = 0; st < LG; ++st) {
        const int s = (N / 2) >> st, mask = 32 >> st;
        const bool up = (lane & mask) != 0;
#pragma unroll
        for (int i = 0; i < N / 2; ++i) if (i < s) {
            const float send = up ? v[i] : v[i + s];
            const float keep = up ? v[i + s] : v[i];
            v[i] = keep + shxr(send, mask, lane);
        }
    }
    float r = v[0];
#pragma unroll
    for (int st = LG; st < 6; ++st) r += shxr(r, 32 >> st, lane);
    return r;
}
template <int N>
DEVI int rs_index(int lane) {
    constexpr int LG = Log2<N>::v;
    int idx = 0;
#pragma unroll
    for (int st = 0; st < LG; ++st) if (lane & (32 >> st)) idx += (N / 2) >> st;
    return idx;
}

struct Ctx {
    const Params* p; unsigned char* ws; LAS unsigned char* lds; int tid, lane, wave, G, bid;
};
#define WSP(T, off) ((T*)(cx.ws + (off)))
DEVI Ctx relaunder(const Ctx& c) { Ctx r = c; int ln, td;
    asm volatile("v_mbcnt_lo_u32_b32 %0, -1, 0\n\tv_mbcnt_hi_u32_b32 %0, -1, %0\n\tv_lshl_add_u32 %1, %2, 6, %0" : "=&v"(ln), "=v"(td) : "s"(c.wave));
    r.lane = ln; r.tid = td; return r; }

DEVI void cvt_tile(const Ctx& cx, const float* src, int ld, bf16_t* dst, int n0, int k0, int kind) {
    LAS bf16_t* tile = (LAS bf16_t*)cx.lds;
    const int n4 = (cx.tid & 63) * 4, w8 = (cx.tid >> 6) * 8, n = n0 + n4;
    int sc; float scale = 1.0f;
    if (kind == 0) { sc = n < 1536 ? n : n + 16; if (n >= 384 && n < 768) scale = 0.10206207261596577f; }
    else if (kind == 2) { const int pn = n >> 8, w = n & 255; sc = w < 128 ? pn * 128 + w : 1024 + pn * 128 + (w - 128); }
    else sc = n;
#pragma unroll 1
    for (int sub = 0; sub < 4; sub += 2) {
        f32x4 v[2][8];
#pragma unroll
        for (int s2 = 0; s2 < 2; ++s2)
#pragma unroll
            for (int p = 0; p < 8; ++p) v[s2][p] = __builtin_nontemporal_load((const f32x4*)(src + (size_t)(k0 + (sub + s2) * 64 + w8 + p) * ld + sc));
#pragma unroll
        for (int s2 = 0; s2 < 2; ++s2)
#pragma unroll
            for (int j = 0; j < 4; ++j) { u32x4 w;
                w.x = pk_bf16(v[s2][0][j] * scale, v[s2][1][j] * scale); w.y = pk_bf16(v[s2][2][j] * scale, v[s2][3][j] * scale);
                w.z = pk_bf16(v[s2][4][j] * scale, v[s2][5][j] * scale); w.w = pk_bf16(v[s2][6][j] * scale, v[s2][7][j] * scale);
                *(LAS u32x4*)(tile + (n4 + j) * 264 + (sub + s2) * 64 + w8) = w; }
    }
    LDS_SYNC();
#pragma unroll
    for (int i = 0; i < 16; ++i) { const int idx = cx.tid + NTHR * i, row = idx >> 5, ch = idx & 31;
        const u32x4 o = *(const LAS u32x4*)(tile + row * 264 + ch * 8);
        *(u32x4*)(dst + (size_t)(n0 + row) * 1024 + k0 + ch * 8) = o; }
    LDS_SYNC();
}

DEVI void cvt_tile8(const Ctx& cx, const float* src, int ld, unsigned char* dst, int n0, int k0, int kind) {
    LAS unsigned char* tile = cx.lds;
    const int n4 = (cx.tid & 63) * 4, w8 = (cx.tid >> 6) * 8, n = n0 + n4;
    int sc;
    if (kind == 2) { const int pn = n >> 8, w = n & 255; sc = w < 128 ? pn * 128 + w : 1024 + pn * 128 + (w - 128); }
    else sc = n;
#pragma unroll 1
    for (int sub = 0; sub < 4; sub += 2) {
        f32x4 v[2][8];
#pragma unroll
        for (int s2 = 0; s2 < 2; ++s2)
#pragma unroll
            for (int p = 0; p < 8; ++p) v[s2][p] = __builtin_nontemporal_load((const f32x4*)(src + (size_t)(k0 + (sub + s2) * 64 + w8 + p) * ld + sc));
#pragma unroll
        for (int s2 = 0; s2 < 2; ++s2)
#pragma unroll
            for (int j = 0; j < 4; ++j) { u32x2 w;
                w.x = pk4_fp8(v[s2][0][j] * W8_SCALE, v[s2][1][j] * W8_SCALE, v[s2][2][j] * W8_SCALE, v[s2][3][j] * W8_SCALE);
                w.y = pk4_fp8(v[s2][4][j] * W8_SCALE, v[s2][5][j] * W8_SCALE, v[s2][6][j] * W8_SCALE, v[s2][7][j] * W8_SCALE);
                *(LAS u32x2*)(tile + (n4 + j) * 272 + (sub + s2) * 64 + w8) = w; }
    }
    LDS_SYNC();
#pragma unroll
    for (int i = 0; i < 8; ++i) { const int idx = cx.tid + NTHR * i, row = idx >> 4, ch = idx & 15;
        const u32x4 o = *(const LAS u32x4*)(tile + row * 272 + ch * 16);
        *(u32x4*)(dst + (size_t)(n0 + row) * 1024 + k0 + ch * 16) = o; }
    LDS_SYNC();
}
DEVI void ph_pro_a(const Ctx& cx) {
    const Params& P = *cx.p;
    {
        constexpr int n_in = DEPTH * 10 * 4, n_out = DEPTH * 4 * 4, n_gu = DEPTH * NE * 8 * 4, n_dn = DEPTH * NE * 4 * 4;
        constexpr int total = n_in + n_out + n_gu + n_dn;
        for (int job = cx.bid; job < total; job += cx.G) {
            int j = job;
            if (j < n_in) { const int l = j / 40, r = j % 40, nt = r / 4, kt = r % 4;
                cvt_tile(cx, P.in[I_WIN] + (size_t)l * 1024 * DIN, DIN, WSP(bf16_t, WS_WIN) + (size_t)l * NP * 1024, nt * 256, kt * 256, 0); continue; }
            j -= n_in;
            if (j < n_out) { const int l = j / 16, r = j % 16, nt = r / 4, kt = r % 4;
                cvt_tile(cx, P.in[I_WOUT] + (size_t)l * 1024 * 1024, 1024, WSP(bf16_t, WS_WOUT) + (size_t)l * 1024 * 1024, nt * 256, kt * 256, 1); continue; }
            j -= n_out;
            if (j < n_gu) { const int le = j / 32, r = j % 32, nt = r / 4, kt = r % 4;
                cvt_tile8(cx, P.in[I_WGU] + (size_t)le * 1024 * 2048, 2048, WSP(unsigned char, WS_WGU) + (size_t)le * 2048 * 1024, nt * 256, kt * 256, 2); continue; }
            j -= n_gu;
            { const int le = j / 16, r = j % 16, nt = r / 4, kt = r % 4;
                cvt_tile8(cx, P.in[I_WD] + (size_t)le * 1024 * 1024, 1024, WSP(unsigned char, WS_WD) + (size_t)le * 1024 * 1024, nt * 256, kt * 256, 1); }
        }
    }
    __syncthreads();
    {
        LAS float* sv = (LAS float*)cx.lds;
        LAS float* red = sv + 9 * 1024;
        constexpr int units = DEPTH * 6144 / 64;
        if (cx.bid < units) {
            for (int i = cx.tid; i < 9 * 1024; i += NTHR) { const int r = i >> 10, k = i & 1023; const float c = r < 8 ? P.in[I_C][r * 1024 + k] : P.in[I_CCTX][k]; sv[i] = c / (1.0f + __expf(-c)); }
            __syncthreads();
            for (int u = cx.bid; u < units; u += cx.G) {
                const int l = u / 96, n = (u % 96) * 64 + cx.lane;
                const float* w = P.in[I_ADAW] + (size_t)l * 1024 * 6144 + n;
                float acc[9];
#pragma unroll
                for (int r = 0; r < 9; ++r) acc[r] = 0.f;
                const int kb = cx.wave * 128;
#pragma unroll 4
                for (int k = 0; k < 128; ++k) { const float wv = w[(size_t)(kb + k) * 6144];
#pragma unroll
                    for (int r = 0; r < 9; ++r) acc[r] += sv[r * 1024 + kb + k] * wv; }
#pragma unroll
                for (int r = 0; r < 9; ++r) red[(cx.wave * 9 + r) * 64 + cx.lane] = acc[r];
                __syncthreads();
                for (int i = cx.tid; i < 9 * 64; i += NTHR) { const int r = i >> 6, ln = i & 63; float s = 0.f;
#pragma unroll
                    for (int w8 = 0; w8 < 8; ++w8) s += red[(w8 * 9 + r) * 64 + ln];
                    const int nn = (u % 96) * 64 + ln;
                    WSP(float, WS_MOD)[((size_t)l * 9 + r) * 6144 + nn] = s + P.in[I_ADAB][l * 6144 + nn]; }
                __syncthreads();
            }
        }
    }
    for (int gt = cx.bid * NTHR + cx.tid; gt < DEPTH * 16 * 2 * 64; gt += cx.G * NTHR) {
        const int n = gt & 63, d = (gt >> 6) & 1, g = (gt >> 7) & 15, l = gt >> 11;
        const float dt = expf(P.in[I_S5LDT][(l * 2 + d) * 16 + g]);
        const float lr = P.in[I_S5LRE][((l * 2 + d) * 16 + g) * 64 + n], li = P.in[I_S5LIM][((l * 2 + d) * 16 + g) * 64 + n];
        f32x2* pw = WSP(f32x2, WS_PW) + (size_t)gt * 33;
        float ar = 0.f, ai = 0.f;
        for (int k = 0; k <= 32; ++k) { const float mag = expf(lr * dt * (float)k); float s, c; sincosf(li * dt * (float)k, &s, &c); pw[k] = (f32x2){mag * c, mag * s}; if (k == 1) { ar = mag * c; ai = mag * s; } }
        const float den = lr * lr + li * li;
        const float cr = ((ar - 1.0f) * lr + ai * li) / den, ci = (ai * lr - (ar - 1.0f) * li) / den;
        f32x2* bb = WSP(f32x2, WS_BB) + (size_t)gt * 16;
        for (int q = 0; q < 16; ++q) { const float br = P.in[I_S5BRE][((l * 16 + g) * 64 + n) * 16 + q], bi = P.in[I_S5BIM][((l * 16 + g) * 64 + n) * 16 + q];
            bb[q] = (f32x2){cr * br - ci * bi, cr * bi + ci * br}; }
    }
    for (int i = cx.bid * NTHR + cx.tid; i < DEPTH * 6 * 256 * 64; i += cx.G * NTHR) {
        const int k = i & 63, n = (i >> 6) & 255, g = (i >> 14) % 6, l = (i >> 14) / 6;
        const int j = n & 63, type = (n >> 6) & 1, dir = n >> 7;
        const float* w = type ? P.in[I_RGWX] : P.in[I_RGWA];
        WSP(bf16_t, WS_WRG)[i] = f2bf(w[((((size_t)l * 2 + dir) * 6 + g) * 64 + k) * 64 + j]);
    }
    for (int i = cx.bid * NTHR + cx.tid; i < DEPTH * NP; i += cx.G * NTHR) {
        const int n = i % NP, l = i / NP; const int sc = n < 1536 ? n : n + 16;
        WSP(float, WS_BIN2)[i] = P.in[I_BIN][l * DIN + sc] * ((n >= 384 && n < 768) ? 0.10206207261596577f : 1.0f);
    }
    for (int i = cx.bid * NTHR + cx.tid; i < DEPTH * 16 * 1024; i += cx.G * NTHR) { const int k = i & 1023, n = (i >> 10) & 15, l = i >> 14;
        WSP(bf16_t, WS_WGT)[i] = f2bf(P.in[I_WIN][((size_t)l * 1024 + k) * DIN + 1536 + n]); }
    for (int i = cx.bid * NTHR + cx.tid; i < DEPTH * 32 * 1024; i += cx.G * NTHR) { const int k = i & 1023, n = (i >> 10) & 31, l = i >> 15;
        const float w = P.in[I_RW][((size_t)l * 1024 + k) * 32 + n]; const bf16_t hi = f2bf(w);
        WSP(bf16_t, WS_RWH)[i] = hi; WSP(bf16_t, WS_RWL)[i] = f2bf(w - bf2f(hi)); }
    for (int i = cx.bid * NTHR + cx.tid; i < DEPTH * 256 * 256; i += cx.G * NTHR) {
        const int k = i & 255, n = (i >> 8) & 255, l = i >> 16;
        WSP(bf16_t, WS_WGLU)[i] = f2bf(P.in[I_S5GW][((size_t)l * 256 + k) * 256 + n]);
    }
}

DEVI void ph_pro_b(const Ctx& cx) {
    const Params& P = *cx.p;
    for (int i = cx.bid * NTHR + cx.tid; i < DEPTH * 16 * 2 * 32 * 256; i += cx.G * NTHR) {
        const int q = i & 15, p = (i >> 4) & 15, tau = (i >> 8) & 31, d = (i >> 13) & 1, g = (i >> 14) & 15, l = i >> 18;
        const f32x2* pw = WSP(f32x2, WS_PW) + (size_t)(((l * 16 + g) * 2 + d) * 64) * 33 + tau;
        const f32x2* bb = WSP(f32x2, WS_BB) + (size_t)(((l * 16 + g) * 2 + d) * 64) * 16 + q;
        const float* cre = P.in[I_S5CRE] + ((size_t)(l * 16 + g) * 16 + p) * 64;
        const float* cim = P.in[I_S5CIM] + ((size_t)(l * 16 + g) * 16 + p) * 64;
        float s = 0.f;
        for (int n = 0; n < 64; ++n) { const f32x2 a = pw[n * 33], b = bb[n * 16]; const float cr = cre[n], ci = cim[n];
            const float xr = cr * a.x - ci * a.y, xi = cr * a.y + ci * a.x; s += xr * b.x - xi * b.y; }
        WSP(float, WS_KT)[i] = s;
    }
}

DEVI void ph_pro_c(const Ctx& cx) {
    const Params& P = *cx.p;
    for (size_t i = (size_t)cx.bid * NTHR + cx.tid; i < (size_t)DEPTH * 16 * 512 * 768; i += (size_t)cx.G * NTHR) {
        const int k = (int)(i % 768), tp = (int)((i / 768) % 512), lg = (int)(i / (768 * 512));
        const int t = tp >> 4, p = tp & 15, l = lg >> 4, g = lg & 15;
        float v;
        if (k < 512) { const int s = k >> 4, q = k & 15; v = 0.f;
            const float* kt = WSP(float, WS_KT) + (size_t)lg * 2 * 32 * 256;
            if (s <= t) v += kt[((0 * 32) + (t - s)) * 256 + p * 16 + q];
            if (s >= t) v += kt[((1 * 32) + (s - t)) * 256 + p * 16 + q];
            if (s == t && p == q) v += P.in[I_S5D][l * 256 + g * 16 + p];
        } else { const int kk = k - 512, d = kk >> 7, im = (kk >> 6) & 1, n = kk & 63;
            const int pwr = d == 0 ? t + 1 : 32 - t;
            const f32x2 a = WSP(f32x2, WS_PW)[(size_t)((lg * 2 + d) * 64 + n) * 33 + pwr];
            const float cr = P.in[I_S5CRE][((size_t)lg * 16 + p) * 64 + n], ci = P.in[I_S5CIM][((size_t)lg * 16 + p) * 64 + n];
            v = im ? -(cr * a.y + ci * a.x) : (cr * a.x - ci * a.y);
        }
        WSP(bf16_t, WS_WY)[i] = f2bf(v);
    }
    for (size_t i = (size_t)cx.bid * NTHR + cx.tid; i < (size_t)DEPTH * 16 * 256 * 512; i += (size_t)cx.G * NTHR) {
        const int k = (int)(i & 511), no = (int)((i >> 9) & 255), lg = (int)(i >> 17);
        const int s = k >> 4, q = k & 15, d = no >> 7, im = (no >> 6) & 1, n = no & 63;
        const int pwr = d == 0 ? 31 - s : s;
        const f32x2 a = WSP(f32x2, WS_PW)[(size_t)((lg * 2 + d) * 64 + n) * 33 + pwr];
        const f32x2 b = WSP(f32x2, WS_BB)[(size_t)((lg * 2 + d) * 64 + n) * 16 + q];
        const float v = im ? (a.x * b.y + a.y * b.x) : (a.x * b.x - a.y * b.y);
        WSP(bf16_t, WS_WE)[i] = f2bf(v);
    }
}

DEVI void moe_info(const Ctx& cx, int l, LAS int* info) {
    if (cx.tid < 64) {
        const unsigned* cnt = (const unsigned*)(cx.ws + WS_CTL) + CW_CNT + l * 32;
        const int c = cx.lane < 32 ? (int)__hip_atomic_load(cnt + (cx.lane & 31), __ATOMIC_RELAXED, __HIP_MEMORY_SCOPE_AGENT) : 0;
        const int nt = (c + 255) >> 8;
        if (cx.lane < 32) { info[72 + cx.lane] = nt; info[40 + cx.lane] = c; }
        if (cx.lane == 0) { int run = 0; info[0] = 0; for (int e = 0; e < 32; ++e) { run += info[72 + e]; info[e + 1] = run; } }
    }
    __syncthreads();
    if (cx.tid < 32) { const int lo = info[cx.tid], hi = info[cx.tid + 1]; for (int t = lo; t < hi; ++t) info[112 + t] = cx.tid;
    }
    __syncthreads();
}

DEVI void block_rows_visible() {
    asm volatile("s_waitcnt vmcnt(0)" ::: "memory");
    __syncthreads();
    __builtin_amdgcn_fence(__ATOMIC_ACQUIRE, "agent");
    asm volatile("s_waitcnt vmcnt(0)" ::: "memory");
}
DEVI void ph_norm1(const Ctx& cx, int l) {
    const Params& P = *cx.p;
    LAS int* info = (LAS int*)cx.lds;
    if (l > 0) moe_info(cx, l - 1, info);
    const int rbeg = (l == DEPTH) ? TCTX : 0, nr = TT - rbeg;
    const int rpb = (nr + cx.G - 1) / cx.G, rb = rbeg + cx.bid * rpb, re = min(TT, rb + rpb);
    const float* modp = WSP(float, WS_MOD);
    const int c0 = 2 * cx.lane;
    for (int r2 = rb + cx.wave; r2 < re; r2 += 16) {
        f32x2 x[2][8]; bool ok[2];
#pragma unroll
        for (int u = 0; u < 2; ++u) { const int row = r2 + 8 * u; ok[u] = row < re; const int rw_ = ok[u] ? row : r2;
            if (l == 0) { const float* src = rw_ < TCTX ? P.in[I_CTX] + (size_t)rw_ * 1024 : P.in[I_X] + (size_t)(rw_ - TCTX) * 1024;
#pragma unroll
                for (int i = 0; i < 8; ++i) x[u][i] = *(const f32x2*)(src + c0 + 128 * i);
            } else {
                const float* src = WSP(float, WS_XMID) + (size_t)rw_ * 1024;
                const float* g2 = modp + ((size_t)(l - 1) * 9 + mod_row(rw_)) * 6144 + 5120;
                const int* ti = WSP(int, WS_TINFO) + (size_t)rw_ * 4;
                f32x2 y[8];
#pragma unroll
                for (int i = 0; i < 8; ++i) y[i] = (f32x2){0.f, 0.f};
#pragma unroll
                for (int k = 0; k < 4; ++k) { const int t = ti[k]; const int e = t >> 20, slot = t & 0xFFFFF;
                    const bf16_t* yp = WSP(bf16_t, WS_YPAD) + ((size_t)info[e] * 256 + slot) * 1024;
#pragma unroll
                    for (int i = 0; i < 8; ++i) { const unsigned w = *(const unsigned*)(yp + c0 + 128 * i); y[i].x += __uint_as_float(w << 16); y[i].y += __uint_as_float(w & 0xFFFF0000u); } }
#pragma unroll
                for (int i = 0; i < 8; ++i) { const f32x2 xv = *(const f32x2*)(src + c0 + 128 * i), gv = *(const f32x2*)(g2 + c0 + 128 * i); x[u][i] = xv + gv * y[i]; }
            }
        }
#pragma unroll
        for (int u = 0; u < 2; ++u) {
            const int row = r2 + 8 * u;
            float ss = 0.f;
#pragma unroll
            for (int i = 0; i < 8; ++i) ss += x[u][i].x * x[u][i].x + x[u][i].y * x[u][i].y;
            ss = wave_sum(ss, 0);
            const float rstd = rsqrtf(ss * (1.0f / 1024.0f) + EPS);
            if (!ok[u]) continue;
            if (l == DEPTH) { float* o = P.out + (size_t)(row - TCTX) * 1024;
#pragma unroll
                for (int i = 0; i < 8; ++i) { const f32x2 fw = *(const f32x2*)(P.in[I_FNW] + c0 + 128 * i); *(f32x2*)(o + c0 + 128 * i) = x[u][i] * rstd * fw; }
                continue; }
            float* xs = WSP(float, WS_XS) + (size_t)row * 1024;
            const float* md = modp + ((size_t)l * 9 + mod_row(row)) * 6144;
            bf16_t* hp = WSP(bf16_t, WS_H) + (size_t)row * 1024;
#pragma unroll
            for (int i = 0; i < 8; ++i) { const int c = c0 + 128 * i;
                *(f32x2*)(xs + c) = x[u][i];
                const f32x2 nw = *(const f32x2*)(P.in[I_N1W] + l * 1024 + c), sc = *(const f32x2*)(md + 1024 + c), sh = *(const f32x2*)(md + c);
                const f32x2 h = x[u][i] * rstd * nw * (sc + 1.0f) + sh;
                *(unsigned*)(hp + c) = pk_bf16(h.x, h.y); }
        }
    }
    if (l == DEPTH) return;
    block_rows_visible();
    const int ntile = (re - rb + 15) / 16;
    for (int t = cx.wave; t < ntile; t += 8) {
        const int fr = cx.lane & 15, fq = cx.lane >> 4; const int row = min(rb + t * 16 + fr, re - 1);
        const bf16_t* hp = WSP(bf16_t, WS_H) + (size_t)row * 1024 + fq * 8;
        const bf16_t* wp = WSP(bf16_t, WS_WGT) + ((size_t)l * 16 + fr) * 1024 + fq * 8;
        f32x4 acc = (f32x4){0.f, 0.f, 0.f, 0.f};
#pragma unroll 8
        for (int k0 = 0; k0 < 1024; k0 += 32) acc = __builtin_amdgcn_mfma_f32_16x16x32_bf16(ldg8(wp + k0), ldg8(hp + k0), acc, 0, 0, 0);
        if (rb + t * 16 + fr < re) { const f32x4 bi = *(const f32x4*)(P.in[I_BIN] + l * DIN + 1536 + 4 * fq); *(f32x4*)(WSP(float, WS_GT) + (size_t)row * 16 + 4 * fq) = acc + bi; }
    }
}

DEVI void ph_norm2(const Ctx& cx, int l) {
    const Params& P = *cx.p;
    LAS float* lgs = (LAS float*)cx.lds;
    LAS int* hist = (LAS int*)(cx.lds + 128 * 33 * 4);
    LAS int* pend = hist + 64;
    if (cx.tid < 64) hist[cx.tid] = 0;
    const int r0 = (l == DEPTH - 1) ? TCTX : 0, nr = TT - r0;
    const int rpb = (nr + cx.G - 1) / cx.G;
    const int rb = r0 + cx.bid * rpb, re = min(TT, rb + rpb);
    const float* modp = WSP(float, WS_MOD);
    const int c0 = 2 * cx.lane;
    for (int r2 = rb + cx.wave; r2 < re; r2 += 16) {
        f32x2 x[2][8]; bool ok[2];
#pragma unroll
        for (int u = 0; u < 2; ++u) { const int row = r2 + 8 * u; ok[u] = row < re; const float* src = WSP(float, WS_XMID) + (size_t)(ok[u] ? row : r2) * 1024;
#pragma unroll
            for (int i = 0; i < 8; ++i) x[u][i] = *(const f32x2*)(src + c0 + 128 * i); }
#pragma unroll
        for (int u = 0; u < 2; ++u) {
            const int row = r2 + 8 * u;
            float ss = 0.f;
#pragma unroll
            for (int i = 0; i < 8; ++i) ss += x[u][i].x * x[u][i].x + x[u][i].y * x[u][i].y;
            ss = wave_sum(ss, 0);
            const float rstd = rsqrtf(ss * (1.0f / 1024.0f) + EPS);
            if (!ok[u]) continue;
            const float* md = modp + ((size_t)l * 9 + mod_row(row)) * 6144;
            bf16_t* hp = WSP(bf16_t, WS_H) + (size_t)row * 1024; bf16_t* hl = WSP(bf16_t, WS_HLO) + (size_t)row * 1024; unsigned char* h8 = WSP(unsigned char, WS_H8) + (size_t)row * 1024;
#pragma unroll
            for (int i = 0; i < 8; ++i) { const int c = c0 + 128 * i;
                const f32x2 nw = *(const f32x2*)(P.in[I_N2W] + l * 1024 + c), sc = *(const f32x2*)(md + 4096 + c), sh = *(const f32x2*)(md + 3072 + c);
                const f32x2 h = x[u][i] * rstd * nw * (sc + 1.0f) + sh;
                const int p8 = __builtin_amdgcn_cvt_pk_fp8_f32(h.x, h.y, 0, false);
                const float q0 = __builtin_amdgcn_cvt_f32_fp8(p8, 0), q1 = __builtin_amdgcn_cvt_f32_fp8(p8, 1);
                *(unsigned short*)(h8 + c) = (unsigned short)p8;
                *(unsigned*)(hp + c) = pk_bf16(q0, q1);
                *(unsigned*)(hl + c) = pk_bf16(h.x - q0, h.y - q1); }
        }
    }
    block_rows_visible();
    const int nrow = re - rb, ntile = (nrow + 15) / 16;
    for (int t2 = cx.wave; t2 < ntile * 2; t2 += 8) {
        const int t = t2 >> 1, nt = t2 & 1, fr = cx.lane & 15, fq = cx.lane >> 4; const int row = min(rb + t * 16 + fr, re - 1);
        const bf16_t* hp = WSP(bf16_t, WS_H) + (size_t)row * 1024 + fq * 8; const bf16_t* hl = WSP(bf16_t, WS_HLO) + (size_t)row * 1024 + fq * 8;
        const bf16_t* wh = WSP(bf16_t, WS_RWH) + ((size_t)l * 32 + nt * 16 + fr) * 1024 + fq * 8; const bf16_t* wl = WSP(bf16_t, WS_RWL) + ((size_t)l * 32 + nt * 16 + fr) * 1024 + fq * 8;
        f32x4 acc = (f32x4){0.f, 0.f, 0.f, 0.f}, acc2 = (f32x4){0.f, 0.f, 0.f, 0.f};
#pragma unroll 8
        for (int k0 = 0; k0 < 1024; k0 += 32) { const bf16x8 ah = ldg8(hp + k0), al = ldg8(hl + k0), bh = ldg8(wh + k0), bl = ldg8(wl + k0);
            acc = __builtin_amdgcn_mfma_f32_16x16x32_bf16(bh, ah, acc, 0, 0, 0);
            acc2 = __builtin_amdgcn_mfma_f32_16x16x32_bf16(bl, ah, acc2, 0, 0, 0);
            acc2 = __builtin_amdgcn_mfma_f32_16x16x32_bf16(bh, al, acc2, 0, 0, 0); }
        const int rl = t * 16 + fr;
        if (rl < nrow) {
#pragma unroll
            for (int j = 0; j < 4; ++j) { const int e = nt * 16 + 4 * fq + j; lgs[rl * 33 + e] = acc[j] + acc2[j] + P.in[I_RB][l * 32 + e]; } }
    }
    __syncthreads();
    if (cx.tid < nrow) {
        const LAS float* lp = lgs + cx.tid * 33;
        float tv[4]; int tix[4]; unsigned taken = 0u;
#pragma unroll
        for (int k = 0; k < 4; ++k) { float bv = -3.0e38f; int bi = 0;
            for (int e = 0; e < 32; ++e) { const float v = lp[e]; const bool better = (v > bv) && !((taken >> e) & 1u); bv = better ? v : bv; bi = better ? e : bi; }
            tv[k] = bv; tix[k] = bi; taken |= 1u << bi; }
        const float e1 = __expf(tv[1] - tv[0]), e2 = __expf(tv[2] - tv[0]), e3 = __expf(tv[3] - tv[0]);
        const float inv = 1.0f / (1.0f + e1 + e2 + e3);
        const float gk[4] = {inv, e1 * inv, e2 * inv, e3 * inv};
#pragma unroll
        for (int k = 0; k < 4; ++k) {
            const int ls = __hip_atomic_fetch_add((LAS int*)(hist + tix[k]), 1, __ATOMIC_RELAXED, __HIP_MEMORY_SCOPE_WORKGROUP);
            pend[(cx.tid * 4 + k) * 2 + 0] = (tix[k] << 20) | ls;
            pend[(cx.tid * 4 + k) * 2 + 1] = __float_as_int(gk[k]); }
    }
    __syncthreads();
    if (cx.tid < 32) { unsigned* cnt = (unsigned*)(cx.ws + WS_CTL) + CW_CNT + l * 32;
        hist[32 + cx.tid] = hist[cx.tid] > 0 ? (int)__hip_atomic_fetch_add(cnt + cx.tid, (unsigned)hist[cx.tid], __ATOMIC_RELAXED, __HIP_MEMORY_SCOPE_AGENT) : 0; }
    __syncthreads();
    for (int i = cx.tid; i < nrow * 4; i += NTHR) {
        const int t = pend[i * 2], e = t >> 20, slot = hist[32 + e] + (t & 0xFFFFF), row = rb + (i >> 2);
        WSP(int, WS_ELIST)[(size_t)e * TT + slot] = row;
        WSP(float, WS_GLIST)[(size_t)e * TT + slot] = __int_as_float(pend[i * 2 + 1]);
        WSP(int, WS_TINFO)[(size_t)row * 4 + (i & 3)] = (e << 20) | slot;
    }
}

DEVI int xcd_contig(int bid, int G) { return (G % 8 == 0) ? (bid % 8) * (G / 8) + bid / 8 : bid; }

struct DenseSched {
    const char* A; const char* B; int nM, nN, pm0, G, bid;
    DEVI bool get(int i, g1::Unit& u) const {
        int pm, pn;
        if (G % 8 == 0) { const int x = bid & 7, r = bid >> 3, nx = G >> 3, lo = (nM * x) >> 3, hi = (nM * (x + 1)) >> 3, nr = hi - lo;
            const int q = i * nx + r; if (nr <= 0 || q >= nr * nN) return false; pm = lo + q % nr; pn = q / nr; }
        else { const int L = i * G + bid; if (L >= nM * nN) return false; pm = L / nN; pn = L % nN; }
        u.A = A + (size_t)(pm0 + pm) * 256 * 2048; u.list = nullptr; u.nvalid = 256; u.B = B + (size_t)pn * 256 * 2048; u.pm = pm0 + pm; u.pn = pn; u.e = 0;
        return true;
    }
};
struct MoeSched {
    const char* A; const char* B; const int* elist; const LAS int* info; int NPN, gather, G, bid; size_t bstride; int kb;
    DEVI bool get(int i, g1::Unit& u) const {
        const int NTt = info[32]; int T, pn;
        if (G % 8 == 0 && (G >> 3) % NPN == 0) { const int x = bid & 7, r = bid >> 3, nx = G >> 3, RT = nx / NPN, lo = (NTt * x) >> 3, hi = (NTt * (x + 1)) >> 3;
            T = lo + i * RT + r % RT; pn = r / RT; if (T >= hi) return false; }
        else { const int L = i * G + bid; if (L >= NTt * NPN) return false; T = L / NPN; pn = L % NPN; }
        const int e = info[112 + T], j = T - info[e];
        u.pm = T; u.pn = pn; u.e = e;
        u.B = B + (size_t)e * bstride + (size_t)pn * 256 * kb;
        if (gather) { u.A = A; u.list = elist + (size_t)e * TT + j * 256; u.nvalid = info[40 + e] - j * 256; }
        else { u.A = A + (size_t)T * 256 * kb; u.list = nullptr; u.nvalid = 256; }
        return true;
    }
};

struct EpiIn {
    static constexpr bool PERM = true;
    bf16_t* Pout; const float* bias;
    DEVI void operator()(const f32x4 (&acc)[2][2][4][2], const g1::Unit& u, int wr, int wc, int fr, int fq) const {
        const int row0 = u.pm * 256 + wr * 64 + fr;
#pragma unroll
        for (int bj = 0; bj < 2; ++bj) {
            const int col0 = u.pn * 256 + bj * 128 + wc * 32 + 8 * fq;
            const int seg = u.pn * 2 + bj; const bool gl = (seg >= 15 && seg < 18);
            const f32x4 b0 = *(const f32x4*)(bias + col0), b1 = *(const f32x4*)(bias + col0 + 4);
#pragma unroll
            for (int ai = 0; ai < 2; ++ai)
#pragma unroll
                for (int m = 0; m < 4; ++m) {
                    f32x4 v0 = acc[ai][bj][m][0] + b0, v1 = acc[ai][bj][m][1] + b1;
                    if (gl) {
#pragma unroll
                        for (int j = 0; j < 4; ++j) { v0[j] = gelu_tanh(v0[j]); v1[j] = gelu_tanh(v1[j]); } }
                    u32x4 w; w.x = pk_bf16(v0[0], v0[1]); w.y = pk_bf16(v0[2], v0[3]); w.z = pk_bf16(v1[0], v1[1]); w.w = pk_bf16(v1[2], v1[3]);
                    *(u32x4*)(Pout + (size_t)(row0 + ai * 128 + m * 16) * NP + col0) = w;
                }
        }
    }
};
struct EpiOut {
    static constexpr bool PERM = false;
    const float* xs; float* xmid; const float* mod;
    DEVI void operator()(const f32x4 (&acc)[2][2][4][2], const g1::Unit& u, int wr, int wc, int fr, int fq) const {
        const int row0 = u.pm * 256 + wr * 64 + fr;
        const float* g1p = mod + (size_t)mod_row(u.pm * 256) * 6144 + 2048;
#pragma unroll
        for (int bj = 0; bj < 2; ++bj)
#pragma unroll
            for (int n = 0; n < 2; ++n) {
                const int col = u.pn * 256 + bj * 128 + wc * 32 + 16 * n + 4 * fq;
                const f32x4 gv = *(const f32x4*)(g1p + col);
#pragma unroll
                for (int ai = 0; ai < 2; ++ai)
#pragma unroll
                    for (int m = 0; m < 4; ++m) {
                        const size_t off = (size_t)(row0 + ai * 128 + m * 16) * 1024 + col;
                        const f32x4 xv = *(const f32x4*)(xs + off);
                        *(f32x4*)(xmid + off) = xv + gv * acc[ai][bj][m][n];
                    }
            }
    }
};
struct EpiGU {
    static constexpr bool PERM = true;
    unsigned char* act; const float* bgu;
    DEVI void operator()(const f32x4 (&acc)[2][2][4][2], const g1::Unit& u, int wr, int wc, int fr, int fq) const {
        const int row0 = u.pm * 256 + wr * 64 + fr, colh = u.pn * 128 + wc * 32 + 8 * fq;
        const float* bg = bgu + (size_t)u.e * 2048 + colh; const float* bu = bg + 1024;
        const f32x4 bg0 = *(const f32x4*)bg, bg1 = *(const f32x4*)(bg + 4), bu0 = *(const f32x4*)bu, bu1 = *(const f32x4*)(bu + 4);
#pragma unroll
        for (int ai = 0; ai < 2; ++ai)
#pragma unroll
            for (int m = 0; m < 4; ++m) {
                float o[8];
#pragma unroll
                for (int n = 0; n < 2; ++n)
#pragma unroll
                    for (int j = 0; j < 4; ++j) {
                        const float g = fminf(acc[ai][0][m][n][j] * W8_INV + (n ? bg1[j] : bg0[j]), 7.0f);
                        const float up = fminf(fmaxf(acc[ai][1][m][n][j] * W8_INV + (n ? bu1[j] : bu0[j]), -7.0f), 7.0f);
                        o[n * 4 + j] = (up + 1.0f) * g * frcp(1.0f + __expf(-1.702f * g));
                    }
                u32x2 w; w.x = pk4_fp8(o[0], o[1], o[2], o[3]); w.y = pk4_fp8(o[4], o[5], o[6], o[7]);
                *(u32x2*)(act + (size_t)(row0 + ai * 128 + m * 16) * 1024 + colh) = w;
            }
    }
};
struct EpiDown {
    static constexpr bool PERM = true;
    bf16_t* ypad; const float* bd; const float* glist; const LAS int* info;
    DEVI void operator()(const f32x4 (&acc)[2][2][4][2], const g1::Unit& u, int wr, int wc, int fr, int fq) const {
        const int j256 = (u.pm - info[u.e]) * 256, cnt = info[40 + u.e];
        const int rl0 = wr * 64 + fr;
#pragma unroll
        for (int ai = 0; ai < 2; ++ai)
#pragma unroll
            for (int m = 0; m < 4; ++m) {
                const int rl = rl0 + ai * 128 + m * 16, slot = j256 + rl;
                const float gt = slot < cnt ? glist[(size_t)u.e * TT + slot] : 0.f;
#pragma unroll
                for (int bj = 0; bj < 2; ++bj) {
                    const int col0 = u.pn * 256 + bj * 128 + wc * 32 + 8 * fq;
                    const f32x4 b0 = *(const f32x4*)(bd + (size_t)u.e * 1024 + col0), b1 = *(const f32x4*)(bd + (size_t)u.e * 1024 + col0 + 4);
                    const f32x4 v0 = (acc[ai][bj][m][0] * W8_INV + b0) * gt, v1 = (acc[ai][bj][m][1] * W8_INV + b1) * gt;
                    u32x4 w; w.x = pk_bf16(v0[0], v0[1]); w.y = pk_bf16(v0[2], v0[3]); w.z = pk_bf16(v1[0], v1[1]); w.w = pk_bf16(v1[2], v1[3]);
                    *(u32x4*)(ypad + (size_t)(u.pm * 256 + rl) * 1024 + col0) = w;
                }
            }
    }
};

DEVI void ph_inproj(const Ctx& cx, int l) {
    DenseSched S{(const char*)WSP(bf16_t, WS_H), (const char*)(WSP(bf16_t, WS_WIN) + (size_t)l * NP * 1024), TT / 256, NP / 256, 0, cx.G, cx.bid};
    EpiIn E{WSP(bf16_t, WS_P), WSP(float, WS_BIN2) + (size_t)l * NP};
    g1::gemm_phase<DenseSched, EpiIn, false>(cx.lds, cx.tid, S, E);
}
DEVI void ph_outproj(const Ctx& cx, int l) {
    const int pm0 = (l == DEPTH - 1) ? TCTX / 256 : 0;
    DenseSched S{(const char*)WSP(bf16_t, WS_MRG), (const char*)(WSP(bf16_t, WS_WOUT) + (size_t)l * 1024 * 1024), TT / 256 - pm0, 4, pm0, cx.G, cx.bid};
    EpiOut E{WSP(float, WS_XS), WSP(float, WS_XMID), WSP(float, WS_MOD) + (size_t)l * 9 * 6144};
    g1::gemm_phase<DenseSched, EpiOut, false>(cx.lds, cx.tid, S, E);
}
DEVI void ph_moe_gu(const Ctx& cx, int l) {
    LAS int* info = (LAS int*)(cx.lds + g1::STAGE_BYTES);
    moe_info(cx, l, info);
    MoeSched S{(const char*)WSP(unsigned char, WS_H8), (const char*)(WSP(unsigned char, WS_WGU) + (size_t)l * NE * 2048 * 1024), WSP(int, WS_ELIST), info, 8, 1, cx.G, cx.bid, (size_t)2048 * 1024, 1024};
    EpiGU E{WSP(unsigned char, WS_ACT), cx.p->in[I_BGU] + (size_t)l * NE * 2048};
    g1::gemm_phase<MoeSched, EpiGU, true, true>(cx.lds, cx.tid, S, E);
}
DEVI void ph_moe_dn(const Ctx& cx, int l) {
    LAS int* info = (LAS int*)(cx.lds + g1::STAGE_BYTES);
    moe_info(cx, l, info);
    MoeSched S{(const char*)WSP(unsigned char, WS_ACT), (const char*)(WSP(unsigned char, WS_WD) + (size_t)l * NE * 1024 * 1024), nullptr, info, 4, 0, cx.G, cx.bid, (size_t)1024 * 1024, 1024};
    EpiDown E{WSP(bf16_t, WS_YPAD), cx.p->in[I_BD] + (size_t)l * NE * 1024, WSP(float, WS_GLIST), info};
    g1::gemm_phase<MoeSched, EpiDown, false, true>(cx.lds, cx.tid, S, E);
}

DEVI int ml_row0(int b, int c) { return c < 2 ? b * CTXL + c * 128 : TCTX + b * SEQ + (c - 2) * 128; }
DEVI unsigned short lds_u16(const LAS bf16_t* p) { return *p; }

DEVI void ml_local_unit(const Ctx& cx, int l, int b, int h, int c) {
    LAS float* sg = (LAS float*)cx.lds;
    LAS float* se = sg + 256;
    LAS float* red = se + 256;
    LAS bf16_t* Ks = (LAS bf16_t*)(cx.lds + 4352);
    LAS bf16_t* Ve = Ks + 128 * 104;
    const int row0 = ml_row0(b, c), tid = cx.tid;
    const int dir = (tid >> 7) & 1, i = tid & 127, p = dir ? 127 - i : i;
    const bool act = tid < 256;
    float gi = 0.f, bval = 0.f, u = 0.f;
    if (act) { const float* gt = WSP(float, WS_GT) + (size_t)(row0 + i) * 16; gi = gt[dir * 4 + h]; const float gf = gt[8 + dir * 4 + h];
        sg[dir * 128 + p] = fminf(gf, 0.f) - log1p_(__expf(-fabsf(gf))); }
    LDS_SYNC();
#pragma unroll 1
    for (int off = 1; off < 128; off <<= 1) { float v = 0.f; if (act) { v = sg[dir * 128 + p]; if (p >= off) v += sg[dir * 128 + p - off]; } LDS_SYNC(); if (act) sg[dir * 128 + p] = v; LDS_SYNC(); }
    if (act) { bval = sg[dir * 128 + p]; u = gi - bval; if (p == 127) red[dir] = bval; }
    LDS_SYNC();
    if (act) sg[dir * 128 + p] = u;
    LDS_SYNC();
#pragma unroll 1
    for (int off = 1; off < 128; off <<= 1) { float v = 0.f; if (act) { v = sg[dir * 128 + p]; if (p >= off) v = fmaxf(v, sg[dir * 128 + p - off]); } LDS_SYNC(); if (act) sg[dir * 128 + p] = v; LDS_SYNC(); }
    if (act) { const float cm = sg[dir * 128 + p]; if (p == 127) red[2 + dir] = cm;
        const size_t gix = (size_t)(row0 + i) * 8 + dir * 4 + h;
        WSP(float, WS_GB)[gix] = bval; WSP(float, WS_GU)[gix] = u; WSP(float, WS_GCM)[gix] = cm; }
    LDS_SYNC();
    if (act) se[dir * 128 + i] = expf(u - red[2 + dir]);
    if (tid < 2) { float* msc = WSP(float, WS_MSC) + ((size_t)((b * 4 + h) * MLC + c) * 2 + tid) * 2; msc[0] = red[tid]; msc[1] = red[tid] + red[2 + tid]; }
    LDS_SYNC();
    const bf16_t* Pp = WSP(bf16_t, WS_P);
#pragma unroll
    for (int it = 0; it < 3; ++it) { const int idx = tid + NTHR * it, r = idx / 12, ch = idx % 12;
        const u32x4 kv = *(const u32x4*)(Pp + (size_t)(row0 + r) * NP + PC_K + h * 96 + ch * 8);
        *(LAS u32x4*)(Ks + r * 104 + ch * 8) = kv;
        const u32x4 vv = *(const u32x4*)(Pp + (size_t)(row0 + r) * NP + PC_V + h * 96 + ch * 8);
        const float e0 = se[r], e1 = se[128 + r];
        u32x4 o0, o1;
#pragma unroll
        for (int q = 0; q < 4; ++q) { const float lo = __uint_as_float(vv[q] << 16), hi = __uint_as_float(vv[q] & 0xFFFF0000u);
            o0[q] = pk_bf16(lo * e0, hi * e0); o1[q] = pk_bf16(lo * e1, hi * e1); }
        *(LAS u32x4*)(Ve + r * 104 + ch * 8) = o0; *(LAS u32x4*)(Ve + (128 + r) * 104 + ch * 8) = o1; }
    LDS_SYNC();
    {
        const int wd = cx.wave >> 2, q9 = (cx.wave & 3) * 9, fr = cx.lane & 15, fq = cx.lane >> 4;
        float* cl = WSP(float, WS_CLOC) + ((size_t)((b * 4 + h) * MLC + c) * 2 + wd) * 9216;
        const LAS bf16_t* V = Ve + wd * 128 * 104;
#pragma unroll 1
        for (int pi = q9; pi < q9 + 9; ++pi) { const int dt = pi / 6, et = pi % 6;
            f32x4 acc = (f32x4){0.f, 0.f, 0.f, 0.f};
#pragma unroll
            for (int kk = 0; kk < 4; ++kk) { bf16x8 a, bb;
#pragma unroll
                for (int j = 0; j < 8; ++j) { const int s = kk * 32 + fq * 8 + j; a[j] = (short)lds_u16(V + s * 104 + dt * 16 + fr); bb[j] = (short)lds_u16(Ks + s * 104 + et * 16 + fr); }
                acc = __builtin_amdgcn_mfma_f32_16x16x32_bf16(a, bb, acc, 0, 0, 0); }
#pragma unroll
            for (int r = 0; r < 4; ++r) cl[(dt * 16 + fq * 4 + r) * 96 + et * 16 + fr] = acc[r]; }
    }
    if (tid < 192) { const int d2 = tid / 96, e = tid % 96; float s = 0.f;
        for (int t = 0; t < 128; ++t) s += se[d2 * 128 + t] * bf2f(Ks[t * 104 + e]);
        WSP(float, WS_NLOC)[((size_t)((b * 4 + h) * MLC + c) * 2 + d2) * 96 + e] = s; }
    LDS_SYNC();
}

DEVI void ml_carry(const Ctx& cx) {
    for (int idx = cx.bid * NTHR + cx.tid; idx < 64 * 9312; idx += cx.G * NTHR) {
        const int combo = idx / 9312, el = idx % 9312, dir = combo & 1, bh = combo >> 1;
        float loc[MLC], bl[MLC], ml[MLC];
#pragma unroll
        for (int s = 0; s < MLC; ++s) {
            const int c = dir == 0 ? s : (s < 2 ? 1 - s : 19 - s);
            const size_t cb = (size_t)(bh * MLC + c) * 2 + dir;
            bl[s] = WSP(float, WS_MSC)[cb * 2]; ml[s] = WSP(float, WS_MSC)[cb * 2 + 1];
            loc[s] = el < 9216 ? WSP(float, WS_CLOC)[cb * 9216 + el] : WSP(float, WS_NLOC)[cb * 96 + el - 9216];
        }
        float Cv = 0.f, m = -1e30f;
#pragma unroll
        for (int s = 0; s < MLC; ++s) {
            const int c = dir == 0 ? s : (s < 2 ? 1 - s : 19 - s);
            const size_t cb = (size_t)(bh * MLC + c) * 2 + dir;
            if (el < 9216) WSP(bf16_t, WS_C0)[cb * 9216 + el] = f2bf(Cv); else WSP(float, WS_N0)[cb * 96 + el - 9216] = Cv;
            if (el == 0) WSP(float, WS_M0)[cb] = m;
            const float mn = fmaxf(bl[s] + m, ml[s]), a = __expf(bl[s] + m - mn), sc = __expf(ml[s] - mn);
            Cv = a * Cv + sc * loc[s]; m = mn;
        }
    }
}

DEVI void ml_out_unit(const Ctx& cx, int l, int b, int h, int c) {
    LAS bf16_t* Qs = (LAS bf16_t*)cx.lds;
    LAS bf16_t* Ks = Qs + 128 * 104;
    LAS bf16_t* Vs = Ks + 128 * 104;
    LAS bf16_t* C0s = Vs + 128 * 104;
    LAS float* gb = (LAS float*)(cx.lds + 119808);
    LAS float* gu = gb + 256;
    LAS float* gM = gu + 256;
    LAS float* n0s = gM + 256;
    LAS float* m0s = n0s + 192;
    const int row0 = ml_row0(b, c), tid = cx.tid;
    const bf16_t* Pp = WSP(bf16_t, WS_P);
    const size_t cb0 = (size_t)((b * 4 + h) * MLC + c) * 2;
#pragma unroll
    for (int it = 0; it < 3; ++it) { const int idx = tid + NTHR * it, r = idx / 12, ch = idx % 12;
        const bf16_t* rp = Pp + (size_t)(row0 + r) * NP + h * 96 + ch * 8;
        *(LAS u32x4*)(Qs + r * 104 + ch * 8) = *(const u32x4*)(rp + PC_Q);
        *(LAS u32x4*)(Ks + r * 104 + ch * 8) = *(const u32x4*)(rp + PC_K);
        *(LAS u32x4*)(Vs + r * 104 + ch * 8) = *(const u32x4*)(rp + PC_V); }
    for (int idx = tid; idx < 2 * 96 * 12; idx += NTHR) { const int d2 = idx / 1152, r = (idx % 1152) / 12, ch = idx % 12;
        *(LAS u32x4*)(C0s + (d2 * 96 + r) * 104 + ch * 8) = *(const u32x4*)(WSP(bf16_t, WS_C0) + (cb0 + d2) * 9216 + r * 96 + ch * 8); }
    if (tid < 256) { const int d2 = tid >> 7, i = tid & 127; const size_t gix = (size_t)(row0 + i) * 8 + d2 * 4 + h;
        gb[tid] = WSP(float, WS_GB)[gix]; gu[tid] = WSP(float, WS_GU)[gix];
        gM[tid] = fmaxf(WSP(float, WS_M0)[cb0 + d2], WSP(float, WS_GCM)[gix]); }
    if (tid >= 256 && tid < 448) { const int k = tid - 256; n0s[k] = WSP(float, WS_N0)[(cb0 + k / 96) * 96 + k % 96]; }
    if (tid >= 448 && tid < 450) m0s[tid - 448] = WSP(float, WS_M0)[cb0 + tid - 448];
    LDS_SYNC();
    const int w = cx.wave, fr = cx.lane & 15, fq = cx.lane >> 4, t = 16 * w + fr;
    bf16x8 qf[3];
#pragma unroll
    for (int kk = 0; kk < 3; ++kk) qf[kk] = *(const LAS bf16x8*)(Qs + t * 104 + kk * 32 + fq * 8);
    f32x4 hs[6];
#pragma unroll
    for (int n = 0; n < 6; ++n) hs[n] = (f32x4){0.f, 0.f, 0.f, 0.f};
#pragma unroll
    for (int dir = 0; dir < 2; ++dir) {
        const float Mt = gM[dir * 128 + t], bt = gb[dir * 128 + t], inter = __expf(m0s[dir] - Mt);
        f32x4 an[6];
#pragma unroll
        for (int n = 0; n < 6; ++n) an[n] = (f32x4){0.f, 0.f, 0.f, 0.f};
        float den = 0.f;
        const int Jlo = dir == 0 ? 0 : (w >> 1), Jhi = dir == 0 ? (w >> 1) : 3;
#pragma unroll 1
        for (int J = Jlo; J <= Jhi; ++J) {
            bf16x8 pf;
#pragma unroll
            for (int half = 0; half < 2; ++half) {
                const int j = 2 * J + half;
                f32x4 D = (f32x4){0.f, 0.f, 0.f, 0.f};
                const bool need = dir == 0 ? (j <= w) : (j >= w);
                if (need) {
#pragma unroll
                    for (int kk = 0; kk < 3; ++kk) { const bf16x8 kf = *(const LAS bf16x8*)(Ks + (16 * j + fr) * 104 + kk * 32 + fq * 8);
                        D = __builtin_amdgcn_mfma_f32_16x16x32_bf16(kf, qf[kk], D, 0, 0, 0); }
                }
                const f32x4 us = *(const LAS f32x4*)(gu + dir * 128 + 16 * j + 4 * fq);
                float pv[4];
#pragma unroll
                for (int r = 0; r < 4; ++r) { const int s = 16 * j + 4 * fq + r; const bool valid = need && (dir == 0 ? (s <= t) : (s >= t));
                    pv[r] = valid ? D[r] * __expf(us[r] - Mt) : 0.f; den += pv[r]; }
                pf[half * 4 + 0] = (short)f2bf(pv[0]); pf[half * 4 + 1] = (short)f2bf(pv[1]); pf[half * 4 + 2] = (short)f2bf(pv[2]); pf[half * 4 + 3] = (short)f2bf(pv[3]);
            }
#pragma unroll
            for (int n = 0; n < 6; ++n) { bf16x8 vf;
#pragma unroll
                for (int jj = 0; jj < 8; ++jj) { const int s = 32 * J + (jj < 4 ? 4 * fq + jj : 16 + 4 * fq + (jj - 4)); vf[jj] = (short)lds_u16(Vs + s * 104 + 16 * n + fr); }
                an[n] = __builtin_amdgcn_mfma_f32_16x16x32_bf16(vf, pf, an[n], 0, 0, 0); }
        }
        float nq = 0.f;
#pragma unroll
        for (int kk = 0; kk < 3; ++kk)
#pragma unroll
            for (int j = 0; j < 8; ++j) nq += n0s[dir * 96 + kk * 32 + fq * 8 + j] * bf2f((bf16_t)qf[kk][j]);
        nq += shx<16>(nq, cx.lane); nq += shx<32>(nq, cx.lane);
        den += shx<16>(den, cx.lane); den += shx<32>(den, cx.lane);
        const float dtot = den + inter * nq;
        const float inv = frcp(fmaxf(fabsf(dtot), __expf(-(Mt + bt))));
#pragma unroll
        for (int n = 0; n < 6; ++n) { f32x4 ac = (f32x4){0.f, 0.f, 0.f, 0.f};
#pragma unroll
            for (int kk = 0; kk < 3; ++kk) { const bf16x8 cf = *(const LAS bf16x8*)(C0s + (dir * 96 + 16 * n + fr) * 104 + kk * 32 + fq * 8);
                ac = __builtin_amdgcn_mfma_f32_16x16x32_bf16(cf, qf[kk], ac, 0, 0, 0); }
            hs[n] += (an[n] + ac * inter) * inv; }
    }
    float ss = 0.f;
#pragma unroll
    for (int n = 0; n < 6; ++n) ss += hs[n][0] * hs[n][0] + hs[n][1] * hs[n][1] + hs[n][2] * hs[n][2] + hs[n][3] * hs[n][3];
    ss += shx<16>(ss, cx.lane); ss += shx<32>(ss, cx.lane);
    const float rstd = rsqrtf(ss * (1.0f / 96.0f) + EPS);
    const size_t prow = (size_t)(row0 + t);
#pragma unroll
    for (int n = 0; n < 6; ++n) { const int d = 16 * n + 4 * fq;
        const u32x2 ov = *(const u32x2*)(Pp + prow * NP + PC_O + h * 96 + d);
        const f32x4 mw = *(const f32x4*)(cx.p->in[I_MIXW] + l * 1024 + h * 96 + d);
        const float o0 = __uint_as_float(ov.x << 16), o1 = __uint_as_float(ov.x & 0xFFFF0000u), o2 = __uint_as_float(ov.y << 16), o3 = __uint_as_float(ov.y & 0xFFFF0000u);
        u32x2 wv; wv.x = pk_bf16(sigmoidf_(o0) * hs[n][0] * rstd * mw[0], sigmoidf_(o1) * hs[n][1] * rstd * mw[1]);
        wv.y = pk_bf16(sigmoidf_(o2) * hs[n][2] * rstd * mw[2], sigmoidf_(o3) * hs[n][3] * rstd * mw[3]);
        *(u32x2*)(WSP(bf16_t, WS_MRG) + prow * 1024 + h * 96 + d) = wv; }
    LDS_SYNC();
}

DEVI void rg_unit(const Ctx& cx, int l, int b, int ck, int g, int mode) {
    const Params& P = *cx.p;
    LAS float* xraw = (LAS float*)cx.lds;
    LAS float* xc = (LAS float*)(cx.lds + 17408);
    LAS bf16_t* xcb = (LAS bf16_t*)(cx.lds + 33792);
    LAS float* ab = (LAS float*)(cx.lds + 43008);
    const int tid = cx.tid;
    const int t0 = ck < 4 ? ck * 64 : (ck - 4) * 64, seglen = ck < 4 ? CTXL : SEQ, rowbase = ck < 4 ? b * CTXL : TCTX + b * SEQ;
    const bf16_t* Pp = WSP(bf16_t, WS_P);
    for (int idx = tid; idx < 67 * 8; idx += NTHR) { const int r = idx >> 3, c8 = idx & 7, tt = t0 - 2 + r;
        u32x4 v = (u32x4){0u, 0u, 0u, 0u};
        if (tt >= 0 && tt < seglen) v = *(const u32x4*)(Pp + (size_t)(rowbase + tt) * NP + PC_RX + g * 64 + c8 * 8);
#pragma unroll
        for (int q = 0; q < 4; ++q) { xraw[r * 64 + c8 * 8 + 2 * q] = __uint_as_float(v[q] << 16); xraw[r * 64 + c8 * 8 + 2 * q + 1] = __uint_as_float(v[q] & 0xFFFF0000u); } }
    LDS_SYNC();
#pragma unroll
    for (int it = 0; it < 8; ++it) { const int idx = tid + NTHR * it, t = idx >> 6, ch = idx & 63, cg = g * 64 + ch;
        float v = P.in[I_RGCB][l * 384 + cg];
#pragma unroll
        for (int j = 0; j < 4; ++j) v += P.in[I_RGCW][(l * 4 + j) * 384 + cg] * xraw[(t + j) * 64 + ch];
        xc[t * 64 + ch] = v; xcb[t * 72 + ch] = f2bf(v); }
    LDS_SYNC();
    {
        const int dir = cx.wave >> 2, cg4 = cx.wave & 3, fr = cx.lane & 15, fq = cx.lane >> 4;
        const bf16_t* wrg = WSP(bf16_t, WS_WRG) + (size_t)(l * 6 + g) * 256 * 64;
        f32x4 ar[4], ai[4];
#pragma unroll
        for (int m = 0; m < 4; ++m) { ar[m] = (f32x4){0.f, 0.f, 0.f, 0.f}; ai[m] = (f32x4){0.f, 0.f, 0.f, 0.f}; }
#pragma unroll
        for (int kk = 0; kk < 2; ++kk) {
            const bf16x8 br = ldg8(wrg + (size_t)((dir * 2 + 0) * 64 + cg4 * 16 + fr) * 64 + kk * 32 + fq * 8);
            const bf16x8 bi = ldg8(wrg + (size_t)((dir * 2 + 1) * 64 + cg4 * 16 + fr) * 64 + kk * 32 + fq * 8);
#pragma unroll
            for (int m = 0; m < 4; ++m) { const bf16x8 a = *(const LAS bf16x8*)(xcb + (m * 16 + fr) * 72 + kk * 32 + fq * 8);
                ar[m] = __builtin_amdgcn_mfma_f32_16x16x32_bf16(br, a, ar[m], 0, 0, 0); ai[m] = __builtin_amdgcn_mfma_f32_16x16x32_bf16(bi, a, ai[m], 0, 0, 0); }
        }
        const int ch0 = cg4 * 16 + 4 * fq, cgl = g * 64 + ch0;
        const f32x4 ba = *(const f32x4*)(P.in[I_RGBA] + (l * 2 + dir) * 384 + cgl), bx = *(const f32x4*)(P.in[I_RGBX] + (l * 2 + dir) * 384 + cgl);
        const f32x4 lam = *(const f32x4*)(P.in[I_RGLAM] + (l * 2 + dir) * 384 + cgl);
        float sp[4];
#pragma unroll
        for (int j = 0; j < 4; ++j) sp[j] = lam[j] > 0.f ? log1p_(__expf(-lam[j])) : -lam[j] + log1p_(__expf(lam[j]));
#pragma unroll
        for (int m = 0; m < 4; ++m) { const int t = m * 16 + fr; const f32x4 xv = *(const LAS f32x4*)(xc + t * 64 + ch0);
            f32x4 av, bv;
#pragma unroll
            for (int j = 0; j < 4; ++j) { const float r = frcp(1.0f + __expf(-(ar[m][j] + ba[j]))), ii = frcp(1.0f + __expf(-(ai[m][j] + bx[j])));
                const float la = -8.0f * r * sp[j], y = 2.0f * la; av[j] = __expf(la);
                const float nem1 = y > -0.3f ? -y * (1.0f + y * (0.5f + y * (0.16666667f + y * (0.041666668f + y * 0.0083333338f)))) : 1.0f - __expf(y);
                bv[j] = sqrtf(nem1) * (ii * xv[j]); }
            *(LAS f32x4*)(ab + ((dir * 2 + 0) * 64 + t) * 64 + ch0) = av; *(LAS f32x4*)(ab + ((dir * 2 + 1) * 64 + t) * 64 + ch0) = bv; }
    }
    LDS_SYNC();
    if (tid < 128) { const int dir = tid >> 6, ch = tid & 63; const size_t ix = ((size_t)(b * RGC + ck) * 2 + dir) * 384 + g * 64 + ch;
        float hc = mode ? WSP(float, WS_RGC)[ix] : 0.f, ap = 1.0f;
        LAS float* A = ab + (dir * 2 + 0) * 4096 + ch; LAS float* B = ab + (dir * 2 + 1) * 4096 + ch;
#pragma unroll 8
        for (int s = 0; s < 64; ++s) { const int t = dir ? 63 - s : s; const float a = A[t * 64]; hc = a * hc + B[t * 64]; ap *= a; if (mode) B[t * 64] = hc; }
        if (!mode) { WSP(float, WS_RGA)[ix] = ap; WSP(float, WS_RGB)[ix] = hc; } }
    LDS_SYNC();
    if (mode) { const int t = tid >> 3, ch0 = (tid & 7) * 8; float hv[8]; float ss = 0.f;
#pragma unroll
        for (int j = 0; j < 8; ++j) { hv[j] = ab[(1 * 64 + t) * 64 + ch0 + j] + ab[(3 * 64 + t) * 64 + ch0 + j]; ss += hv[j] * hv[j]; }
        ss += dpp_<0xB1, 0xF>(ss); ss += dpp_<0x4E, 0xF>(ss); ss += dpp_<0x141, 0xF>(ss);
        const float rstd = rsqrtf(ss * (1.0f / 64.0f) + EPS);
        const size_t row = (size_t)(rowbase + t0 + t);
        const u32x4 gv = *(const u32x4*)(Pp + row * NP + PC_RG + g * 64 + ch0);
        const float* mw = P.in[I_MIXW] + l * 1024 + 384 + g * 64 + ch0;
        u32x4 o;
#pragma unroll
        for (int q = 0; q < 4; ++q) { const float g0 = __uint_as_float(gv[q] << 16), g1v = __uint_as_float(gv[q] & 0xFFFF0000u);
            o[q] = pk_bf16(g0 * hv[2 * q] * rstd * mw[2 * q], g1v * hv[2 * q + 1] * rstd * mw[2 * q + 1]); }
        *(u32x4*)(WSP(bf16_t, WS_MRG) + row * 1024 + 384 + g * 64 + ch0) = o;
        LDS_SYNC(); }
}
DEVI void rg_carry(const Ctx& cx) {
    for (int idx = (cx.G - 1 - cx.bid) * NTHR + cx.tid; idx < NB * 2 * 384; idx += cx.G * NTHR) {
        const int ch = idx % 384, dir = (idx / 384) & 1, b = idx / 768;
        float A[RGC], B[RGC];
#pragma unroll
        for (int s = 0; s < RGC; ++s) { const int ck = dir == 0 ? s : (s < 4 ? 3 - s : 39 - s);
            const size_t ix = ((size_t)(b * RGC + ck) * 2 + dir) * 384 + ch; A[s] = WSP(float, WS_RGA)[ix]; B[s] = WSP(float, WS_RGB)[ix]; }
        float h = 0.f;
#pragma unroll
        for (int s = 0; s < RGC; ++s) { const int ck = dir == 0 ? s : (s < 4 ? 3 - s : 39 - s);
            const size_t ix = ((size_t)(b * RGC + ck) * 2 + dir) * 384 + ch; WSP(float, WS_RGC)[ix] = h; h = A[s] * h + B[s]; }
    }
}

DEVI int s5_trow(int rowi, int s) { const int b = rowi / S5C, c = rowi % S5C; return c < 8 ? b * CTXL + c * 32 + s : TCTX + b * SEQ + s * 64 + (c - 8); }
DEVI void s5_local_wave(const Ctx& cx, int l, int wu) {
    const int g = wu / 36, mt = (wu % 36) / 4, nt = wu % 4;
    const bf16_t* Pp = WSP(bf16_t, WS_P) + PC_S5 + g * 16;
    const bf16_t* we = WSP(bf16_t, WS_WE) + (size_t)(l * 16 + g) * 256 * 512 + (size_t)nt * 64 * 512;
    f32x4 acc[4][4];
    wave_gemm<4, 4>(cx.lane, 512, [&](int row, int k) { return ldg8(Pp + (size_t)s5_trow(mt * 64 + row, k >> 4) * NP + (k & 15)); },
                         [&](int row, int k) { return ldg8(we + (size_t)row * 512 + k); }, acc);
    const int fr = cx.lane & 15, fq = cx.lane >> 4;
#pragma unroll
    for (int m = 0; m < 4; ++m)
#pragma unroll
        for (int n = 0; n < 4; ++n) *(f32x4*)(WSP(float, WS_SLOC) + ((size_t)g * S5R + mt * 64 + m * 16 + fr) * 256 + nt * 64 + n * 16 + 4 * fq) = acc[m][n];
}
DEVI void s5_carry(const Ctx& cx, int l) {
    for (int idx = cx.bid * NTHR + cx.tid; idx < NB * 16 * 2 * 64; idx += cx.G * NTHR) {
        const int n = idx & 63, d = (idx >> 6) & 1, g = (idx >> 7) & 15, b = idx >> 11;
        const f32x2 a32 = WSP(f32x2, WS_PW)[(size_t)(((l * 16 + g) * 2 + d) * 64 + n) * 33 + 32];
        float sr = 0.f, si = 0.f;
#pragma unroll 1
        for (int s0 = 0; s0 < S5C; s0 += 24) {
            float lr[24], li[24];
#pragma unroll
            for (int j = 0; j < 24; ++j) { const int s = s0 + j, c = d == 0 ? s : (s < 8 ? 7 - s : 79 - s);
                const size_t ix = ((size_t)g * S5R + b * S5C + c) * 256 + d * 128 + n; lr[j] = WSP(float, WS_SLOC)[ix]; li[j] = WSP(float, WS_SLOC)[ix + 64]; }
#pragma unroll
            for (int j = 0; j < 24; ++j) { const int s = s0 + j, c = d == 0 ? s : (s < 8 ? 7 - s : 79 - s);
                const size_t ix = ((size_t)g * S5R + b * S5C + c) * 256 + d * 128 + n;
                WSP(bf16_t, WS_SIN)[ix] = f2bf(sr); WSP(bf16_t, WS_SIN)[ix + 64] = f2bf(si);
                const float nr = a32.x * sr - a32.y * si + lr[j], ni = a32.x * si + a32.y * sr + li[j]; sr = nr; si = ni; }
        }
    }
}
DEVI void s5_out_wave(const Ctx& cx, int l, int wu) {
    const int g = wu / 72, mt = (wu % 72) / 8, nt = wu % 8;
    const bf16_t* Pp = WSP(bf16_t, WS_P) + PC_S5 + g * 16;
    const bf16_t* sin_ = WSP(bf16_t, WS_SIN) + (size_t)g * S5R * 256;
    const bf16_t* wy = WSP(bf16_t, WS_WY) + (size_t)(l * 16 + g) * 512 * 768 + (size_t)nt * 64 * 768;
    f32x4 acc[4][4];
    wave_gemm<4, 4>(cx.lane, 768, [&](int row, int k) { return k < 512 ? ldg8(Pp + (size_t)s5_trow(mt * 64 + row, k >> 4) * NP + (k & 15)) : ldg8(sin_ + (size_t)(mt * 64 + row) * 256 + (k - 512)); },
                         [&](int row, int k) { return ldg8(wy + (size_t)row * 768 + k); }, acc);
    const int fr = cx.lane & 15, fq = cx.lane >> 4;
#pragma unroll
    for (int m = 0; m < 4; ++m)
#pragma unroll
        for (int n = 0; n < 4; ++n) { const int trow = s5_trow(mt * 64 + m * 16 + fr, nt * 4 + n);
            u32x2 w; w.x = pk_bf16(gelu_tanh(acc[m][n][0]), gelu_tanh(acc[m][n][1])); w.y = pk_bf16(gelu_tanh(acc[m][n][2]), gelu_tanh(acc[m][n][3]));
            *(u32x2*)(WSP(bf16_t, WS_GS) + (size_t)trow * 256 + g * 16 + 4 * fq) = w; }
}
DEVI void s5_glu_wave(const Ctx& cx, int l, int wu) {
    const int mt = wu / 4, nt = wu % 4;
    const bf16_t* gs = WSP(bf16_t, WS_GS) + (size_t)mt * 64 * 256;
    const bf16_t* wg = WSP(bf16_t, WS_WGLU) + (size_t)l * 65536 + (size_t)nt * 64 * 256;
    f32x4 acc[4][4];
    wave_gemm<4, 4>(cx.lane, 256, [&](int row, int k) { return ldg8(gs + (size_t)row * 256 + k); }, [&](int row, int k) { return ldg8(wg + (size_t)row * 256 + k); }, acc);
    const int fr = cx.lane & 15, fq = cx.lane >> 4;
#pragma unroll
    for (int n = 0; n < 4; ++n) { const int col = nt * 64 + n * 16 + 4 * fq;
        const f32x4 gb = *(const f32x4*)(cx.p->in[I_S5GB] + l * 256 + col), mw = *(const f32x4*)(cx.p->in[I_MIXW] + l * 1024 + 768 + col);
#pragma unroll
        for (int m = 0; m < 4; ++m) { const size_t trow = (size_t)mt * 64 + m * 16 + fr;
            const u32x2 gv = *(const u32x2*)(WSP(bf16_t, WS_GS) + trow * 256 + col);
            const float gq[4] = {__uint_as_float(gv.x << 16), __uint_as_float(gv.x & 0xFFFF0000u), __uint_as_float(gv.y << 16), __uint_as_float(gv.y & 0xFFFF0000u)};
            float o[4]; float ss = 0.f;
#pragma unroll
            for (int j = 0; j < 4; ++j) { o[j] = gq[j] * frcp(1.0f + __expf(-(acc[m][n][j] + gb[j]))); ss += o[j] * o[j]; }
            ss += shx<16>(ss, cx.lane); ss += shx<32>(ss, cx.lane);
            const float rstd = rsqrtf(ss * (1.0f / 16.0f) + EPS);
            u32x2 w; w.x = pk_bf16(o[0] * rstd * mw[0], o[1] * rstd * mw[1]); w.y = pk_bf16(o[2] * rstd * mw[2], o[3] * rstd * mw[3]);
            *(u32x2*)(WSP(bf16_t, WS_MRG) + trow * 1024 + 768 + col) = w; } }
}

#ifndef PH_DUP2
#define PH_DUP2 0
#endif
#define REP_(k) for (int rep_ = 0; rep_ < 1 + ((PH_DUP2 >> (k)) & 1); ++rep_)
DEVI void ph_mix_local(const Ctx& cx, int l) {
    REP_(0) for (int u = cx.bid; u < NB * 4 * MLC; u += cx.G) ml_local_unit(cx, l, u / (4 * MLC), (u / MLC) % 4, u % MLC);
    REP_(1) { const int off = (NB * 4 * MLC) % cx.G; const int first = (cx.bid - off + cx.G) % cx.G;
      for (int u = first; u < NB * RGC * 6; u += cx.G) rg_unit(cx, l, u / (RGC * 6), (u / 6) % RGC, u % 6, 0); }
    REP_(2) { const int off = (NB * 4 * MLC + NB * RGC * 6) % cx.G; const int first = (cx.bid - off + cx.G) % cx.G;
      for (int wu = first * 8 + cx.wave; wu < 16 * 36; wu += cx.G * 8) s5_local_wave(cx, l, wu); }
}
DEVI void ph_mix_carry(const Ctx& cx, int l) { ml_carry(cx); rg_carry(cx); s5_carry(cx, l); }
DEVI void ph_mix_out(const Ctx& cx, int l) {
    const bool last = (l == DEPTH - 1);
    REP_(3) for (int u = cx.bid; u < NB * 4 * MLC; u += cx.G) { const int c = u % MLC; if (last && c < 2) continue; ml_out_unit(cx, l, u / (4 * MLC), (u / MLC) % 4, c); }
    REP_(4) { const int off = (NB * 4 * MLC) % cx.G; const int first = (cx.bid - off + cx.G) % cx.G;
      for (int u = first; u < NB * RGC * 6; u += cx.G) { const int ck = (u / 6) % RGC; if (last && ck < 4) continue; rg_unit(cx, l, u / (RGC * 6), ck, u % 6, 1); } }
    REP_(5) { const int off = (NB * 4 * MLC + NB * RGC * 6) % cx.G; const int first = (cx.bid - off + cx.G) % cx.G;
      for (int wu = first * 8 + cx.wave; wu < 16 * 72; wu += cx.G * 8) s5_out_wave(cx, l, wu); }
}
DEVI void ph_glu(const Ctx& cx, int l) {
    for (int wu = cx.bid * 8 + cx.wave; wu < (TT / 64) * 4; wu += cx.G * 8) s5_glu_wave(cx, l, wu);
}

DEVI unsigned st_launder(unsigned s_addr) { unsigned a; asm volatile("v_mov_b32 %0, %1" : "=v"(a) : "s"(s_addr)); return a; }
constexpr int N_STEPS = 3 + 10 * DEPTH + 1;
__global__ void __launch_bounds__(NTHR, 2) mk_fwd(Params p) {
    extern __shared__ __attribute__((aligned(16))) unsigned char lds_raw[];
    Ctx cx; cx.p = &p; cx.ws = p.ws; cx.lds = (LAS unsigned char*)lds_raw; cx.tid = threadIdx.x; cx.lane = cx.tid & 63;
    cx.wave = __builtin_amdgcn_readfirstlane((int)threadIdx.x >> 6); cx.G = gridDim.x; cx.bid = blockIdx.x;
    volatile LAS unsigned* st = (volatile LAS unsigned*)(cx.lds + LDS_BYTES - 16);
    const unsigned st_s = (unsigned)__builtin_amdgcn_readfirstlane((int)(unsigned)(size_t)(LAS unsigned*)(cx.lds + LDS_BYTES - 16));
#define ST_P ((volatile LAS unsigned*)(size_t)st_launder(st_s))
    if (cx.tid == 0) { st[0] = 0u; st[1] = 0u; st[2] = (unsigned)p.lo; st[3] = (unsigned)p.hi; }
    __syncthreads();
    (void)xcd_barrier_post((unsigned*)(p.ws + WS_CTL) + CW_BAR, st);
#define GRID_BAR() do { XcdBarrier b_; b_.bar = (unsigned*)(p.ws + WS_CTL) + CW_BAR; b_.x = (unsigned)__builtin_amdgcn_readfirstlane((int)xb_xcc_id()); b_.st = ST_P; xcd_barrier(b_); } while (0)
#ifndef PH_MASK
#define PH_MASK 0xFFFF
#endif
#ifndef PH_DUP
#define PH_DUP 0
#endif
#define STEP_(id, k, call) do { const int lo_ = __builtin_amdgcn_readfirstlane((int)ST_P[2]), hi_ = __builtin_amdgcn_readfirstlane((int)ST_P[3]); if (lo_ <= (k) && (k) < hi_) { if ((PH_MASK >> (id)) & 1) { const Ctx cl = relaunder(cx); call; } if ((PH_DUP >> (id)) & 1) { GRID_BAR(); const Ctx cl = relaunder(cx); call; } if ((k) + 1 < hi_) GRID_BAR(); } } while (0)
    STEP_(0, 0, ph_pro_a(cl));
    STEP_(1, 1, ph_pro_b(cl));
    STEP_(2, 2, ph_pro_c(cl));
#pragma unroll 1
    for (int l = 0; l < DEPTH; ++l) {
        const int s0 = 3 + 10 * l;
        STEP_(3, s0 + 0, ph_norm1(cl, l));
        STEP_(4, s0 + 1, ph_inproj(cl, l));
        STEP_(5, s0 + 2, ph_mix_local(cl, l));
        STEP_(6, s0 + 3, ph_mix_carry(cl, l));
        STEP_(7, s0 + 4, ph_mix_out(cl, l));
        STEP_(8, s0 + 5, ph_glu(cl, l));
        STEP_(9, s0 + 6, ph_outproj(cl, l));
        STEP_(10, s0 + 7, ph_norm2(cl, l));
        STEP_(11, s0 + 8, ph_moe_gu(cl, l));
        STEP_(12, s0 + 9, ph_moe_dn(cl, l));
    }
    STEP_(13, N_STEPS - 1, ph_norm1(cl, DEPTH));
#undef STEP_
}

extern "C" void kernel_launch(void* const* d_in, const int* in_sizes, int n_in, void* d_out, int out_size, void* d_ws, size_t ws_size, hipStream_t stream) {
    static int grid = 0;
    if (grid == 0) {
        if (n_in != 36 || out_size != TLAT * DM || ws_size < WS_END) { fprintf(stderr, "kernel_launch: unexpected problem (n_in %d, out %d, ws %zu < %zu)\n", n_in, out_size, ws_size, (size_t)WS_END); grid = -1; return; }
        int dev = 0, cus = 0, per_cu = 0;
        if (hipGetDevice(&dev) != hipSuccess || hipDeviceGetAttribute(&cus, hipDeviceAttributeMultiprocessorCount, dev) != hipSuccess) { grid = -1; return; }
        if (hipFuncSetAttribute((const void*)mk_fwd, hipFuncAttributeMaxDynamicSharedMemorySize, LDS_BYTES) != hipSuccess) { fprintf(stderr, "kernel_launch: hipFuncSetAttribute failed\n"); grid = -1; return; }
        if (hipOccupancyMaxActiveBlocksPerMultiprocessor(&per_cu, (const void*)mk_fwd, NTHR, LDS_BYTES) != hipSuccess || per_cu < 1) { fprintf(stderr, "kernel_launch: occupancy query says %d blocks per CU\n", per_cu); }
        (void)hipGetLastError();
        grid = cus;
    }
    if (grid < 0) return;
    (void)hipMemsetAsync((char*)d_ws + WS_CTL, 0, CTL_BYTES, stream);
    Params p{};
    for (int i = 0; i < 36; ++i) p.in[i] = (const float*)d_in[i];
    p.out = (float*)d_out; p.ws = (unsigned char*)d_ws;
#if MK_FUSED
    p.lo = 0; p.hi = N_STEPS;
    hipLaunchKernelGGL(mk_fwd, dim3(grid), dim3(NTHR), LDS_BYTES, stream, p);
#else
    for (int k = 0; k < N_STEPS; ++k) { p.lo = k; p.hi = k + 1; hipLaunchKernelGGL(mk_fwd, dim3(grid), dim3(NTHR), LDS_BYTES, stream, p); }
#endif
}
```

```cpp
#include <hip/hip_runtime.h>
#include <stdint.h>
#include <stdio.h>

#ifndef MK_FUSED
#define MK_FUSED 1
#endif

typedef unsigned short bf16_t;
typedef short bf16x8 __attribute__((ext_vector_type(8)));
typedef float f32x4 __attribute__((ext_vector_type(4)));
typedef float f32x2 __attribute__((ext_vector_type(2)));
typedef unsigned u32x4 __attribute__((ext_vector_type(4)));
typedef unsigned u32x2 __attribute__((ext_vector_type(2)));
typedef int i32x4 __attribute__((ext_vector_type(4)));
typedef int i32x8 __attribute__((ext_vector_type(8)));
#define LAS __attribute__((address_space(3)))
#define DEVI __device__ __forceinline__

constexpr int DM = 1024, NB = 8, SEQ = 2048, CTXL = 256, DEPTH = 4;
constexpr int TCTX = NB * CTXL, TLAT = NB * SEQ, TT = TCTX + TLAT;
constexpr int DIN = 2576, NP = 2560;
constexpr int NE = 32;
constexpr int PMAX = 81920;
constexpr int NTHR = 512;
constexpr int LDS_BYTES = 152 * 1024;
constexpr float EPS = 1e-6f;
constexpr float W8_SCALE = 32.0f, W8_INV = 0.03125f;
constexpr int PC_Q = 0, PC_K = 384, PC_V = 768, PC_O = 1152, PC_RX = 1536, PC_RG = 1920, PC_S5 = 2304;
constexpr int MLC = 18;
constexpr int RGC = 36;
constexpr int S5C = 72, S5R = NB * S5C;

constexpr size_t al256(size_t x) { return (x + 255) & ~(size_t)255; }
constexpr size_t WS_CTL   = 0;
constexpr size_t CTL_BYTES = 65536;
constexpr size_t CW_BAR = 0;
constexpr size_t CW_CNT = 4096;
constexpr size_t WS_WIN   = al256(WS_CTL + CTL_BYTES);
constexpr size_t WS_WOUT  = al256(WS_WIN + (size_t)DEPTH * NP * 1024 * 2);
constexpr size_t WS_WGU   = al256(WS_WOUT + (size_t)DEPTH * 1024 * 1024 * 2);
constexpr size_t WS_WD    = al256(WS_WGU + (size_t)DEPTH * NE * 2048 * 1024 * 2);
constexpr size_t WS_MOD   = al256(WS_WD + (size_t)DEPTH * NE * 1024 * 1024 * 2);
constexpr size_t WS_PW    = al256(WS_MOD + (size_t)DEPTH * 9 * 6144 * 4);
constexpr size_t WS_BB    = al256(WS_PW + (size_t)DEPTH * 16 * 2 * 64 * 33 * 8);
constexpr size_t WS_KT    = al256(WS_BB + (size_t)DEPTH * 16 * 2 * 64 * 16 * 8);
constexpr size_t WS_WY    = al256(WS_KT + (size_t)DEPTH * 16 * 2 * 32 * 256 * 4);
constexpr size_t WS_WE    = al256(WS_WY + (size_t)DEPTH * 16 * 512 * 768 * 2);
constexpr size_t WS_WRG   = al256(WS_WE + (size_t)DEPTH * 16 * 256 * 512 * 2);
constexpr size_t WS_WGLU  = al256(WS_WRG + (size_t)DEPTH * 6 * 256 * 64 * 2);
constexpr size_t WS_XS    = al256(WS_WGLU + (size_t)DEPTH * 256 * 256 * 2);
constexpr size_t WS_XMID  = al256(WS_XS + (size_t)TT * 1024 * 4);
constexpr size_t WS_H     = al256(WS_XMID + (size_t)TT * 1024 * 4);
constexpr size_t WS_GT    = al256(WS_H + (size_t)TT * 1024 * 2);
constexpr size_t WS_P     = al256(WS_GT + (size_t)TT * 16 * 4);
constexpr size_t WS_GB    = al256(WS_P + (size_t)TT * NP * 2);
constexpr size_t WS_GU    = al256(WS_GB + (size_t)TT * 8 * 4);
constexpr size_t WS_GCM   = al256(WS_GU + (size_t)TT * 8 * 4);
constexpr size_t WS_MSC   = al256(WS_GCM + (size_t)TT * 8 * 4);
constexpr size_t WS_CLOC  = al256(WS_MSC + (size_t)8 * 4 * 18 * 2 * 2 * 4);
constexpr size_t WS_NLOC  = al256(WS_CLOC + (size_t)8 * 4 * 18 * 2 * 9216 * 4);
constexpr size_t WS_C0    = al256(WS_NLOC + (size_t)8 * 4 * 18 * 2 * 96 * 4);
constexpr size_t WS_N0    = al256(WS_C0 + (size_t)8 * 4 * 18 * 2 * 9216 * 2);
constexpr size_t WS_M0    = al256(WS_N0 + (size_t)8 * 4 * 18 * 2 * 96 * 4);
constexpr size_t WS_RGA   = al256(WS_M0 + (size_t)8 * 4 * 18 * 2 * 4);
constexpr size_t WS_RGB   = al256(WS_RGA + (size_t)8 * 36 * 2 * 384 * 4);
constexpr size_t WS_RGC   = al256(WS_RGB + (size_t)8 * 36 * 2 * 384 * 4);
constexpr size_t WS_SLOC  = al256(WS_RGC + (size_t)8 * 36 * 2 * 384 * 4);
constexpr size_t WS_SIN   = al256(WS_SLOC + (size_t)16 * 576 * 256 * 4);
constexpr size_t WS_GS    = al256(WS_SIN + (size_t)16 * 576 * 256 * 2);
constexpr size_t WS_MRG   = al256(WS_GS + (size_t)TT * 256 * 2);
constexpr size_t WS_ELIST = al256(WS_MRG + (size_t)TT * 1024 * 2);
constexpr size_t WS_GLIST = al256(WS_ELIST + (size_t)NE * TT * 4);
constexpr size_t WS_TINFO = al256(WS_GLIST + (size_t)NE * TT * 4);
constexpr size_t WS_ACT   = al256(WS_TINFO + (size_t)TT * 4 * 4);
constexpr size_t WS_YPAD  = al256(WS_ACT + (size_t)PMAX * 1024 * 2);
constexpr size_t WS_BIN2  = al256(WS_YPAD + (size_t)PMAX * 1024 * 2);
constexpr size_t WS_HLO   = al256(WS_BIN2 + (size_t)DEPTH * NP * 4);
constexpr size_t WS_WGT   = al256(WS_HLO + (size_t)TT * 1024 * 2);
constexpr size_t WS_RWH   = al256(WS_WGT + (size_t)DEPTH * 16 * 1024 * 2);
constexpr size_t WS_RWL   = al256(WS_RWH + (size_t)DEPTH * 32 * 1024 * 2);
constexpr size_t WS_H8    = al256(WS_RWL + (size_t)DEPTH * 32 * 1024 * 2);
constexpr size_t WS_END   = al256(WS_H8 + (size_t)TT * 1024);

struct Params { const float* in[36]; float* out; unsigned char* ws; int lo, hi; };

enum { I_X = 0, I_C, I_CTX, I_CCTX, I_ADAW, I_ADAB, I_N1W, I_WIN, I_BIN, I_RGCW, I_RGCB, I_RGWA, I_RGBA, I_RGWX, I_RGBX, I_RGLAM,
       I_S5LRE, I_S5LIM, I_S5LDT, I_S5BRE, I_S5BIM, I_S5CRE, I_S5CIM, I_S5D, I_S5GW, I_S5GB, I_MIXW, I_WOUT, I_N2W, I_RW, I_RB,
       I_WGU, I_BGU, I_WD, I_BD, I_FNW };

DEVI bf16_t f2bf(float f) { unsigned u = __float_as_uint(f); u += 0x7FFFu + ((u >> 16) & 1u); return (bf16_t)(u >> 16); }
DEVI float bf2f(bf16_t b) { return __uint_as_float(((unsigned)b) << 16); }
DEVI unsigned pk_bf16(float lo, float hi) { unsigned r; asm("v_cvt_pk_bf16_f32 %0, %1, %2" : "=v"(r) : "v"(lo), "v"(hi)); return r; }
DEVI unsigned pk4_fp8(float a, float b, float c, float d) { int p = __builtin_amdgcn_cvt_pk_fp8_f32(a, b, 0, false); p = __builtin_amdgcn_cvt_pk_fp8_f32(c, d, p, true); return (unsigned)p; }
DEVI float q8(float x) { const int p = __builtin_amdgcn_cvt_pk_fp8_f32(x, x, 0, false); return __builtin_amdgcn_cvt_f32_fp8(p, 0); }
DEVI float frcp(float x) { return __builtin_amdgcn_rcpf(x); }
DEVI float sigmoidf_(float x) { return frcp(1.0f + __expf(-x)); }
DEVI float gelu_tanh(float x) { const float u = 0.7978845608f * (x + 0.044715f * x * x * x); return x * frcp(1.0f + __expf(-2.0f * u)); }
template <int M> DEVI float shx(float v, int lane) {
    if constexpr (M < 32) return __int_as_float(__builtin_amdgcn_ds_swizzle(__float_as_int(v), 0x1F | (M << 10)));
    else return __int_as_float(__builtin_amdgcn_ds_bpermute((lane ^ 32) << 2, __float_as_int(v)));
}
DEVI float shxr(float v, int m, int lane) {
    switch (m) { case 1: return shx<1>(v, lane); case 2: return shx<2>(v, lane); case 4: return shx<4>(v, lane); case 8: return shx<8>(v, lane); case 16: return shx<16>(v, lane); default: return shx<32>(v, lane); }
}
DEVI int shxri(int v, int m, int lane) { return __float_as_int(shxr(__int_as_float(v), m, lane)); }
template <int CTRL, int ROWMASK> DEVI float dpp_(float v) { return __int_as_float(__builtin_amdgcn_update_dpp(0, __float_as_int(v), CTRL, ROWMASK, 0xF, false)); }
DEVI float wave_sum(float v, int) {
    v += dpp_<0xB1, 0xF>(v); v += dpp_<0x4E, 0xF>(v); v += dpp_<0x141, 0xF>(v); v += dpp_<0x140, 0xF>(v);
    v += dpp_<0x142, 0xA>(v); v += dpp_<0x143, 0xC>(v);
    return __int_as_float(__builtin_amdgcn_readlane(__float_as_int(v), 63));
}
DEVI float log1p_(float e) { return e < 0.06f ? e * (1.0f - e * (0.5f - e * (0.33333334f - e * 0.25f))) : __logf(1.0f + e); }
#define LDS_SYNC() do { asm volatile("s_waitcnt lgkmcnt(0)" ::: "memory"); __builtin_amdgcn_s_barrier(); asm volatile("" ::: "memory"); } while (0)
DEVI int mod_row(int row) { return row < TCTX ? 8 : (row - TCTX) / SEQ; }

#define XB_TMO      128
#define XB_XCNT(j)  (256  + 64 * (j))
#define XB_XSUB(j)  (1280 + 64 * (j))
#define XB_XGEN(j)  (2304 + 64 * (j))
#define XB_TOP      3328
#define XB_TOPGEN   3392
#define XCD_BAR_WORDS 3456
#define XB_SPIN_CAP (1u << 18)
__device__ __forceinline__ unsigned xb_ld(unsigned* p)              { return __hip_atomic_load(p, __ATOMIC_RELAXED, __HIP_MEMORY_SCOPE_AGENT); }
__device__ __forceinline__ unsigned xb_add(unsigned* p, unsigned v) { return __hip_atomic_fetch_add(p, v, __ATOMIC_RELAXED, __HIP_MEMORY_SCOPE_AGENT); }
__device__ __forceinline__ unsigned xb_xcc_id() { return (unsigned)__builtin_amdgcn_s_getreg((3 << 11) | 20) & 0xFu; }
#define XB_SPIN(cond, bar) do { unsigned _sp = 0; while (cond) { __builtin_amdgcn_s_sleep(1); \
    if ((++_sp & 255u) == 0u) { if (xb_ld(&(bar)[XB_TMO])) break; if (_sp > XB_SPIN_CAP) { atomicAdd(&(bar)[XB_TMO], 1u); break; } } } } while (0)
struct XcdBarrier { unsigned* bar; unsigned x; volatile LAS unsigned* st; };
__device__ __forceinline__ XcdBarrier xcd_barrier_post(unsigned* bar, volatile LAS unsigned* st) {
    XcdBarrier b; b.bar = bar; b.x = xb_xcc_id(); b.st = st;
    if (threadIdx.x == 0) (void)xb_add(&bar[XB_XCNT(b.x)], 1u);
    return b;
}
__device__ __forceinline__ void xcd_barrier_complete(unsigned* bar, unsigned x, unsigned& nloc, unsigned& nx) {
    const unsigned G = gridDim.x * gridDim.y * gridDim.z;
    unsigned sum, cnt, mine, sp = 0u;
    for (;;) {
        sum = 0u; cnt = 0u; mine = 0u;
#pragma unroll
        for (unsigned j = 0; j < 16; ++j) { const unsigned c = xb_ld(&bar[XB_XCNT(j)]); sum += c; cnt += (c > 0u) ? 1u : 0u; mine = (j == x) ? c : mine; }
        if (sum == G) break;
        __builtin_amdgcn_s_sleep(1);
        if ((++sp & 255u) == 0u) { if (xb_ld(&bar[XB_TMO])) break; if (sp > XB_SPIN_CAP) { atomicAdd(&bar[XB_TMO], 1u); break; } }
    }
    nloc = mine > 0u ? mine : 1u; nx = cnt > 0u ? cnt : 1u;
}
__device__ __forceinline__ void xcd_barrier(const XcdBarrier& b) {
    asm volatile("s_waitcnt vmcnt(0)" ::: "memory");
    __syncthreads();
    if (threadIdx.x == 0) {
        unsigned* bar = b.bar;
        __builtin_amdgcn_s_waitcnt(0);
        unsigned nloc = b.st[0], nx = b.st[1];
        if (nloc == 0u) { xcd_barrier_complete(bar, b.x, nloc, nx); b.st[0] = nloc; b.st[1] = nx; }
        const unsigned old = xb_add(&bar[XB_XSUB(b.x)], 1u);
        const unsigned gen = old / nloc;
        if (old + 1u == (gen + 1u) * nloc) {
            __builtin_amdgcn_fence(__ATOMIC_RELEASE, "agent");
            asm volatile("s_waitcnt vmcnt(0)" ::: "memory");
            const unsigned og = xb_add(&bar[XB_TOP], 1u);
            const unsigned tg = og / nx;
            if (og + 1u == (tg + 1u) * nx) xb_add(&bar[XB_TOPGEN], 1u);
            else XB_SPIN(xb_ld(&bar[XB_TOPGEN]) == tg, bar);
            __builtin_amdgcn_fence(__ATOMIC_ACQUIRE, "agent");
            xb_add(&bar[XB_XGEN(b.x)], 1u);
            asm volatile("s_waitcnt vmcnt(0)" ::: "memory");
        } else {
            XB_SPIN(xb_ld(&bar[XB_XGEN(b.x)]) == gen, bar);
            __builtin_amdgcn_fence(__ATOMIC_ACQUIRE, "agent");
            asm volatile("s_waitcnt vmcnt(0)" ::: "memory");
        }
    }
    __syncthreads();
}

namespace g1 {
constexpr int BM = 256, BK = 64, HALF = 128, HTB = HALF * BK * 2, STAGE_BYTES = 8 * HTB, K = 1024, NT = K / BK;
DEVI int lds_byte(int r, int c) { const int st = (r >> 4) * 2 + (c >> 5), rr = r & 15, cc = c & 31, ob = rr * 64 + cc * 2; return st * 1024 + (ob ^ (((ob >> 9) & 1) << 5)); }
DEVI void stage_rc(int b, int& R, int& C) { const int st = b / 1024, sb = b % 1024, swz = sb ^ (((sb >> 9) & 1) << 5); R = (st >> 1) * 16 + swz / 64; C = (st & 1) * 32 + (swz % 64) / 2; }
DEVI int perm32(int rho) { const int n = rho >> 4, i = rho & 15; return 8 * (i >> 2) + 4 * n + (i & 3); }

struct Unit {
    const char* A;
    const int* list;
    int nvalid;
    const char* B;
    int pm, pn, e;
};

template <bool F8> struct FragT { typedef bf16x8 T; static constexpr int NK = 2; };
template <> struct FragT<true> { typedef i32x8 T; static constexpr int NK = 1; };
template <bool GATHER, int KB>
DEVI void a_offsets(const Unit& u, int tid, unsigned (&v)[2][2]) {
    int tz = tid; asm volatile("" : "+v"(tz));
#pragma unroll
    for (int i = 0; i < 2; ++i) {
        int R, C; stage_rc(tz * 16 + i * 8192, R, C);
#pragma unroll
        for (int h = 0; h < 2; ++h) {
            const int r = h * HALF + R;
            int src = r;
            if (GATHER) { const int nv = u.nvalid > 256 ? 256 : u.nvalid; const int ld_ = u.list[r < nv ? r : nv - 1]; src = (r < nv) ? ld_ : 0; }
            v[h][i] = (unsigned)src * (unsigned)KB + (unsigned)(C * 2);
        }
    }
}

template <class Sched, class Epi, bool GATHER, bool FP8 = false>
DEVI void gemm_phase(LAS unsigned char* lds, const int tid, const Sched& S, const Epi& E) {
    constexpr int KB = FP8 ? 1024 : 2048, NTK = KB / 128, NK = FragT<FP8>::NK;
    typedef typename FragT<FP8>::T frag_t;
    int sc1 = 0x7F7F7F7F; asm volatile("" : "+v"(sc1));
    const int wid = __builtin_amdgcn_readfirstlane(tid >> 6), lane = tid & 63, wr = wid >> 2, wc = wid & 3, fr = lane & 15, fq = lane >> 4;
    unsigned voffB[2];
#pragma unroll
    for (int i = 0; i < 2; ++i) { int R, C; stage_rc(tid * 16 + i * 8192, R, C); const int Rb = Epi::PERM ? ((R & ~31) + perm32(R & 31)) : R; voffB[i] = (unsigned)(Rb * KB + C * 2); }
    constexpr size_t kstep = (size_t)(BK * 2);
    constexpr size_t hstep = (size_t)HALF * KB;
    const unsigned ldsw = (unsigned)wid * 1024u;
    const int aoff = FP8 ? lds_byte(wr * 64 + fr, fq * 16) : lds_byte(wr * 64 + fr, fq * 8), boff = FP8 ? lds_byte(wc * 32 + fr, fq * 16) : lds_byte(wc * 32 + fr, fq * 8);
    unsigned pa_ = (unsigned)(size_t)(lds + aoff), pb_ = (unsigned)(size_t)(lds + 65536 + boff); asm volatile("" : "+v"(pa_), "+v"(pb_));
    LAS unsigned char* const pa = (LAS unsigned char*)(size_t)pa_; LAS unsigned char* const pb = (LAS unsigned char*)(size_t)pb_;
#define G1_SA(b, h) (((b) * 2 + (h)) * HTB)
#define G1_SB(b, h) ((4 + (b) * 2 + (h)) * HTB)
#define G1_STAGE2(bufoff, gbase, v0, v1) do { \
        __builtin_amdgcn_global_load_lds((const unsigned*)((const char*)(gbase) + (v0)), (LAS unsigned*)(lds + (bufoff) + ldsw), 16, 0, 0); \
        __builtin_amdgcn_global_load_lds((const unsigned*)((const char*)(gbase) + (v1)), (LAS unsigned*)(lds + (bufoff) + ldsw + 8192), 16, 0, 0); } while (0)
#define G1_LDFRAG(dst, ptr) do { if constexpr (FP8) { const i32x4 lo_ = *(const LAS i32x4*)(ptr), hi_ = *(const LAS i32x4*)((ptr) + 16); dst = __builtin_shufflevector(lo_, hi_, 0, 1, 2, 3, 4, 5, 6, 7); } \
        else { dst = *(const LAS frag_t*)(ptr); } } while (0)
#define G1_LDA(dst, b, h) do { _Pragma("unroll") for (int m = 0; m < 4; ++m) _Pragma("unroll") for (int k = 0; k < NK; ++k) G1_LDFRAG(dst[m][k], pa + (G1_SA(b, h) + m * 2048 + k * 1024)); } while (0)
#define G1_LDB(dst, b, h) do { _Pragma("unroll") for (int n = 0; n < 2; ++n) _Pragma("unroll") for (int k = 0; k < NK; ++k) G1_LDFRAG(dst[n][k], pb + (G1_SB(b, h) - 65536 + n * 2048 + k * 1024)); } while (0)
#define G1_MFMA(c_, b_, a_) do { if constexpr (FP8) asm volatile("v_mfma_scale_f32_16x16x128_f8f6f4 %0, %1, %2, %0, %3, %3 op_sel_hi:[0,0,0]" : "+v"(c_) : "v"(b_), "v"(a_), "v"(sc1)); \
        else c_ = __builtin_amdgcn_mfma_f32_16x16x32_bf16(b_, a_, c_, 0, 0, 0); } while (0)
#define G1_MMA(ai, bj, At, Bt) do { __builtin_amdgcn_s_setprio(1); _Pragma("unroll") for (int m = 0; m < 4; ++m) _Pragma("unroll") for (int n = 0; n < 2; ++n) _Pragma("unroll") for (int k = 0; k < NK; ++k) \
        G1_MFMA(acc[ai][bj][m][n], Bt[n][k], At[m][k]); __builtin_amdgcn_s_setprio(0); } while (0)
#define G1_WAIT_V(n) asm volatile("s_waitcnt vmcnt(" #n ")" ::: "memory")
#define G1_WAIT_L(n) asm volatile("s_waitcnt lgkmcnt(" #n ")" ::: "memory")
#define G1_BAR __builtin_amdgcn_s_barrier()
#define G1_SCHED __builtin_amdgcn_sched_barrier(0)
    Unit cur, nxt; int ui = 0;
    if (!S.get(0, cur)) return;
    f32x4 acc[2][2][4][2];
#pragma unroll
    for (int a = 0; a < 2; ++a)
#pragma unroll
        for (int b = 0; b < 2; ++b)
#pragma unroll
            for (int m = 0; m < 4; ++m)
#pragma unroll
                for (int n = 0; n < 2; ++n) acc[a][b][m][n] = (f32x4){0.f, 0.f, 0.f, 0.f};
    frag_t At[4][NK], B0[2][NK], B1[2][NK];
    unsigned vc[2][2], vn[2][2];
    a_offsets<GATHER, KB>(cur, tid, vc);
    const char* cA = cur.A; const char* cB = cur.B;
    G1_STAGE2(G1_SB(0, 0), cB, voffB[0], voffB[1]); G1_STAGE2(G1_SA(0, 0), cA, vc[0][0], vc[0][1]);
    G1_STAGE2(G1_SB(0, 1), cB + hstep, voffB[0], voffB[1]); G1_STAGE2(G1_SA(0, 1), cA, vc[1][0], vc[1][1]);
    if (wr == 1) G1_BAR;
    G1_WAIT_V(4); G1_BAR;
    G1_STAGE2(G1_SB(1, 0), cB + kstep, voffB[0], voffB[1]); G1_STAGE2(G1_SA(1, 0), cA + kstep, vc[0][0], vc[0][1]);
    G1_STAGE2(G1_SB(1, 1), cB + hstep + kstep, voffB[0], voffB[1]);
    G1_WAIT_V(6); G1_BAR;
    for (;;) {
        const bool has_next = S.get(ui + 1, nxt);
        if (has_next) { a_offsets<GATHER, KB>(nxt, tid, vn); }
        else {
#pragma unroll
            for (int h = 0; h < 2; ++h)
#pragma unroll
                for (int i = 0; i < 2; ++i) vn[h][i] = vc[h][i];
        }
        const char* nA = has_next ? nxt.A : cA; const char* nB = has_next ? nxt.B : cB;
#pragma unroll 1
        for (int t = 0; t < NTK; t += 2) {
            const bool last = (t == NTK - 2);
            const char* a1 = cA + (size_t)(t + 1) * kstep;
            const char* a2 = last ? nA : cA + (size_t)(t + 2) * kstep; const char* b2 = last ? nB : cB + (size_t)(t + 2) * kstep;
            const char* a3 = a2 + kstep; const char* b3 = b2 + kstep;
            unsigned w00 = vc[0][0], w01 = vc[0][1], w10 = vc[1][0], w11 = vc[1][1];
            if (last) { w00 = vn[0][0]; w01 = vn[0][1]; w10 = vn[1][0]; w11 = vn[1][1]; asm volatile("" : "+v"(w00), "+v"(w01), "+v"(w10), "+v"(w11)); }
            G1_LDB(B0, 0, 0); G1_SCHED; G1_LDA(At, 0, 0); G1_STAGE2(G1_SA(1, 1), a1, vc[1][0], vc[1][1]);
            G1_WAIT_L(8); G1_BAR; G1_WAIT_L(0); G1_MMA(0, 0, At, B0); G1_BAR; G1_SCHED;
            G1_LDB(B1, 0, 1); G1_STAGE2(G1_SB(0, 0), b2, voffB[0], voffB[1]);
            G1_BAR; G1_WAIT_L(0); G1_MMA(0, 1, At, B1); G1_BAR;
            G1_LDA(At, 0, 1); G1_STAGE2(G1_SA(0, 0), a2, w00, w01);
            G1_BAR; G1_WAIT_L(0); G1_MMA(1, 0, At, B0); G1_BAR; G1_SCHED;
            G1_STAGE2(G1_SB(0, 1), b2 + hstep, voffB[0], voffB[1]);
            G1_WAIT_V(6); G1_BAR; G1_MMA(1, 1, At, B1); G1_BAR;
            G1_LDB(B0, 1, 0); G1_SCHED; G1_LDA(At, 1, 0); G1_STAGE2(G1_SA(0, 1), a2, w10, w11);
            G1_WAIT_L(8); G1_BAR; G1_WAIT_L(0); G1_MMA(0, 0, At, B0); G1_BAR; G1_SCHED;
            G1_LDB(B1, 1, 1); G1_STAGE2(G1_SB(1, 0), b3, voffB[0], voffB[1]);
            G1_BAR; G1_WAIT_L(0); G1_MMA(0, 1, At, B1); G1_BAR;
            G1_LDA(At, 1, 1); G1_STAGE2(G1_SA(1, 0), a3, w00, w01);
            G1_BAR; G1_WAIT_L(0); G1_MMA(1, 0, At, B0); G1_BAR; G1_SCHED;
            G1_STAGE2(G1_SB(1, 1), b3 + hstep, voffB[0], voffB[1]);
            G1_WAIT_V(6); G1_BAR; G1_MMA(1, 1, At, B1); G1_BAR;
        }
        if constexpr (FP8) asm volatile("s_nop 15\n\ts_nop 15" ::: "memory");
        E(acc, cur, wr, wc, fr, fq);
        if (!has_next) break;
#pragma unroll
        for (int a = 0; a < 2; ++a)
#pragma unroll
            for (int b = 0; b < 2; ++b)
#pragma unroll
                for (int m = 0; m < 4; ++m)
#pragma unroll
                    for (int n = 0; n < 2; ++n) acc[a][b][m][n] = (f32x4){0.f, 0.f, 0.f, 0.f};
        cur = nxt; cA = nA; cB = nB; ++ui;
#pragma unroll
        for (int h = 0; h < 2; ++h)
#pragma unroll
            for (int i = 0; i < 2; ++i) vc[h][i] = vn[h][i];
    }
    G1_WAIT_V(0);
    if (wr == 0) G1_BAR;
    G1_BAR;
}
}

template <int MT, int NT_, class AF, class BF>
DEVI void wave_gemm(const int lane, int Kdim, const AF& af, const BF& bf, f32x4 (&acc)[MT][NT_]) {
    const int fr = lane & 15, fq = lane >> 4;
#pragma unroll
    for (int m = 0; m < MT; ++m)
#pragma unroll
        for (int n = 0; n < NT_; ++n) acc[m][n] = (f32x4){0.f, 0.f, 0.f, 0.f};
    bf16x8 fa[4][MT], fb[4][NT_];
#define WG_LOAD(S, KK) do { _Pragma("unroll") for (int m = 0; m < MT; ++m) fa[S][m] = af(m * 16 + fr, (KK) + fq * 8); _Pragma("unroll") for (int n = 0; n < NT_; ++n) fb[S][n] = bf(n * 16 + fr, (KK) + fq * 8); } while (0)
#define WG_MMA(S) do { _Pragma("unroll") for (int m = 0; m < MT; ++m) _Pragma("unroll") for (int n = 0; n < NT_; ++n) acc[m][n] = __builtin_amdgcn_mfma_f32_16x16x32_bf16(fb[S][n], fa[S][m], acc[m][n], 0, 0, 0); } while (0)
    WG_LOAD(0, 0); WG_LOAD(1, 32); WG_LOAD(2, 64);
#pragma unroll 1
    for (int k0 = 0; k0 < Kdim; k0 += 128) {
        const bool more = k0 + 128 < Kdim;
        WG_LOAD(3, k0 + 96); WG_MMA(0);
        if (more) WG_LOAD(0, k0 + 128);
        WG_MMA(1);
        if (more) WG_LOAD(1, k0 + 160);
        WG_MMA(2);
        if (more) WG_LOAD(2, k0 + 192);
        WG_MMA(3);
    }
#undef WG_LOAD
#undef WG_MMA
}
DEVI bf16x8 ldg8(const bf16_t* p) { return *(const bf16x8*)p; }

template <int N> struct Log2 { static constexpr int v = 1 + Log2<N / 2>::v; };
template <> struct Log2<1> { static constexpr int v = 0; };
template <int N>
DEVI float reduce_scatter(const int lane, float (&v)[N]) {
    constexpr int LG = Log2<N>::v;
#pragma unroll
    for (int st = 0; st < LG; ++st) {
        const int s = (N / 2) >> st, mask = 32 >> st;
        const bool up = (lane & mask) != 0;
#pragma unroll
        for (int i = 0; i < N / 2; ++i) if (i < s) {
            const float send = up ? v[i] : v[i + s];
            const float keep = up ? v[i + s] : v[i];
            v[i] = keep + shxr(send, mask, lane);
        }
    }
    float r = v[0];
#pragma unroll
    for (int st = LG; st < 6; ++st) r += shxr(r, 32 >> st, lane);
    return r;
}
template <int N>
DEVI int rs_index(int lane) {
    constexpr int LG = Log2<N>::v;
    int idx = 0;
#pragma unroll
    for (int st = 0; st < LG; ++st) if (lane & (32 >> st)) idx += (N / 2) >> st;
    return idx;
}

struct Ctx {
    const Params* p; unsigned char* ws; LAS unsigned char* lds; int tid, lane, wave, G, bid;
};
#define WSP(T, off) ((T*)(cx.ws + (off)))
DEVI Ctx relaunder(const Ctx& c) { Ctx r = c; int ln, td;
    asm volatile("v_mbcnt_lo_u32_b32 %0, -1, 0\n\tv_mbcnt_hi_u32_b32 %0, -1, %0\n\tv_lshl_add_u32 %1, %2, 6, %0" : "=&v"(ln), "=v"(td) : "s"(c.wave));
    r.lane = ln; r.tid = td; return r; }

DEVI void cvt_tile(const Ctx& cx, const float* src, int ld, bf16_t* dst, int n0, int k0, int kind) {
    LAS bf16_t* tile = (LAS bf16_t*)cx.lds;
    const int n4 = (cx.tid & 63) * 4, w8 = (cx.tid >> 6) * 8, n = n0 + n4;
    int sc; float scale = 1.0f;
    if (kind == 0) { sc = n < 1536 ? n : n + 16; if (n >= 384 && n < 768) scale = 0.10206207261596577f; }
    else if (kind == 2) { const int pn = n >> 8, w = n & 255; sc = w < 128 ? pn * 128 + w : 1024 + pn * 128 + (w - 128); }
    else sc = n;
#pragma unroll 1
    for (int sub = 0; sub < 4; sub += 2) {
        f32x4 v[2][8];
#pragma unroll
        for (int s2 = 0; s2 < 2; ++s2)
#pragma unroll
            for (int p = 0; p < 8; ++p) v[s2][p] = __builtin_nontemporal_load((const f32x4*)(src + (size_t)(k0 + (sub + s2) * 64 + w8 + p) * ld + sc));
#pragma unroll
        for (int s2 = 0; s2 < 2; ++s2)
#pragma unroll
            for (int j = 0; j < 4; ++j) { u32x4 w;
                w.x = pk_bf16(v[s2][0][j] * scale, v[s2][1][j] * scale); w.y = pk_bf16(v[s2][2][j] * scale, v[s2][3][j] * scale);
                w.z = pk_bf16(v[s2][4][j] * scale, v[s2][5][j] * scale); w.w = pk_bf16(v[s2][6][j] * scale, v[s2][7][j] * scale);
                *(LAS u32x4*)(tile + (n4 + j) * 264 + (sub + s2) * 64 + w8) = w; }
    }
    LDS_SYNC();
#pragma unroll
    for (int i = 0; i < 16; ++i) { const int idx = cx.tid + NTHR * i, row = idx >> 5, ch = idx & 31;
        const u32x4 o = *(const LAS u32x4*)(tile + row * 264 + ch * 8);
        *(u32x4*)(dst + (size_t)(n0 + row) * 1024 + k0 + ch * 8) = o; }
    LDS_SYNC();
}

DEVI void cvt_tile8(const Ctx& cx, const float* src, int ld, unsigned char* dst, int n0, int k0, int kind) {
    LAS unsigned char* tile = cx.lds;
    const int n4 = (cx.tid & 63) * 4, w8 = (cx.tid >> 6) * 8, n = n0 + n4;
    int sc;
    if (kind == 2) { const int pn = n >> 8, w = n & 255; sc = w < 128 ? pn * 128 + w : 1024 + pn * 128 + (w - 128); }
    else sc = n;
#pragma unroll 1
    for (int sub = 0; sub < 4; sub += 2) {
        f32x4 v[2][8];
#pragma unroll
        for (int s2 = 0; s2 < 2; ++s2)
#pragma unroll
            for (int p = 0; p < 8; ++p) v[s2][p] = __builtin_nontemporal_load((const f32x4*)(src + (size_t)(k0 + (sub + s2) * 64 + w8 + p) * ld + sc));
#pragma unroll
        for (int s2 = 0; s2 < 2; ++s2)
#pragma unroll
            for (int j = 0; j < 4; ++j) { u32x2 w;
                w.x = pk4_fp8(v[s2][0][j] * W8_SCALE, v[s2][1][j] * W8_SCALE, v[s2][2][j] * W8_SCALE, v[s2][3][j] * W8_SCALE);
                w.y = pk4_fp8(v[s2][4][j] * W8_SCALE, v[s2][5][j] * W8_SCALE, v[s2][6][j] * W8_SCALE, v[s2][7][j] * W8_SCALE);
                *(LAS u32x2*)(tile + (n4 + j) * 272 + (sub + s2) * 64 + w8) = w; }
    }
    LDS_SYNC();
#pragma unroll
    for (int i = 0; i < 8; ++i) { const int idx = cx.tid + NTHR * i, row = idx >> 4, ch = idx & 15;
        const u32x4 o = *(const LAS u32x4*)(tile + row * 272 + ch * 16);
        *(u32x4*)(dst + (size_t)(n0 + row) * 1024 + k0 + ch * 16) = o; }
    LDS_SYNC();
}
DEVI void ph_pro_a(const Ctx& cx) {
    const Params& P = *cx.p;
    {
        constexpr int n_in = DEPTH * 10 * 4, n_out = DEPTH * 4 * 4, n_gu = DEPTH * NE * 8 * 4, n_dn = DEPTH * NE * 4 * 4;
        constexpr int total = n_in + n_out + n_gu + n_dn;
        for (int job = cx.bid; job < total; job += cx.G) {
            int j = job;
            if (j < n_in) { const int l = j / 40, r = j % 40, nt = r / 4, kt = r % 4;
                cvt_tile(cx, P.in[I_WIN] + (size_t)l * 1024 * DIN, DIN, WSP(bf16_t, WS_WIN) + (size_t)l * NP * 1024, nt * 256, kt * 256, 0); continue; }
            j -= n_in;
            if (j < n_out) { const int l = j / 16, r = j % 16, nt = r / 4, kt = r % 4;
                cvt_tile(cx, P.in[I_WOUT] + (size_t)l * 1024 * 1024, 1024, WSP(bf16_t, WS_WOUT) + (size_t)l * 1024 * 1024, nt * 256, kt * 256, 1); continue; }
            j -= n_out;
            if (j < n_gu) { const int le = j / 32, r = j % 32, nt = r / 4, kt = r % 4;
                cvt_tile8(cx, P.in[I_WGU] + (size_t)le * 1024 * 2048, 2048, WSP(unsigned char, WS_WGU) + (size_t)le * 2048 * 1024, nt * 256, kt * 256, 2); continue; }
            j -= n_gu;
            { const int le = j / 16, r = j % 16, nt = r / 4, kt = r % 4;
                cvt_tile8(cx, P.in[I_WD] + (size_t)le * 1024 * 1024, 1024, WSP(unsigned char, WS_WD) + (size_t)le * 1024 * 1024, nt * 256, kt * 256, 1); }
        }
    }
    __syncthreads();
    {
        LAS float* sv = (LAS float*)cx.lds;
        LAS float* red = sv + 9 * 1024;
        constexpr int units = DEPTH * 6144 / 64;
        if (cx.bid < units) {
            for (int i = cx.tid; i < 9 * 1024; i += NTHR) { const int r = i >> 10, k = i & 1023; const float c = r < 8 ? P.in[I_C][r * 1024 + k] : P.in[I_CCTX][k]; sv[i] = c / (1.0f + __expf(-c)); }
            __syncthreads();
            for (int u = cx.bid; u < units; u += cx.G) {
                const int l = u / 96, n = (u % 96) * 64 + cx.lane;
                const float* w = P.in[I_ADAW] + (size_t)l * 1024 * 6144 + n;
                float acc[9];
#pragma unroll
                for (int r = 0; r < 9; ++r) acc[r] = 0.f;
                const int kb = cx.wave * 128;
#pragma unroll 4
                for (int k = 0; k < 128; ++k) { const float wv = w[(size_t)(kb + k) * 6144];
#pragma unroll
                    for (int r = 0; r < 9; ++r) acc[r] += sv[r * 1024 + kb + k] * wv; }
#pragma unroll
                for (int r = 0; r < 9; ++r) red[(cx.wave * 9 + r) * 64 + cx.lane] = acc[r];
                __syncthreads();
                for (int i = cx.tid; i < 9 * 64; i += NTHR) { const int r = i >> 6, ln = i & 63; float s = 0.f;
#pragma unroll
                    for (int w8 = 0; w8 < 8; ++w8) s += red[(w8 * 9 + r) * 64 + ln];
                    const int nn = (u % 96) * 64 + ln;
                    WSP(float, WS_MOD)[((size_t)l * 9 + r) * 6144 + nn] = s + P.in[I_ADAB][l * 6144 + nn]; }
                __syncthreads();
            }
        }
    }
    for (int gt = cx.bid * NTHR + cx.tid; gt < DEPTH * 16 * 2 * 64; gt += cx.G * NTHR) {
        const int n = gt & 63, d = (gt >> 6) & 1, g = (gt >> 7) & 15, l = gt >> 11;
        const float dt = expf(P.in[I_S5LDT][(l * 2 + d) * 16 + g]);
        const float lr = P.in[I_S5LRE][((l * 2 + d) * 16 + g) * 64 + n], li = P.in[I_S5LIM][((l * 2 + d) * 16 + g) * 64 + n];
        f32x2* pw = WSP(f32x2, WS_PW) + (size_t)gt * 33;
        float ar = 0.f, ai = 0.f;
        for (int k = 0; k <= 32; ++k) { const float mag = expf(lr * dt * (float)k); float s, c; sincosf(li * dt * (float)k, &s, &c); pw[k] = (f32x2){mag * c, mag * s}; if (k == 1) { ar = mag * c; ai = mag * s; } }
        const float den = lr * lr + li * li;
        const float cr = ((ar - 1.0f) * lr + ai * li) / den, ci = (ai * lr - (ar - 1.0f) * li) / den;
        f32x2* bb = WSP(f32x2, WS_BB) + (size_t)gt * 16;
        for (int q = 0; q < 16; ++q) { const float br = P.in[I_S5BRE][((l * 16 + g) * 64 + n) * 16 + q], bi = P.in[I_S5BIM][((l * 16 + g) * 64 + n) * 16 + q];
            bb[q] = (f32x2){cr * br - ci * bi, cr * bi + ci * br}; }
    }
    for (int i = cx.bid * NTHR + cx.tid; i < DEPTH * 6 * 256 * 64; i += cx.G * NTHR) {
        const int k = i & 63, n = (i >> 6) & 255, g = (i >> 14) % 6, l = (i >> 14) / 6;
        const int j = n & 63, type = (n >> 6) & 1, dir = n >> 7;
        const float* w = type ? P.in[I_RGWX] : P.in[I_RGWA];
        WSP(bf16_t, WS_WRG)[i] = f2bf(w[((((size_t)l * 2 + dir) * 6 + g) * 64 + k) * 64 + j]);
    }
    for (int i = cx.bid * NTHR + cx.tid; i < DEPTH * NP; i += cx.G * NTHR) {
        const int n = i % NP, l = i / NP; const int sc = n < 1536 ? n : n + 16;
        WSP(float, WS_BIN2)[i] = P.in[I_BIN][l * DIN + sc] * ((n >= 384 && n < 768) ? 0.10206207261596577f : 1.0f);
    }
    for (int i = cx.bid * NTHR + cx.tid; i < DEPTH * 16 * 1024; i += cx.G * NTHR) { const int k = i & 1023, n = (i >> 10) & 15, l = i >> 14;
        WSP(bf16_t, WS_WGT)[i] = f2bf(P.in[I_WIN][((size_t)l * 1024 + k) * DIN + 1536 + n]); }
    for (int i = cx.bid * NTHR + cx.tid; i < DEPTH * 32 * 1024; i += cx.G * NTHR) { const int k = i & 1023, n = (i >> 10) & 31, l = i >> 15;
        const float w = P.in[I_RW][((size_t)l * 1024 + k) * 32 + n]; const bf16_t hi = f2bf(w);
        WSP(bf16_t, WS_RWH)[i] = hi; WSP(bf16_t, WS_RWL)[i] = f2bf(w - bf2f(hi)); }
    for (int i = cx.bid * NTHR + cx.tid; i < DEPTH * 256 * 256; i += cx.G * NTHR) {
        const int k = i & 255, n = (i >> 8) & 255, l = i >> 16;
        WSP(bf16_t, WS_WGLU)[i] = f2bf(P.in[I_S5GW][((size_t)l * 256 + k) * 256 + n]);
    }
}

DEVI void ph_pro_b(const Ctx& cx) {
    const Params& P = *cx.p;
    for (int i = cx.bid * NTHR + cx.tid; i < DEPTH * 16 * 2 * 32 * 256; i += cx.G * NTHR) {
        const int q = i & 15, p = (i >> 4) & 15, tau = (i >> 8) & 31, d = (i >> 13) & 1, g = (i >> 14) & 15, l = i >> 18;
        const f32x2* pw = WSP(f32x2, WS_PW) + (size_t)(((l * 16 + g) * 2 + d) * 64) * 33 + tau;
        const f32x2* bb = WSP(f32x2, WS_BB) + (size_t)(((l * 16 + g) * 2 + d) * 64) * 16 + q;
        const float* cre = P.in[I_S5CRE] + ((size_t)(l * 16 + g) * 16 + p) * 64;
        const float* cim = P.in[I_S5CIM] + ((size_t)(l * 16 + g) * 16 + p) * 64;
        float s = 0.f;
        for (int n = 0; n < 64; ++n) { const f32x2 a = pw[n * 33], b = bb[n * 16]; const float cr = cre[n], ci = cim[n];
            const float xr = cr * a.x - ci * a.y, xi = cr * a.y + ci * a.x; s += xr * b.x - xi * b.y; }
        WSP(float, WS_KT)[i] = s;
    }
}

DEVI void ph_pro_c(const Ctx& cx) {
    const Params& P = *cx.p;
    for (size_t i = (size_t)cx.bid * NTHR + cx.tid; i < (size_t)DEPTH * 16 * 512 * 768; i += (size_t)cx.G * NTHR) {
        const int k = (int)(i % 768), tp = (int)((i / 768) % 512), lg = (int)(i / (768 * 512));
        const int t = tp >> 4, p = tp & 15, l = lg >> 4, g = lg & 15;
        float v;
        if (k < 512) { const int s = k >> 4, q = k & 15; v = 0.f;
            const float* kt = WSP(float, WS_KT) + (size_t)lg * 2 * 32 * 256;
            if (s <= t) v += kt[((0 * 32) + (t - s)) * 256 + p * 16 + q];
            if (s >= t) v += kt[((1 * 32) + (s - t)) * 256 + p * 16 + q];
            if (s == t && p == q) v += P.in[I_S5D][l * 256 + g * 16 + p];
        } else { const int kk = k - 512, d = kk >> 7, im = (kk >> 6) & 1, n = kk & 63;
            const int pwr = d == 0 ? t + 1 : 32 - t;
            const f32x2 a = WSP(f32x2, WS_PW)[(size_t)((lg * 2 + d) * 64 + n) * 33 + pwr];
            const float cr = P.in[I_S5CRE][((size_t)lg * 16 + p) * 64 + n], ci = P.in[I_S5CIM][((size_t)lg * 16 + p) * 64 + n];
            v = im ? -(cr * a.y + ci * a.x) : (cr * a.x - ci * a.y);
        }
        WSP(bf16_t, WS_WY)[i] = f2bf(v);
    }
    for (size_t i = (size_t)cx.bid * NTHR + cx.tid; i < (size_t)DEPTH * 16 * 256 * 512; i += (size_t)cx.G * NTHR) {
        const int k = (int)(i & 511), no = (int)((i >> 9) & 255), lg = (int)(i >> 17);
        const int s = k >> 4, q = k & 15, d = no >> 7, im = (no >> 6) & 1, n = no & 63;
        const int pwr = d == 0 ? 31 - s : s;
        const f32x2 a = WSP(f32x2, WS_PW)[(size_t)((lg * 2 + d) * 64 + n) * 33 + pwr];
        const f32x2 b = WSP(f32x2, WS_BB)[(size_t)((lg * 2 + d) * 64 + n) * 16 + q];
        const float v = im ? (a.x * b.y + a.y * b.x) : (a.x * b.x - a.y * b.y);
        WSP(bf16_t, WS_WE)[i] = f2bf(v);
    }
}

DEVI void moe_info(const Ctx& cx, int l, LAS int* info) {
    if (cx.tid < 64) {
        const unsigned* cnt = (const unsigned*)(cx.ws + WS_CTL) + CW_CNT + l * 32;
        const int c = cx.lane < 32 ? (int)__hip_atomic_load(cnt + (cx.lane & 31), __ATOMIC_RELAXED, __HIP_MEMORY_SCOPE_AGENT) : 0;
        const int nt = (c + 255) >> 8;
        if (cx.lane < 32) { info[72 + cx.lane] = nt; info[40 + cx.lane] = c; }
        if (cx.lane == 0) { int run = 0; info[0] = 0; for (int e = 0; e < 32; ++e) { run += info[72 + e]; info[e + 1] = run; } }
    }
    __syncthreads();
    if (cx.tid < 32) { const int lo = info[cx.tid], hi = info[cx.tid + 1]; for (int t = lo; t < hi; ++t) info[112 + t] = cx.tid;
    }
    __syncthreads();
}

DEVI void block_rows_visible() {
    asm volatile("s_waitcnt vmcnt(0)" ::: "memory");
    __syncthreads();
    __builtin_amdgcn_fence(__ATOMIC_ACQUIRE, "agent");
    asm volatile("s_waitcnt vmcnt(0)" ::: "memory");
}
DEVI void ph_norm1(const Ctx& cx, int l) {
    const Params& P = *cx.p;
    LAS int* info = (LAS int*)cx.lds;
    if (l > 0) moe_info(cx, l - 1, info);
    const int rbeg = (l == DEPTH) ? TCTX : 0, nr = TT - rbeg;
    const int rpb = (nr + cx.G - 1) / cx.G, rb = rbeg + cx.bid * rpb, re = min(TT, rb + rpb);
    const float* modp = WSP(float, WS_MOD);
    const int c0 = 2 * cx.lane;
    for (int r2 = rb + cx.wave; r2 < re; r2 += 16) {
        f32x2 x[2][8]; bool ok[2];
#pragma unroll
        for (int u = 0; u < 2; ++u) { const int row = r2 + 8 * u; ok[u] = row < re; const int rw_ = ok[u] ? row : r2;
            if (l == 0) { const float* src = rw_ < TCTX ? P.in[I_CTX] + (size_t)rw_ * 1024 : P.in[I_X] + (size_t)(rw_ - TCTX) * 1024;
#pragma unroll
                for (int i = 0; i < 8; ++i) x[u][i] = *(const f32x2*)(src + c0 + 128 * i);
            } else {
                const float* src = WSP(float, WS_XMID) + (size_t)rw_ * 1024;
                const float* g2 = modp + ((size_t)(l - 1) * 9 + mod_row(rw_)) * 6144 + 5120;
                const int* ti = WSP(int, WS_TINFO) + (size_t)rw_ * 4;
                f32x2 y[8];
#pragma unroll
                for (int i = 0; i < 8; ++i) y[i] = (f32x2){0.f, 0.f};
#pragma unroll
                for (int k = 0; k < 4; ++k) { const int t = ti[k]; const int e = t >> 20, slot = t & 0xFFFFF;
                    const bf16_t* yp = WSP(bf16_t, WS_YPAD) + ((size_t)info[e] * 256 + slot) * 1024;
#pragma unroll
                    for (int i = 0; i < 8; ++i) { const unsigned w = *(const unsigned*)(yp + c0 + 128 * i); y[i].x += __uint_as_float(w << 16); y[i].y += __uint_as_float(w & 0xFFFF0000u); } }
#pragma unroll
                for (int i = 0; i < 8; ++i) { const f32x2 xv = *(const f32x2*)(src + c0 + 128 * i), gv = *(const f32x2*)(g2 + c0 + 128 * i); x[u][i] = xv + gv * y[i]; }
            }
        }
#pragma unroll
        for (int u = 0; u < 2; ++u) {
            const int row = r2 + 8 * u;
            float ss = 0.f;
#pragma unroll
            for (int i = 0; i < 8; ++i) ss += x[u][i].x * x[u][i].x + x[u][i].y * x[u][i].y;
            ss = wave_sum(ss, 0);
            const float rstd = rsqrtf(ss * (1.0f / 1024.0f) + EPS);
            if (!ok[u]) continue;
            if (l == DEPTH) { float* o = P.out + (size_t)(row - TCTX) * 1024;
#pragma unroll
                for (int i = 0; i < 8; ++i) { const f32x2 fw = *(const f32x2*)(P.in[I_FNW] + c0 + 128 * i); *(f32x2*)(o + c0 + 128 * i) = x[u][i] * rstd * fw; }
                continue; }
            float* xs = WSP(float, WS_XS) + (size_t)row * 1024;
            const float* md = modp + ((size_t)l * 9 + mod_row(row)) * 6144;
            bf16_t* hp = WSP(bf16_t, WS_H) + (size_t)row * 1024;
#pragma unroll
            for (int i = 0; i < 8; ++i) { const int c = c0 + 128 * i;
                *(f32x2*)(xs + c) = x[u][i];
                const f32x2 nw = *(const f32x2*)(P.in[I_N1W] + l * 1024 + c), sc = *(const f32x2*)(md + 1024 + c), sh = *(const f32x2*)(md + c);
                const f32x2 h = x[u][i] * rstd * nw * (sc + 1.0f) + sh;
                *(unsigned*)(hp + c) = pk_bf16(h.x, h.y); }
        }
    }
    if (l == DEPTH) return;
    block_rows_visible();
    const int ntile = (re - rb + 15) / 16;
    for (int t = cx.wave; t < ntile; t += 8) {
        const int fr = cx.lane & 15, fq = cx.lane >> 4; const int row = min(rb + t * 16 + fr, re - 1);
        const bf16_t* hp = WSP(bf16_t, WS_H) + (size_t)row * 1024 + fq * 8;
        const bf16_t* wp = WSP(bf16_t, WS_WGT) + ((size_t)l * 16 + fr) * 1024 + fq * 8;
        f32x4 acc = (f32x4){0.f, 0.f, 0.f, 0.f};
#pragma unroll 8
        for (int k0 = 0; k0 < 1024; k0 += 32) acc = __builtin_amdgcn_mfma_f32_16x16x32_bf16(ldg8(wp + k0), ldg8(hp + k0), acc, 0, 0, 0);
        if (rb + t * 16 + fr < re) { const f32x4 bi = *(const f32x4*)(P.in[I_BIN] + l * DIN + 1536 + 4 * fq); *(f32x4*)(WSP(float, WS_GT) + (size_t)row * 16 + 4 * fq) = acc + bi; }
    }
}

DEVI void ph_norm2(const Ctx& cx, int l) {
    const Params& P = *cx.p;
    LAS float* lgs = (LAS float*)cx.lds;
    LAS int* hist = (LAS int*)(cx.lds + 128 * 33 * 4);
    LAS int* pend = hist + 64;
    if (cx.tid < 64) hist[cx.tid] = 0;
    const int r0 = (l == DEPTH - 1) ? TCTX : 0, nr = TT - r0;
    const int rpb = (nr + cx.G - 1) / cx.G;
    const int rb = r0 + cx.bid * rpb, re = min(TT, rb + rpb);
    const float* modp = WSP(float, WS_MOD);
    const int c0 = 2 * cx.lane;
    for (int r2 = rb + cx.wave; r2 < re; r2 += 16) {
        f32x2 x[2][8]; bool ok[2];
#pragma unroll
        for (int u = 0; u < 2; ++u) { const int row = r2 + 8 * u; ok[u] = row < re; const float* src = WSP(float, WS_XMID) + (size_t)(ok[u] ? row : r2) * 1024;
#pragma unroll
            for (int i = 0; i < 8; ++i) x[u][i] = *(const f32x2*)(src + c0 + 128 * i); }
#pragma unroll
        for (int u = 0; u < 2; ++u) {
            const int row = r2 + 8 * u;
            float ss = 0.f;
#pragma unroll
            for (int i = 0; i < 8; ++i) ss += x[u][i].x * x[u][i].x + x[u][i].y * x[u][i].y;
            ss = wave_sum(ss, 0);
            const float rstd = rsqrtf(ss * (1.0f / 1024.0f) + EPS);
            if (!ok[u]) continue;
            const float* md = modp + ((size_t)l * 9 + mod_row(row)) * 6144;
            bf16_t* hp = WSP(bf16_t, WS_H) + (size_t)row * 1024; bf16_t* hl = WSP(bf16_t, WS_HLO) + (size_t)row * 1024; unsigned char* h8 = WSP(unsigned char, WS_H8) + (size_t)row * 1024;
#pragma unroll
            for (int i = 0; i < 8; ++i) { const int c = c0 + 128 * i;
                const f32x2 nw = *(const f32x2*)(P.in[I_N2W] + l * 1024 + c), sc = *(const f32x2*)(md + 4096 + c), sh = *(const f32x2*)(md + 3072 + c);
                const f32x2 h = x[u][i] * rstd * nw * (sc + 1.0f) + sh;
                const int p8 = __builtin_amdgcn_cvt_pk_fp8_f32(h.x, h.y, 0, false);
                const float q0 = __builtin_amdgcn_cvt_f32_fp8(p8, 0), q1 = __builtin_amdgcn_cvt_f32_fp8(p8, 1);
                *(unsigned short*)(h8 + c) = (unsigned short)p8;
                *(unsigned*)(hp + c) = pk_bf16(q0, q1);
                *(unsigned*)(hl + c) = pk_bf16(h.x - q0, h.y - q1); }
        }
    }
    block_rows_visible();
    const int nrow = re - rb, ntile = (nrow + 15) / 16;
    for (int t2 = cx.wave; t2 < ntile * 2; t2 += 8) {
        const int t = t2 >> 1, nt = t2 & 1, fr = cx.lane & 15, fq = cx.lane >> 4; const int row = min(rb + t * 16 + fr, re - 1);
        const bf16_t* hp = WSP(bf16_t, WS_H) + (size_t)row * 1024 + fq * 8; const bf16_t* hl = WSP(bf16_t, WS_HLO) + (size_t)row * 1024 + fq * 8;
        const bf16_t* wh = WSP(bf16_t, WS_RWH) + ((size_t)l * 32 + nt * 16 + fr) * 1024 + fq * 8; const bf16_t* wl = WSP(bf16_t, WS_RWL) + ((size_t)l * 32 + nt * 16 + fr) * 1024 + fq * 8;
        f32x4 acc = (f32x4){0.f, 0.f, 0.f, 0.f}, acc2 = (f32x4){0.f, 0.f, 0.f, 0.f};
#pragma unroll 8
        for (int k0 = 0; k0 < 1024; k0 += 32) { const bf16x8 ah = ldg8(hp + k0), al = ldg8(hl + k0), bh = ldg8(wh + k0), bl = ldg8(wl + k0);
            acc = __builtin_amdgcn_mfma_f32_16x16x32_bf16(bh, ah, acc, 0, 0, 0);
            acc2 = __builtin_amdgcn_mfma_f32_16x16x32_bf16(bl, ah, acc2, 0, 0, 0);
            acc2 = __builtin_amdgcn_mfma_f32_16x16x32_bf16(bh, al, acc2, 0, 0, 0); }
        const int rl = t * 16 + fr;
        if (rl < nrow) {
#pragma unroll
            for (int j = 0; j < 4; ++j) { const int e = nt * 16 + 4 * fq + j; lgs[rl * 33 + e] = acc[j] + acc2[j] + P.in[I_RB][l * 32 + e]; } }
    }
    __syncthreads();
    if (cx.tid < nrow) {
        const LAS float* lp = lgs + cx.tid * 33;
        float tv[4]; int tix[4]; unsigned taken = 0u;
#pragma unroll
        for (int k = 0; k < 4; ++k) { float bv = -3.0e38f; int bi = 0;
            for (int e = 0; e < 32; ++e) { const float v = lp[e]; const bool better = (v > bv) && !((taken >> e) & 1u); bv = better ? v : bv; bi = better ? e : bi; }
            tv[k] = bv; tix[k] = bi; taken |= 1u << bi; }
        const float e1 = __expf(tv[1] - tv[0]), e2 = __expf(tv[2] - tv[0]), e3 = __expf(tv[3] - tv[0]);
        const float inv = 1.0f / (1.0f + e1 + e2 + e3);
        const float gk[4] = {inv, e1 * inv, e2 * inv, e3 * inv};
#pragma unroll
        for (int k = 0; k < 4; ++k) {
            const int ls = __hip_atomic_fetch_add((LAS int*)(hist + tix[k]), 1, __ATOMIC_RELAXED, __HIP_MEMORY_SCOPE_WORKGROUP);
            pend[(cx.tid * 4 + k) * 2 + 0] = (tix[k] << 20) | ls;
            pend[(cx.tid * 4 + k) * 2 + 1] = __float_as_int(gk[k]); }
    }
    __syncthreads();
    if (cx.tid < 32) { unsigned* cnt = (unsigned*)(cx.ws + WS_CTL) + CW_CNT + l * 32;
        hist[32 + cx.tid] = hist[cx.tid] > 0 ? (int)__hip_atomic_fetch_add(cnt + cx.tid, (unsigned)hist[cx.tid], __ATOMIC_RELAXED, __HIP_MEMORY_SCOPE_AGENT) : 0; }
    __syncthreads();
    for (int i = cx.tid; i < nrow * 4; i += NTHR) {
        const int t = pend[i * 2], e = t >> 20, slot = hist[32 + e] + (t & 0xFFFFF), row = rb + (i >> 2);
        WSP(int, WS_ELIST)[(size_t)e * TT + slot] = row;
        WSP(float, WS_GLIST)[(size_t)e * TT + slot] = __int_as_float(pend[i * 2 + 1]);
        WSP(int, WS_TINFO)[(size_t)row * 4 + (i & 3)] = (e << 20) | slot;
    }
}

DEVI int xcd_contig(int bid, int G) { return (G % 8 == 0) ? (bid % 8) * (G / 8) + bid / 8 : bid; }

struct DenseSched {
    const char* A; const char* B; int nM, nN, pm0, G, bid;
    DEVI bool get(int i, g1::Unit& u) const {
        int pm, pn;
        if (G % 8 == 0) { const int x = bid & 7, r = bid >> 3, nx = G >> 3, lo = (nM * x) >> 3, hi = (nM * (x + 1)) >> 3, nr = hi - lo;
            const int q = i * nx + r; if (nr <= 0 || q >= nr * nN) return false; pm = lo + q % nr; pn = q / nr; }
        else { const int L = i * G + bid; if (L >= nM * nN) return false; pm = L / nN; pn = L % nN; }
        u.A = A + (size_t)(pm0 + pm) * 256 * 2048; u.list = nullptr; u.nvalid = 256; u.B = B + (size_t)pn * 256 * 2048; u.pm = pm0 + pm; u.pn = pn; u.e = 0;
        return true;
    }
};
struct MoeSched {
    const char* A; const char* B; const int* elist; const LAS int* info; int NPN, gather, G, bid; size_t bstride; int kb;
    DEVI int rd(int i) const { return __builtin_amdgcn_readfirstlane(info[i]); }
    DEVI bool get(int i, g1::Unit& u) const {
        const int NTt = rd(32); int T, pn;
        if (G % 8 == 0 && (G >> 3) % NPN == 0) { const int x = bid & 7, r = bid >> 3, nx = G >> 3, RT = nx / NPN, lo = (NTt * x) >> 3, hi = (NTt * (x + 1)) >> 3;
            T = lo + i * RT + r % RT; pn = r / RT; if (T >= hi) return false; }
        else { const int L = i * G + bid; if (L >= NTt * NPN) return false; T = L / NPN; pn = L % NPN; }
        const int e = rd(112 + T), j = T - rd(e);
        u.pm = T; u.pn = pn; u.e = e;
        u.B = B + (size_t)e * bstride + (size_t)pn * 256 * kb;
        if (gather) { u.A = A; u.list = elist + (size_t)e * TT + j * 256; u.nvalid = rd(40 + e) - j * 256; }
        else { u.A = A + (size_t)T * 256 * kb; u.list = nullptr; u.nvalid = 256; }
        return true;
    }
};

struct EpiIn {
    static constexpr bool PERM = true;
    bf16_t* Pout; const float* bias;
    DEVI void operator()(const f32x4 (&acc)[2][2][4][2], const g1::Unit& u, int wr, int wc, int fr, int fq) const {
        const int row0 = u.pm * 256 + wr * 64 + fr;
#pragma unroll
        for (int bj = 0; bj < 2; ++bj) {
            const int col0 = u.pn * 256 + bj * 128 + wc * 32 + 8 * fq;
            const int seg = u.pn * 2 + bj; const bool gl = (seg >= 15 && seg < 18);
            const f32x4 b0 = *(const f32x4*)(bias + col0), b1 = *(const f32x4*)(bias + col0 + 4);
#pragma unroll
            for (int ai = 0; ai < 2; ++ai)
#pragma unroll
                for (int m = 0; m < 4; ++m) {
                    f32x4 v0 = acc[ai][bj][m][0] + b0, v1 = acc[ai][bj][m][1] + b1;
                    if (gl) {
#pragma unroll
                        for (int j = 0; j < 4; ++j) { v0[j] = gelu_tanh(v0[j]); v1[j] = gelu_tanh(v1[j]); } }
                    u32x4 w; w.x = pk_bf16(v0[0], v0[1]); w.y = pk_bf16(v0[2], v0[3]); w.z = pk_bf16(v1[0], v1[1]); w.w = pk_bf16(v1[2], v1[3]);
                    *(u32x4*)(Pout + (size_t)(row0 + ai * 128 + m * 16) * NP + col0) = w;
                }
        }
    }
};
struct EpiOut {
    static constexpr bool PERM = false;
    const float* xs; float* xmid; const float* mod;
    DEVI void operator()(const f32x4 (&acc)[2][2][4][2], const g1::Unit& u, int wr, int wc, int fr, int fq) const {
        const int row0 = u.pm * 256 + wr * 64 + fr;
        const float* g1p = mod + (size_t)mod_row(u.pm * 256) * 6144 + 2048;
#pragma unroll
        for (int bj = 0; bj < 2; ++bj)
#pragma unroll
            for (int n = 0; n < 2; ++n) {
                const int col = u.pn * 256 + bj * 128 + wc * 32 + 16 * n + 4 * fq;
                const f32x4 gv = *(const f32x4*)(g1p + col);
#pragma unroll
                for (int ai = 0; ai < 2; ++ai)
#pragma unroll
                    for (int m = 0; m < 4; ++m) {
                        const size_t off = (size_t)(row0 + ai * 128 + m * 16) * 1024 + col;
                        const f32x4 xv = *(const f32x4*)(xs + off);
                        *(f32x4*)(xmid + off) = xv + gv * acc[ai][bj][m][n];
                    }
            }
    }
};
struct EpiGU {
    static constexpr bool PERM = true;
    unsigned char* act; const float* bgu;
    DEVI void operator()(const f32x4 (&acc)[2][2][4][2], const g1::Unit& u, int wr, int wc, int fr, int fq) const {
        const int row0 = u.pm * 256 + wr * 64 + fr, colh = u.pn * 128 + wc * 32 + 8 * fq;
        const float* bg = bgu + (size_t)u.e * 2048 + colh; const float* bu = bg + 1024;
        const f32x4 bg0 = *(const f32x4*)bg, bg1 = *(const f32x4*)(bg + 4), bu0 = *(const f32x4*)bu, bu1 = *(const f32x4*)(bu + 4);
#pragma unroll
        for (int ai = 0; ai < 2; ++ai)
#pragma unroll
            for (int m = 0; m < 4; ++m) {
                float o[8];
#pragma unroll
                for (int n = 0; n < 2; ++n)
#pragma unroll
                    for (int j = 0; j < 4; ++j) {
                        const float g = fminf(acc[ai][0][m][n][j] * W8_INV + (n ? bg1[j] : bg0[j]), 7.0f);
                        const float up = fminf(fmaxf(acc[ai][1][m][n][j] * W8_INV + (n ? bu1[j] : bu0[j]), -7.0f), 7.0f);
                        o[n * 4 + j] = (up + 1.0f) * g * frcp(1.0f + __expf(-1.702f * g));
                    }
                u32x2 w; w.x = pk4_fp8(o[0], o[1], o[2], o[3]); w.y = pk4_fp8(o[4], o[5], o[6], o[7]);
                *(u32x2*)(act + (size_t)(row0 + ai * 128 + m * 16) * 1024 + colh) = w;
            }
    }
};
struct EpiDown {
    static constexpr bool PERM = true;
    bf16_t* ypad; const float* bd; const float* glist; const LAS int* info;
    DEVI void operator()(const f32x4 (&acc)[2][2][4][2], const g1::Unit& u, int wr, int wc, int fr, int fq) const {
        const int j256 = (u.pm - __builtin_amdgcn_readfirstlane(info[u.e])) * 256, cnt = __builtin_amdgcn_readfirstlane(info[40 + u.e]);
        const int rl0 = wr * 64 + fr;
#pragma unroll
        for (int ai = 0; ai < 2; ++ai)
#pragma unroll
            for (int m = 0; m < 4; ++m) {
                const int rl = rl0 + ai * 128 + m * 16, slot = j256 + rl;
                const float gt = slot < cnt ? glist[(size_t)u.e * TT + slot] : 0.f;
#pragma unroll
                for (int bj = 0; bj < 2; ++bj) {
                    const int col0 = u.pn * 256 + bj * 128 + wc * 32 + 8 * fq;
                    const f32x4 b0 = *(const f32x4*)(bd + (size_t)u.e * 1024 + col0), b1 = *(const f32x4*)(bd + (size_t)u.e * 1024 + col0 + 4);
                    const f32x4 v0 = (acc[ai][bj][m][0] * W8_INV + b0) * gt, v1 = (acc[ai][bj][m][1] * W8_INV + b1) * gt;
                    u32x4 w; w.x = pk_bf16(v0[0], v0[1]); w.y = pk_bf16(v0[2], v0[3]); w.z = pk_bf16(v1[0], v1[1]); w.w = pk_bf16(v1[2], v1[3]);
                    *(u32x4*)(ypad + (size_t)(u.pm * 256 + rl) * 1024 + col0) = w;
                }
            }
    }
};

DEVI void ph_inproj(const Ctx& cx, int l) {
    DenseSched S{(const char*)WSP(bf16_t, WS_H), (const char*)(WSP(bf16_t, WS_WIN) + (size_t)l * NP * 1024), TT / 256, NP / 256, 0, cx.G, cx.bid};
    EpiIn E{WSP(bf16_t, WS_P), WSP(float, WS_BIN2) + (size_t)l * NP};
    g1::gemm_phase<DenseSched, EpiIn, false>(cx.lds, cx.tid, S, E);
}
DEVI void ph_outproj(const Ctx& cx, int l) {
    const int pm0 = (l == DEPTH - 1) ? TCTX / 256 : 0;
    DenseSched S{(const char*)WSP(bf16_t, WS_MRG), (const char*)(WSP(bf16_t, WS_WOUT) + (size_t)l * 1024 * 1024), TT / 256 - pm0, 4, pm0, cx.G, cx.bid};
    EpiOut E{WSP(float, WS_XS), WSP(float, WS_XMID), WSP(float, WS_MOD) + (size_t)l * 9 * 6144};
    g1::gemm_phase<DenseSched, EpiOut, false>(cx.lds, cx.tid, S, E);
}
DEVI void ph_moe_gu(const Ctx& cx, int l) {
    LAS int* info = (LAS int*)(cx.lds + g1::STAGE_BYTES);
    moe_info(cx, l, info);
    MoeSched S{(const char*)WSP(unsigned char, WS_H8), (const char*)(WSP(unsigned char, WS_WGU) + (size_t)l * NE * 2048 * 1024), WSP(int, WS_ELIST), info, 8, 1, cx.G, cx.bid, (size_t)2048 * 1024, 1024};
    EpiGU E{WSP(unsigned char, WS_ACT), cx.p->in[I_BGU] + (size_t)l * NE * 2048};
    g1::gemm_phase<MoeSched, EpiGU, true, true>(cx.lds, cx.tid, S, E);
}
DEVI void ph_moe_dn(const Ctx& cx, int l) {
    LAS int* info = (LAS int*)(cx.lds + g1::STAGE_BYTES);
    moe_info(cx, l, info);
    MoeSched S{(const char*)WSP(unsigned char, WS_ACT), (const char*)(WSP(unsigned char, WS_WD) + (size_t)l * NE * 1024 * 1024), nullptr, info, 4, 0, cx.G, cx.bid, (size_t)1024 * 1024, 1024};
    EpiDown E{WSP(bf16_t, WS_YPAD), cx.p->in[I_BD] + (size_t)l * NE * 1024, WSP(float, WS_GLIST), info};
    g1::gemm_phase<MoeSched, EpiDown, false, true>(cx.lds, cx.tid, S, E);
}

DEVI int ml_row0(int b, int c) { return c < 2 ? b * CTXL + c * 128 : TCTX + b * SEQ + (c - 2) * 128; }
DEVI unsigned short lds_u16(const LAS bf16_t* p) { return *p; }

DEVI void ml_local_unit(const Ctx& cx, int l, int b, int h, int c) {
    LAS float* sg = (LAS float*)cx.lds;
    LAS float* se = sg + 256;
    LAS float* red = se + 256;
    LAS bf16_t* Ks = (LAS bf16_t*)(cx.lds + 4352);
    LAS bf16_t* Ve = Ks + 128 * 104;
    const int row0 = ml_row0(b, c), tid = cx.tid;
    const int dir = (tid >> 7) & 1, i = tid & 127, p = dir ? 127 - i : i;
    const bool act = tid < 256;
    float gi = 0.f, bval = 0.f, u = 0.f;
    if (act) { const float* gt = WSP(float, WS_GT) + (size_t)(row0 + i) * 16; gi = gt[dir * 4 + h]; const float gf = gt[8 + dir * 4 + h];
        sg[dir * 128 + p] = fminf(gf, 0.f) - log1p_(__expf(-fabsf(gf))); }
    LDS_SYNC();
#pragma unroll 1
    for (int off = 1; off < 128; off <<= 1) { float v = 0.f; if (act) { v = sg[dir * 128 + p]; if (p >= off) v += sg[dir * 128 + p - off]; } LDS_SYNC(); if (act) sg[dir * 128 + p] = v; LDS_SYNC(); }
    if (act) { bval = sg[dir * 128 + p]; u = gi - bval; if (p == 127) red[dir] = bval; }
    LDS_SYNC();
    if (act) sg[dir * 128 + p] = u;
    LDS_SYNC();
#pragma unroll 1
    for (int off = 1; off < 128; off <<= 1) { float v = 0.f; if (act) { v = sg[dir * 128 + p]; if (p >= off) v = fmaxf(v, sg[dir * 128 + p - off]); } LDS_SYNC(); if (act) sg[dir * 128 + p] = v; LDS_SYNC(); }
    if (act) { const float cm = sg[dir * 128 + p]; if (p == 127) red[2 + dir] = cm;
        const size_t gix = (size_t)(row0 + i) * 8 + dir * 4 + h;
        WSP(float, WS_GB)[gix] = bval; WSP(float, WS_GU)[gix] = u; WSP(float, WS_GCM)[gix] = cm; }
    LDS_SYNC();
    if (act) se[dir * 128 + i] = expf(u - red[2 + dir]);
    if (tid < 2) { float* msc = WSP(float, WS_MSC) + ((size_t)((b * 4 + h) * MLC + c) * 2 + tid) * 2; msc[0] = red[tid]; msc[1] = red[tid] + red[2 + tid]; }
    LDS_SYNC();
    const bf16_t* Pp = WSP(bf16_t, WS_P);
#pragma unroll
    for (int it = 0; it < 3; ++it) { const int idx = tid + NTHR * it, r = idx / 12, ch = idx % 12;
        const u32x4 kv = *(const u32x4*)(Pp + (size_t)(row0 + r) * NP + PC_K + h * 96 + ch * 8);
        *(LAS u32x4*)(Ks + r * 104 + ch * 8) = kv;
        const u32x4 vv = *(const u32x4*)(Pp + (size_t)(row0 + r) * NP + PC_V + h * 96 + ch * 8);
        const float e0 = se[r], e1 = se[128 + r];
        u32x4 o0, o1;
#pragma unroll
        for (int q = 0; q < 4; ++q) { const float lo = __uint_as_float(vv[q] << 16), hi = __uint_as_float(vv[q] & 0xFFFF0000u);
            o0[q] = pk_bf16(lo * e0, hi * e0); o1[q] = pk_bf16(lo * e1, hi * e1); }
        *(LAS u32x4*)(Ve + r * 104 + ch * 8) = o0; *(LAS u32x4*)(Ve + (128 + r) * 104 + ch * 8) = o1; }
    LDS_SYNC();
    {
        const int wd = cx.wave >> 2, q9 = (cx.wave & 3) * 9, fr = cx.lane & 15, fq = cx.lane >> 4;
        float* cl = WSP(float, WS_CLOC) + ((size_t)((b * 4 + h) * MLC + c) * 2 + wd) * 9216;
        const LAS bf16_t* V = Ve + wd * 128 * 104;
#pragma unroll 1
        for (int pi = q9; pi < q9 + 9; ++pi) { const int dt = pi / 6, et = pi % 6;
            f32x4 acc = (f32x4){0.f, 0.f, 0.f, 0.f};
#pragma unroll
            for (int kk = 0; kk < 4; ++kk) { bf16x8 a, bb;
#pragma unroll
                for (int j = 0; j < 8; ++j) { const int s = kk * 32 + fq * 8 + j; a[j] = (short)lds_u16(V + s * 104 + dt * 16 + fr); bb[j] = (short)lds_u16(Ks + s * 104 + et * 16 + fr); }
                acc = __builtin_amdgcn_mfma_f32_16x16x32_bf16(a, bb, acc, 0, 0, 0); }
#pragma unroll
            for (int r = 0; r < 4; ++r) cl[(dt * 16 + fq * 4 + r) * 96 + et * 16 + fr] = acc[r]; }
    }
    if (tid < 192) { const int d2 = tid / 96, e = tid % 96; float s = 0.f;
        for (int t = 0; t < 128; ++t) s += se[d2 * 128 + t] * bf2f(Ks[t * 104 + e]);
        WSP(float, WS_NLOC)[((size_t)((b * 4 + h) * MLC + c) * 2 + d2) * 96 + e] = s; }
    LDS_SYNC();
}

DEVI void ml_carry(const Ctx& cx) {
    for (int idx = cx.bid * NTHR + cx.tid; idx < 64 * 9312; idx += cx.G * NTHR) {
        const int combo = idx / 9312, el = idx % 9312, dir = combo & 1, bh = combo >> 1;
        float loc[MLC], bl[MLC], ml[MLC];
#pragma unroll
        for (int s = 0; s < MLC; ++s) {
            const int c = dir == 0 ? s : (s < 2 ? 1 - s : 19 - s);
            const size_t cb = (size_t)(bh * MLC + c) * 2 + dir;
            bl[s] = WSP(float, WS_MSC)[cb * 2]; ml[s] = WSP(float, WS_MSC)[cb * 2 + 1];
            loc[s] = el < 9216 ? WSP(float, WS_CLOC)[cb * 9216 + el] : WSP(float, WS_NLOC)[cb * 96 + el - 9216];
        }
        float Cv = 0.f, m = -1e30f;
#pragma unroll
        for (int s = 0; s < MLC; ++s) {
            const int c = dir == 0 ? s : (s < 2 ? 1 - s : 19 - s);
            const size_t cb = (size_t)(bh * MLC + c) * 2 + dir;
            if (el < 9216) WSP(bf16_t, WS_C0)[cb * 9216 + el] = f2bf(Cv); else WSP(float, WS_N0)[cb * 96 + el - 9216] = Cv;
            if (el == 0) WSP(float, WS_M0)[cb] = m;
            const float mn = fmaxf(bl[s] + m, ml[s]), a = __expf(bl[s] + m - mn), sc = __expf(ml[s] - mn);
            Cv = a * Cv + sc * loc[s]; m = mn;
        }
    }
}

DEVI void ml_out_unit(const Ctx& cx, int l, int b, int h, int c) {
    LAS bf16_t* Qs = (LAS bf16_t*)cx.lds;
    LAS bf16_t* Ks = Qs + 128 * 104;
    LAS bf16_t* Vs = Ks + 128 * 104;
    LAS bf16_t* C0s = Vs + 128 * 104;
    LAS float* gb = (LAS float*)(cx.lds + 119808);
    LAS float* gu = gb + 256;
    LAS float* gM = gu + 256;
    LAS float* n0s = gM + 256;
    LAS float* m0s = n0s + 192;
    const int row0 = ml_row0(b, c), tid = cx.tid;
    const bf16_t* Pp = WSP(bf16_t, WS_P);
    const size_t cb0 = (size_t)((b * 4 + h) * MLC + c) * 2;
#pragma unroll
    for (int it = 0; it < 3; ++it) { const int idx = tid + NTHR * it, r = idx / 12, ch = idx % 12;
        const bf16_t* rp = Pp + (size_t)(row0 + r) * NP + h * 96 + ch * 8;
        *(LAS u32x4*)(Qs + r * 104 + ch * 8) = *(const u32x4*)(rp + PC_Q);
        *(LAS u32x4*)(Ks + r * 104 + ch * 8) = *(const u32x4*)(rp + PC_K);
        *(LAS u32x4*)(Vs + r * 104 + ch * 8) = *(const u32x4*)(rp + PC_V); }
    for (int idx = tid; idx < 2 * 96 * 12; idx += NTHR) { const int d2 = idx / 1152, r = (idx % 1152) / 12, ch = idx % 12;
        *(LAS u32x4*)(C0s + (d2 * 96 + r) * 104 + ch * 8) = *(const u32x4*)(WSP(bf16_t, WS_C0) + (cb0 + d2) * 9216 + r * 96 + ch * 8); }
    if (tid < 256) { const int d2 = tid >> 7, i = tid & 127; const size_t gix = (size_t)(row0 + i) * 8 + d2 * 4 + h;
        gb[tid] = WSP(float, WS_GB)[gix]; gu[tid] = WSP(float, WS_GU)[gix];
        gM[tid] = fmaxf(WSP(float, WS_M0)[cb0 + d2], WSP(float, WS_GCM)[gix]); }
    if (tid >= 256 && tid < 448) { const int k = tid - 256; n0s[k] = WSP(float, WS_N0)[(cb0 + k / 96) * 96 + k % 96]; }
    if (tid >= 448 && tid < 450) m0s[tid - 448] = WSP(float, WS_M0)[cb0 + tid - 448];
    LDS_SYNC();
    const int w = cx.wave, fr = cx.lane & 15, fq = cx.lane >> 4, t = 16 * w + fr;
    bf16x8 qf[3];
#pragma unroll
    for (int kk = 0; kk < 3; ++kk) qf[kk] = *(const LAS bf16x8*)(Qs + t * 104 + kk * 32 + fq * 8);
    f32x4 hs[6];
#pragma unroll
    for (int n = 0; n < 6; ++n) hs[n] = (f32x4){0.f, 0.f, 0.f, 0.f};
#pragma unroll
    for (int dir = 0; dir < 2; ++dir) {
        const float Mt = gM[dir * 128 + t], bt = gb[dir * 128 + t], inter = __expf(m0s[dir] - Mt);
        f32x4 an[6];
#pragma unroll
        for (int n = 0; n < 6; ++n) an[n] = (f32x4){0.f, 0.f, 0.f, 0.f};
        float den = 0.f;
        const int Jlo = dir == 0 ? 0 : (w >> 1), Jhi = dir == 0 ? (w >> 1) : 3;
#pragma unroll 1
        for (int J = Jlo; J <= Jhi; ++J) {
            bf16x8 pf;
#pragma unroll
            for (int half = 0; half < 2; ++half) {
                const int j = 2 * J + half;
                f32x4 D = (f32x4){0.f, 0.f, 0.f, 0.f};
                const bool need = dir == 0 ? (j <= w) : (j >= w);
                if (need) {
#pragma unroll
                    for (int kk = 0; kk < 3; ++kk) { const bf16x8 kf = *(const LAS bf16x8*)(Ks + (16 * j + fr) * 104 + kk * 32 + fq * 8);
                        D = __builtin_amdgcn_mfma_f32_16x16x32_bf16(kf, qf[kk], D, 0, 0, 0); }
                }
                const f32x4 us = *(const LAS f32x4*)(gu + dir * 128 + 16 * j + 4 * fq);
                float pv[4];
#pragma unroll
                for (int r = 0; r < 4; ++r) { const int s = 16 * j + 4 * fq + r; const bool valid = need && (dir == 0 ? (s <= t) : (s >= t));
                    pv[r] = valid ? D[r] * __expf(us[r] - Mt) : 0.f; den += pv[r]; }
                pf[half * 4 + 0] = (short)f2bf(pv[0]); pf[half * 4 + 1] = (short)f2bf(pv[1]); pf[half * 4 + 2] = (short)f2bf(pv[2]); pf[half * 4 + 3] = (short)f2bf(pv[3]);
            }
#pragma unroll
            for (int n = 0; n < 6; ++n) { bf16x8 vf;
#pragma unroll
                for (int jj = 0; jj < 8; ++jj) { const int s = 32 * J + (jj < 4 ? 4 * fq + jj : 16 + 4 * fq + (jj - 4)); vf[jj] = (short)lds_u16(Vs + s * 104 + 16 * n + fr); }
                an[n] = __builtin_amdgcn_mfma_f32_16x16x32_bf16(vf, pf, an[n], 0, 0, 0); }
        }
        float nq = 0.f;
#pragma unroll
        for (int kk = 0; kk < 3; ++kk)
#pragma unroll
            for (int j = 0; j < 8; ++j) nq += n0s[dir * 96 + kk * 32 + fq * 8 + j] * bf2f((bf16_t)qf[kk][j]);
        nq += shx<16>(nq, cx.lane); nq += shx<32>(nq, cx.lane);
        den += shx<16>(den, cx.lane); den += shx<32>(den, cx.lane);
        const float dtot = den + inter * nq;
        const float inv = frcp(fmaxf(fabsf(dtot), __expf(-(Mt + bt))));
#pragma unroll
        for (int n = 0; n < 6; ++n) { f32x4 ac = (f32x4){0.f, 0.f, 0.f, 0.f};
#pragma unroll
            for (int kk = 0; kk < 3; ++kk) { const bf16x8 cf = *(const LAS bf16x8*)(C0s + (dir * 96 + 16 * n + fr) * 104 + kk * 32 + fq * 8);
                ac = __builtin_amdgcn_mfma_f32_16x16x32_bf16(cf, qf[kk], ac, 0, 0, 0); }
            hs[n] += (an[n] + ac * inter) * inv; }
    }
    float ss = 0.f;
#pragma unroll
    for (int n = 0; n < 6; ++n) ss += hs[n][0] * hs[n][0] + hs[n][1] * hs[n][1] + hs[n][2] * hs[n][2] + hs[n][3] * hs[n][3];
    ss += shx<16>(ss, cx.lane); ss += shx<32>(ss, cx.lane);
    const float rstd = rsqrtf(ss * (1.0f / 96.0f) + EPS);
    const size_t prow = (size_t)(row0 + t);
#pragma unroll
    for (int n = 0; n < 6; ++n) { const int d = 16 * n + 4 * fq;
        const u32x2 ov = *(const u32x2*)(Pp + prow * NP + PC_O + h * 96 + d);
        const f32x4 mw = *(const f32x4*)(cx.p->in[I_MIXW] + l * 1024 + h * 96 + d);
        const float o0 = __uint_as_float(ov.x << 16), o1 = __uint_as_float(ov.x & 0xFFFF0000u), o2 = __uint_as_float(ov.y << 16), o3 = __uint_as_float(ov.y & 0xFFFF0000u);
        u32x2 wv; wv.x = pk_bf16(sigmoidf_(o0) * hs[n][0] * rstd * mw[0], sigmoidf_(o1) * hs[n][1] * rstd * mw[1]);
        wv.y = pk_bf16(sigmoidf_(o2) * hs[n][2] * rstd * mw[2], sigmoidf_(o3) * hs[n][3] * rstd * mw[3]);
        *(u32x2*)(WSP(bf16_t, WS_MRG) + prow * 1024 + h * 96 + d) = wv; }
    LDS_SYNC();
}

DEVI void rg_unit(const Ctx& cx, int l, int b, int ck, int g, int mode) {
    const Params& P = *cx.p;
    LAS float* xraw = (LAS float*)cx.lds;
    LAS float* xc = (LAS float*)(cx.lds + 17408);
    LAS bf16_t* xcb = (LAS bf16_t*)(cx.lds + 33792);
    LAS float* ab = (LAS float*)(cx.lds + 43008);
    const int tid = cx.tid;
    const int t0 = ck < 4 ? ck * 64 : (ck - 4) * 64, seglen = ck < 4 ? CTXL : SEQ, rowbase = ck < 4 ? b * CTXL : TCTX + b * SEQ;
    const bf16_t* Pp = WSP(bf16_t, WS_P);
    for (int idx = tid; idx < 67 * 8; idx += NTHR) { const int r = idx >> 3, c8 = idx & 7, tt = t0 - 2 + r;
        u32x4 v = (u32x4){0u, 0u, 0u, 0u};
        if (tt >= 0 && tt < seglen) v = *(const u32x4*)(Pp + (size_t)(rowbase + tt) * NP + PC_RX + g * 64 + c8 * 8);
#pragma unroll
        for (int q = 0; q < 4; ++q) { xraw[r * 64 + c8 * 8 + 2 * q] = __uint_as_float(v[q] << 16); xraw[r * 64 + c8 * 8 + 2 * q + 1] = __uint_as_float(v[q] & 0xFFFF0000u); } }
    LDS_SYNC();
#pragma unroll
    for (int it = 0; it < 8; ++it) { const int idx = tid + NTHR * it, t = idx >> 6, ch = idx & 63, cg = g * 64 + ch;
        float v = P.in[I_RGCB][l * 384 + cg];
#pragma unroll
        for (int j = 0; j < 4; ++j) v += P.in[I_RGCW][(l * 4 + j) * 384 + cg] * xraw[(t + j) * 64 + ch];
        xc[t * 64 + ch] = v; xcb[t * 72 + ch] = f2bf(v); }
    LDS_SYNC();
    {
        const int dir = cx.wave >> 2, cg4 = cx.wave & 3, fr = cx.lane & 15, fq = cx.lane >> 4;
        const bf16_t* wrg = WSP(bf16_t, WS_WRG) + (size_t)(l * 6 + g) * 256 * 64;
        f32x4 ar[4], ai[4];
#pragma unroll
        for (int m = 0; m < 4; ++m) { ar[m] = (f32x4){0.f, 0.f, 0.f, 0.f}; ai[m] = (f32x4){0.f, 0.f, 0.f, 0.f}; }
#pragma unroll
        for (int kk = 0; kk < 2; ++kk) {
            const bf16x8 br = ldg8(wrg + (size_t)((dir * 2 + 0) * 64 + cg4 * 16 + fr) * 64 + kk * 32 + fq * 8);
            const bf16x8 bi = ldg8(wrg + (size_t)((dir * 2 + 1) * 64 + cg4 * 16 + fr) * 64 + kk * 32 + fq * 8);
#pragma unroll
            for (int m = 0; m < 4; ++m) { const bf16x8 a = *(const LAS bf16x8*)(xcb + (m * 16 + fr) * 72 + kk * 32 + fq * 8);
                ar[m] = __builtin_amdgcn_mfma_f32_16x16x32_bf16(br, a, ar[m], 0, 0, 0); ai[m] = __builtin_amdgcn_mfma_f32_16x16x32_bf16(bi, a, ai[m], 0, 0, 0); }
        }
        const int ch0 = cg4 * 16 + 4 * fq, cgl = g * 64 + ch0;
        const f32x4 ba = *(const f32x4*)(P.in[I_RGBA] + (l * 2 + dir) * 384 + cgl), bx = *(const f32x4*)(P.in[I_RGBX] + (l * 2 + dir) * 384 + cgl);
        const f32x4 lam = *(const f32x4*)(P.in[I_RGLAM] + (l * 2 + dir) * 384 + cgl);
        float sp[4];
#pragma unroll
        for (int j = 0; j < 4; ++j) sp[j] = lam[j] > 0.f ? log1p_(__expf(-lam[j])) : -lam[j] + log1p_(__expf(lam[j]));
#pragma unroll
        for (int m = 0; m < 4; ++m) { const int t = m * 16 + fr; const f32x4 xv = *(const LAS f32x4*)(xc + t * 64 + ch0);
            f32x4 av, bv;
#pragma unroll
            for (int j = 0; j < 4; ++j) { const float r = frcp(1.0f + __expf(-(ar[m][j] + ba[j]))), ii = frcp(1.0f + __expf(-(ai[m][j] + bx[j])));
                const float la = -8.0f * r * sp[j], y = 2.0f * la; av[j] = __expf(la);
                const float nem1 = y > -0.3f ? -y * (1.0f + y * (0.5f + y * (0.16666667f + y * (0.041666668f + y * 0.0083333338f)))) : 1.0f - __expf(y);
                bv[j] = sqrtf(nem1) * (ii * xv[j]); }
            *(LAS f32x4*)(ab + ((dir * 2 + 0) * 64 + t) * 64 + ch0) = av; *(LAS f32x4*)(ab + ((dir * 2 + 1) * 64 + t) * 64 + ch0) = bv; }
    }
    LDS_SYNC();
    if (tid < 128) { const int dir = tid >> 6, ch = tid & 63; const size_t ix = ((size_t)(b * RGC + ck) * 2 + dir) * 384 + g * 64 + ch;
        float hc = mode ? WSP(float, WS_RGC)[ix] : 0.f, ap = 1.0f;
        LAS float* A = ab + (dir * 2 + 0) * 4096 + ch; LAS float* B = ab + (dir * 2 + 1) * 4096 + ch;
#pragma unroll 8
        for (int s = 0; s < 64; ++s) { const int t = dir ? 63 - s : s; const float a = A[t * 64]; hc = a * hc + B[t * 64]; ap *= a; if (mode) B[t * 64] = hc; }
        if (!mode) { WSP(float, WS_RGA)[ix] = ap; WSP(float, WS_RGB)[ix] = hc; } }
    LDS_SYNC();
    if (mode) { const int t = tid >> 3, ch0 = (tid & 7) * 8; float hv[8]; float ss = 0.f;
#pragma unroll
        for (int j = 0; j < 8; ++j) { hv[j] = ab[(1 * 64 + t) * 64 + ch0 + j] + ab[(3 * 64 + t) * 64 + ch0 + j]; ss += hv[j] * hv[j]; }
        ss += dpp_<0xB1, 0xF>(ss); ss += dpp_<0x4E, 0xF>(ss); ss += dpp_<0x141, 0xF>(ss);
        const float rstd = rsqrtf(ss * (1.0f / 64.0f) + EPS);
        const size_t row = (size_t)(rowbase + t0 + t);
        const u32x4 gv = *(const u32x4*)(Pp + row * NP + PC_RG + g * 64 + ch0);
        const float* mw = P.in[I_MIXW] + l * 1024 + 384 + g * 64 + ch0;
        u32x4 o;
#pragma unroll
        for (int q = 0; q < 4; ++q) { const float g0 = __uint_as_float(gv[q] << 16), g1v = __uint_as_float(gv[q] & 0xFFFF0000u);
            o[q] = pk_bf16(g0 * hv[2 * q] * rstd * mw[2 * q], g1v * hv[2 * q + 1] * rstd * mw[2 * q + 1]); }
        *(u32x4*)(WSP(bf16_t, WS_MRG) + row * 1024 + 384 + g * 64 + ch0) = o;
        LDS_SYNC(); }
}
DEVI void rg_carry(const Ctx& cx) {
    for (int idx = (cx.G - 1 - cx.bid) * NTHR + cx.tid; idx < NB * 2 * 384; idx += cx.G * NTHR) {
        const int ch = idx % 384, dir = (idx / 384) & 1, b = idx / 768;
        float A[RGC], B[RGC];
#pragma unroll
        for (int s = 0; s < RGC; ++s) { const int ck = dir == 0 ? s : (s < 4 ? 3 - s : 39 - s);
            const size_t ix = ((size_t)(b * RGC + ck) * 2 + dir) * 384 + ch; A[s] = WSP(float, WS_RGA)[ix]; B[s] = WSP(float, WS_RGB)[ix]; }
        float h = 0.f;
#pragma unroll
        for (int s = 0; s < RGC; ++s) { const int ck = dir == 0 ? s : (s < 4 ? 3 - s : 39 - s);
            const size_t ix = ((size_t)(b * RGC + ck) * 2 + dir) * 384 + ch; WSP(float, WS_RGC)[ix] = h; h = A[s] * h + B[s]; }
    }
}

DEVI int s5_trow(int rowi, int s) { const int b = rowi / S5C, c = rowi % S5C; return c < 8 ? b * CTXL + c * 32 + s : TCTX + b * SEQ + s * 64 + (c - 8); }
DEVI void s5_local_wave(const Ctx& cx, int l, int wu) {
    const int g = wu / 36, mt = (wu % 36) / 4, nt = wu % 4;
    const bf16_t* Pp = WSP(bf16_t, WS_P) + PC_S5 + g * 16;
    const bf16_t* we = WSP(bf16_t, WS_WE) + (size_t)(l * 16 + g) * 256 * 512 + (size_t)nt * 64 * 512;
    f32x4 acc[4][4];
    wave_gemm<4, 4>(cx.lane, 512, [&](int row, int k) { return ldg8(Pp + (size_t)s5_trow(mt * 64 + row, k >> 4) * NP + (k & 15)); },
                         [&](int row, int k) { return ldg8(we + (size_t)row * 512 + k); }, acc);
    const int fr = cx.lane & 15, fq = cx.lane >> 4;
#pragma unroll
    for (int m = 0; m < 4; ++m)
#pragma unroll
        for (int n = 0; n < 4; ++n) *(f32x4*)(WSP(float, WS_SLOC) + ((size_t)g * S5R + mt * 64 + m * 16 + fr) * 256 + nt * 64 + n * 16 + 4 * fq) = acc[m][n];
}
DEVI void s5_carry(const Ctx& cx, int l) {
    for (int idx = cx.bid * NTHR + cx.tid; idx < NB * 16 * 2 * 64; idx += cx.G * NTHR) {
        const int n = idx & 63, d = (idx >> 6) & 1, g = (idx >> 7) & 15, b = idx >> 11;
        const f32x2 a32 = WSP(f32x2, WS_PW)[(size_t)(((l * 16 + g) * 2 + d) * 64 + n) * 33 + 32];
        float sr = 0.f, si = 0.f;
#pragma unroll 1
        for (int s0 = 0; s0 < S5C; s0 += 24) {
            float lr[24], li[24];
#pragma unroll
            for (int j = 0; j < 24; ++j) { const int s = s0 + j, c = d == 0 ? s : (s < 8 ? 7 - s : 79 - s);
                const size_t ix = ((size_t)g * S5R + b * S5C + c) * 256 + d * 128 + n; lr[j] = WSP(float, WS_SLOC)[ix]; li[j] = WSP(float, WS_SLOC)[ix + 64]; }
#pragma unroll
            for (int j = 0; j < 24; ++j) { const int s = s0 + j, c = d == 0 ? s : (s < 8 ? 7 - s : 79 - s);
                const size_t ix = ((size_t)g * S5R + b * S5C + c) * 256 + d * 128 + n;
                WSP(bf16_t, WS_SIN)[ix] = f2bf(sr); WSP(bf16_t, WS_SIN)[ix + 64] = f2bf(si);
                const float nr = a32.x * sr - a32.y * si + lr[j], ni = a32.x * si + a32.y * sr + li[j]; sr = nr; si = ni; }
        }
    }
}
DEVI void s5_out_wave(const Ctx& cx, int l, int wu) {
    const int g = wu / 72, mt = (wu % 72) / 8, nt = wu % 8;
    const bf16_t* Pp = WSP(bf16_t, WS_P) + PC_S5 + g * 16;
    const bf16_t* sin_ = WSP(bf16_t, WS_SIN) + (size_t)g * S5R * 256;
    const bf16_t* wy = WSP(bf16_t, WS_WY) + (size_t)(l * 16 + g) * 512 * 768 + (size_t)nt * 64 * 768;
    f32x4 acc[4][4];
    wave_gemm<4, 4>(cx.lane, 768, [&](int row, int k) { return k < 512 ? ldg8(Pp + (size_t)s5_trow(mt * 64 + row, k >> 4) * NP + (k & 15)) : ldg8(sin_ + (size_t)(mt * 64 + row) * 256 + (k - 512)); },
                         [&](int row, int k) { return ldg8(wy + (size_t)row * 768 + k); }, acc);
    const int fr = cx.lane & 15, fq = cx.lane >> 4;
#pragma unroll
    for (int m = 0; m < 4; ++m)
#pragma unroll
        for (int n = 0; n < 4; ++n) { const int trow = s5_trow(mt * 64 + m * 16 + fr, nt * 4 + n);
            u32x2 w; w.x = pk_bf16(gelu_tanh(acc[m][n][0]), gelu_tanh(acc[m][n][1])); w.y = pk_bf16(gelu_tanh(acc[m][n][2]), gelu_tanh(acc[m][n][3]));
            *(u32x2*)(WSP(bf16_t, WS_GS) + (size_t)trow * 256 + g * 16 + 4 * fq) = w; }
}
DEVI void s5_glu_wave(const Ctx& cx, int l, int wu) {
    const int mt = wu / 4, nt = wu % 4;
    const bf16_t* gs = WSP(bf16_t, WS_GS) + (size_t)mt * 64 * 256;
    const bf16_t* wg = WSP(bf16_t, WS_WGLU) + (size_t)l * 65536 + (size_t)nt * 64 * 256;
    f32x4 acc[4][4];
    wave_gemm<4, 4>(cx.lane, 256, [&](int row, int k) { return ldg8(gs + (size_t)row * 256 + k); }, [&](int row, int k) { return ldg8(wg + (size_t)row * 256 + k); }, acc);
    const int fr = cx.lane & 15, fq = cx.lane >> 4;
#pragma unroll
    for (int n = 0; n < 4; ++n) { const int col = nt * 64 + n * 16 + 4 * fq;
        const f32x4 gb = *(const f32x4*)(cx.p->in[I_S5GB] + l * 256 + col), mw = *(const f32x4*)(cx.p->in[I_MIXW] + l * 1024 + 768 + col);
#pragma unroll
        for (int m = 0; m < 4; ++m) { const size_t trow = (size_t)mt * 64 + m * 16 + fr;
            const u32x2 gv = *(const u32x2*)(WSP(bf16_t, WS_GS) + trow * 256 + col);
            const float gq[4] = {__uint_as_float(gv.x << 16), __uint_as_float(gv.x & 0xFFFF0000u), __uint_as_float(gv.y << 16), __uint_as_float(gv.y & 0xFFFF0000u)};
            float o[4]; float ss = 0.f;
#pragma unroll
            for (int j = 0; j < 4; ++j) { o[j] = gq[j] * frcp(1.0f + __expf(-(acc[m][n][j] + gb[j]))); ss += o[j] * o[j]; }
            ss += shx<16>(ss, cx.lane); ss += shx<32>(ss, cx.lane);
            const float rstd = rsqrtf(ss * (1.0f / 16.0f) + EPS);
            u32x2 w; w.x = pk_bf16(o[0] * rstd * mw[0], o[1] * rstd * mw[1]); w.y = pk_bf16(o[2] * rstd * mw[2], o[3] * rstd * mw[3]);
            *(u32x2*)(WSP(bf16_t, WS_MRG) + trow * 1024 + 768 + col) = w; } }
}

#ifndef PH_DUP2
#define PH_DUP2 0
#endif
#define REP_(k) for (int rep_ = 0; rep_ < 1 + ((PH_DUP2 >> (k)) & 1); ++rep_)
DEVI void ph_mix_local(const Ctx& cx, int l) {
    REP_(0) for (int u = cx.bid; u < NB * 4 * MLC; u += cx.G) ml_local_unit(cx, l, u / (4 * MLC), (u / MLC) % 4, u % MLC);
    REP_(1) { const int off = (NB * 4 * MLC) % cx.G; const int first = (cx.bid - off + cx.G) % cx.G;
      for (int u = first; u < NB * RGC * 6; u += cx.G) rg_unit(cx, l, u / (RGC * 6), (u / 6) % RGC, u % 6, 0); }
    REP_(2) { const int off = (NB * 4 * MLC + NB * RGC * 6) % cx.G; const int first = (cx.bid - off + cx.G) % cx.G;
      for (int wu = first * 8 + cx.wave; wu < 16 * 36; wu += cx.G * 8) s5_local_wave(cx, l, wu); }
}
DEVI void ph_mix_carry(const Ctx& cx, int l) { ml_carry(cx); rg_carry(cx); s5_carry(cx, l); }
DEVI void ph_mix_out(const Ctx& cx, int l) {
    const bool last = (l == DEPTH - 1);
    REP_(3) for (int u = cx.bid; u < NB * 4 * MLC; u += cx.G) { const int c = u % MLC; if (last && c < 2) continue; ml_out_unit(cx, l, u / (4 * MLC), (u / MLC) % 4, c); }
    REP_(4) { const int off = (NB * 4 * MLC) % cx.G; const int first = (cx.bid - off + cx.G) % cx.G;
      for (int u = first; u < NB * RGC * 6; u += cx.G) { const int ck = (u / 6) % RGC; if (last && ck < 4) continue; rg_unit(cx, l, u / (RGC * 6), ck, u % 6, 1); } }
    REP_(5) { const int off = (NB * 4 * MLC + NB * RGC * 6) % cx.G; const int first = (cx.bid - off + cx.G) % cx.G;
      for (int wu = first * 8 + cx.wave; wu < 16 * 72; wu += cx.G * 8) s5_out_wave(cx, l, wu); }
}
DEVI void ph_glu(const Ctx& cx, int l) {
    for (int wu = cx.bid * 8 + cx.wave; wu < (TT / 64) * 4; wu += cx.G * 8) s5_glu_wave(cx, l, wu);
}

DEVI unsigned st_launder(unsigned s_addr) { unsigned a; asm volatile("v_mov_b32 %0, %1" : "=v"(a) : "s"(s_addr)); return a; }
constexpr int N_STEPS = 3 + 10 * DEPTH + 1;
__global__ void __launch_bounds__(NTHR, 2) mk_fwd(Params p) {
    extern __shared__ __attribute__((aligned(16))) unsigned char lds_raw[];
    Ctx cx; cx.p = &p; cx.ws = p.ws; cx.lds = (LAS unsigned char*)lds_raw; cx.tid = threadIdx.x; cx.lane = cx.tid & 63;
    cx.wave = __builtin_amdgcn_readfirstlane((int)threadIdx.x >> 6); cx.G = gridDim.x; cx.bid = blockIdx.x;
    volatile LAS unsigned* st = (volatile LAS unsigned*)(cx.lds + LDS_BYTES - 16);
    const unsigned st_s = (unsigned)__builtin_amdgcn_readfirstlane((int)(unsigned)(size_t)(LAS unsigned*)(cx.lds + LDS_BYTES - 16));
#define ST_P ((volatile LAS unsigned*)(size_t)st_launder(st_s))
    if (cx.tid == 0) { st[0] = 0u; st[1] = 0u; st[2] = (unsigned)p.lo; st[3] = (unsigned)p.hi; }
    __syncthreads();
    (void)xcd_barrier_post((unsigned*)(p.ws + WS_CTL) + CW_BAR, st);
#define GRID_BAR() do { XcdBarrier b_; b_.bar = (unsigned*)(p.ws + WS_CTL) + CW_BAR; b_.x = (unsigned)__builtin_amdgcn_readfirstlane((int)xb_xcc_id()); b_.st = ST_P; xcd_barrier(b_); } while (0)
#ifndef PH_MASK
#define PH_MASK 0xFFFF
#endif
#ifndef PH_DUP
#define PH_DUP 0
#endif
#define STEP_(id, k, call) do { const int lo_ = __builtin_amdgcn_readfirstlane((int)ST_P[2]), hi_ = __builtin_amdgcn_readfirstlane((int)ST_P[3]); if (lo_ <= (k) && (k) < hi_) { if ((PH_MASK >> (id)) & 1) { const Ctx cl = relaunder(cx); call; } if ((PH_DUP >> (id)) & 1) { GRID_BAR(); const Ctx cl = relaunder(cx); call; } if ((k) + 1 < hi_) GRID_BAR(); } } while (0)
    STEP_(0, 0, ph_pro_a(cl));
    STEP_(1, 1, ph_pro_b(cl));
    STEP_(2, 2, ph_pro_c(cl));
#pragma unroll 1
    for (int l = 0; l < DEPTH; ++l) {
        const int s0 = 3 + 10 * l;
        STEP_(3, s0 + 0, ph_norm1(cl, l));
        STEP_(4, s0 + 1, ph_inproj(cl, l));
        STEP_(5, s0 + 2, ph_mix_local(cl, l));
        STEP_(6, s0 + 3, ph_mix_carry(cl, l));
        STEP_(7, s0 + 4, ph_mix_out(cl, l));
        STEP_(8, s0 + 5, ph_glu(cl, l));
        STEP_(9, s0 + 6, ph_outproj(cl, l));
        STEP_(10, s0 + 7, ph_norm2(cl, l));
        STEP_(11, s0 + 8, ph_moe_gu(cl, l));
        STEP_(12, s0 + 9, ph_moe_dn(cl, l));
    }
    STEP_(13, N_STEPS - 1, ph_norm1(cl, DEPTH));
#undef STEP_
}

extern "C" void kernel_launch(void* const* d_in, const int* in_sizes, int n_in, void* d_out, int out_size, void* d_ws, size_t ws_size, hipStream_t stream) {
    static int grid = 0;
    if (grid == 0) {
        if (n_in != 36 || out_size != TLAT * DM || ws_size < WS_END) { fprintf(stderr, "kernel_launch: unexpected problem (n_in %d, out %d, ws %zu < %zu)\n", n_in, out_size, ws_size, (size_t)WS_END); grid = -1; return; }
        int dev = 0, cus = 0, per_cu = 0;
        if (hipGetDevice(&dev) != hipSuccess || hipDeviceGetAttribute(&cus, hipDeviceAttributeMultiprocessorCount, dev) != hipSuccess) { grid = -1; return; }
        if (hipFuncSetAttribute((const void*)mk_fwd, hipFuncAttributeMaxDynamicSharedMemorySize, LDS_BYTES) != hipSuccess) { fprintf(stderr, "kernel_launch: hipFuncSetAttribute failed\n"); grid = -1; return; }
        if (hipOccupancyMaxActiveBlocksPerMultiprocessor(&per_cu, (const void*)mk_fwd, NTHR, LDS_BYTES) != hipSuccess || per_cu < 1) { fprintf(stderr, "kernel_launch: occupancy query says %d blocks per CU\n", per_cu); }
        (void)hipGetLastError();
        grid = cus;
    }
    if (grid < 0) return;
    (void)hipMemsetAsync((char*)d_ws + WS_CTL, 0, CTL_BYTES, stream);
    Params p{};
    for (int i = 0; i < 36; ++i) p.in[i] = (const float*)d_in[i];
    p.out = (float*)d_out; p.ws = (unsigned char*)d_ws;
#if MK_FUSED
    p.lo = 0; p.hi = N_STEPS;
    hipLaunchKernelGGL(mk_fwd, dim3(grid), dim3(NTHR), LDS_BYTES, stream, p);
#else
    for (int k = 0; k < N_STEPS; ++k) { p.lo = k; p.hi = k + 1; hipLaunchKernelGGL(mk_fwd, dim3(grid), dim3(NTHR), LDS_BYTES, stream, p); }
#endif
}
```

```cpp
#include <hip/hip_runtime.h>
#include <stdint.h>
#include <stdio.h>

#ifndef MK_FUSED
#define MK_FUSED 1
#endif

typedef unsigned short bf16_t;
typedef short bf16x8 __attribute__((ext_vector_type(8)));
typedef float f32x4 __attribute__((ext_vector_type(4)));
typedef float f32x2 __attribute__((ext_vector_type(2)));
typedef unsigned u32x4 __attribute__((ext_vector_type(4)));
typedef unsigned u32x2 __attribute__((ext_vector_type(2)));
typedef int i32x4 __attribute__((ext_vector_type(4)));
typedef int i32x8 __attribute__((ext_vector_type(8)));
#define LAS __attribute__((address_space(3)))
#define DEVI __device__ __forceinline__

constexpr int DM = 1024, NB = 8, SEQ = 2048, CTXL = 256, DEPTH = 4;
constexpr int TCTX = NB * CTXL, TLAT = NB * SEQ, TT = TCTX + TLAT;
constexpr int DIN = 2576, NP = 2560;
constexpr int NE = 32;
constexpr int PMAX = 81920;
constexpr int NTHR = 512;
constexpr int LDS_BYTES = 152 * 1024;
constexpr float EPS = 1e-6f;
constexpr float W8_SCALE = 32.0f, W8_INV = 0.03125f;
constexpr int PC_Q = 0, PC_K = 384, PC_V = 768, PC_O = 1152, PC_RX = 1536, PC_RG = 1920, PC_S5 = 2304;
constexpr int MLC = 18;
constexpr int RGC = 36;
constexpr int S5C = 72, S5R = NB * S5C;

constexpr size_t al256(size_t x) { return (x + 255) & ~(size_t)255; }
constexpr size_t WS_CTL   = 0;
constexpr size_t CTL_BYTES = 65536;
constexpr size_t CW_BAR = 0;
constexpr size_t CW_CNT = 4096;
constexpr size_t WS_WIN   = al256(WS_CTL + CTL_BYTES);
constexpr size_t WS_WOUT  = al256(WS_WIN + (size_t)DEPTH * NP * 1024 * 2);
constexpr size_t WS_WGU   = al256(WS_WOUT + (size_t)DEPTH * 1024 * 1024 * 2);
constexpr size_t WS_WD    = al256(WS_WGU + (size_t)DEPTH * NE * 2048 * 1024 * 2);
constexpr size_t WS_MOD   = al256(WS_WD + (size_t)DEPTH * NE * 1024 * 1024 * 2);
constexpr size_t WS_PW    = al256(WS_MOD + (size_t)DEPTH * 9 * 6144 * 4);
constexpr size_t WS_BB    = al256(WS_PW + (size_t)DEPTH * 16 * 2 * 64 * 33 * 8);
constexpr size_t WS_KT    = al256(WS_BB + (size_t)DEPTH * 16 * 2 * 64 * 16 * 8);
constexpr size_t WS_WY    = al256(WS_KT + (size_t)DEPTH * 16 * 2 * 32 * 256 * 4);
constexpr size_t WS_WE    = al256(WS_WY + (size_t)DEPTH * 16 * 512 * 768 * 2);
constexpr size_t WS_WRG   = al256(WS_WE + (size_t)DEPTH * 16 * 256 * 512 * 2);
constexpr size_t WS_WGLU  = al256(WS_WRG + (size_t)DEPTH * 6 * 256 * 64 * 2);
constexpr size_t WS_XS    = al256(WS_WGLU + (size_t)DEPTH * 256 * 256 * 2);
constexpr size_t WS_XMID  = al256(WS_XS + (size_t)TT * 1024 * 4);
constexpr size_t WS_H     = al256(WS_XMID + (size_t)TT * 1024 * 4);
constexpr size_t WS_GT    = al256(WS_H + (size_t)TT * 1024 * 2);
constexpr size_t WS_P     = al256(WS_GT + (size_t)TT * 16 * 4);
constexpr size_t WS_GB    = al256(WS_P + (size_t)TT * NP * 2);
constexpr size_t WS_GU    = al256(WS_GB + (size_t)TT * 8 * 4);
constexpr size_t WS_GCM   = al256(WS_GU + (size_t)TT * 8 * 4);
constexpr size_t WS_MSC   = al256(WS_GCM + (size_t)TT * 8 * 4);
constexpr size_t WS_CLOC  = al256(WS_MSC + (size_t)8 * 4 * 18 * 2 * 2 * 4);
constexpr size_t WS_NLOC  = al256(WS_CLOC + (size_t)8 * 4 * 18 * 2 * 9216 * 4);
constexpr size_t WS_C0    = al256(WS_NLOC + (size_t)8 * 4 * 18 * 2 * 96 * 4);
constexpr size_t WS_N0    = al256(WS_C0 + (size_t)8 * 4 * 18 * 2 * 9216 * 2);
constexpr size_t WS_M0    = al256(WS_N0 + (size_t)8 * 4 * 18 * 2 * 96 * 4);
constexpr size_t WS_RGA   = al256(WS_M0 + (size_t)8 * 4 * 18 * 2 * 4);
constexpr size_t WS_RGB   = al256(WS_RGA + (size_t)8 * 36 * 2 * 384 * 4);
constexpr size_t WS_RGC   = al256(WS_RGB + (size_t)8 * 36 * 2 * 384 * 4);
constexpr size_t WS_SLOC  = al256(WS_RGC + (size_t)8 * 36 * 2 * 384 * 4);
constexpr size_t WS_SIN   = al256(WS_SLOC + (size_t)16 * 576 * 256 * 4);
constexpr size_t WS_GS    = al256(WS_SIN + (size_t)16 * 576 * 256 * 2);
constexpr size_t WS_MRG   = al256(WS_GS + (size_t)TT * 256 * 2);
constexpr size_t WS_ELIST = al256(WS_MRG + (size_t)TT * 1024 * 2);
constexpr size_t WS_GLIST = al256(WS_ELIST + (size_t)NE * TT * 4);
constexpr size_t WS_TINFO = al256(WS_GLIST + (size_t)NE * TT * 4);
constexpr size_t WS_ACT   = al256(WS_TINFO + (size_t)TT * 4 * 4);
constexpr size_t WS_YPAD  = al256(WS_ACT + (size_t)PMAX * 1024 * 2);
constexpr size_t WS_BIN2  = al256(WS_YPAD + (size_t)PMAX * 1024 * 2);
constexpr size_t WS_HLO   = al256(WS_BIN2 + (size_t)DEPTH * NP * 4);
constexpr size_t WS_WGT   = al256(WS_HLO + (size_t)TT * 1024 * 2);
constexpr size_t WS_RWH   = al256(WS_WGT + (size_t)DEPTH * 16 * 1024 * 2);
constexpr size_t WS_RWL   = al256(WS_RWH + (size_t)DEPTH * 32 * 1024 * 2);
constexpr size_t WS_H8    = al256(WS_RWL + (size_t)DEPTH * 32 * 1024 * 2);
constexpr size_t WS_END   = al256(WS_H8 + (size_t)TT * 1024);

struct Params { const float* in[36]; float* out; unsigned char* ws; int lo, hi; };

enum { I_X = 0, I_C, I_CTX, I_CCTX, I_ADAW, I_ADAB, I_N1W, I_WIN, I_BIN, I_RGCW, I_RGCB, I_RGWA, I_RGBA, I_RGWX, I_RGBX, I_RGLAM,
       I_S5LRE, I_S5LIM, I_S5LDT, I_S5BRE, I_S5BIM, I_S5CRE, I_S5CIM, I_S5D, I_S5GW, I_S5GB, I_MIXW, I_WOUT, I_N2W, I_RW, I_RB,
       I_WGU, I_BGU, I_WD, I_BD, I_FNW };

DEVI bf16_t f2bf(float f) { unsigned u = __float_as_uint(f); u += 0x7FFFu + ((u >> 16) & 1u); return (bf16_t)(u >> 16); }
DEVI float bf2f(bf16_t b) { return __uint_as_float(((unsigned)b) << 16); }
DEVI unsigned pk_bf16(float lo, float hi) { unsigned r; asm("v_cvt_pk_bf16_f32 %0, %1, %2" : "=v"(r) : "v"(lo), "v"(hi)); return r; }
DEVI unsigned pk4_fp8(float a, float b, float c, float d) { int p = __builtin_amdgcn_cvt_pk_fp8_f32(a, b, 0, false); p = __builtin_amdgcn_cvt_pk_fp8_f32(c, d, p, true); return (unsigned)p; }
DEVI float q8(float x) { const int p = __builtin_amdgcn_cvt_pk_fp8_f32(x, x, 0, false); return __builtin_amdgcn_cvt_f32_fp8(p, 0); }
DEVI float frcp(float x) { return __builtin_amdgcn_rcpf(x); }
DEVI float sigmoidf_(float x) { return frcp(1.0f + __expf(-x)); }
DEVI float gelu_tanh(float x) { const float u = 0.7978845608f * (x + 0.044715f * x * x * x); return x * frcp(1.0f + __expf(-2.0f * u)); }
template <int M> DEVI float shx(float v, int lane) {
    if constexpr (M < 32) return __int_as_float(__builtin_amdgcn_ds_swizzle(__float_as_int(v), 0x1F | (M << 10)));
    else return __int_as_float(__builtin_amdgcn_ds_bpermute((lane ^ 32) << 2, __float_as_int(v)));
}
DEVI float shxr(float v, int m, int lane) {
    switch (m) { case 1: return shx<1>(v, lane); case 2: return shx<2>(v, lane); case 4: return shx<4>(v, lane); case 8: return shx<8>(v, lane); case 16: return shx<16>(v, lane); default: return shx<32>(v, lane); }
}
DEVI int shxri(int v, int m, int lane) { return __float_as_int(shxr(__int_as_float(v), m, lane)); }
template <int CTRL, int ROWMASK> DEVI float dpp_(float v) { return __int_as_float(__builtin_amdgcn_update_dpp(0, __float_as_int(v), CTRL, ROWMASK, 0xF, false)); }
DEVI float wave_sum(float v, int) {
    v += dpp_<0xB1, 0xF>(v); v += dpp_<0x4E, 0xF>(v); v += dpp_<0x141, 0xF>(v); v += dpp_<0x140, 0xF>(v);
    v += dpp_<0x142, 0xA>(v); v += dpp_<0x143, 0xC>(v);
    return __int_as_float(__builtin_amdgcn_readlane(__float_as_int(v), 63));
}
DEVI float log1p_(float e) { return e < 0.06f ? e * (1.0f - e * (0.5f - e * (0.33333334f - e * 0.25f))) : __logf(1.0f + e); }
#define LDS_SYNC() do { asm volatile("s_waitcnt lgkmcnt(0)" ::: "memory"); __builtin_amdgcn_s_barrier(); asm volatile("" ::: "memory"); } while (0)
DEVI int mod_row(int row) { return row < TCTX ? 8 : (row - TCTX) / SEQ; }

#define XB_TMO      128
#define XB_XCNT(j)  (256  + 64 * (j))
#define XB_XSUB(j)  (1280 + 64 * (j))
#define XB_XGEN(j)  (2304 + 64 * (j))
#define XB_TOP      3328
#define XB_TOPGEN   3392
#define XCD_BAR_WORDS 3456
#define XB_SPIN_CAP (1u << 18)
__device__ __forceinline__ unsigned xb_ld(unsigned* p)              { return __hip_atomic_load(p, __ATOMIC_RELAXED, __HIP_MEMORY_SCOPE_AGENT); }
__device__ __forceinline__ unsigned xb_add(unsigned* p, unsigned v) { return __hip_atomic_fetch_add(p, v, __ATOMIC_RELAXED, __HIP_MEMORY_SCOPE_AGENT); }
__device__ __forceinline__ unsigned xb_xcc_id() { return (unsigned)__builtin_amdgcn_s_getreg((3 << 11) | 20) & 0xFu; }
#define XB_SPIN(cond, bar) do { unsigned _sp = 0; while (cond) { __builtin_amdgcn_s_sleep(1); \
    if ((++_sp & 255u) == 0u) { if (xb_ld(&(bar)[XB_TMO])) break; if (_sp > XB_SPIN_CAP) { atomicAdd(&(bar)[XB_TMO], 1u); break; } } } } while (0)
struct XcdBarrier { unsigned* bar; unsigned x; volatile LAS unsigned* st; };
__device__ __forceinline__ XcdBarrier xcd_barrier_post(unsigned* bar, volatile LAS unsigned* st) {
    XcdBarrier b; b.bar = bar; b.x = xb_xcc_id(); b.st = st;
    if (threadIdx.x == 0) (void)xb_add(&bar[XB_XCNT(b.x)], 1u);
    return b;
}
__device__ __forceinline__ void xcd_barrier_complete(unsigned* bar, unsigned x, unsigned& nloc, unsigned& nx) {
    const unsigned G = gridDim.x * gridDim.y * gridDim.z;
    unsigned sum, cnt, mine, sp = 0u;
    for (;;) {
        sum = 0u; cnt = 0u; mine = 0u;
#pragma unroll
        for (unsigned j = 0; j < 16; ++j) { const unsigned c = xb_ld(&bar[XB_XCNT(j)]); sum += c; cnt += (c > 0u) ? 1u : 0u; mine = (j == x) ? c : mine; }
        if (sum == G) break;
        __builtin_amdgcn_s_sleep(1);
        if ((++sp & 255u) == 0u) { if (xb_ld(&bar[XB_TMO])) break; if (sp > XB_SPIN_CAP) { atomicAdd(&bar[XB_TMO], 1u); break; } }
    }
    nloc = mine > 0u ? mine : 1u; nx = cnt > 0u ? cnt : 1u;
}
__device__ __forceinline__ void xcd_barrier(const XcdBarrier& b) {
    asm volatile("s_waitcnt vmcnt(0)" ::: "memory");
    __syncthreads();
    if (threadIdx.x == 0) {
        unsigned* bar = b.bar;
        __builtin_amdgcn_s_waitcnt(0);
        unsigned nloc = b.st[0], nx = b.st[1];
        if (nloc == 0u) { xcd_barrier_complete(bar, b.x, nloc, nx); b.st[0] = nloc; b.st[1] = nx; }
        const unsigned old = xb_add(&bar[XB_XSUB(b.x)], 1u);
        const unsigned gen = old / nloc;
        if (old + 1u == (gen + 1u) * nloc) {
            __builtin_amdgcn_fence(__ATOMIC_RELEASE, "agent");
            asm volatile("s_waitcnt vmcnt(0)" ::: "memory");
            const unsigned og = xb_add(&bar[XB_TOP], 1u);
            const unsigned tg = og / nx;
            if (og + 1u == (tg + 1u) * nx) xb_add(&bar[XB_TOPGEN], 1u);
            else XB_SPIN(xb_ld(&bar[XB_TOPGEN]) == tg, bar);
            __builtin_amdgcn_fence(__ATOMIC_ACQUIRE, "agent");
            xb_add(&bar[XB_XGEN(b.x)], 1u);
            asm volatile("s_waitcnt vmcnt(0)" ::: "memory");
        } else {
            XB_SPIN(xb_ld(&bar[XB_XGEN(b.x)]) == gen, bar);
            __builtin_amdgcn_fence(__ATOMIC_ACQUIRE, "agent");
            asm volatile("s_waitcnt vmcnt(0)" ::: "memory");
        }
    }
    __syncthreads();
}

namespace g1 {
constexpr int BM = 256, BK = 64, HALF = 128, HTB = HALF * BK * 2, STAGE_BYTES = 8 * HTB, K = 1024, NT = K / BK;
DEVI int lds_byte(int r, int c) { const int st = (r >> 4) * 2 + (c >> 5), rr = r & 15, cc = c & 31, ob = rr * 64 + cc * 2; return st * 1024 + (ob ^ (((ob >> 9) & 1) << 5)); }
DEVI void stage_rc(int b, int& R, int& C) { const int st = b / 1024, sb = b % 1024, swz = sb ^ (((sb >> 9) & 1) << 5); R = (st >> 1) * 16 + swz / 64; C = (st & 1) * 32 + (swz % 64) / 2; }
DEVI int perm32(int rho) { const int n = rho >> 4, i = rho & 15; return 8 * (i >> 2) + 4 * n + (i & 3); }

struct Unit {
    const char* A;
    const int* list;
    int nvalid;
    const char* B;
    int pm, pn, e;
};

template <bool F8> struct FragT { typedef bf16x8 T; static constexpr int NK = 2; };
template <> struct FragT<true> { typedef i32x8 T; static constexpr int NK = 1; };
template <bool GATHER, int KB>
DEVI void a_offsets(const Unit& u, int tid, unsigned (&v)[2][2]) {
    int tz = tid; asm volatile("" : "+v"(tz));
#pragma unroll
    for (int i = 0; i < 2; ++i) {
        int R, C; stage_rc(tz * 16 + i * 8192, R, C);
#pragma unroll
        for (int h = 0; h < 2; ++h) {
            const int r = h * HALF + R;
            int src = r;
            if (GATHER) { const int nv = u.nvalid > 256 ? 256 : u.nvalid; const int ld_ = u.list[r < nv ? r : nv - 1]; src = (r < nv) ? ld_ : 0; }
            v[h][i] = (unsigned)src * (unsigned)KB + (unsigned)(C * 2);
        }
    }
}
DEVI void a_request(const Unit& u, int tid, int (&raw)[2][2]) {
    int tz = tid; asm volatile("" : "+v"(tz));
    const int nv = u.nvalid > 256 ? 256 : u.nvalid;
#pragma unroll
    for (int i = 0; i < 2; ++i) { int R, C; stage_rc(tz * 16 + i * 8192, R, C);
#pragma unroll
        for (int h = 0; h < 2; ++h) { const int r = h * HALF + R; raw[h][i] = u.list[r < nv ? r : nv - 1]; } }
}
template <int KB>
DEVI void a_finish(int nvalid, int tid, int (&raw)[2][2], unsigned (&v)[2][2]) {
    asm volatile("" : "+v"(raw[0][0]), "+v"(raw[0][1]), "+v"(raw[1][0]), "+v"(raw[1][1]));
    int tz = tid; asm volatile("" : "+v"(tz));
    const int nv = nvalid > 256 ? 256 : nvalid;
#pragma unroll
    for (int i = 0; i < 2; ++i) { int R, C; stage_rc(tz * 16 + i * 8192, R, C);
#pragma unroll
        for (int h = 0; h < 2; ++h) { const int r = h * HALF + R; const int src = (r < nv) ? raw[h][i] : 0; v[h][i] = (unsigned)src * (unsigned)KB + (unsigned)(C * 2); } }
}

template <class Sched, class Epi, bool GATHER, bool FP8 = false>
DEVI void gemm_phase(LAS unsigned char* lds, const int tid, const Sched& S, const Epi& E) {
    constexpr int KB = FP8 ? 1024 : 2048, NTK = KB / 128, NK = FragT<FP8>::NK;
    typedef typename FragT<FP8>::T frag_t;
    int sc1 = 0x7F7F7F7F; asm volatile("" : "+v"(sc1));
    const int wid = __builtin_amdgcn_readfirstlane(tid >> 6), lane = tid & 63, wr = wid >> 2, wc = wid & 3, fr = lane & 15, fq = lane >> 4;
    unsigned voffB[2];
#pragma unroll
    for (int i = 0; i < 2; ++i) { int R, C; stage_rc(tid * 16 + i * 8192, R, C); const int Rb = Epi::PERM ? ((R & ~31) + perm32(R & 31)) : R; voffB[i] = (unsigned)(Rb * KB + C * 2); }
    constexpr size_t kstep = (size_t)(BK * 2);
    constexpr size_t hstep = (size_t)HALF * KB;
    const unsigned ldsw = (unsigned)wid * 1024u;
    const int aoff = FP8 ? lds_byte(wr * 64 + fr, fq * 16) : lds_byte(wr * 64 + fr, fq * 8), boff = FP8 ? lds_byte(wc * 32 + fr, fq * 16) : lds_byte(wc * 32 + fr, fq * 8);
    const int sw16 = FP8 ? 16 * (fq & 1) : 0;
    unsigned pa_ = (unsigned)(size_t)(lds + aoff) + sw16, pb_ = (unsigned)(size_t)(lds + 65536 + boff) + sw16, pa2_ = (unsigned)(size_t)(lds + aoff) + (16 - sw16), pb2_ = (unsigned)(size_t)(lds + 65536 + boff) + (16 - sw16);
    asm volatile("" : "+v"(pa_), "+v"(pb_), "+v"(pa2_), "+v"(pb2_));
    LAS unsigned char* const pa = (LAS unsigned char*)(size_t)pa_; LAS unsigned char* const pb = (LAS unsigned char*)(size_t)pb_;
    LAS unsigned char* const pa2 = (LAS unsigned char*)(size_t)pa2_; LAS unsigned char* const pb2 = (LAS unsigned char*)(size_t)pb2_;
#define G1_SA(b, h) (((b) * 2 + (h)) * HTB)
#define G1_SB(b, h) ((4 + (b) * 2 + (h)) * HTB)
#define G1_STAGE2(bufoff, gbase, v0, v1) do { \
        __builtin_amdgcn_global_load_lds((const unsigned*)((const char*)(gbase) + (v0)), (LAS unsigned*)(lds + (bufoff) + ldsw), 16, 0, 0); \
        __builtin_amdgcn_global_load_lds((const unsigned*)((const char*)(gbase) + (v1)), (LAS unsigned*)(lds + (bufoff) + ldsw + 8192), 16, 0, 0); } while (0)
#define G1_LDFRAG(dst, ptr, ptr2) do { if constexpr (FP8) { const i32x4 lo_ = *(const LAS i32x4*)(ptr), hi_ = *(const LAS i32x4*)(ptr2); dst = __builtin_shufflevector(lo_, hi_, 0, 1, 2, 3, 4, 5, 6, 7); } \
        else { dst = *(const LAS frag_t*)(ptr); } } while (0)
#define G1_LDA(dst, b, h) do { _Pragma("unroll") for (int m = 0; m < 4; ++m) _Pragma("unroll") for (int k = 0; k < NK; ++k) G1_LDFRAG(dst[m][k], pa + (G1_SA(b, h) + m * 2048 + k * 1024), pa2 + (G1_SA(b, h) + m * 2048 + k * 1024)); } while (0)
#define G1_LDB(dst, b, h) do { _Pragma("unroll") for (int n = 0; n < 2; ++n) _Pragma("unroll") for (int k = 0; k < NK; ++k) G1_LDFRAG(dst[n][k], pb + (G1_SB(b, h) - 65536 + n * 2048 + k * 1024), pb2 + (G1_SB(b, h) - 65536 + n * 2048 + k * 1024)); } while (0)
#define G1_MFMA(c_, b_, a_) do { if constexpr (FP8) asm volatile("v_mfma_scale_f32_16x16x128_f8f6f4 %0, %1, %2, %0, %3, %3 op_sel_hi:[0,0,0]" : "+v"(c_) : "v"(b_), "v"(a_), "v"(sc1)); \
        else c_ = __builtin_amdgcn_mfma_f32_16x16x32_bf16(b_, a_, c_, 0, 0, 0); } while (0)
#define G1_MMA(ai, bj, At, Bt) do { __builtin_amdgcn_s_setprio(1); _Pragma("unroll") for (int m = 0; m < 4; ++m) _Pragma("unroll") for (int n = 0; n < 2; ++n) _Pragma("unroll") for (int k = 0; k < NK; ++k) \
        G1_MFMA(acc[ai][bj][m][n], Bt[n][k], At[m][k]); __builtin_amdgcn_s_setprio(0); } while (0)
#define G1_WAIT_V(n) asm volatile("s_waitcnt vmcnt(" #n ")" ::: "memory")
#define G1_WAIT_L(n) asm volatile("s_waitcnt lgkmcnt(" #n ")" ::: "memory")
#define G1_BAR __builtin_amdgcn_s_barrier()
#define G1_SCHED __builtin_amdgcn_sched_barrier(0)
    Unit cur, nxt; int ui = 0;
    if (!S.get(0, cur)) return;
    f32x4 acc[2][2][4][2];
#pragma unroll
    for (int a = 0; a < 2; ++a)
#pragma unroll
        for (int b = 0; b < 2; ++b)
#pragma unroll
            for (int m = 0; m < 4; ++m)
#pragma unroll
                for (int n = 0; n < 2; ++n) acc[a][b][m][n] = (f32x4){0.f, 0.f, 0.f, 0.f};
    frag_t At[4][NK], B0[2][NK], B1[2][NK];
    unsigned vc[2][2], vn[2][2];
    a_offsets<GATHER, KB>(cur, tid, vc);
    const char* cA = cur.A; const char* cB = cur.B;
    G1_STAGE2(G1_SB(0, 0), cB, voffB[0], voffB[1]); G1_STAGE2(G1_SA(0, 0), cA, vc[0][0], vc[0][1]);
    G1_STAGE2(G1_SB(0, 1), cB + hstep, voffB[0], voffB[1]); G1_STAGE2(G1_SA(0, 1), cA, vc[1][0], vc[1][1]);
    if (wr == 1) G1_BAR;
    G1_WAIT_V(4); G1_BAR;
    G1_STAGE2(G1_SB(1, 0), cB + kstep, voffB[0], voffB[1]); G1_STAGE2(G1_SA(1, 0), cA + kstep, vc[0][0], vc[0][1]);
    G1_STAGE2(G1_SB(1, 1), cB + hstep + kstep, voffB[0], voffB[1]);
    G1_WAIT_V(6); G1_BAR;
    for (;;) {
        const bool has_next = S.get(ui + 1, nxt);
        int raw[2][2] = {{0, 0}, {0, 0}};
        if (has_next) { if constexpr (GATHER) a_request(nxt, tid, raw); else a_offsets<GATHER, KB>(nxt, tid, vn); }
        else {
#pragma unroll
            for (int h = 0; h < 2; ++h)
#pragma unroll
                for (int i = 0; i < 2; ++i) vn[h][i] = vc[h][i];
        }
        const char* nA = has_next ? nxt.A : cA; const char* nB = has_next ? nxt.B : cB;
#pragma unroll 1
        for (int t = 0; t < NTK; t += 2) {
            const bool last = (t == NTK - 2);
            const char* a1 = cA + (size_t)(t + 1) * kstep;
            const char* a2 = last ? nA : cA + (size_t)(t + 2) * kstep; const char* b2 = last ? nB : cB + (size_t)(t + 2) * kstep;
            const char* a3 = a2 + kstep; const char* b3 = b2 + kstep;
            unsigned w00 = vc[0][0], w01 = vc[0][1], w10 = vc[1][0], w11 = vc[1][1];
            if (last) { if constexpr (GATHER) { if (has_next) a_finish<KB>(nxt.nvalid, tid, raw, vn); }
                w00 = vn[0][0]; w01 = vn[0][1]; w10 = vn[1][0]; w11 = vn[1][1]; asm volatile("" : "+v"(w00), "+v"(w01), "+v"(w10), "+v"(w11)); }
            G1_LDB(B0, 0, 0); G1_SCHED; G1_LDA(At, 0, 0); G1_STAGE2(G1_SA(1, 1), a1, vc[1][0], vc[1][1]);
            G1_WAIT_L(8); G1_BAR; G1_WAIT_L(0); G1_MMA(0, 0, At, B0); G1_BAR; G1_SCHED;
            G1_LDB(B1, 0, 1); G1_STAGE2(G1_SB(0, 0), b2, voffB[0], voffB[1]);
            G1_BAR; G1_WAIT_L(0); G1_MMA(0, 1, At, B1); G1_BAR;
            G1_LDA(At, 0, 1); G1_STAGE2(G1_SA(0, 0), a2, w00, w01);
            G1_BAR; G1_WAIT_L(0); G1_MMA(1, 0, At, B0); G1_BAR; G1_SCHED;
            G1_STAGE2(G1_SB(0, 1), b2 + hstep, voffB[0], voffB[1]);
            G1_WAIT_V(6); G1_BAR; G1_MMA(1, 1, At, B1); G1_BAR;
            G1_LDB(B0, 1, 0); G1_SCHED; G1_LDA(At, 1, 0); G1_STAGE2(G1_SA(0, 1), a2, w10, w11);
            G1_WAIT_L(8); G1_BAR; G1_WAIT_L(0); G1_MMA(0, 0, At, B0); G1_BAR; G1_SCHED;
            G1_LDB(B1, 1, 1); G1_STAGE2(G1_SB(1, 0), b3, voffB[0], voffB[1]);
            G1_BAR; G1_WAIT_L(0); G1_MMA(0, 1, At, B1); G1_BAR;
            G1_LDA(At, 1, 1); G1_STAGE2(G1_SA(1, 0), a3, w00, w01);
            G1_BAR; G1_WAIT_L(0); G1_MMA(1, 0, At, B0); G1_BAR; G1_SCHED;
            G1_STAGE2(G1_SB(1, 1), b3 + hstep, voffB[0], voffB[1]);
            G1_WAIT_V(6); G1_BAR; G1_MMA(1, 1, At, B1); G1_BAR;
        }
        if constexpr (FP8) asm volatile("s_nop 15\n\ts_nop 15" ::: "memory");
        E(acc, cur, wr, wc, fr, fq);
        if (!has_next) break;
#pragma unroll
        for (int a = 0; a < 2; ++a)
#pragma unroll
            for (int b = 0; b < 2; ++b)
#pragma unroll
                for (int m = 0; m < 4; ++m)
#pragma unroll
                    for (int n = 0; n < 2; ++n) acc[a][b][m][n] = (f32x4){0.f, 0.f, 0.f, 0.f};
        cur = nxt; cA = nA; cB = nB; ++ui;
#pragma unroll
        for (int h = 0; h < 2; ++h)
#pragma unroll
            for (int i = 0; i < 2; ++i) vc[h][i] = vn[h][i];
    }
    G1_WAIT_V(0);
    if (wr == 0) G1_BAR;
    G1_BAR;
}
}

template <int MT, int NT_, class AF, class BF>
DEVI void wave_gemm(const int lane, int Kdim, const AF& af, const BF& bf, f32x4 (&acc)[MT][NT_]) {
    const int fr = lane & 15, fq = lane >> 4;
#pragma unroll
    for (int m = 0; m < MT; ++m)
#pragma unroll
        for (int n = 0; n < NT_; ++n) acc[m][n] = (f32x4){0.f, 0.f, 0.f, 0.f};
    bf16x8 fa[4][MT], fb[4][NT_];
#define WG_LOAD(S, KK) do { _Pragma("unroll") for (int m = 0; m < MT; ++m) fa[S][m] = af(m * 16 + fr, (KK) + fq * 8); _Pragma("unroll") for (int n = 0; n < NT_; ++n) fb[S][n] = bf(n * 16 + fr, (KK) + fq * 8); } while (0)
#define WG_MMA(S) do { _Pragma("unroll") for (int m = 0; m < MT; ++m) _Pragma("unroll") for (int n = 0; n < NT_; ++n) acc[m][n] = __builtin_amdgcn_mfma_f32_16x16x32_bf16(fb[S][n], fa[S][m], acc[m][n], 0, 0, 0); } while (0)
    WG_LOAD(0, 0); WG_LOAD(1, 32); WG_LOAD(2, 64);
#pragma unroll 1
    for (int k0 = 0; k0 < Kdim; k0 += 128) {
        const bool more = k0 + 128 < Kdim;
        WG_LOAD(3, k0 + 96); WG_MMA(0);
        if (more) WG_LOAD(0, k0 + 128);
        WG_MMA(1);
        if (more) WG_LOAD(1, k0 + 160);
        WG_MMA(2);
        if (more) WG_LOAD(2, k0 + 192);
        WG_MMA(3);
    }
#undef WG_LOAD
#undef WG_MMA
}
DEVI bf16x8 ldg8(const bf16_t* p) { return *(const bf16x8*)p; }

template <int N> struct Log2 { static constexpr int v = 1 + Log2<N / 2>::v; };
template <> struct Log2<1> { static constexpr int v = 0; };
template <int N>
DEVI float reduce_scatter(const int lane, float (&v)[N]) {
    constexpr int LG = Log2<N>::v;
#pragma unroll
    for (int st = 0; st < LG; ++st) {
        const int s = (N / 2) >> st, mask = 32 >> st;
        const bool up = (lane & mask) != 0;
#pragma unroll
        for (int i = 0; i < N / 2; ++i) if (i < s) {
            const float send = up ? v[i] : v[i + s];
            const float keep = up ? v[i + s] : v[i];
            v[i] = keep + shxr(send, mask, lane);
        }
    }
    float r = v[0];
#pragma unroll
    for (int st = LG; st < 6; ++st) r += shxr(r, 32 >> st, lane);
    return r;
}
template <int N>
DEVI int rs_index(int lane) {
    constexpr int LG = Log2<N>::v;
    int idx = 0;
#pragma unroll
    for (int st = 0; st < LG; ++st) if (lane & (32 >> st)) idx += (N / 2) >> st;
    return idx;
}

struct Ctx {
    const Params* p; unsigned char* ws; LAS unsigned char* lds; int tid, lane, wave, G, bid;
};
#define WSP(T, off) ((T*)(cx.ws + (off)))
DEVI Ctx relaunder(const Ctx& c) { Ctx r = c; int ln, td;
    asm volatile("v_mbcnt_lo_u32_b32 %0, -1, 0\n\tv_mbcnt_hi_u32_b32 %0, -1, %0\n\tv_lshl_add_u32 %1, %2, 6, %0" : "=&v"(ln), "=v"(td) : "s"(c.wave));
    r.lane = ln; r.tid = td; return r; }

DEVI void cvt_tile(const Ctx& cx, const float* src, int ld, bf16_t* dst, int n0, int k0, int kind) {
    LAS bf16_t* tile = (LAS bf16_t*)cx.lds;
    const int n4 = (cx.tid & 63) * 4, w8 = (cx.tid >> 6) * 8, n = n0 + n4;
    int sc; float scale = 1.0f;
    if (kind == 0) { sc = n < 1536 ? n : n + 16; if (n >= 384 && n < 768) scale = 0.10206207261596577f; }
    else if (kind == 2) { const int pn = n >> 8, w = n & 255; sc = w < 128 ? pn * 128 + w : 1024 + pn * 128 + (w - 128); }
    else sc = n;
#pragma unroll 1
    for (int sub = 0; sub < 4; sub += 2) {
        f32x4 v[2][8];
#pragma unroll
        for (int s2 = 0; s2 < 2; ++s2)
#pragma unroll
            for (int p = 0; p < 8; ++p) v[s2][p] = __builtin_nontemporal_load((const f32x4*)(src + (size_t)(k0 + (sub + s2) * 64 + w8 + p) * ld + sc));
#pragma unroll
        for (int s2 = 0; s2 < 2; ++s2)
#pragma unroll
            for (int j = 0; j < 4; ++j) { u32x4 w;
                w.x = pk_bf16(v[s2][0][j] * scale, v[s2][1][j] * scale); w.y = pk_bf16(v[s2][2][j] * scale, v[s2][3][j] * scale);
                w.z = pk_bf16(v[s2][4][j] * scale, v[s2][5][j] * scale); w.w = pk_bf16(v[s2][6][j] * scale, v[s2][7][j] * scale);
                *(LAS u32x4*)(tile + (n4 + j) * 264 + (sub + s2) * 64 + w8) = w; }
    }
    LDS_SYNC();
#pragma unroll
    for (int i = 0; i < 16; ++i) { const int idx = cx.tid + NTHR * i, row = idx >> 5, ch = idx & 31;
        const u32x4 o = *(const LAS u32x4*)(tile + row * 264 + ch * 8);
        *(u32x4*)(dst + (size_t)(n0 + row) * 1024 + k0 + ch * 8) = o; }
    LDS_SYNC();
}

DEVI void cvt_tile8(const Ctx& cx, const float* src, int ld, unsigned char* dst, int n0, int k0, int kind) {
    LAS unsigned char* tile = cx.lds;
    const int n4 = (cx.tid & 63) * 4, w8 = (cx.tid >> 6) * 8, n = n0 + n4;
    int sc;
    if (kind == 2) { const int pn = n >> 8, w = n & 255; sc = w < 128 ? pn * 128 + w : 1024 + pn * 128 + (w - 128); }
    else sc = n;
#pragma unroll 1
    for (int sub = 0; sub < 4; sub += 2) {
        f32x4 v[2][8];
#pragma unroll
        for (int s2 = 0; s2 < 2; ++s2)
#pragma unroll
            for (int p = 0; p < 8; ++p) v[s2][p] = __builtin_nontemporal_load((const f32x4*)(src + (size_t)(k0 + (sub + s2) * 64 + w8 + p) * ld + sc));
#pragma unroll
        for (int s2 = 0; s2 < 2; ++s2)
#pragma unroll
            for (int j = 0; j < 4; ++j) { u32x2 w;
                w.x = pk4_fp8(v[s2][0][j] * W8_SCALE, v[s2][1][j] * W8_SCALE, v[s2][2][j] * W8_SCALE, v[s2][3][j] * W8_SCALE);
                w.y = pk4_fp8(v[s2][4][j] * W8_SCALE, v[s2][5][j] * W8_SCALE, v[s2][6][j] * W8_SCALE, v[s2][7][j] * W8_SCALE);
                *(LAS u32x2*)(tile + (n4 + j) * 272 + (sub + s2) * 64 + w8) = w; }
    }
    LDS_SYNC();
#pragma unroll
    for (int i = 0; i < 8; ++i) { const int idx = cx.tid + NTHR * i, row = idx >> 4, ch = idx & 15;
        const u32x4 o = *(const LAS u32x4*)(tile + row * 272 + ch * 16);
        *(u32x4*)(dst + (size_t)(n0 + row) * 1024 + k0 + ch * 16) = o; }
    LDS_SYNC();
}
DEVI void ph_pro_a(const Ctx& cx) {
    const Params& P = *cx.p;
    {
        constexpr int n_in = DEPTH * 10 * 4, n_out = DEPTH * 4 * 4, n_gu = DEPTH * NE * 8 * 4, n_dn = DEPTH * NE * 4 * 4;
        constexpr int total = n_in + n_out + n_gu + n_dn;
        for (int job = cx.bid; job < total; job += cx.G) {
            int j = job;
            if (j < n_in) { const int l = j / 40, r = j % 40, kt = r / 10, nt = r % 10;
                cvt_tile(cx, P.in[I_WIN] + (size_t)l * 1024 * DIN, DIN, WSP(bf16_t, WS_WIN) + (size_t)l * NP * 1024, nt * 256, kt * 256, 0); continue; }
            j -= n_in;
            if (j < n_out) { const int l = j / 16, r = j % 16, kt = r / 4, nt = r % 4;
                cvt_tile(cx, P.in[I_WOUT] + (size_t)l * 1024 * 1024, 1024, WSP(bf16_t, WS_WOUT) + (size_t)l * 1024 * 1024, nt * 256, kt * 256, 1); continue; }
            j -= n_out;
            if (j < n_gu) { const int le = j / 32, r = j % 32, kt = r / 8, nt = r % 8;
                cvt_tile8(cx, P.in[I_WGU] + (size_t)le * 1024 * 2048, 2048, WSP(unsigned char, WS_WGU) + (size_t)le * 2048 * 1024, nt * 256, kt * 256, 2); continue; }
            j -= n_gu;
            { const int le = j / 16, r = j % 16, kt = r / 4, nt = r % 4;
                cvt_tile8(cx, P.in[I_WD] + (size_t)le * 1024 * 1024, 1024, WSP(unsigned char, WS_WD) + (size_t)le * 1024 * 1024, nt * 256, kt * 256, 1); }
        }
    }
    __syncthreads();
    {
        LAS float* sv = (LAS float*)cx.lds;
        LAS float* red = sv + 9 * 1024;
        constexpr int units = DEPTH * 6144 / 64;
        if (cx.bid < units) {
            for (int i = cx.tid; i < 9 * 1024; i += NTHR) { const int r = i >> 10, k = i & 1023; const float c = r < 8 ? P.in[I_C][r * 1024 + k] : P.in[I_CCTX][k]; sv[i] = c / (1.0f + __expf(-c)); }
            __syncthreads();
            for (int u = cx.bid; u < units; u += cx.G) {
                const int l = u / 96, n = (u % 96) * 64 + cx.lane;
                const float* w = P.in[I_ADAW] + (size_t)l * 1024 * 6144 + n;
                float acc[9];
#pragma unroll
                for (int r = 0; r < 9; ++r) acc[r] = 0.f;
                const int kb = cx.wave * 128;
#pragma unroll 4
                for (int k = 0; k < 128; ++k) { const float wv = w[(size_t)(kb + k) * 6144];
#pragma unroll
                    for (int r = 0; r < 9; ++r) acc[r] += sv[r * 1024 + kb + k] * wv; }
#pragma unroll
                for (int r = 0; r < 9; ++r) red[(cx.wave * 9 + r) * 64 + cx.lane] = acc[r];
                __syncthreads();
                for (int i = cx.tid; i < 9 * 64; i += NTHR) { const int r = i >> 6, ln = i & 63; float s = 0.f;
#pragma unroll
                    for (int w8 = 0; w8 < 8; ++w8) s += red[(w8 * 9 + r) * 64 + ln];
                    const int nn = (u % 96) * 64 + ln;
                    WSP(float, WS_MOD)[((size_t)l * 9 + r) * 6144 + nn] = s + P.in[I_ADAB][l * 6144 + nn]; }
                __syncthreads();
            }
        }
    }
    for (int gt = cx.bid * NTHR + cx.tid; gt < DEPTH * 16 * 2 * 64; gt += cx.G * NTHR) {
        const int n = gt & 63, d = (gt >> 6) & 1, g = (gt >> 7) & 15, l = gt >> 11;
        const float dt = expf(P.in[I_S5LDT][(l * 2 + d) * 16 + g]);
        const float lr = P.in[I_S5LRE][((l * 2 + d) * 16 + g) * 64 + n], li = P.in[I_S5LIM][((l * 2 + d) * 16 + g) * 64 + n];
        f32x2* pw = WSP(f32x2, WS_PW) + (size_t)gt * 33;
        float ar = 0.f, ai = 0.f;
        for (int k = 0; k <= 32; ++k) { const float mag = expf(lr * dt * (float)k); float s, c; sincosf(li * dt * (float)k, &s, &c); pw[k] = (f32x2){mag * c, mag * s}; if (k == 1) { ar = mag * c; ai = mag * s; } }
        const float den = lr * lr + li * li;
        const float cr = ((ar - 1.0f) * lr + ai * li) / den, ci = (ai * lr - (ar - 1.0f) * li) / den;
        f32x2* bb = WSP(f32x2, WS_BB) + (size_t)gt * 16;
        for (int q = 0; q < 16; ++q) { const float br = P.in[I_S5BRE][((l * 16 + g) * 64 + n) * 16 + q], bi = P.in[I_S5BIM][((l * 16 + g) * 64 + n) * 16 + q];
            bb[q] = (f32x2){cr * br - ci * bi, cr * bi + ci * br}; }
    }
    for (int i = cx.bid * NTHR + cx.tid; i < DEPTH * 6 * 256 * 64; i += cx.G * NTHR) {
        const int k = i & 63, n = (i >> 6) & 255, g = (i >> 14) % 6, l = (i >> 14) / 6;
        const int j = n & 63, type = (n >> 6) & 1, dir = n >> 7;
        const float* w = type ? P.in[I_RGWX] : P.in[I_RGWA];
        WSP(bf16_t, WS_WRG)[i] = f2bf(w[((((size_t)l * 2 + dir) * 6 + g) * 64 + k) * 64 + j]);
    }
    for (int i = cx.bid * NTHR + cx.tid; i < DEPTH * NP; i += cx.G * NTHR) {
        const int n = i % NP, l = i / NP; const int sc = n < 1536 ? n : n + 16;
        WSP(float, WS_BIN2)[i] = P.in[I_BIN][l * DIN + sc] * ((n >= 384 && n < 768) ? 0.10206207261596577f : 1.0f);
    }
    for (int i = cx.bid * NTHR + cx.tid; i < DEPTH * 16 * 1024; i += cx.G * NTHR) { const int k = i & 1023, n = (i >> 10) & 15, l = i >> 14;
        WSP(bf16_t, WS_WGT)[i] = f2bf(P.in[I_WIN][((size_t)l * 1024 + k) * DIN + 1536 + n]); }
    for (int i = cx.bid * NTHR + cx.tid; i < DEPTH * 32 * 1024; i += cx.G * NTHR) { const int k = i & 1023, n = (i >> 10) & 31, l = i >> 15;
        const float w = P.in[I_RW][((size_t)l * 1024 + k) * 32 + n]; const bf16_t hi = f2bf(w);
        WSP(bf16_t, WS_RWH)[i] = hi; WSP(bf16_t, WS_RWL)[i] = f2bf(w - bf2f(hi)); }
    for (int i = cx.bid * NTHR + cx.tid; i < DEPTH * 256 * 256; i += cx.G * NTHR) {
        const int k = i & 255, n = (i >> 8) & 255, l = i >> 16;
        WSP(bf16_t, WS_WGLU)[i] = f2bf(P.in[I_S5GW][((size_t)l * 256 + k) * 256 + n]);
    }
}

DEVI void ph_pro_b(const Ctx& cx) {
    const Params& P = *cx.p;
    LAS f32x2* pw = (LAS f32x2*)cx.lds;
    LAS f32x2* bb = pw + 64 * 33;
    LAS f32x2* cc = bb + 64 * 16;
    for (int u = cx.bid; u < DEPTH * 16 * 2; u += cx.G) {
        const int lg = u >> 1;
        for (int i = cx.tid; i < 64 * 33; i += NTHR) pw[i] = WSP(f32x2, WS_PW)[(size_t)u * 64 * 33 + i];
        for (int i = cx.tid; i < 64 * 16; i += NTHR) bb[i] = WSP(f32x2, WS_BB)[(size_t)u * 64 * 16 + i];
        for (int i = cx.tid; i < 16 * 64; i += NTHR) cc[i] = (f32x2){P.in[I_S5CRE][(size_t)lg * 1024 + i], P.in[I_S5CIM][(size_t)lg * 1024 + i]};
        __syncthreads();
        const int q = cx.tid & 15, p = (cx.tid >> 4) & 15, tau0 = cx.tid >> 8;
        float acc[16];
#pragma unroll
        for (int i = 0; i < 16; ++i) acc[i] = 0.f;
#pragma unroll 2
        for (int n = 0; n < 64; ++n) { const f32x2 b = bb[n * 16 + q], c = cc[p * 64 + n];
#pragma unroll
            for (int i = 0; i < 16; ++i) { const f32x2 a = pw[n * 33 + tau0 + 2 * i]; const float xr = c.x * a.x - c.y * a.y, xi = c.x * a.y + c.y * a.x; acc[i] += xr * b.x - xi * b.y; } }
#pragma unroll
        for (int i = 0; i < 16; ++i) WSP(float, WS_KT)[(((size_t)u * 32 + tau0 + 2 * i) * 16 + p) * 16 + q] = acc[i];
        __syncthreads();
    }
}

DEVI void ph_pro_c(const Ctx& cx) {
    const Params& P = *cx.p;
    LAS float* kt = (LAS float*)cx.lds;
    LAS f32x2* pw = (LAS f32x2*)(kt + 2 * 32 * 256);
    LAS f32x2* bb = pw + 2 * 64 * 33;
    LAS f32x2* cc = bb + 2 * 64 * 16;
    LAS float* dsk = (LAS float*)(cc + 16 * 64);
    for (int u = cx.bid; u < DEPTH * 16 * 4; u += cx.G) {
        const int lg = u >> 2, qt = u & 3, l = lg >> 4, g = lg & 15;
        for (int i = cx.tid; i < 2 * 32 * 256; i += NTHR) kt[i] = WSP(float, WS_KT)[(size_t)lg * 2 * 32 * 256 + i];
        for (int i = cx.tid; i < 2 * 64 * 33; i += NTHR) pw[i] = WSP(f32x2, WS_PW)[(size_t)lg * 2 * 64 * 33 + i];
        for (int i = cx.tid; i < 2 * 64 * 16; i += NTHR) bb[i] = WSP(f32x2, WS_BB)[(size_t)lg * 2 * 64 * 16 + i];
        for (int i = cx.tid; i < 16 * 64; i += NTHR) cc[i] = (f32x2){P.in[I_S5CRE][(size_t)lg * 1024 + i], P.in[I_S5CIM][(size_t)lg * 1024 + i]};
        if (cx.tid < 16) dsk[cx.tid] = P.in[I_S5D][l * 256 + g * 16 + cx.tid];
        __syncthreads();
        bf16_t* wy = WSP(bf16_t, WS_WY) + ((size_t)lg * 512 + qt * 128) * 768;
        for (int idx = cx.tid; idx < 128 * 768; idx += NTHR) {
            const int k = idx % 768, tp = qt * 128 + idx / 768, t = tp >> 4, p = tp & 15;
            float v;
            if (k < 512) { const int sI = k >> 4, q = k & 15; v = 0.f;
                if (sI <= t) v += kt[(0 * 32 + (t - sI)) * 256 + p * 16 + q];
                if (sI >= t) v += kt[(1 * 32 + (sI - t)) * 256 + p * 16 + q];
                if (sI == t && p == q) v += dsk[p];
            } else { const int kk = k - 512, d = kk >> 7, im = (kk >> 6) & 1, n = kk & 63;
                const int pwr = d == 0 ? t + 1 : 32 - t;
                const f32x2 a = pw[(d * 64 + n) * 33 + pwr], c = cc[p * 64 + n];
                v = im ? -(c.x * a.y + c.y * a.x) : (c.x * a.x - c.y * a.y); }
            wy[idx] = f2bf(v);
        }
        bf16_t* we = WSP(bf16_t, WS_WE) + ((size_t)lg * 256 + qt * 64) * 512;
        for (int idx = cx.tid; idx < 64 * 512; idx += NTHR) {
            const int k = idx & 511, no = qt * 64 + (idx >> 9);
            const int sI = k >> 4, q = k & 15, d = no >> 7, im = (no >> 6) & 1, n = no & 63;
            const int pwr = d == 0 ? 31 - sI : sI;
            const f32x2 a = pw[(d * 64 + n) * 33 + pwr], b2 = bb[(d * 64 + n) * 16 + q];
            we[idx] = f2bf(im ? (a.x * b2.y + a.y * b2.x) : (a.x * b2.x - a.y * b2.y));
        }
        __syncthreads();
    }
}

DEVI void moe_info(const Ctx& cx, int l, LAS int* info) {
    if (cx.tid < 64) {
        const unsigned* cnt = (const unsigned*)(cx.ws + WS_CTL) + CW_CNT + l * 32;
        const int c = cx.lane < 32 ? (int)__hip_atomic_load(cnt + (cx.lane & 31), __ATOMIC_RELAXED, __HIP_MEMORY_SCOPE_AGENT) : 0;
        const int nt = (c + 255) >> 8;
        if (cx.lane < 32) { info[72 + cx.lane] = nt; info[40 + cx.lane] = c; }
        if (cx.lane == 0) { int run = 0; info[0] = 0; for (int e = 0; e < 32; ++e) { run += info[72 + e]; info[e + 1] = run; } }
    }
    __syncthreads();
    if (cx.tid < 32) { const int lo = info[cx.tid], hi = info[cx.tid + 1]; for (int t = lo; t < hi; ++t) info[112 + t] = cx.tid;
    }
    __syncthreads();
}

DEVI void block_rows_visible() {
    asm volatile("s_waitcnt vmcnt(0)" ::: "memory");
    __syncthreads();
    __builtin_amdgcn_fence(__ATOMIC_ACQUIRE, "agent");
    asm volatile("s_waitcnt vmcnt(0)" ::: "memory");
}
DEVI void ph_norm1(const Ctx& cx, int l) {
    const Params& P = *cx.p;
    LAS int* info = (LAS int*)cx.lds;
    LAS float* part = (LAS float*)(cx.lds + 4096);
    if (l > 0) moe_info(cx, l - 1, info);
    const int rbeg = (l == DEPTH) ? TCTX : 0, nr = TT - rbeg;
    const int rpb = (nr + cx.G - 1) / cx.G, rb = rbeg + cx.bid * rpb, re = min(TT, rb + rpb);
    const float* modp = WSP(float, WS_MOD);
    const int c0 = 4 * cx.lane;
    for (int r2 = rb + cx.wave; r2 < re; r2 += 16) {
        f32x4 x[2][4]; bool ok[2];
#pragma unroll
        for (int u = 0; u < 2; ++u) { const int row = r2 + 8 * u; ok[u] = row < re; const int rw_ = ok[u] ? row : r2;
            if (l == 0) { const float* src = rw_ < TCTX ? P.in[I_CTX] + (size_t)rw_ * 1024 : P.in[I_X] + (size_t)(rw_ - TCTX) * 1024;
#pragma unroll
                for (int i = 0; i < 4; ++i) x[u][i] = *(const f32x4*)(src + c0 + 256 * i);
            } else {
                const float* src = WSP(float, WS_XMID) + (size_t)rw_ * 1024;
                const float* g2 = modp + ((size_t)(l - 1) * 9 + mod_row(rw_)) * 6144 + 5120;
                const int* ti = WSP(int, WS_TINFO) + (size_t)rw_ * 4;
                f32x4 y[4];
#pragma unroll
                for (int i = 0; i < 4; ++i) y[i] = (f32x4){0.f, 0.f, 0.f, 0.f};
#pragma unroll
                for (int k = 0; k < 4; ++k) { const int t = ti[k]; const int e = t >> 20, slot = t & 0xFFFFF;
                    const bf16_t* yp = WSP(bf16_t, WS_YPAD) + ((size_t)info[e] * 256 + slot) * 1024;
#pragma unroll
                    for (int i = 0; i < 4; ++i) { const u32x2 w = *(const u32x2*)(yp + c0 + 256 * i);
                        y[i][0] += __uint_as_float(w.x << 16); y[i][1] += __uint_as_float(w.x & 0xFFFF0000u); y[i][2] += __uint_as_float(w.y << 16); y[i][3] += __uint_as_float(w.y & 0xFFFF0000u); } }
#pragma unroll
                for (int i = 0; i < 4; ++i) { const f32x4 xv = *(const f32x4*)(src + c0 + 256 * i), gv = *(const f32x4*)(g2 + c0 + 256 * i); x[u][i] = xv + gv * y[i]; }
            }
        }
#pragma unroll
        for (int u = 0; u < 2; ++u) {
            const int row = r2 + 8 * u;
            float ss = 0.f;
#pragma unroll
            for (int i = 0; i < 4; ++i) ss += (x[u][i][0] * x[u][i][0] + x[u][i][1] * x[u][i][1]) + (x[u][i][2] * x[u][i][2] + x[u][i][3] * x[u][i][3]);
            ss = wave_sum(ss, 0);
            const float rstd = rsqrtf(ss * (1.0f / 1024.0f) + EPS);
            if (!ok[u]) continue;
            if (l == DEPTH) { float* o = P.out + (size_t)(row - TCTX) * 1024;
#pragma unroll
                for (int i = 0; i < 4; ++i) { const f32x4 fw = *(const f32x4*)(P.in[I_FNW] + c0 + 256 * i); *(f32x4*)(o + c0 + 256 * i) = x[u][i] * rstd * fw; }
                continue; }
            float* xs = WSP(float, WS_XS) + (size_t)row * 1024;
            const float* md = modp + ((size_t)l * 9 + mod_row(row)) * 6144;
            bf16_t* hp = WSP(bf16_t, WS_H) + (size_t)row * 1024;
#pragma unroll
            for (int i = 0; i < 4; ++i) { const int c = c0 + 256 * i;
                *(f32x4*)(xs + c) = x[u][i];
                const f32x4 nw = *(const f32x4*)(P.in[I_N1W] + l * 1024 + c), sc = *(const f32x4*)(md + 1024 + c), sh = *(const f32x4*)(md + c);
                const f32x4 h = x[u][i] * rstd * nw * (sc + 1.0f) + sh;
                u32x2 w; w.x = pk_bf16(h[0], h[1]); w.y = pk_bf16(h[2], h[3]); *(u32x2*)(hp + c) = w; }
        }
    }
    if (l == DEPTH) return;
    block_rows_visible();
    const int nrow = re - rb, ntile = (nrow + 15) / 16;
    for (int it = cx.wave; it < ntile * 4; it += 8) {
        const int t = it >> 2, kq = it & 3, fr = cx.lane & 15, fq = cx.lane >> 4; const int row = min(rb + t * 16 + fr, re - 1);
        const bf16_t* hp = WSP(bf16_t, WS_H) + (size_t)row * 1024 + kq * 256 + fq * 8;
        const bf16_t* wp = WSP(bf16_t, WS_WGT) + ((size_t)l * 16 + fr) * 1024 + kq * 256 + fq * 8;
        f32x4 acc = (f32x4){0.f, 0.f, 0.f, 0.f};
#pragma unroll
        for (int k0 = 0; k0 < 256; k0 += 32) acc = __builtin_amdgcn_mfma_f32_16x16x32_bf16(ldg8(wp + k0), ldg8(hp + k0), acc, 0, 0, 0);
        *(LAS f32x4*)(part + ((kq * 128) + t * 16 + fr) * 16 + 4 * fq) = acc;
    }
    __syncthreads();
    for (int i = cx.tid; i < nrow * 16; i += NTHR) { const int rl = i >> 4, gi = i & 15;
        WSP(float, WS_GT)[(size_t)(rb + rl) * 16 + gi] = (part[(0 * 128 + rl) * 16 + gi] + part[(1 * 128 + rl) * 16 + gi]) + (part[(2 * 128 + rl) * 16 + gi] + part[(3 * 128 + rl) * 16 + gi]) + P.in[I_BIN][l * DIN + 1536 + gi]; }
}

DEVI void ph_norm2(const Ctx& cx, int l) {
    const Params& P = *cx.p;
    LAS float* lgs = (LAS float*)cx.lds;
    LAS int* hist = (LAS int*)(cx.lds + 4 * 128 * 33 * 4);
    LAS int* pend = hist + 64;
    if (cx.tid < 64) hist[cx.tid] = 0;
    const int r0 = (l == DEPTH - 1) ? TCTX : 0, nr = TT - r0;
    const int rpb = (nr + cx.G - 1) / cx.G;
    const int rb = r0 + cx.bid * rpb, re = min(TT, rb + rpb);
    const float* modp = WSP(float, WS_MOD);
    const int c0 = 4 * cx.lane;
    for (int r2 = rb + cx.wave; r2 < re; r2 += 16) {
        f32x4 x[2][4]; bool ok[2];
#pragma unroll
        for (int u = 0; u < 2; ++u) { const int row = r2 + 8 * u; ok[u] = row < re; const float* src = WSP(float, WS_XMID) + (size_t)(ok[u] ? row : r2) * 1024;
#pragma unroll
            for (int i = 0; i < 4; ++i) x[u][i] = *(const f32x4*)(src + c0 + 256 * i); }
#pragma unroll
        for (int u = 0; u < 2; ++u) {
            const int row = r2 + 8 * u;
            float ss = 0.f;
#pragma unroll
            for (int i = 0; i < 4; ++i) ss += (x[u][i][0] * x[u][i][0] + x[u][i][1] * x[u][i][1]) + (x[u][i][2] * x[u][i][2] + x[u][i][3] * x[u][i][3]);
            ss = wave_sum(ss, 0);
            const float rstd = rsqrtf(ss * (1.0f / 1024.0f) + EPS);
            if (!ok[u]) continue;
            const float* md = modp + ((size_t)l * 9 + mod_row(row)) * 6144;
            bf16_t* hp = WSP(bf16_t, WS_H) + (size_t)row * 1024; bf16_t* hl = WSP(bf16_t, WS_HLO) + (size_t)row * 1024; unsigned char* h8 = WSP(unsigned char, WS_H8) + (size_t)row * 1024;
#pragma unroll
            for (int i = 0; i < 4; ++i) { const int c = c0 + 256 * i;
                const f32x4 nw = *(const f32x4*)(P.in[I_N2W] + l * 1024 + c), sc = *(const f32x4*)(md + 4096 + c), sh = *(const f32x4*)(md + 3072 + c);
                const f32x4 h = x[u][i] * rstd * nw * (sc + 1.0f) + sh;
                const int p8 = (int)pk4_fp8(h[0], h[1], h[2], h[3]);
                const float q0 = __builtin_amdgcn_cvt_f32_fp8(p8, 0), q1 = __builtin_amdgcn_cvt_f32_fp8(p8, 1), q2 = __builtin_amdgcn_cvt_f32_fp8(p8, 2), q3 = __builtin_amdgcn_cvt_f32_fp8(p8, 3);
                *(int*)(h8 + c) = p8;
                u32x2 wh; wh.x = pk_bf16(q0, q1); wh.y = pk_bf16(q2, q3); *(u32x2*)(hp + c) = wh;
                u32x2 wl; wl.x = pk_bf16(h[0] - q0, h[1] - q1); wl.y = pk_bf16(h[2] - q2, h[3] - q3); *(u32x2*)(hl + c) = wl; }
        }
    }
    block_rows_visible();
    const int nrow = re - rb, ntile = (nrow + 15) / 16;
    for (int it = cx.wave; it < ntile * 8; it += 8) {
        const int t = it >> 3, nt = (it >> 2) & 1, kq = it & 3, fr = cx.lane & 15, fq = cx.lane >> 4; const int row = min(rb + t * 16 + fr, re - 1);
        const bf16_t* hp = WSP(bf16_t, WS_H) + (size_t)row * 1024 + kq * 256 + fq * 8; const bf16_t* hl = WSP(bf16_t, WS_HLO) + (size_t)row * 1024 + kq * 256 + fq * 8;
        const bf16_t* wh = WSP(bf16_t, WS_RWH) + ((size_t)l * 32 + nt * 16 + fr) * 1024 + kq * 256 + fq * 8; const bf16_t* wl = WSP(bf16_t, WS_RWL) + ((size_t)l * 32 + nt * 16 + fr) * 1024 + kq * 256 + fq * 8;
        f32x4 acc = (f32x4){0.f, 0.f, 0.f, 0.f}, acc2 = (f32x4){0.f, 0.f, 0.f, 0.f};
#pragma unroll
        for (int k0 = 0; k0 < 256; k0 += 32) { const bf16x8 ah = ldg8(hp + k0), al = ldg8(hl + k0), bh = ldg8(wh + k0), bl = ldg8(wl + k0);
            acc = __builtin_amdgcn_mfma_f32_16x16x32_bf16(bh, ah, acc, 0, 0, 0);
            acc2 = __builtin_amdgcn_mfma_f32_16x16x32_bf16(bl, ah, acc2, 0, 0, 0);
            acc2 = __builtin_amdgcn_mfma_f32_16x16x32_bf16(bh, al, acc2, 0, 0, 0); }
        const int rl = t * 16 + fr;
#pragma unroll
        for (int j = 0; j < 4; ++j) lgs[(kq * 128 + rl) * 33 + nt * 16 + 4 * fq + j] = acc[j] + acc2[j];
    }
    __syncthreads();
    if (cx.tid < nrow) {
        float lg[32];
#pragma unroll
        for (int e = 0; e < 32; ++e) lg[e] = (lgs[(0 * 128 + cx.tid) * 33 + e] + lgs[(1 * 128 + cx.tid) * 33 + e]) + (lgs[(2 * 128 + cx.tid) * 33 + e] + lgs[(3 * 128 + cx.tid) * 33 + e]) + P.in[I_RB][l * 32 + e];
        float tv[4]; int tix[4]; unsigned taken = 0u;
#pragma unroll
        for (int k = 0; k < 4; ++k) { float bv = -3.0e38f; int bi = 0;
#pragma unroll
            for (int e = 0; e < 32; ++e) { const bool better = (lg[e] > bv) && !((taken >> e) & 1u); bv = better ? lg[e] : bv; bi = better ? e : bi; }
            tv[k] = bv; tix[k] = bi; taken |= 1u << bi; }
        const float e1 = __expf(tv[1] - tv[0]), e2 = __expf(tv[2] - tv[0]), e3 = __expf(tv[3] - tv[0]);
        const float inv = 1.0f / (1.0f + e1 + e2 + e3);
        const float gk[4] = {inv, e1 * inv, e2 * inv, e3 * inv};
#pragma unroll
        for (int k = 0; k < 4; ++k) {
            const int ls = __hip_atomic_fetch_add((LAS int*)(hist + tix[k]), 1, __ATOMIC_RELAXED, __HIP_MEMORY_SCOPE_WORKGROUP);
            pend[(cx.tid * 4 + k) * 2 + 0] = (tix[k] << 20) | ls;
            pend[(cx.tid * 4 + k) * 2 + 1] = __float_as_int(gk[k]); }
    }
    __syncthreads();
    if (cx.tid < 32) { unsigned* cnt = (unsigned*)(cx.ws + WS_CTL) + CW_CNT + l * 32;
        hist[32 + cx.tid] = hist[cx.tid] > 0 ? (int)__hip_atomic_fetch_add(cnt + cx.tid, (unsigned)hist[cx.tid], __ATOMIC_RELAXED, __HIP_MEMORY_SCOPE_AGENT) : 0; }
    __syncthreads();
    for (int i = cx.tid; i < nrow * 4; i += NTHR) {
        const int t = pend[i * 2], e = t >> 20, slot = hist[32 + e] + (t & 0xFFFFF), row = rb + (i >> 2);
        WSP(int, WS_ELIST)[(size_t)e * TT + slot] = row;
        WSP(float, WS_GLIST)[(size_t)e * TT + slot] = __int_as_float(pend[i * 2 + 1]);
        WSP(int, WS_TINFO)[(size_t)row * 4 + (i & 3)] = (e << 20) | slot;
    }
}

DEVI int xcd_contig(int bid, int G) { return (G % 8 == 0) ? (bid % 8) * (G / 8) + bid / 8 : bid; }

struct DenseSched {
    const char* A; const char* B; int nM, nN, pm0, G, bid;
    DEVI bool get(int i, g1::Unit& u) const {
        int pm, pn;
        if (G % 8 == 0) { const int x = bid & 7, r = bid >> 3, nx = G >> 3, lo = (nM * x) >> 3, hi = (nM * (x + 1)) >> 3, nr = hi - lo;
            const int q = i * nx + r; if (nr <= 0 || q >= nr * nN) return false; pm = lo + q % nr; pn = q / nr; }
        else { const int L = i * G + bid; if (L >= nM * nN) return false; pm = L / nN; pn = L % nN; }
        u.A = A + (size_t)(pm0 + pm) * 256 * 2048; u.list = nullptr; u.nvalid = 256; u.B = B + (size_t)pn * 256 * 2048; u.pm = pm0 + pm; u.pn = pn; u.e = 0;
        return true;
    }
};
struct MoeSched {
    const char* A; const char* B; const int* elist; const LAS int* info; int NPN, gather, G, bid; size_t bstride; int kb;
    DEVI int rd(int i) const { return __builtin_amdgcn_readfirstlane(info[i]); }
    DEVI bool get(int i, g1::Unit& u) const {
        const int NTt = rd(32); int T, pn;
        if (G % 8 == 0 && (G >> 3) % NPN == 0) { const int x = bid & 7, r = bid >> 3, nx = G >> 3, RT = nx / NPN, lo = (NTt * x) >> 3, hi = (NTt * (x + 1)) >> 3;
            T = lo + i * RT + r % RT; pn = r / RT; if (T >= hi) return false; }
        else { const int L = i * G + bid; if (L >= NTt * NPN) return false; T = L / NPN; pn = L % NPN; }
        const int e = rd(112 + T), j = T - rd(e);
        u.pm = T; u.pn = pn; u.e = e;
        u.B = B + (size_t)e * bstride + (size_t)pn * 256 * kb;
        if (gather) { u.A = A; u.list = elist + (size_t)e * TT + j * 256; u.nvalid = rd(40 + e) - j * 256; }
        else { u.A = A + (size_t)T * 256 * kb; u.list = nullptr; u.nvalid = 256; }
        return true;
    }
};

struct EpiIn {
    static constexpr bool PERM = true;
    bf16_t* Pout; const float* bias;
    DEVI void operator()(const f32x4 (&acc)[2][2][4][2], const g1::Unit& u, int wr, int wc, int fr, int fq) const {
        const int row0 = u.pm * 256 + wr * 64 + fr;
#pragma unroll
        for (int bj = 0; bj < 2; ++bj) {
            const int col0 = u.pn * 256 + bj * 128 + wc * 32 + 8 * fq;
            const int seg = u.pn * 2 + bj; const bool gl = (seg >= 15 && seg < 18);
            const f32x4 b0 = *(const f32x4*)(bias + col0), b1 = *(const f32x4*)(bias + col0 + 4);
#pragma unroll
            for (int ai = 0; ai < 2; ++ai)
#pragma unroll
                for (int m = 0; m < 4; ++m) {
                    f32x4 v0 = acc[ai][bj][m][0] + b0, v1 = acc[ai][bj][m][1] + b1;
                    if (gl) {
#pragma unroll
                        for (int j = 0; j < 4; ++j) { v0[j] = gelu_tanh(v0[j]); v1[j] = gelu_tanh(v1[j]); } }
                    u32x4 w; w.x = pk_bf16(v0[0], v0[1]); w.y = pk_bf16(v0[2], v0[3]); w.z = pk_bf16(v1[0], v1[1]); w.w = pk_bf16(v1[2], v1[3]);
                    *(u32x4*)(Pout + (size_t)(row0 + ai * 128 + m * 16) * NP + col0) = w;
                }
        }
    }
};
struct EpiOut {
    static constexpr bool PERM = false;
    const float* xs; float* xmid; const float* mod;
    DEVI void operator()(const f32x4 (&acc)[2][2][4][2], const g1::Unit& u, int wr, int wc, int fr, int fq) const {
        const int row0 = u.pm * 256 + wr * 64 + fr;
        const float* g1p = mod + (size_t)mod_row(u.pm * 256) * 6144 + 2048;
#pragma unroll
        for (int bj = 0; bj < 2; ++bj)
#pragma unroll
            for (int n = 0; n < 2; ++n) {
                const int col = u.pn * 256 + bj * 128 + wc * 32 + 16 * n + 4 * fq;
                const f32x4 gv = *(const f32x4*)(g1p + col);
#pragma unroll
                for (int ai = 0; ai < 2; ++ai)
#pragma unroll
                    for (int m = 0; m < 4; ++m) {
                        const size_t off = (size_t)(row0 + ai * 128 + m * 16) * 1024 + col;
                        const f32x4 xv = *(const f32x4*)(xs + off);
                        *(f32x4*)(xmid + off) = xv + gv * acc[ai][bj][m][n];
                    }
            }
    }
};
struct EpiGU {
    static constexpr bool PERM = true;
    unsigned char* act; const float* bgu;
    DEVI void operator()(const f32x4 (&acc)[2][2][4][2], const g1::Unit& u, int wr, int wc, int fr, int fq) const {
        const int row0 = u.pm * 256 + wr * 64 + fr, colh = u.pn * 128 + wc * 32 + 8 * fq;
        const float* bg = bgu + (size_t)u.e * 2048 + colh; const float* bu = bg + 1024;
        const f32x4 bg0 = *(const f32x4*)bg, bg1 = *(const f32x4*)(bg + 4), bu0 = *(const f32x4*)bu, bu1 = *(const f32x4*)(bu + 4);
#pragma unroll
        for (int ai = 0; ai < 2; ++ai)
#pragma unroll
            for (int m = 0; m < 4; ++m) {
                float o[8];
#pragma unroll
                for (int n = 0; n < 2; ++n)
#pragma unroll
                    for (int j = 0; j < 4; ++j) {
                        const float g = fminf(acc[ai][0][m][n][j] * W8_INV + (n ? bg1[j] : bg0[j]), 7.0f);
                        const float up = fminf(fmaxf(acc[ai][1][m][n][j] * W8_INV + (n ? bu1[j] : bu0[j]), -7.0f), 7.0f);
                        o[n * 4 + j] = (up + 1.0f) * g * frcp(1.0f + __expf(-1.702f * g));
                    }
                u32x2 w; w.x = pk4_fp8(o[0], o[1], o[2], o[3]); w.y = pk4_fp8(o[4], o[5], o[6], o[7]);
                *(u32x2*)(act + (size_t)(row0 + ai * 128 + m * 16) * 1024 + colh) = w;
            }
    }
};
struct EpiDown {
    static constexpr bool PERM = true;
    bf16_t* ypad; const float* bd; const float* glist; const LAS int* info;
    DEVI void operator()(const f32x4 (&acc)[2][2][4][2], const g1::Unit& u, int wr, int wc, int fr, int fq) const {
        const int j256 = (u.pm - __builtin_amdgcn_readfirstlane(info[u.e])) * 256, cnt = __builtin_amdgcn_readfirstlane(info[40 + u.e]);
        const int rl0 = wr * 64 + fr;
#pragma unroll
        for (int ai = 0; ai < 2; ++ai)
#pragma unroll
            for (int m = 0; m < 4; ++m) {
                const int rl = rl0 + ai * 128 + m * 16, slot = j256 + rl;
                const float gt = slot < cnt ? glist[(size_t)u.e * TT + slot] : 0.f;
#pragma unroll
                for (int bj = 0; bj < 2; ++bj) {
                    const int col0 = u.pn * 256 + bj * 128 + wc * 32 + 8 * fq;
                    const f32x4 b0 = *(const f32x4*)(bd + (size_t)u.e * 1024 + col0), b1 = *(const f32x4*)(bd + (size_t)u.e * 1024 + col0 + 4);
                    const f32x4 v0 = (acc[ai][bj][m][0] * W8_INV + b0) * gt, v1 = (acc[ai][bj][m][1] * W8_INV + b1) * gt;
                    u32x4 w; w.x = pk_bf16(v0[0], v0[1]); w.y = pk_bf16(v0[2], v0[3]); w.z = pk_bf16(v1[0], v1[1]); w.w = pk_bf16(v1[2], v1[3]);
                    *(u32x4*)(ypad + (size_t)(u.pm * 256 + rl) * 1024 + col0) = w;
                }
            }
    }
};

DEVI void ph_inproj(const Ctx& cx, int l) {
    DenseSched S{(const char*)WSP(bf16_t, WS_H), (const char*)(WSP(bf16_t, WS_WIN) + (size_t)l * NP * 1024), TT / 256, NP / 256, 0, cx.G, cx.bid};
    EpiIn E{WSP(bf16_t, WS_P), WSP(float, WS_BIN2) + (size_t)l * NP};
    g1::gemm_phase<DenseSched, EpiIn, false>(cx.lds, cx.tid, S, E);
}
DEVI void ph_outproj(const Ctx& cx, int l) {
    const int pm0 = (l == DEPTH - 1) ? TCTX / 256 : 0;
    DenseSched S{(const char*)WSP(bf16_t, WS_MRG), (const char*)(WSP(bf16_t, WS_WOUT) + (size_t)l * 1024 * 1024), TT / 256 - pm0, 4, pm0, cx.G, cx.bid};
    EpiOut E{WSP(float, WS_XS), WSP(float, WS_XMID), WSP(float, WS_MOD) + (size_t)l * 9 * 6144};
    g1::gemm_phase<DenseSched, EpiOut, false>(cx.lds, cx.tid, S, E);
}
DEVI void ph_moe_gu(const Ctx& cx, int l) {
    LAS int* info = (LAS int*)(cx.lds + g1::STAGE_BYTES);
    moe_info(cx, l, info);
    MoeSched S{(const char*)WSP(unsigned char, WS_H8), (const char*)(WSP(unsigned char, WS_WGU) + (size_t)l * NE * 2048 * 1024), WSP(int, WS_ELIST), info, 8, 1, cx.G, cx.bid, (size_t)2048 * 1024, 1024};
    EpiGU E{WSP(unsigned char, WS_ACT), cx.p->in[I_BGU] + (size_t)l * NE * 2048};
    g1::gemm_phase<MoeSched, EpiGU, true, true>(cx.lds, cx.tid, S, E);
}
DEVI void ph_moe_dn(const Ctx& cx, int l) {
    LAS int* info = (LAS int*)(cx.lds + g1::STAGE_BYTES);
    moe_info(cx, l, info);
    MoeSched S{(const char*)WSP(unsigned char, WS_ACT), (const char*)(WSP(unsigned char, WS_WD) + (size_t)l * NE * 1024 * 1024), nullptr, info, 4, 0, cx.G, cx.bid, (size_t)1024 * 1024, 1024};
    EpiDown E{WSP(bf16_t, WS_YPAD), cx.p->in[I_BD] + (size_t)l * NE * 1024, WSP(float, WS_GLIST), info};
    g1::gemm_phase<MoeSched, EpiDown, false, true>(cx.lds, cx.tid, S, E);
}

DEVI int ml_row0(int b, int c) { return c < 2 ? b * CTXL + c * 128 : TCTX + b * SEQ + (c - 2) * 128; }
DEVI unsigned short lds_u16(const LAS bf16_t* p) { return *p; }

DEVI void ml_local_unit(const Ctx& cx, int l, int b, int h, int c) {
    LAS float* sg = (LAS float*)cx.lds;
    LAS float* se = sg + 256;
    LAS float* red = se + 256;
    LAS bf16_t* Ks = (LAS bf16_t*)(cx.lds + 4352);
    LAS bf16_t* Ve = Ks + 128 * 104;
    const int row0 = ml_row0(b, c), tid = cx.tid;
    const int dir = (tid >> 7) & 1, i = tid & 127, p = dir ? 127 - i : i;
    const bool act = tid < 256;
    float gi = 0.f, bval = 0.f, u = 0.f;
    if (act) { const float* gt = WSP(float, WS_GT) + (size_t)(row0 + i) * 16; gi = gt[dir * 4 + h]; const float gf = gt[8 + dir * 4 + h];
        sg[dir * 128 + p] = fminf(gf, 0.f) - log1p_(__expf(-fabsf(gf))); }
    LDS_SYNC();
#pragma unroll 1
    for (int off = 1; off < 128; off <<= 1) { float v = 0.f; if (act) { v = sg[dir * 128 + p]; if (p >= off) v += sg[dir * 128 + p - off]; } LDS_SYNC(); if (act) sg[dir * 128 + p] = v; LDS_SYNC(); }
    if (act) { bval = sg[dir * 128 + p]; u = gi - bval; if (p == 127) red[dir] = bval; }
    LDS_SYNC();
    if (act) sg[dir * 128 + p] = u;
    LDS_SYNC();
#pragma unroll 1
    for (int off = 1; off < 128; off <<= 1) { float v = 0.f; if (act) { v = sg[dir * 128 + p]; if (p >= off) v = fmaxf(v, sg[dir * 128 + p - off]); } LDS_SYNC(); if (act) sg[dir * 128 + p] = v; LDS_SYNC(); }
    if (act) { const float cm = sg[dir * 128 + p]; if (p == 127) red[2 + dir] = cm;
        const size_t gix = (size_t)(row0 + i) * 8 + dir * 4 + h;
        WSP(float, WS_GB)[gix] = bval; WSP(float, WS_GU)[gix] = u; WSP(float, WS_GCM)[gix] = cm; }
    LDS_SYNC();
    if (act) se[dir * 128 + i] = expf(u - red[2 + dir]);
    if (tid < 2) { float* msc = WSP(float, WS_MSC) + ((size_t)((b * 4 + h) * MLC + c) * 2 + tid) * 2; msc[0] = red[tid]; msc[1] = red[tid] + red[2 + tid]; }
    LDS_SYNC();
    const bf16_t* Pp = WSP(bf16_t, WS_P);
#pragma unroll
    for (int it = 0; it < 3; ++it) { const int idx = tid + NTHR * it, r = idx / 12, ch = idx % 12;
        const u32x4 kv = *(const u32x4*)(Pp + (size_t)(row0 + r) * NP + PC_K + h * 96 + ch * 8);
        *(LAS u32x4*)(Ks + r * 104 + ch * 8) = kv;
        const u32x4 vv = *(const u32x4*)(Pp + (size_t)(row0 + r) * NP + PC_V + h * 96 + ch * 8);
        const float e0 = se[r], e1 = se[128 + r];
        u32x4 o0, o1;
#pragma unroll
        for (int q = 0; q < 4; ++q) { const float lo = __uint_as_float(vv[q] << 16), hi = __uint_as_float(vv[q] & 0xFFFF0000u);
            o0[q] = pk_bf16(lo * e0, hi * e0); o1[q] = pk_bf16(lo * e1, hi * e1); }
        *(LAS u32x4*)(Ve + r * 104 + ch * 8) = o0; *(LAS u32x4*)(Ve + (128 + r) * 104 + ch * 8) = o1; }
    LDS_SYNC();
    {
        const int wd = cx.wave >> 2, q9 = (cx.wave & 3) * 9, fr = cx.lane & 15, fq = cx.lane >> 4;
        float* cl = WSP(float, WS_CLOC) + ((size_t)((b * 4 + h) * MLC + c) * 2 + wd) * 9216;
        const LAS bf16_t* V = Ve + wd * 128 * 104;
#pragma unroll 1
        for (int pi = q9; pi < q9 + 9; ++pi) { const int dt = pi / 6, et = pi % 6;
            f32x4 acc = (f32x4){0.f, 0.f, 0.f, 0.f};
#pragma unroll
            for (int kk = 0; kk < 4; ++kk) { bf16x8 a, bb;
#pragma unroll
                for (int j = 0; j < 8; ++j) { const int s = kk * 32 + fq * 8 + j; a[j] = (short)lds_u16(V + s * 104 + dt * 16 + fr); bb[j] = (short)lds_u16(Ks + s * 104 + et * 16 + fr); }
                acc = __builtin_amdgcn_mfma_f32_16x16x32_bf16(a, bb, acc, 0, 0, 0); }
#pragma unroll
            for (int r = 0; r < 4; ++r) cl[(dt * 16 + fq * 4 + r) * 96 + et * 16 + fr] = acc[r]; }
    }
    if (tid < 192) { const int d2 = tid / 96, e = tid % 96; float s = 0.f;
        for (int t = 0; t < 128; ++t) s += se[d2 * 128 + t] * bf2f(Ks[t * 104 + e]);
        WSP(float, WS_NLOC)[((size_t)((b * 4 + h) * MLC + c) * 2 + d2) * 96 + e] = s; }
    LDS_SYNC();
}

DEVI void ml_carry(const Ctx& cx) {
    for (int idx = cx.bid * NTHR + cx.tid; idx < 64 * 9312; idx += cx.G * NTHR) {
        const int combo = idx / 9312, el = idx % 9312, dir = combo & 1, bh = combo >> 1;
        float loc[MLC], bl[MLC], ml[MLC];
#pragma unroll
        for (int s = 0; s < MLC; ++s) {
            const int c = dir == 0 ? s : (s < 2 ? 1 - s : 19 - s);
            const size_t cb = (size_t)(bh * MLC + c) * 2 + dir;
            bl[s] = WSP(float, WS_MSC)[cb * 2]; ml[s] = WSP(float, WS_MSC)[cb * 2 + 1];
            loc[s] = el < 9216 ? WSP(float, WS_CLOC)[cb * 9216 + el] : WSP(float, WS_NLOC)[cb * 96 + el - 9216];
        }
        float Cv = 0.f, m = -1e30f;
#pragma unroll
        for (int s = 0; s < MLC; ++s) {
            const int c = dir == 0 ? s : (s < 2 ? 1 - s : 19 - s);
            const size_t cb = (size_t)(bh * MLC + c) * 2 + dir;
            if (el < 9216) WSP(bf16_t, WS_C0)[cb * 9216 + el] = f2bf(Cv); else WSP(float, WS_N0)[cb * 96 + el - 9216] = Cv;
            if (el == 0) WSP(float, WS_M0)[cb] = m;
            const float mn = fmaxf(bl[s] + m, ml[s]), a = __expf(bl[s] + m - mn), sc = __expf(ml[s] - mn);
            Cv = a * Cv + sc * loc[s]; m = mn;
        }
    }
}

DEVI void ml_out_unit(const Ctx& cx, int l, int b, int h, int c) {
    LAS bf16_t* Qs = (LAS bf16_t*)cx.lds;
    LAS bf16_t* Ks = Qs + 128 * 104;
    LAS bf16_t* Vs = Ks + 128 * 104;
    LAS bf16_t* C0s = Vs + 128 * 104;
    LAS float* gb = (LAS float*)(cx.lds + 119808);
    LAS float* gu = gb + 256;
    LAS float* gM = gu + 256;
    LAS float* n0s = gM + 256;
    LAS float* m0s = n0s + 192;
    const int row0 = ml_row0(b, c), tid = cx.tid;
    const bf16_t* Pp = WSP(bf16_t, WS_P);
    const size_t cb0 = (size_t)((b * 4 + h) * MLC + c) * 2;
#pragma unroll
    for (int it = 0; it < 3; ++it) { const int idx = tid + NTHR * it, r = idx / 12, ch = idx % 12;
        const bf16_t* rp = Pp + (size_t)(row0 + r) * NP + h * 96 + ch * 8;
        *(LAS u32x4*)(Qs + r * 104 + ch * 8) = *(const u32x4*)(rp + PC_Q);
        *(LAS u32x4*)(Ks + r * 104 + ch * 8) = *(const u32x4*)(rp + PC_K);
        *(LAS u32x4*)(Vs + r * 104 + ch * 8) = *(const u32x4*)(rp + PC_V); }
    for (int idx = tid; idx < 2 * 96 * 12; idx += NTHR) { const int d2 = idx / 1152, r = (idx % 1152) / 12, ch = idx % 12;
        *(LAS u32x4*)(C0s + (d2 * 96 + r) * 104 + ch * 8) = *(const u32x4*)(WSP(bf16_t, WS_C0) + (cb0 + d2) * 9216 + r * 96 + ch * 8); }
    if (tid < 256) { const int d2 = tid >> 7, i = tid & 127; const size_t gix = (size_t)(row0 + i) * 8 + d2 * 4 + h;
        gb[tid] = WSP(float, WS_GB)[gix]; gu[tid] = WSP(float, WS_GU)[gix];
        gM[tid] = fmaxf(WSP(float, WS_M0)[cb0 + d2], WSP(float, WS_GCM)[gix]); }
    if (tid >= 256 && tid < 448) { const int k = tid - 256; n0s[k] = WSP(float, WS_N0)[(cb0 + k / 96) * 96 + k % 96]; }
    if (tid >= 448 && tid < 450) m0s[tid - 448] = WSP(float, WS_M0)[cb0 + tid - 448];
    LDS_SYNC();
    const int w = cx.wave, fr = cx.lane & 15, fq = cx.lane >> 4, t = 16 * w + fr;
    bf16x8 qf[3];
#pragma unroll
    for (int kk = 0; kk < 3; ++kk) qf[kk] = *(const LAS bf16x8*)(Qs + t * 104 + kk * 32 + fq * 8);
    f32x4 hs[6];
#pragma unroll
    for (int n = 0; n < 6; ++n) hs[n] = (f32x4){0.f, 0.f, 0.f, 0.f};
#pragma unroll
    for (int dir = 0; dir < 2; ++dir) {
        const float Mt = gM[dir * 128 + t], bt = gb[dir * 128 + t], inter = __expf(m0s[dir] - Mt);
        f32x4 an[6];
#pragma unroll
        for (int n = 0; n < 6; ++n) an[n] = (f32x4){0.f, 0.f, 0.f, 0.f};
        float den = 0.f;
        const int Jlo = dir == 0 ? 0 : (w >> 1), Jhi = dir == 0 ? (w >> 1) : 3;
#pragma unroll 1
        for (int J = Jlo; J <= Jhi; ++J) {
            bf16x8 pf;
#pragma unroll
            for (int half = 0; half < 2; ++half) {
                const int j = 2 * J + half;
                f32x4 D = (f32x4){0.f, 0.f, 0.f, 0.f};
                const bool need = dir == 0 ? (j <= w) : (j >= w);
                if (need) {
#pragma unroll
                    for (int kk = 0; kk < 3; ++kk) { const bf16x8 kf = *(const LAS bf16x8*)(Ks + (16 * j + fr) * 104 + kk * 32 + fq * 8);
                        D = __builtin_amdgcn_mfma_f32_16x16x32_bf16(kf, qf[kk], D, 0, 0, 0); }
                }
                const f32x4 us = *(const LAS f32x4*)(gu + dir * 128 + 16 * j + 4 * fq);
                float pv[4];
#pragma unroll
                for (int r = 0; r < 4; ++r) { const int s = 16 * j + 4 * fq + r; const bool valid = need && (dir == 0 ? (s <= t) : (s >= t));
                    pv[r] = valid ? D[r] * __expf(us[r] - Mt) : 0.f; den += pv[r]; }
                pf[half * 4 + 0] = (short)f2bf(pv[0]); pf[half * 4 + 1] = (short)f2bf(pv[1]); pf[half * 4 + 2] = (short)f2bf(pv[2]); pf[half * 4 + 3] = (short)f2bf(pv[3]);
            }
#pragma unroll
            for (int n = 0; n < 6; ++n) { bf16x8 vf;
#pragma unroll
                for (int jj = 0; jj < 8; ++jj) { const int s = 32 * J + (jj < 4 ? 4 * fq + jj : 16 + 4 * fq + (jj - 4)); vf[jj] = (short)lds_u16(Vs + s * 104 + 16 * n + fr); }
                an[n] = __builtin_amdgcn_mfma_f32_16x16x32_bf16(vf, pf, an[n], 0, 0, 0); }
        }
        float nq = 0.f;
#pragma unroll
        for (int kk = 0; kk < 3; ++kk)
#pragma unroll
            for (int j = 0; j < 8; ++j) nq += n0s[dir * 96 + kk * 32 + fq * 8 + j] * bf2f((bf16_t)qf[kk][j]);
        nq += shx<16>(nq, cx.lane); nq += shx<32>(nq, cx.lane);
        den += shx<16>(den, cx.lane); den += shx<32>(den, cx.lane);
        const float dtot = den + inter * nq;
        const float inv = frcp(fmaxf(fabsf(dtot), __expf(-(Mt + bt))));
#pragma unroll
        for (int n = 0; n < 6; ++n) { f32x4 ac = (f32x4){0.f, 0.f, 0.f, 0.f};
#pragma unroll
            for (int kk = 0; kk < 3; ++kk) { const bf16x8 cf = *(const LAS bf16x8*)(C0s + (dir * 96 + 16 * n + fr) * 104 + kk * 32 + fq * 8);
                ac = __builtin_amdgcn_mfma_f32_16x16x32_bf16(cf, qf[kk], ac, 0, 0, 0); }
            hs[n] += (an[n] + ac * inter) * inv; }
    }
    float ss = 0.f;
#pragma unroll
    for (int n = 0; n < 6; ++n) ss += hs[n][0] * hs[n][0] + hs[n][1] * hs[n][1] + hs[n][2] * hs[n][2] + hs[n][3] * hs[n][3];
    ss += shx<16>(ss, cx.lane); ss += shx<32>(ss, cx.lane);
    const float rstd = rsqrtf(ss * (1.0f / 96.0f) + EPS);
    const size_t prow = (size_t)(row0 + t);
#pragma unroll
    for (int n = 0; n < 6; ++n) { const int d = 16 * n + 4 * fq;
        const u32x2 ov = *(const u32x2*)(Pp + prow * NP + PC_O + h * 96 + d);
        const f32x4 mw = *(const f32x4*)(cx.p->in[I_MIXW] + l * 1024 + h * 96 + d);
        const float o0 = __uint_as_float(ov.x << 16), o1 = __uint_as_float(ov.x & 0xFFFF0000u), o2 = __uint_as_float(ov.y << 16), o3 = __uint_as_float(ov.y & 0xFFFF0000u);
        u32x2 wv; wv.x = pk_bf16(sigmoidf_(o0) * hs[n][0] * rstd * mw[0], sigmoidf_(o1) * hs[n][1] * rstd * mw[1]);
        wv.y = pk_bf16(sigmoidf_(o2) * hs[n][2] * rstd * mw[2], sigmoidf_(o3) * hs[n][3] * rstd * mw[3]);
        *(u32x2*)(WSP(bf16_t, WS_MRG) + prow * 1024 + h * 96 + d) = wv; }
    LDS_SYNC();
}

DEVI void rg_unit(const Ctx& cx, int l, int b, int ck, int g, int mode) {
    const Params& P = *cx.p;
    LAS float* xraw = (LAS float*)cx.lds;
    LAS float* xc = (LAS float*)(cx.lds + 17408);
    LAS bf16_t* xcb = (LAS bf16_t*)(cx.lds + 33792);
    LAS float* ab = (LAS float*)(cx.lds + 43008);
    LAS float* hbuf = (LAS float*)(cx.lds + 43008 + 65536);
    const int tid = cx.tid;
    const int t0 = ck < 4 ? ck * 64 : (ck - 4) * 64, seglen = ck < 4 ? CTXL : SEQ, rowbase = ck < 4 ? b * CTXL : TCTX + b * SEQ;
    const bf16_t* Pp = WSP(bf16_t, WS_P);
    for (int idx = tid; idx < 67 * 8; idx += NTHR) { const int r = idx >> 3, c8 = idx & 7, tt = t0 - 2 + r;
        u32x4 v = (u32x4){0u, 0u, 0u, 0u};
        if (tt >= 0 && tt < seglen) v = *(const u32x4*)(Pp + (size_t)(rowbase + tt) * NP + PC_RX + g * 64 + c8 * 8);
#pragma unroll
        for (int q = 0; q < 4; ++q) { xraw[r * 64 + c8 * 8 + 2 * q] = __uint_as_float(v[q] << 16); xraw[r * 64 + c8 * 8 + 2 * q + 1] = __uint_as_float(v[q] & 0xFFFF0000u); } }
    LDS_SYNC();
#pragma unroll
    for (int it = 0; it < 8; ++it) { const int idx = tid + NTHR * it, t = idx >> 6, ch = idx & 63, cg = g * 64 + ch;
        float v = P.in[I_RGCB][l * 384 + cg];
#pragma unroll
        for (int j = 0; j < 4; ++j) v += P.in[I_RGCW][(l * 4 + j) * 384 + cg] * xraw[(t + j) * 64 + ch];
        xc[t * 64 + ch] = v; xcb[t * 72 + ch] = f2bf(v); }
    LDS_SYNC();
    {
        const int dir = cx.wave >> 2, cg4 = cx.wave & 3, fr = cx.lane & 15, fq = cx.lane >> 4;
        const bf16_t* wrg = WSP(bf16_t, WS_WRG) + (size_t)(l * 6 + g) * 256 * 64;
        f32x4 ar[4], ai[4];
#pragma unroll
        for (int m = 0; m < 4; ++m) { ar[m] = (f32x4){0.f, 0.f, 0.f, 0.f}; ai[m] = (f32x4){0.f, 0.f, 0.f, 0.f}; }
#pragma unroll
        for (int kk = 0; kk < 2; ++kk) {
            const bf16x8 br = ldg8(wrg + (size_t)((dir * 2 + 0) * 64 + cg4 * 16 + fr) * 64 + kk * 32 + fq * 8);
            const bf16x8 bi = ldg8(wrg + (size_t)((dir * 2 + 1) * 64 + cg4 * 16 + fr) * 64 + kk * 32 + fq * 8);
#pragma unroll
            for (int m = 0; m < 4; ++m) { const bf16x8 a = *(const LAS bf16x8*)(xcb + (m * 16 + fr) * 72 + kk * 32 + fq * 8);
                ar[m] = __builtin_amdgcn_mfma_f32_16x16x32_bf16(br, a, ar[m], 0, 0, 0); ai[m] = __builtin_amdgcn_mfma_f32_16x16x32_bf16(bi, a, ai[m], 0, 0, 0); }
        }
        const int ch0 = cg4 * 16 + 4 * fq, cgl = g * 64 + ch0;
        const f32x4 ba = *(const f32x4*)(P.in[I_RGBA] + (l * 2 + dir) * 384 + cgl), bx = *(const f32x4*)(P.in[I_RGBX] + (l * 2 + dir) * 384 + cgl);
        const f32x4 lam = *(const f32x4*)(P.in[I_RGLAM] + (l * 2 + dir) * 384 + cgl);
        float sp[4];
#pragma unroll
        for (int j = 0; j < 4; ++j) sp[j] = lam[j] > 0.f ? log1p_(__expf(-lam[j])) : -lam[j] + log1p_(__expf(lam[j]));
#pragma unroll
        for (int m = 0; m < 4; ++m) { const int t = m * 16 + fr; const f32x4 xv = *(const LAS f32x4*)(xc + t * 64 + ch0);
            f32x4 av, bv;
#pragma unroll
            for (int j = 0; j < 4; ++j) { const float r = frcp(1.0f + __expf(-(ar[m][j] + ba[j]))), ii = frcp(1.0f + __expf(-(ai[m][j] + bx[j])));
                const float la = -8.0f * r * sp[j], y = 2.0f * la; av[j] = __expf(la);
                const float nem1 = y > -0.02f ? -y * (1.0f + y * (0.5f + y * 0.16666667f)) : 1.0f - av[j] * av[j];
                bv[j] = sqrtf(nem1) * (ii * xv[j]); }
            *(LAS f32x4*)(ab + ((dir * 2 + 0) * 64 + t) * 64 + ch0) = av; *(LAS f32x4*)(ab + ((dir * 2 + 1) * 64 + t) * 64 + ch0) = bv; }
    }
    LDS_SYNC();
    if (tid < 128) { const int dir = tid >> 6, ch = tid & 63; const size_t ix = ((size_t)(b * RGC + ck) * 2 + dir) * 384 + g * 64 + ch;
        float hc = mode ? WSP(float, WS_RGC)[ix] : 0.f, ap = 1.0f;
        const LAS float* __restrict__ A = ab + (dir * 2 + 0) * 4096 + ch; const LAS float* __restrict__ B = ab + (dir * 2 + 1) * 4096 + ch; LAS float* __restrict__ H = hbuf + dir * 4096 + ch;
#pragma unroll 1
        for (int s0 = 0; s0 < 64; s0 += 16) { float av[16], bv[16];
#pragma unroll
            for (int j = 0; j < 16; ++j) { const int t = dir ? 63 - (s0 + j) : s0 + j; av[j] = A[t * 64]; bv[j] = B[t * 64]; }
#pragma unroll
            for (int j = 0; j < 16; ++j) { const int t = dir ? 63 - (s0 + j) : s0 + j; hc = av[j] * hc + bv[j]; ap *= av[j]; if (mode) H[t * 64] = hc; } }
        if (!mode) { WSP(float, WS_RGA)[ix] = ap; WSP(float, WS_RGB)[ix] = hc; } }
    LDS_SYNC();
    if (mode) { const int t = tid >> 3, ch0 = (tid & 7) * 8; float hv[8]; float ss = 0.f;
#pragma unroll
        for (int j = 0; j < 8; ++j) { hv[j] = hbuf[t * 64 + ch0 + j] + hbuf[4096 + t * 64 + ch0 + j]; ss += hv[j] * hv[j]; }
        ss += dpp_<0xB1, 0xF>(ss); ss += dpp_<0x4E, 0xF>(ss); ss += dpp_<0x141, 0xF>(ss);
        const float rstd = rsqrtf(ss * (1.0f / 64.0f) + EPS);
        const size_t row = (size_t)(rowbase + t0 + t);
        const u32x4 gv = *(const u32x4*)(Pp + row * NP + PC_RG + g * 64 + ch0);
        const float* mw = P.in[I_MIXW] + l * 1024 + 384 + g * 64 + ch0;
        u32x4 o;
#pragma unroll
        for (int q = 0; q < 4; ++q) { const float g0 = __uint_as_float(gv[q] << 16), g1v = __uint_as_float(gv[q] & 0xFFFF0000u);
            o[q] = pk_bf16(g0 * hv[2 * q] * rstd * mw[2 * q], g1v * hv[2 * q + 1] * rstd * mw[2 * q + 1]); }
        *(u32x4*)(WSP(bf16_t, WS_MRG) + row * 1024 + 384 + g * 64 + ch0) = o;
        LDS_SYNC(); }
}
DEVI void rg_carry(const Ctx& cx) {
    for (int idx = (cx.G - 1 - cx.bid) * NTHR + cx.tid; idx < NB * 2 * 384; idx += cx.G * NTHR) {
        const int ch = idx % 384, dir = (idx / 384) & 1, b = idx / 768;
        float A[RGC], B[RGC];
#pragma unroll
        for (int s = 0; s < RGC; ++s) { const int ck = dir == 0 ? s : (s < 4 ? 3 - s : 39 - s);
            const size_t ix = ((size_t)(b * RGC + ck) * 2 + dir) * 384 + ch; A[s] = WSP(float, WS_RGA)[ix]; B[s] = WSP(float, WS_RGB)[ix]; }
        float h = 0.f;
#pragma unroll
        for (int s = 0; s < RGC; ++s) { const int ck = dir == 0 ? s : (s < 4 ? 3 - s : 39 - s);
            const size_t ix = ((size_t)(b * RGC + ck) * 2 + dir) * 384 + ch; WSP(float, WS_RGC)[ix] = h; h = A[s] * h + B[s]; }
    }
}

DEVI int s5_trow(int rowi, int s) { const int b = rowi / S5C, c = rowi % S5C; return c < 8 ? b * CTXL + c * 32 + s : TCTX + b * SEQ + s * 64 + (c - 8); }
DEVI void s5_local_wave(const Ctx& cx, int l, int wu) {
    const int g = wu / 36, mt = (wu % 36) / 4, nt = wu % 4;
    const bf16_t* Pp = WSP(bf16_t, WS_P) + PC_S5 + g * 16;
    const bf16_t* we = WSP(bf16_t, WS_WE) + (size_t)(l * 16 + g) * 256 * 512 + (size_t)nt * 64 * 512;
    f32x4 acc[4][4];
    wave_gemm<4, 4>(cx.lane, 512, [&](int row, int k) { return ldg8(Pp + (size_t)s5_trow(mt * 64 + row, k >> 4) * NP + (k & 15)); },
                         [&](int row, int k) { return ldg8(we + (size_t)row * 512 + k); }, acc);
    const int fr = cx.lane & 15, fq = cx.lane >> 4;
#pragma unroll
    for (int m = 0; m < 4; ++m)
#pragma unroll
        for (int n = 0; n < 4; ++n) *(f32x4*)(WSP(float, WS_SLOC) + ((size_t)g * S5R + mt * 64 + m * 16 + fr) * 256 + nt * 64 + n * 16 + 4 * fq) = acc[m][n];
}
DEVI void s5_carry(const Ctx& cx, int l) {
    for (int idx = cx.bid * NTHR + cx.tid; idx < NB * 16 * 2 * 64; idx += cx.G * NTHR) {
        const int n = idx & 63, d = (idx >> 6) & 1, g = (idx >> 7) & 15, b = idx >> 11;
        const f32x2 a32 = WSP(f32x2, WS_PW)[(size_t)(((l * 16 + g) * 2 + d) * 64 + n) * 33 + 32];
        float sr = 0.f, si = 0.f;
#pragma unroll 1
        for (int s0 = 0; s0 < S5C; s0 += 24) {
            float lr[24], li[24];
#pragma unroll
            for (int j = 0; j < 24; ++j) { const int s = s0 + j, c = d == 0 ? s : (s < 8 ? 7 - s : 79 - s);
                const size_t ix = ((size_t)g * S5R + b * S5C + c) * 256 + d * 128 + n; lr[j] = WSP(float, WS_SLOC)[ix]; li[j] = WSP(float, WS_SLOC)[ix + 64]; }
#pragma unroll
            for (int j = 0; j < 24; ++j) { const int s = s0 + j, c = d == 0 ? s : (s < 8 ? 7 - s : 79 - s);
                const size_t ix = ((size_t)g * S5R + b * S5C + c) * 256 + d * 128 + n;
                WSP(bf16_t, WS_SIN)[ix] = f2bf(sr); WSP(bf16_t, WS_SIN)[ix + 64] = f2bf(si);
                const float nr = a32.x * sr - a32.y * si + lr[j], ni = a32.x * si + a32.y * sr + li[j]; sr = nr; si = ni; }
        }
    }
}
DEVI void s5_out_wave(const Ctx& cx, int l, int wu) {
    const int g = wu / 72, mt = (wu % 72) / 8, nt = wu % 8;
    const bf16_t* Pp = WSP(bf16_t, WS_P) + PC_S5 + g * 16;
    const bf16_t* sin_ = WSP(bf16_t, WS_SIN) + (size_t)g * S5R * 256;
    const bf16_t* wy = WSP(bf16_t, WS_WY) + (size_t)(l * 16 + g) * 512 * 768 + (size_t)nt * 64 * 768;
    f32x4 acc[4][4];
    wave_gemm<4, 4>(cx.lane, 768, [&](int row, int k) { return k < 512 ? ldg8(Pp + (size_t)s5_trow(mt * 64 + row, k >> 4) * NP + (k & 15)) : ldg8(sin_ + (size_t)(mt * 64 + row) * 256 + (k - 512)); },
                         [&](int row, int k) { return ldg8(wy + (size_t)row * 768 + k); }, acc);
    const int fr = cx.lane & 15, fq = cx.lane >> 4;
#pragma unroll
    for (int m = 0; m < 4; ++m)
#pragma unroll
        for (int n = 0; n < 4; ++n) { const int trow = s5_trow(mt * 64 + m * 16 + fr, nt * 4 + n);
            u32x2 w; w.x = pk_bf16(gelu_tanh(acc[m][n][0]), gelu_tanh(acc[m][n][1])); w.y = pk_bf16(gelu_tanh(acc[m][n][2]), gelu_tanh(acc[m][n][3]));
            *(u32x2*)(WSP(bf16_t, WS_GS) + (size_t)trow * 256 + g * 16 + 4 * fq) = w; }
}
DEVI void s5_glu_wave(const Ctx& cx, int l, int wu) {
    const int mt = wu / 4, nt = wu % 4;
    const bf16_t* gs = WSP(bf16_t, WS_GS) + (size_t)mt * 64 * 256;
    const bf16_t* wg = WSP(bf16_t, WS_WGLU) + (size_t)l * 65536 + (size_t)nt * 64 * 256;
    f32x4 acc[4][4];
    wave_gemm<4, 4>(cx.lane, 256, [&](int row, int k) { return ldg8(gs + (size_t)row * 256 + k); }, [&](int row, int k) { return ldg8(wg + (size_t)row * 256 + k); }, acc);
    const int fr = cx.lane & 15, fq = cx.lane >> 4;
#pragma unroll
    for (int n = 0; n < 4; ++n) { const int col = nt * 64 + n * 16 + 4 * fq;
        const f32x4 gb = *(const f32x4*)(cx.p->in[I_S5GB] + l * 256 + col), mw = *(const f32x4*)(cx.p->in[I_MIXW] + l * 1024 + 768 + col);
#pragma unroll
        for (int m = 0; m < 4; ++m) { const size_t trow = (size_t)mt * 64 + m * 16 + fr;
            const u32x2 gv = *(const u32x2*)(WSP(bf16_t, WS_GS) + trow * 256 + col);
            const float gq[4] = {__uint_as_float(gv.x << 16), __uint_as_float(gv.x & 0xFFFF0000u), __uint_as_float(gv.y << 16), __uint_as_float(gv.y & 0xFFFF0000u)};
            float o[4]; float ss = 0.f;
#pragma unroll
            for (int j = 0; j < 4; ++j) { o[j] = gq[j] * frcp(1.0f + __expf(-(acc[m][n][j] + gb[j]))); ss += o[j] * o[j]; }
            ss += shx<16>(ss, cx.lane); ss += shx<32>(ss, cx.lane);
            const float rstd = rsqrtf(ss * (1.0f / 16.0f) + EPS);
            u32x2 w; w.x = pk_bf16(o[0] * rstd * mw[0], o[1] * rstd * mw[1]); w.y = pk_bf16(o[2] * rstd * mw[2], o[3] * rstd * mw[3]);
            *(u32x2*)(WSP(bf16_t, WS_MRG) + trow * 1024 + 768 + col) = w; } }
}

#ifndef PH_DUP2
#define PH_DUP2 0
#endif
#define REP_(k) for (int rep_ = 0; rep_ < 1 + ((PH_DUP2 >> (k)) & 1); ++rep_)
DEVI void ph_mix_local(const Ctx& cx, int l) {
    REP_(0) for (int u = cx.bid; u < NB * 4 * MLC; u += cx.G) ml_local_unit(cx, l, u / (4 * MLC), (u / MLC) % 4, u % MLC);
    REP_(1) { const int off = (NB * 4 * MLC) % cx.G; const int first = (cx.bid - off + cx.G) % cx.G;
      for (int u = first; u < NB * RGC * 6; u += cx.G) rg_unit(cx, l, u / (RGC * 6), (u / 6) % RGC, u % 6, 0); }
    REP_(2) { const int off = (NB * 4 * MLC + NB * RGC * 6) % cx.G; const int first = (cx.bid - off + cx.G) % cx.G;
      for (int wu = first * 8 + cx.wave; wu < 16 * 36; wu += cx.G * 8) s5_local_wave(cx, l, wu); }
}
DEVI void ph_mix_carry(const Ctx& cx, int l) { ml_carry(cx); rg_carry(cx); s5_carry(cx, l); }
DEVI void ph_mix_out(const Ctx& cx, int l) {
    const bool last = (l == DEPTH - 1);
    REP_(3) for (int u = cx.bid; u < NB * 4 * MLC; u += cx.G) { const int c = u % MLC; if (last && c < 2) continue; ml_out_unit(cx, l, u / (4 * MLC), (u / MLC) % 4, c); }
    REP_(4) { const int off = (NB * 4 * MLC) % cx.G; const int first = (cx.bid - off + cx.G) % cx.G;
      for (int u = first; u < NB * RGC * 6; u += cx.G) { const int ck = (u / 6) % RGC; if (last && ck < 4) continue; rg_unit(cx, l, u / (RGC * 6), ck, u % 6, 1); } }
    REP_(5) { const int off = (NB * 4 * MLC + NB * RGC * 6) % cx.G; const int first = (cx.bid - off + cx.G) % cx.G;
      for (int wu = first * 8 + cx.wave; wu < 16 * 72; wu += cx.G * 8) s5_out_wave(cx, l, wu); }
}
DEVI void ph_glu(const Ctx& cx, int l) {
    for (int wu = cx.bid * 8 + cx.wave; wu < (TT / 64) * 4; wu += cx.G * 8) s5_glu_wave(cx, l, wu);
}

DEVI unsigned st_launder(unsigned s_addr) { unsigned a; asm volatile("v_mov_b32 %0, %1" : "=v"(a) : "s"(s_addr)); return a; }
constexpr int N_STEPS = 3 + 10 * DEPTH + 1;
__global__ void __launch_bounds__(NTHR, 2) mk_fwd(Params p) {
    extern __shared__ __attribute__((aligned(16))) unsigned char lds_raw[];
    Ctx cx; cx.p = &p; cx.ws = p.ws; cx.lds = (LAS unsigned char*)lds_raw; cx.tid = threadIdx.x; cx.lane = cx.tid & 63;
    cx.wave = __builtin_amdgcn_readfirstlane((int)threadIdx.x >> 6); cx.G = gridDim.x; cx.bid = blockIdx.x;
    volatile LAS unsigned* st = (volatile LAS unsigned*)(cx.lds + LDS_BYTES - 16);
    const unsigned st_s = (unsigned)__builtin_amdgcn_readfirstlane((int)(unsigned)(size_t)(LAS unsigned*)(cx.lds + LDS_BYTES - 16));
#define ST_P ((volatile LAS unsigned*)(size_t)st_launder(st_s))
    if (cx.tid == 0) { st[0] = 0u; st[1] = 0u; st[2] = (unsigned)p.lo; st[3] = (unsigned)p.hi; }
    __syncthreads();
    (void)xcd_barrier_post((unsigned*)(p.ws + WS_CTL) + CW_BAR, st);
#define GRID_BAR() do { XcdBarrier b_; b_.bar = (unsigned*)(p.ws + WS_CTL) + CW_BAR; b_.x = (unsigned)__builtin_amdgcn_readfirstlane((int)xb_xcc_id()); b_.st = ST_P; xcd_barrier(b_); } while (0)
#ifndef PH_MASK
#define PH_MASK 0xFFFF
#endif
#ifndef PH_DUP
#define PH_DUP 0
#endif
#define STEP_(id, k, call) do { const int lo_ = __builtin_amdgcn_readfirstlane((int)ST_P[2]), hi_ = __builtin_amdgcn_readfirstlane((int)ST_P[3]); if (lo_ <= (k) && (k) < hi_) { if ((PH_MASK >> (id)) & 1) { const Ctx cl = relaunder(cx); call; } if ((PH_DUP >> (id)) & 1) { GRID_BAR(); const Ctx cl = relaunder(cx); call; } if ((k) + 1 < hi_) GRID_BAR(); } } while (0)
    STEP_(0, 0, ph_pro_a(cl));
    STEP_(1, 1, ph_pro_b(cl));
    STEP_(2, 2, ph_pro_c(cl));
#pragma unroll 1
    for (int l = 0; l < DEPTH; ++l) {
        const int s0 = 3 + 10 * l;
        STEP_(3, s0 + 0, ph_norm1(cl, l));
        STEP_(4, s0 + 1, ph_inproj(cl, l));
        STEP_(5, s0 + 2, ph_mix_local(cl, l));
        STEP_(6, s0 + 3, ph_mix_carry(cl, l));
        STEP_(7, s0 + 4, ph_mix_out(cl, l));
        STEP_(8, s0 + 5, ph_glu(cl, l));
        STEP_(9, s0 + 6, ph_outproj(cl, l));
        STEP_(10, s0 + 7, ph_norm2(cl, l));
        STEP_(11, s0 + 8, ph_moe_gu(cl, l));
        STEP_(12, s0 + 9, ph_moe_dn(cl, l));
    }
    STEP_(13, N_STEPS - 1, ph_norm1(cl, DEPTH));
#undef STEP_
}

extern "C" void kernel_launch(void* const* d_in, const int* in_sizes, int n_in, void* d_out, int out_size, void* d_ws, size_t ws_size, hipStream_t stream) {
    static int grid = 0;
    if (grid == 0) {
        if (n_in != 36 || out_size != TLAT * DM || ws_size < WS_END) { fprintf(stderr, "kernel_launch: unexpected problem (n_in %d, out %d, ws %zu < %zu)\n", n_in, out_size, ws_size, (size_t)WS_END); grid = -1; return; }
        int dev = 0, cus = 0, per_cu = 0;
        if (hipGetDevice(&dev) != hipSuccess || hipDeviceGetAttribute(&cus, hipDeviceAttributeMultiprocessorCount, dev) != hipSuccess) { grid = -1; return; }
        if (hipFuncSetAttribute((const void*)mk_fwd, hipFuncAttributeMaxDynamicSharedMemorySize, LDS_BYTES) != hipSuccess) { fprintf(stderr, "kernel_launch: hipFuncSetAttribute failed\n"); grid = -1; return; }
        if (hipOccupancyMaxActiveBlocksPerMultiprocessor(&per_cu, (const void*)mk_fwd, NTHR, LDS_BYTES) != hipSuccess || per_cu < 1) { fprintf(stderr, "kernel_launch: occupancy query says %d blocks per CU\n", per_cu); }
        (void)hipGetLastError();
        grid = cus;
    }
    if (grid < 0) return;
    (void)hipMemsetAsync((char*)d_ws + WS_CTL, 0, CTL_BYTES, stream);
    Params p{};
    for (int i = 0; i < 36; ++i) p.in[i] = (const float*)d_in[i];
    p.out = (float*)d_out; p.ws = (unsigned char*)d_ws;
#if MK_FUSED
    p.lo = 0; p.hi = N_STEPS;
    hipLaunchKernelGGL(mk_fwd, dim3(grid), dim3(NTHR), LDS_BYTES, stream, p);
#else
    for (int k = 0; k < N_STEPS; ++k) { p.lo = k; p.hi = k + 1; hipLaunchKernelGGL(mk_fwd, dim3(grid), dim3(NTHR), LDS_BYTES, stream, p); }
#endif
}
```

```cpp
#include <hip/hip_runtime.h>
#include <stdint.h>
#include <stdio.h>

#ifndef MK_FUSED
#define MK_FUSED 1
#endif

typedef unsigned short bf16_t;
typedef short bf16x8 __attribute__((ext_vector_type(8)));
typedef float f32x4 __attribute__((ext_vector_type(4)));
typedef float f32x2 __attribute__((ext_vector_type(2)));
typedef unsigned u32x4 __attribute__((ext_vector_type(4)));
typedef unsigned u32x2 __attribute__((ext_vector_type(2)));
typedef int i32x4 __attribute__((ext_vector_type(4)));
typedef int i32x8 __attribute__((ext_vector_type(8)));
#define LAS __attribute__((address_space(3)))
#define DEVI __device__ __forceinline__

constexpr int DM = 1024, NB = 8, SEQ = 2048, CTXL = 256, DEPTH = 4;
constexpr int TCTX = NB * CTXL, TLAT = NB * SEQ, TT = TCTX + TLAT;
constexpr int DIN = 2576, NP = 2560;
constexpr int NE = 32;
constexpr int PMAX = 81920;
constexpr int NTHR = 512;
constexpr int LDS_BYTES = 152 * 1024;
constexpr float EPS = 1e-6f;
constexpr float W8_SCALE = 32.0f, W8_INV = 0.03125f;
constexpr int PC_Q = 0, PC_K = 384, PC_V = 768, PC_O = 1152, PC_RX = 1536, PC_RG = 1920, PC_S5 = 2304;
constexpr int MLC = 18;
constexpr int RGC = 36;
constexpr int S5C = 72, S5R = NB * S5C;

constexpr size_t al256(size_t x) { return (x + 255) & ~(size_t)255; }
constexpr size_t WS_CTL   = 0;
constexpr size_t CTL_BYTES = 65536;
constexpr size_t CW_BAR = 0;
constexpr size_t CW_CNT = 4096;
constexpr size_t WS_WIN   = al256(WS_CTL + CTL_BYTES);
constexpr size_t WS_WOUT  = al256(WS_WIN + (size_t)DEPTH * NP * 1024 * 2);
constexpr size_t WS_WGU   = al256(WS_WOUT + (size_t)DEPTH * 1024 * 1024 * 2);
constexpr size_t WS_WD    = al256(WS_WGU + (size_t)DEPTH * NE * 2048 * 1024 * 2);
constexpr size_t WS_MOD   = al256(WS_WD + (size_t)DEPTH * NE * 1024 * 1024 * 2);
constexpr size_t WS_PW    = al256(WS_MOD + (size_t)DEPTH * 9 * 6144 * 4);
constexpr size_t WS_BB    = al256(WS_PW + (size_t)DEPTH * 16 * 2 * 64 * 33 * 8);
constexpr size_t WS_KT    = al256(WS_BB + (size_t)DEPTH * 16 * 2 * 64 * 16 * 8);
constexpr size_t WS_WY    = al256(WS_KT + (size_t)DEPTH * 16 * 2 * 32 * 256 * 4);
constexpr size_t WS_WE    = al256(WS_WY + (size_t)DEPTH * 16 * 512 * 768 * 2);
constexpr size_t WS_WRG   = al256(WS_WE + (size_t)DEPTH * 16 * 256 * 512 * 2);
constexpr size_t WS_WGLU  = al256(WS_WRG + (size_t)DEPTH * 6 * 256 * 64 * 2);
constexpr size_t WS_XS    = al256(WS_WGLU + (size_t)DEPTH * 256 * 256 * 2);
constexpr size_t WS_XMID  = al256(WS_XS + (size_t)TT * 1024 * 4);
constexpr size_t WS_H     = al256(WS_XMID + (size_t)TT * 1024 * 4);
constexpr size_t WS_GT    = al256(WS_H + (size_t)TT * 1024 * 2);
constexpr size_t WS_P     = al256(WS_GT + (size_t)TT * 16 * 4);
constexpr size_t WS_GB    = al256(WS_P + (size_t)TT * NP * 2);
constexpr size_t WS_GU    = al256(WS_GB + (size_t)TT * 8 * 4);
constexpr size_t WS_GCM   = al256(WS_GU + (size_t)TT * 8 * 4);
constexpr size_t WS_MSC   = al256(WS_GCM + (size_t)TT * 8 * 4);
constexpr size_t WS_CLOC  = al256(WS_MSC + (size_t)8 * 4 * 18 * 2 * 2 * 4);
constexpr size_t WS_NLOC  = al256(WS_CLOC + (size_t)8 * 4 * 18 * 2 * 9216 * 4);
constexpr size_t WS_C0    = al256(WS_NLOC + (size_t)8 * 4 * 18 * 2 * 96 * 4);
constexpr size_t WS_N0    = al256(WS_C0 + (size_t)8 * 4 * 18 * 2 * 9216 * 2);
constexpr size_t WS_M0    = al256(WS_N0 + (size_t)8 * 4 * 18 * 2 * 96 * 4);
constexpr size_t WS_RGA   = al256(WS_M0 + (size_t)8 * 4 * 18 * 2 * 4);
constexpr size_t WS_RGB   = al256(WS_RGA + (size_t)8 * 36 * 2 * 384 * 4);
constexpr size_t WS_RGC   = al256(WS_RGB + (size_t)8 * 36 * 2 * 384 * 4);
constexpr size_t WS_SLOC  = al256(WS_RGC + (size_t)8 * 36 * 2 * 384 * 4);
constexpr size_t WS_SIN   = al256(WS_SLOC + (size_t)16 * 576 * 256 * 4);
constexpr size_t WS_GS    = al256(WS_SIN + (size_t)16 * 576 * 256 * 2);
constexpr size_t WS_MRG   = al256(WS_GS + (size_t)TT * 256 * 2);
constexpr size_t WS_ELIST = al256(WS_MRG + (size_t)TT * 1024 * 2);
constexpr size_t WS_GLIST = al256(WS_ELIST + (size_t)NE * TT * 4);
constexpr size_t WS_TINFO = al256(WS_GLIST + (size_t)NE * TT * 4);
constexpr size_t WS_ACT   = al256(WS_TINFO + (size_t)TT * 4 * 4);
constexpr size_t WS_YPAD  = al256(WS_ACT + (size_t)PMAX * 1024 * 2);
constexpr size_t WS_BIN2  = al256(WS_YPAD + (size_t)PMAX * 1024 * 2);
constexpr size_t WS_HLO   = al256(WS_BIN2 + (size_t)DEPTH * NP * 4);
constexpr size_t WS_WGT   = al256(WS_HLO + (size_t)TT * 1024 * 2);
constexpr size_t WS_RWH   = al256(WS_WGT + (size_t)DEPTH * 16 * 1024 * 2);
constexpr size_t WS_RWL   = al256(WS_RWH + (size_t)DEPTH * 32 * 1024 * 2);
constexpr size_t WS_H8    = al256(WS_RWL + (size_t)DEPTH * 32 * 1024 * 2);
constexpr size_t WS_END   = al256(WS_H8 + (size_t)TT * 1024);

struct Params { const float* in[36]; float* out; unsigned char* ws; int lo, hi; };

enum { I_X = 0, I_C, I_CTX, I_CCTX, I_ADAW, I_ADAB, I_N1W, I_WIN, I_BIN, I_RGCW, I_RGCB, I_RGWA, I_RGBA, I_RGWX, I_RGBX, I_RGLAM,
       I_S5LRE, I_S5LIM, I_S5LDT, I_S5BRE, I_S5BIM, I_S5CRE, I_S5CIM, I_S5D, I_S5GW, I_S5GB, I_MIXW, I_WOUT, I_N2W, I_RW, I_RB,
       I_WGU, I_BGU, I_WD, I_BD, I_FNW };

DEVI bf16_t f2bf(float f) { unsigned u = __float_as_uint(f); u += 0x7FFFu + ((u >> 16) & 1u); return (bf16_t)(u >> 16); }
DEVI float bf2f(bf16_t b) { return __uint_as_float(((unsigned)b) << 16); }
DEVI unsigned pk_bf16(float lo, float hi) { unsigned r; asm("v_cvt_pk_bf16_f32 %0, %1, %2" : "=v"(r) : "v"(lo), "v"(hi)); return r; }
DEVI unsigned pk4_fp8(float a, float b, float c, float d) { int p = __builtin_amdgcn_cvt_pk_fp8_f32(a, b, 0, false); p = __builtin_amdgcn_cvt_pk_fp8_f32(c, d, p, true); return (unsigned)p; }
DEVI float q8(float x) { const int p = __builtin_amdgcn_cvt_pk_fp8_f32(x, x, 0, false); return __builtin_amdgcn_cvt_f32_fp8(p, 0); }
DEVI float frcp(float x) { return __builtin_amdgcn_rcpf(x); }
DEVI float sigmoidf_(float x) { return frcp(1.0f + __expf(-x)); }
DEVI float gelu_tanh(float x) { const float u = 0.7978845608f * (x + 0.044715f * x * x * x); return x * frcp(1.0f + __expf(-2.0f * u)); }
template <int M> DEVI float shx(float v, int lane) {
    if constexpr (M < 32) return __int_as_float(__builtin_amdgcn_ds_swizzle(__float_as_int(v), 0x1F | (M << 10)));
    else return __int_as_float(__builtin_amdgcn_ds_bpermute((lane ^ 32) << 2, __float_as_int(v)));
}
DEVI float shxr(float v, int m, int lane) {
    switch (m) { case 1: return shx<1>(v, lane); case 2: return shx<2>(v, lane); case 4: return shx<4>(v, lane); case 8: return shx<8>(v, lane); case 16: return shx<16>(v, lane); default: return shx<32>(v, lane); }
}
DEVI int shxri(int v, int m, int lane) { return __float_as_int(shxr(__int_as_float(v), m, lane)); }
template <int CTRL, int ROWMASK> DEVI float dpp_(float v) { return __int_as_float(__builtin_amdgcn_update_dpp(0, __float_as_int(v), CTRL, ROWMASK, 0xF, false)); }
DEVI float wave_sum(float v, int) {
    v += dpp_<0xB1, 0xF>(v); v += dpp_<0x4E, 0xF>(v); v += dpp_<0x141, 0xF>(v); v += dpp_<0x140, 0xF>(v);
    v += dpp_<0x142, 0xA>(v); v += dpp_<0x143, 0xC>(v);
    return __int_as_float(__builtin_amdgcn_readlane(__float_as_int(v), 63));
}
DEVI float log1p_(float e) { return e < 0.06f ? e * (1.0f - e * (0.5f - e * (0.33333334f - e * 0.25f))) : __logf(1.0f + e); }
#define LDS_SYNC() do { asm volatile("s_waitcnt lgkmcnt(0)" ::: "memory"); __builtin_amdgcn_s_barrier(); asm volatile("" ::: "memory"); } while (0)
DEVI int mod_row(int row) { return row < TCTX ? 8 : (row - TCTX) / SEQ; }

#define XB_TMO      128
#define XB_XCNT(j)  (256  + 64 * (j))
#define XB_XSUB(j)  (1280 + 64 * (j))
#define XB_XGEN(j)  (2304 + 64 * (j))
#define XB_TOP      3328
#define XB_TOPGEN   3392
#define XCD_BAR_WORDS 3456
#define XB_SPIN_CAP (1u << 18)
__device__ __forceinline__ unsigned xb_ld(unsigned* p)              { return __hip_atomic_load(p, __ATOMIC_RELAXED, __HIP_MEMORY_SCOPE_AGENT); }
__device__ __forceinline__ unsigned xb_add(unsigned* p, unsigned v) { return __hip_atomic_fetch_add(p, v, __ATOMIC_RELAXED, __HIP_MEMORY_SCOPE_AGENT); }
__device__ __forceinline__ unsigned xb_xcc_id() { return (unsigned)__builtin_amdgcn_s_getreg((3 << 11) | 20) & 0xFu; }
#define XB_SPIN(cond, bar) do { unsigned _sp = 0; while (cond) { __builtin_amdgcn_s_sleep(1); \
    if ((++_sp & 255u) == 0u) { if (xb_ld(&(bar)[XB_TMO])) break; if (_sp > XB_SPIN_CAP) { atomicAdd(&(bar)[XB_TMO], 1u); break; } } } } while (0)
struct XcdBarrier { unsigned* bar; unsigned x; volatile LAS unsigned* st; };
__device__ __forceinline__ XcdBarrier xcd_barrier_post(unsigned* bar, volatile LAS unsigned* st) {
    XcdBarrier b; b.bar = bar; b.x = xb_xcc_id(); b.st = st;
    if (threadIdx.x == 0) (void)xb_add(&bar[XB_XCNT(b.x)], 1u);
    return b;
}
__device__ __forceinline__ void xcd_barrier_complete(unsigned* bar, unsigned x, unsigned& nloc, unsigned& nx) {
    const unsigned G = gridDim.x * gridDim.y * gridDim.z;
    unsigned sum, cnt, mine, sp = 0u;
    for (;;) {
        sum = 0u; cnt = 0u; mine = 0u;
#pragma unroll
        for (unsigned j = 0; j < 16; ++j) { const unsigned c = xb_ld(&bar[XB_XCNT(j)]); sum += c; cnt += (c > 0u) ? 1u : 0u; mine = (j == x) ? c : mine; }
        if (sum == G) break;
        __builtin_amdgcn_s_sleep(1);
        if ((++sp & 255u) == 0u) { if (xb_ld(&bar[XB_TMO])) break; if (sp > XB_SPIN_CAP) { atomicAdd(&bar[XB_TMO], 1u); break; } }
    }
    nloc = mine > 0u ? mine : 1u; nx = cnt > 0u ? cnt : 1u;
}
__device__ __forceinline__ void xcd_barrier(const XcdBarrier& b) {
    asm volatile("s_waitcnt vmcnt(0)" ::: "memory");
    __syncthreads();
    if (threadIdx.x == 0) {
        unsigned* bar = b.bar;
        __builtin_amdgcn_s_waitcnt(0);
        unsigned nloc = b.st[0], nx = b.st[1];
        if (nloc == 0u) { xcd_barrier_complete(bar, b.x, nloc, nx); b.st[0] = nloc; b.st[1] = nx; }
        const unsigned old = xb_add(&bar[XB_XSUB(b.x)], 1u);
        const unsigned gen = old / nloc;
        if (old + 1u == (gen + 1u) * nloc) {
            __builtin_amdgcn_fence(__ATOMIC_RELEASE, "agent");
            asm volatile("s_waitcnt vmcnt(0)" ::: "memory");
            const unsigned og = xb_add(&bar[XB_TOP], 1u);
            const unsigned tg = og / nx;
            if (og + 1u == (tg + 1u) * nx) xb_add(&bar[XB_TOPGEN], 1u);
            else XB_SPIN(xb_ld(&bar[XB_TOPGEN]) == tg, bar);
            __builtin_amdgcn_fence(__ATOMIC_ACQUIRE, "agent");
            xb_add(&bar[XB_XGEN(b.x)], 1u);
            asm volatile("s_waitcnt vmcnt(0)" ::: "memory");
        } else {
            XB_SPIN(xb_ld(&bar[XB_XGEN(b.x)]) == gen, bar);
            __builtin_amdgcn_fence(__ATOMIC_ACQUIRE, "agent");
            asm volatile("s_waitcnt vmcnt(0)" ::: "memory");
        }
    }
    __syncthreads();
}

namespace g1 {
constexpr int BM = 256, BK = 64, HALF = 128, HTB = HALF * BK * 2, STAGE_BYTES = 8 * HTB, K = 1024, NT = K / BK;
DEVI int lds_byte(int r, int c) { const int st = (r >> 4) * 2 + (c >> 5), rr = r & 15, cc = c & 31, ob = rr * 64 + cc * 2; return st * 1024 + (ob ^ (((ob >> 9) & 1) << 5)); }
DEVI void stage_rc(int b, int& R, int& C) { const int st = b / 1024, sb = b % 1024, swz = sb ^ (((sb >> 9) & 1) << 5); R = (st >> 1) * 16 + swz / 64; C = (st & 1) * 32 + (swz % 64) / 2; }
DEVI int perm32(int rho) { const int n = rho >> 4, i = rho & 15; return 8 * (i >> 2) + 4 * n + (i & 3); }

struct Unit {
    const char* A;
    const int* list;
    int nvalid;
    const char* B;
    int pm, pn, e;
};

template <bool F8> struct FragT { typedef bf16x8 T; static constexpr int NK = 2; };
template <> struct FragT<true> { typedef i32x8 T; static constexpr int NK = 1; };
template <bool GATHER, int KB>
DEVI void a_offsets(const Unit& u, int tid, unsigned (&v)[2][2]) {
    int tz = tid; asm volatile("" : "+v"(tz));
#pragma unroll
    for (int i = 0; i < 2; ++i) {
        int R, C; stage_rc(tz * 16 + i * 8192, R, C);
#pragma unroll
        for (int h = 0; h < 2; ++h) {
            const int r = h * HALF + R;
            int src = r;
            if (GATHER) { const int nv = u.nvalid > 256 ? 256 : u.nvalid; const int ld_ = u.list[r < nv ? r : nv - 1]; src = (r < nv) ? ld_ : 0; }
            v[h][i] = (unsigned)src * (unsigned)KB + (unsigned)(C * 2);
        }
    }
}
DEVI void a_request(const Unit& u, int tid, int (&raw)[2][2]) {
    int tz = tid; asm volatile("" : "+v"(tz));
    const int nv = u.nvalid > 256 ? 256 : u.nvalid;
#pragma unroll
    for (int i = 0; i < 2; ++i) { int R, C; stage_rc(tz * 16 + i * 8192, R, C);
#pragma unroll
        for (int h = 0; h < 2; ++h) { const int r = h * HALF + R; raw[h][i] = u.list[r < nv ? r : nv - 1]; } }
}
template <int KB>
DEVI void a_finish(int nvalid, int tid, int (&raw)[2][2], unsigned (&v)[2][2]) {
    asm volatile("" : "+v"(raw[0][0]), "+v"(raw[0][1]), "+v"(raw[1][0]), "+v"(raw[1][1]));
    int tz = tid; asm volatile("" : "+v"(tz));
    const int nv = nvalid > 256 ? 256 : nvalid;
#pragma unroll
    for (int i = 0; i < 2; ++i) { int R, C; stage_rc(tz * 16 + i * 8192, R, C);
#pragma unroll
        for (int h = 0; h < 2; ++h) { const int r = h * HALF + R; const int src = (r < nv) ? raw[h][i] : 0; v[h][i] = (unsigned)src * (unsigned)KB + (unsigned)(C * 2); } }
}

template <class Sched, class Epi, bool GATHER, bool FP8 = false>
DEVI void gemm_phase(LAS unsigned char* lds, const int tid, const Sched& S, const Epi& E) {
    constexpr int KB = FP8 ? 1024 : 2048, NTK = KB / 128, NK = FragT<FP8>::NK;
    typedef typename FragT<FP8>::T frag_t;
    int sc1 = 0x7F7F7F7F; asm volatile("" : "+v"(sc1));
    const int wid = __builtin_amdgcn_readfirstlane(tid >> 6), lane = tid & 63, wr = wid >> 2, wc = wid & 3, fr = lane & 15, fq = lane >> 4;
    unsigned voffB[2];
#pragma unroll
    for (int i = 0; i < 2; ++i) { int R, C; stage_rc(tid * 16 + i * 8192, R, C); const int Rb = Epi::PERM ? ((R & ~31) + perm32(R & 31)) : R; voffB[i] = (unsigned)(Rb * KB + C * 2); }
    constexpr size_t kstep = (size_t)(BK * 2);
    constexpr size_t hstep = (size_t)HALF * KB;
    const unsigned ldsw = (unsigned)wid * 1024u;
    const int aoff = FP8 ? lds_byte(wr * 64 + fr, fq * 16) : lds_byte(wr * 64 + fr, fq * 8), boff = FP8 ? lds_byte(wc * 32 + fr, fq * 16) : lds_byte(wc * 32 + fr, fq * 8);
    const int sw16 = FP8 ? 16 * (fq & 1) : 0;
    unsigned pa_ = (unsigned)(size_t)(lds + aoff) + sw16, pb_ = (unsigned)(size_t)(lds + 65536 + boff) + sw16, pa2_ = (unsigned)(size_t)(lds + aoff) + (16 - sw16), pb2_ = (unsigned)(size_t)(lds + 65536 + boff) + (16 - sw16);
    asm volatile("" : "+v"(pa_), "+v"(pb_), "+v"(pa2_), "+v"(pb2_));
    LAS unsigned char* const pa = (LAS unsigned char*)(size_t)pa_; LAS unsigned char* const pb = (LAS unsigned char*)(size_t)pb_;
    LAS unsigned char* const pa2 = (LAS unsigned char*)(size_t)pa2_; LAS unsigned char* const pb2 = (LAS unsigned char*)(size_t)pb2_;
#define G1_SA(b, h) (((b) * 2 + (h)) * HTB)
#define G1_SB(b, h) ((4 + (b) * 2 + (h)) * HTB)
#define G1_STAGE2(bufoff, gbase, v0, v1) do { \
        __builtin_amdgcn_global_load_lds((const unsigned*)((const char*)(gbase) + (v0)), (LAS unsigned*)(lds + (bufoff) + ldsw), 16, 0, 0); \
        __builtin_amdgcn_global_load_lds((const unsigned*)((const char*)(gbase) + (v1)), (LAS unsigned*)(lds + (bufoff) + ldsw + 8192), 16, 0, 0); } while (0)
#define G1_LDFRAG(dst, ptr, ptr2) do { if constexpr (FP8) { const i32x4 lo_ = *(const LAS i32x4*)(ptr), hi_ = *(const LAS i32x4*)(ptr2); dst = __builtin_shufflevector(lo_, hi_, 0, 1, 2, 3, 4, 5, 6, 7); } \
        else { dst = *(const LAS frag_t*)(ptr); } } while (0)
#define G1_LDA(dst, b, h) do { _Pragma("unroll") for (int m = 0; m < 4; ++m) _Pragma("unroll") for (int k = 0; k < NK; ++k) G1_LDFRAG(dst[m][k], pa + (G1_SA(b, h) + m * 2048 + k * 1024), pa2 + (G1_SA(b, h) + m * 2048 + k * 1024)); } while (0)
#define G1_LDB(dst, b, h) do { _Pragma("unroll") for (int n = 0; n < 2; ++n) _Pragma("unroll") for (int k = 0; k < NK; ++k) G1_LDFRAG(dst[n][k], pb + (G1_SB(b, h) - 65536 + n * 2048 + k * 1024), pb2 + (G1_SB(b, h) - 65536 + n * 2048 + k * 1024)); } while (0)
#define G1_MFMA(c_, b_, a_) do { if constexpr (FP8) asm volatile("v_mfma_scale_f32_16x16x128_f8f6f4 %0, %1, %2, %0, %3, %3 op_sel_hi:[0,0,0]" : "+v"(c_) : "v"(b_), "v"(a_), "v"(sc1)); \
        else c_ = __builtin_amdgcn_mfma_f32_16x16x32_bf16(b_, a_, c_, 0, 0, 0); } while (0)
#define G1_MMA(ai, bj, At, Bt) do { __builtin_amdgcn_s_setprio(1); _Pragma("unroll") for (int m = 0; m < 4; ++m) _Pragma("unroll") for (int n = 0; n < 2; ++n) _Pragma("unroll") for (int k = 0; k < NK; ++k) \
        G1_MFMA(acc[ai][bj][m][n], Bt[n][k], At[m][k]); __builtin_amdgcn_s_setprio(0); } while (0)
#define G1_WAIT_V(n) asm volatile("s_waitcnt vmcnt(" #n ")" ::: "memory")
#define G1_WAIT_L(n) asm volatile("s_waitcnt lgkmcnt(" #n ")" ::: "memory")
#define G1_BAR __builtin_amdgcn_s_barrier()
#define G1_SCHED __builtin_amdgcn_sched_barrier(0)
    Unit cur, nxt; int ui = 0;
    if (!S.get(0, cur)) return;
    f32x4 acc[2][2][4][2];
#pragma unroll
    for (int a = 0; a < 2; ++a)
#pragma unroll
        for (int b = 0; b < 2; ++b)
#pragma unroll
            for (int m = 0; m < 4; ++m)
#pragma unroll
                for (int n = 0; n < 2; ++n) acc[a][b][m][n] = (f32x4){0.f, 0.f, 0.f, 0.f};
    frag_t At[4][NK], B0[2][NK], B1[2][NK];
    unsigned vc[2][2], vn[2][2];
    a_offsets<GATHER, KB>(cur, tid, vc);
    const char* cA = cur.A; const char* cB = cur.B;
    G1_STAGE2(G1_SB(0, 0), cB, voffB[0], voffB[1]); G1_STAGE2(G1_SA(0, 0), cA, vc[0][0], vc[0][1]);
    G1_STAGE2(G1_SB(0, 1), cB + hstep, voffB[0], voffB[1]); G1_STAGE2(G1_SA(0, 1), cA, vc[1][0], vc[1][1]);
    if (wr == 1) G1_BAR;
    G1_WAIT_V(4); G1_BAR;
    G1_STAGE2(G1_SB(1, 0), cB + kstep, voffB[0], voffB[1]); G1_STAGE2(G1_SA(1, 0), cA + kstep, vc[0][0], vc[0][1]);
    G1_STAGE2(G1_SB(1, 1), cB + hstep + kstep, voffB[0], voffB[1]);
    G1_WAIT_V(6); G1_BAR;
    for (;;) {
        const bool has_next = S.get(ui + 1, nxt);
        int raw[2][2] = {{0, 0}, {0, 0}};
        if (has_next) { if constexpr (GATHER) a_request(nxt, tid, raw); else a_offsets<GATHER, KB>(nxt, tid, vn); }
        else {
#pragma unroll
            for (int h = 0; h < 2; ++h)
#pragma unroll
                for (int i = 0; i < 2; ++i) vn[h][i] = vc[h][i];
        }
        const char* nA = has_next ? nxt.A : cA; const char* nB = has_next ? nxt.B : cB;
#pragma unroll 1
        for (int t = 0; t < NTK; t += 2) {
            const bool last = (t == NTK - 2);
            const char* a1 = cA + (size_t)(t + 1) * kstep;
            const char* a2 = last ? nA : cA + (size_t)(t + 2) * kstep; const char* b2 = last ? nB : cB + (size_t)(t + 2) * kstep;
            const char* a3 = a2 + kstep; const char* b3 = b2 + kstep;
            unsigned w00 = vc[0][0], w01 = vc[0][1], w10 = vc[1][0], w11 = vc[1][1];
            if (last) { if constexpr (GATHER) { if (has_next) a_finish<KB>(nxt.nvalid, tid, raw, vn); }
                w00 = vn[0][0]; w01 = vn[0][1]; w10 = vn[1][0]; w11 = vn[1][1]; asm volatile("" : "+v"(w00), "+v"(w01), "+v"(w10), "+v"(w11)); }
            G1_LDB(B0, 0, 0); G1_SCHED; G1_LDA(At, 0, 0); G1_STAGE2(G1_SA(1, 1), a1, vc[1][0], vc[1][1]);
            G1_WAIT_L(8); G1_BAR; G1_WAIT_L(0); G1_MMA(0, 0, At, B0); G1_BAR; G1_SCHED;
            G1_LDB(B1, 0, 1); G1_STAGE2(G1_SB(0, 0), b2, voffB[0], voffB[1]);
            G1_BAR; G1_WAIT_L(0); G1_MMA(0, 1, At, B1); G1_BAR;
            G1_LDA(At, 0, 1); G1_STAGE2(G1_SA(0, 0), a2, w00, w01);
            G1_BAR; G1_WAIT_L(0); G1_MMA(1, 0, At, B0); G1_BAR; G1_SCHED;
            G1_STAGE2(G1_SB(0, 1), b2 + hstep, voffB[0], voffB[1]);
            G1_WAIT_V(6); G1_BAR; G1_MMA(1, 1, At, B1); G1_BAR;
            G1_LDB(B0, 1, 0); G1_SCHED; G1_LDA(At, 1, 0); G1_STAGE2(G1_SA(0, 1), a2, w10, w11);
            G1_WAIT_L(8); G1_BAR; G1_WAIT_L(0); G1_MMA(0, 0, At, B0); G1_BAR; G1_SCHED;
            G1_LDB(B1, 1, 1); G1_STAGE2(G1_SB(1, 0), b3, voffB[0], voffB[1]);
            G1_BAR; G1_WAIT_L(0); G1_MMA(0, 1, At, B1); G1_BAR;
            G1_LDA(At, 1, 1); G1_STAGE2(G1_SA(1, 0), a3, w00, w01);
            G1_BAR; G1_WAIT_L(0); G1_MMA(1, 0, At, B0); G1_BAR; G1_SCHED;
            G1_STAGE2(G1_SB(1, 1), b3 + hstep, voffB[0], voffB[1]);
            G1_WAIT_V(6); G1_BAR; G1_MMA(1, 1, At, B1); G1_BAR;
        }
        if constexpr (FP8) asm volatile("s_nop 15\n\ts_nop 15" ::: "memory");
        E(acc, cur, wr, wc, fr, fq);
        if (!has_next) break;
#pragma unroll
        for (int a = 0; a < 2; ++a)
#pragma unroll
            for (int b = 0; b < 2; ++b)
#pragma unroll
                for (int m = 0; m < 4; ++m)
#pragma unroll
                    for (int n = 0; n < 2; ++n) acc[a][b][m][n] = (f32x4){0.f, 0.f, 0.f, 0.f};
        cur = nxt; cA = nA; cB = nB; ++ui;
#pragma unroll
        for (int h = 0; h < 2; ++h)
#pragma unroll
            for (int i = 0; i < 2; ++i) vc[h][i] = vn[h][i];
    }
    G1_WAIT_V(0);
    if (wr == 0) G1_BAR;
    G1_BAR;
}
}

template <int MT, int NT_, class AF, class BF>
DEVI void wave_gemm(const int lane, int Kdim, const AF& af, const BF& bf, f32x4 (&acc)[MT][NT_]) {
    const int fr = lane & 15, fq = lane >> 4;
#pragma unroll
    for (int m = 0; m < MT; ++m)
#pragma unroll
        for (int n = 0; n < NT_; ++n) acc[m][n] = (f32x4){0.f, 0.f, 0.f, 0.f};
    bf16x8 fa[4][MT], fb[4][NT_];
#define WG_LOAD(S, KK) do { _Pragma("unroll") for (int m = 0; m < MT; ++m) fa[S][m] = af(m * 16 + fr, (KK) + fq * 8); _Pragma("unroll") for (int n = 0; n < NT_; ++n) fb[S][n] = bf(n * 16 + fr, (KK) + fq * 8); } while (0)
#define WG_MMA(S) do { _Pragma("unroll") for (int m = 0; m < MT; ++m) _Pragma("unroll") for (int n = 0; n < NT_; ++n) acc[m][n] = __builtin_amdgcn_mfma_f32_16x16x32_bf16(fb[S][n], fa[S][m], acc[m][n], 0, 0, 0); } while (0)
    WG_LOAD(0, 0); WG_LOAD(1, 32); WG_LOAD(2, 64);
#pragma unroll 1
    for (int k0 = 0; k0 < Kdim; k0 += 128) {
        const bool more = k0 + 128 < Kdim;
        WG_LOAD(3, k0 + 96); WG_MMA(0);
        if (more) WG_LOAD(0, k0 + 128);
        WG_MMA(1);
        if (more) WG_LOAD(1, k0 + 160);
        WG_MMA(2);
        if (more) WG_LOAD(2, k0 + 192);
        WG_MMA(3);
    }
#undef WG_LOAD
#undef WG_MMA
}
DEVI bf16x8 ldg8(const bf16_t* p) { return *(const bf16x8*)p; }

template <int N> struct Log2 { static constexpr int v = 1 + Log2<N / 2>::v; };
template <> struct Log2<1> { static constexpr int v = 0; };
template <int N>
DEVI float reduce_scatter(const int lane, float (&v)[N]) {
    constexpr int LG = Log2<N>::v;
#pragma unroll
    for (int st = 0; st < LG; ++st) {
        const int s = (N / 2) >> st, mask = 32 >> st;
        const bool up = (lane & mask) != 0;
#pragma unroll
        for (int i = 0; i < N / 2; ++i) if (i < s) {
            const float send = up ? v[i] : v[i + s];
            const float keep = up ? v[i + s] : v[i];
            v[i] = keep + shxr(send, mask, lane);
        }
    }
    float r = v[0];
#pragma unroll
    for (int st = LG; st < 6; ++st) r += shxr(r, 32 >> st, lane);
    return r;
}
template <int N>
DEVI int rs_index(int lane) {
    constexpr int LG = Log2<N>::v;
    int idx = 0;
#pragma unroll
    for (int st = 0; st < LG; ++st) if (lane & (32 >> st)) idx += (N / 2) >> st;
    return idx;
}

struct Ctx {
    const Params* p; unsigned char* ws; LAS unsigned char* lds; int tid, lane, wave, G, bid;
};
#define WSP(T, off) ((T*)(cx.ws + (off)))
DEVI Ctx relaunder(const Ctx& c) { Ctx r = c; int ln, td;
    asm volatile("v_mbcnt_lo_u32_b32 %0, -1, 0\n\tv_mbcnt_hi_u32_b32 %0, -1, %0\n\tv_lshl_add_u32 %1, %2, 6, %0" : "=&v"(ln), "=v"(td) : "s"(c.wave));
    r.lane = ln; r.tid = td; return r; }

DEVI void cvt_tile(const Ctx& cx, const float* src, int ld, bf16_t* dst, int n0, int k0, int kind) {
    LAS bf16_t* tile = (LAS bf16_t*)cx.lds;
    const int n4 = (cx.tid & 63) * 4, w8 = (cx.tid >> 6) * 8, n = n0 + n4;
    int sc; float scale = 1.0f;
    if (kind == 0) { sc = n < 1536 ? n : n + 16; if (n >= 384 && n < 768) scale = 0.10206207261596577f; }
    else if (kind == 2) { const int pn = n >> 8, w = n & 255; sc = w < 128 ? pn * 128 + w : 1024 + pn * 128 + (w - 128); }
    else sc = n;
#pragma unroll 1
    for (int sub = 0; sub < 4; sub += 2) {
        f32x4 v[2][8];
#pragma unroll
        for (int s2 = 0; s2 < 2; ++s2)
#pragma unroll
            for (int p = 0; p < 8; ++p) v[s2][p] = __builtin_nontemporal_load((const f32x4*)(src + (size_t)(k0 + (sub + s2) * 64 + w8 + p) * ld + sc));
#pragma unroll
        for (int s2 = 0; s2 < 2; ++s2)
#pragma unroll
            for (int j = 0; j < 4; ++j) { u32x4 w;
                w.x = pk_bf16(v[s2][0][j] * scale, v[s2][1][j] * scale); w.y = pk_bf16(v[s2][2][j] * scale, v[s2][3][j] * scale);
                w.z = pk_bf16(v[s2][4][j] * scale, v[s2][5][j] * scale); w.w = pk_bf16(v[s2][6][j] * scale, v[s2][7][j] * scale);
                *(LAS u32x4*)(tile + (n4 + j) * 264 + (sub + s2) * 64 + w8) = w; }
    }
    LDS_SYNC();
#pragma unroll
    for (int i = 0; i < 16; ++i) { const int idx = cx.tid + NTHR * i, row = idx >> 5, ch = idx & 31;
        const u32x4 o = *(const LAS u32x4*)(tile + row * 264 + ch * 8);
        *(u32x4*)(dst + (size_t)(n0 + row) * 1024 + k0 + ch * 8) = o; }
    LDS_SYNC();
}

DEVI void cvt_tile8(const Ctx& cx, const float* src, int ld, unsigned char* dst, int n0, int k0, int kind) {
    LAS unsigned char* tile = cx.lds;
    const int n4 = (cx.tid & 63) * 4, w8 = (cx.tid >> 6) * 8, n = n0 + n4;
    int sc;
    if (kind == 2) { const int pn = n >> 8, w = n & 255; sc = w < 128 ? pn * 128 + w : 1024 + pn * 128 + (w - 128); }
    else sc = n;
#pragma unroll 1
    for (int sub = 0; sub < 4; sub += 2) {
        f32x4 v[2][8];
#pragma unroll
        for (int s2 = 0; s2 < 2; ++s2)
#pragma unroll
            for (int p = 0; p < 8; ++p) v[s2][p] = __builtin_nontemporal_load((const f32x4*)(src + (size_t)(k0 + (sub + s2) * 64 + w8 + p) * ld + sc));
#pragma unroll
        for (int s2 = 0; s2 < 2; ++s2)
#pragma unroll
            for (int j = 0; j < 4; ++j) { u32x2 w;
                w.x = pk4_fp8(v[s2][0][j] * W8_SCALE, v[s2][1][j] * W8_SCALE, v[s2][2][j] * W8_SCALE, v[s2][3][j] * W8_SCALE);
                w.y = pk4_fp8(v[s2][4][j] * W8_SCALE, v[s2][5][j] * W8_SCALE, v[s2][6][j] * W8_SCALE, v[s2][7][j] * W8_SCALE);
                *(LAS u32x2*)(tile + (n4 + j) * 272 + (sub + s2) * 64 + w8) = w; }
    }
    LDS_SYNC();
#pragma unroll
    for (int i = 0; i < 8; ++i) { const int idx = cx.tid + NTHR * i, row = idx >> 4, ch = idx & 15;
        const u32x4 o = *(const LAS u32x4*)(tile + row * 272 + ch * 16);
        *(u32x4*)(dst + (size_t)(n0 + row) * 1024 + k0 + ch * 16) = o; }
    LDS_SYNC();
}
DEVI void ph_pro_a(const Ctx& cx) {
    const Params& P = *cx.p;
    {
        constexpr int n_in = DEPTH * 10 * 4, n_out = DEPTH * 4 * 4, n_gu = DEPTH * NE * 8 * 4, n_dn = DEPTH * NE * 4 * 4;
        constexpr int total = n_in + n_out + n_gu + n_dn;
        for (int job = cx.bid; job < total; job += cx.G) {
            int j = job;
            if (j < n_in) { const int l = j / 40, r = j % 40, kt = r / 10, nt = r % 10;
                cvt_tile(cx, P.in[I_WIN] + (size_t)l * 1024 * DIN, DIN, WSP(bf16_t, WS_WIN) + (size_t)l * NP * 1024, nt * 256, kt * 256, 0); continue; }
            j -= n_in;
            if (j < n_out) { const int l = j / 16, r = j % 16, kt = r / 4, nt = r % 4;
                cvt_tile(cx, P.in[I_WOUT] + (size_t)l * 1024 * 1024, 1024, WSP(bf16_t, WS_WOUT) + (size_t)l * 1024 * 1024, nt * 256, kt * 256, 1); continue; }
            j -= n_out;
            if (j < n_gu) { const int le = j / 32, r = j % 32, kt = r / 8, nt = r % 8;
                cvt_tile8(cx, P.in[I_WGU] + (size_t)le * 1024 * 2048, 2048, WSP(unsigned char, WS_WGU) + (size_t)le * 2048 * 1024, nt * 256, kt * 256, 2); continue; }
            j -= n_gu;
            { const int le = j / 16, r = j % 16, kt = r / 4, nt = r % 4;
                cvt_tile8(cx, P.in[I_WD] + (size_t)le * 1024 * 1024, 1024, WSP(unsigned char, WS_WD) + (size_t)le * 1024 * 1024, nt * 256, kt * 256, 1); }
        }
    }
    __syncthreads();
    {
        LAS float* sv = (LAS float*)cx.lds;
        LAS float* red = sv + 9 * 1024;
        constexpr int units = DEPTH * 6144 / 64;
        if (cx.bid < units) {
            for (int i = cx.tid; i < 9 * 1024; i += NTHR) { const int r = i >> 10, k = i & 1023; const float c = r < 8 ? P.in[I_C][r * 1024 + k] : P.in[I_CCTX][k]; sv[i] = c / (1.0f + __expf(-c)); }
            __syncthreads();
            for (int u = cx.bid; u < units; u += cx.G) {
                const int l = u / 96, n = (u % 96) * 64 + cx.lane;
                const float* w = P.in[I_ADAW] + (size_t)l * 1024 * 6144 + n;
                float acc[9];
#pragma unroll
                for (int r = 0; r < 9; ++r) acc[r] = 0.f;
                const int kb = cx.wave * 128;
#pragma unroll 4
                for (int k = 0; k < 128; ++k) { const float wv = w[(size_t)(kb + k) * 6144];
#pragma unroll
                    for (int r = 0; r < 9; ++r) acc[r] += sv[r * 1024 + kb + k] * wv; }
#pragma unroll
                for (int r = 0; r < 9; ++r) red[(cx.wave * 9 + r) * 64 + cx.lane] = acc[r];
                __syncthreads();
                for (int i = cx.tid; i < 9 * 64; i += NTHR) { const int r = i >> 6, ln = i & 63; float s = 0.f;
#pragma unroll
                    for (int w8 = 0; w8 < 8; ++w8) s += red[(w8 * 9 + r) * 64 + ln];
                    const int nn = (u % 96) * 64 + ln;
                    WSP(float, WS_MOD)[((size_t)l * 9 + r) * 6144 + nn] = s + P.in[I_ADAB][l * 6144 + nn]; }
                __syncthreads();
            }
        }
    }
    for (int gt = cx.bid * NTHR + cx.tid; gt < DEPTH * 16 * 2 * 64; gt += cx.G * NTHR) {
        const int n = gt & 63, d = (gt >> 6) & 1, g = (gt >> 7) & 15, l = gt >> 11;
        const float dt = expf(P.in[I_S5LDT][(l * 2 + d) * 16 + g]);
        const float lr = P.in[I_S5LRE][((l * 2 + d) * 16 + g) * 64 + n], li = P.in[I_S5LIM][((l * 2 + d) * 16 + g) * 64 + n];
        f32x2* pw = WSP(f32x2, WS_PW) + (size_t)gt * 33;
        float ar = 0.f, ai = 0.f;
        for (int k = 0; k <= 32; ++k) { const float mag = expf(lr * dt * (float)k); float s, c; sincosf(li * dt * (float)k, &s, &c); pw[k] = (f32x2){mag * c, mag * s}; if (k == 1) { ar = mag * c; ai = mag * s; } }
        const float den = lr * lr + li * li;
        const float cr = ((ar - 1.0f) * lr + ai * li) / den, ci = (ai * lr - (ar - 1.0f) * li) / den;
        f32x2* bb = WSP(f32x2, WS_BB) + (size_t)gt * 16;
        for (int q = 0; q < 16; ++q) { const float br = P.in[I_S5BRE][((l * 16 + g) * 64 + n) * 16 + q], bi = P.in[I_S5BIM][((l * 16 + g) * 64 + n) * 16 + q];
            bb[q] = (f32x2){cr * br - ci * bi, cr * bi + ci * br}; }
    }
    for (int i = cx.bid * NTHR + cx.tid; i < DEPTH * 6 * 256 * 64; i += cx.G * NTHR) {
        const int k = i & 63, n = (i >> 6) & 255, g = (i >> 14) % 6, l = (i >> 14) / 6;
        const int j = n & 63, type = (n >> 6) & 1, dir = n >> 7;
        const float* w = type ? P.in[I_RGWX] : P.in[I_RGWA];
        WSP(bf16_t, WS_WRG)[i] = f2bf(w[((((size_t)l * 2 + dir) * 6 + g) * 64 + k) * 64 + j]);
    }
    for (int i = cx.bid * NTHR + cx.tid; i < DEPTH * NP; i += cx.G * NTHR) {
        const int n = i % NP, l = i / NP; const int sc = n < 1536 ? n : n + 16;
        WSP(float, WS_BIN2)[i] = P.in[I_BIN][l * DIN + sc] * ((n >= 384 && n < 768) ? 0.10206207261596577f : 1.0f);
    }
    for (int i = cx.bid * NTHR + cx.tid; i < DEPTH * 16 * 1024; i += cx.G * NTHR) { const int k = i & 1023, n = (i >> 10) & 15, l = i >> 14;
        WSP(bf16_t, WS_WGT)[i] = f2bf(P.in[I_WIN][((size_t)l * 1024 + k) * DIN + 1536 + n]); }
    for (int i = cx.bid * NTHR + cx.tid; i < DEPTH * 32 * 1024; i += cx.G * NTHR) { const int k = i & 1023, n = (i >> 10) & 31, l = i >> 15;
        const float w = P.in[I_RW][((size_t)l * 1024 + k) * 32 + n]; const bf16_t hi = f2bf(w);
        WSP(bf16_t, WS_RWH)[i] = hi; WSP(bf16_t, WS_RWL)[i] = f2bf(w - bf2f(hi)); }
    for (int i = cx.bid * NTHR + cx.tid; i < DEPTH * 256 * 256; i += cx.G * NTHR) {
        const int k = i & 255, n = (i >> 8) & 255, l = i >> 16;
        WSP(bf16_t, WS_WGLU)[i] = f2bf(P.in[I_S5GW][((size_t)l * 256 + k) * 256 + n]);
    }
}

DEVI void ph_pro_b(const Ctx& cx) {
    const Params& P = *cx.p;
    LAS f32x2* pw = (LAS f32x2*)cx.lds;
    LAS f32x2* bb = pw + 64 * 33;
    LAS f32x2* cc = bb + 64 * 16;
    for (int u = cx.bid; u < DEPTH * 16 * 2; u += cx.G) {
        const int lg = u >> 1;
        for (int i = cx.tid; i < 64 * 33; i += NTHR) pw[i] = WSP(f32x2, WS_PW)[(size_t)u * 64 * 33 + i];
        for (int i = cx.tid; i < 64 * 16; i += NTHR) bb[i] = WSP(f32x2, WS_BB)[(size_t)u * 64 * 16 + i];
        for (int i = cx.tid; i < 16 * 64; i += NTHR) cc[i] = (f32x2){P.in[I_S5CRE][(size_t)lg * 1024 + i], P.in[I_S5CIM][(size_t)lg * 1024 + i]};
        __syncthreads();
        const int q = cx.tid & 15, p = (cx.tid >> 4) & 15, tau0 = cx.tid >> 8;
        float acc[16];
#pragma unroll
        for (int i = 0; i < 16; ++i) acc[i] = 0.f;
#pragma unroll 2
        for (int n = 0; n < 64; ++n) { const f32x2 b = bb[n * 16 + q], c = cc[p * 64 + n];
#pragma unroll
            for (int i = 0; i < 16; ++i) { const f32x2 a = pw[n * 33 + tau0 + 2 * i]; const float xr = c.x * a.x - c.y * a.y, xi = c.x * a.y + c.y * a.x; acc[i] += xr * b.x - xi * b.y; } }
#pragma unroll
        for (int i = 0; i < 16; ++i) WSP(float, WS_KT)[(((size_t)u * 32 + tau0 + 2 * i) * 16 + p) * 16 + q] = acc[i];
        __syncthreads();
    }
}

DEVI void ph_pro_c(const Ctx& cx) {
    const Params& P = *cx.p;
    LAS float* kt = (LAS float*)cx.lds;
    LAS f32x2* pw = (LAS f32x2*)(kt + 2 * 32 * 256);
    LAS f32x2* bb = pw + 2 * 64 * 33;
    LAS f32x2* cc = bb + 2 * 64 * 16;
    LAS float* dsk = (LAS float*)(cc + 16 * 64);
    for (int u = cx.bid; u < DEPTH * 16 * 4; u += cx.G) {
        const int lg = u >> 2, qt = u & 3, l = lg >> 4, g = lg & 15;
        for (int i = cx.tid; i < 2 * 32 * 256; i += NTHR) kt[i] = WSP(float, WS_KT)[(size_t)lg * 2 * 32 * 256 + i];
        for (int i = cx.tid; i < 2 * 64 * 33; i += NTHR) pw[i] = WSP(f32x2, WS_PW)[(size_t)lg * 2 * 64 * 33 + i];
        for (int i = cx.tid; i < 2 * 64 * 16; i += NTHR) bb[i] = WSP(f32x2, WS_BB)[(size_t)lg * 2 * 64 * 16 + i];
        for (int i = cx.tid; i < 16 * 64; i += NTHR) cc[i] = (f32x2){P.in[I_S5CRE][(size_t)lg * 1024 + i], P.in[I_S5CIM][(size_t)lg * 1024 + i]};
        if (cx.tid < 16) dsk[cx.tid] = P.in[I_S5D][l * 256 + g * 16 + cx.tid];
        __syncthreads();
        bf16_t* wy = WSP(bf16_t, WS_WY) + ((size_t)lg * 512 + qt * 128) * 768;
        for (int idx = cx.tid; idx < 128 * 768; idx += NTHR) {
            const int k = idx % 768, tp = qt * 128 + idx / 768, t = tp >> 4, p = tp & 15;
            float v;
            if (k < 512) { const int sI = k >> 4, q = k & 15; v = 0.f;
                if (sI <= t) v += kt[(0 * 32 + (t - sI)) * 256 + p * 16 + q];
                if (sI >= t) v += kt[(1 * 32 + (sI - t)) * 256 + p * 16 + q];
                if (sI == t && p == q) v += dsk[p];
            } else { const int kk = k - 512, d = kk >> 7, im = (kk >> 6) & 1, n = kk & 63;
                const int pwr = d == 0 ? t + 1 : 32 - t;
                const f32x2 a = pw[(d * 64 + n) * 33 + pwr], c = cc[p * 64 + n];
                v = im ? -(c.x * a.y + c.y * a.x) : (c.x * a.x - c.y * a.y); }
            wy[idx] = f2bf(v);
        }
        bf16_t* we = WSP(bf16_t, WS_WE) + ((size_t)lg * 256 + qt * 64) * 512;
        for (int idx = cx.tid; idx < 64 * 512; idx += NTHR) {
            const int k = idx & 511, no = qt * 64 + (idx >> 9);
            const int sI = k >> 4, q = k & 15, d = no >> 7, im = (no >> 6) & 1, n = no & 63;
            const int pwr = d == 0 ? 31 - sI : sI;
            const f32x2 a = pw[(d * 64 + n) * 33 + pwr], b2 = bb[(d * 64 + n) * 16 + q];
            we[idx] = f2bf(im ? (a.x * b2.y + a.y * b2.x) : (a.x * b2.x - a.y * b2.y));
        }
        __syncthreads();
    }
}

DEVI void moe_info(const Ctx& cx, int l, LAS int* info) {
    if (cx.tid < 64) {
        const unsigned* cnt = (const unsigned*)(cx.ws + WS_CTL) + CW_CNT + l * 32;
        const int c = cx.lane < 32 ? (int)__hip_atomic_load(cnt + (cx.lane & 31), __ATOMIC_RELAXED, __HIP_MEMORY_SCOPE_AGENT) : 0;
        const int nt = (c + 255) >> 8;
        if (cx.lane < 32) { info[72 + cx.lane] = nt; info[40 + cx.lane] = c; }
        if (cx.lane == 0) { int run = 0; info[0] = 0; for (int e = 0; e < 32; ++e) { run += info[72 + e]; info[e + 1] = run; } }
    }
    __syncthreads();
    if (cx.tid < 32) { const int lo = info[cx.tid], hi = info[cx.tid + 1]; for (int t = lo; t < hi; ++t) info[112 + t] = cx.tid;
    }
    __syncthreads();
}

DEVI void block_rows_visible() {
    asm volatile("s_waitcnt vmcnt(0)" ::: "memory");
    __syncthreads();
}
DEVI void ph_norm1(const Ctx& cx, int l) {
    const Params& P = *cx.p;
    LAS int* info = (LAS int*)cx.lds;
    LAS float* part = (LAS float*)(cx.lds + 4096);
    if (l > 0) moe_info(cx, l - 1, info);
    const int rbeg = (l == DEPTH) ? TCTX : 0, nr = TT - rbeg;
    const int rpb = (nr + cx.G - 1) / cx.G, rb = rbeg + cx.bid * rpb, re = min(TT, rb + rpb);
    const float* modp = WSP(float, WS_MOD);
    const int c0 = 4 * cx.lane;
    for (int r2 = rb + cx.wave; r2 < re; r2 += 16) {
        f32x4 x[2][4]; bool ok[2];
#pragma unroll
        for (int u = 0; u < 2; ++u) { const int row = r2 + 8 * u; ok[u] = row < re; const int rw_ = ok[u] ? row : r2;
            if (l == 0) { const float* src = rw_ < TCTX ? P.in[I_CTX] + (size_t)rw_ * 1024 : P.in[I_X] + (size_t)(rw_ - TCTX) * 1024;
#pragma unroll
                for (int i = 0; i < 4; ++i) x[u][i] = *(const f32x4*)(src + c0 + 256 * i);
            } else {
                const float* src = WSP(float, WS_XMID) + (size_t)rw_ * 1024;
                const float* g2 = modp + ((size_t)(l - 1) * 9 + mod_row(rw_)) * 6144 + 5120;
                const int* ti = WSP(int, WS_TINFO) + (size_t)rw_ * 4;
                f32x4 y[4];
#pragma unroll
                for (int i = 0; i < 4; ++i) y[i] = (f32x4){0.f, 0.f, 0.f, 0.f};
#pragma unroll
                for (int k = 0; k < 4; ++k) { const int t = ti[k]; const int e = t >> 20, slot = t & 0xFFFFF;
                    const bf16_t* yp = WSP(bf16_t, WS_YPAD) + ((size_t)info[e] * 256 + slot) * 1024;
#pragma unroll
                    for (int i = 0; i < 4; ++i) { const u32x2 w = *(const u32x2*)(yp + c0 + 256 * i);
                        y[i][0] += __uint_as_float(w.x << 16); y[i][1] += __uint_as_float(w.x & 0xFFFF0000u); y[i][2] += __uint_as_float(w.y << 16); y[i][3] += __uint_as_float(w.y & 0xFFFF0000u); } }
#pragma unroll
                for (int i = 0; i < 4; ++i) { const f32x4 xv = *(const f32x4*)(src + c0 + 256 * i), gv = *(const f32x4*)(g2 + c0 + 256 * i); x[u][i] = xv + gv * y[i]; }
            }
        }
#pragma unroll
        for (int u = 0; u < 2; ++u) {
            const int row = r2 + 8 * u;
            float ss = 0.f;
#pragma unroll
            for (int i = 0; i < 4; ++i) ss += (x[u][i][0] * x[u][i][0] + x[u][i][1] * x[u][i][1]) + (x[u][i][2] * x[u][i][2] + x[u][i][3] * x[u][i][3]);
            ss = wave_sum(ss, 0);
            const float rstd = rsqrtf(ss * (1.0f / 1024.0f) + EPS);
            if (!ok[u]) continue;
            if (l == DEPTH) { float* o = P.out + (size_t)(row - TCTX) * 1024;
#pragma unroll
                for (int i = 0; i < 4; ++i) { const f32x4 fw = *(const f32x4*)(P.in[I_FNW] + c0 + 256 * i); *(f32x4*)(o + c0 + 256 * i) = x[u][i] * rstd * fw; }
                continue; }
            float* xs = WSP(float, WS_XS) + (size_t)row * 1024;
            const float* md = modp + ((size_t)l * 9 + mod_row(row)) * 6144;
            bf16_t* hp = WSP(bf16_t, WS_H) + (size_t)row * 1024;
#pragma unroll
            for (int i = 0; i < 4; ++i) { const int c = c0 + 256 * i;
                *(f32x4*)(xs + c) = x[u][i];
                const f32x4 nw = *(const f32x4*)(P.in[I_N1W] + l * 1024 + c), sc = *(const f32x4*)(md + 1024 + c), sh = *(const f32x4*)(md + c);
                const f32x4 h = x[u][i] * rstd * nw * (sc + 1.0f) + sh;
                u32x2 w; w.x = pk_bf16(h[0], h[1]); w.y = pk_bf16(h[2], h[3]); *(u32x2*)(hp + c) = w; }
        }
    }
    if (l == DEPTH) return;
    block_rows_visible();
    const int nrow = re - rb, ntile = (nrow + 15) / 16;
    for (int it = cx.wave; it < ntile * 4; it += 8) {
        const int t = it >> 2, kq = it & 3, fr = cx.lane & 15, fq = cx.lane >> 4; const int row = min(rb + t * 16 + fr, re - 1);
        const bf16_t* hp = WSP(bf16_t, WS_H) + (size_t)row * 1024 + kq * 256 + fq * 8;
        const bf16_t* wp = WSP(bf16_t, WS_WGT) + ((size_t)l * 16 + fr) * 1024 + kq * 256 + fq * 8;
        f32x4 acc = (f32x4){0.f, 0.f, 0.f, 0.f};
        bf16x8 af[8], wf[8];
#pragma unroll
        for (int k = 0; k < 8; ++k) { af[k] = ldg8(hp + 32 * k); wf[k] = ldg8(wp + 32 * k); }
        __builtin_amdgcn_sched_barrier(0);
#pragma unroll
        for (int k = 0; k < 8; ++k) acc = __builtin_amdgcn_mfma_f32_16x16x32_bf16(wf[k], af[k], acc, 0, 0, 0);
        __builtin_amdgcn_sched_barrier(0);
        *(LAS f32x4*)(part + ((kq * 128) + t * 16 + fr) * 16 + 4 * fq) = acc;
    }
    __syncthreads();
    for (int i = cx.tid; i < nrow * 16; i += NTHR) { const int rl = i >> 4, gi = i & 15;
        WSP(float, WS_GT)[(size_t)(rb + rl) * 16 + gi] = (part[(0 * 128 + rl) * 16 + gi] + part[(1 * 128 + rl) * 16 + gi]) + (part[(2 * 128 + rl) * 16 + gi] + part[(3 * 128 + rl) * 16 + gi]) + P.in[I_BIN][l * DIN + 1536 + gi]; }
}

DEVI void ph_norm2(const Ctx& cx, int l) {
    const Params& P = *cx.p;
    LAS float* lgs = (LAS float*)cx.lds;
    LAS int* hist = (LAS int*)(cx.lds + 4 * 128 * 33 * 4);
    LAS int* pend = hist + 64;
    if (cx.tid < 64) hist[cx.tid] = 0;
    const int r0 = (l == DEPTH - 1) ? TCTX : 0, nr = TT - r0;
    const int rpb = (nr + cx.G - 1) / cx.G;
    const int rb = r0 + cx.bid * rpb, re = min(TT, rb + rpb);
    const float* modp = WSP(float, WS_MOD);
    const int c0 = 4 * cx.lane;
    for (int r2 = rb + cx.wave; r2 < re; r2 += 16) {
        f32x4 x[2][4]; bool ok[2];
#pragma unroll
        for (int u = 0; u < 2; ++u) { const int row = r2 + 8 * u; ok[u] = row < re; const float* src = WSP(float, WS_XMID) + (size_t)(ok[u] ? row : r2) * 1024;
#pragma unroll
            for (int i = 0; i < 4; ++i) x[u][i] = *(const f32x4*)(src + c0 + 256 * i); }
#pragma unroll
        for (int u = 0; u < 2; ++u) {
            const int row = r2 + 8 * u;
            float ss = 0.f;
#pragma unroll
            for (int i = 0; i < 4; ++i) ss += (x[u][i][0] * x[u][i][0] + x[u][i][1] * x[u][i][1]) + (x[u][i][2] * x[u][i][2] + x[u][i][3] * x[u][i][3]);
            ss = wave_sum(ss, 0);
            const float rstd = rsqrtf(ss * (1.0f / 1024.0f) + EPS);
            if (!ok[u]) continue;
            const float* md = modp + ((size_t)l * 9 + mod_row(row)) * 6144;
            bf16_t* hp = WSP(bf16_t, WS_H) + (size_t)row * 1024; bf16_t* hl = WSP(bf16_t, WS_HLO) + (size_t)row * 1024; unsigned char* h8 = WSP(unsigned char, WS_H8) + (size_t)row * 1024;
#pragma unroll
            for (int i = 0; i < 4; ++i) { const int c = c0 + 256 * i;
                const f32x4 nw = *(const f32x4*)(P.in[I_N2W] + l * 1024 + c), sc = *(const f32x4*)(md + 4096 + c), sh = *(const f32x4*)(md + 3072 + c);
                const f32x4 h = x[u][i] * rstd * nw * (sc + 1.0f) + sh;
                const int p8 = (int)pk4_fp8(h[0], h[1], h[2], h[3]);
                const float q0 = __builtin_amdgcn_cvt_f32_fp8(p8, 0), q1 = __builtin_amdgcn_cvt_f32_fp8(p8, 1), q2 = __builtin_amdgcn_cvt_f32_fp8(p8, 2), q3 = __builtin_amdgcn_cvt_f32_fp8(p8, 3);
                *(int*)(h8 + c) = p8;
                u32x2 wh; wh.x = pk_bf16(q0, q1); wh.y = pk_bf16(q2, q3); *(u32x2*)(hp + c) = wh;
                u32x2 wl; wl.x = pk_bf16(h[0] - q0, h[1] - q1); wl.y = pk_bf16(h[2] - q2, h[3] - q3); *(u32x2*)(hl + c) = wl; }
        }
    }
    block_rows_visible();
    const int nrow = re - rb, ntile = (nrow + 15) / 16;
    for (int it = cx.wave; it < ntile * 8; it += 8) {
        const int t = it >> 3, nt = (it >> 2) & 1, kq = it & 3, fr = cx.lane & 15, fq = cx.lane >> 4; const int row = min(rb + t * 16 + fr, re - 1);
        const bf16_t* hp = WSP(bf16_t, WS_H) + (size_t)row * 1024 + kq * 256 + fq * 8; const bf16_t* hl = WSP(bf16_t, WS_HLO) + (size_t)row * 1024 + kq * 256 + fq * 8;
        const bf16_t* wh = WSP(bf16_t, WS_RWH) + ((size_t)l * 32 + nt * 16 + fr) * 1024 + kq * 256 + fq * 8; const bf16_t* wl = WSP(bf16_t, WS_RWL) + ((size_t)l * 32 + nt * 16 + fr) * 1024 + kq * 256 + fq * 8;
        f32x4 acc = (f32x4){0.f, 0.f, 0.f, 0.f}, acc2 = (f32x4){0.f, 0.f, 0.f, 0.f};
        bf16x8 ah[8], al[8], bh[8], bl[8];
#pragma unroll
        for (int k = 0; k < 8; ++k) { ah[k] = ldg8(hp + 32 * k); al[k] = ldg8(hl + 32 * k); bh[k] = ldg8(wh + 32 * k); bl[k] = ldg8(wl + 32 * k); }
        __builtin_amdgcn_sched_barrier(0);
#pragma unroll
        for (int k = 0; k < 8; ++k) {
            acc = __builtin_amdgcn_mfma_f32_16x16x32_bf16(bh[k], ah[k], acc, 0, 0, 0);
            acc2 = __builtin_amdgcn_mfma_f32_16x16x32_bf16(bl[k], ah[k], acc2, 0, 0, 0);
            acc2 = __builtin_amdgcn_mfma_f32_16x16x32_bf16(bh[k], al[k], acc2, 0, 0, 0); }
        __builtin_amdgcn_sched_barrier(0);
        const int rl = t * 16 + fr;
#pragma unroll
        for (int j = 0; j < 4; ++j) lgs[(kq * 128 + rl) * 33 + nt * 16 + 4 * fq + j] = acc[j] + acc2[j];
    }
    __syncthreads();
    if (cx.tid < nrow) {
        float lg[32];
#pragma unroll
        for (int e = 0; e < 32; ++e) lg[e] = (lgs[(0 * 128 + cx.tid) * 33 + e] + lgs[(1 * 128 + cx.tid) * 33 + e]) + (lgs[(2 * 128 + cx.tid) * 33 + e] + lgs[(3 * 128 + cx.tid) * 33 + e]) + P.in[I_RB][l * 32 + e];
        float tv[4]; int tix[4]; unsigned taken = 0u;
#pragma unroll
        for (int k = 0; k < 4; ++k) { float bv = -3.0e38f; int bi = 0;
#pragma unroll
            for (int e = 0; e < 32; ++e) { const bool better = (lg[e] > bv) && !((taken >> e) & 1u); bv = better ? lg[e] : bv; bi = better ? e : bi; }
            tv[k] = bv; tix[k] = bi; taken |= 1u << bi; }
        const float e1 = __expf(tv[1] - tv[0]), e2 = __expf(tv[2] - tv[0]), e3 = __expf(tv[3] - tv[0]);
        const float inv = 1.0f / (1.0f + e1 + e2 + e3);
        const float gk[4] = {inv, e1 * inv, e2 * inv, e3 * inv};
#pragma unroll
        for (int k = 0; k < 4; ++k) {
            const int ls = __hip_atomic_fetch_add((LAS int*)(hist + tix[k]), 1, __ATOMIC_RELAXED, __HIP_MEMORY_SCOPE_WORKGROUP);
            pend[(cx.tid * 4 + k) * 2 + 0] = (tix[k] << 20) | ls;
            pend[(cx.tid * 4 + k) * 2 + 1] = __float_as_int(gk[k]); }
    }
    __syncthreads();
    if (cx.tid < 32) { unsigned* cnt = (unsigned*)(cx.ws + WS_CTL) + CW_CNT + l * 32;
        hist[32 + cx.tid] = hist[cx.tid] > 0 ? (int)__hip_atomic_fetch_add(cnt + cx.tid, (unsigned)hist[cx.tid], __ATOMIC_RELAXED, __HIP_MEMORY_SCOPE_AGENT) : 0; }
    __syncthreads();
    for (int i = cx.tid; i < nrow * 4; i += NTHR) {
        const int t = pend[i * 2], e = t >> 20, slot = hist[32 + e] + (t & 0xFFFFF), row = rb + (i >> 2);
        WSP(int, WS_ELIST)[(size_t)e * TT + slot] = row;
        WSP(float, WS_GLIST)[(size_t)e * TT + slot] = __int_as_float(pend[i * 2 + 1]);
        WSP(int, WS_TINFO)[(size_t)row * 4 + (i & 3)] = (e << 20) | slot;
    }
}

DEVI int xcd_contig(int bid, int G) { return (G % 8 == 0) ? (bid % 8) * (G / 8) + bid / 8 : bid; }

struct DenseSched {
    const char* A; const char* B; int nM, nN, pm0, G, bid;
    DEVI bool get(int i, g1::Unit& u) const {
        int pm, pn;
        if (G % 8 == 0) { const int x = bid & 7, r = bid >> 3, nx = G >> 3, lo = (nM * x) >> 3, hi = (nM * (x + 1)) >> 3, nr = hi - lo;
            const int q = i * nx + r; if (nr <= 0 || q >= nr * nN) return false; pm = lo + q % nr; pn = q / nr; }
        else { const int L = i * G + bid; if (L >= nM * nN) return false; pm = L / nN; pn = L % nN; }
        u.A = A + (size_t)(pm0 + pm) * 256 * 2048; u.list = nullptr; u.nvalid = 256; u.B = B + (size_t)pn * 256 * 2048; u.pm = pm0 + pm; u.pn = pn; u.e = 0;
        return true;
    }
};
struct MoeSched {
    const char* A; const char* B; const int* elist; const LAS int* info; int NPN, gather, G, bid; size_t bstride; int kb;
    DEVI int rd(int i) const { return __builtin_amdgcn_readfirstlane(info[i]); }
    DEVI bool get(int i, g1::Unit& u) const {
        const int NTt = rd(32); int T, pn;
        if (G % 8 == 0 && (G >> 3) % NPN == 0) { const int x = bid & 7, r = bid >> 3, nx = G >> 3, RT = nx / NPN, lo = (NTt * x) >> 3, hi = (NTt * (x + 1)) >> 3;
            T = lo + i * RT + r % RT; pn = r / RT; if (T >= hi) return false; }
        else { const int L = i * G + bid; if (L >= NTt * NPN) return false; T = L / NPN; pn = L % NPN; }
        const int e = rd(112 + T), j = T - rd(e);
        u.pm = T; u.pn = pn; u.e = e;
        u.B = B + (size_t)e * bstride + (size_t)pn * 256 * kb;
        if (gather) { u.A = A; u.list = elist + (size_t)e * TT + j * 256; u.nvalid = rd(40 + e) - j * 256; }
        else { u.A = A + (size_t)T * 256 * kb; u.list = nullptr; u.nvalid = 256; }
        return true;
    }
};

struct EpiIn {
    static constexpr bool PERM = true;
    bf16_t* Pout; const float* bias;
    DEVI void operator()(const f32x4 (&acc)[2][2][4][2], const g1::Unit& u, int wr, int wc, int fr, int fq) const {
        const int row0 = u.pm * 256 + wr * 64 + fr;
#pragma unroll
        for (int bj = 0; bj < 2; ++bj) {
            const int col0 = u.pn * 256 + bj * 128 + wc * 32 + 8 * fq;
            const int seg = u.pn * 2 + bj; const bool gl = (seg >= 15 && seg < 18);
            const f32x4 b0 = *(const f32x4*)(bias + col0), b1 = *(const f32x4*)(bias + col0 + 4);
#pragma unroll
            for (int ai = 0; ai < 2; ++ai)
#pragma unroll
                for (int m = 0; m < 4; ++m) {
                    f32x4 v0 = acc[ai][bj][m][0] + b0, v1 = acc[ai][bj][m][1] + b1;
                    if (gl) {
#pragma unroll
                        for (int j = 0; j < 4; ++j) { v0[j] = gelu_tanh(v0[j]); v1[j] = gelu_tanh(v1[j]); } }
                    u32x4 w; w.x = pk_bf16(v0[0], v0[1]); w.y = pk_bf16(v0[2], v0[3]); w.z = pk_bf16(v1[0], v1[1]); w.w = pk_bf16(v1[2], v1[3]);
                    *(u32x4*)(Pout + (size_t)(row0 + ai * 128 + m * 16) * NP + col0) = w;
                }
        }
    }
};
struct EpiOut {
    static constexpr bool PERM = false;
    const float* xs; float* xmid; const float* mod;
    DEVI void operator()(const f32x4 (&acc)[2][2][4][2], const g1::Unit& u, int wr, int wc, int fr, int fq) const {
        const int row0 = u.pm * 256 + wr * 64 + fr;
        const float* g1p = mod + (size_t)mod_row(u.pm * 256) * 6144 + 2048;
#pragma unroll
        for (int bj = 0; bj < 2; ++bj)
#pragma unroll
            for (int n = 0; n < 2; ++n) {
                const int col = u.pn * 256 + bj * 128 + wc * 32 + 16 * n + 4 * fq;
                const f32x4 gv = *(const f32x4*)(g1p + col);
#pragma unroll
                for (int ai = 0; ai < 2; ++ai)
#pragma unroll
                    for (int m = 0; m < 4; ++m) {
                        const size_t off = (size_t)(row0 + ai * 128 + m * 16) * 1024 + col;
                        const f32x4 xv = *(const f32x4*)(xs + off);
                        *(f32x4*)(xmid + off) = xv + gv * acc[ai][bj][m][n];
                    }
            }
    }
};
struct EpiGU {
    static constexpr bool PERM = true;
    unsigned char* act; const float* bgu;
    DEVI void operator()(const f32x4 (&acc)[2][2][4][2], const g1::Unit& u, int wr, int wc, int fr, int fq) const {
        const int row0 = u.pm * 256 + wr * 64 + fr, colh = u.pn * 128 + wc * 32 + 8 * fq;
        const float* bg = bgu + (size_t)u.e * 2048 + colh; const float* bu = bg + 1024;
        const f32x4 bg0 = *(const f32x4*)bg, bg1 = *(const f32x4*)(bg + 4), bu0 = *(const f32x4*)bu, bu1 = *(const f32x4*)(bu + 4);
#pragma unroll
        for (int ai = 0; ai < 2; ++ai)
#pragma unroll
            for (int m = 0; m < 4; ++m) {
                float o[8];
#pragma unroll
                for (int n = 0; n < 2; ++n)
#pragma unroll
                    for (int j = 0; j < 4; ++j) {
                        const float g = fminf(acc[ai][0][m][n][j] * W8_INV + (n ? bg1[j] : bg0[j]), 7.0f);
                        const float up = fminf(fmaxf(acc[ai][1][m][n][j] * W8_INV + (n ? bu1[j] : bu0[j]), -7.0f), 7.0f);
                        o[n * 4 + j] = (up + 1.0f) * g * frcp(1.0f + __expf(-1.702f * g));
                    }
                u32x2 w; w.x = pk4_fp8(o[0], o[1], o[2], o[3]); w.y = pk4_fp8(o[4], o[5], o[6], o[7]);
                *(u32x2*)(act + (size_t)(row0 + ai * 128 + m * 16) * 1024 + colh) = w;
            }
    }
};
struct EpiDown {
    static constexpr bool PERM = true;
    bf16_t* ypad; const float* bd; const float* glist; const LAS int* info;
    DEVI void operator()(const f32x4 (&acc)[2][2][4][2], const g1::Unit& u, int wr, int wc, int fr, int fq) const {
        const int j256 = (u.pm - __builtin_amdgcn_readfirstlane(info[u.e])) * 256, cnt = __builtin_amdgcn_readfirstlane(info[40 + u.e]);
        const int rl0 = wr * 64 + fr;
#pragma unroll
        for (int ai = 0; ai < 2; ++ai)
#pragma unroll
            for (int m = 0; m < 4; ++m) {
                const int rl = rl0 + ai * 128 + m * 16, slot = j256 + rl;
                const float gt = slot < cnt ? glist[(size_t)u.e * TT + slot] : 0.f;
#pragma unroll
                for (int bj = 0; bj < 2; ++bj) {
                    const int col0 = u.pn * 256 + bj * 128 + wc * 32 + 8 * fq;
                    const f32x4 b0 = *(const f32x4*)(bd + (size_t)u.e * 1024 + col0), b1 = *(const f32x4*)(bd + (size_t)u.e * 1024 + col0 + 4);
                    const f32x4 v0 = (acc[ai][bj][m][0] * W8_INV + b0) * gt, v1 = (acc[ai][bj][m][1] * W8_INV + b1) * gt;
                    u32x4 w; w.x = pk_bf16(v0[0], v0[1]); w.y = pk_bf16(v0[2], v0[3]); w.z = pk_bf16(v1[0], v1[1]); w.w = pk_bf16(v1[2], v1[3]);
                    *(u32x4*)(ypad + (size_t)(u.pm * 256 + rl) * 1024 + col0) = w;
                }
            }
    }
};

DEVI void ph_inproj(const Ctx& cx, int l) {
    DenseSched S{(const char*)WSP(bf16_t, WS_H), (const char*)(WSP(bf16_t, WS_WIN) + (size_t)l * NP * 1024), TT / 256, NP / 256, 0, cx.G, cx.bid};
    EpiIn E{WSP(bf16_t, WS_P), WSP(float, WS_BIN2) + (size_t)l * NP};
    g1::gemm_phase<DenseSched, EpiIn, false>(cx.lds, cx.tid, S, E);
}
DEVI void ph_outproj(const Ctx& cx, int l) {
    const int pm0 = (l == DEPTH - 1) ? TCTX / 256 : 0;
    DenseSched S{(const char*)WSP(bf16_t, WS_MRG), (const char*)(WSP(bf16_t, WS_WOUT) + (size_t)l * 1024 * 1024), TT / 256 - pm0, 4, pm0, cx.G, cx.bid};
    EpiOut E{WSP(float, WS_XS), WSP(float, WS_XMID), WSP(float, WS_MOD) + (size_t)l * 9 * 6144};
    g1::gemm_phase<DenseSched, EpiOut, false>(cx.lds, cx.tid, S, E);
}
DEVI void ph_moe_gu(const Ctx& cx, int l) {
    LAS int* info = (LAS int*)(cx.lds + g1::STAGE_BYTES);
    moe_info(cx, l, info);
    MoeSched S{(const char*)WSP(unsigned char, WS_H8), (const char*)(WSP(unsigned char, WS_WGU) + (size_t)l * NE * 2048 * 1024), WSP(int, WS_ELIST), info, 8, 1, cx.G, cx.bid, (size_t)2048 * 1024, 1024};
    EpiGU E{WSP(unsigned char, WS_ACT), cx.p->in[I_BGU] + (size_t)l * NE * 2048};
    g1::gemm_phase<MoeSched, EpiGU, true, true>(cx.lds, cx.tid, S, E);
}
DEVI void ph_moe_dn(const Ctx& cx, int l) {
    LAS int* info = (LAS int*)(cx.lds + g1::STAGE_BYTES);
    moe_info(cx, l, info);
    MoeSched S{(const char*)WSP(unsigned char, WS_ACT), (const char*)(WSP(unsigned char, WS_WD) + (size_t)l * NE * 1024 * 1024), nullptr, info, 4, 0, cx.G, cx.bid, (size_t)1024 * 1024, 1024};
    EpiDown E{WSP(bf16_t, WS_YPAD), cx.p->in[I_BD] + (size_t)l * NE * 1024, WSP(float, WS_GLIST), info};
    g1::gemm_phase<MoeSched, EpiDown, false, true>(cx.lds, cx.tid, S, E);
}

DEVI int ml_row0(int b, int c) { return c < 2 ? b * CTXL + c * 128 : TCTX + b * SEQ + (c - 2) * 128; }
DEVI unsigned short lds_u16(const LAS bf16_t* p) { return *p; }

DEVI void ml_local_unit(const Ctx& cx, int l, int b, int h, int c) {
    LAS float* sg = (LAS float*)cx.lds;
    LAS float* se = sg + 256;
    LAS float* red = se + 256;
    LAS bf16_t* Ks = (LAS bf16_t*)(cx.lds + 4352);
    LAS bf16_t* Ve = Ks + 128 * 104;
    const int row0 = ml_row0(b, c), tid = cx.tid;
    const int dir = (tid >> 7) & 1, i = tid & 127, p = dir ? 127 - i : i;
    const bool act = tid < 256;
    float gi = 0.f, bval = 0.f, u = 0.f;
    if (act) { const float* gt = WSP(float, WS_GT) + (size_t)(row0 + i) * 16; gi = gt[dir * 4 + h]; const float gf = gt[8 + dir * 4 + h];
        sg[dir * 128 + p] = fminf(gf, 0.f) - log1p_(__expf(-fabsf(gf))); }
    LDS_SYNC();
#pragma unroll 1
    for (int off = 1; off < 128; off <<= 1) { float v = 0.f; if (act) { v = sg[dir * 128 + p]; if (p >= off) v += sg[dir * 128 + p - off]; } LDS_SYNC(); if (act) sg[dir * 128 + p] = v; LDS_SYNC(); }
    if (act) { bval = sg[dir * 128 + p]; u = gi - bval; if (p == 127) red[dir] = bval; }
    LDS_SYNC();
    if (act) sg[dir * 128 + p] = u;
    LDS_SYNC();
#pragma unroll 1
    for (int off = 1; off < 128; off <<= 1) { float v = 0.f; if (act) { v = sg[dir * 128 + p]; if (p >= off) v = fmaxf(v, sg[dir * 128 + p - off]); } LDS_SYNC(); if (act) sg[dir * 128 + p] = v; LDS_SYNC(); }
    if (act) { const float cm = sg[dir * 128 + p]; if (p == 127) red[2 + dir] = cm;
        const size_t gix = (size_t)(row0 + i) * 8 + dir * 4 + h;
        WSP(float, WS_GB)[gix] = bval; WSP(float, WS_GU)[gix] = u; WSP(float, WS_GCM)[gix] = cm; }
    LDS_SYNC();
    if (act) se[dir * 128 + i] = expf(u - red[2 + dir]);
    if (tid < 2) { float* msc = WSP(float, WS_MSC) + ((size_t)((b * 4 + h) * MLC + c) * 2 + tid) * 2; msc[0] = red[tid]; msc[1] = red[tid] + red[2 + tid]; }
    LDS_SYNC();
    const bf16_t* Pp = WSP(bf16_t, WS_P);
#pragma unroll
    for (int it = 0; it < 3; ++it) { const int idx = tid + NTHR * it, r = idx / 12, ch = idx % 12;
        const u32x4 kv = *(const u32x4*)(Pp + (size_t)(row0 + r) * NP + PC_K + h * 96 + ch * 8);
        *(LAS u32x4*)(Ks + r * 104 + ch * 8) = kv;
        const u32x4 vv = *(const u32x4*)(Pp + (size_t)(row0 + r) * NP + PC_V + h * 96 + ch * 8);
        const float e0 = se[r], e1 = se[128 + r];
        u32x4 o0, o1;
#pragma unroll
        for (int q = 0; q < 4; ++q) { const float lo = __uint_as_float(vv[q] << 16), hi = __uint_as_float(vv[q] & 0xFFFF0000u);
            o0[q] = pk_bf16(lo * e0, hi * e0); o1[q] = pk_bf16(lo * e1, hi * e1); }
        *(LAS u32x4*)(Ve + r * 104 + ch * 8) = o0; *(LAS u32x4*)(Ve + (128 + r) * 104 + ch * 8) = o1; }
    LDS_SYNC();
    {
        const int wd = cx.wave >> 2, q9 = (cx.wave & 3) * 9, fr = cx.lane & 15, fq = cx.lane >> 4;
        float* cl = WSP(float, WS_CLOC) + ((size_t)((b * 4 + h) * MLC + c) * 2 + wd) * 9216;
        const LAS bf16_t* V = Ve + wd * 128 * 104;
#pragma unroll 1
        for (int pi = q9; pi < q9 + 9; ++pi) { const int dt = pi / 6, et = pi % 6;
            f32x4 acc = (f32x4){0.f, 0.f, 0.f, 0.f};
#pragma unroll
            for (int kk = 0; kk < 4; ++kk) { bf16x8 a, bb;
#pragma unroll
                for (int j = 0; j < 8; ++j) { const int s = kk * 32 + fq * 8 + j; a[j] = (short)lds_u16(V + s * 104 + dt * 16 + fr); bb[j] = (short)lds_u16(Ks + s * 104 + et * 16 + fr); }
                acc = __builtin_amdgcn_mfma_f32_16x16x32_bf16(a, bb, acc, 0, 0, 0); }
#pragma unroll
            for (int r = 0; r < 4; ++r) cl[(dt * 16 + fq * 4 + r) * 96 + et * 16 + fr] = acc[r]; }
    }
    if (tid < 192) { const int d2 = tid / 96, e = tid % 96; float s = 0.f;
        for (int t = 0; t < 128; ++t) s += se[d2 * 128 + t] * bf2f(Ks[t * 104 + e]);
        WSP(float, WS_NLOC)[((size_t)((b * 4 + h) * MLC + c) * 2 + d2) * 96 + e] = s; }
    LDS_SYNC();
}

DEVI void ml_carry(const Ctx& cx) {
    for (int idx = cx.bid * NTHR + cx.tid; idx < 64 * 9312; idx += cx.G * NTHR) {
        const int combo = idx / 9312, el = idx % 9312, dir = combo & 1, bh = combo >> 1;
        float loc[MLC], bl[MLC], ml[MLC];
#pragma unroll
        for (int s = 0; s < MLC; ++s) {
            const int c = dir == 0 ? s : (s < 2 ? 1 - s : 19 - s);
            const size_t cb = (size_t)(bh * MLC + c) * 2 + dir;
            bl[s] = WSP(float, WS_MSC)[cb * 2]; ml[s] = WSP(float, WS_MSC)[cb * 2 + 1];
            loc[s] = el < 9216 ? WSP(float, WS_CLOC)[cb * 9216 + el] : WSP(float, WS_NLOC)[cb * 96 + el - 9216];
        }
        float Cv = 0.f, m = -1e30f;
#pragma unroll
        for (int s = 0; s < MLC; ++s) {
            const int c = dir == 0 ? s : (s < 2 ? 1 - s : 19 - s);
            const size_t cb = (size_t)(bh * MLC + c) * 2 + dir;
            if (el < 9216) WSP(bf16_t, WS_C0)[cb * 9216 + el] = f2bf(Cv); else WSP(float, WS_N0)[cb * 96 + el - 9216] = Cv;
            if (el == 0) WSP(float, WS_M0)[cb] = m;
            const float mn = fmaxf(bl[s] + m, ml[s]), a = __expf(bl[s] + m - mn), sc = __expf(ml[s] - mn);
            Cv = a * Cv + sc * loc[s]; m = mn;
        }
    }
}

DEVI void ml_out_unit(const Ctx& cx, int l, int b, int h, int c) {
    LAS bf16_t* Qs = (LAS bf16_t*)cx.lds;
    LAS bf16_t* Ks = Qs + 128 * 104;
    LAS bf16_t* Vs = Ks + 128 * 104;
    LAS bf16_t* C0s = Vs + 128 * 104;
    LAS float* gb = (LAS float*)(cx.lds + 119808);
    LAS float* gu = gb + 256;
    LAS float* gM = gu + 256;
    LAS float* n0s = gM + 256;
    LAS float* m0s = n0s + 192;
    const int row0 = ml_row0(b, c), tid = cx.tid;
    const bf16_t* Pp = WSP(bf16_t, WS_P);
    const size_t cb0 = (size_t)((b * 4 + h) * MLC + c) * 2;
#pragma unroll
    for (int it = 0; it < 3; ++it) { const int idx = tid + NTHR * it, r = idx / 12, ch = idx % 12;
        const bf16_t* rp = Pp + (size_t)(row0 + r) * NP + h * 96 + ch * 8;
        *(LAS u32x4*)(Qs + r * 104 + ch * 8) = *(const u32x4*)(rp + PC_Q);
        *(LAS u32x4*)(Ks + r * 104 + ch * 8) = *(const u32x4*)(rp + PC_K);
        *(LAS u32x4*)(Vs + r * 104 + ch * 8) = *(const u32x4*)(rp + PC_V); }
    for (int idx = tid; idx < 2 * 96 * 12; idx += NTHR) { const int d2 = idx / 1152, r = (idx % 1152) / 12, ch = idx % 12;
        *(LAS u32x4*)(C0s + (d2 * 96 + r) * 104 + ch * 8) = *(const u32x4*)(WSP(bf16_t, WS_C0) + (cb0 + d2) * 9216 + r * 96 + ch * 8); }
    if (tid < 256) { const int d2 = tid >> 7, i = tid & 127; const size_t gix = (size_t)(row0 + i) * 8 + d2 * 4 + h;
        gb[tid] = WSP(float, WS_GB)[gix]; gu[tid] = WSP(float, WS_GU)[gix];
        gM[tid] = fmaxf(WSP(float, WS_M0)[cb0 + d2], WSP(float, WS_GCM)[gix]); }
    if (tid >= 256 && tid < 448) { const int k = tid - 256; n0s[k] = WSP(float, WS_N0)[(cb0 + k / 96) * 96 + k % 96]; }
    if (tid >= 448 && tid < 450) m0s[tid - 448] = WSP(float, WS_M0)[cb0 + tid - 448];
    LDS_SYNC();
    const int w = cx.wave, fr = cx.lane & 15, fq = cx.lane >> 4, t = 16 * w + fr;
    bf16x8 qf[3];
#pragma unroll
    for (int kk = 0; kk < 3; ++kk) qf[kk] = *(const LAS bf16x8*)(Qs + t * 104 + kk * 32 + fq * 8);
    f32x4 hs[6];
#pragma unroll
    for (int n = 0; n < 6; ++n) hs[n] = (f32x4){0.f, 0.f, 0.f, 0.f};
#pragma unroll
    for (int dir = 0; dir < 2; ++dir) {
        const float Mt = gM[dir * 128 + t], bt = gb[dir * 128 + t], inter = __expf(m0s[dir] - Mt);
        f32x4 an[6];
#pragma unroll
        for (int n = 0; n < 6; ++n) an[n] = (f32x4){0.f, 0.f, 0.f, 0.f};
        float den = 0.f;
        const int Jlo = dir == 0 ? 0 : (w >> 1), Jhi = dir == 0 ? (w >> 1) : 3;
#pragma unroll 1
        for (int J = Jlo; J <= Jhi; ++J) {
            bf16x8 pf;
#pragma unroll
            for (int half = 0; half < 2; ++half) {
                const int j = 2 * J + half;
                f32x4 D = (f32x4){0.f, 0.f, 0.f, 0.f};
                const bool need = dir == 0 ? (j <= w) : (j >= w);
                if (need) {
#pragma unroll
                    for (int kk = 0; kk < 3; ++kk) { const bf16x8 kf = *(const LAS bf16x8*)(Ks + (16 * j + fr) * 104 + kk * 32 + fq * 8);
                        D = __builtin_amdgcn_mfma_f32_16x16x32_bf16(kf, qf[kk], D, 0, 0, 0); }
                }
                const f32x4 us = *(const LAS f32x4*)(gu + dir * 128 + 16 * j + 4 * fq);
                float pv[4];
#pragma unroll
                for (int r = 0; r < 4; ++r) { const int s = 16 * j + 4 * fq + r; const bool valid = need && (dir == 0 ? (s <= t) : (s >= t));
                    pv[r] = valid ? D[r] * __expf(us[r] - Mt) : 0.f; den += pv[r]; }
                pf[half * 4 + 0] = (short)f2bf(pv[0]); pf[half * 4 + 1] = (short)f2bf(pv[1]); pf[half * 4 + 2] = (short)f2bf(pv[2]); pf[half * 4 + 3] = (short)f2bf(pv[3]);
            }
#pragma unroll
            for (int n = 0; n < 6; ++n) { bf16x8 vf;
#pragma unroll
                for (int jj = 0; jj < 8; ++jj) { const int s = 32 * J + (jj < 4 ? 4 * fq + jj : 16 + 4 * fq + (jj - 4)); vf[jj] = (short)lds_u16(Vs + s * 104 + 16 * n + fr); }
                an[n] = __builtin_amdgcn_mfma_f32_16x16x32_bf16(vf, pf, an[n], 0, 0, 0); }
        }
        float nq = 0.f;
#pragma unroll
        for (int kk = 0; kk < 3; ++kk)
#pragma unroll
            for (int j = 0; j < 8; ++j) nq += n0s[dir * 96 + kk * 32 + fq * 8 + j] * bf2f((bf16_t)qf[kk][j]);
        nq += shx<16>(nq, cx.lane); nq += shx<32>(nq, cx.lane);
        den += shx<16>(den, cx.lane); den += shx<32>(den, cx.lane);
        const float dtot = den + inter * nq;
        const float inv = frcp(fmaxf(fabsf(dtot), __expf(-(Mt + bt))));
#pragma unroll
        for (int n = 0; n < 6; ++n) { f32x4 ac = (f32x4){0.f, 0.f, 0.f, 0.f};
#pragma unroll
            for (int kk = 0; kk < 3; ++kk) { const bf16x8 cf = *(const LAS bf16x8*)(C0s + (dir * 96 + 16 * n + fr) * 104 + kk * 32 + fq * 8);
                ac = __builtin_amdgcn_mfma_f32_16x16x32_bf16(cf, qf[kk], ac, 0, 0, 0); }
            hs[n] += (an[n] + ac * inter) * inv; }
    }
    float ss = 0.f;
#pragma unroll
    for (int n = 0; n < 6; ++n) ss += hs[n][0] * hs[n][0] + hs[n][1] * hs[n][1] + hs[n][2] * hs[n][2] + hs[n][3] * hs[n][3];
    ss += shx<16>(ss, cx.lane); ss += shx<32>(ss, cx.lane);
    const float rstd = rsqrtf(ss * (1.0f / 96.0f) + EPS);
    const size_t prow = (size_t)(row0 + t);
#pragma unroll
    for (int n = 0; n < 6; ++n) { const int d = 16 * n + 4 * fq;
        const u32x2 ov = *(const u32x2*)(Pp + prow * NP + PC_O + h * 96 + d);
        const f32x4 mw = *(const f32x4*)(cx.p->in[I_MIXW] + l * 1024 + h * 96 + d);
        const float o0 = __uint_as_float(ov.x << 16), o1 = __uint_as_float(ov.x & 0xFFFF0000u), o2 = __uint_as_float(ov.y << 16), o3 = __uint_as_float(ov.y & 0xFFFF0000u);
        u32x2 wv; wv.x = pk_bf16(sigmoidf_(o0) * hs[n][0] * rstd * mw[0], sigmoidf_(o1) * hs[n][1] * rstd * mw[1]);
        wv.y = pk_bf16(sigmoidf_(o2) * hs[n][2] * rstd * mw[2], sigmoidf_(o3) * hs[n][3] * rstd * mw[3]);
        *(u32x2*)(WSP(bf16_t, WS_MRG) + prow * 1024 + h * 96 + d) = wv; }
    LDS_SYNC();
}

DEVI void rg_unit(const Ctx& cx, int l, int b, int ck, int g, int mode) {
    const Params& P = *cx.p;
    LAS float* xraw = (LAS float*)cx.lds;
    LAS float* xc = (LAS float*)(cx.lds + 17408);
    LAS bf16_t* xcb = (LAS bf16_t*)(cx.lds + 33792);
    LAS float* ab = (LAS float*)(cx.lds + 43008);
    LAS float* hbuf = (LAS float*)(cx.lds + 43008 + 65536);
    const int tid = cx.tid;
    const int t0 = ck < 4 ? ck * 64 : (ck - 4) * 64, seglen = ck < 4 ? CTXL : SEQ, rowbase = ck < 4 ? b * CTXL : TCTX + b * SEQ;
    const bf16_t* Pp = WSP(bf16_t, WS_P);
    for (int idx = tid; idx < 67 * 8; idx += NTHR) { const int r = idx >> 3, c8 = idx & 7, tt = t0 - 2 + r;
        u32x4 v = (u32x4){0u, 0u, 0u, 0u};
        if (tt >= 0 && tt < seglen) v = *(const u32x4*)(Pp + (size_t)(rowbase + tt) * NP + PC_RX + g * 64 + c8 * 8);
#pragma unroll
        for (int q = 0; q < 4; ++q) { xraw[r * 64 + c8 * 8 + 2 * q] = __uint_as_float(v[q] << 16); xraw[r * 64 + c8 * 8 + 2 * q + 1] = __uint_as_float(v[q] & 0xFFFF0000u); } }
    LDS_SYNC();
#pragma unroll
    for (int it = 0; it < 8; ++it) { const int idx = tid + NTHR * it, t = idx >> 6, ch = idx & 63, cg = g * 64 + ch;
        float v = P.in[I_RGCB][l * 384 + cg];
#pragma unroll
        for (int j = 0; j < 4; ++j) v += P.in[I_RGCW][(l * 4 + j) * 384 + cg] * xraw[(t + j) * 64 + ch];
        xc[t * 64 + ch] = v; xcb[t * 72 + ch] = f2bf(v); }
    LDS_SYNC();
    {
        const int dir = cx.wave >> 2, cg4 = cx.wave & 3, fr = cx.lane & 15, fq = cx.lane >> 4;
        const bf16_t* wrg = WSP(bf16_t, WS_WRG) + (size_t)(l * 6 + g) * 256 * 64;
        f32x4 ar[4], ai[4];
#pragma unroll
        for (int m = 0; m < 4; ++m) { ar[m] = (f32x4){0.f, 0.f, 0.f, 0.f}; ai[m] = (f32x4){0.f, 0.f, 0.f, 0.f}; }
#pragma unroll
        for (int kk = 0; kk < 2; ++kk) {
            const bf16x8 br = ldg8(wrg + (size_t)((dir * 2 + 0) * 64 + cg4 * 16 + fr) * 64 + kk * 32 + fq * 8);
            const bf16x8 bi = ldg8(wrg + (size_t)((dir * 2 + 1) * 64 + cg4 * 16 + fr) * 64 + kk * 32 + fq * 8);
#pragma unroll
            for (int m = 0; m < 4; ++m) { const bf16x8 a = *(const LAS bf16x8*)(xcb + (m * 16 + fr) * 72 + kk * 32 + fq * 8);
                ar[m] = __builtin_amdgcn_mfma_f32_16x16x32_bf16(br, a, ar[m], 0, 0, 0); ai[m] = __builtin_amdgcn_mfma_f32_16x16x32_bf16(bi, a, ai[m], 0, 0, 0); }
        }
        const int ch0 = cg4 * 16 + 4 * fq, cgl = g * 64 + ch0;
        const f32x4 ba = *(const f32x4*)(P.in[I_RGBA] + (l * 2 + dir) * 384 + cgl), bx = *(const f32x4*)(P.in[I_RGBX] + (l * 2 + dir) * 384 + cgl);
        const f32x4 lam = *(const f32x4*)(P.in[I_RGLAM] + (l * 2 + dir) * 384 + cgl);
        float sp[4];
#pragma unroll
        for (int j = 0; j < 4; ++j) sp[j] = lam[j] > 0.f ? log1p_(__expf(-lam[j])) : -lam[j] + log1p_(__expf(lam[j]));
#pragma unroll
        for (int m = 0; m < 4; ++m) { const int t = m * 16 + fr; const f32x4 xv = *(const LAS f32x4*)(xc + t * 64 + ch0);
            f32x4 av, bv;
#pragma unroll
            for (int j = 0; j < 4; ++j) { const float r = frcp(1.0f + __expf(-(ar[m][j] + ba[j]))), ii = frcp(1.0f + __expf(-(ai[m][j] + bx[j])));
                const float la = -8.0f * r * sp[j], y = 2.0f * la; av[j] = __expf(la);
                const float nem1 = y > -0.02f ? -y * (1.0f + y * (0.5f + y * 0.16666667f)) : 1.0f - av[j] * av[j];
                bv[j] = sqrtf(nem1) * (ii * xv[j]); }
            *(LAS f32x4*)(ab + ((dir * 2 + 0) * 64 + t) * 64 + ch0) = av; *(LAS f32x4*)(ab + ((dir * 2 + 1) * 64 + t) * 64 + ch0) = bv; }
    }
    LDS_SYNC();
    if (tid < 128) { const int dir = tid >> 6, ch = tid & 63; const size_t ix = ((size_t)(b * RGC + ck) * 2 + dir) * 384 + g * 64 + ch;
        float hc = mode ? WSP(float, WS_RGC)[ix] : 0.f, ap = 1.0f;
        const LAS float* __restrict__ A = ab + (dir * 2 + 0) * 4096 + ch; const LAS float* __restrict__ B = ab + (dir * 2 + 1) * 4096 + ch; LAS float* __restrict__ H = hbuf + dir * 4096 + ch;
#pragma unroll 1
        for (int s0 = 0; s0 < 64; s0 += 16) { float av[16], bv[16];
#pragma unroll
            for (int j = 0; j < 16; ++j) { const int t = dir ? 63 - (s0 + j) : s0 + j; av[j] = A[t * 64]; bv[j] = B[t * 64]; }
#pragma unroll
            for (int j = 0; j < 16; ++j) { const int t = dir ? 63 - (s0 + j) : s0 + j; hc = av[j] * hc + bv[j]; ap *= av[j]; if (mode) H[t * 64] = hc; } }
        if (!mode) { WSP(float, WS_RGA)[ix] = ap; WSP(float, WS_RGB)[ix] = hc; } }
    LDS_SYNC();
    if (mode) { const int t = tid >> 3, ch0 = (tid & 7) * 8; float hv[8]; float ss = 0.f;
#pragma unroll
        for (int j = 0; j < 8; ++j) { hv[j] = hbuf[t * 64 + ch0 + j] + hbuf[4096 + t * 64 + ch0 + j]; ss += hv[j] * hv[j]; }
        ss += dpp_<0xB1, 0xF>(ss); ss += dpp_<0x4E, 0xF>(ss); ss += dpp_<0x141, 0xF>(ss);
        const float rstd = rsqrtf(ss * (1.0f / 64.0f) + EPS);
        const size_t row = (size_t)(rowbase + t0 + t);
        const u32x4 gv = *(const u32x4*)(Pp + row * NP + PC_RG + g * 64 + ch0);
        const float* mw = P.in[I_MIXW] + l * 1024 + 384 + g * 64 + ch0;
        u32x4 o;
#pragma unroll
        for (int q = 0; q < 4; ++q) { const float g0 = __uint_as_float(gv[q] << 16), g1v = __uint_as_float(gv[q] & 0xFFFF0000u);
            o[q] = pk_bf16(g0 * hv[2 * q] * rstd * mw[2 * q], g1v * hv[2 * q + 1] * rstd * mw[2 * q + 1]); }
        *(u32x4*)(WSP(bf16_t, WS_MRG) + row * 1024 + 384 + g * 64 + ch0) = o;
        LDS_SYNC(); }
}
DEVI void rg_carry(const Ctx& cx) {
    for (int idx = (cx.G - 1 - cx.bid) * NTHR + cx.tid; idx < NB * 2 * 384; idx += cx.G * NTHR) {
        const int ch = idx % 384, dir = (idx / 384) & 1, b = idx / 768;
        float A[RGC], B[RGC];
#pragma unroll
        for (int s = 0; s < RGC; ++s) { const int ck = dir == 0 ? s : (s < 4 ? 3 - s : 39 - s);
            const size_t ix = ((size_t)(b * RGC + ck) * 2 + dir) * 384 + ch; A[s] = WSP(float, WS_RGA)[ix]; B[s] = WSP(float, WS_RGB)[ix]; }
        float h = 0.f;
#pragma unroll
        for (int s = 0; s < RGC; ++s) { const int ck = dir == 0 ? s : (s < 4 ? 3 - s : 39 - s);
            const size_t ix = ((size_t)(b * RGC + ck) * 2 + dir) * 384 + ch; WSP(float, WS_RGC)[ix] = h; h = A[s] * h + B[s]; }
    }
}

DEVI int s5_trow(int rowi, int s) { const int b = rowi / S5C, c = rowi % S5C; return c < 8 ? b * CTXL + c * 32 + s : TCTX + b * SEQ + s * 64 + (c - 8); }
DEVI void s5_local_wave(const Ctx& cx, int l, int wu) {
    const int g = wu / 36, mt = (wu % 36) / 4, nt = wu % 4;
    const bf16_t* Pp = WSP(bf16_t, WS_P) + PC_S5 + g * 16;
    const bf16_t* we = WSP(bf16_t, WS_WE) + (size_t)(l * 16 + g) * 256 * 512 + (size_t)nt * 64 * 512;
    f32x4 acc[4][4];
    wave_gemm<4, 4>(cx.lane, 512, [&](int row, int k) { return ldg8(Pp + (size_t)s5_trow(mt * 64 + row, k >> 4) * NP + (k & 15)); },
                         [&](int row, int k) { return ldg8(we + (size_t)row * 512 + k); }, acc);
    const int fr = cx.lane & 15, fq = cx.lane >> 4;
#pragma unroll
    for (int m = 0; m < 4; ++m)
#pragma unroll
        for (int n = 0; n < 4; ++n) *(f32x4*)(WSP(float, WS_SLOC) + ((size_t)g * S5R + mt * 64 + m * 16 + fr) * 256 + nt * 64 + n * 16 + 4 * fq) = acc[m][n];
}
DEVI void s5_carry(const Ctx& cx, int l) {
    for (int idx = cx.bid * NTHR + cx.tid; idx < NB * 16 * 2 * 64; idx += cx.G * NTHR) {
        const int n = idx & 63, d = (idx >> 6) & 1, g = (idx >> 7) & 15, b = idx >> 11;
        const f32x2 a32 = WSP(f32x2, WS_PW)[(size_t)(((l * 16 + g) * 2 + d) * 64 + n) * 33 + 32];
        float sr = 0.f, si = 0.f;
#pragma unroll 1
        for (int s0 = 0; s0 < S5C; s0 += 24) {
            float lr[24], li[24];
#pragma unroll
            for (int j = 0; j < 24; ++j) { const int s = s0 + j, c = d == 0 ? s : (s < 8 ? 7 - s : 79 - s);
                const size_t ix = ((size_t)g * S5R + b * S5C + c) * 256 + d * 128 + n; lr[j] = WSP(float, WS_SLOC)[ix]; li[j] = WSP(float, WS_SLOC)[ix + 64]; }
#pragma unroll
            for (int j = 0; j < 24; ++j) { const int s = s0 + j, c = d == 0 ? s : (s < 8 ? 7 - s : 79 - s);
                const size_t ix = ((size_t)g * S5R + b * S5C + c) * 256 + d * 128 + n;
                WSP(bf16_t, WS_SIN)[ix] = f2bf(sr); WSP(bf16_t, WS_SIN)[ix + 64] = f2bf(si);
                const float nr = a32.x * sr - a32.y * si + lr[j], ni = a32.x * si + a32.y * sr + li[j]; sr = nr; si = ni; }
        }
    }
}
DEVI void s5_out_wave(const Ctx& cx, int l, int wu) {
    const int g = wu / 72, mt = (wu % 72) / 8, nt = wu % 8;
    const bf16_t* Pp = WSP(bf16_t, WS_P) + PC_S5 + g * 16;
    const bf16_t* sin_ = WSP(bf16_t, WS_SIN) + (size_t)g * S5R * 256;
    const bf16_t* wy = WSP(bf16_t, WS_WY) + (size_t)(l * 16 + g) * 512 * 768 + (size_t)nt * 64 * 768;
    f32x4 acc[4][4];
    wave_gemm<4, 4>(cx.lane, 768, [&](int row, int k) { return k < 512 ? ldg8(Pp + (size_t)s5_trow(mt * 64 + row, k >> 4) * NP + (k & 15)) : ldg8(sin_ + (size_t)(mt * 64 + row) * 256 + (k - 512)); },
                         [&](int row, int k) { return ldg8(wy + (size_t)row * 768 + k); }, acc);
    const int fr = cx.lane & 15, fq = cx.lane >> 4;
#pragma unroll
    for (int m = 0; m < 4; ++m)
#pragma unroll
        for (int n = 0; n < 4; ++n) { const int trow = s5_trow(mt * 64 + m * 16 + fr, nt * 4 + n);
            u32x2 w; w.x = pk_bf16(gelu_tanh(acc[m][n][0]), gelu_tanh(acc[m][n][1])); w.y = pk_bf16(gelu_tanh(acc[m][n][2]), gelu_tanh(acc[m][n][3]));
            *(u32x2*)(WSP(bf16_t, WS_GS) + (size_t)trow * 256 + g * 16 + 4 * fq) = w; }
}
DEVI void s5_glu_wave(const Ctx& cx, int l, int wu) {
    const int mt = wu / 4, nt = wu % 4;
    const bf16_t* gs = WSP(bf16_t, WS_GS) + (size_t)mt * 64 * 256;
    const bf16_t* wg = WSP(bf16_t, WS_WGLU) + (size_t)l * 65536 + (size_t)nt * 64 * 256;
    f32x4 acc[4][4];
    wave_gemm<4, 4>(cx.lane, 256, [&](int row, int k) { return ldg8(gs + (size_t)row * 256 + k); }, [&](int row, int k) { return ldg8(wg + (size_t)row * 256 + k); }, acc);
    const int fr = cx.lane & 15, fq = cx.lane >> 4;
#pragma unroll
    for (int n = 0; n < 4; ++n) { const int col = nt * 64 + n * 16 + 4 * fq;
        const f32x4 gb = *(const f32x4*)(cx.p->in[I_S5GB] + l * 256 + col), mw = *(const f32x4*)(cx.p->in[I_MIXW] + l * 1024 + 768 + col);
#pragma unroll
        for (int m = 0; m < 4; ++m) { const size_t trow = (size_t)mt * 64 + m * 16 + fr;
            const u32x2 gv = *(const u32x2*)(WSP(bf16_t, WS_GS) + trow * 256 + col);
            const float gq[4] = {__uint_as_float(gv.x << 16), __uint_as_float(gv.x & 0xFFFF0000u), __uint_as_float(gv.y << 16), __uint_as_float(gv.y & 0xFFFF0000u)};
            float o[4]; float ss = 0.f;
#pragma unroll
            for (int j = 0; j < 4; ++j) { o[j] = gq[j] * frcp(1.0f + __expf(-(acc[m][n][j] + gb[j]))); ss += o[j] * o[j]; }
            ss += shx<16>(ss, cx.lane); ss += shx<32>(ss, cx.lane);
            const float rstd = rsqrtf(ss * (1.0f / 16.0f) + EPS);
            u32x2 w; w.x = pk_bf16(o[0] * rstd * mw[0], o[1] * rstd * mw[1]); w.y = pk_bf16(o[2] * rstd * mw[2], o[3] * rstd * mw[3]);
            *(u32x2*)(WSP(bf16_t, WS_MRG) + trow * 1024 + 768 + col) = w; } }
}

#ifndef PH_DUP2
#define PH_DUP2 0
#endif
#define REP_(k) for (int rep_ = 0; rep_ < 1 + ((PH_DUP2 >> (k)) & 1); ++rep_)
DEVI void ph_mix_local(const Ctx& cx, int l) {
    REP_(0) for (int u = cx.bid; u < NB * 4 * MLC; u += cx.G) ml_local_unit(cx, l, u / (4 * MLC), (u / MLC) % 4, u % MLC);
    REP_(1) { const int off = (NB * 4 * MLC) % cx.G; const int first = (cx.bid - off + cx.G) % cx.G;
      for (int u = first; u < NB * RGC * 6; u += cx.G) rg_unit(cx, l, u / (RGC * 6), (u / 6) % RGC, u % 6, 0); }
    REP_(2) { const int off = (NB * 4 * MLC + NB * RGC * 6) % cx.G; const int first = (cx.bid - off + cx.G) % cx.G;
      for (int wu = first * 8 + cx.wave; wu < 16 * 36; wu += cx.G * 8) s5_local_wave(cx, l, wu); }
}
DEVI void ph_mix_carry(const Ctx& cx, int l) { ml_carry(cx); rg_carry(cx); s5_carry(cx, l); }
DEVI void ph_mix_out(const Ctx& cx, int l) {
    const bool last = (l == DEPTH - 1);
    REP_(3) for (int u = cx.bid; u < NB * 4 * MLC; u += cx.G) { const int c = u % MLC; if (last && c < 2) continue; ml_out_unit(cx, l, u / (4 * MLC), (u / MLC) % 4, c); }
    REP_(4) { const int off = (NB * 4 * MLC) % cx.G; const int first = (cx.bid - off + cx.G) % cx.G;
      for (int u = first; u < NB * RGC * 6; u += cx.G) { const int ck = (u / 6) % RGC; if (last && ck < 4) continue; rg_unit(cx, l, u / (RGC * 6), ck, u % 6, 1); } }
    REP_(5) { const int off = (NB * 4 * MLC + NB * RGC * 6) % cx.G; const int first = (cx.bid - off + cx.G) % cx.G;
      for (int wu = first * 8 + cx.wave; wu < 16 * 72; wu += cx.G * 8) s5_out_wave(cx, l, wu); }
}
DEVI void ph_glu(const Ctx& cx, int l) {
    for (int wu = cx.bid * 8 + cx.wave; wu < (TT / 64) * 4; wu += cx.G * 8) s5_glu_wave(cx, l, wu);
}

DEVI unsigned st_launder(unsigned s_addr) { unsigned a; asm volatile("v_mov_b32 %0, %1" : "=v"(a) : "s"(s_addr)); return a; }
constexpr int N_STEPS = 3 + 10 * DEPTH + 1;
__global__ void __launch_bounds__(NTHR, 2) mk_fwd(Params p) {
    extern __shared__ __attribute__((aligned(16))) unsigned char lds_raw[];
    Ctx cx; cx.p = &p; cx.ws = p.ws; cx.lds = (LAS unsigned char*)lds_raw; cx.tid = threadIdx.x; cx.lane = cx.tid & 63;
    cx.wave = __builtin_amdgcn_readfirstlane((int)threadIdx.x >> 6); cx.G = gridDim.x; cx.bid = blockIdx.x;
    volatile LAS unsigned* st = (volatile LAS unsigned*)(cx.lds + LDS_BYTES - 16);
    const unsigned st_s = (unsigned)__builtin_amdgcn_readfirstlane((int)(unsigned)(size_t)(LAS unsigned*)(cx.lds + LDS_BYTES - 16));
#define ST_P ((volatile LAS unsigned*)(size_t)st_launder(st_s))
    if (cx.tid == 0) { st[0] = 0u; st[1] = 0u; st[2] = (unsigned)p.lo; st[3] = (unsigned)p.hi; }
    __syncthreads();
    (void)xcd_barrier_post((unsigned*)(p.ws + WS_CTL) + CW_BAR, st);
#define GRID_BAR() do { XcdBarrier b_; b_.bar = (unsigned*)(p.ws + WS_CTL) + CW_BAR; b_.x = (unsigned)__builtin_amdgcn_readfirstlane((int)xb_xcc_id()); b_.st = ST_P; xcd_barrier(b_); } while (0)
#ifndef PH_MASK
#define PH_MASK 0xFFFF
#endif
#ifndef PH_DUP
#define PH_DUP 0
#endif
#define STEP_(id, k, call) do { const int lo_ = __builtin_amdgcn_readfirstlane((int)ST_P[2]), hi_ = __builtin_amdgcn_readfirstlane((int)ST_P[3]); if (lo_ <= (k) && (k) < hi_) { if ((PH_MASK >> (id)) & 1) { const Ctx cl = relaunder(cx); call; } if ((PH_DUP >> (id)) & 1) { GRID_BAR(); const Ctx cl = relaunder(cx); call; } if ((k) + 1 < hi_) GRID_BAR(); } } while (0)
    STEP_(0, 0, ph_pro_a(cl));
    STEP_(1, 1, ph_pro_b(cl));
    STEP_(2, 2, ph_pro_c(cl));
#pragma unroll 1
    for (int l = 0; l < DEPTH; ++l) {
        const int s0 = 3 + 10 * l;
        STEP_(3, s0 + 0, ph_norm1(cl, l));
        STEP_(4, s0 + 1, ph_inproj(cl, l));
        STEP_(5, s0 + 2, ph_mix_local(cl, l));
        STEP_(6, s0 + 3, ph_mix_carry(cl, l));
        STEP_(7, s0 + 4, ph_mix_out(cl, l));
        STEP_(8, s0 + 5, ph_glu(cl, l));
        STEP_(9, s0 + 6, ph_outproj(cl, l));
        STEP_(10, s0 + 7, ph_norm2(cl, l));
        STEP_(11, s0 + 8, ph_moe_gu(cl, l));
        STEP_(12, s0 + 9, ph_moe_dn(cl, l));
    }
    STEP_(13, N_STEPS - 1, ph_norm1(cl, DEPTH));
#undef STEP_
}

extern "C" void kernel_launch(void* const* d_in, const int* in_sizes, int n_in, void* d_out, int out_size, void* d_ws, size_t ws_size, hipStream_t stream) {
    static int grid = 0;
    if (grid == 0) {
        if (n_in != 36 || out_size != TLAT * DM || ws_size < WS_END) { fprintf(stderr, "kernel_launch: unexpected problem (n_in %d, out %d, ws %zu < %zu)\n", n_in, out_size, ws_size, (size_t)WS_END); grid = -1; return; }
        int dev = 0, cus = 0, per_cu = 0;
        if (hipGetDevice(&dev) != hipSuccess || hipDeviceGetAttribute(&cus, hipDeviceAttributeMultiprocessorCount, dev) != hipSuccess) { grid = -1; return; }
        if (hipFuncSetAttribute((const void*)mk_fwd, hipFuncAttributeMaxDynamicSharedMemorySize, LDS_BYTES) != hipSuccess) { fprintf(stderr, "kernel_launch: hipFuncSetAttribute failed\n"); grid = -1; return; }
        if (hipOccupancyMaxActiveBlocksPerMultiprocessor(&per_cu, (const void*)mk_fwd, NTHR, LDS_BYTES) != hipSuccess || per_cu < 1) { fprintf(stderr, "kernel_launch: occupancy query says %d blocks per CU\n", per_cu); }
        (void)hipGetLastError();
        grid = cus;
    }
    if (grid < 0) return;
    (void)hipMemsetAsync((char*)d_ws + WS_CTL, 0, CTL_BYTES, stream);
    Params p{};
    for (int i = 0; i < 36; ++i) p.in[i] = (const float*)d_in[i];
    p.out = (float*)d_out; p.ws = (unsigned char*)d_ws;
#if MK_FUSED
    p.lo = 0; p.hi = N_STEPS;
    hipLaunchKernelGGL(mk_fwd, dim3(grid), dim3(NTHR), LDS_BYTES, stream, p);
#else
    for (int k = 0; k < N_STEPS; ++k) { p.lo = k; p.hi = k + 1; hipLaunchKernelGGL(mk_fwd, dim3(grid), dim3(NTHR), LDS_BYTES, stream, p); }
#endif
}
```

```cpp
#include <hip/hip_runtime.h>
#include <stdint.h>
#include <stdio.h>

#ifndef MK_FUSED
#define MK_FUSED 1
#endif

typedef unsigned short bf16_t;
typedef short bf16x8 __attribute__((ext_vector_type(8)));
typedef float f32x4 __attribute__((ext_vector_type(4)));
typedef float f32x2 __attribute__((ext_vector_type(2)));
typedef unsigned u32x4 __attribute__((ext_vector_type(4)));
typedef unsigned u32x2 __attribute__((ext_vector_type(2)));
typedef int i32x4 __attribute__((ext_vector_type(4)));
typedef int i32x8 __attribute__((ext_vector_type(8)));
#define LAS __attribute__((address_space(3)))
#define DEVI __device__ __forceinline__

constexpr int DM = 1024, NB = 8, SEQ = 2048, CTXL = 256, DEPTH = 4;
constexpr int TCTX = NB * CTXL, TLAT = NB * SEQ, TT = TCTX + TLAT;
constexpr int DIN = 2576, NP = 2560;
constexpr int NE = 32;
constexpr int PMAX = 81920;
constexpr int NTHR = 512;
constexpr int LDS_BYTES = 152 * 1024;
constexpr float EPS = 1e-6f;
constexpr float W8_SCALE = 32.0f, W8_INV = 0.03125f;
constexpr float Y8_SCALE = 8.0f, Y8_INV = 0.125f;
constexpr int PC_Q = 0, PC_K = 384, PC_V = 768, PC_O = 1152, PC_RX = 1536, PC_RG = 1920, PC_S5 = 2304;
constexpr int MLC = 18;
constexpr int RGC = 36;
constexpr int S5C = 72, S5R = NB * S5C;

constexpr size_t al256(size_t x) { return (x + 255) & ~(size_t)255; }
constexpr size_t WS_CTL   = 0;
constexpr size_t CTL_BYTES = 65536;
constexpr size_t CW_BAR = 0;
constexpr size_t CW_CNT = 4096;
constexpr size_t WS_WIN   = al256(WS_CTL + CTL_BYTES);
constexpr size_t WS_WOUT  = al256(WS_WIN + (size_t)DEPTH * NP * 1024 * 2);
constexpr size_t WS_WGU   = al256(WS_WOUT + (size_t)DEPTH * 1024 * 1024 * 2);
constexpr size_t WS_WD    = al256(WS_WGU + (size_t)DEPTH * NE * 2048 * 1024 * 2);
constexpr size_t WS_MOD   = al256(WS_WD + (size_t)DEPTH * NE * 1024 * 1024 * 2);
constexpr size_t WS_PW    = al256(WS_MOD + (size_t)DEPTH * 9 * 6144 * 4);
constexpr size_t WS_BB    = al256(WS_PW + (size_t)DEPTH * 16 * 2 * 64 * 33 * 8);
constexpr size_t WS_KT    = al256(WS_BB + (size_t)DEPTH * 16 * 2 * 64 * 16 * 8);
constexpr size_t WS_WY    = al256(WS_KT + (size_t)DEPTH * 16 * 2 * 32 * 256 * 4);
constexpr size_t WS_WE    = al256(WS_WY + (size_t)DEPTH * 16 * 512 * 768 * 2);
constexpr size_t WS_WRG   = al256(WS_WE + (size_t)DEPTH * 16 * 256 * 512 * 2);
constexpr size_t WS_WGLU  = al256(WS_WRG + (size_t)DEPTH * 6 * 256 * 64 * 2);
constexpr size_t WS_XS    = al256(WS_WGLU + (size_t)DEPTH * 256 * 256 * 2);
constexpr size_t WS_XMID  = al256(WS_XS + (size_t)TT * 1024 * 4);
constexpr size_t WS_H     = al256(WS_XMID + (size_t)TT * 1024 * 4);
constexpr size_t WS_GT    = al256(WS_H + (size_t)TT * 1024 * 2);
constexpr size_t WS_P     = al256(WS_GT + (size_t)TT * 16 * 4);
constexpr size_t WS_GB    = al256(WS_P + (size_t)TT * NP * 2);
constexpr size_t WS_GU    = al256(WS_GB + (size_t)TT * 8 * 4);
constexpr size_t WS_GCM   = al256(WS_GU + (size_t)TT * 8 * 4);
constexpr size_t WS_MSC   = al256(WS_GCM + (size_t)TT * 8 * 4);
constexpr size_t WS_CLOC  = al256(WS_MSC + (size_t)8 * 4 * 18 * 2 * 2 * 4);
constexpr size_t WS_NLOC  = al256(WS_CLOC + (size_t)8 * 4 * 18 * 2 * 9216 * 4);
constexpr size_t WS_C0    = al256(WS_NLOC + (size_t)8 * 4 * 18 * 2 * 96 * 4);
constexpr size_t WS_N0    = al256(WS_C0 + (size_t)8 * 4 * 18 * 2 * 9216 * 2);
constexpr size_t WS_M0    = al256(WS_N0 + (size_t)8 * 4 * 18 * 2 * 96 * 4);
constexpr size_t WS_RGA   = al256(WS_M0 + (size_t)8 * 4 * 18 * 2 * 4);
constexpr size_t WS_RGB   = al256(WS_RGA + (size_t)8 * 36 * 2 * 384 * 4);
constexpr size_t WS_RGC   = al256(WS_RGB + (size_t)8 * 36 * 2 * 384 * 4);
constexpr size_t WS_SLOC  = al256(WS_RGC + (size_t)8 * 36 * 2 * 384 * 4);
constexpr size_t WS_SIN   = al256(WS_SLOC + (size_t)16 * 576 * 256 * 4);
constexpr size_t WS_GS    = al256(WS_SIN + (size_t)16 * 576 * 256 * 2);
constexpr size_t WS_MRG   = al256(WS_GS + (size_t)TT * 256 * 2);
constexpr size_t WS_ELIST = al256(WS_MRG + (size_t)TT * 1024 * 2);
constexpr size_t WS_GLIST = al256(WS_ELIST + (size_t)NE * TT * 4);
constexpr size_t WS_TINFO = al256(WS_GLIST + (size_t)NE * TT * 4);
constexpr size_t WS_ACT   = al256(WS_TINFO + (size_t)TT * 4 * 4);
constexpr size_t WS_YPAD  = al256(WS_ACT + (size_t)PMAX * 1024 * 2);
constexpr size_t WS_BIN2  = al256(WS_YPAD + (size_t)PMAX * 1024 * 2);
constexpr size_t WS_HLO   = al256(WS_BIN2 + (size_t)DEPTH * NP * 4);
constexpr size_t WS_WGT   = al256(WS_HLO + (size_t)TT * 1024 * 2);
constexpr size_t WS_RWH   = al256(WS_WGT + (size_t)DEPTH * 16 * 1024 * 2);
constexpr size_t WS_RWL   = al256(WS_RWH + (size_t)DEPTH * 32 * 1024 * 2);
constexpr size_t WS_H8    = al256(WS_RWL + (size_t)DEPTH * 32 * 1024 * 2);
constexpr size_t WS_END   = al256(WS_H8 + (size_t)TT * 1024);

struct Params { const float* in[36]; float* out; unsigned char* ws; int lo, hi; };

enum { I_X = 0, I_C, I_CTX, I_CCTX, I_ADAW, I_ADAB, I_N1W, I_WIN, I_BIN, I_RGCW, I_RGCB, I_RGWA, I_RGBA, I_RGWX, I_RGBX, I_RGLAM,
       I_S5LRE, I_S5LIM, I_S5LDT, I_S5BRE, I_S5BIM, I_S5CRE, I_S5CIM, I_S5D, I_S5GW, I_S5GB, I_MIXW, I_WOUT, I_N2W, I_RW, I_RB,
       I_WGU, I_BGU, I_WD, I_BD, I_FNW };

DEVI bf16_t f2bf(float f) { unsigned u = __float_as_uint(f); u += 0x7FFFu + ((u >> 16) & 1u); return (bf16_t)(u >> 16); }
DEVI float bf2f(bf16_t b) { return __uint_as_float(((unsigned)b) << 16); }
DEVI unsigned pk_bf16(float lo, float hi) { unsigned r; asm("v_cvt_pk_bf16_f32 %0, %1, %2" : "=v"(r) : "v"(lo), "v"(hi)); return r; }
DEVI unsigned pk4_fp8(float a, float b, float c, float d) { int p = __builtin_amdgcn_cvt_pk_fp8_f32(a, b, 0, false); p = __builtin_amdgcn_cvt_pk_fp8_f32(c, d, p, true); return (unsigned)p; }
DEVI float q8(float x) { const int p = __builtin_amdgcn_cvt_pk_fp8_f32(x, x, 0, false); return __builtin_amdgcn_cvt_f32_fp8(p, 0); }
DEVI float frcp(float x) { return __builtin_amdgcn_rcpf(x); }
DEVI float sigmoidf_(float x) { return frcp(1.0f + __expf(-x)); }
DEVI float gelu_tanh(float x) { const float u = 0.7978845608f * (x + 0.044715f * x * x * x); return x * frcp(1.0f + __expf(-2.0f * u)); }
template <int M> DEVI float shx(float v, int lane) {
    if constexpr (M < 32) return __int_as_float(__builtin_amdgcn_ds_swizzle(__float_as_int(v), 0x1F | (M << 10)));
    else return __int_as_float(__builtin_amdgcn_ds_bpermute((lane ^ 32) << 2, __float_as_int(v)));
}
DEVI float shxr(float v, int m, int lane) {
    switch (m) { case 1: return shx<1>(v, lane); case 2: return shx<2>(v, lane); case 4: return shx<4>(v, lane); case 8: return shx<8>(v, lane); case 16: return shx<16>(v, lane); default: return shx<32>(v, lane); }
}
DEVI int shxri(int v, int m, int lane) { return __float_as_int(shxr(__int_as_float(v), m, lane)); }
template <int CTRL, int ROWMASK> DEVI float dpp_(float v) { return __int_as_float(__builtin_amdgcn_update_dpp(0, __float_as_int(v), CTRL, ROWMASK, 0xF, false)); }
DEVI float wave_sum(float v, int) {
    v += dpp_<0xB1, 0xF>(v); v += dpp_<0x4E, 0xF>(v); v += dpp_<0x141, 0xF>(v); v += dpp_<0x140, 0xF>(v);
    v += dpp_<0x142, 0xA>(v); v += dpp_<0x143, 0xC>(v);
    return __int_as_float(__builtin_amdgcn_readlane(__float_as_int(v), 63));
}
DEVI float log1p_(float e) { return e < 0.06f ? e * (1.0f - e * (0.5f - e * (0.33333334f - e * 0.25f))) : __logf(1.0f + e); }
#define LDS_SYNC() do { asm volatile("s_waitcnt lgkmcnt(0)" ::: "memory"); __builtin_amdgcn_s_barrier(); asm volatile("" ::: "memory"); } while (0)
DEVI int mod_row(int row) { return row < TCTX ? 8 : (row - TCTX) / SEQ; }

#define XB_TMO      128
#define XB_XCNT(j)  (256  + 64 * (j))
#define XB_XSUB(j)  (1280 + 64 * (j))
#define XB_XGEN(j)  (2304 + 64 * (j))
#define XB_TOP      3328
#define XB_TOPGEN   3392
#define XCD_BAR_WORDS 3456
#define XB_SPIN_CAP (1u << 18)
__device__ __forceinline__ unsigned xb_ld(unsigned* p)              { return __hip_atomic_load(p, __ATOMIC_RELAXED, __HIP_MEMORY_SCOPE_AGENT); }
__device__ __forceinline__ unsigned xb_add(unsigned* p, unsigned v) { return __hip_atomic_fetch_add(p, v, __ATOMIC_RELAXED, __HIP_MEMORY_SCOPE_AGENT); }
__device__ __forceinline__ unsigned xb_xcc_id() { return (unsigned)__builtin_amdgcn_s_getreg((3 << 11) | 20) & 0xFu; }
#define XB_SPIN(cond, bar) do { unsigned _sp = 0; while (cond) { __builtin_amdgcn_s_sleep(1); \
    if ((++_sp & 255u) == 0u) { if (xb_ld(&(bar)[XB_TMO])) break; if (_sp > XB_SPIN_CAP) { atomicAdd(&(bar)[XB_TMO], 1u); break; } } } } while (0)
struct XcdBarrier { unsigned* bar; unsigned x; volatile LAS unsigned* st; };
__device__ __forceinline__ XcdBarrier xcd_barrier_post(unsigned* bar, volatile LAS unsigned* st) {
    XcdBarrier b; b.bar = bar; b.x = xb_xcc_id(); b.st = st;
    if (threadIdx.x == 0) (void)xb_add(&bar[XB_XCNT(b.x)], 1u);
    return b;
}
__device__ __forceinline__ void xcd_barrier_complete(unsigned* bar, unsigned x, unsigned& nloc, unsigned& nx) {
    const unsigned G = gridDim.x * gridDim.y * gridDim.z;
    unsigned sum, cnt, mine, sp = 0u;
    for (;;) {
        sum = 0u; cnt = 0u; mine = 0u;
#pragma unroll
        for (unsigned j = 0; j < 16; ++j) { const unsigned c = xb_ld(&bar[XB_XCNT(j)]); sum += c; cnt += (c > 0u) ? 1u : 0u; mine = (j == x) ? c : mine; }
        if (sum == G) break;
        __builtin_amdgcn_s_sleep(1);
        if ((++sp & 255u) == 0u) { if (xb_ld(&bar[XB_TMO])) break; if (sp > XB_SPIN_CAP) { atomicAdd(&bar[XB_TMO], 1u); break; } }
    }
    nloc = mine > 0u ? mine : 1u; nx = cnt > 0u ? cnt : 1u;
}
__device__ __forceinline__ void xcd_barrier(const XcdBarrier& b) {
    asm volatile("s_waitcnt vmcnt(0)" ::: "memory");
    __syncthreads();
    if (threadIdx.x == 0) {
        unsigned* bar = b.bar;
        __builtin_amdgcn_s_waitcnt(0);
        unsigned nloc = b.st[0], nx = b.st[1];
        if (nloc == 0u) { xcd_barrier_complete(bar, b.x, nloc, nx); b.st[0] = nloc; b.st[1] = nx; }
        const unsigned old = xb_add(&bar[XB_XSUB(b.x)], 1u);
        const unsigned gen = old / nloc;
        if (old + 1u == (gen + 1u) * nloc) {
            __builtin_amdgcn_fence(__ATOMIC_RELEASE, "agent");
            asm volatile("s_waitcnt vmcnt(0)" ::: "memory");
            const unsigned og = xb_add(&bar[XB_TOP], 1u);
            const unsigned tg = og / nx;
            if (og + 1u == (tg + 1u) * nx) xb_add(&bar[XB_TOPGEN], 1u);
            else XB_SPIN(xb_ld(&bar[XB_TOPGEN]) == tg, bar);
            __builtin_amdgcn_fence(__ATOMIC_ACQUIRE, "agent");
            xb_add(&bar[XB_XGEN(b.x)], 1u);
            asm volatile("s_waitcnt vmcnt(0)" ::: "memory");
        } else {
            XB_SPIN(xb_ld(&bar[XB_XGEN(b.x)]) == gen, bar);
            __builtin_amdgcn_fence(__ATOMIC_ACQUIRE, "agent");
            asm volatile("s_waitcnt vmcnt(0)" ::: "memory");
        }
    }
    __syncthreads();
}

namespace g1 {
constexpr int BM = 256, BK = 64, HALF = 128, HTB = HALF * BK * 2, STAGE_BYTES = 8 * HTB, K = 1024, NT = K / BK;
DEVI int lds_byte(int r, int c) { const int st = (r >> 4) * 2 + (c >> 5), rr = r & 15, cc = c & 31, ob = rr * 64 + cc * 2; return st * 1024 + (ob ^ (((ob >> 9) & 1) << 5)); }
DEVI void stage_rc(int b, int& R, int& C) { const int st = b / 1024, sb = b % 1024, swz = sb ^ (((sb >> 9) & 1) << 5); R = (st >> 1) * 16 + swz / 64; C = (st & 1) * 32 + (swz % 64) / 2; }
DEVI int perm32(int rho) { const int n = rho >> 4, i = rho & 15; return 8 * (i >> 2) + 4 * n + (i & 3); }

struct Unit {
    const char* A;
    const int* list;
    int nvalid;
    const char* B;
    int pm, pn, e;
};

template <bool F8> struct FragT { typedef bf16x8 T; static constexpr int NK = 2; };
template <> struct FragT<true> { typedef i32x8 T; static constexpr int NK = 1; };
template <bool GATHER, int KB>
DEVI void a_offsets(const Unit& u, int tid, unsigned (&v)[2][2]) {
    int tz = tid; asm volatile("" : "+v"(tz));
#pragma unroll
    for (int i = 0; i < 2; ++i) {
        int R, C; stage_rc(tz * 16 + i * 8192, R, C);
#pragma unroll
        for (int h = 0; h < 2; ++h) {
            const int r = h * HALF + R;
            int src = r;
            if (GATHER) { const int nv = u.nvalid > 256 ? 256 : u.nvalid; const int ld_ = u.list[r < nv ? r : nv - 1]; src = (r < nv) ? ld_ : 0; }
            v[h][i] = (unsigned)src * (unsigned)KB + (unsigned)(C * 2);
        }
    }
}
DEVI void a_request(const Unit& u, int tid, int (&raw)[2][2]) {
    int tz = tid; asm volatile("" : "+v"(tz));
    const int nv = u.nvalid > 256 ? 256 : u.nvalid;
#pragma unroll
    for (int i = 0; i < 2; ++i) { int R, C; stage_rc(tz * 16 + i * 8192, R, C);
#pragma unroll
        for (int h = 0; h < 2; ++h) { const int r = h * HALF + R; raw[h][i] = u.list[r < nv ? r : nv - 1]; } }
}
template <int KB>
DEVI void a_finish(int nvalid, int tid, int (&raw)[2][2], unsigned (&v)[2][2]) {
    asm volatile("" : "+v"(raw[0][0]), "+v"(raw[0][1]), "+v"(raw[1][0]), "+v"(raw[1][1]));
    int tz = tid; asm volatile("" : "+v"(tz));
    const int nv = nvalid > 256 ? 256 : nvalid;
#pragma unroll
    for (int i = 0; i < 2; ++i) { int R, C; stage_rc(tz * 16 + i * 8192, R, C);
#pragma unroll
        for (int h = 0; h < 2; ++h) { const int r = h * HALF + R; const int src = (r < nv) ? raw[h][i] : 0; v[h][i] = (unsigned)src * (unsigned)KB + (unsigned)(C * 2); } }
}

template <class Sched, class Epi, bool GATHER, bool FP8 = false>
DEVI void gemm_phase(LAS unsigned char* lds, const int tid, const Sched& S, const Epi& E) {
    constexpr int KB = FP8 ? 1024 : 2048, NTK = KB / 128, NK = FragT<FP8>::NK;
    typedef typename FragT<FP8>::T frag_t;
    int sc1 = 0x7F7F7F7F; asm volatile("" : "+v"(sc1));
    const int wid = __builtin_amdgcn_readfirstlane(tid >> 6), lane = tid & 63, wr = wid >> 2, wc = wid & 3, fr = lane & 15, fq = lane >> 4;
    unsigned voffB[2];
#pragma unroll
    for (int i = 0; i < 2; ++i) { int R, C; stage_rc(tid * 16 + i * 8192, R, C); const int Rb = Epi::PERM ? ((R & ~31) + perm32(R & 31)) : R; voffB[i] = (unsigned)(Rb * KB + C * 2); }
    constexpr size_t kstep = (size_t)(BK * 2);
    constexpr size_t hstep = (size_t)HALF * KB;
    const unsigned ldsw = (unsigned)wid * 1024u;
    const int aoff = FP8 ? lds_byte(wr * 64 + fr, fq * 16) : lds_byte(wr * 64 + fr, fq * 8), boff = FP8 ? lds_byte(wc * 32 + fr, fq * 16) : lds_byte(wc * 32 + fr, fq * 8);
    const int sw16 = FP8 ? 16 * (fq & 1) : 0;
    unsigned pa_ = (unsigned)(size_t)(lds + aoff) + sw16, pb_ = (unsigned)(size_t)(lds + 65536 + boff) + sw16, pa2_ = (unsigned)(size_t)(lds + aoff) + (16 - sw16), pb2_ = (unsigned)(size_t)(lds + 65536 + boff) + (16 - sw16);
    asm volatile("" : "+v"(pa_), "+v"(pb_), "+v"(pa2_), "+v"(pb2_));
    LAS unsigned char* const pa = (LAS unsigned char*)(size_t)pa_; LAS unsigned char* const pb = (LAS unsigned char*)(size_t)pb_;
    LAS unsigned char* const pa2 = (LAS unsigned char*)(size_t)pa2_; LAS unsigned char* const pb2 = (LAS unsigned char*)(size_t)pb2_;
#define G1_SA(b, h) (((b) * 2 + (h)) * HTB)
#define G1_SB(b, h) ((4 + (b) * 2 + (h)) * HTB)
#define G1_STAGE2(bufoff, gbase, v0, v1) do { \
        __builtin_amdgcn_global_load_lds((const unsigned*)((const char*)(gbase) + (v0)), (LAS unsigned*)(lds + (bufoff) + ldsw), 16, 0, 0); \
        __builtin_amdgcn_global_load_lds((const unsigned*)((const char*)(gbase) + (v1)), (LAS unsigned*)(lds + (bufoff) + ldsw + 8192), 16, 0, 0); } while (0)
#define G1_LDFRAG(dst, ptr, ptr2) do { if constexpr (FP8) { const i32x4 lo_ = *(const LAS i32x4*)(ptr), hi_ = *(const LAS i32x4*)(ptr2); dst = __builtin_shufflevector(lo_, hi_, 0, 1, 2, 3, 4, 5, 6, 7); } \
        else { dst = *(const LAS frag_t*)(ptr); } } while (0)
#define G1_LDA(dst, b, h) do { _Pragma("unroll") for (int m = 0; m < 4; ++m) _Pragma("unroll") for (int k = 0; k < NK; ++k) G1_LDFRAG(dst[m][k], pa + (G1_SA(b, h) + m * 2048 + k * 1024), pa2 + (G1_SA(b, h) + m * 2048 + k * 1024)); } while (0)
#define G1_LDB(dst, b, h) do { _Pragma("unroll") for (int n = 0; n < 2; ++n) _Pragma("unroll") for (int k = 0; k < NK; ++k) G1_LDFRAG(dst[n][k], pb + (G1_SB(b, h) - 65536 + n * 2048 + k * 1024), pb2 + (G1_SB(b, h) - 65536 + n * 2048 + k * 1024)); } while (0)
#define G1_MFMA(c_, b_, a_) do { if constexpr (FP8) asm volatile("v_mfma_scale_f32_16x16x128_f8f6f4 %0, %1, %2, %0, %3, %3 op_sel_hi:[0,0,0]" : "+v"(c_) : "v"(b_), "v"(a_), "v"(sc1)); \
        else c_ = __builtin_amdgcn_mfma_f32_16x16x32_bf16(b_, a_, c_, 0, 0, 0); } while (0)
#define G1_MMA(ai, bj, At, Bt) do { __builtin_amdgcn_s_setprio(1); _Pragma("unroll") for (int m = 0; m < 4; ++m) _Pragma("unroll") for (int n = 0; n < 2; ++n) _Pragma("unroll") for (int k = 0; k < NK; ++k) \
        G1_MFMA(acc[ai][bj][m][n], Bt[n][k], At[m][k]); __builtin_amdgcn_s_setprio(0); } while (0)
#define G1_WAIT_V(n) asm volatile("s_waitcnt vmcnt(" #n ")" ::: "memory")
#define G1_WAIT_L(n) asm volatile("s_waitcnt lgkmcnt(" #n ")" ::: "memory")
#define G1_BAR __builtin_amdgcn_s_barrier()
#define G1_SCHED __builtin_amdgcn_sched_barrier(0)
    Unit cur, nxt; int ui = 0;
    if (!S.get(0, cur)) return;
    f32x4 acc[2][2][4][2];
#pragma unroll
    for (int a = 0; a < 2; ++a)
#pragma unroll
        for (int b = 0; b < 2; ++b)
#pragma unroll
            for (int m = 0; m < 4; ++m)
#pragma unroll
                for (int n = 0; n < 2; ++n) acc[a][b][m][n] = (f32x4){0.f, 0.f, 0.f, 0.f};
    frag_t At[4][NK], B0[2][NK], B1[2][NK];
    unsigned vc[2][2], vn[2][2];
    a_offsets<GATHER, KB>(cur, tid, vc);
    const char* cA = cur.A; const char* cB = cur.B;
    G1_STAGE2(G1_SB(0, 0), cB, voffB[0], voffB[1]); G1_STAGE2(G1_SA(0, 0), cA, vc[0][0], vc[0][1]);
    G1_STAGE2(G1_SB(0, 1), cB + hstep, voffB[0], voffB[1]); G1_STAGE2(G1_SA(0, 1), cA, vc[1][0], vc[1][1]);
    if (wr == 1) G1_BAR;
    G1_WAIT_V(4); G1_BAR;
    G1_STAGE2(G1_SB(1, 0), cB + kstep, voffB[0], voffB[1]); G1_STAGE2(G1_SA(1, 0), cA + kstep, vc[0][0], vc[0][1]);
    G1_STAGE2(G1_SB(1, 1), cB + hstep + kstep, voffB[0], voffB[1]);
    G1_WAIT_V(6); G1_BAR;
    for (;;) {
        const bool has_next = S.get(ui + 1, nxt);
        int raw[2][2] = {{0, 0}, {0, 0}};
        if (has_next) { if constexpr (GATHER) a_request(nxt, tid, raw); else a_offsets<GATHER, KB>(nxt, tid, vn); }
        else {
#pragma unroll
            for (int h = 0; h < 2; ++h)
#pragma unroll
                for (int i = 0; i < 2; ++i) vn[h][i] = vc[h][i];
        }
        const char* nA = has_next ? nxt.A : cA; const char* nB = has_next ? nxt.B : cB;
#pragma unroll 1
        for (int t = 0; t < NTK; t += 2) {
            const bool last = (t == NTK - 2);
            const char* a1 = cA + (size_t)(t + 1) * kstep;
            const char* a2 = last ? nA : cA + (size_t)(t + 2) * kstep; const char* b2 = last ? nB : cB + (size_t)(t + 2) * kstep;
            const char* a3 = a2 + kstep; const char* b3 = b2 + kstep;
            unsigned w00 = vc[0][0], w01 = vc[0][1], w10 = vc[1][0], w11 = vc[1][1];
            if (last) { if constexpr (GATHER) { if (has_next) a_finish<KB>(nxt.nvalid, tid, raw, vn); }
                w00 = vn[0][0]; w01 = vn[0][1]; w10 = vn[1][0]; w11 = vn[1][1]; asm volatile("" : "+v"(w00), "+v"(w01), "+v"(w10), "+v"(w11)); }
            G1_LDB(B0, 0, 0); G1_SCHED; G1_LDA(At, 0, 0); G1_STAGE2(G1_SA(1, 1), a1, vc[1][0], vc[1][1]);
            G1_WAIT_L(8); G1_BAR; G1_WAIT_L(0); G1_MMA(0, 0, At, B0); G1_BAR; G1_SCHED;
            G1_LDB(B1, 0, 1); G1_STAGE2(G1_SB(0, 0), b2, voffB[0], voffB[1]);
            G1_BAR; G1_WAIT_L(0); G1_MMA(0, 1, At, B1); G1_BAR;
            G1_LDA(At, 0, 1); G1_STAGE2(G1_SA(0, 0), a2, w00, w01);
            G1_BAR; G1_WAIT_L(0); G1_MMA(1, 0, At, B0); G1_BAR; G1_SCHED;
            G1_STAGE2(G1_SB(0, 1), b2 + hstep, voffB[0], voffB[1]);
            G1_WAIT_V(6); G1_BAR; G1_MMA(1, 1, At, B1); G1_BAR;
            G1_LDB(B0, 1, 0); G1_SCHED; G1_LDA(At, 1, 0); G1_STAGE2(G1_SA(0, 1), a2, w10, w11);
            G1_WAIT_L(8); G1_BAR; G1_WAIT_L(0); G1_MMA(0, 0, At, B0); G1_BAR; G1_SCHED;
            G1_LDB(B1, 1, 1); G1_STAGE2(G1_SB(1, 0), b3, voffB[0], voffB[1]);
            G1_BAR; G1_WAIT_L(0); G1_MMA(0, 1, At, B1); G1_BAR;
            G1_LDA(At, 1, 1); G1_STAGE2(G1_SA(1, 0), a3, w00, w01);
            G1_BAR; G1_WAIT_L(0); G1_MMA(1, 0, At, B0); G1_BAR; G1_SCHED;
            G1_STAGE2(G1_SB(1, 1), b3 + hstep, voffB[0], voffB[1]);
            G1_WAIT_V(6); G1_BAR; G1_MMA(1, 1, At, B1); G1_BAR;
        }
        if constexpr (FP8) asm volatile("s_nop 15\n\ts_nop 15" ::: "memory");
        E(acc, cur, wr, wc, fr, fq);
        if (!has_next) break;
#pragma unroll
        for (int a = 0; a < 2; ++a)
#pragma unroll
            for (int b = 0; b < 2; ++b)
#pragma unroll
                for (int m = 0; m < 4; ++m)
#pragma unroll
                    for (int n = 0; n < 2; ++n) acc[a][b][m][n] = (f32x4){0.f, 0.f, 0.f, 0.f};
        cur = nxt; cA = nA; cB = nB; ++ui;
#pragma unroll
        for (int h = 0; h < 2; ++h)
#pragma unroll
            for (int i = 0; i < 2; ++i) vc[h][i] = vn[h][i];
    }
    G1_WAIT_V(0);
    if (wr == 0) G1_BAR;
    G1_BAR;
}
}

template <int MT, int NT_, class AF, class BF>
DEVI void wave_gemm(const int lane, int Kdim, const AF& af, const BF& bf, f32x4 (&acc)[MT][NT_]) {
    const int fr = lane & 15, fq = lane >> 4;
#pragma unroll
    for (int m = 0; m < MT; ++m)
#pragma unroll
        for (int n = 0; n < NT_; ++n) acc[m][n] = (f32x4){0.f, 0.f, 0.f, 0.f};
    bf16x8 fa[4][MT], fb[4][NT_];
#define WG_LOAD(S, KK) do { _Pragma("unroll") for (int m = 0; m < MT; ++m) fa[S][m] = af(m * 16 + fr, (KK) + fq * 8); _Pragma("unroll") for (int n = 0; n < NT_; ++n) fb[S][n] = bf(n * 16 + fr, (KK) + fq * 8); } while (0)
#define WG_MMA(S) do { _Pragma("unroll") for (int m = 0; m < MT; ++m) _Pragma("unroll") for (int n = 0; n < NT_; ++n) acc[m][n] = __builtin_amdgcn_mfma_f32_16x16x32_bf16(fb[S][n], fa[S][m], acc[m][n], 0, 0, 0); } while (0)
    WG_LOAD(0, 0); WG_LOAD(1, 32); WG_LOAD(2, 64);
#pragma unroll 1
    for (int k0 = 0; k0 < Kdim; k0 += 128) {
        const bool more = k0 + 128 < Kdim;
        WG_LOAD(3, k0 + 96); WG_MMA(0);
        if (more) WG_LOAD(0, k0 + 128);
        WG_MMA(1);
        if (more) WG_LOAD(1, k0 + 160);
        WG_MMA(2);
        if (more) WG_LOAD(2, k0 + 192);
        WG_MMA(3);
    }
#undef WG_LOAD
#undef WG_MMA
}
DEVI bf16x8 ldg8(const bf16_t* p) { return *(const bf16x8*)p; }

template <int N> struct Log2 { static constexpr int v = 1 + Log2<N / 2>::v; };
template <> struct Log2<1> { static constexpr int v = 0; };
template <int N>
DEVI float reduce_scatter(const int lane, float (&v)[N]) {
    constexpr int LG = Log2<N>::v;
#pragma unroll
    for (int st = 0; st < LG; ++st) {
        const int s = (N / 2) >> st, mask = 32 >> st;
        const bool up = (lane & mask) != 0;
#pragma unroll
        for (int i = 0; i < N / 2; ++i) if (i < s) {
            const float send = up ? v[i] : v[i + s];
            const float keep = up ? v[i + s] : v[i];
            v[i] = keep + shxr(send, mask, lane);
        }
    }
    float r = v[0];
#pragma unroll
    for (int st = LG; st < 6; ++st) r += shxr(r, 32 >> st, lane);
    return r;
}
template <int N>
DEVI int rs_index(int lane) {
    constexpr int LG = Log2<N>::v;
    int idx = 0;
#pragma unroll
    for (int st = 0; st < LG; ++st) if (lane & (32 >> st)) idx += (N / 2) >> st;
    return idx;
}

struct Ctx {
    const Params* p; unsigned char* ws; LAS unsigned char* lds; int tid, lane, wave, G, bid;
};
#define WSP(T, off) ((T*)(cx.ws + (off)))
DEVI Ctx relaunder(const Ctx& c) { Ctx r = c; int ln, td;
    asm volatile("v_mbcnt_lo_u32_b32 %0, -1, 0\n\tv_mbcnt_hi_u32_b32 %0, -1, %0\n\tv_lshl_add_u32 %1, %2, 6, %0" : "=&v"(ln), "=v"(td) : "s"(c.wave));
    r.lane = ln; r.tid = td; return r; }

DEVI void cvt_tile(const Ctx& cx, const float* src, int ld, bf16_t* dst, int n0, int k0, int kind) {
    LAS bf16_t* tile = (LAS bf16_t*)cx.lds;
    const int n4 = (cx.tid & 63) * 4, w8 = (cx.tid >> 6) * 8, n = n0 + n4;
    int sc; float scale = 1.0f;
    if (kind == 0) { sc = n < 1536 ? n : n + 16; if (n >= 384 && n < 768) scale = 0.10206207261596577f; }
    else if (kind == 2) { const int pn = n >> 8, w = n & 255; sc = w < 128 ? pn * 128 + w : 1024 + pn * 128 + (w - 128); }
    else sc = n;
#pragma unroll 1
    for (int sub = 0; sub < 4; sub += 2) {
        f32x4 v[2][8];
#pragma unroll
        for (int s2 = 0; s2 < 2; ++s2)
#pragma unroll
            for (int p = 0; p < 8; ++p) v[s2][p] = __builtin_nontemporal_load((const f32x4*)(src + (size_t)(k0 + (sub + s2) * 64 + w8 + p) * ld + sc));
#pragma unroll
        for (int s2 = 0; s2 < 2; ++s2)
#pragma unroll
            for (int j = 0; j < 4; ++j) { u32x4 w;
                w.x = pk_bf16(v[s2][0][j] * scale, v[s2][1][j] * scale); w.y = pk_bf16(v[s2][2][j] * scale, v[s2][3][j] * scale);
                w.z = pk_bf16(v[s2][4][j] * scale, v[s2][5][j] * scale); w.w = pk_bf16(v[s2][6][j] * scale, v[s2][7][j] * scale);
                *(LAS u32x4*)(tile + (n4 + j) * 264 + (sub + s2) * 64 + w8) = w; }
    }
    LDS_SYNC();
#pragma unroll
    for (int i = 0; i < 16; ++i) { const int idx = cx.tid + NTHR * i, row = idx >> 5, ch = idx & 31;
        const u32x4 o = *(const LAS u32x4*)(tile + row * 264 + ch * 8);
        *(u32x4*)(dst + (size_t)(n0 + row) * 1024 + k0 + ch * 8) = o; }
    LDS_SYNC();
}

DEVI void cvt_tile8(const Ctx& cx, const float* src, int ld, unsigned char* dst, int n0, int k0, int kind) {
    LAS unsigned char* tile = cx.lds;
    const int n4 = (cx.tid & 63) * 4, w8 = (cx.tid >> 6) * 8, n = n0 + n4;
    int sc;
    if (kind == 2) { const int pn = n >> 8, w = n & 255; sc = w < 128 ? pn * 128 + w : 1024 + pn * 128 + (w - 128); }
    else sc = n;
#pragma unroll 1
    for (int sub = 0; sub < 4; sub += 2) {
        f32x4 v[2][8];
#pragma unroll
        for (int s2 = 0; s2 < 2; ++s2)
#pragma unroll
            for (int p = 0; p < 8; ++p) v[s2][p] = __builtin_nontemporal_load((const f32x4*)(src + (size_t)(k0 + (sub + s2) * 64 + w8 + p) * ld + sc));
#pragma unroll
        for (int s2 = 0; s2 < 2; ++s2)
#pragma unroll
            for (int j = 0; j < 4; ++j) { u32x2 w;
                w.x = pk4_fp8(v[s2][0][j] * W8_SCALE, v[s2][1][j] * W8_SCALE, v[s2][2][j] * W8_SCALE, v[s2][3][j] * W8_SCALE);
                w.y = pk4_fp8(v[s2][4][j] * W8_SCALE, v[s2][5][j] * W8_SCALE, v[s2][6][j] * W8_SCALE, v[s2][7][j] * W8_SCALE);
                *(LAS u32x2*)(tile + (n4 + j) * 272 + (sub + s2) * 64 + w8) = w; }
    }
    LDS_SYNC();
#pragma unroll
    for (int i = 0; i < 8; ++i) { const int idx = cx.tid + NTHR * i, row = idx >> 4, ch = idx & 15;
        const u32x4 o = *(const LAS u32x4*)(tile + row * 272 + ch * 16);
        *(u32x4*)(dst + (size_t)(n0 + row) * 1024 + k0 + ch * 16) = o; }
    LDS_SYNC();
}
DEVI void ph_pro_a(const Ctx& cx) {
    const Params& P = *cx.p;
    {
        constexpr int n_in = DEPTH * 10 * 4, n_out = DEPTH * 4 * 4, n_gu = DEPTH * NE * 8 * 4, n_dn = DEPTH * NE * 4 * 4;
        constexpr int total = n_in + n_out + n_gu + n_dn;
        for (int job = cx.bid; job < total; job += cx.G) {
            int j = job;
            if (j < n_in) { const int l = j / 40, r = j % 40, kt = r / 10, nt = r % 10;
                cvt_tile(cx, P.in[I_WIN] + (size_t)l * 1024 * DIN, DIN, WSP(bf16_t, WS_WIN) + (size_t)l * NP * 1024, nt * 256, kt * 256, 0); continue; }
            j -= n_in;
            if (j < n_out) { const int l = j / 16, r = j % 16, kt = r / 4, nt = r % 4;
                cvt_tile(cx, P.in[I_WOUT] + (size_t)l * 1024 * 1024, 1024, WSP(bf16_t, WS_WOUT) + (size_t)l * 1024 * 1024, nt * 256, kt * 256, 1); continue; }
            j -= n_out;
            if (j < n_gu) { const int le = j / 32, r = j % 32, kt = r / 8, nt = r % 8;
                cvt_tile8(cx, P.in[I_WGU] + (size_t)le * 1024 * 2048, 2048, WSP(unsigned char, WS_WGU) + (size_t)le * 2048 * 1024, nt * 256, kt * 256, 2); continue; }
            j -= n_gu;
            { const int le = j / 16, r = j % 16, kt = r / 4, nt = r % 4;
                cvt_tile8(cx, P.in[I_WD] + (size_t)le * 1024 * 1024, 1024, WSP(unsigned char, WS_WD) + (size_t)le * 1024 * 1024, nt * 256, kt * 256, 1); }
        }
    }
    __syncthreads();
    {
        LAS float* sv = (LAS float*)cx.lds;
        LAS float* red = sv + 9 * 1024;
        constexpr int units = DEPTH * 6144 / 64;
        if (cx.bid < units) {
            for (int i = cx.tid; i < 9 * 1024; i += NTHR) { const int r = i >> 10, k = i & 1023; const float c = r < 8 ? P.in[I_C][r * 1024 + k] : P.in[I_CCTX][k]; sv[i] = c / (1.0f + __expf(-c)); }
            __syncthreads();
            for (int u = cx.bid; u < units; u += cx.G) {
                const int l = u / 96, n = (u % 96) * 64 + cx.lane;
                const float* w = P.in[I_ADAW] + (size_t)l * 1024 * 6144 + n;
                float acc[9];
#pragma unroll
                for (int r = 0; r < 9; ++r) acc[r] = 0.f;
                const int kb = cx.wave * 128;
#pragma unroll 4
                for (int k = 0; k < 128; ++k) { const float wv = w[(size_t)(kb + k) * 6144];
#pragma unroll
                    for (int r = 0; r < 9; ++r) acc[r] += sv[r * 1024 + kb + k] * wv; }
#pragma unroll
                for (int r = 0; r < 9; ++r) red[(cx.wave * 9 + r) * 64 + cx.lane] = acc[r];
                __syncthreads();
                for (int i = cx.tid; i < 9 * 64; i += NTHR) { const int r = i >> 6, ln = i & 63; float s = 0.f;
#pragma unroll
                    for (int w8 = 0; w8 < 8; ++w8) s += red[(w8 * 9 + r) * 64 + ln];
                    const int nn = (u % 96) * 64 + ln;
                    WSP(float, WS_MOD)[((size_t)l * 9 + r) * 6144 + nn] = s + P.in[I_ADAB][l * 6144 + nn]; }
                __syncthreads();
            }
        }
    }
    for (int gt = cx.bid * NTHR + cx.tid; gt < DEPTH * 16 * 2 * 64; gt += cx.G * NTHR) {
        const int n = gt & 63, d = (gt >> 6) & 1, g = (gt >> 7) & 15, l = gt >> 11;
        const float dt = expf(P.in[I_S5LDT][(l * 2 + d) * 16 + g]);
        const float lr = P.in[I_S5LRE][((l * 2 + d) * 16 + g) * 64 + n], li = P.in[I_S5LIM][((l * 2 + d) * 16 + g) * 64 + n];
        f32x2* pw = WSP(f32x2, WS_PW) + (size_t)gt * 33;
        float ar = 0.f, ai = 0.f;
        for (int k = 0; k <= 32; ++k) { const float mag = expf(lr * dt * (float)k); float s, c; sincosf(li * dt * (float)k, &s, &c); pw[k] = (f32x2){mag * c, mag * s}; if (k == 1) { ar = mag * c; ai = mag * s; } }
        const float den = lr * lr + li * li;
        const float cr = ((ar - 1.0f) * lr + ai * li) / den, ci = (ai * lr - (ar - 1.0f) * li) / den;
        f32x2* bb = WSP(f32x2, WS_BB) + (size_t)gt * 16;
        for (int q = 0; q < 16; ++q) { const float br = P.in[I_S5BRE][((l * 16 + g) * 64 + n) * 16 + q], bi = P.in[I_S5BIM][((l * 16 + g) * 64 + n) * 16 + q];
            bb[q] = (f32x2){cr * br - ci * bi, cr * bi + ci * br}; }
    }
    for (int i = cx.bid * NTHR + cx.tid; i < DEPTH * 6 * 256 * 64; i += cx.G * NTHR) {
        const int k = i & 63, n = (i >> 6) & 255, g = (i >> 14) % 6, l = (i >> 14) / 6;
        const int j = n & 63, type = (n >> 6) & 1, dir = n >> 7;
        const float* w = type ? P.in[I_RGWX] : P.in[I_RGWA];
        WSP(bf16_t, WS_WRG)[i] = f2bf(w[((((size_t)l * 2 + dir) * 6 + g) * 64 + k) * 64 + j]);
    }
    for (int i = cx.bid * NTHR + cx.tid; i < DEPTH * NP; i += cx.G * NTHR) {
        const int n = i % NP, l = i / NP; const int sc = n < 1536 ? n : n + 16;
        WSP(float, WS_BIN2)[i] = P.in[I_BIN][l * DIN + sc] * ((n >= 384 && n < 768) ? 0.10206207261596577f : 1.0f);
    }
    for (int i = cx.bid * NTHR + cx.tid; i < DEPTH * 16 * 1024; i += cx.G * NTHR) { const int k = i & 1023, n = (i >> 10) & 15, l = i >> 14;
        WSP(bf16_t, WS_WGT)[i] = f2bf(P.in[I_WIN][((size_t)l * 1024 + k) * DIN + 1536 + n]); }
    for (int i = cx.bid * NTHR + cx.tid; i < DEPTH * 32 * 1024; i += cx.G * NTHR) { const int k = i & 1023, n = (i >> 10) & 31, l = i >> 15;
        const float w = P.in[I_RW][((size_t)l * 1024 + k) * 32 + n]; const bf16_t hi = f2bf(w);
        WSP(bf16_t, WS_RWH)[i] = hi; WSP(bf16_t, WS_RWL)[i] = f2bf(w - bf2f(hi)); }
    for (int i = cx.bid * NTHR + cx.tid; i < DEPTH * 256 * 256; i += cx.G * NTHR) {
        const int k = i & 255, n = (i >> 8) & 255, l = i >> 16;
        WSP(bf16_t, WS_WGLU)[i] = f2bf(P.in[I_S5GW][((size_t)l * 256 + k) * 256 + n]);
    }
}

DEVI void ph_pro_b(const Ctx& cx) {
    const Params& P = *cx.p;
    LAS f32x2* pw = (LAS f32x2*)cx.lds;
    LAS f32x2* bb = pw + 64 * 33;
    LAS f32x2* cc = bb + 64 * 16;
    for (int u = cx.bid; u < DEPTH * 16 * 2; u += cx.G) {
        const int lg = u >> 1;
        for (int i = cx.tid; i < 64 * 33; i += NTHR) pw[i] = WSP(f32x2, WS_PW)[(size_t)u * 64 * 33 + i];
        for (int i = cx.tid; i < 64 * 16; i += NTHR) bb[i] = WSP(f32x2, WS_BB)[(size_t)u * 64 * 16 + i];
        for (int i = cx.tid; i < 16 * 64; i += NTHR) cc[i] = (f32x2){P.in[I_S5CRE][(size_t)lg * 1024 + i], P.in[I_S5CIM][(size_t)lg * 1024 + i]};
        __syncthreads();
        const int q = cx.tid & 15, p = (cx.tid >> 4) & 15, tau0 = cx.tid >> 8;
        float acc[16];
#pragma unroll
        for (int i = 0; i < 16; ++i) acc[i] = 0.f;
#pragma unroll 2
        for (int n = 0; n < 64; ++n) { const f32x2 b = bb[n * 16 + q], c = cc[p * 64 + n];
#pragma unroll
            for (int i = 0; i < 16; ++i) { const f32x2 a = pw[n * 33 + tau0 + 2 * i]; const float xr = c.x * a.x - c.y * a.y, xi = c.x * a.y + c.y * a.x; acc[i] += xr * b.x - xi * b.y; } }
#pragma unroll
        for (int i = 0; i < 16; ++i) WSP(float, WS_KT)[(((size_t)u * 32 + tau0 + 2 * i) * 16 + p) * 16 + q] = acc[i];
        __syncthreads();
    }
}

DEVI void ph_pro_c(const Ctx& cx) {
    const Params& P = *cx.p;
    LAS float* kt = (LAS float*)cx.lds;
    LAS f32x2* pw = (LAS f32x2*)(kt + 2 * 32 * 256);
    LAS f32x2* bb = pw + 2 * 64 * 33;
    LAS f32x2* cc = bb + 2 * 64 * 16;
    LAS float* dsk = (LAS float*)(cc + 16 * 64);
    for (int u = cx.bid; u < DEPTH * 16 * 4; u += cx.G) {
        const int lg = u >> 2, qt = u & 3, l = lg >> 4, g = lg & 15;
        for (int i = cx.tid; i < 2 * 32 * 256; i += NTHR) kt[i] = WSP(float, WS_KT)[(size_t)lg * 2 * 32 * 256 + i];
        for (int i = cx.tid; i < 2 * 64 * 33; i += NTHR) pw[i] = WSP(f32x2, WS_PW)[(size_t)lg * 2 * 64 * 33 + i];
        for (int i = cx.tid; i < 2 * 64 * 16; i += NTHR) bb[i] = WSP(f32x2, WS_BB)[(size_t)lg * 2 * 64 * 16 + i];
        for (int i = cx.tid; i < 16 * 64; i += NTHR) cc[i] = (f32x2){P.in[I_S5CRE][(size_t)lg * 1024 + i], P.in[I_S5CIM][(size_t)lg * 1024 + i]};
        if (cx.tid < 16) dsk[cx.tid] = P.in[I_S5D][l * 256 + g * 16 + cx.tid];
        __syncthreads();
        bf16_t* wy = WSP(bf16_t, WS_WY) + ((size_t)lg * 512 + qt * 128) * 768;
        for (int idx = cx.tid; idx < 128 * 768; idx += NTHR) {
            const int k = idx % 768, tp = qt * 128 + idx / 768, t = tp >> 4, p = tp & 15;
            float v;
            if (k < 512) { const int sI = k >> 4, q = k & 15; v = 0.f;
                if (sI <= t) v += kt[(0 * 32 + (t - sI)) * 256 + p * 16 + q];
                if (sI >= t) v += kt[(1 * 32 + (sI - t)) * 256 + p * 16 + q];
                if (sI == t && p == q) v += dsk[p];
            } else { const int kk = k - 512, d = kk >> 7, im = (kk >> 6) & 1, n = kk & 63;
                const int pwr = d == 0 ? t + 1 : 32 - t;
                const f32x2 a = pw[(d * 64 + n) * 33 + pwr], c = cc[p * 64 + n];
                v = im ? -(c.x * a.y + c.y * a.x) : (c.x * a.x - c.y * a.y); }
            wy[idx] = f2bf(v);
        }
        bf16_t* we = WSP(bf16_t, WS_WE) + ((size_t)lg * 256 + qt * 64) * 512;
        for (int idx = cx.tid; idx < 64 * 512; idx += NTHR) {
            const int k = idx & 511, no = qt * 64 + (idx >> 9);
            const int sI = k >> 4, q = k & 15, d = no >> 7, im = (no >> 6) & 1, n = no & 63;
            const int pwr = d == 0 ? 31 - sI : sI;
            const f32x2 a = pw[(d * 64 + n) * 33 + pwr], b2 = bb[(d * 64 + n) * 16 + q];
            we[idx] = f2bf(im ? (a.x * b2.y + a.y * b2.x) : (a.x * b2.x - a.y * b2.y));
        }
        __syncthreads();
    }
}

DEVI void moe_info(const Ctx& cx, int l, LAS int* info) {
    if (cx.tid < 64) {
        const unsigned* cnt = (const unsigned*)(cx.ws + WS_CTL) + CW_CNT + l * 32;
        const int c = cx.lane < 32 ? (int)__hip_atomic_load(cnt + (cx.lane & 31), __ATOMIC_RELAXED, __HIP_MEMORY_SCOPE_AGENT) : 0;
        const int nt = (c + 255) >> 8;
        if (cx.lane < 32) { info[72 + cx.lane] = nt; info[40 + cx.lane] = c; }
        if (cx.lane == 0) { int run = 0; info[0] = 0; for (int e = 0; e < 32; ++e) { run += info[72 + e]; info[e + 1] = run; } }
    }
    __syncthreads();
    if (cx.tid < 32) { const int lo = info[cx.tid], hi = info[cx.tid + 1]; for (int t = lo; t < hi; ++t) info[112 + t] = cx.tid;
    }
    __syncthreads();
}

DEVI void block_rows_visible() {
    asm volatile("s_waitcnt vmcnt(0)" ::: "memory");
    __syncthreads();
}
DEVI void ph_norm1(const Ctx& cx, int l) {
    const Params& P = *cx.p;
    LAS int* info = (LAS int*)cx.lds;
    LAS float* part = (LAS float*)(cx.lds + 4096);
    if (l > 0) moe_info(cx, l - 1, info);
    const int rbeg = (l == DEPTH) ? TCTX : 0, nr = TT - rbeg;
    const int rpb = (nr + cx.G - 1) / cx.G, rb = rbeg + cx.bid * rpb, re = min(TT, rb + rpb);
    const float* modp = WSP(float, WS_MOD);
    const int c0 = 4 * cx.lane;
    for (int r2 = rb + cx.wave; r2 < re; r2 += 16) {
        f32x4 x[2][4]; bool ok[2];
#pragma unroll
        for (int u = 0; u < 2; ++u) { const int row = r2 + 8 * u; ok[u] = row < re; const int rw_ = ok[u] ? row : r2;
            if (l == 0) { const float* src = rw_ < TCTX ? P.in[I_CTX] + (size_t)rw_ * 1024 : P.in[I_X] + (size_t)(rw_ - TCTX) * 1024;
#pragma unroll
                for (int i = 0; i < 4; ++i) x[u][i] = *(const f32x4*)(src + c0 + 256 * i);
            } else {
                const float* src = WSP(float, WS_XMID) + (size_t)rw_ * 1024;
                const float* g2 = modp + ((size_t)(l - 1) * 9 + mod_row(rw_)) * 6144 + 5120;
                const int* ti = WSP(int, WS_TINFO) + (size_t)rw_ * 4;
                f32x4 y[4];
#pragma unroll
                for (int i = 0; i < 4; ++i) y[i] = (f32x4){0.f, 0.f, 0.f, 0.f};
#pragma unroll
                for (int k = 0; k < 4; ++k) { const int t = ti[k]; const int e = t >> 20, slot = t & 0xFFFFF;
                    const unsigned char* yp = WSP(unsigned char, WS_YPAD) + ((size_t)info[e] * 256 + slot) * 1024;
#pragma unroll
                    for (int i = 0; i < 4; ++i) { const int w = *(const int*)(yp + c0 + 256 * i);
                        y[i][0] += __builtin_amdgcn_cvt_f32_fp8(w, 0); y[i][1] += __builtin_amdgcn_cvt_f32_fp8(w, 1); y[i][2] += __builtin_amdgcn_cvt_f32_fp8(w, 2); y[i][3] += __builtin_amdgcn_cvt_f32_fp8(w, 3); } }
#pragma unroll
                for (int i = 0; i < 4; ++i) { const f32x4 xv = *(const f32x4*)(src + c0 + 256 * i), gv = *(const f32x4*)(g2 + c0 + 256 * i); x[u][i] = xv + gv * (y[i] * Y8_INV); }
            }
        }
#pragma unroll
        for (int u = 0; u < 2; ++u) {
            const int row = r2 + 8 * u;
            float ss = 0.f;
#pragma unroll
            for (int i = 0; i < 4; ++i) ss += (x[u][i][0] * x[u][i][0] + x[u][i][1] * x[u][i][1]) + (x[u][i][2] * x[u][i][2] + x[u][i][3] * x[u][i][3]);
            ss = wave_sum(ss, 0);
            const float rstd = rsqrtf(ss * (1.0f / 1024.0f) + EPS);
            if (!ok[u]) continue;
            if (l == DEPTH) { float* o = P.out + (size_t)(row - TCTX) * 1024;
#pragma unroll
                for (int i = 0; i < 4; ++i) { const f32x4 fw = *(const f32x4*)(P.in[I_FNW] + c0 + 256 * i); *(f32x4*)(o + c0 + 256 * i) = x[u][i] * rstd * fw; }
                continue; }
            float* xs = WSP(float, WS_XS) + (size_t)row * 1024;
            const float* md = modp + ((size_t)l * 9 + mod_row(row)) * 6144;
            bf16_t* hp = WSP(bf16_t, WS_H) + (size_t)row * 1024;
#pragma unroll
            for (int i = 0; i < 4; ++i) { const int c = c0 + 256 * i;
                *(f32x4*)(xs + c) = x[u][i];
                const f32x4 nw = *(const f32x4*)(P.in[I_N1W] + l * 1024 + c), sc = *(const f32x4*)(md + 1024 + c), sh = *(const f32x4*)(md + c);
                const f32x4 h = x[u][i] * rstd * nw * (sc + 1.0f) + sh;
                u32x2 w; w.x = pk_bf16(h[0], h[1]); w.y = pk_bf16(h[2], h[3]); *(u32x2*)(hp + c) = w; }
        }
    }
    if (l == DEPTH) return;
    block_rows_visible();
    const int nrow = re - rb, ntile = (nrow + 15) / 16;
    for (int it = cx.wave; it < ntile * 4; it += 8) {
        const int t = it >> 2, kq = it & 3, fr = cx.lane & 15, fq = cx.lane >> 4; const int row = min(rb + t * 16 + fr, re - 1);
        const bf16_t* hp = WSP(bf16_t, WS_H) + (size_t)row * 1024 + kq * 256 + fq * 8;
        const bf16_t* wp = WSP(bf16_t, WS_WGT) + ((size_t)l * 16 + fr) * 1024 + kq * 256 + fq * 8;
        f32x4 acc = (f32x4){0.f, 0.f, 0.f, 0.f};
        bf16x8 af[8], wf[8];
#pragma unroll
        for (int k = 0; k < 8; ++k) { af[k] = ldg8(hp + 32 * k); wf[k] = ldg8(wp + 32 * k); }
        __builtin_amdgcn_sched_barrier(0);
#pragma unroll
        for (int k = 0; k < 8; ++k) acc = __builtin_amdgcn_mfma_f32_16x16x32_bf16(wf[k], af[k], acc, 0, 0, 0);
        __builtin_amdgcn_sched_barrier(0);
        *(LAS f32x4*)(part + ((kq * 128) + t * 16 + fr) * 16 + 4 * fq) = acc;
    }
    __syncthreads();
    for (int i = cx.tid; i < nrow * 16; i += NTHR) { const int rl = i >> 4, gi = i & 15;
        WSP(float, WS_GT)[(size_t)(rb + rl) * 16 + gi] = (part[(0 * 128 + rl) * 16 + gi] + part[(1 * 128 + rl) * 16 + gi]) + (part[(2 * 128 + rl) * 16 + gi] + part[(3 * 128 + rl) * 16 + gi]) + P.in[I_BIN][l * DIN + 1536 + gi]; }
}

DEVI void ph_norm2(const Ctx& cx, int l) {
    const Params& P = *cx.p;
    LAS float* lgs = (LAS float*)cx.lds;
    LAS int* hist = (LAS int*)(cx.lds + 4 * 128 * 33 * 4);
    LAS int* pend = hist + 64;
    if (cx.tid < 64) hist[cx.tid] = 0;
    const int r0 = (l == DEPTH - 1) ? TCTX : 0, nr = TT - r0;
    const int rpb = (nr + cx.G - 1) / cx.G;
    const int rb = r0 + cx.bid * rpb, re = min(TT, rb + rpb);
    const float* modp = WSP(float, WS_MOD);
    const int c0 = 4 * cx.lane;
    for (int r2 = rb + cx.wave; r2 < re; r2 += 16) {
        f32x4 x[2][4]; bool ok[2];
#pragma unroll
        for (int u = 0; u < 2; ++u) { const int row = r2 + 8 * u; ok[u] = row < re; const float* src = WSP(float, WS_XMID) + (size_t)(ok[u] ? row : r2) * 1024;
#pragma unroll
            for (int i = 0; i < 4; ++i) x[u][i] = *(const f32x4*)(src + c0 + 256 * i); }
#pragma unroll
        for (int u = 0; u < 2; ++u) {
            const int row = r2 + 8 * u;
            float ss = 0.f;
#pragma unroll
            for (int i = 0; i < 4; ++i) ss += (x[u][i][0] * x[u][i][0] + x[u][i][1] * x[u][i][1]) + (x[u][i][2] * x[u][i][2] + x[u][i][3] * x[u][i][3]);
            ss = wave_sum(ss, 0);
            const float rstd = rsqrtf(ss * (1.0f / 1024.0f) + EPS);
            if (!ok[u]) continue;
            const float* md = modp + ((size_t)l * 9 + mod_row(row)) * 6144;
            bf16_t* hp = WSP(bf16_t, WS_H) + (size_t)row * 1024; bf16_t* hl = WSP(bf16_t, WS_HLO) + (size_t)row * 1024; unsigned char* h8 = WSP(unsigned char, WS_H8) + (size_t)row * 1024;
#pragma unroll
            for (int i = 0; i < 4; ++i) { const int c = c0 + 256 * i;
                const f32x4 nw = *(const f32x4*)(P.in[I_N2W] + l * 1024 + c), sc = *(const f32x4*)(md + 4096 + c), sh = *(const f32x4*)(md + 3072 + c);
                const f32x4 h = x[u][i] * rstd * nw * (sc + 1.0f) + sh;
                const int p8 = (int)pk4_fp8(h[0], h[1], h[2], h[3]);
                const float q0 = __builtin_amdgcn_cvt_f32_fp8(p8, 0), q1 = __builtin_amdgcn_cvt_f32_fp8(p8, 1), q2 = __builtin_amdgcn_cvt_f32_fp8(p8, 2), q3 = __builtin_amdgcn_cvt_f32_fp8(p8, 3);
                *(int*)(h8 + c) = p8;
                u32x2 wh; wh.x = pk_bf16(q0, q1); wh.y = pk_bf16(q2, q3); *(u32x2*)(hp + c) = wh;
                u32x2 wl; wl.x = pk_bf16(h[0] - q0, h[1] - q1); wl.y = pk_bf16(h[2] - q2, h[3] - q3); *(u32x2*)(hl + c) = wl; }
        }
    }
    block_rows_visible();
    const int nrow = re - rb, ntile = (nrow + 15) / 16;
    for (int it = cx.wave; it < ntile * 8; it += 8) {
        const int t = it >> 3, nt = (it >> 2) & 1, kq = it & 3, fr = cx.lane & 15, fq = cx.lane >> 4; const int row = min(rb + t * 16 + fr, re - 1);
        const bf16_t* hp = WSP(bf16_t, WS_H) + (size_t)row * 1024 + kq * 256 + fq * 8; const bf16_t* hl = WSP(bf16_t, WS_HLO) + (size_t)row * 1024 + kq * 256 + fq * 8;
        const bf16_t* wh = WSP(bf16_t, WS_RWH) + ((size_t)l * 32 + nt * 16 + fr) * 1024 + kq * 256 + fq * 8; const bf16_t* wl = WSP(bf16_t, WS_RWL) + ((size_t)l * 32 + nt * 16 + fr) * 1024 + kq * 256 + fq * 8;
        f32x4 acc = (f32x4){0.f, 0.f, 0.f, 0.f}, acc2 = (f32x4){0.f, 0.f, 0.f, 0.f};
        bf16x8 ah[8], al[8], bh[8], bl[8];
#pragma unroll
        for (int k = 0; k < 8; ++k) { ah[k] = ldg8(hp + 32 * k); al[k] = ldg8(hl + 32 * k); bh[k] = ldg8(wh + 32 * k); bl[k] = ldg8(wl + 32 * k); }
        __builtin_amdgcn_sched_barrier(0);
#pragma unroll
        for (int k = 0; k < 8; ++k) {
            acc = __builtin_amdgcn_mfma_f32_16x16x32_bf16(bh[k], ah[k], acc, 0, 0, 0);
            acc2 = __builtin_amdgcn_mfma_f32_16x16x32_bf16(bl[k], ah[k], acc2, 0, 0, 0);
            acc2 = __builtin_amdgcn_mfma_f32_16x16x32_bf16(bh[k], al[k], acc2, 0, 0, 0); }
        __builtin_amdgcn_sched_barrier(0);
        const int rl = t * 16 + fr;
#pragma unroll
        for (int j = 0; j < 4; ++j) lgs[(kq * 128 + rl) * 33 + nt * 16 + 4 * fq + j] = acc[j] + acc2[j];
    }
    __syncthreads();
    if (cx.tid < nrow) {
        float lg[32];
#pragma unroll
        for (int e = 0; e < 32; ++e) lg[e] = (lgs[(0 * 128 + cx.tid) * 33 + e] + lgs[(1 * 128 + cx.tid) * 33 + e]) + (lgs[(2 * 128 + cx.tid) * 33 + e] + lgs[(3 * 128 + cx.tid) * 33 + e]) + P.in[I_RB][l * 32 + e];
        float tv[4]; int tix[4]; unsigned taken = 0u;
#pragma unroll
        for (int k = 0; k < 4; ++k) { float bv = -3.0e38f; int bi = 0;
#pragma unroll
            for (int e = 0; e < 32; ++e) { const bool better = (lg[e] > bv) && !((taken >> e) & 1u); bv = better ? lg[e] : bv; bi = better ? e : bi; }
            tv[k] = bv; tix[k] = bi; taken |= 1u << bi; }
        const float e1 = __expf(tv[1] - tv[0]), e2 = __expf(tv[2] - tv[0]), e3 = __expf(tv[3] - tv[0]);
        const float inv = 1.0f / (1.0f + e1 + e2 + e3);
        const float gk[4] = {inv, e1 * inv, e2 * inv, e3 * inv};
#pragma unroll
        for (int k = 0; k < 4; ++k) {
            const int ls = __hip_atomic_fetch_add((LAS int*)(hist + tix[k]), 1, __ATOMIC_RELAXED, __HIP_MEMORY_SCOPE_WORKGROUP);
            pend[(cx.tid * 4 + k) * 2 + 0] = (tix[k] << 20) | ls;
            pend[(cx.tid * 4 + k) * 2 + 1] = __float_as_int(gk[k]); }
    }
    __syncthreads();
    if (cx.tid < 32) { unsigned* cnt = (unsigned*)(cx.ws + WS_CTL) + CW_CNT + l * 32;
        hist[32 + cx.tid] = hist[cx.tid] > 0 ? (int)__hip_atomic_fetch_add(cnt + cx.tid, (unsigned)hist[cx.tid], __ATOMIC_RELAXED, __HIP_MEMORY_SCOPE_AGENT) : 0; }
    __syncthreads();
    for (int i = cx.tid; i < nrow * 4; i += NTHR) {
        const int t = pend[i * 2], e = t >> 20, slot = hist[32 + e] + (t & 0xFFFFF), row = rb + (i >> 2);
        WSP(int, WS_ELIST)[(size_t)e * TT + slot] = row;
        WSP(float, WS_GLIST)[(size_t)e * TT + slot] = __int_as_float(pend[i * 2 + 1]);
        WSP(int, WS_TINFO)[(size_t)row * 4 + (i & 3)] = (e << 20) | slot;
    }
}

DEVI int xcd_contig(int bid, int G) { return (G % 8 == 0) ? (bid % 8) * (G / 8) + bid / 8 : bid; }

struct DenseSched {
    const char* A; const char* B; int nM, nN, pm0, G, bid;
    DEVI bool get(int i, g1::Unit& u) const {
        int pm, pn;
        if (G % 8 == 0) { const int x = bid & 7, r = bid >> 3, nx = G >> 3, lo = (nM * x) >> 3, hi = (nM * (x + 1)) >> 3, nr = hi - lo;
            const int q = i * nx + r; if (nr <= 0 || q >= nr * nN) return false; pm = lo + q % nr; pn = q / nr; }
        else { const int L = i * G + bid; if (L >= nM * nN) return false; pm = L / nN; pn = L % nN; }
        u.A = A + (size_t)(pm0 + pm) * 256 * 2048; u.list = nullptr; u.nvalid = 256; u.B = B + (size_t)pn * 256 * 2048; u.pm = pm0 + pm; u.pn = pn; u.e = 0;
        return true;
    }
};
struct MoeSched {
    const char* A; const char* B; const int* elist; const LAS int* info; int NPN, gather, G, bid; size_t bstride; int kb;
    DEVI int rd(int i) const { return __builtin_amdgcn_readfirstlane(info[i]); }
    DEVI bool get(int i, g1::Unit& u) const {
        const int NTt = rd(32); int T, pn;
        if (G % 8 == 0 && (G >> 3) % NPN == 0) { const int x = bid & 7, r = bid >> 3, nx = G >> 3, RT = nx / NPN, lo = (NTt * x) >> 3, hi = (NTt * (x + 1)) >> 3;
            T = lo + i * RT + r % RT; pn = r / RT; if (T >= hi) return false; }
        else { const int L = i * G + bid; if (L >= NTt * NPN) return false; T = L / NPN; pn = L % NPN; }
        const int e = rd(112 + T), j = T - rd(e);
        u.pm = T; u.pn = pn; u.e = e;
        u.B = B + (size_t)e * bstride + (size_t)pn * 256 * kb;
        if (gather) { u.A = A; u.list = elist + (size_t)e * TT + j * 256; u.nvalid = rd(40 + e) - j * 256; }
        else { u.A = A + (size_t)T * 256 * kb; u.list = nullptr; u.nvalid = 256; }
        return true;
    }
};

struct EpiIn {
    static constexpr bool PERM = true;
    bf16_t* Pout; const float* bias;
    DEVI void operator()(const f32x4 (&acc)[2][2][4][2], const g1::Unit& u, int wr, int wc, int fr, int fq) const {
        const int row0 = u.pm * 256 + wr * 64 + fr;
#pragma unroll
        for (int bj = 0; bj < 2; ++bj) {
            const int col0 = u.pn * 256 + bj * 128 + wc * 32 + 8 * fq;
            const int seg = u.pn * 2 + bj; const bool gl = (seg >= 15 && seg < 18);
            const f32x4 b0 = *(const f32x4*)(bias + col0), b1 = *(const f32x4*)(bias + col0 + 4);
#pragma unroll
            for (int ai = 0; ai < 2; ++ai)
#pragma unroll
                for (int m = 0; m < 4; ++m) {
                    f32x4 v0 = acc[ai][bj][m][0] + b0, v1 = acc[ai][bj][m][1] + b1;
                    if (gl) {
#pragma unroll
                        for (int j = 0; j < 4; ++j) { v0[j] = gelu_tanh(v0[j]); v1[j] = gelu_tanh(v1[j]); } }
                    u32x4 w; w.x = pk_bf16(v0[0], v0[1]); w.y = pk_bf16(v0[2], v0[3]); w.z = pk_bf16(v1[0], v1[1]); w.w = pk_bf16(v1[2], v1[3]);
                    *(u32x4*)(Pout + (size_t)(row0 + ai * 128 + m * 16) * NP + col0) = w;
                }
        }
    }
};
struct EpiOut {
    static constexpr bool PERM = false;
    const float* xs; float* xmid; const float* mod;
    DEVI void operator()(const f32x4 (&acc)[2][2][4][2], const g1::Unit& u, int wr, int wc, int fr, int fq) const {
        const int row0 = u.pm * 256 + wr * 64 + fr;
        const float* g1p = mod + (size_t)mod_row(u.pm * 256) * 6144 + 2048;
#pragma unroll
        for (int bj = 0; bj < 2; ++bj)
#pragma unroll
            for (int n = 0; n < 2; ++n) {
                const int col = u.pn * 256 + bj * 128 + wc * 32 + 16 * n + 4 * fq;
                const f32x4 gv = *(const f32x4*)(g1p + col);
#pragma unroll
                for (int ai = 0; ai < 2; ++ai)
#pragma unroll
                    for (int m = 0; m < 4; ++m) {
                        const size_t off = (size_t)(row0 + ai * 128 + m * 16) * 1024 + col;
                        const f32x4 xv = *(const f32x4*)(xs + off);
                        *(f32x4*)(xmid + off) = xv + gv * acc[ai][bj][m][n];
                    }
            }
    }
};
struct EpiGU {
    static constexpr bool PERM = true;
    unsigned char* act; const float* bgu;
    DEVI void operator()(const f32x4 (&acc)[2][2][4][2], const g1::Unit& u, int wr, int wc, int fr, int fq) const {
        const int row0 = u.pm * 256 + wr * 64 + fr, colh = u.pn * 128 + wc * 32 + 8 * fq;
        const float* bg = bgu + (size_t)u.e * 2048 + colh; const float* bu = bg + 1024;
        const f32x4 bg0 = *(const f32x4*)bg, bg1 = *(const f32x4*)(bg + 4), bu0 = *(const f32x4*)bu, bu1 = *(const f32x4*)(bu + 4);
#pragma unroll
        for (int ai = 0; ai < 2; ++ai)
#pragma unroll
            for (int m = 0; m < 4; ++m) {
                float o[8];
#pragma unroll
                for (int n = 0; n < 2; ++n)
#pragma unroll
                    for (int j = 0; j < 4; ++j) {
                        const float g = fminf(acc[ai][0][m][n][j] * W8_INV + (n ? bg1[j] : bg0[j]), 7.0f);
                        const float up = fminf(fmaxf(acc[ai][1][m][n][j] * W8_INV + (n ? bu1[j] : bu0[j]), -7.0f), 7.0f);
                        o[n * 4 + j] = (up + 1.0f) * g * frcp(1.0f + __expf(-1.702f * g));
                    }
                u32x2 w; w.x = pk4_fp8(o[0], o[1], o[2], o[3]); w.y = pk4_fp8(o[4], o[5], o[6], o[7]);
                *(u32x2*)(act + (size_t)(row0 + ai * 128 + m * 16) * 1024 + colh) = w;
            }
    }
};
struct EpiDown {
    static constexpr bool PERM = true;
    unsigned char* ypad; const float* bd; const float* glist; const LAS int* info;
    DEVI void operator()(const f32x4 (&acc)[2][2][4][2], const g1::Unit& u, int wr, int wc, int fr, int fq) const {
        const int j256 = (u.pm - __builtin_amdgcn_readfirstlane(info[u.e])) * 256, cnt = __builtin_amdgcn_readfirstlane(info[40 + u.e]);
        const int rl0 = wr * 64 + fr;
#pragma unroll
        for (int ai = 0; ai < 2; ++ai)
#pragma unroll
            for (int m = 0; m < 4; ++m) {
                const int rl = rl0 + ai * 128 + m * 16, slot = j256 + rl;
                const float gt = slot < cnt ? glist[(size_t)u.e * TT + slot] : 0.f;
#pragma unroll
                for (int bj = 0; bj < 2; ++bj) {
                    const int col0 = u.pn * 256 + bj * 128 + wc * 32 + 8 * fq;
                    const f32x4 b0 = *(const f32x4*)(bd + (size_t)u.e * 1024 + col0), b1 = *(const f32x4*)(bd + (size_t)u.e * 1024 + col0 + 4);
                    const f32x4 v0 = (acc[ai][bj][m][0] * W8_INV + b0) * gt, v1 = (acc[ai][bj][m][1] * W8_INV + b1) * gt;
                    u32x2 w; w.x = pk4_fp8(v0[0] * Y8_SCALE, v0[1] * Y8_SCALE, v0[2] * Y8_SCALE, v0[3] * Y8_SCALE); w.y = pk4_fp8(v1[0] * Y8_SCALE, v1[1] * Y8_SCALE, v1[2] * Y8_SCALE, v1[3] * Y8_SCALE);
                    *(u32x2*)(ypad + (size_t)(u.pm * 256 + rl) * 1024 + col0) = w;
                }
            }
    }
};

DEVI void ph_inproj(const Ctx& cx, int l) {
    DenseSched S{(const char*)WSP(bf16_t, WS_H), (const char*)(WSP(bf16_t, WS_WIN) + (size_t)l * NP * 1024), TT / 256, NP / 256, 0, cx.G, cx.bid};
    EpiIn E{WSP(bf16_t, WS_P), WSP(float, WS_BIN2) + (size_t)l * NP};
    g1::gemm_phase<DenseSched, EpiIn, false>(cx.lds, cx.tid, S, E);
}
DEVI void ph_outproj(const Ctx& cx, int l) {
    const int pm0 = (l == DEPTH - 1) ? TCTX / 256 : 0;
    DenseSched S{(const char*)WSP(bf16_t, WS_MRG), (const char*)(WSP(bf16_t, WS_WOUT) + (size_t)l * 1024 * 1024), TT / 256 - pm0, 4, pm0, cx.G, cx.bid};
    EpiOut E{WSP(float, WS_XS), WSP(float, WS_XMID), WSP(float, WS_MOD) + (size_t)l * 9 * 6144};
    g1::gemm_phase<DenseSched, EpiOut, false>(cx.lds, cx.tid, S, E);
}
DEVI void ph_moe_gu(const Ctx& cx, int l) {
    LAS int* info = (LAS int*)(cx.lds + g1::STAGE_BYTES);
    moe_info(cx, l, info);
    MoeSched S{(const char*)WSP(unsigned char, WS_H8), (const char*)(WSP(unsigned char, WS_WGU) + (size_t)l * NE * 2048 * 1024), WSP(int, WS_ELIST), info, 8, 1, cx.G, cx.bid, (size_t)2048 * 1024, 1024};
    EpiGU E{WSP(unsigned char, WS_ACT), cx.p->in[I_BGU] + (size_t)l * NE * 2048};
    g1::gemm_phase<MoeSched, EpiGU, true, true>(cx.lds, cx.tid, S, E);
}
DEVI void ph_moe_dn(const Ctx& cx, int l) {
    LAS int* info = (LAS int*)(cx.lds + g1::STAGE_BYTES);
    moe_info(cx, l, info);
    MoeSched S{(const char*)WSP(unsigned char, WS_ACT), (const char*)(WSP(unsigned char, WS_WD) + (size_t)l * NE * 1024 * 1024), nullptr, info, 4, 0, cx.G, cx.bid, (size_t)1024 * 1024, 1024};
    EpiDown E{WSP(unsigned char, WS_YPAD), cx.p->in[I_BD] + (size_t)l * NE * 1024, WSP(float, WS_GLIST), info};
    g1::gemm_phase<MoeSched, EpiDown, false, true>(cx.lds, cx.tid, S, E);
}

DEVI int ml_row0(int b, int c) { return c < 2 ? b * CTXL + c * 128 : TCTX + b * SEQ + (c - 2) * 128; }
DEVI unsigned short lds_u16(const LAS bf16_t* p) { return *p; }

DEVI void ml_local_unit(const Ctx& cx, int l, int b, int h, int c) {
    LAS float* sg = (LAS float*)cx.lds;
    LAS float* se = sg + 256;
    LAS float* red = se + 256;
    LAS bf16_t* Ks = (LAS bf16_t*)(cx.lds + 4352);
    LAS bf16_t* Ve = Ks + 128 * 104;
    const int row0 = ml_row0(b, c), tid = cx.tid;
    const int dir = (tid >> 7) & 1, i = tid & 127, p = dir ? 127 - i : i;
    const bool act = tid < 256;
    float gi = 0.f, bval = 0.f, u = 0.f;
    if (act) { const float* gt = WSP(float, WS_GT) + (size_t)(row0 + i) * 16; gi = gt[dir * 4 + h]; const float gf = gt[8 + dir * 4 + h];
        sg[dir * 128 + p] = fminf(gf, 0.f) - log1p_(__expf(-fabsf(gf))); }
    LDS_SYNC();
#pragma unroll 1
    for (int off = 1; off < 128; off <<= 1) { float v = 0.f; if (act) { v = sg[dir * 128 + p]; if (p >= off) v += sg[dir * 128 + p - off]; } LDS_SYNC(); if (act) sg[dir * 128 + p] = v; LDS_SYNC(); }
    if (act) { bval = sg[dir * 128 + p]; u = gi - bval; if (p == 127) red[dir] = bval; }
    LDS_SYNC();
    if (act) sg[dir * 128 + p] = u;
    LDS_SYNC();
#pragma unroll 1
    for (int off = 1; off < 128; off <<= 1) { float v = 0.f; if (act) { v = sg[dir * 128 + p]; if (p >= off) v = fmaxf(v, sg[dir * 128 + p - off]); } LDS_SYNC(); if (act) sg[dir * 128 + p] = v; LDS_SYNC(); }
    if (act) { const float cm = sg[dir * 128 + p]; if (p == 127) red[2 + dir] = cm;
        const size_t gix = (size_t)(row0 + i) * 8 + dir * 4 + h;
        WSP(float, WS_GB)[gix] = bval; WSP(float, WS_GU)[gix] = u; WSP(float, WS_GCM)[gix] = cm; }
    LDS_SYNC();
    if (act) se[dir * 128 + i] = expf(u - red[2 + dir]);
    if (tid < 2) { float* msc = WSP(float, WS_MSC) + ((size_t)((b * 4 + h) * MLC + c) * 2 + tid) * 2; msc[0] = red[tid]; msc[1] = red[tid] + red[2 + tid]; }
    LDS_SYNC();
    const bf16_t* Pp = WSP(bf16_t, WS_P);
#pragma unroll
    for (int it = 0; it < 3; ++it) { const int idx = tid + NTHR * it, r = idx / 12, ch = idx % 12;
        const u32x4 kv = *(const u32x4*)(Pp + (size_t)(row0 + r) * NP + PC_K + h * 96 + ch * 8);
        *(LAS u32x4*)(Ks + r * 104 + ch * 8) = kv;
        const u32x4 vv = *(const u32x4*)(Pp + (size_t)(row0 + r) * NP + PC_V + h * 96 + ch * 8);
        const float e0 = se[r], e1 = se[128 + r];
        u32x4 o0, o1;
#pragma unroll
        for (int q = 0; q < 4; ++q) { const float lo = __uint_as_float(vv[q] << 16), hi = __uint_as_float(vv[q] & 0xFFFF0000u);
            o0[q] = pk_bf16(lo * e0, hi * e0); o1[q] = pk_bf16(lo * e1, hi * e1); }
        *(LAS u32x4*)(Ve + r * 104 + ch * 8) = o0; *(LAS u32x4*)(Ve + (128 + r) * 104 + ch * 8) = o1; }
    LDS_SYNC();
    {
        const int wd = cx.wave >> 2, q9 = (cx.wave & 3) * 9, fr = cx.lane & 15, fq = cx.lane >> 4;
        float* cl = WSP(float, WS_CLOC) + ((size_t)((b * 4 + h) * MLC + c) * 2 + wd) * 9216;
        const LAS bf16_t* V = Ve + wd * 128 * 104;
#pragma unroll 1
        for (int pi = q9; pi < q9 + 9; ++pi) { const int dt = pi / 6, et = pi % 6;
            f32x4 acc = (f32x4){0.f, 0.f, 0.f, 0.f};
#pragma unroll
            for (int kk = 0; kk < 4; ++kk) { bf16x8 a, bb;
#pragma unroll
                for (int j = 0; j < 8; ++j) { const int s = kk * 32 + fq * 8 + j; a[j] = (short)lds_u16(V + s * 104 + dt * 16 + fr); bb[j] = (short)lds_u16(Ks + s * 104 + et * 16 + fr); }
                acc = __builtin_amdgcn_mfma_f32_16x16x32_bf16(a, bb, acc, 0, 0, 0); }
#pragma unroll
            for (int r = 0; r < 4; ++r) cl[(dt * 16 + fq * 4 + r) * 96 + et * 16 + fr] = acc[r]; }
    }
    if (tid < 192) { const int d2 = tid / 96, e = tid % 96; float s = 0.f;
        for (int t = 0; t < 128; ++t) s += se[d2 * 128 + t] * bf2f(Ks[t * 104 + e]);
        WSP(float, WS_NLOC)[((size_t)((b * 4 + h) * MLC + c) * 2 + d2) * 96 + e] = s; }
    LDS_SYNC();
}

DEVI void ml_carry(const Ctx& cx) {
    for (int idx = cx.bid * NTHR + cx.tid; idx < 64 * 9312; idx += cx.G * NTHR) {
        const int combo = idx / 9312, el = idx % 9312, dir = combo & 1, bh = combo >> 1;
        float loc[MLC], bl[MLC], ml[MLC];
#pragma unroll
        for (int s = 0; s < MLC; ++s) {
            const int c = dir == 0 ? s : (s < 2 ? 1 - s : 19 - s);
            const size_t cb = (size_t)(bh * MLC + c) * 2 + dir;
            bl[s] = WSP(float, WS_MSC)[cb * 2]; ml[s] = WSP(float, WS_MSC)[cb * 2 + 1];
            loc[s] = el < 9216 ? WSP(float, WS_CLOC)[cb * 9216 + el] : WSP(float, WS_NLOC)[cb * 96 + el - 9216];
        }
        float Cv = 0.f, m = -1e30f;
#pragma unroll
        for (int s = 0; s < MLC; ++s) {
            const int c = dir == 0 ? s : (s < 2 ? 1 - s : 19 - s);
            const size_t cb = (size_t)(bh * MLC + c) * 2 + dir;
            if (el < 9216) WSP(bf16_t, WS_C0)[cb * 9216 + el] = f2bf(Cv); else WSP(float, WS_N0)[cb * 96 + el - 9216] = Cv;
            if (el == 0) WSP(float, WS_M0)[cb] = m;
            const float mn = fmaxf(bl[s] + m, ml[s]), a = __expf(bl[s] + m - mn), sc = __expf(ml[s] - mn);
            Cv = a * Cv + sc * loc[s]; m = mn;
        }
    }
}

DEVI void ml_out_unit(const Ctx& cx, int l, int b, int h, int c) {
    LAS bf16_t* Qs = (LAS bf16_t*)cx.lds;
    LAS bf16_t* Ks = Qs + 128 * 104;
    LAS bf16_t* Vs = Ks + 128 * 104;
    LAS bf16_t* C0s = Vs + 128 * 104;
    LAS float* gb = (LAS float*)(cx.lds + 119808);
    LAS float* gu = gb + 256;
    LAS float* gM = gu + 256;
    LAS float* n0s = gM + 256;
    LAS float* m0s = n0s + 192;
    const int row0 = ml_row0(b, c), tid = cx.tid;
    const bf16_t* Pp = WSP(bf16_t, WS_P);
    const size_t cb0 = (size_t)((b * 4 + h) * MLC + c) * 2;
#pragma unroll
    for (int it = 0; it < 3; ++it) { const int idx = tid + NTHR * it, r = idx / 12, ch = idx % 12;
        const bf16_t* rp = Pp + (size_t)(row0 + r) * NP + h * 96 + ch * 8;
        *(LAS u32x4*)(Qs + r * 104 + ch * 8) = *(const u32x4*)(rp + PC_Q);
        *(LAS u32x4*)(Ks + r * 104 + ch * 8) = *(const u32x4*)(rp + PC_K);
        *(LAS u32x4*)(Vs + r * 104 + ch * 8) = *(const u32x4*)(rp + PC_V); }
    for (int idx = tid; idx < 2 * 96 * 12; idx += NTHR) { const int d2 = idx / 1152, r = (idx % 1152) / 12, ch = idx % 12;
        *(LAS u32x4*)(C0s + (d2 * 96 + r) * 104 + ch * 8) = *(const u32x4*)(WSP(bf16_t, WS_C0) + (cb0 + d2) * 9216 + r * 96 + ch * 8); }
    if (tid < 256) { const int d2 = tid >> 7, i = tid & 127; const size_t gix = (size_t)(row0 + i) * 8 + d2 * 4 + h;
        gb[tid] = WSP(float, WS_GB)[gix]; gu[tid] = WSP(float, WS_GU)[gix];
        gM[tid] = fmaxf(WSP(float, WS_M0)[cb0 + d2], WSP(float, WS_GCM)[gix]); }
    if (tid >= 256 && tid < 448) { const int k = tid - 256; n0s[k] = WSP(float, WS_N0)[(cb0 + k / 96) * 96 + k % 96]; }
    if (tid >= 448 && tid < 450) m0s[tid - 448] = WSP(float, WS_M0)[cb0 + tid - 448];
    LDS_SYNC();
    const int w = cx.wave, fr = cx.lane & 15, fq = cx.lane >> 4, t = 16 * w + fr;
    bf16x8 qf[3];
#pragma unroll
    for (int kk = 0; kk < 3; ++kk) qf[kk] = *(const LAS bf16x8*)(Qs + t * 104 + kk * 32 + fq * 8);
    f32x4 hs[6];
#pragma unroll
    for (int n = 0; n < 6; ++n) hs[n] = (f32x4){0.f, 0.f, 0.f, 0.f};
#pragma unroll
    for (int dir = 0; dir < 2; ++dir) {
        const float Mt = gM[dir * 128 + t], bt = gb[dir * 128 + t], inter = __expf(m0s[dir] - Mt);
        f32x4 an[6];
#pragma unroll
        for (int n = 0; n < 6; ++n) an[n] = (f32x4){0.f, 0.f, 0.f, 0.f};
        float den = 0.f;
        const int Jlo = dir == 0 ? 0 : (w >> 1), Jhi = dir == 0 ? (w >> 1) : 3;
#pragma unroll 1
        for (int J = Jlo; J <= Jhi; ++J) {
            bf16x8 pf;
#pragma unroll
            for (int half = 0; half < 2; ++half) {
                const int j = 2 * J + half;
                f32x4 D = (f32x4){0.f, 0.f, 0.f, 0.f};
                const bool need = dir == 0 ? (j <= w) : (j >= w);
                if (need) {
#pragma unroll
                    for (int kk = 0; kk < 3; ++kk) { const bf16x8 kf = *(const LAS bf16x8*)(Ks + (16 * j + fr) * 104 + kk * 32 + fq * 8);
                        D = __builtin_amdgcn_mfma_f32_16x16x32_bf16(kf, qf[kk], D, 0, 0, 0); }
                }
                const f32x4 us = *(const LAS f32x4*)(gu + dir * 128 + 16 * j + 4 * fq);
                float pv[4];
#pragma unroll
                for (int r = 0; r < 4; ++r) { const int s = 16 * j + 4 * fq + r; const bool valid = need && (dir == 0 ? (s <= t) : (s >= t));
                    pv[r] = valid ? D[r] * __expf(us[r] - Mt) : 0.f; den += pv[r]; }
                pf[half * 4 + 0] = (short)f2bf(pv[0]); pf[half * 4 + 1] = (short)f2bf(pv[1]); pf[half * 4 + 2] = (short)f2bf(pv[2]); pf[half * 4 + 3] = (short)f2bf(pv[3]);
            }
#pragma unroll
            for (int n = 0; n < 6; ++n) { bf16x8 vf;
#pragma unroll
                for (int jj = 0; jj < 8; ++jj) { const int s = 32 * J + (jj < 4 ? 4 * fq + jj : 16 + 4 * fq + (jj - 4)); vf[jj] = (short)lds_u16(Vs + s * 104 + 16 * n + fr); }
                an[n] = __builtin_amdgcn_mfma_f32_16x16x32_bf16(vf, pf, an[n], 0, 0, 0); }
        }
        float nq = 0.f;
#pragma unroll
        for (int kk = 0; kk < 3; ++kk)
#pragma unroll
            for (int j = 0; j < 8; ++j) nq += n0s[dir * 96 + kk * 32 + fq * 8 + j] * bf2f((bf16_t)qf[kk][j]);
        nq += shx<16>(nq, cx.lane); nq += shx<32>(nq, cx.lane);
        den += shx<16>(den, cx.lane); den += shx<32>(den, cx.lane);
        const float dtot = den + inter * nq;
        const float inv = frcp(fmaxf(fabsf(dtot), __expf(-(Mt + bt))));
#pragma unroll
        for (int n = 0; n < 6; ++n) { f32x4 ac = (f32x4){0.f, 0.f, 0.f, 0.f};
#pragma unroll
            for (int kk = 0; kk < 3; ++kk) { const bf16x8 cf = *(const LAS bf16x8*)(C0s + (dir * 96 + 16 * n + fr) * 104 + kk * 32 + fq * 8);
                ac = __builtin_amdgcn_mfma_f32_16x16x32_bf16(cf, qf[kk], ac, 0, 0, 0); }
            hs[n] += (an[n] + ac * inter) * inv; }
    }
    float ss = 0.f;
#pragma unroll
    for (int n = 0; n < 6; ++n) ss += hs[n][0] * hs[n][0] + hs[n][1] * hs[n][1] + hs[n][2] * hs[n][2] + hs[n][3] * hs[n][3];
    ss += shx<16>(ss, cx.lane); ss += shx<32>(ss, cx.lane);
    const float rstd = rsqrtf(ss * (1.0f / 96.0f) + EPS);
    const size_t prow = (size_t)(row0 + t);
#pragma unroll
    for (int n = 0; n < 6; ++n) { const int d = 16 * n + 4 * fq;
        const u32x2 ov = *(const u32x2*)(Pp + prow * NP + PC_O + h * 96 + d);
        const f32x4 mw = *(const f32x4*)(cx.p->in[I_MIXW] + l * 1024 + h * 96 + d);
        const float o0 = __uint_as_float(ov.x << 16), o1 = __uint_as_float(ov.x & 0xFFFF0000u), o2 = __uint_as_float(ov.y << 16), o3 = __uint_as_float(ov.y & 0xFFFF0000u);
        u32x2 wv; wv.x = pk_bf16(sigmoidf_(o0) * hs[n][0] * rstd * mw[0], sigmoidf_(o1) * hs[n][1] * rstd * mw[1]);
        wv.y = pk_bf16(sigmoidf_(o2) * hs[n][2] * rstd * mw[2], sigmoidf_(o3) * hs[n][3] * rstd * mw[3]);
        *(u32x2*)(WSP(bf16_t, WS_MRG) + prow * 1024 + h * 96 + d) = wv; }
    LDS_SYNC();
}

DEVI void rg_unit(const Ctx& cx, int l, int b, int ck, int g, int mode) {
    const Params& P = *cx.p;
    LAS float* xraw = (LAS float*)cx.lds;
    LAS float* xc = (LAS float*)(cx.lds + 17408);
    LAS bf16_t* xcb = (LAS bf16_t*)(cx.lds + 33792);
    LAS float* ab = (LAS float*)(cx.lds + 43008);
    LAS float* hbuf = (LAS float*)(cx.lds + 43008 + 65536);
    const int tid = cx.tid;
    const int t0 = ck < 4 ? ck * 64 : (ck - 4) * 64, seglen = ck < 4 ? CTXL : SEQ, rowbase = ck < 4 ? b * CTXL : TCTX + b * SEQ;
    const bf16_t* Pp = WSP(bf16_t, WS_P);
    for (int idx = tid; idx < 67 * 8; idx += NTHR) { const int r = idx >> 3, c8 = idx & 7, tt = t0 - 2 + r;
        u32x4 v = (u32x4){0u, 0u, 0u, 0u};
        if (tt >= 0 && tt < seglen) v = *(const u32x4*)(Pp + (size_t)(rowbase + tt) * NP + PC_RX + g * 64 + c8 * 8);
#pragma unroll
        for (int q = 0; q < 4; ++q) { xraw[r * 64 + c8 * 8 + 2 * q] = __uint_as_float(v[q] << 16); xraw[r * 64 + c8 * 8 + 2 * q + 1] = __uint_as_float(v[q] & 0xFFFF0000u); } }
    LDS_SYNC();
#pragma unroll
    for (int it = 0; it < 8; ++it) { const int idx = tid + NTHR * it, t = idx >> 6, ch = idx & 63, cg = g * 64 + ch;
        float v = P.in[I_RGCB][l * 384 + cg];
#pragma unroll
        for (int j = 0; j < 4; ++j) v += P.in[I_RGCW][(l * 4 + j) * 384 + cg] * xraw[(t + j) * 64 + ch];
        xc[t * 64 + ch] = v; xcb[t * 72 + ch] = f2bf(v); }
    LDS_SYNC();
    {
        const int dir = cx.wave >> 2, cg4 = cx.wave & 3, fr = cx.lane & 15, fq = cx.lane >> 4;
        const bf16_t* wrg = WSP(bf16_t, WS_WRG) + (size_t)(l * 6 + g) * 256 * 64;
        f32x4 ar[4], ai[4];
#pragma unroll
        for (int m = 0; m < 4; ++m) { ar[m] = (f32x4){0.f, 0.f, 0.f, 0.f}; ai[m] = (f32x4){0.f, 0.f, 0.f, 0.f}; }
#pragma unroll
        for (int kk = 0; kk < 2; ++kk) {
            const bf16x8 br = ldg8(wrg + (size_t)((dir * 2 + 0) * 64 + cg4 * 16 + fr) * 64 + kk * 32 + fq * 8);
            const bf16x8 bi = ldg8(wrg + (size_t)((dir * 2 + 1) * 64 + cg4 * 16 + fr) * 64 + kk * 32 + fq * 8);
#pragma unroll
            for (int m = 0; m < 4; ++m) { const bf16x8 a = *(const LAS bf16x8*)(xcb + (m * 16 + fr) * 72 + kk * 32 + fq * 8);
                ar[m] = __builtin_amdgcn_mfma_f32_16x16x32_bf16(br, a, ar[m], 0, 0, 0); ai[m] = __builtin_amdgcn_mfma_f32_16x16x32_bf16(bi, a, ai[m], 0, 0, 0); }
        }
        const int ch0 = cg4 * 16 + 4 * fq, cgl = g * 64 + ch0;
        const f32x4 ba = *(const f32x4*)(P.in[I_RGBA] + (l * 2 + dir) * 384 + cgl), bx = *(const f32x4*)(P.in[I_RGBX] + (l * 2 + dir) * 384 + cgl);
        const f32x4 lam = *(const f32x4*)(P.in[I_RGLAM] + (l * 2 + dir) * 384 + cgl);
        float sp[4];
#pragma unroll
        for (int j = 0; j < 4; ++j) sp[j] = lam[j] > 0.f ? log1p_(__expf(-lam[j])) : -lam[j] + log1p_(__expf(lam[j]));
#pragma unroll
        for (int m = 0; m < 4; ++m) { const int t = m * 16 + fr; const f32x4 xv = *(const LAS f32x4*)(xc + t * 64 + ch0);
            f32x4 av, bv;
#pragma unroll
            for (int j = 0; j < 4; ++j) { const float r = frcp(1.0f + __expf(-(ar[m][j] + ba[j]))), ii = frcp(1.0f + __expf(-(ai[m][j] + bx[j])));
                const float la = -8.0f * r * sp[j], y = 2.0f * la; av[j] = __expf(la);
                const float nem1 = y > -0.02f ? -y * (1.0f + y * (0.5f + y * 0.16666667f)) : 1.0f - av[j] * av[j];
                bv[j] = sqrtf(nem1) * (ii * xv[j]); }
            *(LAS f32x4*)(ab + ((dir * 2 + 0) * 64 + t) * 64 + ch0) = av; *(LAS f32x4*)(ab + ((dir * 2 + 1) * 64 + t) * 64 + ch0) = bv; }
    }
    LDS_SYNC();
    if (tid < 128) { const int dir = tid >> 6, ch = tid & 63; const size_t ix = ((size_t)(b * RGC + ck) * 2 + dir) * 384 + g * 64 + ch;
        float hc = mode ? WSP(float, WS_RGC)[ix] : 0.f, ap = 1.0f;
        const LAS float* __restrict__ A = ab + (dir * 2 + 0) * 4096 + ch; const LAS float* __restrict__ B = ab + (dir * 2 + 1) * 4096 + ch; LAS float* __restrict__ H = hbuf + dir * 4096 + ch;
#pragma unroll 1
        for (int s0 = 0; s0 < 64; s0 += 16) { float av[16], bv[16];
#pragma unroll
            for (int j = 0; j < 16; ++j) { const int t = dir ? 63 - (s0 + j) : s0 + j; av[j] = A[t * 64]; bv[j] = B[t * 64]; }
#pragma unroll
            for (int j = 0; j < 16; ++j) { const int t = dir ? 63 - (s0 + j) : s0 + j; hc = av[j] * hc + bv[j]; ap *= av[j]; if (mode) H[t * 64] = hc; } }
        if (!mode) { WSP(float, WS_RGA)[ix] = ap; WSP(float, WS_RGB)[ix] = hc; } }
    LDS_SYNC();
    if (mode) { const int t = tid >> 3, ch0 = (tid & 7) * 8; float hv[8]; float ss = 0.f;
#pragma unroll
        for (int j = 0; j < 8; ++j) { hv[j] = hbuf[t * 64 + ch0 + j] + hbuf[4096 + t * 64 + ch0 + j]; ss += hv[j] * hv[j]; }
        ss += dpp_<0xB1, 0xF>(ss); ss += dpp_<0x4E, 0xF>(ss); ss += dpp_<0x141, 0xF>(ss);
        const float rstd = rsqrtf(ss * (1.0f / 64.0f) + EPS);
        const size_t row = (size_t)(rowbase + t0 + t);
        const u32x4 gv = *(const u32x4*)(Pp + row * NP + PC_RG + g * 64 + ch0);
        const float* mw = P.in[I_MIXW] + l * 1024 + 384 + g * 64 + ch0;
        u32x4 o;
#pragma unroll
        for (int q = 0; q < 4; ++q) { const float g0 = __uint_as_float(gv[q] << 16), g1v = __uint_as_float(gv[q] & 0xFFFF0000u);
            o[q] = pk_bf16(g0 * hv[2 * q] * rstd * mw[2 * q], g1v * hv[2 * q + 1] * rstd * mw[2 * q + 1]); }
        *(u32x4*)(WSP(bf16_t, WS_MRG) + row * 1024 + 384 + g * 64 + ch0) = o;
        LDS_SYNC(); }
}
DEVI void rg_carry(const Ctx& cx) {
    for (int idx = (cx.G - 1 - cx.bid) * NTHR + cx.tid; idx < NB * 2 * 384; idx += cx.G * NTHR) {
        const int ch = idx % 384, dir = (idx / 384) & 1, b = idx / 768;
        float A[RGC], B[RGC];
#pragma unroll
        for (int s = 0; s < RGC; ++s) { const int ck = dir == 0 ? s : (s < 4 ? 3 - s : 39 - s);
            const size_t ix = ((size_t)(b * RGC + ck) * 2 + dir) * 384 + ch; A[s] = WSP(float, WS_RGA)[ix]; B[s] = WSP(float, WS_RGB)[ix]; }
        float h = 0.f;
#pragma unroll
        for (int s = 0; s < RGC; ++s) { const int ck = dir == 0 ? s : (s < 4 ? 3 - s : 39 - s);
            const size_t ix = ((size_t)(b * RGC + ck) * 2 + dir) * 384 + ch; WSP(float, WS_RGC)[ix] = h; h = A[s] * h + B[s]; }
    }
}

DEVI int s5_trow(int rowi, int s) { const int b = rowi / S5C, c = rowi % S5C; return c < 8 ? b * CTXL + c * 32 + s : TCTX + b * SEQ + s * 64 + (c - 8); }
DEVI void s5_local_wave(const Ctx& cx, int l, int wu) {
    const int g = wu / 36, mt = (wu % 36) / 4, nt = wu % 4;
    const bf16_t* Pp = WSP(bf16_t, WS_P) + PC_S5 + g * 16;
    const bf16_t* we = WSP(bf16_t, WS_WE) + (size_t)(l * 16 + g) * 256 * 512 + (size_t)nt * 64 * 512;
    f32x4 acc[4][4];
    wave_gemm<4, 4>(cx.lane, 512, [&](int row, int k) { return ldg8(Pp + (size_t)s5_trow(mt * 64 + row, k >> 4) * NP + (k & 15)); },
                         [&](int row, int k) { return ldg8(we + (size_t)row * 512 + k); }, acc);
    const int fr = cx.lane & 15, fq = cx.lane >> 4;
#pragma unroll
    for (int m = 0; m < 4; ++m)
#pragma unroll
        for (int n = 0; n < 4; ++n) *(f32x4*)(WSP(float, WS_SLOC) + ((size_t)g * S5R + mt * 64 + m * 16 + fr) * 256 + nt * 64 + n * 16 + 4 * fq) = acc[m][n];
}
DEVI void s5_carry(const Ctx& cx, int l) {
    for (int idx = cx.bid * NTHR + cx.tid; idx < NB * 16 * 2 * 64; idx += cx.G * NTHR) {
        const int n = idx & 63, d = (idx >> 6) & 1, g = (idx >> 7) & 15, b = idx >> 11;
        const f32x2 a32 = WSP(f32x2, WS_PW)[(size_t)(((l * 16 + g) * 2 + d) * 64 + n) * 33 + 32];
        float sr = 0.f, si = 0.f;
#pragma unroll 1
        for (int s0 = 0; s0 < S5C; s0 += 24) {
            float lr[24], li[24];
#pragma unroll
            for (int j = 0; j < 24; ++j) { const int s = s0 + j, c = d == 0 ? s : (s < 8 ? 7 - s : 79 - s);
                const size_t ix = ((size_t)g * S5R + b * S5C + c) * 256 + d * 128 + n; lr[j] = WSP(float, WS_SLOC)[ix]; li[j] = WSP(float, WS_SLOC)[ix + 64]; }
#pragma unroll
            for (int j = 0; j < 24; ++j) { const int s = s0 + j, c = d == 0 ? s : (s < 8 ? 7 - s : 79 - s);
                const size_t ix = ((size_t)g * S5R + b * S5C + c) * 256 + d * 128 + n;
                WSP(bf16_t, WS_SIN)[ix] = f2bf(sr); WSP(bf16_t, WS_SIN)[ix + 64] = f2bf(si);
                const float nr = a32.x * sr - a32.y * si + lr[j], ni = a32.x * si + a32.y * sr + li[j]; sr = nr; si = ni; }
        }
    }
}
DEVI void s5_out_wave(const Ctx& cx, int l, int wu) {
    const int g = wu / 72, mt = (wu % 72) / 8, nt = wu % 8;
    const bf16_t* Pp = WSP(bf16_t, WS_P) + PC_S5 + g * 16;
    const bf16_t* sin_ = WSP(bf16_t, WS_SIN) + (size_t)g * S5R * 256;
    const bf16_t* wy = WSP(bf16_t, WS_WY) + (size_t)(l * 16 + g) * 512 * 768 + (size_t)nt * 64 * 768;
    f32x4 acc[4][4];
    wave_gemm<4, 4>(cx.lane, 768, [&](int row, int k) { return k < 512 ? ldg8(Pp + (size_t)s5_trow(mt * 64 + row, k >> 4) * NP + (k & 15)) : ldg8(sin_ + (size_t)(mt * 64 + row) * 256 + (k - 512)); },
                         [&](int row, int k) { return ldg8(wy + (size_t)row * 768 + k); }, acc);
    const int fr = cx.lane & 15, fq = cx.lane >> 4;
#pragma unroll
    for (int m = 0; m < 4; ++m)
#pragma unroll
        for (int n = 0; n < 4; ++n) { const int trow = s5_trow(mt * 64 + m * 16 + fr, nt * 4 + n);
            u32x2 w; w.x = pk_bf16(gelu_tanh(acc[m][n][0]), gelu_tanh(acc[m][n][1])); w.y = pk_bf16(gelu_tanh(acc[m][n][2]), gelu_tanh(acc[m][n][3]));
            *(u32x2*)(WSP(bf16_t, WS_GS) + (size_t)trow * 256 + g * 16 + 4 * fq) = w; }
}
DEVI void s5_glu_wave(const Ctx& cx, int l, int wu) {
    const int mt = wu / 4, nt = wu % 4;
    const bf16_t* gs = WSP(bf16_t, WS_GS) + (size_t)mt * 64 * 256;
    const bf16_t* wg = WSP(bf16_t, WS_WGLU) + (size_t)l * 65536 + (size_t)nt * 64 * 256;
    f32x4 acc[4][4];
    wave_gemm<4, 4>(cx.lane, 256, [&](int row, int k) { return ldg8(gs + (size_t)row * 256 + k); }, [&](int row, int k) { return ldg8(wg + (size_t)row * 256 + k); }, acc);
    const int fr = cx.lane & 15, fq = cx.lane >> 4;
#pragma unroll
    for (int n = 0; n < 4; ++n) { const int col = nt * 64 + n * 16 + 4 * fq;
        const f32x4 gb = *(const f32x4*)(cx.p->in[I_S5GB] + l * 256 + col), mw = *(const f32x4*)(cx.p->in[I_MIXW] + l * 1024 + 768 + col);
#pragma unroll
        for (int m = 0; m < 4; ++m) { const size_t trow = (size_t)mt * 64 + m * 16 + fr;
            const u32x2 gv = *(const u32x2*)(WSP(bf16_t, WS_GS) + trow * 256 + col);
            const float gq[4] = {__uint_as_float(gv.x << 16), __uint_as_float(gv.x & 0xFFFF0000u), __uint_as_float(gv.y << 16), __uint_as_float(gv.y & 0xFFFF0000u)};
            float o[4]; float ss = 0.f;
#pragma unroll
            for (int j = 0; j < 4; ++j) { o[j] = gq[j] * frcp(1.0f + __expf(-(acc[m][n][j] + gb[j]))); ss += o[j] * o[j]; }
            ss += shx<16>(ss, cx.lane); ss += shx<32>(ss, cx.lane);
            const float rstd = rsqrtf(ss * (1.0f / 16.0f) + EPS);
            u32x2 w; w.x = pk_bf16(o[0] * rstd * mw[0], o[1] * rstd * mw[1]); w.y = pk_bf16(o[2] * rstd * mw[2], o[3] * rstd * mw[3]);
            *(u32x2*)(WSP(bf16_t, WS_MRG) + trow * 1024 + 768 + col) = w; } }
}

#ifndef PH_DUP2
#define PH_DUP2 0
#endif
#define REP_(k) for (int rep_ = 0; rep_ < 1 + ((PH_DUP2 >> (k)) & 1); ++rep_)
DEVI void ph_mix_local(const Ctx& cx, int l) {
    REP_(0) for (int u = cx.bid; u < NB * 4 * MLC; u += cx.G) ml_local_unit(cx, l, u / (4 * MLC), (u / MLC) % 4, u % MLC);
    REP_(1) { const int off = (NB * 4 * MLC) % cx.G; const int first = (cx.bid - off + cx.G) % cx.G;
      for (int u = first; u < NB * RGC * 6; u += cx.G) rg_unit(cx, l, u / (RGC * 6), (u / 6) % RGC, u % 6, 0); }
    REP_(2) { const int off = (NB * 4 * MLC + NB * RGC * 6) % cx.G; const int first = (cx.bid - off + cx.G) % cx.G;
      for (int wu = first * 8 + cx.wave; wu < 16 * 36; wu += cx.G * 8) s5_local_wave(cx, l, wu); }
}
DEVI void ph_mix_carry(const Ctx& cx, int l) { ml_carry(cx); rg_carry(cx); s5_carry(cx, l); }
DEVI void ph_mix_out(const Ctx& cx, int l) {
    const bool last = (l == DEPTH - 1);
    REP_(3) for (int u = cx.bid; u < NB * 4 * MLC; u += cx.G) { const int c = u % MLC; if (last && c < 2) continue; ml_out_unit(cx, l, u / (4 * MLC), (u / MLC) % 4, c); }
    REP_(4) { const int off = (NB * 4 * MLC) % cx.G; const int first = (cx.bid - off + cx.G) % cx.G;
      for (int u = first; u < NB * RGC * 6; u += cx.G) { const int ck = (u / 6) % RGC; if (last && ck < 4) continue; rg_unit(cx, l, u / (RGC * 6), ck, u % 6, 1); } }
    REP_(5) { const int off = (NB * 4 * MLC + NB * RGC * 6) % cx.G; const int first = (cx.bid - off + cx.G) % cx.G;
      for (int wu = first * 8 + cx.wave; wu < 16 * 72; wu += cx.G * 8) s5_out_wave(cx, l, wu); }
}
DEVI void ph_glu(const Ctx& cx, int l) {
    for (int wu = cx.bid * 8 + cx.wave; wu < (TT / 64) * 4; wu += cx.G * 8) s5_glu_wave(cx, l, wu);
}

DEVI unsigned st_launder(unsigned s_addr) { unsigned a; asm volatile("v_mov_b32 %0, %1" : "=v"(a) : "s"(s_addr)); return a; }
constexpr int N_STEPS = 3 + 10 * DEPTH + 1;
__global__ void __launch_bounds__(NTHR, 2) mk_fwd(Params p) {
    extern __shared__ __attribute__((aligned(16))) unsigned char lds_raw[];
    Ctx cx; cx.p = &p; cx.ws = p.ws; cx.lds = (LAS unsigned char*)lds_raw; cx.tid = threadIdx.x; cx.lane = cx.tid & 63;
    cx.wave = __builtin_amdgcn_readfirstlane((int)threadIdx.x >> 6); cx.G = gridDim.x; cx.bid = blockIdx.x;
    volatile LAS unsigned* st = (volatile LAS unsigned*)(cx.lds + LDS_BYTES - 16);
    const unsigned st_s = (unsigned)__builtin_amdgcn_readfirstlane((int)(unsigned)(size_t)(LAS unsigned*)(cx.lds + LDS_BYTES - 16));
#define ST_P ((volatile LAS unsigned*)(size_t)st_launder(st_s))
    if (cx.tid == 0) { st[0] = 0u; st[1] = 0u; st[2] = (unsigned)p.lo; st[3] = (unsigned)p.hi; }
    __syncthreads();
    (void)xcd_barrier_post((unsigned*)(p.ws + WS_CTL) + CW_BAR, st);
#define GRID_BAR() do { XcdBarrier b_; b_.bar = (unsigned*)(p.ws + WS_CTL) + CW_BAR; b_.x = (unsigned)__builtin_amdgcn_readfirstlane((int)xb_xcc_id()); b_.st = ST_P; xcd_barrier(b_); } while (0)
#ifndef PH_MASK
#define PH_MASK 0xFFFF
#endif
#ifndef PH_DUP
#define PH_DUP 0
#endif
#define STEP_(id, k, call) do { const int lo_ = __builtin_amdgcn_readfirstlane((int)ST_P[2]), hi_ = __builtin_amdgcn_readfirstlane((int)ST_P[3]); if (lo_ <= (k) && (k) < hi_) { if ((PH_MASK >> (id)) & 1) { const Ctx cl = relaunder(cx); call; } if ((PH_DUP >> (id)) & 1) { GRID_BAR(); const Ctx cl = relaunder(cx); call; } if ((k) + 1 < hi_) GRID_BAR(); } } while (0)
    STEP_(0, 0, ph_pro_a(cl));
    STEP_(1, 1, ph_pro_b(cl));
    STEP_(2, 2, ph_pro_c(cl));
#pragma unroll 1
    for (int l = 0; l < DEPTH; ++l) {
        const int s0 = 3 + 10 * l;
        STEP_(3, s0 + 0, ph_norm1(cl, l));
        STEP_(4, s0 + 1, ph_inproj(cl, l));
        STEP_(5, s0 + 2, ph_mix_local(cl, l));
        STEP_(6, s0 + 3, ph_mix_carry(cl, l));
        STEP_(7, s0 + 4, ph_mix_out(cl, l));
        STEP_(8, s0 + 5, ph_glu(cl, l));
        STEP_(9, s0 + 6, ph_outproj(cl, l));
        STEP_(10, s0 + 7, ph_norm2(cl, l));
        STEP_(11, s0 + 8, ph_moe_gu(cl, l));
        STEP_(12, s0 + 9, ph_moe_dn(cl, l));
    }
    STEP_(13, N_STEPS - 1, ph_norm1(cl, DEPTH));
#undef STEP_
}

extern "C" void kernel_launch(void* const* d_in, const int* in_sizes, int n_in, void* d_out, int out_size, void* d_ws, size_t ws_size, hipStream_t stream) {
    static int grid = 0;
    if (grid == 0) {
        if (n_in != 36 || out_size != TLAT * DM || ws_size < WS_END) { fprintf(stderr, "kernel_launch: unexpected problem (n_in %d, out %d, ws %zu < %zu)\n", n_in, out_size, ws_size, (size_t)WS_END); grid = -1; return; }
        int dev = 0, cus = 0, per_cu = 0;
        if (hipGetDevice(&dev) != hipSuccess || hipDeviceGetAttribute(&cus, hipDeviceAttributeMultiprocessorCount, dev) != hipSuccess) { grid = -1; return; }
        if (hipFuncSetAttribute((const void*)mk_fwd, hipFuncAttributeMaxDynamicSharedMemorySize, LDS_BYTES) != hipSuccess) { fprintf(stderr, "kernel_launch: hipFuncSetAttribute failed\n"); grid = -1; return; }
        if (hipOccupancyMaxActiveBlocksPerMultiprocessor(&per_cu, (const void*)mk_fwd, NTHR, LDS_BYTES) != hipSuccess || per_cu < 1) { fprintf(stderr, "kernel_launch: occupancy query says %d blocks per CU\n", per_cu); }
        (void)hipGetLastError();
        grid = cus;
    }
    if (grid < 0) return;
    (void)hipMemsetAsync((char*)d_ws + WS_CTL, 0, CTL_BYTES, stream);
    Params p{};
    for (int i = 0; i < 36; ++i) p.in[i] = (const float*)d_in[i];
    p.out = (float*)d_out; p.ws = (unsigned char*)d_ws;
#if MK_FUSED
    p.lo = 0; p.hi = N_STEPS;
    hipLaunchKernelGGL(mk_fwd, dim3(grid), dim3(NTHR), LDS_BYTES, stream, p);
#else
    for (int k = 0; k < N_STEPS; ++k) { p.lo = k; p.hi = k + 1; hipLaunchKernelGGL(mk_fwd, dim3(grid), dim3(NTHR), LDS_BYTES, stream, p); }
#endif
}
```

```cpp
#include <hip/hip_runtime.h>
#include <stdint.h>
#include <stdio.h>

#ifndef MK_FUSED
#define MK_FUSED 1
#endif

typedef unsigned short bf16_t;
typedef short bf16x8 __attribute__((ext_vector_type(8)));
typedef float f32x4 __attribute__((ext_vector_type(4)));
typedef float f32x2 __attribute__((ext_vector_type(2)));
typedef unsigned u32x4 __attribute__((ext_vector_type(4)));
typedef unsigned u32x2 __attribute__((ext_vector_type(2)));
typedef int i32x4 __attribute__((ext_vector_type(4)));
typedef int i32x8 __attribute__((ext_vector_type(8)));
#define LAS __attribute__((address_space(3)))
#define DEVI __device__ __forceinline__

constexpr int DM = 1024, NB = 8, SEQ = 2048, CTXL = 256, DEPTH = 4;
constexpr int TCTX = NB * CTXL, TLAT = NB * SEQ, TT = TCTX + TLAT;
constexpr int DIN = 2576, NP = 2560;
constexpr int NE = 32;
constexpr int PMAX = 81920;
constexpr int NTHR = 512;
constexpr int LDS_BYTES = 152 * 1024;
constexpr float EPS = 1e-6f;
constexpr float W8_SCALE = 32.0f, W8_INV = 0.03125f;
constexpr float Y8_SCALE = 8.0f, Y8_INV = 0.125f;
constexpr int PC_Q = 0, PC_K = 384, PC_V = 768, PC_O = 1152, PC_RX = 1536, PC_RG = 1920, PC_S5 = 2304;
constexpr int MLC = 18;
constexpr int RGC = 36;
constexpr int S5C = 72, S5R = NB * S5C;

constexpr size_t al256(size_t x) { return (x + 255) & ~(size_t)255; }
constexpr size_t WS_CTL   = 0;
constexpr size_t CTL_BYTES = 65536;
constexpr size_t CW_BAR = 0;
constexpr size_t CW_CNT = 4096;
constexpr size_t WS_WIN   = al256(WS_CTL + CTL_BYTES);
constexpr size_t WS_WOUT  = al256(WS_WIN + (size_t)DEPTH * NP * 1024 * 2);
constexpr size_t WS_WGU   = al256(WS_WOUT + (size_t)DEPTH * 1024 * 1024 * 2);
constexpr size_t WS_WD    = al256(WS_WGU + (size_t)DEPTH * NE * 2048 * 1024 * 2);
constexpr size_t WS_MOD   = al256(WS_WD + (size_t)DEPTH * NE * 1024 * 1024 * 2);
constexpr size_t WS_PW    = al256(WS_MOD + (size_t)DEPTH * 9 * 6144 * 4);
constexpr size_t WS_BB    = al256(WS_PW + (size_t)DEPTH * 16 * 2 * 64 * 33 * 8);
constexpr size_t WS_KT    = al256(WS_BB + (size_t)DEPTH * 16 * 2 * 64 * 16 * 8);
constexpr size_t WS_WY    = al256(WS_KT + (size_t)DEPTH * 16 * 2 * 32 * 256 * 4);
constexpr size_t WS_WE    = al256(WS_WY + (size_t)DEPTH * 16 * 512 * 768 * 2);
constexpr size_t WS_WRG   = al256(WS_WE + (size_t)DEPTH * 16 * 256 * 512 * 2);
constexpr size_t WS_WGLU  = al256(WS_WRG + (size_t)DEPTH * 6 * 256 * 64 * 2);
constexpr size_t WS_XS    = al256(WS_WGLU + (size_t)DEPTH * 256 * 256 * 2);
constexpr size_t WS_XMID  = al256(WS_XS + (size_t)TT * 1024 * 4);
constexpr size_t WS_H     = al256(WS_XMID + (size_t)TT * 1024 * 4);
constexpr size_t WS_GT    = al256(WS_H + (size_t)TT * 1024 * 2);
constexpr size_t WS_P     = al256(WS_GT + (size_t)TT * 16 * 4);
constexpr size_t WS_GB    = al256(WS_P + (size_t)TT * NP * 2);
constexpr size_t WS_GU    = al256(WS_GB + (size_t)TT * 8 * 4);
constexpr size_t WS_GCM   = al256(WS_GU + (size_t)TT * 8 * 4);
constexpr size_t WS_MSC   = al256(WS_GCM + (size_t)TT * 8 * 4);
constexpr size_t WS_CLOC  = al256(WS_MSC + (size_t)8 * 4 * 18 * 2 * 2 * 4);
constexpr size_t WS_NLOC  = al256(WS_CLOC + (size_t)8 * 4 * 18 * 2 * 9216 * 4);
constexpr size_t WS_C0    = al256(WS_NLOC + (size_t)8 * 4 * 18 * 2 * 96 * 4);
constexpr size_t WS_N0    = al256(WS_C0 + (size_t)8 * 4 * 18 * 2 * 9216 * 2);
constexpr size_t WS_M0    = al256(WS_N0 + (size_t)8 * 4 * 18 * 2 * 96 * 4);
constexpr size_t WS_RGA   = al256(WS_M0 + (size_t)8 * 4 * 18 * 2 * 4);
constexpr size_t WS_RGB   = al256(WS_RGA + (size_t)8 * 36 * 2 * 384 * 4);
constexpr size_t WS_RGC   = al256(WS_RGB + (size_t)8 * 36 * 2 * 384 * 4);
constexpr size_t WS_SLOC  = al256(WS_RGC + (size_t)8 * 36 * 2 * 384 * 4);
constexpr size_t WS_SIN   = al256(WS_SLOC + (size_t)16 * 576 * 256 * 4);
constexpr size_t WS_GS    = al256(WS_SIN + (size_t)16 * 576 * 256 * 2);
constexpr size_t WS_MRG   = al256(WS_GS + (size_t)TT * 256 * 2);
constexpr size_t WS_ELIST = al256(WS_MRG + (size_t)TT * 1024 * 2);
constexpr size_t WS_GLIST = al256(WS_ELIST + (size_t)NE * TT * 4);
constexpr size_t WS_TINFO = al256(WS_GLIST + (size_t)NE * TT * 4);
constexpr size_t WS_ACT   = al256(WS_TINFO + (size_t)TT * 4 * 4);
constexpr size_t WS_YPAD  = al256(WS_ACT + (size_t)PMAX * 1024 * 2);
constexpr size_t WS_BIN2  = al256(WS_YPAD + (size_t)PMAX * 1024 * 2);
constexpr size_t WS_HLO   = al256(WS_BIN2 + (size_t)DEPTH * NP * 4);
constexpr size_t WS_WGT   = al256(WS_HLO + (size_t)TT * 1024 * 2);
constexpr size_t WS_RWH   = al256(WS_WGT + (size_t)DEPTH * 16 * 1024 * 2);
constexpr size_t WS_RWL   = al256(WS_RWH + (size_t)DEPTH * 32 * 1024 * 2);
constexpr size_t WS_H8    = al256(WS_RWL + (size_t)DEPTH * 32 * 1024 * 2);
constexpr size_t WS_END   = al256(WS_H8 + (size_t)TT * 1024);

struct Params { const float* in[36]; float* out; unsigned char* ws; int lo, hi; };

enum { I_X = 0, I_C, I_CTX, I_CCTX, I_ADAW, I_ADAB, I_N1W, I_WIN, I_BIN, I_RGCW, I_RGCB, I_RGWA, I_RGBA, I_RGWX, I_RGBX, I_RGLAM,
       I_S5LRE, I_S5LIM, I_S5LDT, I_S5BRE, I_S5BIM, I_S5CRE, I_S5CIM, I_S5D, I_S5GW, I_S5GB, I_MIXW, I_WOUT, I_N2W, I_RW, I_RB,
       I_WGU, I_BGU, I_WD, I_BD, I_FNW };

DEVI bf16_t f2bf(float f) { unsigned u = __float_as_uint(f); u += 0x7FFFu + ((u >> 16) & 1u); return (bf16_t)(u >> 16); }
DEVI float bf2f(bf16_t b) { return __uint_as_float(((unsigned)b) << 16); }
DEVI unsigned pk_bf16(float lo, float hi) { unsigned r; asm("v_cvt_pk_bf16_f32 %0, %1, %2" : "=v"(r) : "v"(lo), "v"(hi)); return r; }
DEVI unsigned pk4_fp8(float a, float b, float c, float d) { int p = __builtin_amdgcn_cvt_pk_fp8_f32(a, b, 0, false); p = __builtin_amdgcn_cvt_pk_fp8_f32(c, d, p, true); return (unsigned)p; }
DEVI float q8(float x) { const int p = __builtin_amdgcn_cvt_pk_fp8_f32(x, x, 0, false); return __builtin_amdgcn_cvt_f32_fp8(p, 0); }
DEVI float frcp(float x) { return __builtin_amdgcn_rcpf(x); }
DEVI float sigmoidf_(float x) { return frcp(1.0f + __expf(-x)); }
DEVI float gelu_tanh(float x) { const float u = 0.7978845608f * (x + 0.044715f * x * x * x); return x * frcp(1.0f + __expf(-2.0f * u)); }
template <int M> DEVI float shx(float v, int lane) {
    if constexpr (M < 32) return __int_as_float(__builtin_amdgcn_ds_swizzle(__float_as_int(v), 0x1F | (M << 10)));
    else return __int_as_float(__builtin_amdgcn_ds_bpermute((lane ^ 32) << 2, __float_as_int(v)));
}
DEVI float shxr(float v, int m, int lane) {
    switch (m) { case 1: return shx<1>(v, lane); case 2: return shx<2>(v, lane); case 4: return shx<4>(v, lane); case 8: return shx<8>(v, lane); case 16: return shx<16>(v, lane); default: return shx<32>(v, lane); }
}
DEVI int shxri(int v, int m, int lane) { return __float_as_int(shxr(__int_as_float(v), m, lane)); }
template <int CTRL, int ROWMASK> DEVI float dpp_(float v) { return __int_as_float(__builtin_amdgcn_update_dpp(0, __float_as_int(v), CTRL, ROWMASK, 0xF, false)); }
DEVI float wave_sum(float v, int) {
    v += dpp_<0xB1, 0xF>(v); v += dpp_<0x4E, 0xF>(v); v += dpp_<0x141, 0xF>(v); v += dpp_<0x140, 0xF>(v);
    v += dpp_<0x142, 0xA>(v); v += dpp_<0x143, 0xC>(v);
    return __int_as_float(__builtin_amdgcn_readlane(__float_as_int(v), 63));
}
DEVI float log1p_(float e) { return e < 0.06f ? e * (1.0f - e * (0.5f - e * (0.33333334f - e * 0.25f))) : __logf(1.0f + e); }
#define LDS_SYNC() do { asm volatile("s_waitcnt lgkmcnt(0)" ::: "memory"); __builtin_amdgcn_s_barrier(); asm volatile("" ::: "memory"); } while (0)
DEVI int mod_row(int row) { return row < TCTX ? 8 : (row - TCTX) / SEQ; }

#define XB_TMO      128
#define XB_XCNT(j)  (256  + 64 * (j))
#define XB_XSUB(j)  (1280 + 64 * (j))
#define XB_XGEN(j)  (2304 + 64 * (j))
#define XB_TOP      3328
#define XB_TOPGEN   3392
#define XCD_BAR_WORDS 3456
#define XB_SPIN_CAP (1u << 18)
__device__ __forceinline__ unsigned xb_ld(unsigned* p)              { return __hip_atomic_load(p, __ATOMIC_RELAXED, __HIP_MEMORY_SCOPE_AGENT); }
__device__ __forceinline__ unsigned xb_add(unsigned* p, unsigned v) { return __hip_atomic_fetch_add(p, v, __ATOMIC_RELAXED, __HIP_MEMORY_SCOPE_AGENT); }
__device__ __forceinline__ unsigned xb_xcc_id() { return (unsigned)__builtin_amdgcn_s_getreg((3 << 11) | 20) & 0xFu; }
#define XB_SPIN(cond, bar) do { unsigned _sp = 0; while (cond) { __builtin_amdgcn_s_sleep(1); \
    if ((++_sp & 255u) == 0u) { if (xb_ld(&(bar)[XB_TMO])) break; if (_sp > XB_SPIN_CAP) { atomicAdd(&(bar)[XB_TMO], 1u); break; } } } } while (0)
struct XcdBarrier { unsigned* bar; unsigned x; volatile LAS unsigned* st; };
__device__ __forceinline__ XcdBarrier xcd_barrier_post(unsigned* bar, volatile LAS unsigned* st) {
    XcdBarrier b; b.bar = bar; b.x = xb_xcc_id(); b.st = st;
    if (threadIdx.x == 0) (void)xb_add(&bar[XB_XCNT(b.x)], 1u);
    return b;
}
__device__ __forceinline__ void xcd_barrier_complete(unsigned* bar, unsigned x, unsigned& nloc, unsigned& nx) {
    const unsigned G = gridDim.x * gridDim.y * gridDim.z;
    unsigned sum, cnt, mine, sp = 0u;
    for (;;) {
        sum = 0u; cnt = 0u; mine = 0u;
#pragma unroll
        for (unsigned j = 0; j < 16; ++j) { const unsigned c = xb_ld(&bar[XB_XCNT(j)]); sum += c; cnt += (c > 0u) ? 1u : 0u; mine = (j == x) ? c : mine; }
        if (sum == G) break;
        __builtin_amdgcn_s_sleep(1);
        if ((++sp & 255u) == 0u) { if (xb_ld(&bar[XB_TMO])) break; if (sp > XB_SPIN_CAP) { atomicAdd(&bar[XB_TMO], 1u); break; } }
    }
    nloc = mine > 0u ? mine : 1u; nx = cnt > 0u ? cnt : 1u;
}
__device__ __forceinline__ void xcd_barrier(const XcdBarrier& b) {
    asm volatile("s_waitcnt vmcnt(0)" ::: "memory");
    __syncthreads();
    if (threadIdx.x == 0) {
        unsigned* bar = b.bar;
        __builtin_amdgcn_s_waitcnt(0);
        unsigned nloc = b.st[0], nx = b.st[1];
        if (nloc == 0u) { xcd_barrier_complete(bar, b.x, nloc, nx); b.st[0] = nloc; b.st[1] = nx; }
        const unsigned old = xb_add(&bar[XB_XSUB(b.x)], 1u);
        const unsigned gen = old / nloc;
        if (old + 1u == (gen + 1u) * nloc) {
            __builtin_amdgcn_fence(__ATOMIC_RELEASE, "agent");
            asm volatile("s_waitcnt vmcnt(0)" ::: "memory");
            const unsigned og = xb_add(&bar[XB_TOP], 1u);
            const unsigned tg = og / nx;
            if (og + 1u == (tg + 1u) * nx) xb_add(&bar[XB_TOPGEN], 1u);
            else XB_SPIN(xb_ld(&bar[XB_TOPGEN]) == tg, bar);
            __builtin_amdgcn_fence(__ATOMIC_ACQUIRE, "agent");
            xb_add(&bar[XB_XGEN(b.x)], 1u);
            asm volatile("s_waitcnt vmcnt(0)" ::: "memory");
        } else {
            XB_SPIN(xb_ld(&bar[XB_XGEN(b.x)]) == gen, bar);
            __builtin_amdgcn_fence(__ATOMIC_ACQUIRE, "agent");
            asm volatile("s_waitcnt vmcnt(0)" ::: "memory");
        }
    }
    __syncthreads();
}

namespace g1 {
constexpr int BM = 256, BK = 64, HALF = 128, HTB = HALF * BK * 2, STAGE_BYTES = 8 * HTB, K = 1024, NT = K / BK;
DEVI int lds_byte(int r, int c) { const int st = (r >> 4) * 2 + (c >> 5), rr = r & 15, cc = c & 31, ob = rr * 64 + cc * 2; return st * 1024 + (ob ^ (((ob >> 9) & 1) << 5)); }
DEVI void stage_rc(int b, int& R, int& C) { const int st = b / 1024, sb = b % 1024, swz = sb ^ (((sb >> 9) & 1) << 5); R = (st >> 1) * 16 + swz / 64; C = (st & 1) * 32 + (swz % 64) / 2; }
DEVI int perm32(int rho) { const int n = rho >> 4, i = rho & 15; return 8 * (i >> 2) + 4 * n + (i & 3); }

struct Unit {
    const char* A;
    const int* list;
    int nvalid;
    const char* B;
    int pm, pn, e;
};

template <bool F8> struct FragT { typedef bf16x8 T; static constexpr int NK = 2; };
template <> struct FragT<true> { typedef i32x8 T; static constexpr int NK = 1; };
template <bool GATHER, int KB>
DEVI void a_offsets(const Unit& u, int tid, unsigned (&v)[2][2]) {
    int tz = tid; asm volatile("" : "+v"(tz));
#pragma unroll
    for (int i = 0; i < 2; ++i) {
        int R, C; stage_rc(tz * 16 + i * 8192, R, C);
#pragma unroll
        for (int h = 0; h < 2; ++h) {
            const int r = h * HALF + R;
            int src = r;
            if (GATHER) { const int nv = u.nvalid > 256 ? 256 : u.nvalid; const int ld_ = u.list[r < nv ? r : nv - 1]; src = (r < nv) ? ld_ : 0; }
            v[h][i] = (unsigned)src * (unsigned)KB + (unsigned)(C * 2);
        }
    }
}
DEVI void a_request(const Unit& u, int tid, int (&raw)[2][2]) {
    int tz = tid; asm volatile("" : "+v"(tz));
    const int nv = u.nvalid > 256 ? 256 : u.nvalid;
#pragma unroll
    for (int i = 0; i < 2; ++i) { int R, C; stage_rc(tz * 16 + i * 8192, R, C);
#pragma unroll
        for (int h = 0; h < 2; ++h) { const int r = h * HALF + R; raw[h][i] = u.list[r < nv ? r : nv - 1]; } }
}
template <int KB>
DEVI void a_finish(int nvalid, int tid, int (&raw)[2][2], unsigned (&v)[2][2]) {
    asm volatile("" : "+v"(raw[0][0]), "+v"(raw[0][1]), "+v"(raw[1][0]), "+v"(raw[1][1]));
    int tz = tid; asm volatile("" : "+v"(tz));
    const int nv = nvalid > 256 ? 256 : nvalid;
#pragma unroll
    for (int i = 0; i < 2; ++i) { int R, C; stage_rc(tz * 16 + i * 8192, R, C);
#pragma unroll
        for (int h = 0; h < 2; ++h) { const int r = h * HALF + R; const int src = (r < nv) ? raw[h][i] : 0; v[h][i] = (unsigned)src * (unsigned)KB + (unsigned)(C * 2); } }
}

template <class Sched, class Epi, bool GATHER, bool FP8 = false>
DEVI void gemm_phase(LAS unsigned char* lds, const int tid, const Sched& S, const Epi& E) {
    constexpr int KB = FP8 ? 1024 : 2048, NTK = KB / 128, NK = FragT<FP8>::NK;
    typedef typename FragT<FP8>::T frag_t;
    int sc1 = 0x7F7F7F7F; asm volatile("" : "+v"(sc1));
    const int wid = __builtin_amdgcn_readfirstlane(tid >> 6), lane = tid & 63, wr = wid >> 2, wc = wid & 3, fr = lane & 15, fq = lane >> 4;
    unsigned voffB[2];
#pragma unroll
    for (int i = 0; i < 2; ++i) { int R, C; stage_rc(tid * 16 + i * 8192, R, C); const int Rb = Epi::PERM ? ((R & ~31) + perm32(R & 31)) : R; voffB[i] = (unsigned)(Rb * KB + C * 2); }
    constexpr size_t kstep = (size_t)(BK * 2);
    constexpr size_t hstep = (size_t)HALF * KB;
    const unsigned ldsw = (unsigned)wid * 1024u;
    const int aoff = FP8 ? lds_byte(wr * 64 + fr, fq * 16) : lds_byte(wr * 64 + fr, fq * 8), boff = FP8 ? lds_byte(wc * 32 + fr, fq * 16) : lds_byte(wc * 32 + fr, fq * 8);
    const int sw16 = FP8 ? 16 * (fq & 1) : 0;
    unsigned pa_ = (unsigned)(size_t)(lds + aoff) + sw16, pb_ = (unsigned)(size_t)(lds + 65536 + boff) + sw16, pa2_ = (unsigned)(size_t)(lds + aoff) + (16 - sw16), pb2_ = (unsigned)(size_t)(lds + 65536 + boff) + (16 - sw16);
    asm volatile("" : "+v"(pa_), "+v"(pb_), "+v"(pa2_), "+v"(pb2_));
    LAS unsigned char* const pa = (LAS unsigned char*)(size_t)pa_; LAS unsigned char* const pb = (LAS unsigned char*)(size_t)pb_;
    LAS unsigned char* const pa2 = (LAS unsigned char*)(size_t)pa2_; LAS unsigned char* const pb2 = (LAS unsigned char*)(size_t)pb2_;
#define G1_SA(b, h) (((b) * 2 + (h)) * HTB)
#define G1_SB(b, h) ((4 + (b) * 2 + (h)) * HTB)
#define G1_STAGE2(bufoff, gbase, v0, v1) do { \
        __builtin_amdgcn_global_load_lds((const unsigned*)((const char*)(gbase) + (v0)), (LAS unsigned*)(lds + (bufoff) + ldsw), 16, 0, 0); \
        __builtin_amdgcn_global_load_lds((const unsigned*)((const char*)(gbase) + (v1)), (LAS unsigned*)(lds + (bufoff) + ldsw + 8192), 16, 0, 0); } while (0)
#define G1_LDFRAG(dst, ptr, ptr2) do { if constexpr (FP8) { const i32x4 lo_ = *(const LAS i32x4*)(ptr), hi_ = *(const LAS i32x4*)(ptr2); dst = __builtin_shufflevector(lo_, hi_, 0, 1, 2, 3, 4, 5, 6, 7); } \
        else { dst = *(const LAS frag_t*)(ptr); } } while (0)
#define G1_LDA(dst, b, h) do { _Pragma("unroll") for (int m = 0; m < 4; ++m) _Pragma("unroll") for (int k = 0; k < NK; ++k) G1_LDFRAG(dst[m][k], pa + (G1_SA(b, h) + m * 2048 + k * 1024), pa2 + (G1_SA(b, h) + m * 2048 + k * 1024)); } while (0)
#define G1_LDB(dst, b, h) do { _Pragma("unroll") for (int n = 0; n < 2; ++n) _Pragma("unroll") for (int k = 0; k < NK; ++k) G1_LDFRAG(dst[n][k], pb + (G1_SB(b, h) - 65536 + n * 2048 + k * 1024), pb2 + (G1_SB(b, h) - 65536 + n * 2048 + k * 1024)); } while (0)
#define G1_MFMA(c_, b_, a_) do { if constexpr (FP8) asm volatile("v_mfma_scale_f32_16x16x128_f8f6f4 %0, %1, %2, %0, %3, %3 op_sel_hi:[0,0,0]" : "+v"(c_) : "v"(b_), "v"(a_), "v"(sc1)); \
        else c_ = __builtin_amdgcn_mfma_f32_16x16x32_bf16(b_, a_, c_, 0, 0, 0); } while (0)
#define G1_MMA(ai, bj, At, Bt) do { __builtin_amdgcn_s_setprio(1); _Pragma("unroll") for (int m = 0; m < 4; ++m) _Pragma("unroll") for (int n = 0; n < 2; ++n) _Pragma("unroll") for (int k = 0; k < NK; ++k) \
        G1_MFMA(acc[ai][bj][m][n], Bt[n][k], At[m][k]); __builtin_amdgcn_s_setprio(0); } while (0)
#define G1_WAIT_V(n) asm volatile("s_waitcnt vmcnt(" #n ")" ::: "memory")
#define G1_WAIT_L(n) asm volatile("s_waitcnt lgkmcnt(" #n ")" ::: "memory")
#define G1_BAR __builtin_amdgcn_s_barrier()
#define G1_SCHED __builtin_amdgcn_sched_barrier(0)
    Unit cur, nxt; int ui = 0;
    if (!S.get(0, cur)) return;
    f32x4 acc[2][2][4][2];
#pragma unroll
    for (int a = 0; a < 2; ++a)
#pragma unroll
        for (int b = 0; b < 2; ++b)
#pragma unroll
            for (int m = 0; m < 4; ++m)
#pragma unroll
                for (int n = 0; n < 2; ++n) acc[a][b][m][n] = (f32x4){0.f, 0.f, 0.f, 0.f};
    frag_t At[4][NK], B0[2][NK], B1[2][NK];
    unsigned vc[2][2], vn[2][2];
    a_offsets<GATHER, KB>(cur, tid, vc);
    const char* cA = cur.A; const char* cB = cur.B;
    G1_STAGE2(G1_SB(0, 0), cB, voffB[0], voffB[1]); G1_STAGE2(G1_SA(0, 0), cA, vc[0][0], vc[0][1]);
    G1_STAGE2(G1_SB(0, 1), cB + hstep, voffB[0], voffB[1]); G1_STAGE2(G1_SA(0, 1), cA, vc[1][0], vc[1][1]);
    if (wr == 1) G1_BAR;
    G1_WAIT_V(4); G1_BAR;
    G1_STAGE2(G1_SB(1, 0), cB + kstep, voffB[0], voffB[1]); G1_STAGE2(G1_SA(1, 0), cA + kstep, vc[0][0], vc[0][1]);
    G1_STAGE2(G1_SB(1, 1), cB + hstep + kstep, voffB[0], voffB[1]);
    G1_WAIT_V(6); G1_BAR;
    for (;;) {
        const bool has_next = S.get(ui + 1, nxt);
        int raw[2][2] = {{0, 0}, {0, 0}};
        if (has_next) { if constexpr (GATHER) a_request(nxt, tid, raw); else a_offsets<GATHER, KB>(nxt, tid, vn); }
        else {
#pragma unroll
            for (int h = 0; h < 2; ++h)
#pragma unroll
                for (int i = 0; i < 2; ++i) vn[h][i] = vc[h][i];
        }
        const char* nA = has_next ? nxt.A : cA; const char* nB = has_next ? nxt.B : cB;
#pragma unroll 1
        for (int t = 0; t < NTK; t += 2) {
            const bool last = (t == NTK - 2);
            const char* a1 = cA + (size_t)(t + 1) * kstep;
            const char* a2 = last ? nA : cA + (size_t)(t + 2) * kstep; const char* b2 = last ? nB : cB + (size_t)(t + 2) * kstep;
            const char* a3 = a2 + kstep; const char* b3 = b2 + kstep;
            unsigned w00 = vc[0][0], w01 = vc[0][1], w10 = vc[1][0], w11 = vc[1][1];
            if (last) { if constexpr (GATHER) { if (has_next) a_finish<KB>(nxt.nvalid, tid, raw, vn); }
                w00 = vn[0][0]; w01 = vn[0][1]; w10 = vn[1][0]; w11 = vn[1][1]; asm volatile("" : "+v"(w00), "+v"(w01), "+v"(w10), "+v"(w11)); }
            G1_LDB(B0, 0, 0); G1_SCHED; G1_LDA(At, 0, 0); G1_STAGE2(G1_SA(1, 1), a1, vc[1][0], vc[1][1]);
            G1_WAIT_L(8); G1_BAR; G1_WAIT_L(0); G1_MMA(0, 0, At, B0); G1_BAR; G1_SCHED;
            G1_LDB(B1, 0, 1); G1_STAGE2(G1_SB(0, 0), b2, voffB[0], voffB[1]);
            G1_BAR; G1_WAIT_L(0); G1_MMA(0, 1, At, B1); G1_BAR;
            G1_LDA(At, 0, 1); G1_STAGE2(G1_SA(0, 0), a2, w00, w01);
            G1_BAR; G1_WAIT_L(0); G1_MMA(1, 0, At, B0); G1_BAR; G1_SCHED;
            G1_STAGE2(G1_SB(0, 1), b2 + hstep, voffB[0], voffB[1]);
            G1_WAIT_V(6); G1_BAR; G1_MMA(1, 1, At, B1); G1_BAR;
            G1_LDB(B0, 1, 0); G1_SCHED; G1_LDA(At, 1, 0); G1_STAGE2(G1_SA(0, 1), a2, w10, w11);
            G1_WAIT_L(8); G1_BAR; G1_WAIT_L(0); G1_MMA(0, 0, At, B0); G1_BAR; G1_SCHED;
            G1_LDB(B1, 1, 1); G1_STAGE2(G1_SB(1, 0), b3, voffB[0], voffB[1]);
            G1_BAR; G1_WAIT_L(0); G1_MMA(0, 1, At, B1); G1_BAR;
            G1_LDA(At, 1, 1); G1_STAGE2(G1_SA(1, 0), a3, w00, w01);
            G1_BAR; G1_WAIT_L(0); G1_MMA(1, 0, At, B0); G1_BAR; G1_SCHED;
            G1_STAGE2(G1_SB(1, 1), b3 + hstep, voffB[0], voffB[1]);
            G1_WAIT_V(6); G1_BAR; G1_MMA(1, 1, At, B1); G1_BAR;
        }
        if constexpr (FP8) asm volatile("s_nop 15\n\ts_nop 15" ::: "memory");
        E(acc, cur, wr, wc, fr, fq);
        if (!has_next) break;
#pragma unroll
        for (int a = 0; a < 2; ++a)
#pragma unroll
            for (int b = 0; b < 2; ++b)
#pragma unroll
                for (int m = 0; m < 4; ++m)
#pragma unroll
                    for (int n = 0; n < 2; ++n) acc[a][b][m][n] = (f32x4){0.f, 0.f, 0.f, 0.f};
        cur = nxt; cA = nA; cB = nB; ++ui;
#pragma unroll
        for (int h = 0; h < 2; ++h)
#pragma unroll
            for (int i = 0; i < 2; ++i) vc[h][i] = vn[h][i];
    }
    G1_WAIT_V(0);
    if (wr == 0) G1_BAR;
    G1_BAR;
}
}

template <int MT, int NT_, class AF, class BF>
DEVI void wave_gemm(const int lane, int Kdim, const AF& af, const BF& bf, f32x4 (&acc)[MT][NT_]) {
    const int fr = lane & 15, fq = lane >> 4;
#pragma unroll
    for (int m = 0; m < MT; ++m)
#pragma unroll
        for (int n = 0; n < NT_; ++n) acc[m][n] = (f32x4){0.f, 0.f, 0.f, 0.f};
    bf16x8 fa[4][MT], fb[4][NT_];
#define WG_LOAD(S, KK) do { _Pragma("unroll") for (int m = 0; m < MT; ++m) fa[S][m] = af(m * 16 + fr, (KK) + fq * 8); _Pragma("unroll") for (int n = 0; n < NT_; ++n) fb[S][n] = bf(n * 16 + fr, (KK) + fq * 8); } while (0)
#define WG_MMA(S) do { _Pragma("unroll") for (int m = 0; m < MT; ++m) _Pragma("unroll") for (int n = 0; n < NT_; ++n) acc[m][n] = __builtin_amdgcn_mfma_f32_16x16x32_bf16(fb[S][n], fa[S][m], acc[m][n], 0, 0, 0); } while (0)
    WG_LOAD(0, 0); WG_LOAD(1, 32); WG_LOAD(2, 64);
#pragma unroll 1
    for (int k0 = 0; k0 < Kdim; k0 += 128) {
        const bool more = k0 + 128 < Kdim;
        WG_LOAD(3, k0 + 96); WG_MMA(0);
        if (more) WG_LOAD(0, k0 + 128);
        WG_MMA(1);
        if (more) WG_LOAD(1, k0 + 160);
        WG_MMA(2);
        if (more) WG_LOAD(2, k0 + 192);
        WG_MMA(3);
    }
#undef WG_LOAD
#undef WG_MMA
}
DEVI bf16x8 ldg8(const bf16_t* p) { return *(const bf16x8*)p; }

template <int N> struct Log2 { static constexpr int v = 1 + Log2<N / 2>::v; };
template <> struct Log2<1> { static constexpr int v = 0; };
template <int N>
DEVI float reduce_scatter(const int lane, float (&v)[N]) {
    constexpr int LG = Log2<N>::v;
#pragma unroll
    for (int st = 0; st < LG; ++st) {
        const int s = (N / 2) >> st, mask = 32 >> st;
        const bool up = (lane & mask) != 0;
#pragma unroll
        for (int i = 0; i < N / 2; ++i) if (i < s) {
            const float send = up ? v[i] : v[i + s];
            const float keep = up ? v[i + s] : v[i];
            v[i] = keep + shxr(send, mask, lane);
        }
    }
    float r = v[0];
#pragma unroll
    for (int st = LG; st < 6; ++st) r += shxr(r, 32 >> st, lane);
    return r;
}
template <int N>
DEVI int rs_index(int lane) {
    constexpr int LG = Log2<N>::v;
    int idx = 0;
#pragma unroll
    for (int st = 0; st < LG; ++st) if (lane & (32 >> st)) idx += (N / 2) >> st;
    return idx;
}

struct Ctx {
    const Params* p; unsigned char* ws; LAS unsigned char* lds; int tid, lane, wave, G, bid;
};
#define WSP(T, off) ((T*)(cx.ws + (off)))
DEVI Ctx relaunder(const Ctx& c) { Ctx r = c; int ln, td;
    asm volatile("v_mbcnt_lo_u32_b32 %0, -1, 0\n\tv_mbcnt_hi_u32_b32 %0, -1, %0\n\tv_lshl_add_u32 %1, %2, 6, %0" : "=&v"(ln), "=v"(td) : "s"(c.wave));
    r.lane = ln; r.tid = td; return r; }

DEVI void cvt_tile(const Ctx& cx, const float* src, int ld, bf16_t* dst, int n0, int k0, int kind) {
    LAS bf16_t* tile = (LAS bf16_t*)cx.lds;
    const int n4 = (cx.tid & 63) * 4, w8 = (cx.tid >> 6) * 8, n = n0 + n4;
    int sc; float scale = 1.0f;
    if (kind == 0) { sc = n < 1536 ? n : n + 16; if (n >= 384 && n < 768) scale = 0.10206207261596577f; }
    else if (kind == 2) { const int pn = n >> 8, w = n & 255; sc = w < 128 ? pn * 128 + w : 1024 + pn * 128 + (w - 128); }
    else sc = n;
#pragma unroll 1
    for (int sub = 0; sub < 4; sub += 2) {
        f32x4 v[2][8];
#pragma unroll
        for (int s2 = 0; s2 < 2; ++s2)
#pragma unroll
            for (int p = 0; p < 8; ++p) v[s2][p] = __builtin_nontemporal_load((const f32x4*)(src + (size_t)(k0 + (sub + s2) * 64 + w8 + p) * ld + sc));
#pragma unroll
        for (int s2 = 0; s2 < 2; ++s2)
#pragma unroll
            for (int j = 0; j < 4; ++j) { u32x4 w;
                w.x = pk_bf16(v[s2][0][j] * scale, v[s2][1][j] * scale); w.y = pk_bf16(v[s2][2][j] * scale, v[s2][3][j] * scale);
                w.z = pk_bf16(v[s2][4][j] * scale, v[s2][5][j] * scale); w.w = pk_bf16(v[s2][6][j] * scale, v[s2][7][j] * scale);
                *(LAS u32x4*)(tile + (n4 + j) * 264 + (sub + s2) * 64 + w8) = w; }
    }
    LDS_SYNC();
#pragma unroll
    for (int i = 0; i < 16; ++i) { const int idx = cx.tid + NTHR * i, row = idx >> 5, ch = idx & 31;
        const u32x4 o = *(const LAS u32x4*)(tile + row * 264 + ch * 8);
        *(u32x4*)(dst + (size_t)(n0 + row) * 1024 + k0 + ch * 8) = o; }
    LDS_SYNC();
}

DEVI void cvt_tile8(const Ctx& cx, const float* src, int ld, unsigned char* dst, int n0, int k0, int kind) {
    LAS unsigned char* tile = cx.lds;
    const int n4 = (cx.tid & 63) * 4, w8 = (cx.tid >> 6) * 8, n = n0 + n4;
    int sc;
    if (kind == 2) { const int pn = n >> 8, w = n & 255; sc = w < 128 ? pn * 128 + w : 1024 + pn * 128 + (w - 128); }
    else sc = n;
#pragma unroll 1
    for (int sub = 0; sub < 4; sub += 2) {
        f32x4 v[2][8];
#pragma unroll
        for (int s2 = 0; s2 < 2; ++s2)
#pragma unroll
            for (int p = 0; p < 8; ++p) v[s2][p] = __builtin_nontemporal_load((const f32x4*)(src + (size_t)(k0 + (sub + s2) * 64 + w8 + p) * ld + sc));
#pragma unroll
        for (int s2 = 0; s2 < 2; ++s2)
#pragma unroll
            for (int j = 0; j < 4; ++j) { u32x2 w;
                w.x = pk4_fp8(v[s2][0][j] * W8_SCALE, v[s2][1][j] * W8_SCALE, v[s2][2][j] * W8_SCALE, v[s2][3][j] * W8_SCALE);
                w.y = pk4_fp8(v[s2][4][j] * W8_SCALE, v[s2][5][j] * W8_SCALE, v[s2][6][j] * W8_SCALE, v[s2][7][j] * W8_SCALE);
                *(LAS u32x2*)(tile + (n4 + j) * 272 + (sub + s2) * 64 + w8) = w; }
    }
    LDS_SYNC();
#pragma unroll
    for (int i = 0; i < 8; ++i) { const int idx = cx.tid + NTHR * i, row = idx >> 4, ch = idx & 15;
        const u32x4 o = *(const LAS u32x4*)(tile + row * 272 + ch * 16);
        *(u32x4*)(dst + (size_t)(n0 + row) * 1024 + k0 + ch * 16) = o; }
    LDS_SYNC();
}
DEVI void ph_pro_a(const Ctx& cx) {
    const Params& P = *cx.p;
    {
        constexpr int n_in = DEPTH * 10 * 4, n_out = DEPTH * 4 * 4, n_gu = DEPTH * NE * 8 * 4, n_dn = DEPTH * NE * 4 * 4;
        constexpr int total = n_in + n_out + n_gu + n_dn;
        for (int job = cx.bid; job < total; job += cx.G) {
            int j = job;
            if (j < n_in) { const int l = j / 40, r = j % 40, kt = r / 10, nt = r % 10;
                cvt_tile(cx, P.in[I_WIN] + (size_t)l * 1024 * DIN, DIN, WSP(bf16_t, WS_WIN) + (size_t)l * NP * 1024, nt * 256, kt * 256, 0); continue; }
            j -= n_in;
            if (j < n_out) { const int l = j / 16, r = j % 16, kt = r / 4, nt = r % 4;
                cvt_tile(cx, P.in[I_WOUT] + (size_t)l * 1024 * 1024, 1024, WSP(bf16_t, WS_WOUT) + (size_t)l * 1024 * 1024, nt * 256, kt * 256, 1); continue; }
            j -= n_out;
            if (j < n_gu) { const int le = j / 32, r = j % 32, kt = r / 8, nt = r % 8;
                cvt_tile8(cx, P.in[I_WGU] + (size_t)le * 1024 * 2048, 2048, WSP(unsigned char, WS_WGU) + (size_t)le * 2048 * 1024, nt * 256, kt * 256, 2); continue; }
            j -= n_gu;
            { const int le = j / 16, r = j % 16, kt = r / 4, nt = r % 4;
                cvt_tile8(cx, P.in[I_WD] + (size_t)le * 1024 * 1024, 1024, WSP(unsigned char, WS_WD) + (size_t)le * 1024 * 1024, nt * 256, kt * 256, 1); }
        }
    }
    __syncthreads();
    {
        LAS float* sv = (LAS float*)cx.lds;
        LAS float* red = sv + 9 * 1024;
        constexpr int units = DEPTH * 6144 / 64;
        if (cx.bid < units) {
            for (int i = cx.tid; i < 9 * 1024; i += NTHR) { const int r = i >> 10, k = i & 1023; const float c = r < 8 ? P.in[I_C][r * 1024 + k] : P.in[I_CCTX][k]; sv[i] = c / (1.0f + __expf(-c)); }
            __syncthreads();
            for (int u = cx.bid; u < units; u += cx.G) {
                const int l = u / 96, n = (u % 96) * 64 + cx.lane;
                const float* w = P.in[I_ADAW] + (size_t)l * 1024 * 6144 + n;
                float acc[9];
#pragma unroll
                for (int r = 0; r < 9; ++r) acc[r] = 0.f;
                const int kb = cx.wave * 128;
#pragma unroll 4
                for (int k = 0; k < 128; ++k) { const float wv = w[(size_t)(kb + k) * 6144];
#pragma unroll
                    for (int r = 0; r < 9; ++r) acc[r] += sv[r * 1024 + kb + k] * wv; }
#pragma unroll
                for (int r = 0; r < 9; ++r) red[(cx.wave * 9 + r) * 64 + cx.lane] = acc[r];
                __syncthreads();
                for (int i = cx.tid; i < 9 * 64; i += NTHR) { const int r = i >> 6, ln = i & 63; float s = 0.f;
#pragma unroll
                    for (int w8 = 0; w8 < 8; ++w8) s += red[(w8 * 9 + r) * 64 + ln];
                    const int nn = (u % 96) * 64 + ln;
                    WSP(float, WS_MOD)[((size_t)l * 9 + r) * 6144 + nn] = s + P.in[I_ADAB][l * 6144 + nn]; }
                __syncthreads();
            }
        }
    }
    for (int gt = cx.bid * NTHR + cx.tid; gt < DEPTH * 16 * 2 * 64; gt += cx.G * NTHR) {
        const int n = gt & 63, d = (gt >> 6) & 1, g = (gt >> 7) & 15, l = gt >> 11;
        const float dt = expf(P.in[I_S5LDT][(l * 2 + d) * 16 + g]);
        const float lr = P.in[I_S5LRE][((l * 2 + d) * 16 + g) * 64 + n], li = P.in[I_S5LIM][((l * 2 + d) * 16 + g) * 64 + n];
        f32x2* pw = WSP(f32x2, WS_PW) + (size_t)gt * 33;
        float ar = 0.f, ai = 0.f;
        for (int k = 0; k <= 32; ++k) { const float mag = expf(lr * dt * (float)k); float s, c; sincosf(li * dt * (float)k, &s, &c); pw[k] = (f32x2){mag * c, mag * s}; if (k == 1) { ar = mag * c; ai = mag * s; } }
        const float den = lr * lr + li * li;
        const float cr = ((ar - 1.0f) * lr + ai * li) / den, ci = (ai * lr - (ar - 1.0f) * li) / den;
        f32x2* bb = WSP(f32x2, WS_BB) + (size_t)gt * 16;
        for (int q = 0; q < 16; ++q) { const float br = P.in[I_S5BRE][((l * 16 + g) * 64 + n) * 16 + q], bi = P.in[I_S5BIM][((l * 16 + g) * 64 + n) * 16 + q];
            bb[q] = (f32x2){cr * br - ci * bi, cr * bi + ci * br}; }
    }
    for (int i = cx.bid * NTHR + cx.tid; i < DEPTH * 6 * 256 * 64; i += cx.G * NTHR) {
        const int k = i & 63, n = (i >> 6) & 255, g = (i >> 14) % 6, l = (i >> 14) / 6;
        const int j = n & 63, type = (n >> 6) & 1, dir = n >> 7;
        const float* w = type ? P.in[I_RGWX] : P.in[I_RGWA];
        WSP(bf16_t, WS_WRG)[i] = f2bf(w[((((size_t)l * 2 + dir) * 6 + g) * 64 + k) * 64 + j]);
    }
    for (int i = cx.bid * NTHR + cx.tid; i < DEPTH * NP; i += cx.G * NTHR) {
        const int n = i % NP, l = i / NP; const int sc = n < 1536 ? n : n + 16;
        WSP(float, WS_BIN2)[i] = P.in[I_BIN][l * DIN + sc] * ((n >= 384 && n < 768) ? 0.10206207261596577f : 1.0f);
    }
    for (int i = cx.bid * NTHR + cx.tid; i < DEPTH * 16 * 1024; i += cx.G * NTHR) { const int k = i & 1023, n = (i >> 10) & 15, l = i >> 14;
        WSP(bf16_t, WS_WGT)[i] = f2bf(P.in[I_WIN][((size_t)l * 1024 + k) * DIN + 1536 + n]); }
    for (int i = cx.bid * NTHR + cx.tid; i < DEPTH * 32 * 1024; i += cx.G * NTHR) { const int k = i & 1023, n = (i >> 10) & 31, l = i >> 15;
        const float w = P.in[I_RW][((size_t)l * 1024 + k) * 32 + n]; const bf16_t hi = f2bf(w);
        WSP(bf16_t, WS_RWH)[i] = hi; WSP(bf16_t, WS_RWL)[i] = f2bf(w - bf2f(hi)); }
    for (int i = cx.bid * NTHR + cx.tid; i < DEPTH * 256 * 256; i += cx.G * NTHR) {
        const int k = i & 255, n = (i >> 8) & 255, l = i >> 16;
        WSP(bf16_t, WS_WGLU)[i] = f2bf(P.in[I_S5GW][((size_t)l * 256 + k) * 256 + n]);
    }
}

DEVI void ph_pro_b(const Ctx& cx) {
    const Params& P = *cx.p;
    LAS f32x2* pw = (LAS f32x2*)cx.lds;
    LAS f32x2* bb = pw + 64 * 33;
    LAS f32x2* cc = bb + 64 * 16;
    for (int u = cx.bid; u < DEPTH * 16 * 2; u += cx.G) {
        const int lg = u >> 1;
        for (int i = cx.tid; i < 64 * 33; i += NTHR) pw[i] = WSP(f32x2, WS_PW)[(size_t)u * 64 * 33 + i];
        for (int i = cx.tid; i < 64 * 16; i += NTHR) bb[i] = WSP(f32x2, WS_BB)[(size_t)u * 64 * 16 + i];
        for (int i = cx.tid; i < 16 * 64; i += NTHR) cc[i] = (f32x2){P.in[I_S5CRE][(size_t)lg * 1024 + i], P.in[I_S5CIM][(size_t)lg * 1024 + i]};
        __syncthreads();
        const int q = cx.tid & 15, p = (cx.tid >> 4) & 15, tau0 = cx.tid >> 8;
        float acc[16];
#pragma unroll
        for (int i = 0; i < 16; ++i) acc[i] = 0.f;
#pragma unroll 2
        for (int n = 0; n < 64; ++n) { const f32x2 b = bb[n * 16 + q], c = cc[p * 64 + n];
#pragma unroll
            for (int i = 0; i < 16; ++i) { const f32x2 a = pw[n * 33 + tau0 + 2 * i]; const float xr = c.x * a.x - c.y * a.y, xi = c.x * a.y + c.y * a.x; acc[i] += xr * b.x - xi * b.y; } }
#pragma unroll
        for (int i = 0; i < 16; ++i) WSP(float, WS_KT)[(((size_t)u * 32 + tau0 + 2 * i) * 16 + p) * 16 + q] = acc[i];
        __syncthreads();
    }
}

DEVI void ph_pro_c(const Ctx& cx) {
    const Params& P = *cx.p;
    LAS float* kt = (LAS float*)cx.lds;
    LAS f32x2* pw = (LAS f32x2*)(kt + 2 * 32 * 256);
    LAS f32x2* bb = pw + 2 * 64 * 33;
    LAS f32x2* cc = bb + 2 * 64 * 16;
    LAS float* dsk = (LAS float*)(cc + 16 * 64);
    for (int u = cx.bid; u < DEPTH * 16 * 4; u += cx.G) {
        const int lg = u >> 2, qt = u & 3, l = lg >> 4, g = lg & 15;
        for (int i = cx.tid; i < 2 * 32 * 256; i += NTHR) kt[i] = WSP(float, WS_KT)[(size_t)lg * 2 * 32 * 256 + i];
        for (int i = cx.tid; i < 2 * 64 * 33; i += NTHR) pw[i] = WSP(f32x2, WS_PW)[(size_t)lg * 2 * 64 * 33 + i];
        for (int i = cx.tid; i < 2 * 64 * 16; i += NTHR) bb[i] = WSP(f32x2, WS_BB)[(size_t)lg * 2 * 64 * 16 + i];
        for (int i = cx.tid; i < 16 * 64; i += NTHR) cc[i] = (f32x2){P.in[I_S5CRE][(size_t)lg * 1024 + i], P.in[I_S5CIM][(size_t)lg * 1024 + i]};
        if (cx.tid < 16) dsk[cx.tid] = P.in[I_S5D][l * 256 + g * 16 + cx.tid];
        __syncthreads();
        bf16_t* wy = WSP(bf16_t, WS_WY) + ((size_t)lg * 512 + qt * 128) * 768;
        for (int idx = cx.tid; idx < 128 * 768; idx += NTHR) {
            const int k = idx % 768, tp = qt * 128 + idx / 768, t = tp >> 4, p = tp & 15;
            float v;
            if (k < 512) { const int sI = k >> 4, q = k & 15; v = 0.f;
                if (sI <= t) v += kt[(0 * 32 + (t - sI)) * 256 + p * 16 + q];
                if (sI >= t) v += kt[(1 * 32 + (sI - t)) * 256 + p * 16 + q];
                if (sI == t && p == q) v += dsk[p];
            } else { const int kk = k - 512, d = kk >> 7, im = (kk >> 6) & 1, n = kk & 63;
                const int pwr = d == 0 ? t + 1 : 32 - t;
                const f32x2 a = pw[(d * 64 + n) * 33 + pwr], c = cc[p * 64 + n];
                v = im ? -(c.x * a.y + c.y * a.x) : (c.x * a.x - c.y * a.y); }
            wy[idx] = f2bf(v);
        }
        bf16_t* we = WSP(bf16_t, WS_WE) + ((size_t)lg * 256 + qt * 64) * 512;
        for (int idx = cx.tid; idx < 64 * 512; idx += NTHR) {
            const int k = idx & 511, no = qt * 64 + (idx >> 9);
            const int sI = k >> 4, q = k & 15, d = no >> 7, im = (no >> 6) & 1, n = no & 63;
            const int pwr = d == 0 ? 31 - sI : sI;
            const f32x2 a = pw[(d * 64 + n) * 33 + pwr], b2 = bb[(d * 64 + n) * 16 + q];
            we[idx] = f2bf(im ? (a.x * b2.y + a.y * b2.x) : (a.x * b2.x - a.y * b2.y));
        }
        __syncthreads();
    }
}

DEVI void moe_info(const Ctx& cx, int l, LAS int* info) {
    if (cx.tid < 64) {
        const unsigned* cnt = (const unsigned*)(cx.ws + WS_CTL) + CW_CNT + l * 32;
        const int c = cx.lane < 32 ? (int)__hip_atomic_load(cnt + (cx.lane & 31), __ATOMIC_RELAXED, __HIP_MEMORY_SCOPE_AGENT) : 0;
        const int nt = (c + 255) >> 8;
        if (cx.lane < 32) { info[72 + cx.lane] = nt; info[40 + cx.lane] = c; }
        if (cx.lane == 0) { int run = 0; info[0] = 0; for (int e = 0; e < 32; ++e) { run += info[72 + e]; info[e + 1] = run; } }
    }
    __syncthreads();
    if (cx.tid < 32) { const int lo = info[cx.tid], hi = info[cx.tid + 1]; for (int t = lo; t < hi; ++t) info[112 + t] = cx.tid;
    }
    __syncthreads();
}

DEVI void block_rows_visible() {
    asm volatile("s_waitcnt vmcnt(0)" ::: "memory");
    __syncthreads();
}
DEVI void ph_norm1(const Ctx& cx, int l) {
    const Params& P = *cx.p;
    LAS int* info = (LAS int*)cx.lds;
    LAS float* part = (LAS float*)(cx.lds + 4096);
    if (l > 0) moe_info(cx, l - 1, info);
    const int rbeg = (l == DEPTH) ? TCTX : 0, nr = TT - rbeg;
    const int rpb = (nr + cx.G - 1) / cx.G, rb = rbeg + cx.bid * rpb, re = min(TT, rb + rpb);
    const float* modp = WSP(float, WS_MOD);
    const int c0 = 4 * cx.lane;
    for (int r2 = rb + cx.wave; r2 < re; r2 += 16) {
        f32x4 x[2][4]; bool ok[2];
#pragma unroll
        for (int u = 0; u < 2; ++u) { const int row = r2 + 8 * u; ok[u] = row < re; const int rw_ = ok[u] ? row : r2;
            if (l == 0) { const float* src = rw_ < TCTX ? P.in[I_CTX] + (size_t)rw_ * 1024 : P.in[I_X] + (size_t)(rw_ - TCTX) * 1024;
#pragma unroll
                for (int i = 0; i < 4; ++i) x[u][i] = *(const f32x4*)(src + c0 + 256 * i);
            } else {
                const float* src = WSP(float, WS_XMID) + (size_t)rw_ * 1024;
                const float* g2 = modp + ((size_t)(l - 1) * 9 + mod_row(rw_)) * 6144 + 5120;
                const int* ti = WSP(int, WS_TINFO) + (size_t)rw_ * 4;
                f32x4 y[4];
#pragma unroll
                for (int i = 0; i < 4; ++i) y[i] = (f32x4){0.f, 0.f, 0.f, 0.f};
#pragma unroll
                for (int k = 0; k < 4; ++k) { const int t = ti[k]; const int e = t >> 20, slot = t & 0xFFFFF;
                    const unsigned char* yp = WSP(unsigned char, WS_YPAD) + ((size_t)info[e] * 256 + slot) * 1024;
#pragma unroll
                    for (int i = 0; i < 4; ++i) { const int w = *(const int*)(yp + c0 + 256 * i);
                        y[i][0] += __builtin_amdgcn_cvt_f32_fp8(w, 0); y[i][1] += __builtin_amdgcn_cvt_f32_fp8(w, 1); y[i][2] += __builtin_amdgcn_cvt_f32_fp8(w, 2); y[i][3] += __builtin_amdgcn_cvt_f32_fp8(w, 3); } }
#pragma unroll
                for (int i = 0; i < 4; ++i) { const f32x4 xv = *(const f32x4*)(src + c0 + 256 * i), gv = *(const f32x4*)(g2 + c0 + 256 * i); x[u][i] = xv + gv * (y[i] * Y8_INV); }
            }
        }
#pragma unroll
        for (int u = 0; u < 2; ++u) {
            const int row = r2 + 8 * u;
            float ss = 0.f;
#pragma unroll
            for (int i = 0; i < 4; ++i) ss += (x[u][i][0] * x[u][i][0] + x[u][i][1] * x[u][i][1]) + (x[u][i][2] * x[u][i][2] + x[u][i][3] * x[u][i][3]);
            ss = wave_sum(ss, 0);
            const float rstd = rsqrtf(ss * (1.0f / 1024.0f) + EPS);
            if (!ok[u]) continue;
            if (l == DEPTH) { float* o = P.out + (size_t)(row - TCTX) * 1024;
#pragma unroll
                for (int i = 0; i < 4; ++i) { const f32x4 fw = *(const f32x4*)(P.in[I_FNW] + c0 + 256 * i); *(f32x4*)(o + c0 + 256 * i) = x[u][i] * rstd * fw; }
                continue; }
            float* xs = WSP(float, WS_XS) + (size_t)row * 1024;
            const float* md = modp + ((size_t)l * 9 + mod_row(row)) * 6144;
            bf16_t* hp = WSP(bf16_t, WS_H) + (size_t)row * 1024;
#pragma unroll
            for (int i = 0; i < 4; ++i) { const int c = c0 + 256 * i;
                *(f32x4*)(xs + c) = x[u][i];
                const f32x4 nw = *(const f32x4*)(P.in[I_N1W] + l * 1024 + c), sc = *(const f32x4*)(md + 1024 + c), sh = *(const f32x4*)(md + c);
                const f32x4 h = x[u][i] * rstd * nw * (sc + 1.0f) + sh;
                u32x2 w; w.x = pk_bf16(h[0], h[1]); w.y = pk_bf16(h[2], h[3]); *(u32x2*)(hp + c) = w; }
        }
    }
    if (l == DEPTH) return;
    block_rows_visible();
    const int nrow = re - rb, ntile = (nrow + 15) / 16;
    for (int it = cx.wave; it < ntile * 4; it += 8) {
        const int t = it >> 2, kq = it & 3, fr = cx.lane & 15, fq = cx.lane >> 4; const int row = min(rb + t * 16 + fr, re - 1);
        const bf16_t* hp = WSP(bf16_t, WS_H) + (size_t)row * 1024 + kq * 256 + fq * 8;
        const bf16_t* wp = WSP(bf16_t, WS_WGT) + ((size_t)l * 16 + fr) * 1024 + kq * 256 + fq * 8;
        f32x4 acc = (f32x4){0.f, 0.f, 0.f, 0.f};
        bf16x8 af[8], wf[8];
#pragma unroll
        for (int k = 0; k < 8; ++k) { af[k] = ldg8(hp + 32 * k); wf[k] = ldg8(wp + 32 * k); }
        __builtin_amdgcn_sched_barrier(0);
#pragma unroll
        for (int k = 0; k < 8; ++k) acc = __builtin_amdgcn_mfma_f32_16x16x32_bf16(wf[k], af[k], acc, 0, 0, 0);
        __builtin_amdgcn_sched_barrier(0);
        *(LAS f32x4*)(part + ((kq * 128) + t * 16 + fr) * 16 + 4 * fq) = acc;
    }
    __syncthreads();
    for (int i = cx.tid; i < nrow * 16; i += NTHR) { const int rl = i >> 4, gi = i & 15;
        WSP(float, WS_GT)[(size_t)(rb + rl) * 16 + gi] = (part[(0 * 128 + rl) * 16 + gi] + part[(1 * 128 + rl) * 16 + gi]) + (part[(2 * 128 + rl) * 16 + gi] + part[(3 * 128 + rl) * 16 + gi]) + P.in[I_BIN][l * DIN + 1536 + gi]; }
}

DEVI void ph_norm2(const Ctx& cx, int l) {
    const Params& P = *cx.p;
    LAS float* lgs = (LAS float*)cx.lds;
    LAS int* hist = (LAS int*)(cx.lds + 4 * 128 * 33 * 4);
    LAS int* pend = hist + 64;
    if (cx.tid < 64) hist[cx.tid] = 0;
    const int r0 = (l == DEPTH - 1) ? TCTX : 0, nr = TT - r0;
    const int rpb = (nr + cx.G - 1) / cx.G;
    const int rb = r0 + cx.bid * rpb, re = min(TT, rb + rpb);
    const float* modp = WSP(float, WS_MOD);
    const int c0 = 4 * cx.lane;
    for (int r2 = rb + cx.wave; r2 < re; r2 += 16) {
        f32x4 x[2][4]; bool ok[2];
#pragma unroll
        for (int u = 0; u < 2; ++u) { const int row = r2 + 8 * u; ok[u] = row < re; const float* src = WSP(float, WS_XMID) + (size_t)(ok[u] ? row : r2) * 1024;
#pragma unroll
            for (int i = 0; i < 4; ++i) x[u][i] = *(const f32x4*)(src + c0 + 256 * i); }
#pragma unroll
        for (int u = 0; u < 2; ++u) {
            const int row = r2 + 8 * u;
            float ss = 0.f;
#pragma unroll
            for (int i = 0; i < 4; ++i) ss += (x[u][i][0] * x[u][i][0] + x[u][i][1] * x[u][i][1]) + (x[u][i][2] * x[u][i][2] + x[u][i][3] * x[u][i][3]);
            ss = wave_sum(ss, 0);
            const float rstd = rsqrtf(ss * (1.0f / 1024.0f) + EPS);
            if (!ok[u]) continue;
            const float* md = modp + ((size_t)l * 9 + mod_row(row)) * 6144;
            bf16_t* hp = WSP(bf16_t, WS_H) + (size_t)row * 1024; bf16_t* hl = WSP(bf16_t, WS_HLO) + (size_t)row * 1024; unsigned char* h8 = WSP(unsigned char, WS_H8) + (size_t)row * 1024;
#pragma unroll
            for (int i = 0; i < 4; ++i) { const int c = c0 + 256 * i;
                const f32x4 nw = *(const f32x4*)(P.in[I_N2W] + l * 1024 + c), sc = *(const f32x4*)(md + 4096 + c), sh = *(const f32x4*)(md + 3072 + c);
                const f32x4 h = x[u][i] * rstd * nw * (sc + 1.0f) + sh;
                const int p8 = (int)pk4_fp8(h[0], h[1], h[2], h[3]);
                const float q0 = __builtin_amdgcn_cvt_f32_fp8(p8, 0), q1 = __builtin_amdgcn_cvt_f32_fp8(p8, 1), q2 = __builtin_amdgcn_cvt_f32_fp8(p8, 2), q3 = __builtin_amdgcn_cvt_f32_fp8(p8, 3);
                *(int*)(h8 + c) = p8;
                u32x2 wh; wh.x = pk_bf16(q0, q1); wh.y = pk_bf16(q2, q3); *(u32x2*)(hp + c) = wh;
                u32x2 wl; wl.x = pk_bf16(h[0] - q0, h[1] - q1); wl.y = pk_bf16(h[2] - q2, h[3] - q3); *(u32x2*)(hl + c) = wl; }
        }
    }
    block_rows_visible();
    const int nrow = re - rb, ntile = (nrow + 15) / 16;
    for (int it = cx.wave; it < ntile * 8; it += 8) {
        const int t = it >> 3, nt = (it >> 2) & 1, kq = it & 3, fr = cx.lane & 15, fq = cx.lane >> 4; const int row = min(rb + t * 16 + fr, re - 1);
        const bf16_t* hp = WSP(bf16_t, WS_H) + (size_t)row * 1024 + kq * 256 + fq * 8; const bf16_t* hl = WSP(bf16_t, WS_HLO) + (size_t)row * 1024 + kq * 256 + fq * 8;
        const bf16_t* wh = WSP(bf16_t, WS_RWH) + ((size_t)l * 32 + nt * 16 + fr) * 1024 + kq * 256 + fq * 8; const bf16_t* wl = WSP(bf16_t, WS_RWL) + ((size_t)l * 32 + nt * 16 + fr) * 1024 + kq * 256 + fq * 8;
        f32x4 acc = (f32x4){0.f, 0.f, 0.f, 0.f}, acc2 = (f32x4){0.f, 0.f, 0.f, 0.f};
        bf16x8 ah[8], al[8], bh[8], bl[8];
#pragma unroll
        for (int k = 0; k < 8; ++k) { ah[k] = ldg8(hp + 32 * k); al[k] = ldg8(hl + 32 * k); bh[k] = ldg8(wh + 32 * k); bl[k] = ldg8(wl + 32 * k); }
        __builtin_amdgcn_sched_barrier(0);
#pragma unroll
        for (int k = 0; k < 8; ++k) {
            acc = __builtin_amdgcn_mfma_f32_16x16x32_bf16(bh[k], ah[k], acc, 0, 0, 0);
            acc2 = __builtin_amdgcn_mfma_f32_16x16x32_bf16(bl[k], ah[k], acc2, 0, 0, 0);
            acc2 = __builtin_amdgcn_mfma_f32_16x16x32_bf16(bh[k], al[k], acc2, 0, 0, 0); }
        __builtin_amdgcn_sched_barrier(0);
        const int rl = t * 16 + fr;
#pragma unroll
        for (int j = 0; j < 4; ++j) lgs[(kq * 128 + rl) * 33 + nt * 16 + 4 * fq + j] = acc[j] + acc2[j];
    }
    __syncthreads();
    if (cx.tid < nrow) {
        float lg[32];
#pragma unroll
        for (int e = 0; e < 32; ++e) lg[e] = (lgs[(0 * 128 + cx.tid) * 33 + e] + lgs[(1 * 128 + cx.tid) * 33 + e]) + (lgs[(2 * 128 + cx.tid) * 33 + e] + lgs[(3 * 128 + cx.tid) * 33 + e]) + P.in[I_RB][l * 32 + e];
        float tv[4]; int tix[4]; unsigned taken = 0u;
#pragma unroll
        for (int k = 0; k < 4; ++k) { float bv = -3.0e38f; int bi = 0;
#pragma unroll
            for (int e = 0; e < 32; ++e) { const bool better = (lg[e] > bv) && !((taken >> e) & 1u); bv = better ? lg[e] : bv; bi = better ? e : bi; }
            tv[k] = bv; tix[k] = bi; taken |= 1u << bi; }
        const float e1 = __expf(tv[1] - tv[0]), e2 = __expf(tv[2] - tv[0]), e3 = __expf(tv[3] - tv[0]);
        const float inv = 1.0f / (1.0f + e1 + e2 + e3);
        const float gk[4] = {inv, e1 * inv, e2 * inv, e3 * inv};
#pragma unroll
        for (int k = 0; k < 4; ++k) {
            const int ls = __hip_atomic_fetch_add((LAS int*)(hist + tix[k]), 1, __ATOMIC_RELAXED, __HIP_MEMORY_SCOPE_WORKGROUP);
            pend[(cx.tid * 4 + k) * 2 + 0] = (tix[k] << 20) | ls;
            pend[(cx.tid * 4 + k) * 2 + 1] = __float_as_int(gk[k]); }
    }
    __syncthreads();
    if (cx.tid < 32) { unsigned* cnt = (unsigned*)(cx.ws + WS_CTL) + CW_CNT + l * 32;
        hist[32 + cx.tid] = hist[cx.tid] > 0 ? (int)__hip_atomic_fetch_add(cnt + cx.tid, (unsigned)hist[cx.tid], __ATOMIC_RELAXED, __HIP_MEMORY_SCOPE_AGENT) : 0; }
    __syncthreads();
    for (int i = cx.tid; i < nrow * 4; i += NTHR) {
        const int t = pend[i * 2], e = t >> 20, slot = hist[32 + e] + (t & 0xFFFFF), row = rb + (i >> 2);
        WSP(int, WS_ELIST)[(size_t)e * TT + slot] = row;
        WSP(float, WS_GLIST)[(size_t)e * TT + slot] = __int_as_float(pend[i * 2 + 1]);
        WSP(int, WS_TINFO)[(size_t)row * 4 + (i & 3)] = (e << 20) | slot;
    }
}

DEVI int xcd_contig(int bid, int G) { return (G % 8 == 0) ? (bid % 8) * (G / 8) + bid / 8 : bid; }

struct DenseSched {
    const char* A; const char* B; int nM, nN, pm0, G, bid;
    DEVI bool get(int i, g1::Unit& u) const {
        int pm, pn;
        if (G % 8 == 0) { const int x = bid & 7, r = bid >> 3, nx = G >> 3, lo = (nM * x) >> 3, hi = (nM * (x + 1)) >> 3, nr = hi - lo;
            const int q = i * nx + r; if (nr <= 0 || q >= nr * nN) return false; pm = lo + q % nr; pn = q / nr; }
        else { const int L = i * G + bid; if (L >= nM * nN) return false; pm = L / nN; pn = L % nN; }
        u.A = A + (size_t)(pm0 + pm) * 256 * 2048; u.list = nullptr; u.nvalid = 256; u.B = B + (size_t)pn * 256 * 2048; u.pm = pm0 + pm; u.pn = pn; u.e = 0;
        return true;
    }
};
struct MoeSched {
    const char* A; const char* B; const int* elist; const LAS int* info; int NPN, gather, G, bid; size_t bstride; int kb;
    DEVI int rd(int i) const { return __builtin_amdgcn_readfirstlane(info[i]); }
    DEVI bool get(int i, g1::Unit& u) const {
        const int NTt = rd(32); int T, pn;
        if (G % 8 == 0 && (G >> 3) % NPN == 0) { const int x = bid & 7, r = bid >> 3, nx = G >> 3, RT = nx / NPN, lo = (NTt * x) >> 3, hi = (NTt * (x + 1)) >> 3;
            T = lo + i * RT + r % RT; pn = r / RT; if (T >= hi) return false; }
        else { const int L = i * G + bid; if (L >= NTt * NPN) return false; T = L / NPN; pn = L % NPN; }
        const int e = rd(112 + T), j = T - rd(e);
        u.pm = T; u.pn = pn; u.e = e;
        u.B = B + (size_t)e * bstride + (size_t)pn * 256 * kb;
        if (gather) { u.A = A; u.list = elist + (size_t)e * TT + j * 256; u.nvalid = rd(40 + e) - j * 256; }
        else { u.A = A + (size_t)T * 256 * kb; u.list = nullptr; u.nvalid = 256; }
        return true;
    }
};

struct EpiIn {
    static constexpr bool PERM = true;
    bf16_t* Pout; const float* bias;
    DEVI void operator()(const f32x4 (&acc)[2][2][4][2], const g1::Unit& u, int wr, int wc, int fr, int fq) const {
        const int row0 = u.pm * 256 + wr * 64 + fr;
#pragma unroll
        for (int bj = 0; bj < 2; ++bj) {
            const int col0 = u.pn * 256 + bj * 128 + wc * 32 + 8 * fq;
            const int seg = u.pn * 2 + bj; const bool gl = (seg >= 15 && seg < 18);
            const f32x4 b0 = *(const f32x4*)(bias + col0), b1 = *(const f32x4*)(bias + col0 + 4);
#pragma unroll
            for (int ai = 0; ai < 2; ++ai)
#pragma unroll
                for (int m = 0; m < 4; ++m) {
                    f32x4 v0 = acc[ai][bj][m][0] + b0, v1 = acc[ai][bj][m][1] + b1;
                    if (gl) {
#pragma unroll
                        for (int j = 0; j < 4; ++j) { v0[j] = gelu_tanh(v0[j]); v1[j] = gelu_tanh(v1[j]); } }
                    u32x4 w; w.x = pk_bf16(v0[0], v0[1]); w.y = pk_bf16(v0[2], v0[3]); w.z = pk_bf16(v1[0], v1[1]); w.w = pk_bf16(v1[2], v1[3]);
                    *(u32x4*)(Pout + (size_t)(row0 + ai * 128 + m * 16) * NP + col0) = w;
                }
        }
    }
};
struct EpiOut {
    static constexpr bool PERM = false;
    const float* xs; float* xmid; const float* mod;
    DEVI void operator()(const f32x4 (&acc)[2][2][4][2], const g1::Unit& u, int wr, int wc, int fr, int fq) const {
        const int row0 = u.pm * 256 + wr * 64 + fr;
        const float* g1p = mod + (size_t)mod_row(u.pm * 256) * 6144 + 2048;
#pragma unroll
        for (int bj = 0; bj < 2; ++bj)
#pragma unroll
            for (int n = 0; n < 2; ++n) {
                const int col = u.pn * 256 + bj * 128 + wc * 32 + 16 * n + 4 * fq;
                const f32x4 gv = *(const f32x4*)(g1p + col);
#pragma unroll
                for (int ai = 0; ai < 2; ++ai)
#pragma unroll
                    for (int m = 0; m < 4; ++m) {
                        const size_t off = (size_t)(row0 + ai * 128 + m * 16) * 1024 + col;
                        const f32x4 xv = *(const f32x4*)(xs + off);
                        *(f32x4*)(xmid + off) = xv + gv * acc[ai][bj][m][n];
                    }
            }
    }
};
struct EpiGU {
    static constexpr bool PERM = true;
    unsigned char* act; const float* bgu;
    DEVI void operator()(const f32x4 (&acc)[2][2][4][2], const g1::Unit& u, int wr, int wc, int fr, int fq) const {
        const int row0 = u.pm * 256 + wr * 64 + fr, colh = u.pn * 128 + wc * 32 + 8 * fq;
        const float* bg = bgu + (size_t)u.e * 2048 + colh; const float* bu = bg + 1024;
        const f32x4 bg0 = *(const f32x4*)bg, bg1 = *(const f32x4*)(bg + 4), bu0 = *(const f32x4*)bu, bu1 = *(const f32x4*)(bu + 4);
#pragma unroll
        for (int ai = 0; ai < 2; ++ai)
#pragma unroll
            for (int m = 0; m < 4; ++m) {
                float o[8];
#pragma unroll
                for (int n = 0; n < 2; ++n)
#pragma unroll
                    for (int j = 0; j < 4; ++j) {
                        const float g = fminf(acc[ai][0][m][n][j] * W8_INV + (n ? bg1[j] : bg0[j]), 7.0f);
                        const float up = fminf(fmaxf(acc[ai][1][m][n][j] * W8_INV + (n ? bu1[j] : bu0[j]), -7.0f), 7.0f);
                        o[n * 4 + j] = (up + 1.0f) * g * frcp(1.0f + __expf(-1.702f * g));
                    }
                u32x2 w; w.x = pk4_fp8(o[0], o[1], o[2], o[3]); w.y = pk4_fp8(o[4], o[5], o[6], o[7]);
                *(u32x2*)(act + (size_t)(row0 + ai * 128 + m * 16) * 1024 + colh) = w;
            }
    }
};
struct EpiDown {
    static constexpr bool PERM = true;
    unsigned char* ypad; const float* bd; const float* glist; const LAS int* info;
    DEVI void operator()(const f32x4 (&acc)[2][2][4][2], const g1::Unit& u, int wr, int wc, int fr, int fq) const {
        const int j256 = (u.pm - __builtin_amdgcn_readfirstlane(info[u.e])) * 256, cnt = __builtin_amdgcn_readfirstlane(info[40 + u.e]);
        const int rl0 = wr * 64 + fr;
#pragma unroll
        for (int ai = 0; ai < 2; ++ai)
#pragma unroll
            for (int m = 0; m < 4; ++m) {
                const int rl = rl0 + ai * 128 + m * 16, slot = j256 + rl;
                const float gt = slot < cnt ? glist[(size_t)u.e * TT + slot] : 0.f;
#pragma unroll
                for (int bj = 0; bj < 2; ++bj) {
                    const int col0 = u.pn * 256 + bj * 128 + wc * 32 + 8 * fq;
                    const f32x4 b0 = *(const f32x4*)(bd + (size_t)u.e * 1024 + col0), b1 = *(const f32x4*)(bd + (size_t)u.e * 1024 + col0 + 4);
                    const f32x4 v0 = (acc[ai][bj][m][0] * W8_INV + b0) * gt, v1 = (acc[ai][bj][m][1] * W8_INV + b1) * gt;
                    u32x2 w; w.x = pk4_fp8(v0[0] * Y8_SCALE, v0[1] * Y8_SCALE, v0[2] * Y8_SCALE, v0[3] * Y8_SCALE); w.y = pk4_fp8(v1[0] * Y8_SCALE, v1[1] * Y8_SCALE, v1[2] * Y8_SCALE, v1[3] * Y8_SCALE);
                    *(u32x2*)(ypad + (size_t)(u.pm * 256 + rl) * 1024 + col0) = w;
                }
            }
    }
};

DEVI void ph_inproj(const Ctx& cx, int l) {
    DenseSched S{(const char*)WSP(bf16_t, WS_H), (const char*)(WSP(bf16_t, WS_WIN) + (size_t)l * NP * 1024), TT / 256, NP / 256, 0, cx.G, cx.bid};
    EpiIn E{WSP(bf16_t, WS_P), WSP(float, WS_BIN2) + (size_t)l * NP};
    g1::gemm_phase<DenseSched, EpiIn, false>(cx.lds, cx.tid, S, E);
}
DEVI void ph_outproj(const Ctx& cx, int l) {
    const int pm0 = (l == DEPTH - 1) ? TCTX / 256 : 0;
    DenseSched S{(const char*)WSP(bf16_t, WS_MRG), (const char*)(WSP(bf16_t, WS_WOUT) + (size_t)l * 1024 * 1024), TT / 256 - pm0, 4, pm0, cx.G, cx.bid};
    EpiOut E{WSP(float, WS_XS), WSP(float, WS_XMID), WSP(float, WS_MOD) + (size_t)l * 9 * 6144};
    g1::gemm_phase<DenseSched, EpiOut, false>(cx.lds, cx.tid, S, E);
}
DEVI void ph_moe_gu(const Ctx& cx, int l) {
    LAS int* info = (LAS int*)(cx.lds + g1::STAGE_BYTES);
    moe_info(cx, l, info);
    MoeSched S{(const char*)WSP(unsigned char, WS_H8), (const char*)(WSP(unsigned char, WS_WGU) + (size_t)l * NE * 2048 * 1024), WSP(int, WS_ELIST), info, 8, 1, cx.G, cx.bid, (size_t)2048 * 1024, 1024};
    EpiGU E{WSP(unsigned char, WS_ACT), cx.p->in[I_BGU] + (size_t)l * NE * 2048};
    g1::gemm_phase<MoeSched, EpiGU, true, true>(cx.lds, cx.tid, S, E);
}
DEVI void ph_moe_dn(const Ctx& cx, int l) {
    LAS int* info = (LAS int*)(cx.lds + g1::STAGE_BYTES);
    moe_info(cx, l, info);
    MoeSched S{(const char*)WSP(unsigned char, WS_ACT), (const char*)(WSP(unsigned char, WS_WD) + (size_t)l * NE * 1024 * 1024), nullptr, info, 4, 0, cx.G, cx.bid, (size_t)1024 * 1024, 1024};
    EpiDown E{WSP(unsigned char, WS_YPAD), cx.p->in[I_BD] + (size_t)l * NE * 1024, WSP(float, WS_GLIST), info};
    g1::gemm_phase<MoeSched, EpiDown, false, true>(cx.lds, cx.tid, S, E);
}

DEVI int ml_row0(int b, int c) { return c < 2 ? b * CTXL + c * 128 : TCTX + b * SEQ + (c - 2) * 128; }
DEVI unsigned short lds_u16(const LAS bf16_t* p) { return *p; }
typedef short s16x4 __attribute__((ext_vector_type(4)));
DEVI bf16x8 tr8(const LAS bf16_t* tile, int stride, int r0, int r1, int c0, int lane) {
    const int q = (lane & 15) >> 2, p = lane & 3;
    const s16x4 a = __builtin_amdgcn_ds_read_tr16_b64_v4i16((LAS s16x4*)(tile + (r0 + q) * stride + c0 + 4 * p));
    const s16x4 b = __builtin_amdgcn_ds_read_tr16_b64_v4i16((LAS s16x4*)(tile + (r1 + q) * stride + c0 + 4 * p));
    return __builtin_shufflevector(a, b, 0, 1, 2, 3, 4, 5, 6, 7);
}

DEVI void ml_local_unit(const Ctx& cx, int l, int b, int h, int c) {
    LAS float* sg = (LAS float*)cx.lds;
    LAS float* se = sg + 256;
    LAS float* red = se + 256;
    LAS bf16_t* Ks = (LAS bf16_t*)(cx.lds + 4352);
    LAS bf16_t* Ve = Ks + 128 * 104;
    const int row0 = ml_row0(b, c), tid = cx.tid;
    const int dir = (tid >> 7) & 1, i = tid & 127, p = dir ? 127 - i : i;
    const bool act = tid < 256;
    float gi = 0.f, bval = 0.f, u = 0.f;
    if (act) { const float* gt = WSP(float, WS_GT) + (size_t)(row0 + i) * 16; gi = gt[dir * 4 + h]; const float gf = gt[8 + dir * 4 + h];
        sg[dir * 128 + p] = fminf(gf, 0.f) - log1p_(__expf(-fabsf(gf))); }
    LDS_SYNC();
#pragma unroll 1
    for (int off = 1; off < 128; off <<= 1) { float v = 0.f; if (act) { v = sg[dir * 128 + p]; if (p >= off) v += sg[dir * 128 + p - off]; } LDS_SYNC(); if (act) sg[dir * 128 + p] = v; LDS_SYNC(); }
    if (act) { bval = sg[dir * 128 + p]; u = gi - bval; if (p == 127) red[dir] = bval; }
    LDS_SYNC();
    if (act) sg[dir * 128 + p] = u;
    LDS_SYNC();
#pragma unroll 1
    for (int off = 1; off < 128; off <<= 1) { float v = 0.f; if (act) { v = sg[dir * 128 + p]; if (p >= off) v = fmaxf(v, sg[dir * 128 + p - off]); } LDS_SYNC(); if (act) sg[dir * 128 + p] = v; LDS_SYNC(); }
    if (act) { const float cm = sg[dir * 128 + p]; if (p == 127) red[2 + dir] = cm;
        const size_t gix = (size_t)(row0 + i) * 8 + dir * 4 + h;
        WSP(float, WS_GB)[gix] = bval; WSP(float, WS_GU)[gix] = u; WSP(float, WS_GCM)[gix] = cm; }
    LDS_SYNC();
    if (act) se[dir * 128 + i] = expf(u - red[2 + dir]);
    if (tid < 2) { float* msc = WSP(float, WS_MSC) + ((size_t)((b * 4 + h) * MLC + c) * 2 + tid) * 2; msc[0] = red[tid]; msc[1] = red[tid] + red[2 + tid]; }
    LDS_SYNC();
    const bf16_t* Pp = WSP(bf16_t, WS_P);
#pragma unroll
    for (int it = 0; it < 3; ++it) { const int idx = tid + NTHR * it, r = idx / 12, ch = idx % 12;
        const u32x4 kv = *(const u32x4*)(Pp + (size_t)(row0 + r) * NP + PC_K + h * 96 + ch * 8);
        *(LAS u32x4*)(Ks + r * 104 + ch * 8) = kv;
        const u32x4 vv = *(const u32x4*)(Pp + (size_t)(row0 + r) * NP + PC_V + h * 96 + ch * 8);
        const float e0 = se[r], e1 = se[128 + r];
        u32x4 o0, o1;
#pragma unroll
        for (int q = 0; q < 4; ++q) { const float lo = __uint_as_float(vv[q] << 16), hi = __uint_as_float(vv[q] & 0xFFFF0000u);
            o0[q] = pk_bf16(lo * e0, hi * e0); o1[q] = pk_bf16(lo * e1, hi * e1); }
        *(LAS u32x4*)(Ve + r * 104 + ch * 8) = o0; *(LAS u32x4*)(Ve + (128 + r) * 104 + ch * 8) = o1; }
    LDS_SYNC();
    {
        const int wd = cx.wave >> 2, q9 = (cx.wave & 3) * 9, fr = cx.lane & 15, fq = cx.lane >> 4;
        float* cl = WSP(float, WS_CLOC) + ((size_t)((b * 4 + h) * MLC + c) * 2 + wd) * 9216;
        const LAS bf16_t* V = Ve + wd * 128 * 104;
#pragma unroll 1
        for (int pi = q9; pi < q9 + 9; ++pi) { const int dt = pi / 6, et = pi % 6;
            f32x4 acc = (f32x4){0.f, 0.f, 0.f, 0.f};
#pragma unroll
            for (int kk = 0; kk < 4; ++kk) { const int s0 = kk * 32 + fq * 8;
                const bf16x8 a = tr8(V, 104, s0, s0 + 4, dt * 16, cx.lane), bb = tr8(Ks, 104, s0, s0 + 4, et * 16, cx.lane);
                acc = __builtin_amdgcn_mfma_f32_16x16x32_bf16(a, bb, acc, 0, 0, 0); }
#pragma unroll
            for (int r = 0; r < 4; ++r) cl[(dt * 16 + fq * 4 + r) * 96 + et * 16 + fr] = acc[r]; }
    }
    {
        LAS float* nred = (LAS float*)(cx.lds + 4352 + 3 * 128 * 104 * 2);
        for (int idx = tid; idx < 768; idx += NTHR) { const int qd = idx / 192, rem = idx % 192, d2 = rem / 96, e = rem % 96; float s = 0.f;
#pragma unroll 8
            for (int t = qd * 32; t < qd * 32 + 32; ++t) s += se[d2 * 128 + t] * bf2f(Ks[t * 104 + e]);
            nred[idx] = s; }
        LDS_SYNC();
        if (tid < 192) WSP(float, WS_NLOC)[((size_t)((b * 4 + h) * MLC + c) * 2 + tid / 96) * 96 + tid % 96] = (nred[tid] + nred[192 + tid]) + (nred[384 + tid] + nred[576 + tid]);
    }
    LDS_SYNC();
}

DEVI void ml_carry(const Ctx& cx) {
    for (int idx = cx.bid * NTHR + cx.tid; idx < 64 * 9312; idx += cx.G * NTHR) {
        const int combo = idx / 9312, el = idx % 9312, dir = combo & 1, bh = combo >> 1;
        float loc[MLC], bl[MLC], ml[MLC];
#pragma unroll
        for (int s = 0; s < MLC; ++s) {
            const int c = dir == 0 ? s : (s < 2 ? 1 - s : 19 - s);
            const size_t cb = (size_t)(bh * MLC + c) * 2 + dir;
            bl[s] = WSP(float, WS_MSC)[cb * 2]; ml[s] = WSP(float, WS_MSC)[cb * 2 + 1];
            loc[s] = el < 9216 ? WSP(float, WS_CLOC)[cb * 9216 + el] : WSP(float, WS_NLOC)[cb * 96 + el - 9216];
        }
        float Cv = 0.f, m = -1e30f;
#pragma unroll
        for (int s = 0; s < MLC; ++s) {
            const int c = dir == 0 ? s : (s < 2 ? 1 - s : 19 - s);
            const size_t cb = (size_t)(bh * MLC + c) * 2 + dir;
            if (el < 9216) WSP(bf16_t, WS_C0)[cb * 9216 + el] = f2bf(Cv); else WSP(float, WS_N0)[cb * 96 + el - 9216] = Cv;
            if (el == 0) WSP(float, WS_M0)[cb] = m;
            const float mn = fmaxf(bl[s] + m, ml[s]), a = __expf(bl[s] + m - mn), sc = __expf(ml[s] - mn);
            Cv = a * Cv + sc * loc[s]; m = mn;
        }
    }
}

DEVI void ml_out_unit(const Ctx& cx, int l, int b, int h, int c) {
    LAS bf16_t* Qs = (LAS bf16_t*)cx.lds;
    LAS bf16_t* Ks = Qs + 128 * 104;
    LAS bf16_t* Vs = Ks + 128 * 104;
    LAS bf16_t* C0s = Vs + 128 * 104;
    LAS float* gb = (LAS float*)(cx.lds + 119808);
    LAS float* gu = gb + 256;
    LAS float* gM = gu + 256;
    LAS float* n0s = gM + 256;
    LAS float* m0s = n0s + 192;
    const int row0 = ml_row0(b, c), tid = cx.tid;
    const bf16_t* Pp = WSP(bf16_t, WS_P);
    const size_t cb0 = (size_t)((b * 4 + h) * MLC + c) * 2;
#pragma unroll
    for (int it = 0; it < 3; ++it) { const int idx = tid + NTHR * it, r = idx / 12, ch = idx % 12;
        const bf16_t* rp = Pp + (size_t)(row0 + r) * NP + h * 96 + ch * 8;
        *(LAS u32x4*)(Qs + r * 104 + ch * 8) = *(const u32x4*)(rp + PC_Q);
        *(LAS u32x4*)(Ks + r * 104 + ch * 8) = *(const u32x4*)(rp + PC_K);
        *(LAS u32x4*)(Vs + r * 104 + ch * 8) = *(const u32x4*)(rp + PC_V); }
    for (int idx = tid; idx < 2 * 96 * 12; idx += NTHR) { const int d2 = idx / 1152, r = (idx % 1152) / 12, ch = idx % 12;
        *(LAS u32x4*)(C0s + (d2 * 96 + r) * 104 + ch * 8) = *(const u32x4*)(WSP(bf16_t, WS_C0) + (cb0 + d2) * 9216 + r * 96 + ch * 8); }
    if (tid < 256) { const int d2 = tid >> 7, i = tid & 127; const size_t gix = (size_t)(row0 + i) * 8 + d2 * 4 + h;
        gb[tid] = WSP(float, WS_GB)[gix]; gu[tid] = WSP(float, WS_GU)[gix];
        gM[tid] = fmaxf(WSP(float, WS_M0)[cb0 + d2], WSP(float, WS_GCM)[gix]); }
    if (tid >= 256 && tid < 448) { const int k = tid - 256; n0s[k] = WSP(float, WS_N0)[(cb0 + k / 96) * 96 + k % 96]; }
    if (tid >= 448 && tid < 450) m0s[tid - 448] = WSP(float, WS_M0)[cb0 + tid - 448];
    LDS_SYNC();
    const int w = cx.wave, fr = cx.lane & 15, fq = cx.lane >> 4, t = 16 * w + fr;
    bf16x8 qf[3];
#pragma unroll
    for (int kk = 0; kk < 3; ++kk) qf[kk] = *(const LAS bf16x8*)(Qs + t * 104 + kk * 32 + fq * 8);
    f32x4 hs[6];
#pragma unroll
    for (int n = 0; n < 6; ++n) hs[n] = (f32x4){0.f, 0.f, 0.f, 0.f};
#pragma unroll
    for (int dir = 0; dir < 2; ++dir) {
        const float Mt = gM[dir * 128 + t], bt = gb[dir * 128 + t], inter = __expf(m0s[dir] - Mt);
        f32x4 an[6];
#pragma unroll
        for (int n = 0; n < 6; ++n) an[n] = (f32x4){0.f, 0.f, 0.f, 0.f};
        float den = 0.f;
        const int Jlo = dir == 0 ? 0 : (w >> 1), Jhi = dir == 0 ? (w >> 1) : 3;
#pragma unroll 1
        for (int J = Jlo; J <= Jhi; ++J) {
            bf16x8 pf;
#pragma unroll
            for (int half = 0; half < 2; ++half) {
                const int j = 2 * J + half;
                f32x4 D = (f32x4){0.f, 0.f, 0.f, 0.f};
                const bool need = dir == 0 ? (j <= w) : (j >= w);
                if (need) {
#pragma unroll
                    for (int kk = 0; kk < 3; ++kk) { const bf16x8 kf = *(const LAS bf16x8*)(Ks + (16 * j + fr) * 104 + kk * 32 + fq * 8);
                        D = __builtin_amdgcn_mfma_f32_16x16x32_bf16(kf, qf[kk], D, 0, 0, 0); }
                }
                const f32x4 us = *(const LAS f32x4*)(gu + dir * 128 + 16 * j + 4 * fq);
                float pv[4];
#pragma unroll
                for (int r = 0; r < 4; ++r) { const int s = 16 * j + 4 * fq + r; const bool valid = need && (dir == 0 ? (s <= t) : (s >= t));
                    pv[r] = valid ? D[r] * __expf(us[r] - Mt) : 0.f; den += pv[r]; }
                pf[half * 4 + 0] = (short)f2bf(pv[0]); pf[half * 4 + 1] = (short)f2bf(pv[1]); pf[half * 4 + 2] = (short)f2bf(pv[2]); pf[half * 4 + 3] = (short)f2bf(pv[3]);
            }
#pragma unroll
            for (int n = 0; n < 6; ++n) { const bf16x8 vf = tr8(Vs, 104, 32 * J + 4 * fq, 32 * J + 16 + 4 * fq, 16 * n, cx.lane);
                an[n] = __builtin_amdgcn_mfma_f32_16x16x32_bf16(vf, pf, an[n], 0, 0, 0); }
        }
        float nq = 0.f;
#pragma unroll
        for (int kk = 0; kk < 3; ++kk)
#pragma unroll
            for (int j = 0; j < 8; ++j) nq += n0s[dir * 96 + kk * 32 + fq * 8 + j] * bf2f((bf16_t)qf[kk][j]);
        nq += shx<16>(nq, cx.lane); nq += shx<32>(nq, cx.lane);
        den += shx<16>(den, cx.lane); den += shx<32>(den, cx.lane);
        const float dtot = den + inter * nq;
        const float inv = frcp(fmaxf(fabsf(dtot), __expf(-(Mt + bt))));
#pragma unroll
        for (int n = 0; n < 6; ++n) { f32x4 ac = (f32x4){0.f, 0.f, 0.f, 0.f};
#pragma unroll
            for (int kk = 0; kk < 3; ++kk) { const bf16x8 cf = *(const LAS bf16x8*)(C0s + (dir * 96 + 16 * n + fr) * 104 + kk * 32 + fq * 8);
                ac = __builtin_amdgcn_mfma_f32_16x16x32_bf16(cf, qf[kk], ac, 0, 0, 0); }
            hs[n] += (an[n] + ac * inter) * inv; }
    }
    float ss = 0.f;
#pragma unroll
    for (int n = 0; n < 6; ++n) ss += hs[n][0] * hs[n][0] + hs[n][1] * hs[n][1] + hs[n][2] * hs[n][2] + hs[n][3] * hs[n][3];
    ss += shx<16>(ss, cx.lane); ss += shx<32>(ss, cx.lane);
    const float rstd = rsqrtf(ss * (1.0f / 96.0f) + EPS);
    const size_t prow = (size_t)(row0 + t);
#pragma unroll
    for (int n = 0; n < 6; ++n) { const int d = 16 * n + 4 * fq;
        const u32x2 ov = *(const u32x2*)(Pp + prow * NP + PC_O + h * 96 + d);
        const f32x4 mw = *(const f32x4*)(cx.p->in[I_MIXW] + l * 1024 + h * 96 + d);
        const float o0 = __uint_as_float(ov.x << 16), o1 = __uint_as_float(ov.x & 0xFFFF0000u), o2 = __uint_as_float(ov.y << 16), o3 = __uint_as_float(ov.y & 0xFFFF0000u);
        u32x2 wv; wv.x = pk_bf16(sigmoidf_(o0) * hs[n][0] * rstd * mw[0], sigmoidf_(o1) * hs[n][1] * rstd * mw[1]);
        wv.y = pk_bf16(sigmoidf_(o2) * hs[n][2] * rstd * mw[2], sigmoidf_(o3) * hs[n][3] * rstd * mw[3]);
        *(u32x2*)(WSP(bf16_t, WS_MRG) + prow * 1024 + h * 96 + d) = wv; }
    LDS_SYNC();
}

DEVI void rg_unit(const Ctx& cx, int l, int b, int ck, int g, int mode) {
    const Params& P = *cx.p;
    LAS float* xraw = (LAS float*)cx.lds;
    LAS float* xc = (LAS float*)(cx.lds + 17408);
    LAS bf16_t* xcb = (LAS bf16_t*)(cx.lds + 33792);
    LAS float* ab = (LAS float*)(cx.lds + 43008);
    LAS float* hbuf = (LAS float*)(cx.lds + 43008 + 65536);
    const int tid = cx.tid;
    const int t0 = ck < 4 ? ck * 64 : (ck - 4) * 64, seglen = ck < 4 ? CTXL : SEQ, rowbase = ck < 4 ? b * CTXL : TCTX + b * SEQ;
    const bf16_t* Pp = WSP(bf16_t, WS_P);
    for (int idx = tid; idx < 67 * 8; idx += NTHR) { const int r = idx >> 3, c8 = idx & 7, tt = t0 - 2 + r;
        u32x4 v = (u32x4){0u, 0u, 0u, 0u};
        if (tt >= 0 && tt < seglen) v = *(const u32x4*)(Pp + (size_t)(rowbase + tt) * NP + PC_RX + g * 64 + c8 * 8);
#pragma unroll
        for (int q = 0; q < 4; ++q) { xraw[r * 64 + c8 * 8 + 2 * q] = __uint_as_float(v[q] << 16); xraw[r * 64 + c8 * 8 + 2 * q + 1] = __uint_as_float(v[q] & 0xFFFF0000u); } }
    LDS_SYNC();
#pragma unroll
    for (int it = 0; it < 8; ++it) { const int idx = tid + NTHR * it, t = idx >> 6, ch = idx & 63, cg = g * 64 + ch;
        float v = P.in[I_RGCB][l * 384 + cg];
#pragma unroll
        for (int j = 0; j < 4; ++j) v += P.in[I_RGCW][(l * 4 + j) * 384 + cg] * xraw[(t + j) * 64 + ch];
        xc[t * 64 + ch] = v; xcb[t * 72 + ch] = f2bf(v); }
    LDS_SYNC();
    {
        const int dir = cx.wave >> 2, cg4 = cx.wave & 3, fr = cx.lane & 15, fq = cx.lane >> 4;
        const bf16_t* wrg = WSP(bf16_t, WS_WRG) + (size_t)(l * 6 + g) * 256 * 64;
        f32x4 ar[4], ai[4];
#pragma unroll
        for (int m = 0; m < 4; ++m) { ar[m] = (f32x4){0.f, 0.f, 0.f, 0.f}; ai[m] = (f32x4){0.f, 0.f, 0.f, 0.f}; }
#pragma unroll
        for (int kk = 0; kk < 2; ++kk) {
            const bf16x8 br = ldg8(wrg + (size_t)((dir * 2 + 0) * 64 + cg4 * 16 + fr) * 64 + kk * 32 + fq * 8);
            const bf16x8 bi = ldg8(wrg + (size_t)((dir * 2 + 1) * 64 + cg4 * 16 + fr) * 64 + kk * 32 + fq * 8);
#pragma unroll
            for (int m = 0; m < 4; ++m) { const bf16x8 a = *(const LAS bf16x8*)(xcb + (m * 16 + fr) * 72 + kk * 32 + fq * 8);
                ar[m] = __builtin_amdgcn_mfma_f32_16x16x32_bf16(br, a, ar[m], 0, 0, 0); ai[m] = __builtin_amdgcn_mfma_f32_16x16x32_bf16(bi, a, ai[m], 0, 0, 0); }
        }
        const int ch0 = cg4 * 16 + 4 * fq, cgl = g * 64 + ch0;
        const f32x4 ba = *(const f32x4*)(P.in[I_RGBA] + (l * 2 + dir) * 384 + cgl), bx = *(const f32x4*)(P.in[I_RGBX] + (l * 2 + dir) * 384 + cgl);
        const f32x4 lam = *(const f32x4*)(P.in[I_RGLAM] + (l * 2 + dir) * 384 + cgl);
        float sp[4];
#pragma unroll
        for (int j = 0; j < 4; ++j) sp[j] = lam[j] > 0.f ? log1p_(__expf(-lam[j])) : -lam[j] + log1p_(__expf(lam[j]));
#pragma unroll
        for (int m = 0; m < 4; ++m) { const int t = m * 16 + fr; const f32x4 xv = *(const LAS f32x4*)(xc + t * 64 + ch0);
            f32x4 av, bv;
#pragma unroll
            for (int j = 0; j < 4; ++j) { const float r = frcp(1.0f + __expf(-(ar[m][j] + ba[j]))), ii = frcp(1.0f + __expf(-(ai[m][j] + bx[j])));
                const float la = -8.0f * r * sp[j], y = 2.0f * la; av[j] = __expf(la);
                const float nem1 = y > -0.02f ? -y * (1.0f + y * (0.5f + y * 0.16666667f)) : 1.0f - av[j] * av[j];
                bv[j] = sqrtf(nem1) * (ii * xv[j]); }
            *(LAS f32x4*)(ab + ((dir * 2 + 0) * 64 + t) * 64 + ch0) = av; *(LAS f32x4*)(ab + ((dir * 2 + 1) * 64 + t) * 64 + ch0) = bv; }
    }
    LDS_SYNC();
    if (tid < 128) { const int dir = tid >> 6, ch = tid & 63; const size_t ix = ((size_t)(b * RGC + ck) * 2 + dir) * 384 + g * 64 + ch;
        float hc = mode ? WSP(float, WS_RGC)[ix] : 0.f, ap = 1.0f;
        const LAS float* __restrict__ A = ab + (dir * 2 + 0) * 4096 + ch; const LAS float* __restrict__ B = ab + (dir * 2 + 1) * 4096 + ch; LAS float* __restrict__ H = hbuf + dir * 4096 + ch;
#pragma unroll 1
        for (int s0 = 0; s0 < 64; s0 += 16) { float av[16], bv[16];
#pragma unroll
            for (int j = 0; j < 16; ++j) { const int t = dir ? 63 - (s0 + j) : s0 + j; av[j] = A[t * 64]; bv[j] = B[t * 64]; }
#pragma unroll
            for (int j = 0; j < 16; ++j) { const int t = dir ? 63 - (s0 + j) : s0 + j; hc = av[j] * hc + bv[j]; ap *= av[j]; if (mode) H[t * 64] = hc; } }
        if (!mode) { WSP(float, WS_RGA)[ix] = ap; WSP(float, WS_RGB)[ix] = hc; } }
    LDS_SYNC();
    if (mode) { const int t = tid >> 3, ch0 = (tid & 7) * 8; float hv[8]; float ss = 0.f;
#pragma unroll
        for (int j = 0; j < 8; ++j) { hv[j] = hbuf[t * 64 + ch0 + j] + hbuf[4096 + t * 64 + ch0 + j]; ss += hv[j] * hv[j]; }
        ss += dpp_<0xB1, 0xF>(ss); ss += dpp_<0x4E, 0xF>(ss); ss += dpp_<0x141, 0xF>(ss);
        const float rstd = rsqrtf(ss * (1.0f / 64.0f) + EPS);
        const size_t row = (size_t)(rowbase + t0 + t);
        const u32x4 gv = *(const u32x4*)(Pp + row * NP + PC_RG + g * 64 + ch0);
        const float* mw = P.in[I_MIXW] + l * 1024 + 384 + g * 64 + ch0;
        u32x4 o;
#pragma unroll
        for (int q = 0; q < 4; ++q) { const float g0 = __uint_as_float(gv[q] << 16), g1v = __uint_as_float(gv[q] & 0xFFFF0000u);
            o[q] = pk_bf16(g0 * hv[2 * q] * rstd * mw[2 * q], g1v * hv[2 * q + 1] * rstd * mw[2 * q + 1]); }
        *(u32x4*)(WSP(bf16_t, WS_MRG) + row * 1024 + 384 + g * 64 + ch0) = o;
        LDS_SYNC(); }
}
DEVI void rg_carry(const Ctx& cx) {
    for (int idx = (cx.G - 1 - cx.bid) * NTHR + cx.tid; idx < NB * 2 * 384; idx += cx.G * NTHR) {
        const int ch = idx % 384, dir = (idx / 384) & 1, b = idx / 768;
        float A[RGC], B[RGC];
#pragma unroll
        for (int s = 0; s < RGC; ++s) { const int ck = dir == 0 ? s : (s < 4 ? 3 - s : 39 - s);
            const size_t ix = ((size_t)(b * RGC + ck) * 2 + dir) * 384 + ch; A[s] = WSP(float, WS_RGA)[ix]; B[s] = WSP(float, WS_RGB)[ix]; }
        float h = 0.f;
#pragma unroll
        for (int s = 0; s < RGC; ++s) { const int ck = dir == 0 ? s : (s < 4 ? 3 - s : 39 - s);
            const size_t ix = ((size_t)(b * RGC + ck) * 2 + dir) * 384 + ch; WSP(float, WS_RGC)[ix] = h; h = A[s] * h + B[s]; }
    }
}

DEVI int s5_trow(int rowi, int s) { const int b = rowi / S5C, c = rowi % S5C; return c < 8 ? b * CTXL + c * 32 + s : TCTX + b * SEQ + s * 64 + (c - 8); }
DEVI void s5_local_wave(const Ctx& cx, int l, int wu) {
    const int g = wu / 36, mt = (wu % 36) / 4, nt = wu % 4;
    const bf16_t* Pp = WSP(bf16_t, WS_P) + PC_S5 + g * 16;
    const bf16_t* we = WSP(bf16_t, WS_WE) + (size_t)(l * 16 + g) * 256 * 512 + (size_t)nt * 64 * 512;
    f32x4 acc[4][4];
    wave_gemm<4, 4>(cx.lane, 512, [&](int row, int k) { return ldg8(Pp + (size_t)s5_trow(mt * 64 + row, k >> 4) * NP + (k & 15)); },
                         [&](int row, int k) { return ldg8(we + (size_t)row * 512 + k); }, acc);
    const int fr = cx.lane & 15, fq = cx.lane >> 4;
#pragma unroll
    for (int m = 0; m < 4; ++m)
#pragma unroll
        for (int n = 0; n < 4; ++n) *(f32x4*)(WSP(float, WS_SLOC) + ((size_t)g * S5R + mt * 64 + m * 16 + fr) * 256 + nt * 64 + n * 16 + 4 * fq) = acc[m][n];
}
DEVI void s5_carry(const Ctx& cx, int l) {
    for (int idx = cx.bid * NTHR + cx.tid; idx < NB * 16 * 2 * 64; idx += cx.G * NTHR) {
        const int n = idx & 63, d = (idx >> 6) & 1, g = (idx >> 7) & 15, b = idx >> 11;
        const f32x2 a32 = WSP(f32x2, WS_PW)[(size_t)(((l * 16 + g) * 2 + d) * 64 + n) * 33 + 32];
        float sr = 0.f, si = 0.f;
#pragma unroll 1
        for (int s0 = 0; s0 < S5C; s0 += 24) {
            float lr[24], li[24];
#pragma unroll
            for (int j = 0; j < 24; ++j) { const int s = s0 + j, c = d == 0 ? s : (s < 8 ? 7 - s : 79 - s);
                const size_t ix = ((size_t)g * S5R + b * S5C + c) * 256 + d * 128 + n; lr[j] = WSP(float, WS_SLOC)[ix]; li[j] = WSP(float, WS_SLOC)[ix + 64]; }
#pragma unroll
            for (int j = 0; j < 24; ++j) { const int s = s0 + j, c = d == 0 ? s : (s < 8 ? 7 - s : 79 - s);
                const size_t ix = ((size_t)g * S5R + b * S5C + c) * 256 + d * 128 + n;
                WSP(bf16_t, WS_SIN)[ix] = f2bf(sr); WSP(bf16_t, WS_SIN)[ix + 64] = f2bf(si);
                const float nr = a32.x * sr - a32.y * si + lr[j], ni = a32.x * si + a32.y * sr + li[j]; sr = nr; si = ni; }
        }
    }
}
DEVI void s5_out_wave(const Ctx& cx, int l, int wu) {
    const int g = wu / 72, mt = (wu % 72) / 8, nt = wu % 8;
    const bf16_t* Pp = WSP(bf16_t, WS_P) + PC_S5 + g * 16;
    const bf16_t* sin_ = WSP(bf16_t, WS_SIN) + (size_t)g * S5R * 256;
    const bf16_t* wy = WSP(bf16_t, WS_WY) + (size_t)(l * 16 + g) * 512 * 768 + (size_t)nt * 64 * 768;
    f32x4 acc[4][4];
    wave_gemm<4, 4>(cx.lane, 768, [&](int row, int k) { return k < 512 ? ldg8(Pp + (size_t)s5_trow(mt * 64 + row, k >> 4) * NP + (k & 15)) : ldg8(sin_ + (size_t)(mt * 64 + row) * 256 + (k - 512)); },
                         [&](int row, int k) { return ldg8(wy + (size_t)row * 768 + k); }, acc);
    const int fr = cx.lane & 15, fq = cx.lane >> 4;
#pragma unroll
    for (int m = 0; m < 4; ++m)
#pragma unroll
        for (int n = 0; n < 4; ++n) { const int trow = s5_trow(mt * 64 + m * 16 + fr, nt * 4 + n);
            u32x2 w; w.x = pk_bf16(gelu_tanh(acc[m][n][0]), gelu_tanh(acc[m][n][1])); w.y = pk_bf16(gelu_tanh(acc[m][n][2]), gelu_tanh(acc[m][n][3]));
            *(u32x2*)(WSP(bf16_t, WS_GS) + (size_t)trow * 256 + g * 16 + 4 * fq) = w; }
}
DEVI void s5_glu_wave(const Ctx& cx, int l, int wu) {
    const int mt = wu / 4, nt = wu % 4;
    const bf16_t* gs = WSP(bf16_t, WS_GS) + (size_t)mt * 64 * 256;
    const bf16_t* wg = WSP(bf16_t, WS_WGLU) + (size_t)l * 65536 + (size_t)nt * 64 * 256;
    f32x4 acc[4][4];
    wave_gemm<4, 4>(cx.lane, 256, [&](int row, int k) { return ldg8(gs + (size_t)row * 256 + k); }, [&](int row, int k) { return ldg8(wg + (size_t)row * 256 + k); }, acc);
    const int fr = cx.lane & 15, fq = cx.lane >> 4;
#pragma unroll
    for (int n = 0; n < 4; ++n) { const int col = nt * 64 + n * 16 + 4 * fq;
        const f32x4 gb = *(const f32x4*)(cx.p->in[I_S5GB] + l * 256 + col), mw = *(const f32x4*)(cx.p->in[I_MIXW] + l * 1024 + 768 + col);
#pragma unroll
        for (int m = 0; m < 4; ++m) { const size_t trow = (size_t)mt * 64 + m * 16 + fr;
            const u32x2 gv = *(const u32x2*)(WSP(bf16_t, WS_GS) + trow * 256 + col);
            const float gq[4] = {__uint_as_float(gv.x << 16), __uint_as_float(gv.x & 0xFFFF0000u), __uint_as_float(gv.y << 16), __uint_as_float(gv.y & 0xFFFF0000u)};
            float o[4]; float ss = 0.f;
#pragma unroll
            for (int j = 0; j < 4; ++j) { o[j] = gq[j] * frcp(1.0f + __expf(-(acc[m][n][j] + gb[j]))); ss += o[j] * o[j]; }
            ss += shx<16>(ss, cx.lane); ss += shx<32>(ss, cx.lane);
            const float rstd = rsqrtf(ss * (1.0f / 16.0f) + EPS);
            u32x2 w; w.x = pk_bf16(o[0] * rstd * mw[0], o[1] * rstd * mw[1]); w.y = pk_bf16(o[2] * rstd * mw[2], o[3] * rstd * mw[3]);
            *(u32x2*)(WSP(bf16_t, WS_MRG) + trow * 1024 + 768 + col) = w; } }
}

#ifndef PH_DUP2
#define PH_DUP2 0
#endif
#define REP_(k) for (int rep_ = 0; rep_ < 1 + ((PH_DUP2 >> (k)) & 1); ++rep_)
DEVI void ph_mix_local(const Ctx& cx, int l) {
    REP_(0) for (int u = cx.bid; u < NB * 4 * MLC; u += cx.G) ml_local_unit(cx, l, u / (4 * MLC), (u / MLC) % 4, u % MLC);
    REP_(1) { const int off = (NB * 4 * MLC) % cx.G; const int first = (cx.bid - off + cx.G) % cx.G;
      for (int u = first; u < NB * RGC * 6; u += cx.G) rg_unit(cx, l, u / (RGC * 6), (u / 6) % RGC, u % 6, 0); }
    REP_(2) { const int off = (NB * 4 * MLC + NB * RGC * 6) % cx.G; const int first = (cx.bid - off + cx.G) % cx.G;
      for (int wu = first * 8 + cx.wave; wu < 16 * 36; wu += cx.G * 8) s5_local_wave(cx, l, wu); }
}
DEVI void ph_mix_carry(const Ctx& cx, int l) { ml_carry(cx); rg_carry(cx); s5_carry(cx, l); }
DEVI void ph_mix_out(const Ctx& cx, int l) {
    const bool last = (l == DEPTH - 1);
    REP_(3) for (int u = cx.bid; u < NB * 4 * MLC; u += cx.G) { const int c = u % MLC; if (last && c < 2) continue; ml_out_unit(cx, l, u / (4 * MLC), (u / MLC) % 4, c); }
    REP_(4) { const int off = (NB * 4 * MLC) % cx.G; const int first = (cx.bid - off + cx.G) % cx.G;
      for (int u = first; u < NB * RGC * 6; u += cx.G) { const int ck = (u / 6) % RGC; if (last && ck < 4) continue; rg_unit(cx, l, u / (RGC * 6), ck, u % 6, 1); } }
    REP_(5) { const int off = (NB * 4 * MLC + NB * RGC * 6) % cx.G; const int first = (cx.bid - off + cx.G) % cx.G;
      for (int wu = first * 8 + cx.wave; wu < 16 * 72; wu += cx.G * 8) s5_out_wave(cx, l, wu); }
}
DEVI void ph_glu(const Ctx& cx, int l) {
    for (int wu = cx.bid * 8 + cx.wave; wu < (TT / 64) * 4; wu += cx.G * 8) s5_glu_wave(cx, l, wu);
}

DEVI unsigned st_launder(unsigned s_addr) { unsigned a; asm volatile("v_mov_b32 %0, %1" : "=v"(a) : "s"(s_addr)); return a; }
constexpr int N_STEPS = 3 + 10 * DEPTH + 1;
__global__ void __launch_bounds__(NTHR, 2) mk_fwd(Params p) {
    extern __shared__ __attribute__((aligned(16))) unsigned char lds_raw[];
    Ctx cx; cx.p = &p; cx.ws = p.ws; cx.lds = (LAS unsigned char*)lds_raw; cx.tid = threadIdx.x; cx.lane = cx.tid & 63;
    cx.wave = __builtin_amdgcn_readfirstlane((int)threadIdx.x >> 6); cx.G = gridDim.x; cx.bid = blockIdx.x;
    volatile LAS unsigned* st = (volatile LAS unsigned*)(cx.lds + LDS_BYTES - 16);
    const unsigned st_s = (unsigned)__builtin_amdgcn_readfirstlane((int)(unsigned)(size_t)(LAS unsigned*)(cx.lds + LDS_BYTES - 16));
#define ST_P ((volatile LAS unsigned*)(size_t)st_launder(st_s))
    if (cx.tid == 0) { st[0] = 0u; st[1] = 0u; st[2] = (unsigned)p.lo; st[3] = (unsigned)p.hi; }
    __syncthreads();
    (void)xcd_barrier_post((unsigned*)(p.ws + WS_CTL) + CW_BAR, st);
#define GRID_BAR() do { XcdBarrier b_; b_.bar = (unsigned*)(p.ws + WS_CTL) + CW_BAR; b_.x = (unsigned)__builtin_amdgcn_readfirstlane((int)xb_xcc_id()); b_.st = ST_P; xcd_barrier(b_); } while (0)
#ifndef PH_MASK
#define PH_MASK 0xFFFF
#endif
#ifndef PH_DUP
#define PH_DUP 0
#endif
#define STEP_(id, k, call) do { const int lo_ = __builtin_amdgcn_readfirstlane((int)ST_P[2]), hi_ = __builtin_amdgcn_readfirstlane((int)ST_P[3]); if (lo_ <= (k) && (k) < hi_) { if ((PH_MASK >> (id)) & 1) { const Ctx cl = relaunder(cx); call; } if ((PH_DUP >> (id)) & 1) { GRID_BAR(); const Ctx cl = relaunder(cx); call; } if ((k) + 1 < hi_) GRID_BAR(); } } while (0)
    STEP_(0, 0, ph_pro_a(cl));
    STEP_(1, 1, ph_pro_b(cl));
    STEP_(2, 2, ph_pro_c(cl));
#pragma unroll 1
    for (int l = 0; l < DEPTH; ++l) {
        const int s0 = 3 + 10 * l;
        STEP_(3, s0 + 0, ph_norm1(cl, l));
        STEP_(4, s0 + 1, ph_inproj(cl, l));
        STEP_(5, s0 + 2, ph_mix_local(cl, l));
        STEP_(6, s0 + 3, ph_mix_carry(cl, l));
        STEP_(7, s0 + 4, ph_mix_out(cl, l));
        STEP_(8, s0 + 5, ph_glu(cl, l));
        STEP_(9, s0 + 6, ph_outproj(cl, l));
        STEP_(10, s0 + 7, ph_norm2(cl, l));
        STEP_(11, s0 + 8, ph_moe_gu(cl, l));
        STEP_(12, s0 + 9, ph_moe_dn(cl, l));
    }
    STEP_(13, N_STEPS - 1, ph_norm1(cl, DEPTH));
#undef STEP_
}

extern "C" void kernel_launch(void* const* d_in, const int* in_sizes, int n_in, void* d_out, int out_size, void* d_ws, size_t ws_size, hipStream_t stream) {
    static int grid = 0;
    if (grid == 0) {
        if (n_in != 36 || out_size != TLAT * DM || ws_size < WS_END) { fprintf(stderr, "kernel_launch: unexpected problem (n_in %d, out %d, ws %zu < %zu)\n", n_in, out_size, ws_size, (size_t)WS_END); grid = -1; return; }
        int dev = 0, cus = 0, per_cu = 0;
        if (hipGetDevice(&dev) != hipSuccess || hipDeviceGetAttribute(&cus, hipDeviceAttributeMultiprocessorCount, dev) != hipSuccess) { grid = -1; return; }
        if (hipFuncSetAttribute((const void*)mk_fwd, hipFuncAttributeMaxDynamicSharedMemorySize, LDS_BYTES) != hipSuccess) { fprintf(stderr, "kernel_launch: hipFuncSetAttribute failed\n"); grid = -1; return; }
        if (hipOccupancyMaxActiveBlocksPerMultiprocessor(&per_cu, (const void*)mk_fwd, NTHR, LDS_BYTES) != hipSuccess || per_cu < 1) { fprintf(stderr, "kernel_launch: occupancy query says %d blocks per CU\n", per_cu); }
        (void)hipGetLastError();
        grid = cus;
    }
    if (grid < 0) return;
    (void)hipMemsetAsync((char*)d_ws + WS_CTL, 0, CTL_BYTES, stream);
    Params p{};
    for (int i = 0; i < 36; ++i) p.in[i] = (const float*)d_in[i];
    p.out = (float*)d_out; p.ws = (unsigned char*)d_ws;
#if MK_FUSED
    p.lo = 0; p.hi = N_STEPS;
    hipLaunchKernelGGL(mk_fwd, dim3(grid), dim3(NTHR), LDS_BYTES, stream, p);
#else
    for (int k = 0; k < N_STEPS; ++k) { p.lo = k; p.hi = k + 1; hipLaunchKernelGGL(mk_fwd, dim3(grid), dim3(NTHR), LDS_BYTES, stream, p); }
#endif
}
```

```cpp
#include <hip/hip_runtime.h>
#include <stdint.h>
#include <stdio.h>

#ifndef MK_FUSED
#define MK_FUSED 1
#endif

typedef unsigned short bf16_t;
typedef short bf16x8 __attribute__((ext_vector_type(8)));
typedef float f32x4 __attribute__((ext_vector_type(4)));
typedef float f32x2 __attribute__((ext_vector_type(2)));
typedef unsigned u32x4 __attribute__((ext_vector_type(4)));
typedef unsigned u32x2 __attribute__((ext_vector_type(2)));
typedef int i32x4 __attribute__((ext_vector_type(4)));
typedef int i32x8 __attribute__((ext_vector_type(8)));
#define LAS __attribute__((address_space(3)))
#define DEVI __device__ __forceinline__

constexpr int DM = 1024, NB = 8, SEQ = 2048, CTXL = 256, DEPTH = 4;
constexpr int TCTX = NB * CTXL, TLAT = NB * SEQ, TT = TCTX + TLAT;
constexpr int DIN = 2576, NP = 2560;
constexpr int NE = 32;
constexpr int PMAX = 81920;
constexpr int NTHR = 512;
constexpr int LDS_BYTES = 152 * 1024;
constexpr float EPS = 1e-6f;
constexpr float W8_SCALE = 32.0f, W8_INV = 0.03125f;
constexpr float Y8_SCALE = 8.0f, Y8_INV = 0.125f;
constexpr int PC_Q = 0, PC_K = 384, PC_V = 768, PC_O = 1152, PC_RX = 1536, PC_RG = 1920, PC_S5 = 2304;
constexpr int MLC = 18;
constexpr int RGC = 36;
constexpr int S5C = 72, S5R = NB * S5C;

constexpr size_t al256(size_t x) { return (x + 255) & ~(size_t)255; }
constexpr size_t WS_CTL   = 0;
constexpr size_t CTL_BYTES = 65536;
constexpr size_t CW_BAR = 0;
constexpr size_t CW_CNT = 4096;
constexpr size_t WS_WIN   = al256(WS_CTL + CTL_BYTES);
constexpr size_t WS_WOUT  = al256(WS_WIN + (size_t)DEPTH * NP * 1024 * 2);
constexpr size_t WS_WGU   = al256(WS_WOUT + (size_t)DEPTH * 1024 * 1024 * 2);
constexpr size_t WS_WD    = al256(WS_WGU + (size_t)DEPTH * NE * 2048 * 1024 * 2);
constexpr size_t WS_MOD   = al256(WS_WD + (size_t)DEPTH * NE * 1024 * 1024 * 2);
constexpr size_t WS_PW    = al256(WS_MOD + (size_t)DEPTH * 9 * 6144 * 4);
constexpr size_t WS_BB    = al256(WS_PW + (size_t)DEPTH * 16 * 2 * 64 * 33 * 8);
constexpr size_t WS_KT    = al256(WS_BB + (size_t)DEPTH * 16 * 2 * 64 * 16 * 8);
constexpr size_t WS_WY    = al256(WS_KT + (size_t)DEPTH * 16 * 2 * 32 * 256 * 4);
constexpr size_t WS_WE    = al256(WS_WY + (size_t)DEPTH * 16 * 512 * 768 * 2);
constexpr size_t WS_WRG   = al256(WS_WE + (size_t)DEPTH * 16 * 256 * 512 * 2);
constexpr size_t WS_WGLU  = al256(WS_WRG + (size_t)DEPTH * 6 * 256 * 64 * 2);
constexpr size_t WS_XS    = al256(WS_WGLU + (size_t)DEPTH * 256 * 256 * 2);
constexpr size_t WS_XMID  = al256(WS_XS + (size_t)TT * 1024 * 4);
constexpr size_t WS_H     = al256(WS_XMID + (size_t)TT * 1024 * 4);
constexpr size_t WS_GT    = al256(WS_H + (size_t)TT * 1024 * 2);
constexpr size_t WS_P     = al256(WS_GT + (size_t)TT * 16 * 4);
constexpr size_t WS_GB    = al256(WS_P + (size_t)TT * NP * 2);
constexpr size_t WS_GU    = al256(WS_GB + (size_t)TT * 8 * 4);
constexpr size_t WS_GCM   = al256(WS_GU + (size_t)TT * 8 * 4);
constexpr size_t WS_MSC   = al256(WS_GCM + (size_t)TT * 8 * 4);
constexpr size_t WS_CLOC  = al256(WS_MSC + (size_t)8 * 4 * 18 * 2 * 2 * 4);
constexpr size_t WS_NLOC  = al256(WS_CLOC + (size_t)8 * 4 * 18 * 2 * 9216 * 4);
constexpr size_t WS_C0    = al256(WS_NLOC + (size_t)8 * 4 * 18 * 2 * 96 * 4);
constexpr size_t WS_N0    = al256(WS_C0 + (size_t)8 * 4 * 18 * 2 * 9216 * 2);
constexpr size_t WS_M0    = al256(WS_N0 + (size_t)8 * 4 * 18 * 2 * 96 * 4);
constexpr size_t WS_RGA   = al256(WS_M0 + (size_t)8 * 4 * 18 * 2 * 4);
constexpr size_t WS_RGB   = al256(WS_RGA + (size_t)8 * 36 * 2 * 384 * 4);
constexpr size_t WS_RGC   = al256(WS_RGB + (size_t)8 * 36 * 2 * 384 * 4);
constexpr size_t WS_SLOC  = al256(WS_RGC + (size_t)8 * 36 * 2 * 384 * 4);
constexpr size_t WS_SIN   = al256(WS_SLOC + (size_t)16 * 576 * 256 * 4);
constexpr size_t WS_GS    = al256(WS_SIN + (size_t)16 * 576 * 256 * 2);
constexpr size_t WS_MRG   = al256(WS_GS + (size_t)TT * 256 * 2);
constexpr size_t WS_ELIST = al256(WS_MRG + (size_t)TT * 1024 * 2);
constexpr size_t WS_GLIST = al256(WS_ELIST + (size_t)NE * TT * 4);
constexpr size_t WS_TINFO = al256(WS_GLIST + (size_t)NE * TT * 4);
constexpr size_t WS_ACT   = al256(WS_TINFO + (size_t)TT * 4 * 4);
constexpr size_t WS_YPAD  = al256(WS_ACT + (size_t)PMAX * 1024 * 2);
constexpr size_t WS_BIN2  = al256(WS_YPAD + (size_t)PMAX * 1024 * 2);
constexpr size_t WS_HLO   = al256(WS_BIN2 + (size_t)DEPTH * NP * 4);
constexpr size_t WS_WGT   = al256(WS_HLO + (size_t)TT * 1024 * 2);
constexpr size_t WS_RWH   = al256(WS_WGT + (size_t)DEPTH * 16 * 1024 * 2);
constexpr size_t WS_RWL   = al256(WS_RWH + (size_t)DEPTH * 32 * 1024 * 2);
constexpr size_t WS_H8    = al256(WS_RWL + (size_t)DEPTH * 32 * 1024 * 2);
constexpr size_t WS_TGATE = al256(WS_H8 + (size_t)TT * 1024);
constexpr size_t WS_END   = al256(WS_TGATE + (size_t)TT * 4 * 4);

struct Params { const float* in[36]; float* out; unsigned char* ws; int lo, hi; };

enum { I_X = 0, I_C, I_CTX, I_CCTX, I_ADAW, I_ADAB, I_N1W, I_WIN, I_BIN, I_RGCW, I_RGCB, I_RGWA, I_RGBA, I_RGWX, I_RGBX, I_RGLAM,
       I_S5LRE, I_S5LIM, I_S5LDT, I_S5BRE, I_S5BIM, I_S5CRE, I_S5CIM, I_S5D, I_S5GW, I_S5GB, I_MIXW, I_WOUT, I_N2W, I_RW, I_RB,
       I_WGU, I_BGU, I_WD, I_BD, I_FNW };

DEVI bf16_t f2bf(float f) { unsigned u = __float_as_uint(f); u += 0x7FFFu + ((u >> 16) & 1u); return (bf16_t)(u >> 16); }
DEVI float bf2f(bf16_t b) { return __uint_as_float(((unsigned)b) << 16); }
DEVI unsigned pk_bf16(float lo, float hi) { unsigned r; asm("v_cvt_pk_bf16_f32 %0, %1, %2" : "=v"(r) : "v"(lo), "v"(hi)); return r; }
DEVI unsigned pk4_fp8(float a, float b, float c, float d) { int p = __builtin_amdgcn_cvt_pk_fp8_f32(a, b, 0, false); p = __builtin_amdgcn_cvt_pk_fp8_f32(c, d, p, true); return (unsigned)p; }
DEVI float q8(float x) { const int p = __builtin_amdgcn_cvt_pk_fp8_f32(x, x, 0, false); return __builtin_amdgcn_cvt_f32_fp8(p, 0); }
DEVI float frcp(float x) { return __builtin_amdgcn_rcpf(x); }
DEVI float sigmoidf_(float x) { return frcp(1.0f + __expf(-x)); }
DEVI float gelu_tanh(float x) { const float u = 0.7978845608f * (x + 0.044715f * x * x * x); return x * frcp(1.0f + __expf(-2.0f * u)); }
template <int M> DEVI float shx(float v, int lane) {
    if constexpr (M < 32) return __int_as_float(__builtin_amdgcn_ds_swizzle(__float_as_int(v), 0x1F | (M << 10)));
    else return __int_as_float(__builtin_amdgcn_ds_bpermute((lane ^ 32) << 2, __float_as_int(v)));
}
DEVI float shxr(float v, int m, int lane) {
    switch (m) { case 1: return shx<1>(v, lane); case 2: return shx<2>(v, lane); case 4: return shx<4>(v, lane); case 8: return shx<8>(v, lane); case 16: return shx<16>(v, lane); default: return shx<32>(v, lane); }
}
DEVI int shxri(int v, int m, int lane) { return __float_as_int(shxr(__int_as_float(v), m, lane)); }
template <int CTRL, int ROWMASK> DEVI float dpp_(float v) { return __int_as_float(__builtin_amdgcn_update_dpp(0, __float_as_int(v), CTRL, ROWMASK, 0xF, false)); }
DEVI float wave_sum(float v, int) {
    v += dpp_<0xB1, 0xF>(v); v += dpp_<0x4E, 0xF>(v); v += dpp_<0x141, 0xF>(v); v += dpp_<0x140, 0xF>(v);
    v += dpp_<0x142, 0xA>(v); v += dpp_<0x143, 0xC>(v);
    return __int_as_float(__builtin_amdgcn_readlane(__float_as_int(v), 63));
}
DEVI float log1p_(float e) { return e < 0.06f ? e * (1.0f - e * (0.5f - e * (0.33333334f - e * 0.25f))) : __logf(1.0f + e); }
#define LDS_SYNC() do { asm volatile("s_waitcnt lgkmcnt(0)" ::: "memory"); __builtin_amdgcn_s_barrier(); asm volatile("" ::: "memory"); } while (0)
DEVI int mod_row(int row) { return row < TCTX ? 8 : (row - TCTX) / SEQ; }

#define XB_TMO      128
#define XB_XCNT(j)  (256  + 64 * (j))
#define XB_XSUB(j)  (1280 + 64 * (j))
#define XB_XGEN(j)  (2304 + 64 * (j))
#define XB_TOP      3328
#define XB_TOPGEN   3392
#define XCD_BAR_WORDS 3456
#define XB_SPIN_CAP (1u << 18)
__device__ __forceinline__ unsigned xb_ld(unsigned* p)              { return __hip_atomic_load(p, __ATOMIC_RELAXED, __HIP_MEMORY_SCOPE_AGENT); }
__device__ __forceinline__ unsigned xb_add(unsigned* p, unsigned v) { return __hip_atomic_fetch_add(p, v, __ATOMIC_RELAXED, __HIP_MEMORY_SCOPE_AGENT); }
__device__ __forceinline__ unsigned xb_xcc_id() { return (unsigned)__builtin_amdgcn_s_getreg((3 << 11) | 20) & 0xFu; }
#define XB_SPIN(cond, bar) do { unsigned _sp = 0; while (cond) { __builtin_amdgcn_s_sleep(1); \
    if ((++_sp & 255u) == 0u) { if (xb_ld(&(bar)[XB_TMO])) break; if (_sp > XB_SPIN_CAP) { atomicAdd(&(bar)[XB_TMO], 1u); break; } } } } while (0)
struct XcdBarrier { unsigned* bar; unsigned x; volatile LAS unsigned* st; };
__device__ __forceinline__ XcdBarrier xcd_barrier_post(unsigned* bar, volatile LAS unsigned* st) {
    XcdBarrier b; b.bar = bar; b.x = xb_xcc_id(); b.st = st;
    if (threadIdx.x == 0) (void)xb_add(&bar[XB_XCNT(b.x)], 1u);
    return b;
}
__device__ __forceinline__ void xcd_barrier_complete(unsigned* bar, unsigned x, unsigned& nloc, unsigned& nx) {
    const unsigned G = gridDim.x * gridDim.y * gridDim.z;
    unsigned sum, cnt, mine, sp = 0u;
    for (;;) {
        sum = 0u; cnt = 0u; mine = 0u;
#pragma unroll
        for (unsigned j = 0; j < 16; ++j) { const unsigned c = xb_ld(&bar[XB_XCNT(j)]); sum += c; cnt += (c > 0u) ? 1u : 0u; mine = (j == x) ? c : mine; }
        if (sum == G) break;
        __builtin_amdgcn_s_sleep(1);
        if ((++sp & 255u) == 0u) { if (xb_ld(&bar[XB_TMO])) break; if (sp > XB_SPIN_CAP) { atomicAdd(&bar[XB_TMO], 1u); break; } }
    }
    nloc = mine > 0u ? mine : 1u; nx = cnt > 0u ? cnt : 1u;
}
__device__ __forceinline__ void xcd_barrier(const XcdBarrier& b) {
    asm volatile("s_waitcnt vmcnt(0)" ::: "memory");
    __syncthreads();
    if (threadIdx.x == 0) {
        unsigned* bar = b.bar;
        __builtin_amdgcn_s_waitcnt(0);
        unsigned nloc = b.st[0], nx = b.st[1];
        if (nloc == 0u) { xcd_barrier_complete(bar, b.x, nloc, nx); b.st[0] = nloc; b.st[1] = nx; }
        const unsigned old = xb_add(&bar[XB_XSUB(b.x)], 1u);
        const unsigned gen = old / nloc;
        if (old + 1u == (gen + 1u) * nloc) {
            __builtin_amdgcn_fence(__ATOMIC_RELEASE, "agent");
            asm volatile("s_waitcnt vmcnt(0)" ::: "memory");
            const unsigned og = xb_add(&bar[XB_TOP], 1u);
            const unsigned tg = og / nx;
            if (og + 1u == (tg + 1u) * nx) xb_add(&bar[XB_TOPGEN], 1u);
            else XB_SPIN(xb_ld(&bar[XB_TOPGEN]) == tg, bar);
            __builtin_amdgcn_fence(__ATOMIC_ACQUIRE, "agent");
            xb_add(&bar[XB_XGEN(b.x)], 1u);
            asm volatile("s_waitcnt vmcnt(0)" ::: "memory");
        } else {
            XB_SPIN(xb_ld(&bar[XB_XGEN(b.x)]) == gen, bar);
            __builtin_amdgcn_fence(__ATOMIC_ACQUIRE, "agent");
            asm volatile("s_waitcnt vmcnt(0)" ::: "memory");
        }
    }
    __syncthreads();
}

namespace g1 {
constexpr int BM = 256, BK = 64, HALF = 128, HTB = HALF * BK * 2, STAGE_BYTES = 8 * HTB, K = 1024, NT = K / BK;
DEVI int lds_byte(int r, int c) { const int st = (r >> 4) * 2 + (c >> 5), rr = r & 15, cc = c & 31, ob = rr * 64 + cc * 2; return st * 1024 + (ob ^ (((ob >> 9) & 1) << 5)); }
DEVI void stage_rc(int b, int& R, int& C) { const int st = b / 1024, sb = b % 1024, swz = sb ^ (((sb >> 9) & 1) << 5); R = (st >> 1) * 16 + swz / 64; C = (st & 1) * 32 + (swz % 64) / 2; }
DEVI int perm32(int rho) { const int n = rho >> 4, i = rho & 15; return 8 * (i >> 2) + 4 * n + (i & 3); }

struct Unit {
    const char* A;
    const int* list;
    int nvalid;
    const char* B;
    int pm, pn, e;
};

template <bool F8> struct FragT { typedef bf16x8 T; static constexpr int NK = 2; };
template <> struct FragT<true> { typedef i32x8 T; static constexpr int NK = 1; };
template <bool GATHER, int KB>
DEVI void a_offsets(const Unit& u, int tid, unsigned (&v)[2][2]) {
    int tz = tid; asm volatile("" : "+v"(tz));
#pragma unroll
    for (int i = 0; i < 2; ++i) {
        int R, C; stage_rc(tz * 16 + i * 8192, R, C);
#pragma unroll
        for (int h = 0; h < 2; ++h) {
            const int r = h * HALF + R;
            int src = r;
            if (GATHER) { const int nv = u.nvalid > 256 ? 256 : u.nvalid; const int ld_ = u.list[r < nv ? r : nv - 1]; src = (r < nv) ? ld_ : 0; }
            v[h][i] = (unsigned)src * (unsigned)KB + (unsigned)(C * 2);
        }
    }
}
DEVI void a_request(const Unit& u, int tid, int (&raw)[2][2]) {
    int tz = tid; asm volatile("" : "+v"(tz));
    const int nv = u.nvalid > 256 ? 256 : u.nvalid;
#pragma unroll
    for (int i = 0; i < 2; ++i) { int R, C; stage_rc(tz * 16 + i * 8192, R, C);
#pragma unroll
        for (int h = 0; h < 2; ++h) { const int r = h * HALF + R; raw[h][i] = u.list[r < nv ? r : nv - 1]; } }
}
template <int KB>
DEVI void a_finish(int nvalid, int tid, int (&raw)[2][2], unsigned (&v)[2][2]) {
    asm volatile("" : "+v"(raw[0][0]), "+v"(raw[0][1]), "+v"(raw[1][0]), "+v"(raw[1][1]));
    int tz = tid; asm volatile("" : "+v"(tz));
    const int nv = nvalid > 256 ? 256 : nvalid;
#pragma unroll
    for (int i = 0; i < 2; ++i) { int R, C; stage_rc(tz * 16 + i * 8192, R, C);
#pragma unroll
        for (int h = 0; h < 2; ++h) { const int r = h * HALF + R; const int src = (r < nv) ? raw[h][i] : 0; v[h][i] = (unsigned)src * (unsigned)KB + (unsigned)(C * 2); } }
}

template <class Sched, class Epi, bool GATHER, bool FP8 = false>
DEVI void gemm_phase(LAS unsigned char* lds, const int tid, const Sched& S, const Epi& E) {
    constexpr int KB = FP8 ? 1024 : 2048, NTK = KB / 128, NK = FragT<FP8>::NK;
    typedef typename FragT<FP8>::T frag_t;
    int sc1 = 0x7F7F7F7F; asm volatile("" : "+v"(sc1));
    const int wid = __builtin_amdgcn_readfirstlane(tid >> 6), lane = tid & 63, wr = wid >> 2, wc = wid & 3, fr = lane & 15, fq = lane >> 4;
    unsigned voffB[2];
#pragma unroll
    for (int i = 0; i < 2; ++i) { int R, C; stage_rc(tid * 16 + i * 8192, R, C); const int Rb = Epi::PERM ? ((R & ~31) + perm32(R & 31)) : R; voffB[i] = (unsigned)(Rb * KB + C * 2); }
    constexpr size_t kstep = (size_t)(BK * 2);
    constexpr size_t hstep = (size_t)HALF * KB;
    const unsigned ldsw = (unsigned)wid * 1024u;
    const int aoff = FP8 ? lds_byte(wr * 64 + fr, fq * 16) : lds_byte(wr * 64 + fr, fq * 8), boff = FP8 ? lds_byte(wc * 32 + fr, fq * 16) : lds_byte(wc * 32 + fr, fq * 8);
    const int sw16 = FP8 ? 16 * (fq & 1) : 0;
    unsigned pa_ = (unsigned)(size_t)(lds + aoff) + sw16, pb_ = (unsigned)(size_t)(lds + 65536 + boff) + sw16, pa2_ = (unsigned)(size_t)(lds + aoff) + (16 - sw16), pb2_ = (unsigned)(size_t)(lds + 65536 + boff) + (16 - sw16);
    asm volatile("" : "+v"(pa_), "+v"(pb_), "+v"(pa2_), "+v"(pb2_));
    LAS unsigned char* const pa = (LAS unsigned char*)(size_t)pa_; LAS unsigned char* const pb = (LAS unsigned char*)(size_t)pb_;
    LAS unsigned char* const pa2 = (LAS unsigned char*)(size_t)pa2_; LAS unsigned char* const pb2 = (LAS unsigned char*)(size_t)pb2_;
#define G1_SA(b, h) (((b) * 2 + (h)) * HTB)
#define G1_SB(b, h) ((4 + (b) * 2 + (h)) * HTB)
#define G1_STAGE2(bufoff, gbase, v0, v1) do { \
        __builtin_amdgcn_global_load_lds((const unsigned*)((const char*)(gbase) + (v0)), (LAS unsigned*)(lds + (bufoff) + ldsw), 16, 0, 0); \
        __builtin_amdgcn_global_load_lds((const unsigned*)((const char*)(gbase) + (v1)), (LAS unsigned*)(lds + (bufoff) + ldsw + 8192), 16, 0, 0); } while (0)
#define G1_LDFRAG(dst, ptr, ptr2) do { if constexpr (FP8) { const i32x4 lo_ = *(const LAS i32x4*)(ptr), hi_ = *(const LAS i32x4*)(ptr2); dst = __builtin_shufflevector(lo_, hi_, 0, 1, 2, 3, 4, 5, 6, 7); } \
        else { dst = *(const LAS frag_t*)(ptr); } } while (0)
#define G1_LDA(dst, b, h) do { _Pragma("unroll") for (int m = 0; m < 4; ++m) _Pragma("unroll") for (int k = 0; k < NK; ++k) G1_LDFRAG(dst[m][k], pa + (G1_SA(b, h) + m * 2048 + k * 1024), pa2 + (G1_SA(b, h) + m * 2048 + k * 1024)); } while (0)
#define G1_LDB(dst, b, h) do { _Pragma("unroll") for (int n = 0; n < 2; ++n) _Pragma("unroll") for (int k = 0; k < NK; ++k) G1_LDFRAG(dst[n][k], pb + (G1_SB(b, h) - 65536 + n * 2048 + k * 1024), pb2 + (G1_SB(b, h) - 65536 + n * 2048 + k * 1024)); } while (0)
#define G1_MFMA(c_, b_, a_) do { if constexpr (FP8) asm volatile("v_mfma_scale_f32_16x16x128_f8f6f4 %0, %1, %2, %0, %3, %3 op_sel_hi:[0,0,0]" : "+v"(c_) : "v"(b_), "v"(a_), "v"(sc1)); \
        else c_ = __builtin_amdgcn_mfma_f32_16x16x32_bf16(b_, a_, c_, 0, 0, 0); } while (0)
#define G1_MMA(ai, bj, At, Bt) do { __builtin_amdgcn_s_setprio(1); _Pragma("unroll") for (int m = 0; m < 4; ++m) _Pragma("unroll") for (int n = 0; n < 2; ++n) _Pragma("unroll") for (int k = 0; k < NK; ++k) \
        G1_MFMA(acc[ai][bj][m][n], Bt[n][k], At[m][k]); __builtin_amdgcn_s_setprio(0); } while (0)
#define G1_WAIT_V(n) asm volatile("s_waitcnt vmcnt(" #n ")" ::: "memory")
#define G1_WAIT_L(n) asm volatile("s_waitcnt lgkmcnt(" #n ")" ::: "memory")
#define G1_BAR __builtin_amdgcn_s_barrier()
#define G1_SCHED __builtin_amdgcn_sched_barrier(0)
    Unit cur, nxt; int ui = 0;
    if (!S.get(0, cur)) return;
    f32x4 acc[2][2][4][2];
#pragma unroll
    for (int a = 0; a < 2; ++a)
#pragma unroll
        for (int b = 0; b < 2; ++b)
#pragma unroll
            for (int m = 0; m < 4; ++m)
#pragma unroll
                for (int n = 0; n < 2; ++n) acc[a][b][m][n] = (f32x4){0.f, 0.f, 0.f, 0.f};
    frag_t At[4][NK], B0[2][NK], B1[2][NK];
    unsigned vc[2][2], vn[2][2];
    a_offsets<GATHER, KB>(cur, tid, vc);
    const char* cA = cur.A; const char* cB = cur.B;
    G1_STAGE2(G1_SB(0, 0), cB, voffB[0], voffB[1]); G1_STAGE2(G1_SA(0, 0), cA, vc[0][0], vc[0][1]);
    G1_STAGE2(G1_SB(0, 1), cB + hstep, voffB[0], voffB[1]); G1_STAGE2(G1_SA(0, 1), cA, vc[1][0], vc[1][1]);
    if (wr == 1) G1_BAR;
    G1_WAIT_V(4); G1_BAR;
    G1_STAGE2(G1_SB(1, 0), cB + kstep, voffB[0], voffB[1]); G1_STAGE2(G1_SA(1, 0), cA + kstep, vc[0][0], vc[0][1]);
    G1_STAGE2(G1_SB(1, 1), cB + hstep + kstep, voffB[0], voffB[1]);
    G1_WAIT_V(6); G1_BAR;
    for (;;) {
        const bool has_next = S.get(ui + 1, nxt);
        int raw[2][2] = {{0, 0}, {0, 0}};
        if (has_next) { if constexpr (GATHER) a_request(nxt, tid, raw); else a_offsets<GATHER, KB>(nxt, tid, vn); }
        else {
#pragma unroll
            for (int h = 0; h < 2; ++h)
#pragma unroll
                for (int i = 0; i < 2; ++i) vn[h][i] = vc[h][i];
        }
        const char* nA = has_next ? nxt.A : cA; const char* nB = has_next ? nxt.B : cB;
#pragma unroll 1
        for (int t = 0; t < NTK; t += 2) {
            const bool last = (t == NTK - 2);
            const char* a1 = cA + (size_t)(t + 1) * kstep;
            const char* a2 = last ? nA : cA + (size_t)(t + 2) * kstep; const char* b2 = last ? nB : cB + (size_t)(t + 2) * kstep;
            const char* a3 = a2 + kstep; const char* b3 = b2 + kstep;
            unsigned w00 = vc[0][0], w01 = vc[0][1], w10 = vc[1][0], w11 = vc[1][1];
            if (last) { if constexpr (GATHER) { if (has_next) a_finish<KB>(nxt.nvalid, tid, raw, vn); }
                w00 = vn[0][0]; w01 = vn[0][1]; w10 = vn[1][0]; w11 = vn[1][1]; asm volatile("" : "+v"(w00), "+v"(w01), "+v"(w10), "+v"(w11)); }
            G1_LDB(B0, 0, 0); G1_SCHED; G1_LDA(At, 0, 0); G1_STAGE2(G1_SA(1, 1), a1, vc[1][0], vc[1][1]);
            G1_WAIT_L(8); G1_BAR; G1_WAIT_L(0); G1_MMA(0, 0, At, B0); G1_BAR; G1_SCHED;
            G1_LDB(B1, 0, 1); G1_STAGE2(G1_SB(0, 0), b2, voffB[0], voffB[1]);
            G1_BAR; G1_WAIT_L(0); G1_MMA(0, 1, At, B1); G1_BAR;
            G1_LDA(At, 0, 1); G1_STAGE2(G1_SA(0, 0), a2, w00, w01);
            G1_BAR; G1_WAIT_L(0); G1_MMA(1, 0, At, B0); G1_BAR; G1_SCHED;
            G1_STAGE2(G1_SB(0, 1), b2 + hstep, voffB[0], voffB[1]);
            G1_WAIT_V(6); G1_BAR; G1_MMA(1, 1, At, B1); G1_BAR;
            G1_LDB(B0, 1, 0); G1_SCHED; G1_LDA(At, 1, 0); G1_STAGE2(G1_SA(0, 1), a2, w10, w11);
            G1_WAIT_L(8); G1_BAR; G1_WAIT_L(0); G1_MMA(0, 0, At, B0); G1_BAR; G1_SCHED;
            G1_LDB(B1, 1, 1); G1_STAGE2(G1_SB(1, 0), b3, voffB[0], voffB[1]);
            G1_BAR; G1_WAIT_L(0); G1_MMA(0, 1, At, B1); G1_BAR;
            G1_LDA(At, 1, 1); G1_STAGE2(G1_SA(1, 0), a3, w00, w01);
            G1_BAR; G1_WAIT_L(0); G1_MMA(1, 0, At, B0); G1_BAR; G1_SCHED;
            G1_STAGE2(G1_SB(1, 1), b3 + hstep, voffB[0], voffB[1]);
            G1_WAIT_V(6); G1_BAR; G1_MMA(1, 1, At, B1); G1_BAR;
        }
        if constexpr (FP8) asm volatile("s_nop 15\n\ts_nop 15" ::: "memory");
        E(acc, cur, wr, wc, fr, fq);
        if (!has_next) break;
#pragma unroll
        for (int a = 0; a < 2; ++a)
#pragma unroll
            for (int b = 0; b < 2; ++b)
#pragma unroll
                for (int m = 0; m < 4; ++m)
#pragma unroll
                    for (int n = 0; n < 2; ++n) acc[a][b][m][n] = (f32x4){0.f, 0.f, 0.f, 0.f};
        cur = nxt; cA = nA; cB = nB; ++ui;
#pragma unroll
        for (int h = 0; h < 2; ++h)
#pragma unroll
            for (int i = 0; i < 2; ++i) vc[h][i] = vn[h][i];
    }
    G1_WAIT_V(0);
    if (wr == 0) G1_BAR;
    G1_BAR;
}
}

template <int MT, int NT_, class AF, class BF>
DEVI void wave_gemm(const int lane, int Kdim, const AF& af, const BF& bf, f32x4 (&acc)[MT][NT_]) {
    const int fr = lane & 15, fq = lane >> 4;
#pragma unroll
    for (int m = 0; m < MT; ++m)
#pragma unroll
        for (int n = 0; n < NT_; ++n) acc[m][n] = (f32x4){0.f, 0.f, 0.f, 0.f};
    bf16x8 fa[4][MT], fb[4][NT_];
#define WG_LOAD(S, KK) do { _Pragma("unroll") for (int m = 0; m < MT; ++m) fa[S][m] = af(m * 16 + fr, (KK) + fq * 8); _Pragma("unroll") for (int n = 0; n < NT_; ++n) fb[S][n] = bf(n * 16 + fr, (KK) + fq * 8); } while (0)
#define WG_MMA(S) do { _Pragma("unroll") for (int m = 0; m < MT; ++m) _Pragma("unroll") for (int n = 0; n < NT_; ++n) acc[m][n] = __builtin_amdgcn_mfma_f32_16x16x32_bf16(fb[S][n], fa[S][m], acc[m][n], 0, 0, 0); } while (0)
    WG_LOAD(0, 0); WG_LOAD(1, 32); WG_LOAD(2, 64);
#pragma unroll 1
    for (int k0 = 0; k0 < Kdim; k0 += 128) {
        const bool more = k0 + 128 < Kdim;
        WG_LOAD(3, k0 + 96); WG_MMA(0);
        if (more) WG_LOAD(0, k0 + 128);
        WG_MMA(1);
        if (more) WG_LOAD(1, k0 + 160);
        WG_MMA(2);
        if (more) WG_LOAD(2, k0 + 192);
        WG_MMA(3);
    }
#undef WG_LOAD
#undef WG_MMA
}
DEVI bf16x8 ldg8(const bf16_t* p) { return *(const bf16x8*)p; }

template <int N> struct Log2 { static constexpr int v = 1 + Log2<N / 2>::v; };
template <> struct Log2<1> { static constexpr int v = 0; };
template <int N>
DEVI float reduce_scatter(const int lane, float (&v)[N]) {
    constexpr int LG = Log2<N>::v;
#pragma unroll
    for (int st = 0; st < LG; ++st) {
        const int s = (N / 2) >> st, mask = 32 >> st;
        const bool up = (lane & mask) != 0;
#pragma unroll
        for (int i = 0; i < N / 2; ++i) if (i < s) {
            const float send = up ? v[i] : v[i + s];
            const float keep = up ? v[i + s] : v[i];
            v[i] = keep + shxr(send, mask, lane);
        }
    }
    float r = v[0];
#pragma unroll
    for (int st = LG; st < 6; ++st) r += shxr(r, 32 >> st, lane);
    return r;
}
template <int N>
DEVI int rs_index(int lane) {
    constexpr int LG = Log2<N>::v;
    int idx = 0;
#pragma unroll
    for (int st = 0; st < LG; ++st) if (lane & (32 >> st)) idx += (N / 2) >> st;
    return idx;
}

struct Ctx {
    const Params* p; unsigned char* ws; LAS unsigned char* lds; int tid, lane, wave, G, bid;
};
#define WSP(T, off) ((T*)(cx.ws + (off)))
DEVI Ctx relaunder(const Ctx& c) { Ctx r = c; int ln, td;
    asm volatile("v_mbcnt_lo_u32_b32 %0, -1, 0\n\tv_mbcnt_hi_u32_b32 %0, -1, %0\n\tv_lshl_add_u32 %1, %2, 6, %0" : "=&v"(ln), "=v"(td) : "s"(c.wave));
    r.lane = ln; r.tid = td; return r; }

DEVI void cvt_tile(const Ctx& cx, const float* src, int ld, bf16_t* dst, int n0, int k0, int kind) {
    LAS bf16_t* tile = (LAS bf16_t*)cx.lds;
    const int n4 = (cx.tid & 63) * 4, w8 = (cx.tid >> 6) * 8, n = n0 + n4;
    int sc; float scale = 1.0f;
    if (kind == 0) { sc = n < 1536 ? n : n + 16; if (n >= 384 && n < 768) scale = 0.10206207261596577f; }
    else if (kind == 2) { const int pn = n >> 8, w = n & 255; sc = w < 128 ? pn * 128 + w : 1024 + pn * 128 + (w - 128); }
    else sc = n;
#pragma unroll 1
    for (int sub = 0; sub < 4; sub += 2) {
        f32x4 v[2][8];
#pragma unroll
        for (int s2 = 0; s2 < 2; ++s2)
#pragma unroll
            for (int p = 0; p < 8; ++p) v[s2][p] = __builtin_nontemporal_load((const f32x4*)(src + (size_t)(k0 + (sub + s2) * 64 + w8 + p) * ld + sc));
#pragma unroll
        for (int s2 = 0; s2 < 2; ++s2)
#pragma unroll
            for (int j = 0; j < 4; ++j) { u32x4 w;
                w.x = pk_bf16(v[s2][0][j] * scale, v[s2][1][j] * scale); w.y = pk_bf16(v[s2][2][j] * scale, v[s2][3][j] * scale);
                w.z = pk_bf16(v[s2][4][j] * scale, v[s2][5][j] * scale); w.w = pk_bf16(v[s2][6][j] * scale, v[s2][7][j] * scale);
                *(LAS u32x4*)(tile + (n4 + j) * 264 + (sub + s2) * 64 + w8) = w; }
    }
    LDS_SYNC();
#pragma unroll
    for (int i = 0; i < 16; ++i) { const int idx = cx.tid + NTHR * i, row = idx >> 5, ch = idx & 31;
        const u32x4 o = *(const LAS u32x4*)(tile + row * 264 + ch * 8);
        *(u32x4*)(dst + (size_t)(n0 + row) * 1024 + k0 + ch * 8) = o; }
    LDS_SYNC();
}

DEVI void cvt_tile8(const Ctx& cx, const float* src, int ld, unsigned char* dst, int n0, int k0, int kind) {
    LAS unsigned char* tile = cx.lds;
    const int n4 = (cx.tid & 63) * 4, w8 = (cx.tid >> 6) * 8, n = n0 + n4;
    int sc;
    if (kind == 2) { const int pn = n >> 8, w = n & 255; sc = w < 128 ? pn * 128 + w : 1024 + pn * 128 + (w - 128); }
    else sc = n;
#pragma unroll 1
    for (int sub = 0; sub < 4; sub += 2) {
        f32x4 v[2][8];
#pragma unroll
        for (int s2 = 0; s2 < 2; ++s2)
#pragma unroll
            for (int p = 0; p < 8; ++p) v[s2][p] = __builtin_nontemporal_load((const f32x4*)(src + (size_t)(k0 + (sub + s2) * 64 + w8 + p) * ld + sc));
#pragma unroll
        for (int s2 = 0; s2 < 2; ++s2)
#pragma unroll
            for (int j = 0; j < 4; ++j) { u32x2 w;
                w.x = pk4_fp8(v[s2][0][j] * W8_SCALE, v[s2][1][j] * W8_SCALE, v[s2][2][j] * W8_SCALE, v[s2][3][j] * W8_SCALE);
                w.y = pk4_fp8(v[s2][4][j] * W8_SCALE, v[s2][5][j] * W8_SCALE, v[s2][6][j] * W8_SCALE, v[s2][7][j] * W8_SCALE);
                *(LAS u32x2*)(tile + (n4 + j) * 272 + (sub + s2) * 64 + w8) = w; }
    }
    LDS_SYNC();
#pragma unroll
    for (int i = 0; i < 8; ++i) { const int idx = cx.tid + NTHR * i, row = idx >> 4, ch = idx & 15;
        const u32x4 o = *(const LAS u32x4*)(tile + row * 272 + ch * 16);
        *(u32x4*)(dst + (size_t)(n0 + row) * 1024 + k0 + ch * 16) = o; }
    LDS_SYNC();
}
DEVI void ph_pro_a(const Ctx& cx) {
    const Params& P = *cx.p;
    {
        constexpr int n_in = DEPTH * 10 * 4, n_out = DEPTH * 4 * 4, n_gu = DEPTH * NE * 8 * 4, n_dn = DEPTH * NE * 4 * 4;
        constexpr int total = n_in + n_out + n_gu + n_dn;
        for (int job = cx.bid; job < total; job += cx.G) {
            int j = job;
            if (j < n_in) { const int l = j / 40, r = j % 40, kt = r / 10, nt = r % 10;
                cvt_tile(cx, P.in[I_WIN] + (size_t)l * 1024 * DIN, DIN, WSP(bf16_t, WS_WIN) + (size_t)l * NP * 1024, nt * 256, kt * 256, 0); continue; }
            j -= n_in;
            if (j < n_out) { const int l = j / 16, r = j % 16, kt = r / 4, nt = r % 4;
                cvt_tile(cx, P.in[I_WOUT] + (size_t)l * 1024 * 1024, 1024, WSP(bf16_t, WS_WOUT) + (size_t)l * 1024 * 1024, nt * 256, kt * 256, 1); continue; }
            j -= n_out;
            if (j < n_gu) { const int le = j / 32, r = j % 32, kt = r / 8, nt = r % 8;
                cvt_tile8(cx, P.in[I_WGU] + (size_t)le * 1024 * 2048, 2048, WSP(unsigned char, WS_WGU) + (size_t)le * 2048 * 1024, nt * 256, kt * 256, 2); continue; }
            j -= n_gu;
            { const int le = j / 16, r = j % 16, kt = r / 4, nt = r % 4;
                cvt_tile8(cx, P.in[I_WD] + (size_t)le * 1024 * 1024, 1024, WSP(unsigned char, WS_WD) + (size_t)le * 1024 * 1024, nt * 256, kt * 256, 1); }
        }
    }
    __syncthreads();
    {
        LAS float* sv = (LAS float*)cx.lds;
        LAS float* red = sv + 9 * 1024;
        constexpr int units = DEPTH * 6144 / 64;
        if (cx.bid < units) {
            for (int i = cx.tid; i < 9 * 1024; i += NTHR) { const int r = i >> 10, k = i & 1023; const float c = r < 8 ? P.in[I_C][r * 1024 + k] : P.in[I_CCTX][k]; sv[i] = c / (1.0f + __expf(-c)); }
            __syncthreads();
            for (int u = cx.bid; u < units; u += cx.G) {
                const int l = u / 96, n = (u % 96) * 64 + cx.lane;
                const float* w = P.in[I_ADAW] + (size_t)l * 1024 * 6144 + n;
                float acc[9];
#pragma unroll
                for (int r = 0; r < 9; ++r) acc[r] = 0.f;
                const int kb = cx.wave * 128;
#pragma unroll 4
                for (int k = 0; k < 128; ++k) { const float wv = w[(size_t)(kb + k) * 6144];
#pragma unroll
                    for (int r = 0; r < 9; ++r) acc[r] += sv[r * 1024 + kb + k] * wv; }
#pragma unroll
                for (int r = 0; r < 9; ++r) red[(cx.wave * 9 + r) * 64 + cx.lane] = acc[r];
                __syncthreads();
                for (int i = cx.tid; i < 9 * 64; i += NTHR) { const int r = i >> 6, ln = i & 63; float s = 0.f;
#pragma unroll
                    for (int w8 = 0; w8 < 8; ++w8) s += red[(w8 * 9 + r) * 64 + ln];
                    const int nn = (u % 96) * 64 + ln;
                    WSP(float, WS_MOD)[((size_t)l * 9 + r) * 6144 + nn] = s + P.in[I_ADAB][l * 6144 + nn]; }
                __syncthreads();
            }
        }
    }
    for (int gt = cx.bid * NTHR + cx.tid; gt < DEPTH * 16 * 2 * 64; gt += cx.G * NTHR) {
        const int n = gt & 63, d = (gt >> 6) & 1, g = (gt >> 7) & 15, l = gt >> 11;
        const float dt = expf(P.in[I_S5LDT][(l * 2 + d) * 16 + g]);
        const float lr = P.in[I_S5LRE][((l * 2 + d) * 16 + g) * 64 + n], li = P.in[I_S5LIM][((l * 2 + d) * 16 + g) * 64 + n];
        f32x2* pw = WSP(f32x2, WS_PW) + (size_t)gt * 33;
        float ar = 0.f, ai = 0.f;
        for (int k = 0; k <= 32; ++k) { const float mag = expf(lr * dt * (float)k); float s, c; sincosf(li * dt * (float)k, &s, &c); pw[k] = (f32x2){mag * c, mag * s}; if (k == 1) { ar = mag * c; ai = mag * s; } }
        const float den = lr * lr + li * li;
        const float cr = ((ar - 1.0f) * lr + ai * li) / den, ci = (ai * lr - (ar - 1.0f) * li) / den;
        f32x2* bb = WSP(f32x2, WS_BB) + (size_t)gt * 16;
        for (int q = 0; q < 16; ++q) { const float br = P.in[I_S5BRE][((l * 16 + g) * 64 + n) * 16 + q], bi = P.in[I_S5BIM][((l * 16 + g) * 64 + n) * 16 + q];
            bb[q] = (f32x2){cr * br - ci * bi, cr * bi + ci * br}; }
    }
    for (int i = cx.bid * NTHR + cx.tid; i < DEPTH * 6 * 256 * 64; i += cx.G * NTHR) {
        const int k = i & 63, n = (i >> 6) & 255, g = (i >> 14) % 6, l = (i >> 14) / 6;
        const int j = n & 63, type = (n >> 6) & 1, dir = n >> 7;
        const float* w = type ? P.in[I_RGWX] : P.in[I_RGWA];
        WSP(bf16_t, WS_WRG)[i] = f2bf(w[((((size_t)l * 2 + dir) * 6 + g) * 64 + k) * 64 + j]);
    }
    for (int i = cx.bid * NTHR + cx.tid; i < DEPTH * NP; i += cx.G * NTHR) {
        const int n = i % NP, l = i / NP; const int sc = n < 1536 ? n : n + 16;
        WSP(float, WS_BIN2)[i] = P.in[I_BIN][l * DIN + sc] * ((n >= 384 && n < 768) ? 0.10206207261596577f : 1.0f);
    }
    for (int i = cx.bid * NTHR + cx.tid; i < DEPTH * 16 * 1024; i += cx.G * NTHR) { const int k = i & 1023, n = (i >> 10) & 15, l = i >> 14;
        WSP(bf16_t, WS_WGT)[i] = f2bf(P.in[I_WIN][((size_t)l * 1024 + k) * DIN + 1536 + n]); }
    for (int i = cx.bid * NTHR + cx.tid; i < DEPTH * 32 * 1024; i += cx.G * NTHR) { const int k = i & 1023, n = (i >> 10) & 31, l = i >> 15;
        const float w = P.in[I_RW][((size_t)l * 1024 + k) * 32 + n]; const bf16_t hi = f2bf(w);
        WSP(bf16_t, WS_RWH)[i] = hi; WSP(bf16_t, WS_RWL)[i] = f2bf(w - bf2f(hi)); }
    for (int i = cx.bid * NTHR + cx.tid; i < DEPTH * 256 * 256; i += cx.G * NTHR) {
        const int k = i & 255, n = (i >> 8) & 255, l = i >> 16;
        WSP(bf16_t, WS_WGLU)[i] = f2bf(P.in[I_S5GW][((size_t)l * 256 + k) * 256 + n]);
    }
}

DEVI void ph_pro_b(const Ctx& cx) {
    const Params& P = *cx.p;
    LAS f32x2* pw = (LAS f32x2*)cx.lds;
    LAS f32x2* bb = pw + 64 * 33;
    LAS f32x2* cc = bb + 64 * 16;
    for (int u = cx.bid; u < DEPTH * 16 * 2; u += cx.G) {
        const int lg = u >> 1;
        for (int i = cx.tid; i < 64 * 33; i += NTHR) pw[i] = WSP(f32x2, WS_PW)[(size_t)u * 64 * 33 + i];
        for (int i = cx.tid; i < 64 * 16; i += NTHR) bb[i] = WSP(f32x2, WS_BB)[(size_t)u * 64 * 16 + i];
        for (int i = cx.tid; i < 16 * 64; i += NTHR) cc[i] = (f32x2){P.in[I_S5CRE][(size_t)lg * 1024 + i], P.in[I_S5CIM][(size_t)lg * 1024 + i]};
        __syncthreads();
        const int q = cx.tid & 15, p = (cx.tid >> 4) & 15, tau0 = cx.tid >> 8;
        float acc[16];
#pragma unroll
        for (int i = 0; i < 16; ++i) acc[i] = 0.f;
#pragma unroll 2
        for (int n = 0; n < 64; ++n) { const f32x2 b = bb[n * 16 + q], c = cc[p * 64 + n];
#pragma unroll
            for (int i = 0; i < 16; ++i) { const f32x2 a = pw[n * 33 + tau0 + 2 * i]; const float xr = c.x * a.x - c.y * a.y, xi = c.x * a.y + c.y * a.x; acc[i] += xr * b.x - xi * b.y; } }
#pragma unroll
        for (int i = 0; i < 16; ++i) WSP(float, WS_KT)[(((size_t)u * 32 + tau0 + 2 * i) * 16 + p) * 16 + q] = acc[i];
        __syncthreads();
    }
}

DEVI void ph_pro_c(const Ctx& cx) {
    const Params& P = *cx.p;
    LAS float* kt = (LAS float*)cx.lds;
    LAS f32x2* pw = (LAS f32x2*)(kt + 2 * 32 * 256);
    LAS f32x2* bb = pw + 2 * 64 * 33;
    LAS f32x2* cc = bb + 2 * 64 * 16;
    LAS float* dsk = (LAS float*)(cc + 16 * 64);
    for (int u = cx.bid; u < DEPTH * 16 * 4; u += cx.G) {
        const int lg = u >> 2, qt = u & 3, l = lg >> 4, g = lg & 15;
        for (int i = cx.tid; i < 2 * 32 * 256; i += NTHR) kt[i] = WSP(float, WS_KT)[(size_t)lg * 2 * 32 * 256 + i];
        for (int i = cx.tid; i < 2 * 64 * 33; i += NTHR) pw[i] = WSP(f32x2, WS_PW)[(size_t)lg * 2 * 64 * 33 + i];
        for (int i = cx.tid; i < 2 * 64 * 16; i += NTHR) bb[i] = WSP(f32x2, WS_BB)[(size_t)lg * 2 * 64 * 16 + i];
        for (int i = cx.tid; i < 16 * 64; i += NTHR) cc[i] = (f32x2){P.in[I_S5CRE][(size_t)lg * 1024 + i], P.in[I_S5CIM][(size_t)lg * 1024 + i]};
        if (cx.tid < 16) dsk[cx.tid] = P.in[I_S5D][l * 256 + g * 16 + cx.tid];
        __syncthreads();
        bf16_t* wy = WSP(bf16_t, WS_WY) + ((size_t)lg * 512 + qt * 128) * 768;
        for (int idx = cx.tid; idx < 128 * 768; idx += NTHR) {
            const int k = idx % 768, tp = qt * 128 + idx / 768, t = tp >> 4, p = tp & 15;
            float v;
            if (k < 512) { const int sI = k >> 4, q = k & 15; v = 0.f;
                if (sI <= t) v += kt[(0 * 32 + (t - sI)) * 256 + p * 16 + q];
                if (sI >= t) v += kt[(1 * 32 + (sI - t)) * 256 + p * 16 + q];
                if (sI == t && p == q) v += dsk[p];
            } else { const int kk = k - 512, d = kk >> 7, im = (kk >> 6) & 1, n = kk & 63;
                const int pwr = d == 0 ? t + 1 : 32 - t;
                const f32x2 a = pw[(d * 64 + n) * 33 + pwr], c = cc[p * 64 + n];
                v = im ? -(c.x * a.y + c.y * a.x) : (c.x * a.x - c.y * a.y); }
            wy[idx] = f2bf(v);
        }
        bf16_t* we = WSP(bf16_t, WS_WE) + ((size_t)lg * 256 + qt * 64) * 512;
        for (int idx = cx.tid; idx < 64 * 512; idx += NTHR) {
            const int k = idx & 511, no = qt * 64 + (idx >> 9);
            const int sI = k >> 4, q = k & 15, d = no >> 7, im = (no >> 6) & 1, n = no & 63;
            const int pwr = d == 0 ? 31 - sI : sI;
            const f32x2 a = pw[(d * 64 + n) * 33 + pwr], b2 = bb[(d * 64 + n) * 16 + q];
            we[idx] = f2bf(im ? (a.x * b2.y + a.y * b2.x) : (a.x * b2.x - a.y * b2.y));
        }
        __syncthreads();
    }
}

DEVI void moe_info(const Ctx& cx, int l, LAS int* info) {
    if (cx.tid < 64) {
        const unsigned* cnt = (const unsigned*)(cx.ws + WS_CTL) + CW_CNT + l * 32;
        const int c = cx.lane < 32 ? (int)__hip_atomic_load(cnt + (cx.lane & 31), __ATOMIC_RELAXED, __HIP_MEMORY_SCOPE_AGENT) : 0;
        const int nt = (c + 255) >> 8;
        if (cx.lane < 32) { info[72 + cx.lane] = nt; info[40 + cx.lane] = c; }
        if (cx.lane == 0) { int run = 0; info[0] = 0; for (int e = 0; e < 32; ++e) { run += info[72 + e]; info[e + 1] = run; } }
    }
    __syncthreads();
    if (cx.tid < 32) { const int lo = info[cx.tid], hi = info[cx.tid + 1]; for (int t = lo; t < hi; ++t) info[112 + t] = cx.tid;
    }
    __syncthreads();
}

DEVI void block_rows_visible() {
    asm volatile("s_waitcnt vmcnt(0)" ::: "memory");
    __syncthreads();
}
DEVI void ph_norm1(const Ctx& cx, int l) {
    const Params& P = *cx.p;
    LAS int* info = (LAS int*)cx.lds;
    LAS float* part = (LAS float*)(cx.lds + 4096);
    if (l > 0) moe_info(cx, l - 1, info);
    const int rbeg = (l == DEPTH) ? TCTX : 0, nr = TT - rbeg;
    const int rpb = (nr + cx.G - 1) / cx.G, rb = rbeg + cx.bid * rpb, re = min(TT, rb + rpb);
    const float* modp = WSP(float, WS_MOD);
    const int c0 = 4 * cx.lane;
    for (int r2 = rb + cx.wave; r2 < re; r2 += 16) {
        f32x4 x[2][4]; bool ok[2];
#pragma unroll
        for (int u = 0; u < 2; ++u) { const int row = r2 + 8 * u; ok[u] = row < re; const int rw_ = ok[u] ? row : r2;
            if (l == 0) { const float* src = rw_ < TCTX ? P.in[I_CTX] + (size_t)rw_ * 1024 : P.in[I_X] + (size_t)(rw_ - TCTX) * 1024;
#pragma unroll
                for (int i = 0; i < 4; ++i) x[u][i] = *(const f32x4*)(src + c0 + 256 * i);
            } else {
                const float* src = WSP(float, WS_XMID) + (size_t)rw_ * 1024;
                const float* g2 = modp + ((size_t)(l - 1) * 9 + mod_row(rw_)) * 6144 + 5120;
                const int* ti = WSP(int, WS_TINFO) + (size_t)rw_ * 4;
                const f32x4 tg = *(const f32x4*)(WSP(float, WS_TGATE) + (size_t)rw_ * 4);
                f32x4 y[4];
#pragma unroll
                for (int i = 0; i < 4; ++i) y[i] = (f32x4){0.f, 0.f, 0.f, 0.f};
#pragma unroll
                for (int k = 0; k < 4; ++k) { const int t = ti[k]; const int e = t >> 20, slot = t & 0xFFFFF;
                    const unsigned char* yp = WSP(unsigned char, WS_YPAD) + ((size_t)info[e] * 256 + slot) * 1024;
#pragma unroll
                    for (int i = 0; i < 4; ++i) { const int w = *(const int*)(yp + c0 + 256 * i);
                        const float gk_ = tg[k]; y[i][0] += gk_ * __builtin_amdgcn_cvt_f32_fp8(w, 0); y[i][1] += gk_ * __builtin_amdgcn_cvt_f32_fp8(w, 1); y[i][2] += gk_ * __builtin_amdgcn_cvt_f32_fp8(w, 2); y[i][3] += gk_ * __builtin_amdgcn_cvt_f32_fp8(w, 3); } }
#pragma unroll
                for (int i = 0; i < 4; ++i) { const f32x4 xv = *(const f32x4*)(src + c0 + 256 * i), gv = *(const f32x4*)(g2 + c0 + 256 * i); x[u][i] = xv + gv * (y[i] * Y8_INV); }
            }
        }
#pragma unroll
        for (int u = 0; u < 2; ++u) {
            const int row = r2 + 8 * u;
            float ss = 0.f;
#pragma unroll
            for (int i = 0; i < 4; ++i) ss += (x[u][i][0] * x[u][i][0] + x[u][i][1] * x[u][i][1]) + (x[u][i][2] * x[u][i][2] + x[u][i][3] * x[u][i][3]);
            ss = wave_sum(ss, 0);
            const float rstd = rsqrtf(ss * (1.0f / 1024.0f) + EPS);
            if (!ok[u]) continue;
            if (l == DEPTH) { float* o = P.out + (size_t)(row - TCTX) * 1024;
#pragma unroll
                for (int i = 0; i < 4; ++i) { const f32x4 fw = *(const f32x4*)(P.in[I_FNW] + c0 + 256 * i); *(f32x4*)(o + c0 + 256 * i) = x[u][i] * rstd * fw; }
                continue; }
            float* xs = WSP(float, WS_XS) + (size_t)row * 1024;
            const float* md = modp + ((size_t)l * 9 + mod_row(row)) * 6144;
            bf16_t* hp = WSP(bf16_t, WS_H) + (size_t)row * 1024;
#pragma unroll
            for (int i = 0; i < 4; ++i) { const int c = c0 + 256 * i;
                *(f32x4*)(xs + c) = x[u][i];
                const f32x4 nw = *(const f32x4*)(P.in[I_N1W] + l * 1024 + c), sc = *(const f32x4*)(md + 1024 + c), sh = *(const f32x4*)(md + c);
                const f32x4 h = x[u][i] * rstd * nw * (sc + 1.0f) + sh;
                u32x2 w; w.x = pk_bf16(h[0], h[1]); w.y = pk_bf16(h[2], h[3]); *(u32x2*)(hp + c) = w; }
        }
    }
    if (l == DEPTH) return;
    block_rows_visible();
    const int nrow = re - rb, ntile = (nrow + 15) / 16;
    for (int it = cx.wave; it < ntile * 4; it += 8) {
        const int t = it >> 2, kq = it & 3, fr = cx.lane & 15, fq = cx.lane >> 4; const int row = min(rb + t * 16 + fr, re - 1);
        const bf16_t* hp = WSP(bf16_t, WS_H) + (size_t)row * 1024 + kq * 256 + fq * 8;
        const bf16_t* wp = WSP(bf16_t, WS_WGT) + ((size_t)l * 16 + fr) * 1024 + kq * 256 + fq * 8;
        f32x4 acc = (f32x4){0.f, 0.f, 0.f, 0.f};
        bf16x8 af[8], wf[8];
#pragma unroll
        for (int k = 0; k < 8; ++k) { af[k] = ldg8(hp + 32 * k); wf[k] = ldg8(wp + 32 * k); }
        __builtin_amdgcn_sched_barrier(0);
#pragma unroll
        for (int k = 0; k < 8; ++k) acc = __builtin_amdgcn_mfma_f32_16x16x32_bf16(wf[k], af[k], acc, 0, 0, 0);
        __builtin_amdgcn_sched_barrier(0);
        *(LAS f32x4*)(part + ((kq * 128) + t * 16 + fr) * 16 + 4 * fq) = acc;
    }
    __syncthreads();
    for (int i = cx.tid; i < nrow * 16; i += NTHR) { const int rl = i >> 4, gi = i & 15;
        WSP(float, WS_GT)[(size_t)(rb + rl) * 16 + gi] = (part[(0 * 128 + rl) * 16 + gi] + part[(1 * 128 + rl) * 16 + gi]) + (part[(2 * 128 + rl) * 16 + gi] + part[(3 * 128 + rl) * 16 + gi]) + P.in[I_BIN][l * DIN + 1536 + gi]; }
}

DEVI void ph_norm2(const Ctx& cx, int l) {
    const Params& P = *cx.p;
    LAS float* lgs = (LAS float*)cx.lds;
    LAS int* hist = (LAS int*)(cx.lds + 4 * 128 * 33 * 4);
    LAS int* pend = hist + 64;
    if (cx.tid < 64) hist[cx.tid] = 0;
    const int r0 = (l == DEPTH - 1) ? TCTX : 0, nr = TT - r0;
    const int rpb = (nr + cx.G - 1) / cx.G;
    const int rb = r0 + cx.bid * rpb, re = min(TT, rb + rpb);
    const float* modp = WSP(float, WS_MOD);
    const int c0 = 4 * cx.lane;
    for (int r2 = rb + cx.wave; r2 < re; r2 += 16) {
        f32x4 x[2][4]; bool ok[2];
#pragma unroll
        for (int u = 0; u < 2; ++u) { const int row = r2 + 8 * u; ok[u] = row < re; const float* src = WSP(float, WS_XMID) + (size_t)(ok[u] ? row : r2) * 1024;
#pragma unroll
            for (int i = 0; i < 4; ++i) x[u][i] = *(const f32x4*)(src + c0 + 256 * i); }
#pragma unroll
        for (int u = 0; u < 2; ++u) {
            const int row = r2 + 8 * u;
            float ss = 0.f;
#pragma unroll
            for (int i = 0; i < 4; ++i) ss += (x[u][i][0] * x[u][i][0] + x[u][i][1] * x[u][i][1]) + (x[u][i][2] * x[u][i][2] + x[u][i][3] * x[u][i][3]);
            ss = wave_sum(ss, 0);
            const float rstd = rsqrtf(ss * (1.0f / 1024.0f) + EPS);
            if (!ok[u]) continue;
            const float* md = modp + ((size_t)l * 9 + mod_row(row)) * 6144;
            bf16_t* hp = WSP(bf16_t, WS_H) + (size_t)row * 1024; bf16_t* hl = WSP(bf16_t, WS_HLO) + (size_t)row * 1024; unsigned char* h8 = WSP(unsigned char, WS_H8) + (size_t)row * 1024;
#pragma unroll
            for (int i = 0; i < 4; ++i) { const int c = c0 + 256 * i;
                const f32x4 nw = *(const f32x4*)(P.in[I_N2W] + l * 1024 + c), sc = *(const f32x4*)(md + 4096 + c), sh = *(const f32x4*)(md + 3072 + c);
                const f32x4 h = x[u][i] * rstd * nw * (sc + 1.0f) + sh;
                const int p8 = (int)pk4_fp8(h[0], h[1], h[2], h[3]);
                const float q0 = __builtin_amdgcn_cvt_f32_fp8(p8, 0), q1 = __builtin_amdgcn_cvt_f32_fp8(p8, 1), q2 = __builtin_amdgcn_cvt_f32_fp8(p8, 2), q3 = __builtin_amdgcn_cvt_f32_fp8(p8, 3);
                *(int*)(h8 + c) = p8;
                u32x2 wh; wh.x = pk_bf16(q0, q1); wh.y = pk_bf16(q2, q3); *(u32x2*)(hp + c) = wh;
                u32x2 wl; wl.x = pk_bf16(h[0] - q0, h[1] - q1); wl.y = pk_bf16(h[2] - q2, h[3] - q3); *(u32x2*)(hl + c) = wl; }
        }
    }
    block_rows_visible();
    const int nrow = re - rb, ntile = (nrow + 15) / 16;
    for (int it = cx.wave; it < ntile * 8; it += 8) {
        const int t = it >> 3, nt = (it >> 2) & 1, kq = it & 3, fr = cx.lane & 15, fq = cx.lane >> 4; const int row = min(rb + t * 16 + fr, re - 1);
        const bf16_t* hp = WSP(bf16_t, WS_H) + (size_t)row * 1024 + kq * 256 + fq * 8; const bf16_t* hl = WSP(bf16_t, WS_HLO) + (size_t)row * 1024 + kq * 256 + fq * 8;
        const bf16_t* wh = WSP(bf16_t, WS_RWH) + ((size_t)l * 32 + nt * 16 + fr) * 1024 + kq * 256 + fq * 8; const bf16_t* wl = WSP(bf16_t, WS_RWL) + ((size_t)l * 32 + nt * 16 + fr) * 1024 + kq * 256 + fq * 8;
        f32x4 acc = (f32x4){0.f, 0.f, 0.f, 0.f}, acc2 = (f32x4){0.f, 0.f, 0.f, 0.f};
        bf16x8 ah[8], al[8], bh[8], bl[8];
#pragma unroll
        for (int k = 0; k < 8; ++k) { ah[k] = ldg8(hp + 32 * k); al[k] = ldg8(hl + 32 * k); bh[k] = ldg8(wh + 32 * k); bl[k] = ldg8(wl + 32 * k); }
        __builtin_amdgcn_sched_barrier(0);
#pragma unroll
        for (int k = 0; k < 8; ++k) {
            acc = __builtin_amdgcn_mfma_f32_16x16x32_bf16(bh[k], ah[k], acc, 0, 0, 0);
            acc2 = __builtin_amdgcn_mfma_f32_16x16x32_bf16(bl[k], ah[k], acc2, 0, 0, 0);
            acc2 = __builtin_amdgcn_mfma_f32_16x16x32_bf16(bh[k], al[k], acc2, 0, 0, 0); }
        __builtin_amdgcn_sched_barrier(0);
        const int rl = t * 16 + fr;
#pragma unroll
        for (int j = 0; j < 4; ++j) lgs[(kq * 128 + rl) * 33 + nt * 16 + 4 * fq + j] = acc[j] + acc2[j];
    }
    __syncthreads();
    if (cx.tid < nrow) {
        float lg[32];
#pragma unroll
        for (int e = 0; e < 32; ++e) lg[e] = (lgs[(0 * 128 + cx.tid) * 33 + e] + lgs[(1 * 128 + cx.tid) * 33 + e]) + (lgs[(2 * 128 + cx.tid) * 33 + e] + lgs[(3 * 128 + cx.tid) * 33 + e]) + P.in[I_RB][l * 32 + e];
        float tv[4]; int tix[4]; unsigned taken = 0u;
#pragma unroll
        for (int k = 0; k < 4; ++k) { float bv = -3.0e38f; int bi = 0;
#pragma unroll
            for (int e = 0; e < 32; ++e) { const bool better = (lg[e] > bv) && !((taken >> e) & 1u); bv = better ? lg[e] : bv; bi = better ? e : bi; }
            tv[k] = bv; tix[k] = bi; taken |= 1u << bi; }
        const float e1 = __expf(tv[1] - tv[0]), e2 = __expf(tv[2] - tv[0]), e3 = __expf(tv[3] - tv[0]);
        const float inv = 1.0f / (1.0f + e1 + e2 + e3);
        const float gk[4] = {inv, e1 * inv, e2 * inv, e3 * inv};
#pragma unroll
        for (int k = 0; k < 4; ++k) {
            const int ls = __hip_atomic_fetch_add((LAS int*)(hist + tix[k]), 1, __ATOMIC_RELAXED, __HIP_MEMORY_SCOPE_WORKGROUP);
            pend[(cx.tid * 4 + k) * 2 + 0] = (tix[k] << 20) | ls;
            pend[(cx.tid * 4 + k) * 2 + 1] = __float_as_int(gk[k]); }
    }
    __syncthreads();
    if (cx.tid < 32) { unsigned* cnt = (unsigned*)(cx.ws + WS_CTL) + CW_CNT + l * 32;
        hist[32 + cx.tid] = hist[cx.tid] > 0 ? (int)__hip_atomic_fetch_add(cnt + cx.tid, (unsigned)hist[cx.tid], __ATOMIC_RELAXED, __HIP_MEMORY_SCOPE_AGENT) : 0; }
    __syncthreads();
    for (int i = cx.tid; i < nrow * 4; i += NTHR) {
        const int t = pend[i * 2], e = t >> 20, slot = hist[32 + e] + (t & 0xFFFFF), row = rb + (i >> 2);
        WSP(int, WS_ELIST)[(size_t)e * TT + slot] = row;
        WSP(float, WS_TGATE)[(size_t)row * 4 + (i & 3)] = __int_as_float(pend[i * 2 + 1]);
        WSP(int, WS_TINFO)[(size_t)row * 4 + (i & 3)] = (e << 20) | slot;
    }
}

DEVI int xcd_contig(int bid, int G) { return (G % 8 == 0) ? (bid % 8) * (G / 8) + bid / 8 : bid; }

struct DenseSched {
    const char* A; const char* B; int nM, nN, pm0, G, bid;
    DEVI bool get(int i, g1::Unit& u) const {
        int pm, pn;
        if (G % 8 == 0) { const int x = bid & 7, r = bid >> 3, nx = G >> 3, lo = (nM * x) >> 3, hi = (nM * (x + 1)) >> 3, nr = hi - lo;
            const int q = i * nx + r; if (nr <= 0 || q >= nr * nN) return false; pm = lo + q % nr; pn = q / nr; }
        else { const int L = i * G + bid; if (L >= nM * nN) return false; pm = L / nN; pn = L % nN; }
        u.A = A + (size_t)(pm0 + pm) * 256 * 2048; u.list = nullptr; u.nvalid = 256; u.B = B + (size_t)pn * 256 * 2048; u.pm = pm0 + pm; u.pn = pn; u.e = 0;
        return true;
    }
};
struct MoeSched {
    const char* A; const char* B; const int* elist; const LAS int* info; int NPN, gather, G, bid; size_t bstride; int kb;
    DEVI int rd(int i) const { return __builtin_amdgcn_readfirstlane(info[i]); }
    DEVI bool get(int i, g1::Unit& u) const {
        const int NTt = rd(32); int T, pn;
        if (G % 8 == 0 && (G >> 3) % NPN == 0) { const int x = bid & 7, r = bid >> 3, nx = G >> 3, RT = nx / NPN, lo = (NTt * x) >> 3, hi = (NTt * (x + 1)) >> 3;
            T = lo + i * RT + r % RT; pn = r / RT; if (T >= hi) return false; }
        else { const int L = i * G + bid; if (L >= NTt * NPN) return false; T = L / NPN; pn = L % NPN; }
        const int e = rd(112 + T), j = T - rd(e);
        u.pm = T; u.pn = pn; u.e = e;
        u.B = B + (size_t)e * bstride + (size_t)pn * 256 * kb;
        if (gather) { u.A = A; u.list = elist + (size_t)e * TT + j * 256; u.nvalid = rd(40 + e) - j * 256; }
        else { u.A = A + (size_t)T * 256 * kb; u.list = nullptr; u.nvalid = 256; }
        return true;
    }
};

struct EpiIn {
    static constexpr bool PERM = true;
    bf16_t* Pout; const float* bias;
    DEVI void operator()(const f32x4 (&acc)[2][2][4][2], const g1::Unit& u, int wr, int wc, int fr, int fq) const {
        const int row0 = u.pm * 256 + wr * 64 + fr;
#pragma unroll
        for (int bj = 0; bj < 2; ++bj) {
            const int col0 = u.pn * 256 + bj * 128 + wc * 32 + 8 * fq;
            const int seg = u.pn * 2 + bj; const bool gl = (seg >= 15 && seg < 18);
            const f32x4 b0 = *(const f32x4*)(bias + col0), b1 = *(const f32x4*)(bias + col0 + 4);
#pragma unroll
            for (int ai = 0; ai < 2; ++ai)
#pragma unroll
                for (int m = 0; m < 4; ++m) {
                    f32x4 v0 = acc[ai][bj][m][0] + b0, v1 = acc[ai][bj][m][1] + b1;
                    if (gl) {
#pragma unroll
                        for (int j = 0; j < 4; ++j) { v0[j] = gelu_tanh(v0[j]); v1[j] = gelu_tanh(v1[j]); } }
                    u32x4 w; w.x = pk_bf16(v0[0], v0[1]); w.y = pk_bf16(v0[2], v0[3]); w.z = pk_bf16(v1[0], v1[1]); w.w = pk_bf16(v1[2], v1[3]);
                    *(u32x4*)(Pout + (size_t)(row0 + ai * 128 + m * 16) * NP + col0) = w;
                }
        }
    }
};
struct EpiOut {
    static constexpr bool PERM = false;
    const float* xs; float* xmid; const float* mod;
    DEVI void operator()(const f32x4 (&acc)[2][2][4][2], const g1::Unit& u, int wr, int wc, int fr, int fq) const {
        const int row0 = u.pm * 256 + wr * 64 + fr;
        const float* g1p = mod + (size_t)mod_row(u.pm * 256) * 6144 + 2048;
#pragma unroll
        for (int bj = 0; bj < 2; ++bj)
#pragma unroll
            for (int n = 0; n < 2; ++n) {
                const int col = u.pn * 256 + bj * 128 + wc * 32 + 16 * n + 4 * fq;
                const f32x4 gv = *(const f32x4*)(g1p + col);
#pragma unroll
                for (int ai = 0; ai < 2; ++ai)
#pragma unroll
                    for (int m = 0; m < 4; ++m) {
                        const size_t off = (size_t)(row0 + ai * 128 + m * 16) * 1024 + col;
                        const f32x4 xv = *(const f32x4*)(xs + off);
                        *(f32x4*)(xmid + off) = xv + gv * acc[ai][bj][m][n];
                    }
            }
    }
};
struct EpiGU {
    static constexpr bool PERM = true;
    unsigned char* act; const float* bgu;
    DEVI void operator()(const f32x4 (&acc)[2][2][4][2], const g1::Unit& u, int wr, int wc, int fr, int fq) const {
        const int row0 = u.pm * 256 + wr * 64 + fr, colh = u.pn * 128 + wc * 32 + 8 * fq;
        const float* bg = bgu + (size_t)u.e * 2048 + colh; const float* bu = bg + 1024;
        const f32x4 bg0 = *(const f32x4*)bg, bg1 = *(const f32x4*)(bg + 4), bu0 = *(const f32x4*)bu, bu1 = *(const f32x4*)(bu + 4);
#pragma unroll
        for (int ai = 0; ai < 2; ++ai)
#pragma unroll
            for (int m = 0; m < 4; ++m) {
                float o[8];
#pragma unroll
                for (int n = 0; n < 2; ++n)
#pragma unroll
                    for (int j = 0; j < 4; ++j) {
                        const float g = fminf(acc[ai][0][m][n][j] * W8_INV + (n ? bg1[j] : bg0[j]), 7.0f);
                        const float up = fminf(fmaxf(acc[ai][1][m][n][j] * W8_INV + (n ? bu1[j] : bu0[j]), -7.0f), 7.0f);
                        o[n * 4 + j] = (up + 1.0f) * g * frcp(1.0f + __expf(-1.702f * g));
                    }
                u32x2 w; w.x = pk4_fp8(o[0], o[1], o[2], o[3]); w.y = pk4_fp8(o[4], o[5], o[6], o[7]);
                *(u32x2*)(act + (size_t)(row0 + ai * 128 + m * 16) * 1024 + colh) = w;
            }
    }
};
struct EpiDown {
    static constexpr bool PERM = true;
    unsigned char* ypad; const float* bd; const float* glist; const LAS int* info;
    DEVI void operator()(const f32x4 (&acc)[2][2][4][2], const g1::Unit& u, int wr, int wc, int fr, int fq) const {
        const int rl0 = wr * 64 + fr;
#pragma unroll
        for (int ai = 0; ai < 2; ++ai)
#pragma unroll
            for (int m = 0; m < 4; ++m) {
                const int rl = rl0 + ai * 128 + m * 16;
#pragma unroll
                for (int bj = 0; bj < 2; ++bj) {
                    const int col0 = u.pn * 256 + bj * 128 + wc * 32 + 8 * fq;
                    const f32x4 b0 = *(const f32x4*)(bd + (size_t)u.e * 1024 + col0), b1 = *(const f32x4*)(bd + (size_t)u.e * 1024 + col0 + 4);
                    const f32x4 v0 = acc[ai][bj][m][0] * W8_INV + b0, v1 = acc[ai][bj][m][1] * W8_INV + b1;
                    u32x2 w; w.x = pk4_fp8(v0[0] * Y8_SCALE, v0[1] * Y8_SCALE, v0[2] * Y8_SCALE, v0[3] * Y8_SCALE); w.y = pk4_fp8(v1[0] * Y8_SCALE, v1[1] * Y8_SCALE, v1[2] * Y8_SCALE, v1[3] * Y8_SCALE);
                    *(u32x2*)(ypad + (size_t)(u.pm * 256 + rl) * 1024 + col0) = w;
                }
            }
    }
};

DEVI void ph_inproj(const Ctx& cx, int l) {
    DenseSched S{(const char*)WSP(bf16_t, WS_H), (const char*)(WSP(bf16_t, WS_WIN) + (size_t)l * NP * 1024), TT / 256, NP / 256, 0, cx.G, cx.bid};
    EpiIn E{WSP(bf16_t, WS_P), WSP(float, WS_BIN2) + (size_t)l * NP};
    g1::gemm_phase<DenseSched, EpiIn, false>(cx.lds, cx.tid, S, E);
}
DEVI void ph_outproj(const Ctx& cx, int l) {
    const int pm0 = (l == DEPTH - 1) ? TCTX / 256 : 0;
    DenseSched S{(const char*)WSP(bf16_t, WS_MRG), (const char*)(WSP(bf16_t, WS_WOUT) + (size_t)l * 1024 * 1024), TT / 256 - pm0, 4, pm0, cx.G, cx.bid};
    EpiOut E{WSP(float, WS_XS), WSP(float, WS_XMID), WSP(float, WS_MOD) + (size_t)l * 9 * 6144};
    g1::gemm_phase<DenseSched, EpiOut, false>(cx.lds, cx.tid, S, E);
}
DEVI void ph_moe_gu(const Ctx& cx, int l) {
    LAS int* info = (LAS int*)(cx.lds + g1::STAGE_BYTES);
    moe_info(cx, l, info);
    MoeSched S{(const char*)WSP(unsigned char, WS_H8), (const char*)(WSP(unsigned char, WS_WGU) + (size_t)l * NE * 2048 * 1024), WSP(int, WS_ELIST), info, 8, 1, cx.G, cx.bid, (size_t)2048 * 1024, 1024};
    EpiGU E{WSP(unsigned char, WS_ACT), cx.p->in[I_BGU] + (size_t)l * NE * 2048};
    g1::gemm_phase<MoeSched, EpiGU, true, true>(cx.lds, cx.tid, S, E);
}
DEVI void ph_moe_dn(const Ctx& cx, int l) {
    LAS int* info = (LAS int*)(cx.lds + g1::STAGE_BYTES);
    moe_info(cx, l, info);
    MoeSched S{(const char*)WSP(unsigned char, WS_ACT), (const char*)(WSP(unsigned char, WS_WD) + (size_t)l * NE * 1024 * 1024), nullptr, info, 4, 0, cx.G, cx.bid, (size_t)1024 * 1024, 1024};
    EpiDown E{WSP(unsigned char, WS_YPAD), cx.p->in[I_BD] + (size_t)l * NE * 1024, WSP(float, WS_GLIST), info};
    g1::gemm_phase<MoeSched, EpiDown, false, true>(cx.lds, cx.tid, S, E);
}

DEVI int ml_row0(int b, int c) { return c < 2 ? b * CTXL + c * 128 : TCTX + b * SEQ + (c - 2) * 128; }
DEVI unsigned short lds_u16(const LAS bf16_t* p) { return *p; }
typedef short s16x4 __attribute__((ext_vector_type(4)));
DEVI bf16x8 tr8(const LAS bf16_t* tile, int stride, int r0, int r1, int c0, int lane) {
    const int q = (lane & 15) >> 2, p = lane & 3;
    const s16x4 a = __builtin_amdgcn_ds_read_tr16_b64_v4i16((LAS s16x4*)(tile + (r0 + q) * stride + c0 + 4 * p));
    const s16x4 b = __builtin_amdgcn_ds_read_tr16_b64_v4i16((LAS s16x4*)(tile + (r1 + q) * stride + c0 + 4 * p));
    return __builtin_shufflevector(a, b, 0, 1, 2, 3, 4, 5, 6, 7);
}

DEVI void ml_local_unit(const Ctx& cx, int l, int b, int h, int c) {
    LAS float* sg = (LAS float*)cx.lds;
    LAS float* se = sg + 256;
    LAS float* red = se + 256;
    LAS bf16_t* Ks = (LAS bf16_t*)(cx.lds + 4352);
    LAS bf16_t* Ve = Ks + 128 * 104;
    const int row0 = ml_row0(b, c), tid = cx.tid;
    const int dir = (tid >> 7) & 1, i = tid & 127, p = dir ? 127 - i : i;
    const bool act = tid < 256;
    float gi = 0.f, bval = 0.f, u = 0.f;
    if (act) { const float* gt = WSP(float, WS_GT) + (size_t)(row0 + i) * 16; gi = gt[dir * 4 + h]; const float gf = gt[8 + dir * 4 + h];
        sg[dir * 128 + p] = fminf(gf, 0.f) - log1p_(__expf(-fabsf(gf))); }
    LDS_SYNC();
#pragma unroll 1
    for (int off = 1; off < 128; off <<= 1) { float v = 0.f; if (act) { v = sg[dir * 128 + p]; if (p >= off) v += sg[dir * 128 + p - off]; } LDS_SYNC(); if (act) sg[dir * 128 + p] = v; LDS_SYNC(); }
    if (act) { bval = sg[dir * 128 + p]; u = gi - bval; if (p == 127) red[dir] = bval; }
    LDS_SYNC();
    if (act) sg[dir * 128 + p] = u;
    LDS_SYNC();
#pragma unroll 1
    for (int off = 1; off < 128; off <<= 1) { float v = 0.f; if (act) { v = sg[dir * 128 + p]; if (p >= off) v = fmaxf(v, sg[dir * 128 + p - off]); } LDS_SYNC(); if (act) sg[dir * 128 + p] = v; LDS_SYNC(); }
    if (act) { const float cm = sg[dir * 128 + p]; if (p == 127) red[2 + dir] = cm;
        const size_t gix = (size_t)(row0 + i) * 8 + dir * 4 + h;
        WSP(float, WS_GB)[gix] = bval; WSP(float, WS_GU)[gix] = u; WSP(float, WS_GCM)[gix] = cm; }
    LDS_SYNC();
    if (act) se[dir * 128 + i] = expf(u - red[2 + dir]);
    if (tid < 2) { float* msc = WSP(float, WS_MSC) + ((size_t)((b * 4 + h) * MLC + c) * 2 + tid) * 2; msc[0] = red[tid]; msc[1] = red[tid] + red[2 + tid]; }
    LDS_SYNC();
    const bf16_t* Pp = WSP(bf16_t, WS_P);
#pragma unroll
    for (int it = 0; it < 3; ++it) { const int idx = tid + NTHR * it, r = idx / 12, ch = idx % 12;
        const u32x4 kv = *(const u32x4*)(Pp + (size_t)(row0 + r) * NP + PC_K + h * 96 + ch * 8);
        *(LAS u32x4*)(Ks + r * 104 + ch * 8) = kv;
        const u32x4 vv = *(const u32x4*)(Pp + (size_t)(row0 + r) * NP + PC_V + h * 96 + ch * 8);
        const float e0 = se[r], e1 = se[128 + r];
        u32x4 o0, o1;
#pragma unroll
        for (int q = 0; q < 4; ++q) { const float lo = __uint_as_float(vv[q] << 16), hi = __uint_as_float(vv[q] & 0xFFFF0000u);
            o0[q] = pk_bf16(lo * e0, hi * e0); o1[q] = pk_bf16(lo * e1, hi * e1); }
        *(LAS u32x4*)(Ve + r * 104 + ch * 8) = o0; *(LAS u32x4*)(Ve + (128 + r) * 104 + ch * 8) = o1; }
    LDS_SYNC();
    {
        const int wd = cx.wave >> 2, q9 = (cx.wave & 3) * 9, fr = cx.lane & 15, fq = cx.lane >> 4;
        float* cl = WSP(float, WS_CLOC) + ((size_t)((b * 4 + h) * MLC + c) * 2 + wd) * 9216;
        const LAS bf16_t* V = Ve + wd * 128 * 104;
#pragma unroll 1
        for (int pi = q9; pi < q9 + 9; ++pi) { const int dt = pi / 6, et = pi % 6;
            f32x4 acc = (f32x4){0.f, 0.f, 0.f, 0.f};
#pragma unroll
            for (int kk = 0; kk < 4; ++kk) { const int s0 = kk * 32 + fq * 8;
                const bf16x8 a = tr8(V, 104, s0, s0 + 4, dt * 16, cx.lane), bb = tr8(Ks, 104, s0, s0 + 4, et * 16, cx.lane);
                acc = __builtin_amdgcn_mfma_f32_16x16x32_bf16(a, bb, acc, 0, 0, 0); }
#pragma unroll
            for (int r = 0; r < 4; ++r) cl[(dt * 16 + fq * 4 + r) * 96 + et * 16 + fr] = acc[r]; }
    }
    {
        LAS float* nred = (LAS float*)(cx.lds + 4352 + 3 * 128 * 104 * 2);
        for (int idx = tid; idx < 768; idx += NTHR) { const int qd = idx / 192, rem = idx % 192, d2 = rem / 96, e = rem % 96; float s = 0.f;
#pragma unroll 8
            for (int t = qd * 32; t < qd * 32 + 32; ++t) s += se[d2 * 128 + t] * bf2f(Ks[t * 104 + e]);
            nred[idx] = s; }
        LDS_SYNC();
        if (tid < 192) WSP(float, WS_NLOC)[((size_t)((b * 4 + h) * MLC + c) * 2 + tid / 96) * 96 + tid % 96] = (nred[tid] + nred[192 + tid]) + (nred[384 + tid] + nred[576 + tid]);
    }
    LDS_SYNC();
}

DEVI void ml_carry(const Ctx& cx) {
    for (int idx = cx.bid * NTHR + cx.tid; idx < 64 * 9312; idx += cx.G * NTHR) {
        const int combo = idx / 9312, el = idx % 9312, dir = combo & 1, bh = combo >> 1;
        float loc[MLC], bl[MLC], ml[MLC];
#pragma unroll
        for (int s = 0; s < MLC; ++s) {
            const int c = dir == 0 ? s : (s < 2 ? 1 - s : 19 - s);
            const size_t cb = (size_t)(bh * MLC + c) * 2 + dir;
            bl[s] = WSP(float, WS_MSC)[cb * 2]; ml[s] = WSP(float, WS_MSC)[cb * 2 + 1];
            loc[s] = el < 9216 ? WSP(float, WS_CLOC)[cb * 9216 + el] : WSP(float, WS_NLOC)[cb * 96 + el - 9216];
        }
        float Cv = 0.f, m = -1e30f;
#pragma unroll
        for (int s = 0; s < MLC; ++s) {
            const int c = dir == 0 ? s : (s < 2 ? 1 - s : 19 - s);
            const size_t cb = (size_t)(bh * MLC + c) * 2 + dir;
            if (el < 9216) WSP(bf16_t, WS_C0)[cb * 9216 + el] = f2bf(Cv); else WSP(float, WS_N0)[cb * 96 + el - 9216] = Cv;
            if (el == 0) WSP(float, WS_M0)[cb] = m;
            const float mn = fmaxf(bl[s] + m, ml[s]), a = __expf(bl[s] + m - mn), sc = __expf(ml[s] - mn);
            Cv = a * Cv + sc * loc[s]; m = mn;
        }
    }
}

DEVI void ml_out_unit(const Ctx& cx, int l, int b, int h, int c) {
    LAS bf16_t* Qs = (LAS bf16_t*)cx.lds;
    LAS bf16_t* Ks = Qs + 128 * 104;
    LAS bf16_t* Vs = Ks + 128 * 104;
    LAS bf16_t* C0s = Vs + 128 * 104;
    LAS float* gb = (LAS float*)(cx.lds + 119808);
    LAS float* gu = gb + 256;
    LAS float* gM = gu + 256;
    LAS float* n0s = gM + 256;
    LAS float* m0s = n0s + 192;
    const int row0 = ml_row0(b, c), tid = cx.tid;
    const bf16_t* Pp = WSP(bf16_t, WS_P);
    const size_t cb0 = (size_t)((b * 4 + h) * MLC + c) * 2;
#pragma unroll
    for (int it = 0; it < 3; ++it) { const int idx = tid + NTHR * it, r = idx / 12, ch = idx % 12;
        const bf16_t* rp = Pp + (size_t)(row0 + r) * NP + h * 96 + ch * 8;
        *(LAS u32x4*)(Qs + r * 104 + ch * 8) = *(const u32x4*)(rp + PC_Q);
        *(LAS u32x4*)(Ks + r * 104 + ch * 8) = *(const u32x4*)(rp + PC_K);
        *(LAS u32x4*)(Vs + r * 104 + ch * 8) = *(const u32x4*)(rp + PC_V); }
    for (int idx = tid; idx < 2 * 96 * 12; idx += NTHR) { const int d2 = idx / 1152, r = (idx % 1152) / 12, ch = idx % 12;
        *(LAS u32x4*)(C0s + (d2 * 96 + r) * 104 + ch * 8) = *(const u32x4*)(WSP(bf16_t, WS_C0) + (cb0 + d2) * 9216 + r * 96 + ch * 8); }
    if (tid < 256) { const int d2 = tid >> 7, i = tid & 127; const size_t gix = (size_t)(row0 + i) * 8 + d2 * 4 + h;
        gb[tid] = WSP(float, WS_GB)[gix]; gu[tid] = WSP(float, WS_GU)[gix];
        gM[tid] = fmaxf(WSP(float, WS_M0)[cb0 + d2], WSP(float, WS_GCM)[gix]); }
    if (tid >= 256 && tid < 448) { const int k = tid - 256; n0s[k] = WSP(float, WS_N0)[(cb0 + k / 96) * 96 + k % 96]; }
    if (tid >= 448 && tid < 450) m0s[tid - 448] = WSP(float, WS_M0)[cb0 + tid - 448];
    LDS_SYNC();
    const int w = cx.wave, fr = cx.lane & 15, fq = cx.lane >> 4, t = 16 * w + fr;
    bf16x8 qf[3];
#pragma unroll
    for (int kk = 0; kk < 3; ++kk) qf[kk] = *(const LAS bf16x8*)(Qs + t * 104 + kk * 32 + fq * 8);
    f32x4 hs[6];
#pragma unroll
    for (int n = 0; n < 6; ++n) hs[n] = (f32x4){0.f, 0.f, 0.f, 0.f};
#pragma unroll
    for (int dir = 0; dir < 2; ++dir) {
        const float Mt = gM[dir * 128 + t], bt = gb[dir * 128 + t], inter = __expf(m0s[dir] - Mt);
        f32x4 an[6];
#pragma unroll
        for (int n = 0; n < 6; ++n) an[n] = (f32x4){0.f, 0.f, 0.f, 0.f};
        float den = 0.f;
        const int Jlo = dir == 0 ? 0 : (w >> 1), Jhi = dir == 0 ? (w >> 1) : 3;
#pragma unroll 1
        for (int J = Jlo; J <= Jhi; ++J) {
            bf16x8 pf;
#pragma unroll
            for (int half = 0; half < 2; ++half) {
                const int j = 2 * J + half;
                f32x4 D = (f32x4){0.f, 0.f, 0.f, 0.f};
                const bool need = dir == 0 ? (j <= w) : (j >= w);
                if (need) {
#pragma unroll
                    for (int kk = 0; kk < 3; ++kk) { const bf16x8 kf = *(const LAS bf16x8*)(Ks + (16 * j + fr) * 104 + kk * 32 + fq * 8);
                        D = __builtin_amdgcn_mfma_f32_16x16x32_bf16(kf, qf[kk], D, 0, 0, 0); }
                }
                const f32x4 us = *(const LAS f32x4*)(gu + dir * 128 + 16 * j + 4 * fq);
                float pv[4];
#pragma unroll
                for (int r = 0; r < 4; ++r) { const int s = 16 * j + 4 * fq + r; const bool valid = need && (dir == 0 ? (s <= t) : (s >= t));
                    pv[r] = valid ? D[r] * __expf(us[r] - Mt) : 0.f; den += pv[r]; }
                pf[half * 4 + 0] = (short)f2bf(pv[0]); pf[half * 4 + 1] = (short)f2bf(pv[1]); pf[half * 4 + 2] = (short)f2bf(pv[2]); pf[half * 4 + 3] = (short)f2bf(pv[3]);
            }
#pragma unroll
            for (int n = 0; n < 6; ++n) { const bf16x8 vf = tr8(Vs, 104, 32 * J + 4 * fq, 32 * J + 16 + 4 * fq, 16 * n, cx.lane);
                an[n] = __builtin_amdgcn_mfma_f32_16x16x32_bf16(vf, pf, an[n], 0, 0, 0); }
        }
        float nq = 0.f;
#pragma unroll
        for (int kk = 0; kk < 3; ++kk)
#pragma unroll
            for (int j = 0; j < 8; ++j) nq += n0s[dir * 96 + kk * 32 + fq * 8 + j] * bf2f((bf16_t)qf[kk][j]);
        nq += shx<16>(nq, cx.lane); nq += shx<32>(nq, cx.lane);
        den += shx<16>(den, cx.lane); den += shx<32>(den, cx.lane);
        const float dtot = den + inter * nq;
        const float inv = frcp(fmaxf(fabsf(dtot), __expf(-(Mt + bt))));
#pragma unroll
        for (int n = 0; n < 6; ++n) { f32x4 ac = (f32x4){0.f, 0.f, 0.f, 0.f};
#pragma unroll
            for (int kk = 0; kk < 3; ++kk) { const bf16x8 cf = *(const LAS bf16x8*)(C0s + (dir * 96 + 16 * n + fr) * 104 + kk * 32 + fq * 8);
                ac = __builtin_amdgcn_mfma_f32_16x16x32_bf16(cf, qf[kk], ac, 0, 0, 0); }
            hs[n] += (an[n] + ac * inter) * inv; }
    }
    float ss = 0.f;
#pragma unroll
    for (int n = 0; n < 6; ++n) ss += hs[n][0] * hs[n][0] + hs[n][1] * hs[n][1] + hs[n][2] * hs[n][2] + hs[n][3] * hs[n][3];
    ss += shx<16>(ss, cx.lane); ss += shx<32>(ss, cx.lane);
    const float rstd = rsqrtf(ss * (1.0f / 96.0f) + EPS);
    const size_t prow = (size_t)(row0 + t);
#pragma unroll
    for (int n = 0; n < 6; ++n) { const int d = 16 * n + 4 * fq;
        const u32x2 ov = *(const u32x2*)(Pp + prow * NP + PC_O + h * 96 + d);
        const f32x4 mw = *(const f32x4*)(cx.p->in[I_MIXW] + l * 1024 + h * 96 + d);
        const float o0 = __uint_as_float(ov.x << 16), o1 = __uint_as_float(ov.x & 0xFFFF0000u), o2 = __uint_as_float(ov.y << 16), o3 = __uint_as_float(ov.y & 0xFFFF0000u);
        u32x2 wv; wv.x = pk_bf16(sigmoidf_(o0) * hs[n][0] * rstd * mw[0], sigmoidf_(o1) * hs[n][1] * rstd * mw[1]);
        wv.y = pk_bf16(sigmoidf_(o2) * hs[n][2] * rstd * mw[2], sigmoidf_(o3) * hs[n][3] * rstd * mw[3]);
        *(u32x2*)(WSP(bf16_t, WS_MRG) + prow * 1024 + h * 96 + d) = wv; }
    LDS_SYNC();
}

DEVI void rg_unit(const Ctx& cx, int l, int b, int ck, int g, int mode) {
    const Params& P = *cx.p;
    LAS float* xraw = (LAS float*)cx.lds;
    LAS float* xc = (LAS float*)(cx.lds + 17408);
    LAS bf16_t* xcb = (LAS bf16_t*)(cx.lds + 33792);
    LAS float* ab = (LAS float*)(cx.lds + 43008);
    LAS float* hbuf = (LAS float*)(cx.lds + 43008 + 65536);
    const int tid = cx.tid;
    const int t0 = ck < 4 ? ck * 64 : (ck - 4) * 64, seglen = ck < 4 ? CTXL : SEQ, rowbase = ck < 4 ? b * CTXL : TCTX + b * SEQ;
    const bf16_t* Pp = WSP(bf16_t, WS_P);
    for (int idx = tid; idx < 67 * 8; idx += NTHR) { const int r = idx >> 3, c8 = idx & 7, tt = t0 - 2 + r;
        u32x4 v = (u32x4){0u, 0u, 0u, 0u};
        if (tt >= 0 && tt < seglen) v = *(const u32x4*)(Pp + (size_t)(rowbase + tt) * NP + PC_RX + g * 64 + c8 * 8);
#pragma unroll
        for (int q = 0; q < 4; ++q) { xraw[r * 64 + c8 * 8 + 2 * q] = __uint_as_float(v[q] << 16); xraw[r * 64 + c8 * 8 + 2 * q + 1] = __uint_as_float(v[q] & 0xFFFF0000u); } }
    LDS_SYNC();
#pragma unroll
    for (int it = 0; it < 8; ++it) { const int idx = tid + NTHR * it, t = idx >> 6, ch = idx & 63, cg = g * 64 + ch;
        float v = P.in[I_RGCB][l * 384 + cg];
#pragma unroll
        for (int j = 0; j < 4; ++j) v += P.in[I_RGCW][(l * 4 + j) * 384 + cg] * xraw[(t + j) * 64 + ch];
        xc[t * 64 + ch] = v; xcb[t * 72 + ch] = f2bf(v); }
    LDS_SYNC();
    {
        const int dir = cx.wave >> 2, cg4 = cx.wave & 3, fr = cx.lane & 15, fq = cx.lane >> 4;
        const bf16_t* wrg = WSP(bf16_t, WS_WRG) + (size_t)(l * 6 + g) * 256 * 64;
        f32x4 ar[4], ai[4];
#pragma unroll
        for (int m = 0; m < 4; ++m) { ar[m] = (f32x4){0.f, 0.f, 0.f, 0.f}; ai[m] = (f32x4){0.f, 0.f, 0.f, 0.f}; }
#pragma unroll
        for (int kk = 0; kk < 2; ++kk) {
            const bf16x8 br = ldg8(wrg + (size_t)((dir * 2 + 0) * 64 + cg4 * 16 + fr) * 64 + kk * 32 + fq * 8);
            const bf16x8 bi = ldg8(wrg + (size_t)((dir * 2 + 1) * 64 + cg4 * 16 + fr) * 64 + kk * 32 + fq * 8);
#pragma unroll
            for (int m = 0; m < 4; ++m) { const bf16x8 a = *(const LAS bf16x8*)(xcb + (m * 16 + fr) * 72 + kk * 32 + fq * 8);
                ar[m] = __builtin_amdgcn_mfma_f32_16x16x32_bf16(br, a, ar[m], 0, 0, 0); ai[m] = __builtin_amdgcn_mfma_f32_16x16x32_bf16(bi, a, ai[m], 0, 0, 0); }
        }
        const int ch0 = cg4 * 16 + 4 * fq, cgl = g * 64 + ch0;
        const f32x4 ba = *(const f32x4*)(P.in[I_RGBA] + (l * 2 + dir) * 384 + cgl), bx = *(const f32x4*)(P.in[I_RGBX] + (l * 2 + dir) * 384 + cgl);
        const f32x4 lam = *(const f32x4*)(P.in[I_RGLAM] + (l * 2 + dir) * 384 + cgl);
        float sp[4];
#pragma unroll
        for (int j = 0; j < 4; ++j) sp[j] = lam[j] > 0.f ? log1p_(__expf(-lam[j])) : -lam[j] + log1p_(__expf(lam[j]));
#pragma unroll
        for (int m = 0; m < 4; ++m) { const int t = m * 16 + fr; const f32x4 xv = *(const LAS f32x4*)(xc + t * 64 + ch0);
            f32x4 av, bv;
#pragma unroll
            for (int j = 0; j < 4; ++j) { const float r = frcp(1.0f + __expf(-(ar[m][j] + ba[j]))), ii = frcp(1.0f + __expf(-(ai[m][j] + bx[j])));
                const float la = -8.0f * r * sp[j], y = 2.0f * la; av[j] = __expf(la);
                const float nem1 = y > -0.02f ? -y * (1.0f + y * (0.5f + y * 0.16666667f)) : 1.0f - av[j] * av[j];
                bv[j] = sqrtf(nem1) * (ii * xv[j]); }
            *(LAS f32x4*)(ab + ((dir * 2 + 0) * 64 + t) * 64 + ch0) = av; *(LAS f32x4*)(ab + ((dir * 2 + 1) * 64 + t) * 64 + ch0) = bv; }
    }
    LDS_SYNC();
    if (tid < 128) { const int dir = tid >> 6, ch = tid & 63; const size_t ix = ((size_t)(b * RGC + ck) * 2 + dir) * 384 + g * 64 + ch;
        float hc = mode ? WSP(float, WS_RGC)[ix] : 0.f, ap = 1.0f;
        const LAS float* __restrict__ A = ab + (dir * 2 + 0) * 4096 + ch; const LAS float* __restrict__ B = ab + (dir * 2 + 1) * 4096 + ch; LAS float* __restrict__ H = hbuf + dir * 4096 + ch;
#pragma unroll 1
        for (int s0 = 0; s0 < 64; s0 += 16) { float av[16], bv[16];
#pragma unroll
            for (int j = 0; j < 16; ++j) { const int t = dir ? 63 - (s0 + j) : s0 + j; av[j] = A[t * 64]; bv[j] = B[t * 64]; }
#pragma unroll
            for (int j = 0; j < 16; ++j) { const int t = dir ? 63 - (s0 + j) : s0 + j; hc = av[j] * hc + bv[j]; ap *= av[j]; if (mode) H[t * 64] = hc; } }
        if (!mode) { WSP(float, WS_RGA)[ix] = ap; WSP(float, WS_RGB)[ix] = hc; } }
    LDS_SYNC();
    if (mode) { const int t = tid >> 3, ch0 = (tid & 7) * 8; float hv[8]; float ss = 0.f;
#pragma unroll
        for (int j = 0; j < 8; ++j) { hv[j] = hbuf[t * 64 + ch0 + j] + hbuf[4096 + t * 64 + ch0 + j]; ss += hv[j] * hv[j]; }
        ss += dpp_<0xB1, 0xF>(ss); ss += dpp_<0x4E, 0xF>(ss); ss += dpp_<0x141, 0xF>(ss);
        const float rstd = rsqrtf(ss * (1.0f / 64.0f) + EPS);
        const size_t row = (size_t)(rowbase + t0 + t);
        const u32x4 gv = *(const u32x4*)(Pp + row * NP + PC_RG + g * 64 + ch0);
        const float* mw = P.in[I_MIXW] + l * 1024 + 384 + g * 64 + ch0;
        u32x4 o;
#pragma unroll
        for (int q = 0; q < 4; ++q) { const float g0 = __uint_as_float(gv[q] << 16), g1v = __uint_as_float(gv[q] & 0xFFFF0000u);
            o[q] = pk_bf16(g0 * hv[2 * q] * rstd * mw[2 * q], g1v * hv[2 * q + 1] * rstd * mw[2 * q + 1]); }
        *(u32x4*)(WSP(bf16_t, WS_MRG) + row * 1024 + 384 + g * 64 + ch0) = o;
        LDS_SYNC(); }
}
DEVI void rg_carry(const Ctx& cx) {
    for (int idx = (cx.G - 1 - cx.bid) * NTHR + cx.tid; idx < NB * 2 * 384; idx += cx.G * NTHR) {
        const int ch = idx % 384, dir = (idx / 384) & 1, b = idx / 768;
        float A[RGC], B[RGC];
#pragma unroll
        for (int s = 0; s < RGC; ++s) { const int ck = dir == 0 ? s : (s < 4 ? 3 - s : 39 - s);
            const size_t ix = ((size_t)(b * RGC + ck) * 2 + dir) * 384 + ch; A[s] = WSP(float, WS_RGA)[ix]; B[s] = WSP(float, WS_RGB)[ix]; }
        float h = 0.f;
#pragma unroll
        for (int s = 0; s < RGC; ++s) { const int ck = dir == 0 ? s : (s < 4 ? 3 - s : 39 - s);
            const size_t ix = ((size_t)(b * RGC + ck) * 2 + dir) * 384 + ch; WSP(float, WS_RGC)[ix] = h; h = A[s] * h + B[s]; }
    }
}

DEVI int s5_trow(int rowi, int s) { const int b = rowi / S5C, c = rowi % S5C; return c < 8 ? b * CTXL + c * 32 + s : TCTX + b * SEQ + s * 64 + (c - 8); }
DEVI void s5_local_wave(const Ctx& cx, int l, int wu) {
    const int g = wu / 36, mt = (wu % 36) / 4, nt = wu % 4;
    const bf16_t* Pp = WSP(bf16_t, WS_P) + PC_S5 + g * 16;
    const bf16_t* we = WSP(bf16_t, WS_WE) + (size_t)(l * 16 + g) * 256 * 512 + (size_t)nt * 64 * 512;
    f32x4 acc[4][4];
    wave_gemm<4, 4>(cx.lane, 512, [&](int row, int k) { return ldg8(Pp + (size_t)s5_trow(mt * 64 + row, k >> 4) * NP + (k & 15)); },
                         [&](int row, int k) { return ldg8(we + (size_t)row * 512 + k); }, acc);
    const int fr = cx.lane & 15, fq = cx.lane >> 4;
#pragma unroll
    for (int m = 0; m < 4; ++m)
#pragma unroll
        for (int n = 0; n < 4; ++n) *(f32x4*)(WSP(float, WS_SLOC) + ((size_t)g * S5R + mt * 64 + m * 16 + fr) * 256 + nt * 64 + n * 16 + 4 * fq) = acc[m][n];
}
DEVI void s5_carry(const Ctx& cx, int l) {
    for (int idx = cx.bid * NTHR + cx.tid; idx < NB * 16 * 2 * 64; idx += cx.G * NTHR) {
        const int n = idx & 63, d = (idx >> 6) & 1, g = (idx >> 7) & 15, b = idx >> 11;
        const f32x2 a32 = WSP(f32x2, WS_PW)[(size_t)(((l * 16 + g) * 2 + d) * 64 + n) * 33 + 32];
        float sr = 0.f, si = 0.f;
#pragma unroll 1
        for (int s0 = 0; s0 < S5C; s0 += 24) {
            float lr[24], li[24];
#pragma unroll
            for (int j = 0; j < 24; ++j) { const int s = s0 + j, c = d == 0 ? s : (s < 8 ? 7 - s : 79 - s);
                const size_t ix = ((size_t)g * S5R + b * S5C + c) * 256 + d * 128 + n; lr[j] = WSP(float, WS_SLOC)[ix]; li[j] = WSP(float, WS_SLOC)[ix + 64]; }
#pragma unroll
            for (int j = 0; j < 24; ++j) { const int s = s0 + j, c = d == 0 ? s : (s < 8 ? 7 - s : 79 - s);
                const size_t ix = ((size_t)g * S5R + b * S5C + c) * 256 + d * 128 + n;
                WSP(bf16_t, WS_SIN)[ix] = f2bf(sr); WSP(bf16_t, WS_SIN)[ix + 64] = f2bf(si);
                const float nr = a32.x * sr - a32.y * si + lr[j], ni = a32.x * si + a32.y * sr + li[j]; sr = nr; si = ni; }
        }
    }
}
DEVI void s5_out_wave(const Ctx& cx, int l, int wu) {
    const int g = wu / 72, mt = (wu % 72) / 8, nt = wu % 8;
    const bf16_t* Pp = WSP(bf16_t, WS_P) + PC_S5 + g * 16;
    const bf16_t* sin_ = WSP(bf16_t, WS_SIN) + (size_t)g * S5R * 256;
    const bf16_t* wy = WSP(bf16_t, WS_WY) + (size_t)(l * 16 + g) * 512 * 768 + (size_t)nt * 64 * 768;
    f32x4 acc[4][4];
    wave_gemm<4, 4>(cx.lane, 768, [&](int row, int k) { return k < 512 ? ldg8(Pp + (size_t)s5_trow(mt * 64 + row, k >> 4) * NP + (k & 15)) : ldg8(sin_ + (size_t)(mt * 64 + row) * 256 + (k - 512)); },
                         [&](int row, int k) { return ldg8(wy + (size_t)row * 768 + k); }, acc);
    const int fr = cx.lane & 15, fq = cx.lane >> 4;
#pragma unroll
    for (int m = 0; m < 4; ++m)
#pragma unroll
        for (int n = 0; n < 4; ++n) { const int trow = s5_trow(mt * 64 + m * 16 + fr, nt * 4 + n);
            u32x2 w; w.x = pk_bf16(gelu_tanh(acc[m][n][0]), gelu_tanh(acc[m][n][1])); w.y = pk_bf16(gelu_tanh(acc[m][n][2]), gelu_tanh(acc[m][n][3]));
            *(u32x2*)(WSP(bf16_t, WS_GS) + (size_t)trow * 256 + g * 16 + 4 * fq) = w; }
}
DEVI void s5_glu_wave(const Ctx& cx, int l, int wu) {
    const int mt = wu / 4, nt = wu % 4;
    const bf16_t* gs = WSP(bf16_t, WS_GS) + (size_t)mt * 64 * 256;
    const bf16_t* wg = WSP(bf16_t, WS_WGLU) + (size_t)l * 65536 + (size_t)nt * 64 * 256;
    f32x4 acc[4][4];
    wave_gemm<4, 4>(cx.lane, 256, [&](int row, int k) { return ldg8(gs + (size_t)row * 256 + k); }, [&](int row, int k) { return ldg8(wg + (size_t)row * 256 + k); }, acc);
    const int fr = cx.lane & 15, fq = cx.lane >> 4;
#pragma unroll
    for (int n = 0; n < 4; ++n) { const int col = nt * 64 + n * 16 + 4 * fq;
        const f32x4 gb = *(const f32x4*)(cx.p->in[I_S5GB] + l * 256 + col), mw = *(const f32x4*)(cx.p->in[I_MIXW] + l * 1024 + 768 + col);
#pragma unroll
        for (int m = 0; m < 4; ++m) { const size_t trow = (size_t)mt * 64 + m * 16 + fr;
            const u32x2 gv = *(const u32x2*)(WSP(bf16_t, WS_GS) + trow * 256 + col);
            const float gq[4] = {__uint_as_float(gv.x << 16), __uint_as_float(gv.x & 0xFFFF0000u), __uint_as_float(gv.y << 16), __uint_as_float(gv.y & 0xFFFF0000u)};
            float o[4]; float ss = 0.f;
#pragma unroll
            for (int j = 0; j < 4; ++j) { o[j] = gq[j] * frcp(1.0f + __expf(-(acc[m][n][j] + gb[j]))); ss += o[j] * o[j]; }
            ss += shx<16>(ss, cx.lane); ss += shx<32>(ss, cx.lane);
            const float rstd = rsqrtf(ss * (1.0f / 16.0f) + EPS);
            u32x2 w; w.x = pk_bf16(o[0] * rstd * mw[0], o[1] * rstd * mw[1]); w.y = pk_bf16(o[2] * rstd * mw[2], o[3] * rstd * mw[3]);
            *(u32x2*)(WSP(bf16_t, WS_MRG) + trow * 1024 + 768 + col) = w; } }
}

#ifndef PH_DUP2
#define PH_DUP2 0
#endif
#define REP_(k) for (int rep_ = 0; rep_ < 1 + ((PH_DUP2 >> (k)) & 1); ++rep_)
DEVI void ph_mix_local(const Ctx& cx, int l) {
    REP_(0) for (int u = cx.bid; u < NB * 4 * MLC; u += cx.G) ml_local_unit(cx, l, u / (4 * MLC), (u / MLC) % 4, u % MLC);
    REP_(1) { const int off = (NB * 4 * MLC) % cx.G; const int first = (cx.bid - off + cx.G) % cx.G;
      for (int u = first; u < NB * RGC * 6; u += cx.G) rg_unit(cx, l, u / (RGC * 6), (u / 6) % RGC, u % 6, 0); }
    REP_(2) { const int off = (NB * 4 * MLC + NB * RGC * 6) % cx.G; const int first = (cx.bid - off + cx.G) % cx.G;
      for (int wu = first * 8 + cx.wave; wu < 16 * 36; wu += cx.G * 8) s5_local_wave(cx, l, wu); }
}
DEVI void ph_mix_carry(const Ctx& cx, int l) { ml_carry(cx); rg_carry(cx); s5_carry(cx, l); }
DEVI void ph_mix_out(const Ctx& cx, int l) {
    const bool last = (l == DEPTH - 1);
    REP_(3) for (int u = cx.bid; u < NB * 4 * MLC; u += cx.G) { const int c = u % MLC; if (last && c < 2) continue; ml_out_unit(cx, l, u / (4 * MLC), (u / MLC) % 4, c); }
    REP_(4) { const int off = (NB * 4 * MLC) % cx.G; const int first = (cx.bid - off + cx.G) % cx.G;
      for (int u = first; u < NB * RGC * 6; u += cx.G) { const int ck = (u / 6) % RGC; if (last && ck < 4) continue; rg_unit(cx, l, u / (RGC * 6), ck, u % 6, 1); } }
    REP_(5) { const int off = (NB * 4 * MLC + NB * RGC * 6) % cx.G; const int first = (cx.bid - off + cx.G) % cx.G;
      for (int wu = first * 8 + cx.wave; wu < 16 * 72; wu += cx.G * 8) s5_out_wave(cx, l, wu); }
}
DEVI void ph_glu(const Ctx& cx, int l) {
    for (int wu = cx.bid * 8 + cx.wave; wu < (TT / 64) * 4; wu += cx.G * 8) s5_glu_wave(cx, l, wu);
}

DEVI unsigned st_launder(unsigned s_addr) { unsigned a; asm volatile("v_mov_b32 %0, %1" : "=v"(a) : "s"(s_addr)); return a; }
constexpr int N_STEPS = 3 + 10 * DEPTH + 1;
__global__ void __launch_bounds__(NTHR, 2) mk_fwd(Params p) {
    extern __shared__ __attribute__((aligned(16))) unsigned char lds_raw[];
    Ctx cx; cx.p = &p; cx.ws = p.ws; cx.lds = (LAS unsigned char*)lds_raw; cx.tid = threadIdx.x; cx.lane = cx.tid & 63;
    cx.wave = __builtin_amdgcn_readfirstlane((int)threadIdx.x >> 6); cx.G = gridDim.x; cx.bid = blockIdx.x;
    volatile LAS unsigned* st = (volatile LAS unsigned*)(cx.lds + LDS_BYTES - 16);
    const unsigned st_s = (unsigned)__builtin_amdgcn_readfirstlane((int)(unsigned)(size_t)(LAS unsigned*)(cx.lds + LDS_BYTES - 16));
#define ST_P ((volatile LAS unsigned*)(size_t)st_launder(st_s))
    if (cx.tid == 0) { st[0] = 0u; st[1] = 0u; st[2] = (unsigned)p.lo; st[3] = (unsigned)p.hi; }
    __syncthreads();
    (void)xcd_barrier_post((unsigned*)(p.ws + WS_CTL) + CW_BAR, st);
#define GRID_BAR() do { XcdBarrier b_; b_.bar = (unsigned*)(p.ws + WS_CTL) + CW_BAR; b_.x = (unsigned)__builtin_amdgcn_readfirstlane((int)xb_xcc_id()); b_.st = ST_P; xcd_barrier(b_); } while (0)
#ifndef PH_MASK
#define PH_MASK 0xFFFF
#endif
#ifndef PH_DUP
#define PH_DUP 0
#endif
#define STEP_(id, k, call) do { const int lo_ = __builtin_amdgcn_readfirstlane((int)ST_P[2]), hi_ = __builtin_amdgcn_readfirstlane((int)ST_P[3]); if (lo_ <= (k) && (k) < hi_) { if ((PH_MASK >> (id)) & 1) { const Ctx cl = relaunder(cx); call; } if ((PH_DUP >> (id)) & 1) { GRID_BAR(); const Ctx cl = relaunder(cx); call; } if ((k) + 1 < hi_) GRID_BAR(); } } while (0)
    STEP_(0, 0, ph_pro_a(cl));
    STEP_(1, 1, ph_pro_b(cl));
    STEP_(2, 2, ph_pro_c(cl));
#pragma unroll 1
    for (int l = 0; l < DEPTH; ++l) {
        const int s0 = 3 + 10 * l;
        STEP_(3, s0 + 0, ph_norm1(cl, l));
        STEP_(4, s0 + 1, ph_inproj(cl, l));
        STEP_(5, s0 + 2, ph_mix_local(cl, l));
        STEP_(6, s0 + 3, ph_mix_carry(cl, l));
        STEP_(7, s0 + 4, ph_mix_out(cl, l));
        STEP_(8, s0 + 5, ph_glu(cl, l));
        STEP_(9, s0 + 6, ph_outproj(cl, l));
        STEP_(10, s0 + 7, ph_norm2(cl, l));
        STEP_(11, s0 + 8, ph_moe_gu(cl, l));
        STEP_(12, s0 + 9, ph_moe_dn(cl, l));
    }
    STEP_(13, N_STEPS - 1, ph_norm1(cl, DEPTH));
#undef STEP_
}

extern "C" void kernel_launch(void* const* d_in, const int* in_sizes, int n_in, void* d_out, int out_size, void* d_ws, size_t ws_size, hipStream_t stream) {
    static int grid = 0;
    if (grid == 0) {
        if (n_in != 36 || out_size != TLAT * DM || ws_size < WS_END) { fprintf(stderr, "kernel_launch: unexpected problem (n_in %d, out %d, ws %zu < %zu)\n", n_in, out_size, ws_size, (size_t)WS_END); grid = -1; return; }
        int dev = 0, cus = 0, per_cu = 0;
        if (hipGetDevice(&dev) != hipSuccess || hipDeviceGetAttribute(&cus, hipDeviceAttributeMultiprocessorCount, dev) != hipSuccess) { grid = -1; return; }
        if (hipFuncSetAttribute((const void*)mk_fwd, hipFuncAttributeMaxDynamicSharedMemorySize, LDS_BYTES) != hipSuccess) { fprintf(stderr, "kernel_launch: hipFuncSetAttribute failed\n"); grid = -1; return; }
        if (hipOccupancyMaxActiveBlocksPerMultiprocessor(&per_cu, (const void*)mk_fwd, NTHR, LDS_BYTES) != hipSuccess || per_cu < 1) { fprintf(stderr, "kernel_launch: occupancy query says %d blocks per CU\n", per_cu); }
        (void)hipGetLastError();
        grid = cus;
    }
    if (grid < 0) return;
    (void)hipMemsetAsync((char*)d_ws + WS_CTL, 0, CTL_BYTES, stream);
    Params p{};
    for (int i = 0; i < 36; ++i) p.in[i] = (const float*)d_in[i];
    p.out = (float*)d_out; p.ws = (unsigned char*)d_ws;
#if MK_FUSED
    p.lo = 0; p.hi = N_STEPS;
    hipLaunchKernelGGL(mk_fwd, dim3(grid), dim3(NTHR), LDS_BYTES, stream, p);
#else
    for (int k = 0; k < N_STEPS; ++k) { p.lo = k; p.hi = k + 1; hipLaunchKernelGGL(mk_fwd, dim3(grid), dim3(NTHR), LDS_BYTES, stream, p); }
#endif
}
```

```cpp
#include <hip/hip_runtime.h>
#include <stdint.h>
#include <stdio.h>

#ifndef MK_FUSED
#define MK_FUSED 1
#endif

typedef unsigned short bf16_t;
typedef short bf16x8 __attribute__((ext_vector_type(8)));
typedef float f32x4 __attribute__((ext_vector_type(4)));
typedef float f32x2 __attribute__((ext_vector_type(2)));
typedef unsigned u32x4 __attribute__((ext_vector_type(4)));
typedef unsigned u32x2 __attribute__((ext_vector_type(2)));
typedef int i32x4 __attribute__((ext_vector_type(4)));
typedef int i32x8 __attribute__((ext_vector_type(8)));
#define LAS __attribute__((address_space(3)))
#define DEVI __device__ __forceinline__

constexpr int DM = 1024, NB = 8, SEQ = 2048, CTXL = 256, DEPTH = 4;
constexpr int TCTX = NB * CTXL, TLAT = NB * SEQ, TT = TCTX + TLAT;
constexpr int DIN = 2576, NP = 2560;
constexpr int NE = 32;
constexpr int PMAX = 81920;
constexpr int NTHR = 512;
constexpr int LDS_BYTES = 152 * 1024;
constexpr float EPS = 1e-6f;
constexpr float W8_SCALE = 32.0f, W8_INV = 0.03125f;
constexpr float Y8_SCALE = 8.0f, Y8_INV = 0.125f;
constexpr int PC_Q = 0, PC_K = 384, PC_V = 768, PC_O = 1152, PC_RX = 1536, PC_RG = 1920, PC_S5 = 2304;
constexpr int MLC = 18;
constexpr int RGC = 36;
constexpr int S5C = 72, S5R = NB * S5C;

constexpr size_t al256(size_t x) { return (x + 255) & ~(size_t)255; }
constexpr size_t WS_CTL   = 0;
constexpr size_t CTL_BYTES = 65536;
constexpr size_t CW_BAR = 0;
constexpr size_t CW_CNT = 4096;
constexpr size_t WS_WIN   = al256(WS_CTL + CTL_BYTES);
constexpr size_t WS_WOUT  = al256(WS_WIN + (size_t)DEPTH * NP * 1024 * 2);
constexpr size_t WS_WGU   = al256(WS_WOUT + (size_t)DEPTH * 1024 * 1024 * 2);
constexpr size_t WS_WD    = al256(WS_WGU + (size_t)DEPTH * NE * 2048 * 1024 * 2);
constexpr size_t WS_MOD   = al256(WS_WD + (size_t)DEPTH * NE * 1024 * 1024 * 2);
constexpr size_t WS_PW    = al256(WS_MOD + (size_t)DEPTH * 9 * 6144 * 4);
constexpr size_t WS_BB    = al256(WS_PW + (size_t)DEPTH * 16 * 2 * 64 * 33 * 8);
constexpr size_t WS_KT    = al256(WS_BB + (size_t)DEPTH * 16 * 2 * 64 * 16 * 8);
constexpr size_t WS_WY    = al256(WS_KT + (size_t)DEPTH * 16 * 2 * 32 * 256 * 4);
constexpr size_t WS_WE    = al256(WS_WY + (size_t)DEPTH * 16 * 512 * 768 * 2);
constexpr size_t WS_WRG   = al256(WS_WE + (size_t)DEPTH * 16 * 256 * 512 * 2);
constexpr size_t WS_WGLU  = al256(WS_WRG + (size_t)DEPTH * 6 * 256 * 64 * 2);
constexpr size_t WS_XS    = al256(WS_WGLU + (size_t)DEPTH * 256 * 256 * 2);
constexpr size_t WS_XMID  = al256(WS_XS + (size_t)TT * 1024 * 4);
constexpr size_t WS_H     = al256(WS_XMID + (size_t)TT * 1024 * 4);
constexpr size_t WS_GT    = al256(WS_H + (size_t)TT * 1024 * 2);
constexpr size_t WS_P     = al256(WS_GT + (size_t)TT * 16 * 4);
constexpr size_t WS_GB    = al256(WS_P + (size_t)TT * NP * 2);
constexpr size_t WS_GU    = al256(WS_GB + (size_t)TT * 8 * 4);
constexpr size_t WS_GCM   = al256(WS_GU + (size_t)TT * 8 * 4);
constexpr size_t WS_MSC   = al256(WS_GCM + (size_t)TT * 8 * 4);
constexpr size_t WS_CLOC  = al256(WS_MSC + (size_t)8 * 4 * 18 * 2 * 2 * 4);
constexpr size_t WS_NLOC  = al256(WS_CLOC + (size_t)8 * 4 * 18 * 2 * 9216 * 4);
constexpr size_t WS_C0    = al256(WS_NLOC + (size_t)8 * 4 * 18 * 2 * 96 * 4);
constexpr size_t WS_N0    = al256(WS_C0 + (size_t)8 * 4 * 18 * 2 * 9216 * 2);
constexpr size_t WS_M0    = al256(WS_N0 + (size_t)8 * 4 * 18 * 2 * 96 * 4);
constexpr size_t WS_RGA   = al256(WS_M0 + (size_t)8 * 4 * 18 * 2 * 4);
constexpr size_t WS_RGB   = al256(WS_RGA + (size_t)8 * 36 * 2 * 384 * 4);
constexpr size_t WS_RGC   = al256(WS_RGB + (size_t)8 * 36 * 2 * 384 * 4);
constexpr size_t WS_SLOC  = al256(WS_RGC + (size_t)8 * 36 * 2 * 384 * 4);
constexpr size_t WS_SIN   = al256(WS_SLOC + (size_t)16 * 576 * 256 * 4);
constexpr size_t WS_GS    = al256(WS_SIN + (size_t)16 * 576 * 256 * 2);
constexpr size_t WS_MRG   = al256(WS_GS + (size_t)TT * 256 * 2);
constexpr size_t WS_ELIST = al256(WS_MRG + (size_t)TT * 1024 * 2);
constexpr size_t WS_GLIST = al256(WS_ELIST + (size_t)NE * TT * 4);
constexpr size_t WS_TINFO = al256(WS_GLIST + (size_t)NE * TT * 4);
constexpr size_t WS_ACT   = al256(WS_TINFO + (size_t)TT * 4 * 4);
constexpr size_t WS_YPAD  = al256(WS_ACT + (size_t)PMAX * 1024 * 2);
constexpr size_t WS_BIN2  = al256(WS_YPAD + (size_t)PMAX * 1024 * 2);
constexpr size_t WS_HLO   = al256(WS_BIN2 + (size_t)DEPTH * NP * 4);
constexpr size_t WS_WGT   = al256(WS_HLO + (size_t)TT * 1024 * 2);
constexpr size_t WS_RWH   = al256(WS_WGT + (size_t)DEPTH * 16 * 1024 * 2);
constexpr size_t WS_RWL   = al256(WS_RWH + (size_t)DEPTH * 32 * 1024 * 2);
constexpr size_t WS_H8    = al256(WS_RWL + (size_t)DEPTH * 32 * 1024 * 2);
constexpr size_t WS_TGATE = al256(WS_H8 + (size_t)TT * 1024);
constexpr size_t WS_END   = al256(WS_TGATE + (size_t)TT * 4 * 4);

struct Params { const float* in[36]; float* out; unsigned char* ws; int lo, hi; };

enum { I_X = 0, I_C, I_CTX, I_CCTX, I_ADAW, I_ADAB, I_N1W, I_WIN, I_BIN, I_RGCW, I_RGCB, I_RGWA, I_RGBA, I_RGWX, I_RGBX, I_RGLAM,
       I_S5LRE, I_S5LIM, I_S5LDT, I_S5BRE, I_S5BIM, I_S5CRE, I_S5CIM, I_S5D, I_S5GW, I_S5GB, I_MIXW, I_WOUT, I_N2W, I_RW, I_RB,
       I_WGU, I_BGU, I_WD, I_BD, I_FNW };

DEVI bf16_t f2bf(float f) { unsigned u = __float_as_uint(f); u += 0x7FFFu + ((u >> 16) & 1u); return (bf16_t)(u >> 16); }
DEVI float bf2f(bf16_t b) { return __uint_as_float(((unsigned)b) << 16); }
DEVI unsigned pk_bf16(float lo, float hi) { unsigned r; asm("v_cvt_pk_bf16_f32 %0, %1, %2" : "=v"(r) : "v"(lo), "v"(hi)); return r; }
DEVI unsigned pk4_fp8(float a, float b, float c, float d) { int p = __builtin_amdgcn_cvt_pk_fp8_f32(a, b, 0, false); p = __builtin_amdgcn_cvt_pk_fp8_f32(c, d, p, true); return (unsigned)p; }
DEVI float q8(float x) { const int p = __builtin_amdgcn_cvt_pk_fp8_f32(x, x, 0, false); return __builtin_amdgcn_cvt_f32_fp8(p, 0); }
DEVI float frcp(float x) { return __builtin_amdgcn_rcpf(x); }
DEVI float sigmoidf_(float x) { return frcp(1.0f + __expf(-x)); }
DEVI float gelu_tanh(float x) { const float u = 0.7978845608f * (x + 0.044715f * x * x * x); return x * frcp(1.0f + __expf(-2.0f * u)); }
template <int M> DEVI float shx(float v, int lane) {
    if constexpr (M < 32) return __int_as_float(__builtin_amdgcn_ds_swizzle(__float_as_int(v), 0x1F | (M << 10)));
    else return __int_as_float(__builtin_amdgcn_ds_bpermute((lane ^ 32) << 2, __float_as_int(v)));
}
DEVI float shxr(float v, int m, int lane) {
    switch (m) { case 1: return shx<1>(v, lane); case 2: return shx<2>(v, lane); case 4: return shx<4>(v, lane); case 8: return shx<8>(v, lane); case 16: return shx<16>(v, lane); default: return shx<32>(v, lane); }
}
DEVI int shxri(int v, int m, int lane) { return __float_as_int(shxr(__int_as_float(v), m, lane)); }
template <int CTRL, int ROWMASK> DEVI float dpp_(float v) { return __int_as_float(__builtin_amdgcn_update_dpp(0, __float_as_int(v), CTRL, ROWMASK, 0xF, false)); }
DEVI float wave_sum(float v, int) {
    v += dpp_<0xB1, 0xF>(v); v += dpp_<0x4E, 0xF>(v); v += dpp_<0x141, 0xF>(v); v += dpp_<0x140, 0xF>(v);
    v += dpp_<0x142, 0xA>(v); v += dpp_<0x143, 0xC>(v);
    return __int_as_float(__builtin_amdgcn_readlane(__float_as_int(v), 63));
}
DEVI float log1p_(float e) { return e < 0.06f ? e * (1.0f - e * (0.5f - e * (0.33333334f - e * 0.25f))) : __logf(1.0f + e); }
#define LDS_SYNC() do { asm volatile("s_waitcnt lgkmcnt(0)" ::: "memory"); __builtin_amdgcn_s_barrier(); asm volatile("" ::: "memory"); } while (0)
DEVI int mod_row(int row) { return row < TCTX ? 8 : (row - TCTX) / SEQ; }

#define XB_TMO      128
#define XB_XCNT(j)  (256  + 64 * (j))
#define XB_XSUB(j)  (1280 + 64 * (j))
#define XB_XGEN(j)  (2304 + 64 * (j))
#define XB_TOP      3328
#define XB_TOPGEN   3392
#define XCD_BAR_WORDS 3456
#define XB_SPIN_CAP (1u << 18)
__device__ __forceinline__ unsigned xb_ld(unsigned* p)              { return __hip_atomic_load(p, __ATOMIC_RELAXED, __HIP_MEMORY_SCOPE_AGENT); }
__device__ __forceinline__ unsigned xb_add(unsigned* p, unsigned v) { return __hip_atomic_fetch_add(p, v, __ATOMIC_RELAXED, __HIP_MEMORY_SCOPE_AGENT); }
__device__ __forceinline__ unsigned xb_xcc_id() { return (unsigned)__builtin_amdgcn_s_getreg((3 << 11) | 20) & 0xFu; }
#define XB_SPIN(cond, bar) do { unsigned _sp = 0; while (cond) { __builtin_amdgcn_s_sleep(1); \
    if ((++_sp & 255u) == 0u) { if (xb_ld(&(bar)[XB_TMO])) break; if (_sp > XB_SPIN_CAP) { atomicAdd(&(bar)[XB_TMO], 1u); break; } } } } while (0)
struct XcdBarrier { unsigned* bar; unsigned x; volatile LAS unsigned* st; };
__device__ __forceinline__ XcdBarrier xcd_barrier_post(unsigned* bar, volatile LAS unsigned* st) {
    XcdBarrier b; b.bar = bar; b.x = xb_xcc_id(); b.st = st;
    if (threadIdx.x == 0) (void)xb_add(&bar[XB_XCNT(b.x)], 1u);
    return b;
}
__device__ __forceinline__ void xcd_barrier_complete(unsigned* bar, unsigned x, unsigned& nloc, unsigned& nx) {
    const unsigned G = gridDim.x * gridDim.y * gridDim.z;
    unsigned sum, cnt, mine, sp = 0u;
    for (;;) {
        sum = 0u; cnt = 0u; mine = 0u;
#pragma unroll
        for (unsigned j = 0; j < 16; ++j) { const unsigned c = xb_ld(&bar[XB_XCNT(j)]); sum += c; cnt += (c > 0u) ? 1u : 0u; mine = (j == x) ? c : mine; }
        if (sum == G) break;
        __builtin_amdgcn_s_sleep(1);
        if ((++sp & 255u) == 0u) { if (xb_ld(&bar[XB_TMO])) break; if (sp > XB_SPIN_CAP) { atomicAdd(&bar[XB_TMO], 1u); break; } }
    }
    nloc = mine > 0u ? mine : 1u; nx = cnt > 0u ? cnt : 1u;
}
__device__ __forceinline__ void xcd_barrier(const XcdBarrier& b) {
    asm volatile("s_waitcnt vmcnt(0)" ::: "memory");
    __syncthreads();
    if (threadIdx.x == 0) {
        unsigned* bar = b.bar;
        __builtin_amdgcn_s_waitcnt(0);
        unsigned nloc = b.st[0], nx = b.st[1];
        if (nloc == 0u) { xcd_barrier_complete(bar, b.x, nloc, nx); b.st[0] = nloc; b.st[1] = nx; }
        const unsigned old = xb_add(&bar[XB_XSUB(b.x)], 1u);
        const unsigned gen = old / nloc;
        if (old + 1u == (gen + 1u) * nloc) {
            __builtin_amdgcn_fence(__ATOMIC_RELEASE, "agent");
            asm volatile("s_waitcnt vmcnt(0)" ::: "memory");
            const unsigned og = xb_add(&bar[XB_TOP], 1u);
            const unsigned tg = og / nx;
            if (og + 1u == (tg + 1u) * nx) xb_add(&bar[XB_TOPGEN], 1u);
            else XB_SPIN(xb_ld(&bar[XB_TOPGEN]) == tg, bar);
            __builtin_amdgcn_fence(__ATOMIC_ACQUIRE, "agent");
            xb_add(&bar[XB_XGEN(b.x)], 1u);
            asm volatile("s_waitcnt vmcnt(0)" ::: "memory");
        } else {
            XB_SPIN(xb_ld(&bar[XB_XGEN(b.x)]) == gen, bar);
            __builtin_amdgcn_fence(__ATOMIC_ACQUIRE, "agent");
            asm volatile("s_waitcnt vmcnt(0)" ::: "memory");
        }
    }
    __syncthreads();
}

namespace g1 {
constexpr int BM = 256, BK = 64, HALF = 128, HTB = HALF * BK * 2, STAGE_BYTES = 8 * HTB, K = 1024, NT = K / BK;
DEVI int lds_byte(int r, int c) { const int st = (r >> 4) * 2 + (c >> 5), rr = r & 15, cc = c & 31, ob = rr * 64 + cc * 2; return st * 1024 + (ob ^ (((ob >> 9) & 1) << 5)); }
DEVI void stage_rc(int b, int& R, int& C) { const int st = b / 1024, sb = b % 1024, swz = sb ^ (((sb >> 9) & 1) << 5); R = (st >> 1) * 16 + swz / 64; C = (st & 1) * 32 + (swz % 64) / 2; }
DEVI int perm32(int rho) { const int n = rho >> 4, i = rho & 15; return 8 * (i >> 2) + 4 * n + (i & 3); }

struct Unit {
    const char* A;
    const int* list;
    int nvalid;
    const char* B;
    int pm, pn, e;
};

template <bool F8> struct FragT { typedef bf16x8 T; static constexpr int NK = 2; };
template <> struct FragT<true> { typedef i32x8 T; static constexpr int NK = 1; };
template <bool GATHER, int KB>
DEVI void a_offsets(const Unit& u, int tid, unsigned (&v)[2][2]) {
    int tz = tid; asm volatile("" : "+v"(tz));
#pragma unroll
    for (int i = 0; i < 2; ++i) {
        int R, C; stage_rc(tz * 16 + i * 8192, R, C);
#pragma unroll
        for (int h = 0; h < 2; ++h) {
            const int r = h * HALF + R;
            int src = r;
            if (GATHER) { const int nv = u.nvalid > 256 ? 256 : u.nvalid; const int ld_ = u.list[r < nv ? r : nv - 1]; src = (r < nv) ? ld_ : 0; }
            v[h][i] = (unsigned)src * (unsigned)KB + (unsigned)(C * 2);
        }
    }
}
DEVI void a_request(const Unit& u, int tid, int (&raw)[2][2]) {
    int tz = tid; asm volatile("" : "+v"(tz));
    const int nv = u.nvalid > 256 ? 256 : u.nvalid;
#pragma unroll
    for (int i = 0; i < 2; ++i) { int R, C; stage_rc(tz * 16 + i * 8192, R, C);
#pragma unroll
        for (int h = 0; h < 2; ++h) { const int r = h * HALF + R; raw[h][i] = u.list[r < nv ? r : nv - 1]; } }
}
template <int KB>
DEVI void a_finish(int nvalid, int tid, int (&raw)[2][2], unsigned (&v)[2][2]) {
    asm volatile("" : "+v"(raw[0][0]), "+v"(raw[0][1]), "+v"(raw[1][0]), "+v"(raw[1][1]));
    int tz = tid; asm volatile("" : "+v"(tz));
    const int nv = nvalid > 256 ? 256 : nvalid;
#pragma unroll
    for (int i = 0; i < 2; ++i) { int R, C; stage_rc(tz * 16 + i * 8192, R, C);
#pragma unroll
        for (int h = 0; h < 2; ++h) { const int r = h * HALF + R; const int src = (r < nv) ? raw[h][i] : 0; v[h][i] = (unsigned)src * (unsigned)KB + (unsigned)(C * 2); } }
}

template <class Sched, class Epi, bool GATHER, bool FP8 = false>
DEVI void gemm_phase(LAS unsigned char* lds, const int tid, const Sched& S, const Epi& E) {
    constexpr int KB = FP8 ? 1024 : 2048, NTK = KB / 128, NK = FragT<FP8>::NK;
    typedef typename FragT<FP8>::T frag_t;
    int sc1 = 0x7F7F7F7F; asm volatile("" : "+v"(sc1));
    const int wid = __builtin_amdgcn_readfirstlane(tid >> 6), lane = tid & 63, wr = wid >> 2, wc = wid & 3, fr = lane & 15, fq = lane >> 4;
    unsigned voffB[2];
#pragma unroll
    for (int i = 0; i < 2; ++i) { int R, C; stage_rc(tid * 16 + i * 8192, R, C); const int Rb = Epi::PERM ? ((R & ~31) + perm32(R & 31)) : R; voffB[i] = (unsigned)(Rb * KB + C * 2); }
    constexpr size_t kstep = (size_t)(BK * 2);
    constexpr size_t hstep = (size_t)HALF * KB;
    const unsigned ldsw = (unsigned)wid * 1024u;
    const int aoff = FP8 ? lds_byte(wr * 64 + fr, fq * 16) : lds_byte(wr * 64 + fr, fq * 8), boff = FP8 ? lds_byte(wc * 32 + fr, fq * 16) : lds_byte(wc * 32 + fr, fq * 8);
    const int sw16 = FP8 ? 16 * (fq & 1) : 0;
    unsigned pa_ = (unsigned)(size_t)(lds + aoff) + sw16, pb_ = (unsigned)(size_t)(lds + 65536 + boff) + sw16, pa2_ = (unsigned)(size_t)(lds + aoff) + (16 - sw16), pb2_ = (unsigned)(size_t)(lds + 65536 + boff) + (16 - sw16);
    asm volatile("" : "+v"(pa_), "+v"(pb_), "+v"(pa2_), "+v"(pb2_));
    LAS unsigned char* const pa = (LAS unsigned char*)(size_t)pa_; LAS unsigned char* const pb = (LAS unsigned char*)(size_t)pb_;
    LAS unsigned char* const pa2 = (LAS unsigned char*)(size_t)pa2_; LAS unsigned char* const pb2 = (LAS unsigned char*)(size_t)pb2_;
#define G1_SA(b, h) (((b) * 2 + (h)) * HTB)
#define G1_SB(b, h) ((4 + (b) * 2 + (h)) * HTB)
#define G1_STAGE2(bufoff, gbase, v0, v1) do { \
        __builtin_amdgcn_global_load_lds((const unsigned*)((const char*)(gbase) + (v0)), (LAS unsigned*)(lds + (bufoff) + ldsw), 16, 0, 0); \
        __builtin_amdgcn_global_load_lds((const unsigned*)((const char*)(gbase) + (v1)), (LAS unsigned*)(lds + (bufoff) + ldsw + 8192), 16, 0, 0); } while (0)
#define G1_LDFRAG(dst, ptr, ptr2) do { if constexpr (FP8) { const i32x4 lo_ = *(const LAS i32x4*)(ptr), hi_ = *(const LAS i32x4*)(ptr2); dst = __builtin_shufflevector(lo_, hi_, 0, 1, 2, 3, 4, 5, 6, 7); } \
        else { dst = *(const LAS frag_t*)(ptr); } } while (0)
#define G1_LDA(dst, b, h) do { _Pragma("unroll") for (int m = 0; m < 4; ++m) _Pragma("unroll") for (int k = 0; k < NK; ++k) G1_LDFRAG(dst[m][k], pa + (G1_SA(b, h) + m * 2048 + k * 1024), pa2 + (G1_SA(b, h) + m * 2048 + k * 1024)); } while (0)
#define G1_LDB(dst, b, h) do { _Pragma("unroll") for (int n = 0; n < 2; ++n) _Pragma("unroll") for (int k = 0; k < NK; ++k) G1_LDFRAG(dst[n][k], pb + (G1_SB(b, h) - 65536 + n * 2048 + k * 1024), pb2 + (G1_SB(b, h) - 65536 + n * 2048 + k * 1024)); } while (0)
#define G1_MFMA(c_, b_, a_) do { if constexpr (FP8) asm volatile("v_mfma_scale_f32_16x16x128_f8f6f4 %0, %1, %2, %0, %3, %3 op_sel_hi:[0,0,0]" : "+v"(c_) : "v"(b_), "v"(a_), "v"(sc1)); \
        else c_ = __builtin_amdgcn_mfma_f32_16x16x32_bf16(b_, a_, c_, 0, 0, 0); } while (0)
#define G1_MMA(ai, bj, At, Bt) do { __builtin_amdgcn_s_setprio(1); _Pragma("unroll") for (int m = 0; m < 4; ++m) _Pragma("unroll") for (int n = 0; n < 2; ++n) _Pragma("unroll") for (int k = 0; k < NK; ++k) \
        G1_MFMA(acc[ai][bj][m][n], Bt[n][k], At[m][k]); __builtin_amdgcn_s_setprio(0); } while (0)
#define G1_WAIT_V(n) asm volatile("s_waitcnt vmcnt(" #n ")" ::: "memory")
#define G1_WAIT_L(n) asm volatile("s_waitcnt lgkmcnt(" #n ")" ::: "memory")
#define G1_BAR __builtin_amdgcn_s_barrier()
#define G1_SCHED __builtin_amdgcn_sched_barrier(0)
    Unit cur, nxt; int ui = 0;
    if (!S.get(0, cur)) return;
    f32x4 acc[2][2][4][2];
#pragma unroll
    for (int a = 0; a < 2; ++a)
#pragma unroll
        for (int b = 0; b < 2; ++b)
#pragma unroll
            for (int m = 0; m < 4; ++m)
#pragma unroll
                for (int n = 0; n < 2; ++n) acc[a][b][m][n] = (f32x4){0.f, 0.f, 0.f, 0.f};
    frag_t At[4][NK], B0[2][NK], B1[2][NK];
    unsigned vc[2][2], vn[2][2];
    a_offsets<GATHER, KB>(cur, tid, vc);
    const char* cA = cur.A; const char* cB = cur.B;
    LAS unsigned char* const aux = lds + STAGE_BYTES + 2048;
    if constexpr (Epi::LDSC) { if (tid < 256) __builtin_amdgcn_global_load_lds((const unsigned*)(E.cptr(cur, tid)), (LAS unsigned*)(aux + ldsw / 4), 4, 0, 0); }
    G1_STAGE2(G1_SB(0, 0), cB, voffB[0], voffB[1]); G1_STAGE2(G1_SA(0, 0), cA, vc[0][0], vc[0][1]);
    G1_STAGE2(G1_SB(0, 1), cB + hstep, voffB[0], voffB[1]); G1_STAGE2(G1_SA(0, 1), cA, vc[1][0], vc[1][1]);
    if (wr == 1) G1_BAR;
    G1_WAIT_V(4); G1_BAR;
    G1_STAGE2(G1_SB(1, 0), cB + kstep, voffB[0], voffB[1]); G1_STAGE2(G1_SA(1, 0), cA + kstep, vc[0][0], vc[0][1]);
    G1_STAGE2(G1_SB(1, 1), cB + hstep + kstep, voffB[0], voffB[1]);
    G1_WAIT_V(6); G1_BAR;
    for (;;) {
        const bool has_next = S.get(ui + 1, nxt);
        if constexpr (Epi::LDSC) { if (has_next && tid < 256) __builtin_amdgcn_global_load_lds((const unsigned*)(E.cptr(nxt, tid)), (LAS unsigned*)(aux + ((ui + 1) % 3) * 1024 + ldsw / 4), 4, 0, 0); }
        int raw[2][2] = {{0, 0}, {0, 0}};
        if (has_next) { if constexpr (GATHER) a_request(nxt, tid, raw); else a_offsets<GATHER, KB>(nxt, tid, vn); }
        else {
#pragma unroll
            for (int h = 0; h < 2; ++h)
#pragma unroll
                for (int i = 0; i < 2; ++i) vn[h][i] = vc[h][i];
        }
        const char* nA = has_next ? nxt.A : cA; const char* nB = has_next ? nxt.B : cB;
#pragma unroll 1
        for (int t = 0; t < NTK; t += 2) {
            const bool last = (t == NTK - 2);
            const char* a1 = cA + (size_t)(t + 1) * kstep;
            const char* a2 = last ? nA : cA + (size_t)(t + 2) * kstep; const char* b2 = last ? nB : cB + (size_t)(t + 2) * kstep;
            const char* a3 = a2 + kstep; const char* b3 = b2 + kstep;
            unsigned w00 = vc[0][0], w01 = vc[0][1], w10 = vc[1][0], w11 = vc[1][1];
            if (last) { if constexpr (GATHER) { if (has_next) a_finish<KB>(nxt.nvalid, tid, raw, vn); }
                w00 = vn[0][0]; w01 = vn[0][1]; w10 = vn[1][0]; w11 = vn[1][1]; asm volatile("" : "+v"(w00), "+v"(w01), "+v"(w10), "+v"(w11)); }
            G1_LDB(B0, 0, 0); G1_SCHED; G1_LDA(At, 0, 0); G1_STAGE2(G1_SA(1, 1), a1, vc[1][0], vc[1][1]);
            G1_WAIT_L(8); G1_BAR; G1_WAIT_L(0); G1_MMA(0, 0, At, B0); G1_BAR; G1_SCHED;
            G1_LDB(B1, 0, 1); G1_STAGE2(G1_SB(0, 0), b2, voffB[0], voffB[1]);
            G1_BAR; G1_WAIT_L(0); G1_MMA(0, 1, At, B1); G1_BAR;
            G1_LDA(At, 0, 1); G1_STAGE2(G1_SA(0, 0), a2, w00, w01);
            G1_BAR; G1_WAIT_L(0); G1_MMA(1, 0, At, B0); G1_BAR; G1_SCHED;
            G1_STAGE2(G1_SB(0, 1), b2 + hstep, voffB[0], voffB[1]);
            G1_WAIT_V(6); G1_BAR; G1_MMA(1, 1, At, B1); G1_BAR;
            G1_LDB(B0, 1, 0); G1_SCHED; G1_LDA(At, 1, 0); G1_STAGE2(G1_SA(0, 1), a2, w10, w11);
            G1_WAIT_L(8); G1_BAR; G1_WAIT_L(0); G1_MMA(0, 0, At, B0); G1_BAR; G1_SCHED;
            G1_LDB(B1, 1, 1); G1_STAGE2(G1_SB(1, 0), b3, voffB[0], voffB[1]);
            G1_BAR; G1_WAIT_L(0); G1_MMA(0, 1, At, B1); G1_BAR;
            G1_LDA(At, 1, 1); G1_STAGE2(G1_SA(1, 0), a3, w00, w01);
            G1_BAR; G1_WAIT_L(0); G1_MMA(1, 0, At, B0); G1_BAR; G1_SCHED;
            G1_STAGE2(G1_SB(1, 1), b3 + hstep, voffB[0], voffB[1]);
            G1_WAIT_V(6); G1_BAR; G1_MMA(1, 1, At, B1); G1_BAR;
        }
        if constexpr (FP8) asm volatile("s_nop 15\n\ts_nop 15" ::: "memory");
        if constexpr (Epi::LDSC) E(acc, cur, wr, wc, fr, fq, (const LAS float*)(aux + (ui % 3) * 1024)); else E(acc, cur, wr, wc, fr, fq);
        if (!has_next) break;
#pragma unroll
        for (int a = 0; a < 2; ++a)
#pragma unroll
            for (int b = 0; b < 2; ++b)
#pragma unroll
                for (int m = 0; m < 4; ++m)
#pragma unroll
                    for (int n = 0; n < 2; ++n) acc[a][b][m][n] = (f32x4){0.f, 0.f, 0.f, 0.f};
        cur = nxt; cA = nA; cB = nB; ++ui;
#pragma unroll
        for (int h = 0; h < 2; ++h)
#pragma unroll
            for (int i = 0; i < 2; ++i) vc[h][i] = vn[h][i];
    }
    G1_WAIT_V(0);
    if (wr == 0) G1_BAR;
    G1_BAR;
}
}

template <int MT, int NT_, class AF, class BF>
DEVI void wave_gemm(const int lane, int Kdim, const AF& af, const BF& bf, f32x4 (&acc)[MT][NT_]) {
    const int fr = lane & 15, fq = lane >> 4;
#pragma unroll
    for (int m = 0; m < MT; ++m)
#pragma unroll
        for (int n = 0; n < NT_; ++n) acc[m][n] = (f32x4){0.f, 0.f, 0.f, 0.f};
    bf16x8 fa[4][MT], fb[4][NT_];
#define WG_LOAD(S, KK) do { _Pragma("unroll") for (int m = 0; m < MT; ++m) fa[S][m] = af(m * 16 + fr, (KK) + fq * 8); _Pragma("unroll") for (int n = 0; n < NT_; ++n) fb[S][n] = bf(n * 16 + fr, (KK) + fq * 8); } while (0)
#define WG_MMA(S) do { _Pragma("unroll") for (int m = 0; m < MT; ++m) _Pragma("unroll") for (int n = 0; n < NT_; ++n) acc[m][n] = __builtin_amdgcn_mfma_f32_16x16x32_bf16(fb[S][n], fa[S][m], acc[m][n], 0, 0, 0); } while (0)
    WG_LOAD(0, 0); WG_LOAD(1, 32); WG_LOAD(2, 64);
#pragma unroll 1
    for (int k0 = 0; k0 < Kdim; k0 += 128) {
        const bool more = k0 + 128 < Kdim;
        WG_LOAD(3, k0 + 96); WG_MMA(0);
        if (more) WG_LOAD(0, k0 + 128);
        WG_MMA(1);
        if (more) WG_LOAD(1, k0 + 160);
        WG_MMA(2);
        if (more) WG_LOAD(2, k0 + 192);
        WG_MMA(3);
    }
#undef WG_LOAD
#undef WG_MMA
}
DEVI bf16x8 ldg8(const bf16_t* p) { return *(const bf16x8*)p; }

template <int N> struct Log2 { static constexpr int v = 1 + Log2<N / 2>::v; };
template <> struct Log2<1> { static constexpr int v = 0; };
template <int N>
DEVI float reduce_scatter(const int lane, float (&v)[N]) {
    constexpr int LG = Log2<N>::v;
#pragma unroll
    for (int st = 0; st < LG; ++st) {
        const int s = (N / 2) >> st, mask = 32 >> st;
        const bool up = (lane & mask) != 0;
#pragma unroll
        for (int i = 0; i < N / 2; ++i) if (i < s) {
            const float send = up ? v[i] : v[i + s];
            const float keep = up ? v[i + s] : v[i];
            v[i] = keep + shxr(send, mask, lane);
        }
    }
    float r = v[0];
#pragma unroll
    for (int st = LG; st < 6; ++st) r += shxr(r, 32 >> st, lane);
    return r;
}
template <int N>
DEVI int rs_index(int lane) {
    constexpr int LG = Log2<N>::v;
    int idx = 0;
#pragma unroll
    for (int st = 0; st < LG; ++st) if (lane & (32 >> st)) idx += (N / 2) >> st;
    return idx;
}

struct Ctx {
    const Params* p; unsigned char* ws; LAS unsigned char* lds; int tid, lane, wave, G, bid;
};
#define WSP(T, off) ((T*)(cx.ws + (off)))
DEVI Ctx relaunder(const Ctx& c) { Ctx r = c; int ln, td;
    asm volatile("v_mbcnt_lo_u32_b32 %0, -1, 0\n\tv_mbcnt_hi_u32_b32 %0, -1, %0\n\tv_lshl_add_u32 %1, %2, 6, %0" : "=&v"(ln), "=v"(td) : "s"(c.wave));
    r.lane = ln; r.tid = td; return r; }

DEVI void cvt_tile(const Ctx& cx, const float* src, int ld, bf16_t* dst, int n0, int k0, int kind) {
    LAS bf16_t* tile = (LAS bf16_t*)cx.lds;
    const int n4 = (cx.tid & 63) * 4, w8 = (cx.tid >> 6) * 8, n = n0 + n4;
    int sc; float scale = 1.0f;
    if (kind == 0) { sc = n < 1536 ? n : n + 16; if (n >= 384 && n < 768) scale = 0.10206207261596577f; }
    else if (kind == 2) { const int pn = n >> 8, w = n & 255; sc = w < 128 ? pn * 128 + w : 1024 + pn * 128 + (w - 128); }
    else sc = n;
#pragma unroll 1
    for (int sub = 0; sub < 4; sub += 2) {
        f32x4 v[2][8];
#pragma unroll
        for (int s2 = 0; s2 < 2; ++s2)
#pragma unroll
            for (int p = 0; p < 8; ++p) v[s2][p] = __builtin_nontemporal_load((const f32x4*)(src + (size_t)(k0 + (sub + s2) * 64 + w8 + p) * ld + sc));
#pragma unroll
        for (int s2 = 0; s2 < 2; ++s2)
#pragma unroll
            for (int j = 0; j < 4; ++j) { u32x4 w;
                w.x = pk_bf16(v[s2][0][j] * scale, v[s2][1][j] * scale); w.y = pk_bf16(v[s2][2][j] * scale, v[s2][3][j] * scale);
                w.z = pk_bf16(v[s2][4][j] * scale, v[s2][5][j] * scale); w.w = pk_bf16(v[s2][6][j] * scale, v[s2][7][j] * scale);
                *(LAS u32x4*)(tile + (n4 + j) * 264 + (sub + s2) * 64 + w8) = w; }
    }
    LDS_SYNC();
#pragma unroll
    for (int i = 0; i < 16; ++i) { const int idx = cx.tid + NTHR * i, row = idx >> 5, ch = idx & 31;
        const u32x4 o = *(const LAS u32x4*)(tile + row * 264 + ch * 8);
        *(u32x4*)(dst + (size_t)(n0 + row) * 1024 + k0 + ch * 8) = o; }
    LDS_SYNC();
}

DEVI void cvt_tile8(const Ctx& cx, const float* src, int ld, unsigned char* dst, int n0, int k0, int kind) {
    LAS unsigned char* tile = cx.lds;
    const int n4 = (cx.tid & 63) * 4, w8 = (cx.tid >> 6) * 8, n = n0 + n4;
    int sc;
    if (kind == 2) { const int pn = n >> 8, w = n & 255; sc = w < 128 ? pn * 128 + w : 1024 + pn * 128 + (w - 128); }
    else sc = n;
#pragma unroll 1
    for (int sub = 0; sub < 4; sub += 2) {
        f32x4 v[2][8];
#pragma unroll
        for (int s2 = 0; s2 < 2; ++s2)
#pragma unroll
            for (int p = 0; p < 8; ++p) v[s2][p] = __builtin_nontemporal_load((const f32x4*)(src + (size_t)(k0 + (sub + s2) * 64 + w8 + p) * ld + sc));
#pragma unroll
        for (int s2 = 0; s2 < 2; ++s2)
#pragma unroll
            for (int j = 0; j < 4; ++j) { u32x2 w;
                w.x = pk4_fp8(v[s2][0][j] * W8_SCALE, v[s2][1][j] * W8_SCALE, v[s2][2][j] * W8_SCALE, v[s2][3][j] * W8_SCALE);
                w.y = pk4_fp8(v[s2][4][j] * W8_SCALE, v[s2][5][j] * W8_SCALE, v[s2][6][j] * W8_SCALE, v[s2][7][j] * W8_SCALE);
                *(LAS u32x2*)(tile + (n4 + j) * 272 + (sub + s2) * 64 + w8) = w; }
    }
    LDS_SYNC();
#pragma unroll
    for (int i = 0; i < 8; ++i) { const int idx = cx.tid + NTHR * i, row = idx >> 4, ch = idx & 15;
        const u32x4 o = *(const LAS u32x4*)(tile + row * 272 + ch * 16);
        *(u32x4*)(dst + (size_t)(n0 + row) * 1024 + k0 + ch * 16) = o; }
    LDS_SYNC();
}
DEVI void ph_pro_a(const Ctx& cx) {
    const Params& P = *cx.p;
    {
        constexpr int n_in = DEPTH * 10 * 4, n_out = DEPTH * 4 * 4, n_gu = DEPTH * NE * 8 * 4, n_dn = DEPTH * NE * 4 * 4;
        constexpr int total = n_in + n_out + n_gu + n_dn;
        for (int job = cx.bid; job < total; job += cx.G) {
            int j = job;
            if (j < n_in) { const int l = j / 40, r = j % 40, kt = r / 10, nt = r % 10;
                cvt_tile(cx, P.in[I_WIN] + (size_t)l * 1024 * DIN, DIN, WSP(bf16_t, WS_WIN) + (size_t)l * NP * 1024, nt * 256, kt * 256, 0); continue; }
            j -= n_in;
            if (j < n_out) { const int l = j / 16, r = j % 16, kt = r / 4, nt = r % 4;
                cvt_tile(cx, P.in[I_WOUT] + (size_t)l * 1024 * 1024, 1024, WSP(bf16_t, WS_WOUT) + (size_t)l * 1024 * 1024, nt * 256, kt * 256, 1); continue; }
            j -= n_out;
            if (j < n_gu) { const int le = j / 32, r = j % 32, kt = r / 8, nt = r % 8;
                cvt_tile8(cx, P.in[I_WGU] + (size_t)le * 1024 * 2048, 2048, WSP(unsigned char, WS_WGU) + (size_t)le * 2048 * 1024, nt * 256, kt * 256, 2); continue; }
            j -= n_gu;
            { const int le = j / 16, r = j % 16, kt = r / 4, nt = r % 4;
                cvt_tile8(cx, P.in[I_WD] + (size_t)le * 1024 * 1024, 1024, WSP(unsigned char, WS_WD) + (size_t)le * 1024 * 1024, nt * 256, kt * 256, 1); }
        }
    }
    __syncthreads();
    {
        LAS float* sv = (LAS float*)cx.lds;
        LAS float* red = sv + 9 * 1024;
        constexpr int units = DEPTH * 6144 / 64;
        if (cx.bid < units) {
            for (int i = cx.tid; i < 9 * 1024; i += NTHR) { const int r = i >> 10, k = i & 1023; const float c = r < 8 ? P.in[I_C][r * 1024 + k] : P.in[I_CCTX][k]; sv[i] = c / (1.0f + __expf(-c)); }
            __syncthreads();
            for (int u = cx.bid; u < units; u += cx.G) {
                const int l = u / 96, n = (u % 96) * 64 + cx.lane;
                const float* w = P.in[I_ADAW] + (size_t)l * 1024 * 6144 + n;
                float acc[9];
#pragma unroll
                for (int r = 0; r < 9; ++r) acc[r] = 0.f;
                const int kb = cx.wave * 128;
#pragma unroll 4
                for (int k = 0; k < 128; ++k) { const float wv = w[(size_t)(kb + k) * 6144];
#pragma unroll
                    for (int r = 0; r < 9; ++r) acc[r] += sv[r * 1024 + kb + k] * wv; }
#pragma unroll
                for (int r = 0; r < 9; ++r) red[(cx.wave * 9 + r) * 64 + cx.lane] = acc[r];
                __syncthreads();
                for (int i = cx.tid; i < 9 * 64; i += NTHR) { const int r = i >> 6, ln = i & 63; float s = 0.f;
#pragma unroll
                    for (int w8 = 0; w8 < 8; ++w8) s += red[(w8 * 9 + r) * 64 + ln];
                    const int nn = (u % 96) * 64 + ln;
                    WSP(float, WS_MOD)[((size_t)l * 9 + r) * 6144 + nn] = s + P.in[I_ADAB][l * 6144 + nn]; }
                __syncthreads();
            }
        }
    }
    for (int gt = cx.bid * NTHR + cx.tid; gt < DEPTH * 16 * 2 * 64; gt += cx.G * NTHR) {
        const int n = gt & 63, d = (gt >> 6) & 1, g = (gt >> 7) & 15, l = gt >> 11;
        const float dt = expf(P.in[I_S5LDT][(l * 2 + d) * 16 + g]);
        const float lr = P.in[I_S5LRE][((l * 2 + d) * 16 + g) * 64 + n], li = P.in[I_S5LIM][((l * 2 + d) * 16 + g) * 64 + n];
        f32x2* pw = WSP(f32x2, WS_PW) + (size_t)gt * 33;
        float ar = 0.f, ai = 0.f;
        for (int k = 0; k <= 32; ++k) { const float mag = expf(lr * dt * (float)k); float s, c; sincosf(li * dt * (float)k, &s, &c); pw[k] = (f32x2){mag * c, mag * s}; if (k == 1) { ar = mag * c; ai = mag * s; } }
        const float den = lr * lr + li * li;
        const float cr = ((ar - 1.0f) * lr + ai * li) / den, ci = (ai * lr - (ar - 1.0f) * li) / den;
        f32x2* bb = WSP(f32x2, WS_BB) + (size_t)gt * 16;
        for (int q = 0; q < 16; ++q) { const float br = P.in[I_S5BRE][((l * 16 + g) * 64 + n) * 16 + q], bi = P.in[I_S5BIM][((l * 16 + g) * 64 + n) * 16 + q];
            bb[q] = (f32x2){cr * br - ci * bi, cr * bi + ci * br}; }
    }
    for (int i = cx.bid * NTHR + cx.tid; i < DEPTH * 6 * 256 * 64; i += cx.G * NTHR) {
        const int k = i & 63, n = (i >> 6) & 255, g = (i >> 14) % 6, l = (i >> 14) / 6;
        const int j = n & 63, type = (n >> 6) & 1, dir = n >> 7;
        const float* w = type ? P.in[I_RGWX] : P.in[I_RGWA];
        WSP(bf16_t, WS_WRG)[i] = f2bf(w[((((size_t)l * 2 + dir) * 6 + g) * 64 + k) * 64 + j]);
    }
    for (int i = cx.bid * NTHR + cx.tid; i < DEPTH * NP; i += cx.G * NTHR) {
        const int n = i % NP, l = i / NP; const int sc = n < 1536 ? n : n + 16;
        WSP(float, WS_BIN2)[i] = P.in[I_BIN][l * DIN + sc] * ((n >= 384 && n < 768) ? 0.10206207261596577f : 1.0f);
    }
    for (int i = cx.bid * NTHR + cx.tid; i < DEPTH * 16 * 1024; i += cx.G * NTHR) { const int k = i & 1023, n = (i >> 10) & 15, l = i >> 14;
        WSP(bf16_t, WS_WGT)[i] = f2bf(P.in[I_WIN][((size_t)l * 1024 + k) * DIN + 1536 + n]); }
    for (int i = cx.bid * NTHR + cx.tid; i < DEPTH * 32 * 1024; i += cx.G * NTHR) { const int k = i & 1023, n = (i >> 10) & 31, l = i >> 15;
        const float w = P.in[I_RW][((size_t)l * 1024 + k) * 32 + n]; const bf16_t hi = f2bf(w);
        WSP(bf16_t, WS_RWH)[i] = hi; WSP(bf16_t, WS_RWL)[i] = f2bf(w - bf2f(hi)); }
    for (int i = cx.bid * NTHR + cx.tid; i < DEPTH * 256 * 256; i += cx.G * NTHR) {
        const int k = i & 255, n = (i >> 8) & 255, l = i >> 16;
        WSP(bf16_t, WS_WGLU)[i] = f2bf(P.in[I_S5GW][((size_t)l * 256 + k) * 256 + n]);
    }
}

DEVI void ph_pro_b(const Ctx& cx) {
    const Params& P = *cx.p;
    LAS f32x2* pw = (LAS f32x2*)cx.lds;
    LAS f32x2* bb = pw + 64 * 33;
    LAS f32x2* cc = bb + 64 * 16;
    for (int u = cx.bid; u < DEPTH * 16 * 2; u += cx.G) {
        const int lg = u >> 1;
        for (int i = cx.tid; i < 64 * 33; i += NTHR) pw[i] = WSP(f32x2, WS_PW)[(size_t)u * 64 * 33 + i];
        for (int i = cx.tid; i < 64 * 16; i += NTHR) bb[i] = WSP(f32x2, WS_BB)[(size_t)u * 64 * 16 + i];
        for (int i = cx.tid; i < 16 * 64; i += NTHR) cc[i] = (f32x2){P.in[I_S5CRE][(size_t)lg * 1024 + i], P.in[I_S5CIM][(size_t)lg * 1024 + i]};
        __syncthreads();
        const int q = cx.tid & 15, p = (cx.tid >> 4) & 15, tau0 = cx.tid >> 8;
        float acc[16];
#pragma unroll
        for (int i = 0; i < 16; ++i) acc[i] = 0.f;
#pragma unroll 2
        for (int n = 0; n < 64; ++n) { const f32x2 b = bb[n * 16 + q], c = cc[p * 64 + n];
#pragma unroll
            for (int i = 0; i < 16; ++i) { const f32x2 a = pw[n * 33 + tau0 + 2 * i]; const float xr = c.x * a.x - c.y * a.y, xi = c.x * a.y + c.y * a.x; acc[i] += xr * b.x - xi * b.y; } }
#pragma unroll
        for (int i = 0; i < 16; ++i) WSP(float, WS_KT)[(((size_t)u * 32 + tau0 + 2 * i) * 16 + p) * 16 + q] = acc[i];
        __syncthreads();
    }
}

DEVI void ph_pro_c(const Ctx& cx) {
    const Params& P = *cx.p;
    LAS float* kt = (LAS float*)cx.lds;
    LAS f32x2* pw = (LAS f32x2*)(kt + 2 * 32 * 256);
    LAS f32x2* bb = pw + 2 * 64 * 33;
    LAS f32x2* cc = bb + 2 * 64 * 16;
    LAS float* dsk = (LAS float*)(cc + 16 * 64);
    for (int u = cx.bid; u < DEPTH * 16 * 4; u += cx.G) {
        const int lg = u >> 2, qt = u & 3, l = lg >> 4, g = lg & 15;
        for (int i = cx.tid; i < 2 * 32 * 256; i += NTHR) kt[i] = WSP(float, WS_KT)[(size_t)lg * 2 * 32 * 256 + i];
        for (int i = cx.tid; i < 2 * 64 * 33; i += NTHR) pw[i] = WSP(f32x2, WS_PW)[(size_t)lg * 2 * 64 * 33 + i];
        for (int i = cx.tid; i < 2 * 64 * 16; i += NTHR) bb[i] = WSP(f32x2, WS_BB)[(size_t)lg * 2 * 64 * 16 + i];
        for (int i = cx.tid; i < 16 * 64; i += NTHR) cc[i] = (f32x2){P.in[I_S5CRE][(size_t)lg * 1024 + i], P.in[I_S5CIM][(size_t)lg * 1024 + i]};
        if (cx.tid < 16) dsk[cx.tid] = P.in[I_S5D][l * 256 + g * 16 + cx.tid];
        __syncthreads();
        bf16_t* wy = WSP(bf16_t, WS_WY) + ((size_t)lg * 512 + qt * 128) * 768;
        for (int idx = cx.tid; idx < 128 * 768; idx += NTHR) {
            const int k = idx % 768, tp = qt * 128 + idx / 768, t = tp >> 4, p = tp & 15;
            float v;
            if (k < 512) { const int sI = k >> 4, q = k & 15; v = 0.f;
                if (sI <= t) v += kt[(0 * 32 + (t - sI)) * 256 + p * 16 + q];
                if (sI >= t) v += kt[(1 * 32 + (sI - t)) * 256 + p * 16 + q];
                if (sI == t && p == q) v += dsk[p];
            } else { const int kk = k - 512, d = kk >> 7, im = (kk >> 6) & 1, n = kk & 63;
                const int pwr = d == 0 ? t + 1 : 32 - t;
                const f32x2 a = pw[(d * 64 + n) * 33 + pwr], c = cc[p * 64 + n];
                v = im ? -(c.x * a.y + c.y * a.x) : (c.x * a.x - c.y * a.y); }
            wy[idx] = f2bf(v);
        }
        bf16_t* we = WSP(bf16_t, WS_WE) + ((size_t)lg * 256 + qt * 64) * 512;
        for (int idx = cx.tid; idx < 64 * 512; idx += NTHR) {
            const int k = idx & 511, no = qt * 64 + (idx >> 9);
            const int sI = k >> 4, q = k & 15, d = no >> 7, im = (no >> 6) & 1, n = no & 63;
            const int pwr = d == 0 ? 31 - sI : sI;
            const f32x2 a = pw[(d * 64 + n) * 33 + pwr], b2 = bb[(d * 64 + n) * 16 + q];
            we[idx] = f2bf(im ? (a.x * b2.y + a.y * b2.x) : (a.x * b2.x - a.y * b2.y));
        }
        __syncthreads();
    }
}

DEVI void moe_info(const Ctx& cx, int l, LAS int* info) {
    if (cx.tid < 64) {
        const unsigned* cnt = (const unsigned*)(cx.ws + WS_CTL) + CW_CNT + l * 32;
        const int c = cx.lane < 32 ? (int)__hip_atomic_load(cnt + (cx.lane & 31), __ATOMIC_RELAXED, __HIP_MEMORY_SCOPE_AGENT) : 0;
        const int nt = (c + 255) >> 8;
        if (cx.lane < 32) { info[72 + cx.lane] = nt; info[40 + cx.lane] = c; }
        if (cx.lane == 0) { int run = 0; info[0] = 0; for (int e = 0; e < 32; ++e) { run += info[72 + e]; info[e + 1] = run; } }
    }
    __syncthreads();
    if (cx.tid < 32) { const int lo = info[cx.tid], hi = info[cx.tid + 1]; for (int t = lo; t < hi; ++t) info[112 + t] = cx.tid;
    }
    __syncthreads();
}

DEVI void block_rows_visible() {
    asm volatile("s_waitcnt vmcnt(0)" ::: "memory");
    __syncthreads();
}
DEVI void ph_norm1(const Ctx& cx, int l) {
    const Params& P = *cx.p;
    LAS int* info = (LAS int*)cx.lds;
    LAS float* part = (LAS float*)(cx.lds + 4096);
    if (l > 0) moe_info(cx, l - 1, info);
    const int rbeg = (l == DEPTH) ? TCTX : 0, nr = TT - rbeg;
    const int rpb = (nr + cx.G - 1) / cx.G, rb = rbeg + cx.bid * rpb, re = min(TT, rb + rpb);
    const float* modp = WSP(float, WS_MOD);
    const int c0 = 4 * cx.lane;
    for (int r2 = rb + cx.wave; r2 < re; r2 += 16) {
        f32x4 x[2][4]; bool ok[2];
#pragma unroll
        for (int u = 0; u < 2; ++u) { const int row = r2 + 8 * u; ok[u] = row < re; const int rw_ = ok[u] ? row : r2;
            if (l == 0) { const float* src = rw_ < TCTX ? P.in[I_CTX] + (size_t)rw_ * 1024 : P.in[I_X] + (size_t)(rw_ - TCTX) * 1024;
#pragma unroll
                for (int i = 0; i < 4; ++i) x[u][i] = *(const f32x4*)(src + c0 + 256 * i);
            } else {
                const float* src = WSP(float, WS_XMID) + (size_t)rw_ * 1024;
                const float* g2 = modp + ((size_t)(l - 1) * 9 + mod_row(rw_)) * 6144 + 5120;
                const int* ti = WSP(int, WS_TINFO) + (size_t)rw_ * 4;
                const f32x4 tg = *(const f32x4*)(WSP(float, WS_TGATE) + (size_t)rw_ * 4);
                f32x4 y[4];
#pragma unroll
                for (int i = 0; i < 4; ++i) y[i] = (f32x4){0.f, 0.f, 0.f, 0.f};
#pragma unroll
                for (int k = 0; k < 4; ++k) { const int t = ti[k]; const int e = t >> 20, slot = t & 0xFFFFF;
                    const unsigned char* yp = WSP(unsigned char, WS_YPAD) + ((size_t)info[e] * 256 + slot) * 1024;
#pragma unroll
                    for (int i = 0; i < 4; ++i) { const int w = *(const int*)(yp + c0 + 256 * i);
                        const float gk_ = tg[k]; y[i][0] += gk_ * __builtin_amdgcn_cvt_f32_fp8(w, 0); y[i][1] += gk_ * __builtin_amdgcn_cvt_f32_fp8(w, 1); y[i][2] += gk_ * __builtin_amdgcn_cvt_f32_fp8(w, 2); y[i][3] += gk_ * __builtin_amdgcn_cvt_f32_fp8(w, 3); } }
#pragma unroll
                for (int i = 0; i < 4; ++i) { const f32x4 xv = *(const f32x4*)(src + c0 + 256 * i), gv = *(const f32x4*)(g2 + c0 + 256 * i); x[u][i] = xv + gv * (y[i] * Y8_INV); }
            }
        }
#pragma unroll
        for (int u = 0; u < 2; ++u) {
            const int row = r2 + 8 * u;
            float ss = 0.f;
#pragma unroll
            for (int i = 0; i < 4; ++i) ss += (x[u][i][0] * x[u][i][0] + x[u][i][1] * x[u][i][1]) + (x[u][i][2] * x[u][i][2] + x[u][i][3] * x[u][i][3]);
            ss = wave_sum(ss, 0);
            const float rstd = rsqrtf(ss * (1.0f / 1024.0f) + EPS);
            if (!ok[u]) continue;
            if (l == DEPTH) { float* o = P.out + (size_t)(row - TCTX) * 1024;
#pragma unroll
                for (int i = 0; i < 4; ++i) { const f32x4 fw = *(const f32x4*)(P.in[I_FNW] + c0 + 256 * i); *(f32x4*)(o + c0 + 256 * i) = x[u][i] * rstd * fw; }
                continue; }
            float* xs = WSP(float, WS_XS) + (size_t)row * 1024;
            const float* md = modp + ((size_t)l * 9 + mod_row(row)) * 6144;
            bf16_t* hp = WSP(bf16_t, WS_H) + (size_t)row * 1024;
#pragma unroll
            for (int i = 0; i < 4; ++i) { const int c = c0 + 256 * i;
                *(f32x4*)(xs + c) = x[u][i];
                const f32x4 nw = *(const f32x4*)(P.in[I_N1W] + l * 1024 + c), sc = *(const f32x4*)(md + 1024 + c), sh = *(const f32x4*)(md + c);
                const f32x4 h = x[u][i] * rstd * nw * (sc + 1.0f) + sh;
                u32x2 w; w.x = pk_bf16(h[0], h[1]); w.y = pk_bf16(h[2], h[3]); *(u32x2*)(hp + c) = w; }
        }
    }
    if (l == DEPTH) return;
    block_rows_visible();
    const int nrow = re - rb, ntile = (nrow + 15) / 16;
    for (int it = cx.wave; it < ntile * 4; it += 8) {
        const int t = it >> 2, kq = it & 3, fr = cx.lane & 15, fq = cx.lane >> 4; const int row = min(rb + t * 16 + fr, re - 1);
        const bf16_t* hp = WSP(bf16_t, WS_H) + (size_t)row * 1024 + kq * 256 + fq * 8;
        const bf16_t* wp = WSP(bf16_t, WS_WGT) + ((size_t)l * 16 + fr) * 1024 + kq * 256 + fq * 8;
        f32x4 acc = (f32x4){0.f, 0.f, 0.f, 0.f};
        bf16x8 af[8], wf[8];
#pragma unroll
        for (int k = 0; k < 8; ++k) { af[k] = ldg8(hp + 32 * k); wf[k] = ldg8(wp + 32 * k); }
        __builtin_amdgcn_sched_barrier(0);
#pragma unroll
        for (int k = 0; k < 8; ++k) acc = __builtin_amdgcn_mfma_f32_16x16x32_bf16(wf[k], af[k], acc, 0, 0, 0);
        __builtin_amdgcn_sched_barrier(0);
        *(LAS f32x4*)(part + ((kq * 128) + t * 16 + fr) * 16 + 4 * fq) = acc;
    }
    __syncthreads();
    for (int i = cx.tid; i < nrow * 16; i += NTHR) { const int rl = i >> 4, gi = i & 15;
        WSP(float, WS_GT)[(size_t)(rb + rl) * 16 + gi] = (part[(0 * 128 + rl) * 16 + gi] + part[(1 * 128 + rl) * 16 + gi]) + (part[(2 * 128 + rl) * 16 + gi] + part[(3 * 128 + rl) * 16 + gi]) + P.in[I_BIN][l * DIN + 1536 + gi]; }
}

DEVI void ph_norm2(const Ctx& cx, int l) {
    const Params& P = *cx.p;
    LAS float* lgs = (LAS float*)cx.lds;
    LAS int* hist = (LAS int*)(cx.lds + 4 * 128 * 33 * 4);
    LAS int* pend = hist + 64;
    if (cx.tid < 64) hist[cx.tid] = 0;
    const int r0 = (l == DEPTH - 1) ? TCTX : 0, nr = TT - r0;
    const int rpb = (nr + cx.G - 1) / cx.G;
    const int rb = r0 + cx.bid * rpb, re = min(TT, rb + rpb);
    const float* modp = WSP(float, WS_MOD);
    const int c0 = 4 * cx.lane;
    for (int r2 = rb + cx.wave; r2 < re; r2 += 16) {
        f32x4 x[2][4]; bool ok[2];
#pragma unroll
        for (int u = 0; u < 2; ++u) { const int row = r2 + 8 * u; ok[u] = row < re; const float* src = WSP(float, WS_XMID) + (size_t)(ok[u] ? row : r2) * 1024;
#pragma unroll
            for (int i = 0; i < 4; ++i) x[u][i] = *(const f32x4*)(src + c0 + 256 * i); }
#pragma unroll
        for (int u = 0; u < 2; ++u) {
            const int row = r2 + 8 * u;
            float ss = 0.f;
#pragma unroll
            for (int i = 0; i < 4; ++i) ss += (x[u][i][0] * x[u][i][0] + x[u][i][1] * x[u][i][1]) + (x[u][i][2] * x[u][i][2] + x[u][i][3] * x[u][i][3]);
            ss = wave_sum(ss, 0);
            const float rstd = rsqrtf(ss * (1.0f / 1024.0f) + EPS);
            if (!ok[u]) continue;
            const float* md = modp + ((size_t)l * 9 + mod_row(row)) * 6144;
            bf16_t* hp = WSP(bf16_t, WS_H) + (size_t)row * 1024; bf16_t* hl = WSP(bf16_t, WS_HLO) + (size_t)row * 1024; unsigned char* h8 = WSP(unsigned char, WS_H8) + (size_t)row * 1024;
#pragma unroll
            for (int i = 0; i < 4; ++i) { const int c = c0 + 256 * i;
                const f32x4 nw = *(const f32x4*)(P.in[I_N2W] + l * 1024 + c), sc = *(const f32x4*)(md + 4096 + c), sh = *(const f32x4*)(md + 3072 + c);
                const f32x4 h = x[u][i] * rstd * nw * (sc + 1.0f) + sh;
                const int p8 = (int)pk4_fp8(h[0], h[1], h[2], h[3]);
                const float q0 = __builtin_amdgcn_cvt_f32_fp8(p8, 0), q1 = __builtin_amdgcn_cvt_f32_fp8(p8, 1), q2 = __builtin_amdgcn_cvt_f32_fp8(p8, 2), q3 = __builtin_amdgcn_cvt_f32_fp8(p8, 3);
                *(int*)(h8 + c) = p8;
                u32x2 wh; wh.x = pk_bf16(q0, q1); wh.y = pk_bf16(q2, q3); *(u32x2*)(hp + c) = wh;
                u32x2 wl; wl.x = pk_bf16(h[0] - q0, h[1] - q1); wl.y = pk_bf16(h[2] - q2, h[3] - q3); *(u32x2*)(hl + c) = wl; }
        }
    }
    block_rows_visible();
    const int nrow = re - rb, ntile = (nrow + 15) / 16;
    for (int it = cx.wave; it < ntile * 8; it += 8) {
        const int t = it >> 3, nt = (it >> 2) & 1, kq = it & 3, fr = cx.lane & 15, fq = cx.lane >> 4; const int row = min(rb + t * 16 + fr, re - 1);
        const bf16_t* hp = WSP(bf16_t, WS_H) + (size_t)row * 1024 + kq * 256 + fq * 8; const bf16_t* hl = WSP(bf16_t, WS_HLO) + (size_t)row * 1024 + kq * 256 + fq * 8;
        const bf16_t* wh = WSP(bf16_t, WS_RWH) + ((size_t)l * 32 + nt * 16 + fr) * 1024 + kq * 256 + fq * 8; const bf16_t* wl = WSP(bf16_t, WS_RWL) + ((size_t)l * 32 + nt * 16 + fr) * 1024 + kq * 256 + fq * 8;
        f32x4 acc = (f32x4){0.f, 0.f, 0.f, 0.f}, acc2 = (f32x4){0.f, 0.f, 0.f, 0.f};
        bf16x8 ah[8], al[8], bh[8], bl[8];
#pragma unroll
        for (int k = 0; k < 8; ++k) { ah[k] = ldg8(hp + 32 * k); al[k] = ldg8(hl + 32 * k); bh[k] = ldg8(wh + 32 * k); bl[k] = ldg8(wl + 32 * k); }
        __builtin_amdgcn_sched_barrier(0);
#pragma unroll
        for (int k = 0; k < 8; ++k) {
            acc = __builtin_amdgcn_mfma_f32_16x16x32_bf16(bh[k], ah[k], acc, 0, 0, 0);
            acc2 = __builtin_amdgcn_mfma_f32_16x16x32_bf16(bl[k], ah[k], acc2, 0, 0, 0);
            acc2 = __builtin_amdgcn_mfma_f32_16x16x32_bf16(bh[k], al[k], acc2, 0, 0, 0); }
        __builtin_amdgcn_sched_barrier(0);
        const int rl = t * 16 + fr;
#pragma unroll
        for (int j = 0; j < 4; ++j) lgs[(kq * 128 + rl) * 33 + nt * 16 + 4 * fq + j] = acc[j] + acc2[j];
    }
    __syncthreads();
    if (cx.tid < nrow) {
        float lg[32];
#pragma unroll
        for (int e = 0; e < 32; ++e) lg[e] = (lgs[(0 * 128 + cx.tid) * 33 + e] + lgs[(1 * 128 + cx.tid) * 33 + e]) + (lgs[(2 * 128 + cx.tid) * 33 + e] + lgs[(3 * 128 + cx.tid) * 33 + e]) + P.in[I_RB][l * 32 + e];
        float tv[4]; int tix[4]; unsigned taken = 0u;
#pragma unroll
        for (int k = 0; k < 4; ++k) { float bv = -3.0e38f; int bi = 0;
#pragma unroll
            for (int e = 0; e < 32; ++e) { const bool better = (lg[e] > bv) && !((taken >> e) & 1u); bv = better ? lg[e] : bv; bi = better ? e : bi; }
            tv[k] = bv; tix[k] = bi; taken |= 1u << bi; }
        const float e1 = __expf(tv[1] - tv[0]), e2 = __expf(tv[2] - tv[0]), e3 = __expf(tv[3] - tv[0]);
        const float inv = 1.0f / (1.0f + e1 + e2 + e3);
        const float gk[4] = {inv, e1 * inv, e2 * inv, e3 * inv};
#pragma unroll
        for (int k = 0; k < 4; ++k) {
            const int ls = __hip_atomic_fetch_add((LAS int*)(hist + tix[k]), 1, __ATOMIC_RELAXED, __HIP_MEMORY_SCOPE_WORKGROUP);
            pend[(cx.tid * 4 + k) * 2 + 0] = (tix[k] << 20) | ls;
            pend[(cx.tid * 4 + k) * 2 + 1] = __float_as_int(gk[k]); }
    }
    __syncthreads();
    if (cx.tid < 32) { unsigned* cnt = (unsigned*)(cx.ws + WS_CTL) + CW_CNT + l * 32;
        hist[32 + cx.tid] = hist[cx.tid] > 0 ? (int)__hip_atomic_fetch_add(cnt + cx.tid, (unsigned)hist[cx.tid], __ATOMIC_RELAXED, __HIP_MEMORY_SCOPE_AGENT) : 0; }
    __syncthreads();
    for (int i = cx.tid; i < nrow * 4; i += NTHR) {
        const int t = pend[i * 2], e = t >> 20, slot = hist[32 + e] + (t & 0xFFFFF), row = rb + (i >> 2);
        WSP(int, WS_ELIST)[(size_t)e * TT + slot] = row;
        WSP(float, WS_TGATE)[(size_t)row * 4 + (i & 3)] = __int_as_float(pend[i * 2 + 1]);
        WSP(int, WS_TINFO)[(size_t)row * 4 + (i & 3)] = (e << 20) | slot;
    }
}

DEVI int xcd_contig(int bid, int G) { return (G % 8 == 0) ? (bid % 8) * (G / 8) + bid / 8 : bid; }

struct DenseSched {
    const char* A; const char* B; int nM, nN, pm0, G, bid;
    DEVI bool get(int i, g1::Unit& u) const {
        int pm, pn;
        if (G % 8 == 0) { const int x = bid & 7, r = bid >> 3, nx = G >> 3, lo = (nM * x) >> 3, hi = (nM * (x + 1)) >> 3, nr = hi - lo;
            const int q = i * nx + r; if (nr <= 0 || q >= nr * nN) return false; pm = lo + q % nr; pn = q / nr; }
        else { const int L = i * G + bid; if (L >= nM * nN) return false; pm = L / nN; pn = L % nN; }
        u.A = A + (size_t)(pm0 + pm) * 256 * 2048; u.list = nullptr; u.nvalid = 256; u.B = B + (size_t)pn * 256 * 2048; u.pm = pm0 + pm; u.pn = pn; u.e = 0;
        return true;
    }
};
struct MoeSched {
    const char* A; const char* B; const int* elist; const LAS int* info; int NPN, gather, G, bid; size_t bstride; int kb;
    DEVI int rd(int i) const { return __builtin_amdgcn_readfirstlane(info[i]); }
    DEVI bool get(int i, g1::Unit& u) const {
        const int NTt = rd(32); int T, pn;
        if (G % 8 == 0 && (G >> 3) % NPN == 0) { const int x = bid & 7, r = bid >> 3, nx = G >> 3, RT = nx / NPN, lo = (NTt * x) >> 3, hi = (NTt * (x + 1)) >> 3;
            T = lo + i * RT + r % RT; pn = r / RT; if (T >= hi) return false; }
        else { const int L = i * G + bid; if (L >= NTt * NPN) return false; T = L / NPN; pn = L % NPN; }
        const int e = rd(112 + T), j = T - rd(e);
        u.pm = T; u.pn = pn; u.e = e;
        u.B = B + (size_t)e * bstride + (size_t)pn * 256 * kb;
        if (gather) { u.A = A; u.list = elist + (size_t)e * TT + j * 256; u.nvalid = rd(40 + e) - j * 256; }
        else { u.A = A + (size_t)T * 256 * kb; u.list = nullptr; u.nvalid = 256; }
        return true;
    }
};

struct EpiIn {
    static constexpr bool PERM = true, LDSC = true;
    bf16_t* Pout; const float* bias;
    DEVI const float* cptr(const g1::Unit& u, int tid) const { return bias + u.pn * 256 + tid; }
    DEVI void operator()(const f32x4 (&acc)[2][2][4][2], const g1::Unit& u, int wr, int wc, int fr, int fq, const LAS float* cb) const {
        const int row0 = u.pm * 256 + wr * 64 + fr;
#pragma unroll
        for (int bj = 0; bj < 2; ++bj) {
            const int col0 = u.pn * 256 + bj * 128 + wc * 32 + 8 * fq;
            const int seg = u.pn * 2 + bj; const bool gl = (seg >= 15 && seg < 18);
            const int cl = bj * 128 + wc * 32 + 8 * fq;
            const f32x4 b0 = *(const LAS f32x4*)(cb + cl), b1 = *(const LAS f32x4*)(cb + cl + 4);
#pragma unroll
            for (int ai = 0; ai < 2; ++ai)
#pragma unroll
                for (int m = 0; m < 4; ++m) {
                    f32x4 v0 = acc[ai][bj][m][0] + b0, v1 = acc[ai][bj][m][1] + b1;
                    if (gl) {
#pragma unroll
                        for (int j = 0; j < 4; ++j) { v0[j] = gelu_tanh(v0[j]); v1[j] = gelu_tanh(v1[j]); } }
                    u32x4 w; w.x = pk_bf16(v0[0], v0[1]); w.y = pk_bf16(v0[2], v0[3]); w.z = pk_bf16(v1[0], v1[1]); w.w = pk_bf16(v1[2], v1[3]);
                    *(u32x4*)(Pout + (size_t)(row0 + ai * 128 + m * 16) * NP + col0) = w;
                }
        }
    }
};
struct EpiOut {
    static constexpr bool PERM = false, LDSC = true;
    const float* xs; float* xmid; const float* mod;
    DEVI const float* cptr(const g1::Unit& u, int tid) const { return mod + (size_t)mod_row(u.pm * 256) * 6144 + 2048 + u.pn * 256 + tid; }
    DEVI void operator()(const f32x4 (&acc)[2][2][4][2], const g1::Unit& u, int wr, int wc, int fr, int fq, const LAS float* cb) const {
        const int row0 = u.pm * 256 + wr * 64 + fr;
#pragma unroll
        for (int bj = 0; bj < 2; ++bj)
#pragma unroll
            for (int n = 0; n < 2; ++n) {
                const int col = u.pn * 256 + bj * 128 + wc * 32 + 16 * n + 4 * fq;
                const f32x4 gv = *(const LAS f32x4*)(cb + bj * 128 + wc * 32 + 16 * n + 4 * fq);
#pragma unroll
                for (int ai = 0; ai < 2; ++ai)
#pragma unroll
                    for (int m = 0; m < 4; ++m) {
                        const size_t off = (size_t)(row0 + ai * 128 + m * 16) * 1024 + col;
                        const f32x4 xv = *(const f32x4*)(xs + off);
                        *(f32x4*)(xmid + off) = xv + gv * acc[ai][bj][m][n];
                    }
            }
    }
};
struct EpiGU {
    static constexpr bool PERM = true, LDSC = true;
    unsigned char* act; const float* bgu;
    DEVI const float* cptr(const g1::Unit& u, int tid) const { return bgu + (size_t)u.e * 2048 + (tid < 128 ? u.pn * 128 + tid : 1024 + u.pn * 128 + (tid - 128)); }
    DEVI void operator()(const f32x4 (&acc)[2][2][4][2], const g1::Unit& u, int wr, int wc, int fr, int fq, const LAS float* cb) const {
        const int row0 = u.pm * 256 + wr * 64 + fr, cl = wc * 32 + 8 * fq, colh = u.pn * 128 + cl;
        const f32x4 bg0 = *(const LAS f32x4*)(cb + cl), bg1 = *(const LAS f32x4*)(cb + cl + 4), bu0 = *(const LAS f32x4*)(cb + 128 + cl), bu1 = *(const LAS f32x4*)(cb + 128 + cl + 4);
#pragma unroll
        for (int ai = 0; ai < 2; ++ai)
#pragma unroll
            for (int m = 0; m < 4; ++m) {
                float o[8];
#pragma unroll
                for (int n = 0; n < 2; ++n)
#pragma unroll
                    for (int j = 0; j < 4; ++j) {
                        const float g = fminf(acc[ai][0][m][n][j] * W8_INV + (n ? bg1[j] : bg0[j]), 7.0f);
                        const float up = fminf(fmaxf(acc[ai][1][m][n][j] * W8_INV + (n ? bu1[j] : bu0[j]), -7.0f), 7.0f);
                        o[n * 4 + j] = (up + 1.0f) * g * frcp(1.0f + __expf(-1.702f * g));
                    }
                u32x2 w; w.x = pk4_fp8(o[0], o[1], o[2], o[3]); w.y = pk4_fp8(o[4], o[5], o[6], o[7]);
                *(u32x2*)(act + (size_t)(row0 + ai * 128 + m * 16) * 1024 + colh) = w;
            }
    }
};
struct EpiDown {
    static constexpr bool PERM = true, LDSC = true;
    unsigned char* ypad; const float* bd;
    DEVI const float* cptr(const g1::Unit& u, int tid) const { return bd + (size_t)u.e * 1024 + u.pn * 256 + tid; }
    DEVI void operator()(const f32x4 (&acc)[2][2][4][2], const g1::Unit& u, int wr, int wc, int fr, int fq, const LAS float* cb) const {
        const int rl0 = wr * 64 + fr;
#pragma unroll
        for (int bj = 0; bj < 2; ++bj) {
            const int cl = bj * 128 + wc * 32 + 8 * fq, col0 = u.pn * 256 + cl;
            const f32x4 b0 = *(const LAS f32x4*)(cb + cl), b1 = *(const LAS f32x4*)(cb + cl + 4);
#pragma unroll
            for (int ai = 0; ai < 2; ++ai)
#pragma unroll
                for (int m = 0; m < 4; ++m) {
                    const int rl = rl0 + ai * 128 + m * 16;
                    const f32x4 v0 = acc[ai][bj][m][0] * W8_INV + b0, v1 = acc[ai][bj][m][1] * W8_INV + b1;
                    u32x2 w; w.x = pk4_fp8(v0[0] * Y8_SCALE, v0[1] * Y8_SCALE, v0[2] * Y8_SCALE, v0[3] * Y8_SCALE); w.y = pk4_fp8(v1[0] * Y8_SCALE, v1[1] * Y8_SCALE, v1[2] * Y8_SCALE, v1[3] * Y8_SCALE);
                    *(u32x2*)(ypad + (size_t)(u.pm * 256 + rl) * 1024 + col0) = w;
                }
        }
    }
};

DEVI void ph_inproj(const Ctx& cx, int l) {
    DenseSched S{(const char*)WSP(bf16_t, WS_H), (const char*)(WSP(bf16_t, WS_WIN) + (size_t)l * NP * 1024), TT / 256, NP / 256, 0, cx.G, cx.bid};
    EpiIn E{WSP(bf16_t, WS_P), WSP(float, WS_BIN2) + (size_t)l * NP};
    g1::gemm_phase<DenseSched, EpiIn, false>(cx.lds, cx.tid, S, E);
}
DEVI void ph_outproj(const Ctx& cx, int l) {
    const int pm0 = (l == DEPTH - 1) ? TCTX / 256 : 0;
    DenseSched S{(const char*)WSP(bf16_t, WS_MRG), (const char*)(WSP(bf16_t, WS_WOUT) + (size_t)l * 1024 * 1024), TT / 256 - pm0, 4, pm0, cx.G, cx.bid};
    EpiOut E{WSP(float, WS_XS), WSP(float, WS_XMID), WSP(float, WS_MOD) + (size_t)l * 9 * 6144};
    g1::gemm_phase<DenseSched, EpiOut, false>(cx.lds, cx.tid, S, E);
}
DEVI void ph_moe_gu(const Ctx& cx, int l) {
    LAS int* info = (LAS int*)(cx.lds + g1::STAGE_BYTES);
    moe_info(cx, l, info);
    MoeSched S{(const char*)WSP(unsigned char, WS_H8), (const char*)(WSP(unsigned char, WS_WGU) + (size_t)l * NE * 2048 * 1024), WSP(int, WS_ELIST), info, 8, 1, cx.G, cx.bid, (size_t)2048 * 1024, 1024};
    EpiGU E{WSP(unsigned char, WS_ACT), cx.p->in[I_BGU] + (size_t)l * NE * 2048};
    g1::gemm_phase<MoeSched, EpiGU, true, true>(cx.lds, cx.tid, S, E);
}
DEVI void ph_moe_dn(const Ctx& cx, int l) {
    LAS int* info = (LAS int*)(cx.lds + g1::STAGE_BYTES);
    moe_info(cx, l, info);
    MoeSched S{(const char*)WSP(unsigned char, WS_ACT), (const char*)(WSP(unsigned char, WS_WD) + (size_t)l * NE * 1024 * 1024), nullptr, info, 4, 0, cx.G, cx.bid, (size_t)1024 * 1024, 1024};
    EpiDown E{WSP(unsigned char, WS_YPAD), cx.p->in[I_BD] + (size_t)l * NE * 1024};
    g1::gemm_phase<MoeSched, EpiDown, false, true>(cx.lds, cx.tid, S, E);
}

DEVI int ml_row0(int b, int c) { return c < 2 ? b * CTXL + c * 128 : TCTX + b * SEQ + (c - 2) * 128; }
DEVI unsigned short lds_u16(const LAS bf16_t* p) { return *p; }
typedef short s16x4 __attribute__((ext_vector_type(4)));
DEVI bf16x8 tr8(const LAS bf16_t* tile, int stride, int r0, int r1, int c0, int lane) {
    const int q = (lane & 15) >> 2, p = lane & 3;
    const s16x4 a = __builtin_amdgcn_ds_read_tr16_b64_v4i16((LAS s16x4*)(tile + (r0 + q) * stride + c0 + 4 * p));
    const s16x4 b = __builtin_amdgcn_ds_read_tr16_b64_v4i16((LAS s16x4*)(tile + (r1 + q) * stride + c0 + 4 * p));
    return __builtin_shufflevector(a, b, 0, 1, 2, 3, 4, 5, 6, 7);
}

DEVI void ml_local_unit(const Ctx& cx, int l, int b, int h, int c) {
    LAS float* sg = (LAS float*)cx.lds;
    LAS float* se = sg + 256;
    LAS float* red = se + 256;
    LAS bf16_t* Ks = (LAS bf16_t*)(cx.lds + 4352);
    LAS bf16_t* Ve = Ks + 128 * 104;
    const int row0 = ml_row0(b, c), tid = cx.tid;
    const int dir = (tid >> 7) & 1, i = tid & 127, p = dir ? 127 - i : i;
    const bool act = tid < 256;
    float gi = 0.f, bval = 0.f, u = 0.f;
    if (act) { const float* gt = WSP(float, WS_GT) + (size_t)(row0 + i) * 16; gi = gt[dir * 4 + h]; const float gf = gt[8 + dir * 4 + h];
        sg[dir * 128 + p] = fminf(gf, 0.f) - log1p_(__expf(-fabsf(gf))); }
    LDS_SYNC();
#pragma unroll 1
    for (int off = 1; off < 128; off <<= 1) { float v = 0.f; if (act) { v = sg[dir * 128 + p]; if (p >= off) v += sg[dir * 128 + p - off]; } LDS_SYNC(); if (act) sg[dir * 128 + p] = v; LDS_SYNC(); }
    if (act) { bval = sg[dir * 128 + p]; u = gi - bval; if (p == 127) red[dir] = bval; }
    LDS_SYNC();
    if (act) sg[dir * 128 + p] = u;
    LDS_SYNC();
#pragma unroll 1
    for (int off = 1; off < 128; off <<= 1) { float v = 0.f; if (act) { v = sg[dir * 128 + p]; if (p >= off) v = fmaxf(v, sg[dir * 128 + p - off]); } LDS_SYNC(); if (act) sg[dir * 128 + p] = v; LDS_SYNC(); }
    if (act) { const float cm = sg[dir * 128 + p]; if (p == 127) red[2 + dir] = cm;
        const size_t gix = (size_t)(row0 + i) * 8 + dir * 4 + h;
        WSP(float, WS_GB)[gix] = bval; WSP(float, WS_GU)[gix] = u; WSP(float, WS_GCM)[gix] = cm; }
    LDS_SYNC();
    if (act) se[dir * 128 + i] = expf(u - red[2 + dir]);
    if (tid < 2) { float* msc = WSP(float, WS_MSC) + ((size_t)((b * 4 + h) * MLC + c) * 2 + tid) * 2; msc[0] = red[tid]; msc[1] = red[tid] + red[2 + tid]; }
    LDS_SYNC();
    const bf16_t* Pp = WSP(bf16_t, WS_P);
#pragma unroll
    for (int it = 0; it < 3; ++it) { const int idx = tid + NTHR * it, r = idx / 12, ch = idx % 12;
        const u32x4 kv = *(const u32x4*)(Pp + (size_t)(row0 + r) * NP + PC_K + h * 96 + ch * 8);
        *(LAS u32x4*)(Ks + r * 104 + ch * 8) = kv;
        const u32x4 vv = *(const u32x4*)(Pp + (size_t)(row0 + r) * NP + PC_V + h * 96 + ch * 8);
        const float e0 = se[r], e1 = se[128 + r];
        u32x4 o0, o1;
#pragma unroll
        for (int q = 0; q < 4; ++q) { const float lo = __uint_as_float(vv[q] << 16), hi = __uint_as_float(vv[q] & 0xFFFF0000u);
            o0[q] = pk_bf16(lo * e0, hi * e0); o1[q] = pk_bf16(lo * e1, hi * e1); }
        *(LAS u32x4*)(Ve + r * 104 + ch * 8) = o0; *(LAS u32x4*)(Ve + (128 + r) * 104 + ch * 8) = o1; }
    LDS_SYNC();
    {
        const int wd = cx.wave >> 2, q9 = (cx.wave & 3) * 9, fr = cx.lane & 15, fq = cx.lane >> 4;
        float* cl = WSP(float, WS_CLOC) + ((size_t)((b * 4 + h) * MLC + c) * 2 + wd) * 9216;
        const LAS bf16_t* V = Ve + wd * 128 * 104;
#pragma unroll 1
        for (int pi = q9; pi < q9 + 9; ++pi) { const int dt = pi / 6, et = pi % 6;
            f32x4 acc = (f32x4){0.f, 0.f, 0.f, 0.f};
#pragma unroll
            for (int kk = 0; kk < 4; ++kk) { const int s0 = kk * 32 + fq * 8;
                const bf16x8 a = tr8(V, 104, s0, s0 + 4, dt * 16, cx.lane), bb = tr8(Ks, 104, s0, s0 + 4, et * 16, cx.lane);
                acc = __builtin_amdgcn_mfma_f32_16x16x32_bf16(a, bb, acc, 0, 0, 0); }
#pragma unroll
            for (int r = 0; r < 4; ++r) cl[(dt * 16 + fq * 4 + r) * 96 + et * 16 + fr] = acc[r]; }
    }
    {
        LAS float* nred = (LAS float*)(cx.lds + 4352 + 3 * 128 * 104 * 2);
        for (int idx = tid; idx < 768; idx += NTHR) { const int qd = idx / 192, rem = idx % 192, d2 = rem / 96, e = rem % 96; float s = 0.f;
#pragma unroll 8
            for (int t = qd * 32; t < qd * 32 + 32; ++t) s += se[d2 * 128 + t] * bf2f(Ks[t * 104 + e]);
            nred[idx] = s; }
        LDS_SYNC();
        if (tid < 192) WSP(float, WS_NLOC)[((size_t)((b * 4 + h) * MLC + c) * 2 + tid / 96) * 96 + tid % 96] = (nred[tid] + nred[192 + tid]) + (nred[384 + tid] + nred[576 + tid]);
    }
    LDS_SYNC();
}

DEVI void ml_carry(const Ctx& cx) {
    for (int idx = cx.bid * NTHR + cx.tid; idx < 64 * 9312; idx += cx.G * NTHR) {
        const int combo = idx / 9312, el = idx % 9312, dir = combo & 1, bh = combo >> 1;
        float loc[MLC], bl[MLC], ml[MLC];
#pragma unroll
        for (int s = 0; s < MLC; ++s) {
            const int c = dir == 0 ? s : (s < 2 ? 1 - s : 19 - s);
            const size_t cb = (size_t)(bh * MLC + c) * 2 + dir;
            bl[s] = WSP(float, WS_MSC)[cb * 2]; ml[s] = WSP(float, WS_MSC)[cb * 2 + 1];
            loc[s] = el < 9216 ? WSP(float, WS_CLOC)[cb * 9216 + el] : WSP(float, WS_NLOC)[cb * 96 + el - 9216];
        }
        float Cv = 0.f, m = -1e30f;
#pragma unroll
        for (int s = 0; s < MLC; ++s) {
            const int c = dir == 0 ? s : (s < 2 ? 1 - s : 19 - s);
            const size_t cb = (size_t)(bh * MLC + c) * 2 + dir;
            if (el < 9216) WSP(bf16_t, WS_C0)[cb * 9216 + el] = f2bf(Cv); else WSP(float, WS_N0)[cb * 96 + el - 9216] = Cv;
            if (el == 0) WSP(float, WS_M0)[cb] = m;
            const float mn = fmaxf(bl[s] + m, ml[s]), a = __expf(bl[s] + m - mn), sc = __expf(ml[s] - mn);
            Cv = a * Cv + sc * loc[s]; m = mn;
        }
    }
}

DEVI void ml_out_unit(const Ctx& cx, int l, int b, int h, int c) {
    LAS bf16_t* Qs = (LAS bf16_t*)cx.lds;
    LAS bf16_t* Ks = Qs + 128 * 104;
    LAS bf16_t* Vs = Ks + 128 * 104;
    LAS bf16_t* C0s = Vs + 128 * 104;
    LAS float* gb = (LAS float*)(cx.lds + 119808);
    LAS float* gu = gb + 256;
    LAS float* gM = gu + 256;
    LAS float* n0s = gM + 256;
    LAS float* m0s = n0s + 192;
    const int row0 = ml_row0(b, c), tid = cx.tid;
    const bf16_t* Pp = WSP(bf16_t, WS_P);
    const size_t cb0 = (size_t)((b * 4 + h) * MLC + c) * 2;
#pragma unroll
    for (int it = 0; it < 3; ++it) { const int idx = tid + NTHR * it, r = idx / 12, ch = idx % 12;
        const bf16_t* rp = Pp + (size_t)(row0 + r) * NP + h * 96 + ch * 8;
        *(LAS u32x4*)(Qs + r * 104 + ch * 8) = *(const u32x4*)(rp + PC_Q);
        *(LAS u32x4*)(Ks + r * 104 + ch * 8) = *(const u32x4*)(rp + PC_K);
        *(LAS u32x4*)(Vs + r * 104 + ch * 8) = *(const u32x4*)(rp + PC_V); }
    for (int idx = tid; idx < 2 * 96 * 12; idx += NTHR) { const int d2 = idx / 1152, r = (idx % 1152) / 12, ch = idx % 12;
        *(LAS u32x4*)(C0s + (d2 * 96 + r) * 104 + ch * 8) = *(const u32x4*)(WSP(bf16_t, WS_C0) + (cb0 + d2) * 9216 + r * 96 + ch * 8); }
    if (tid < 256) { const int d2 = tid >> 7, i = tid & 127; const size_t gix = (size_t)(row0 + i) * 8 + d2 * 4 + h;
        gb[tid] = WSP(float, WS_GB)[gix]; gu[tid] = WSP(float, WS_GU)[gix];
        gM[tid] = fmaxf(WSP(float, WS_M0)[cb0 + d2], WSP(float, WS_GCM)[gix]); }
    if (tid >= 256 && tid < 448) { const int k = tid - 256; n0s[k] = WSP(float, WS_N0)[(cb0 + k / 96) * 96 + k % 96]; }
    if (tid >= 448 && tid < 450) m0s[tid - 448] = WSP(float, WS_M0)[cb0 + tid - 448];
    LDS_SYNC();
    const int w = cx.wave, fr = cx.lane & 15, fq = cx.lane >> 4, t = 16 * w + fr;
    bf16x8 qf[3];
#pragma unroll
    for (int kk = 0; kk < 3; ++kk) qf[kk] = *(const LAS bf16x8*)(Qs + t * 104 + kk * 32 + fq * 8);
    f32x4 hs[6];
#pragma unroll
    for (int n = 0; n < 6; ++n) hs[n] = (f32x4){0.f, 0.f, 0.f, 0.f};
#pragma unroll
    for (int dir = 0; dir < 2; ++dir) {
        const float Mt = gM[dir * 128 + t], bt = gb[dir * 128 + t], inter = __expf(m0s[dir] - Mt);
        f32x4 an[6];
#pragma unroll
        for (int n = 0; n < 6; ++n) an[n] = (f32x4){0.f, 0.f, 0.f, 0.f};
        float den = 0.f;
        const int Jlo = dir == 0 ? 0 : (w >> 1), Jhi = dir == 0 ? (w >> 1) : 3;
#pragma unroll 1
        for (int J = Jlo; J <= Jhi; ++J) {
            bf16x8 pf;
#pragma unroll
            for (int half = 0; half < 2; ++half) {
                const int j = 2 * J + half;
                f32x4 D = (f32x4){0.f, 0.f, 0.f, 0.f};
                const bool need = dir == 0 ? (j <= w) : (j >= w);
                if (need) {
#pragma unroll
                    for (int kk = 0; kk < 3; ++kk) { const bf16x8 kf = *(const LAS bf16x8*)(Ks + (16 * j + fr) * 104 + kk * 32 + fq * 8);
                        D = __builtin_amdgcn_mfma_f32_16x16x32_bf16(kf, qf[kk], D, 0, 0, 0); }
                }
                const f32x4 us = *(const LAS f32x4*)(gu + dir * 128 + 16 * j + 4 * fq);
                float pv[4];
#pragma unroll
                for (int r = 0; r < 4; ++r) { const int s = 16 * j + 4 * fq + r; const bool valid = need && (dir == 0 ? (s <= t) : (s >= t));
                    pv[r] = valid ? D[r] * __expf(us[r] - Mt) : 0.f; den += pv[r]; }
                pf[half * 4 + 0] = (short)f2bf(pv[0]); pf[half * 4 + 1] = (short)f2bf(pv[1]); pf[half * 4 + 2] = (short)f2bf(pv[2]); pf[half * 4 + 3] = (short)f2bf(pv[3]);
            }
#pragma unroll
            for (int n = 0; n < 6; ++n) { const bf16x8 vf = tr8(Vs, 104, 32 * J + 4 * fq, 32 * J + 16 + 4 * fq, 16 * n, cx.lane);
                an[n] = __builtin_amdgcn_mfma_f32_16x16x32_bf16(vf, pf, an[n], 0, 0, 0); }
        }
        float nq = 0.f;
#pragma unroll
        for (int kk = 0; kk < 3; ++kk)
#pragma unroll
            for (int j = 0; j < 8; ++j) nq += n0s[dir * 96 + kk * 32 + fq * 8 + j] * bf2f((bf16_t)qf[kk][j]);
        nq += shx<16>(nq, cx.lane); nq += shx<32>(nq, cx.lane);
        den += shx<16>(den, cx.lane); den += shx<32>(den, cx.lane);
        const float dtot = den + inter * nq;
        const float inv = frcp(fmaxf(fabsf(dtot), __expf(-(Mt + bt))));
#pragma unroll
        for (int n = 0; n < 6; ++n) { f32x4 ac = (f32x4){0.f, 0.f, 0.f, 0.f};
#pragma unroll
            for (int kk = 0; kk < 3; ++kk) { const bf16x8 cf = *(const LAS bf16x8*)(C0s + (dir * 96 + 16 * n + fr) * 104 + kk * 32 + fq * 8);
                ac = __builtin_amdgcn_mfma_f32_16x16x32_bf16(cf, qf[kk], ac, 0, 0, 0); }
            hs[n] += (an[n] + ac * inter) * inv; }
    }
    float ss = 0.f;
#pragma unroll
    for (int n = 0; n < 6; ++n) ss += hs[n][0] * hs[n][0] + hs[n][1] * hs[n][1] + hs[n][2] * hs[n][2] + hs[n][3] * hs[n][3];
    ss += shx<16>(ss, cx.lane); ss += shx<32>(ss, cx.lane);
    const float rstd = rsqrtf(ss * (1.0f / 96.0f) + EPS);
    const size_t prow = (size_t)(row0 + t);
#pragma unroll
    for (int n = 0; n < 6; ++n) { const int d = 16 * n + 4 * fq;
        const u32x2 ov = *(const u32x2*)(Pp + prow * NP + PC_O + h * 96 + d);
        const f32x4 mw = *(const f32x4*)(cx.p->in[I_MIXW] + l * 1024 + h * 96 + d);
        const float o0 = __uint_as_float(ov.x << 16), o1 = __uint_as_float(ov.x & 0xFFFF0000u), o2 = __uint_as_float(ov.y << 16), o3 = __uint_as_float(ov.y & 0xFFFF0000u);
        u32x2 wv; wv.x = pk_bf16(sigmoidf_(o0) * hs[n][0] * rstd * mw[0], sigmoidf_(o1) * hs[n][1] * rstd * mw[1]);
        wv.y = pk_bf16(sigmoidf_(o2) * hs[n][2] * rstd * mw[2], sigmoidf_(o3) * hs[n][3] * rstd * mw[3]);
        *(u32x2*)(WSP(bf16_t, WS_MRG) + prow * 1024 + h * 96 + d) = wv; }
    LDS_SYNC();
}

DEVI void rg_unit(const Ctx& cx, int l, int b, int ck, int g, int mode) {
    const Params& P = *cx.p;
    LAS float* xraw = (LAS float*)cx.lds;
    LAS float* xc = (LAS float*)(cx.lds + 17408);
    LAS bf16_t* xcb = (LAS bf16_t*)(cx.lds + 33792);
    LAS float* ab = (LAS float*)(cx.lds + 43008);
    LAS float* hbuf = (LAS float*)(cx.lds + 43008 + 65536);
    const int tid = cx.tid;
    const int t0 = ck < 4 ? ck * 64 : (ck - 4) * 64, seglen = ck < 4 ? CTXL : SEQ, rowbase = ck < 4 ? b * CTXL : TCTX + b * SEQ;
    const bf16_t* Pp = WSP(bf16_t, WS_P);
    for (int idx = tid; idx < 67 * 8; idx += NTHR) { const int r = idx >> 3, c8 = idx & 7, tt = t0 - 2 + r;
        u32x4 v = (u32x4){0u, 0u, 0u, 0u};
        if (tt >= 0 && tt < seglen) v = *(const u32x4*)(Pp + (size_t)(rowbase + tt) * NP + PC_RX + g * 64 + c8 * 8);
#pragma unroll
        for (int q = 0; q < 4; ++q) { xraw[r * 64 + c8 * 8 + 2 * q] = __uint_as_float(v[q] << 16); xraw[r * 64 + c8 * 8 + 2 * q + 1] = __uint_as_float(v[q] & 0xFFFF0000u); } }
    LDS_SYNC();
#pragma unroll
    for (int it = 0; it < 8; ++it) { const int idx = tid + NTHR * it, t = idx >> 6, ch = idx & 63, cg = g * 64 + ch;
        float v = P.in[I_RGCB][l * 384 + cg];
#pragma unroll
        for (int j = 0; j < 4; ++j) v += P.in[I_RGCW][(l * 4 + j) * 384 + cg] * xraw[(t + j) * 64 + ch];
        xc[t * 64 + ch] = v; xcb[t * 72 + ch] = f2bf(v); }
    LDS_SYNC();
    {
        const int dir = cx.wave >> 2, cg4 = cx.wave & 3, fr = cx.lane & 15, fq = cx.lane >> 4;
        const bf16_t* wrg = WSP(bf16_t, WS_WRG) + (size_t)(l * 6 + g) * 256 * 64;
        f32x4 ar[4], ai[4];
#pragma unroll
        for (int m = 0; m < 4; ++m) { ar[m] = (f32x4){0.f, 0.f, 0.f, 0.f}; ai[m] = (f32x4){0.f, 0.f, 0.f, 0.f}; }
#pragma unroll
        for (int kk = 0; kk < 2; ++kk) {
            const bf16x8 br = ldg8(wrg + (size_t)((dir * 2 + 0) * 64 + cg4 * 16 + fr) * 64 + kk * 32 + fq * 8);
            const bf16x8 bi = ldg8(wrg + (size_t)((dir * 2 + 1) * 64 + cg4 * 16 + fr) * 64 + kk * 32 + fq * 8);
#pragma unroll
            for (int m = 0; m < 4; ++m) { const bf16x8 a = *(const LAS bf16x8*)(xcb + (m * 16 + fr) * 72 + kk * 32 + fq * 8);
                ar[m] = __builtin_amdgcn_mfma_f32_16x16x32_bf16(br, a, ar[m], 0, 0, 0); ai[m] = __builtin_amdgcn_mfma_f32_16x16x32_bf16(bi, a, ai[m], 0, 0, 0); }
        }
        const int ch0 = cg4 * 16 + 4 * fq, cgl = g * 64 + ch0;
        const f32x4 ba = *(const f32x4*)(P.in[I_RGBA] + (l * 2 + dir) * 384 + cgl), bx = *(const f32x4*)(P.in[I_RGBX] + (l * 2 + dir) * 384 + cgl);
        const f32x4 lam = *(const f32x4*)(P.in[I_RGLAM] + (l * 2 + dir) * 384 + cgl);
        float sp[4];
#pragma unroll
        for (int j = 0; j < 4; ++j) sp[j] = lam[j] > 0.f ? log1p_(__expf(-lam[j])) : -lam[j] + log1p_(__expf(lam[j]));
#pragma unroll
        for (int m = 0; m < 4; ++m) { const int t = m * 16 + fr; const f32x4 xv = *(const LAS f32x4*)(xc + t * 64 + ch0);
            f32x4 av, bv;
#pragma unroll
            for (int j = 0; j < 4; ++j) { const float r = frcp(1.0f + __expf(-(ar[m][j] + ba[j]))), ii = frcp(1.0f + __expf(-(ai[m][j] + bx[j])));
                const float la = -8.0f * r * sp[j], y = 2.0f * la; av[j] = __expf(la);
                const float nem1 = y > -0.02f ? -y * (1.0f + y * (0.5f + y * 0.16666667f)) : 1.0f - av[j] * av[j];
                bv[j] = sqrtf(nem1) * (ii * xv[j]); }
            *(LAS f32x4*)(ab + ((dir * 2 + 0) * 64 + t) * 64 + ch0) = av; *(LAS f32x4*)(ab + ((dir * 2 + 1) * 64 + t) * 64 + ch0) = bv; }
    }
    LDS_SYNC();
    if (tid < 128) { const int dir = tid >> 6, ch = tid & 63; const size_t ix = ((size_t)(b * RGC + ck) * 2 + dir) * 384 + g * 64 + ch;
        float hc = mode ? WSP(float, WS_RGC)[ix] : 0.f, ap = 1.0f;
        const LAS float* __restrict__ A = ab + (dir * 2 + 0) * 4096 + ch; const LAS float* __restrict__ B = ab + (dir * 2 + 1) * 4096 + ch; LAS float* __restrict__ H = hbuf + dir * 4096 + ch;
#pragma unroll 1
        for (int s0 = 0; s0 < 64; s0 += 16) { float av[16], bv[16];
#pragma unroll
            for (int j = 0; j < 16; ++j) { const int t = dir ? 63 - (s0 + j) : s0 + j; av[j] = A[t * 64]; bv[j] = B[t * 64]; }
#pragma unroll
            for (int j = 0; j < 16; ++j) { const int t = dir ? 63 - (s0 + j) : s0 + j; hc = av[j] * hc + bv[j]; ap *= av[j]; if (mode) H[t * 64] = hc; } }
        if (!mode) { WSP(float, WS_RGA)[ix] = ap; WSP(float, WS_RGB)[ix] = hc; } }
    LDS_SYNC();
    if (mode) { const int t = tid >> 3, ch0 = (tid & 7) * 8; float hv[8]; float ss = 0.f;
#pragma unroll
        for (int j = 0; j < 8; ++j) { hv[j] = hbuf[t * 64 + ch0 + j] + hbuf[4096 + t * 64 + ch0 + j]; ss += hv[j] * hv[j]; }
        ss += dpp_<0xB1, 0xF>(ss); ss += dpp_<0x4E, 0xF>(ss); ss += dpp_<0x141, 0xF>(ss);
        const float rstd = rsqrtf(ss * (1.0f / 64.0f) + EPS);
        const size_t row = (size_t)(rowbase + t0 + t);
        const u32x4 gv = *(const u32x4*)(Pp + row * NP + PC_RG + g * 64 + ch0);
        const float* mw = P.in[I_MIXW] + l * 1024 + 384 + g * 64 + ch0;
        u32x4 o;
#pragma unroll
        for (int q = 0; q < 4; ++q) { const float g0 = __uint_as_float(gv[q] << 16), g1v = __uint_as_float(gv[q] & 0xFFFF0000u);
            o[q] = pk_bf16(g0 * hv[2 * q] * rstd * mw[2 * q], g1v * hv[2 * q + 1] * rstd * mw[2 * q + 1]); }
        *(u32x4*)(WSP(bf16_t, WS_MRG) + row * 1024 + 384 + g * 64 + ch0) = o;
        LDS_SYNC(); }
}
DEVI void rg_carry(const Ctx& cx) {
    for (int idx = (cx.G - 1 - cx.bid) * NTHR + cx.tid; idx < NB * 2 * 384; idx += cx.G * NTHR) {
        const int ch = idx % 384, dir = (idx / 384) & 1, b = idx / 768;
        float A[RGC], B[RGC];
#pragma unroll
        for (int s = 0; s < RGC; ++s) { const int ck = dir == 0 ? s : (s < 4 ? 3 - s : 39 - s);
            const size_t ix = ((size_t)(b * RGC + ck) * 2 + dir) * 384 + ch; A[s] = WSP(float, WS_RGA)[ix]; B[s] = WSP(float, WS_RGB)[ix]; }
        float h = 0.f;
#pragma unroll
        for (int s = 0; s < RGC; ++s) { const int ck = dir == 0 ? s : (s < 4 ? 3 - s : 39 - s);
            const size_t ix = ((size_t)(b * RGC + ck) * 2 + dir) * 384 + ch; WSP(float, WS_RGC)[ix] = h; h = A[s] * h + B[s]; }
    }
}

DEVI int s5_trow(int rowi, int s) { const int b = rowi / S5C, c = rowi % S5C; return c < 8 ? b * CTXL + c * 32 + s : TCTX + b * SEQ + s * 64 + (c - 8); }
DEVI void s5_local_wave(const Ctx& cx, int l, int wu) {
    const int g = wu / 36, mt = (wu % 36) / 4, nt = wu % 4;
    const bf16_t* Pp = WSP(bf16_t, WS_P) + PC_S5 + g * 16;
    const bf16_t* we = WSP(bf16_t, WS_WE) + (size_t)(l * 16 + g) * 256 * 512 + (size_t)nt * 64 * 512;
    f32x4 acc[4][4];
    wave_gemm<4, 4>(cx.lane, 512, [&](int row, int k) { return ldg8(Pp + (size_t)s5_trow(mt * 64 + row, k >> 4) * NP + (k & 15)); },
                         [&](int row, int k) { return ldg8(we + (size_t)row * 512 + k); }, acc);
    const int fr = cx.lane & 15, fq = cx.lane >> 4;
#pragma unroll
    for (int m = 0; m < 4; ++m)
#pragma unroll
        for (int n = 0; n < 4; ++n) *(f32x4*)(WSP(float, WS_SLOC) + ((size_t)g * S5R + mt * 64 + m * 16 + fr) * 256 + nt * 64 + n * 16 + 4 * fq) = acc[m][n];
}
DEVI void s5_carry(const Ctx& cx, int l) {
    for (int idx = cx.bid * NTHR + cx.tid; idx < NB * 16 * 2 * 64; idx += cx.G * NTHR) {
        const int n = idx & 63, d = (idx >> 6) & 1, g = (idx >> 7) & 15, b = idx >> 11;
        const f32x2 a32 = WSP(f32x2, WS_PW)[(size_t)(((l * 16 + g) * 2 + d) * 64 + n) * 33 + 32];
        float sr = 0.f, si = 0.f;
#pragma unroll 1
        for (int s0 = 0; s0 < S5C; s0 += 24) {
            float lr[24], li[24];
#pragma unroll
            for (int j = 0; j < 24; ++j) { const int s = s0 + j, c = d == 0 ? s : (s < 8 ? 7 - s : 79 - s);
                const size_t ix = ((size_t)g * S5R + b * S5C + c) * 256 + d * 128 + n; lr[j] = WSP(float, WS_SLOC)[ix]; li[j] = WSP(float, WS_SLOC)[ix + 64]; }
#pragma unroll
            for (int j = 0; j < 24; ++j) { const int s = s0 + j, c = d == 0 ? s : (s < 8 ? 7 - s : 79 - s);
                const size_t ix = ((size_t)g * S5R + b * S5C + c) * 256 + d * 128 + n;
                WSP(bf16_t, WS_SIN)[ix] = f2bf(sr); WSP(bf16_t, WS_SIN)[ix + 64] = f2bf(si);
                const float nr = a32.x * sr - a32.y * si + lr[j], ni = a32.x * si + a32.y * sr + li[j]; sr = nr; si = ni; }
        }
    }
}
DEVI void s5_out_wave(const Ctx& cx, int l, int wu) {
    const int g = wu / 72, mt = (wu % 72) / 8, nt = wu % 8;
    const bf16_t* Pp = WSP(bf16_t, WS_P) + PC_S5 + g * 16;
    const bf16_t* sin_ = WSP(bf16_t, WS_SIN) + (size_t)g * S5R * 256;
    const bf16_t* wy = WSP(bf16_t, WS_WY) + (size_t)(l * 16 + g) * 512 * 768 + (size_t)nt * 64 * 768;
    f32x4 acc[4][4];
    wave_gemm<4, 4>(cx.lane, 768, [&](int row, int k) { return k < 512 ? ldg8(Pp + (size_t)s5_trow(mt * 64 + row, k >> 4) * NP + (k & 15)) : ldg8(sin_ + (size_t)(mt * 64 + row) * 256 + (k - 512)); },
                         [&](int row, int k) { return ldg8(wy + (size_t)row * 768 + k); }, acc);
    const int fr = cx.lane & 15, fq = cx.lane >> 4;
#pragma unroll
    for (int m = 0; m < 4; ++m)
#pragma unroll
        for (int n = 0; n < 4; ++n) { const int trow = s5_trow(mt * 64 + m * 16 + fr, nt * 4 + n);
            u32x2 w; w.x = pk_bf16(gelu_tanh(acc[m][n][0]), gelu_tanh(acc[m][n][1])); w.y = pk_bf16(gelu_tanh(acc[m][n][2]), gelu_tanh(acc[m][n][3]));
            *(u32x2*)(WSP(bf16_t, WS_GS) + (size_t)trow * 256 + g * 16 + 4 * fq) = w; }
}
DEVI void s5_glu_wave(const Ctx& cx, int l, int wu) {
    const int mt = wu / 4, nt = wu % 4;
    const bf16_t* gs = WSP(bf16_t, WS_GS) + (size_t)mt * 64 * 256;
    const bf16_t* wg = WSP(bf16_t, WS_WGLU) + (size_t)l * 65536 + (size_t)nt * 64 * 256;
    f32x4 acc[4][4];
    wave_gemm<4, 4>(cx.lane, 256, [&](int row, int k) { return ldg8(gs + (size_t)row * 256 + k); }, [&](int row, int k) { return ldg8(wg + (size_t)row * 256 + k); }, acc);
    const int fr = cx.lane & 15, fq = cx.lane >> 4;
#pragma unroll
    for (int n = 0; n < 4; ++n) { const int col = nt * 64 + n * 16 + 4 * fq;
        const f32x4 gb = *(const f32x4*)(cx.p->in[I_S5GB] + l * 256 + col), mw = *(const f32x4*)(cx.p->in[I_MIXW] + l * 1024 + 768 + col);
#pragma unroll
        for (int m = 0; m < 4; ++m) { const size_t trow = (size_t)mt * 64 + m * 16 + fr;
            const u32x2 gv = *(const u32x2*)(WSP(bf16_t, WS_GS) + trow * 256 + col);
            const float gq[4] = {__uint_as_float(gv.x << 16), __uint_as_float(gv.x & 0xFFFF0000u), __uint_as_float(gv.y << 16), __uint_as_float(gv.y & 0xFFFF0000u)};
            float o[4]; float ss = 0.f;
#pragma unroll
            for (int j = 0; j < 4; ++j) { o[j] = gq[j] * frcp(1.0f + __expf(-(acc[m][n][j] + gb[j]))); ss += o[j] * o[j]; }
            ss += shx<16>(ss, cx.lane); ss += shx<32>(ss, cx.lane);
            const float rstd = rsqrtf(ss * (1.0f / 16.0f) + EPS);
            u32x2 w; w.x = pk_bf16(o[0] * rstd * mw[0], o[1] * rstd * mw[1]); w.y = pk_bf16(o[2] * rstd * mw[2], o[3] * rstd * mw[3]);
            *(u32x2*)(WSP(bf16_t, WS_MRG) + trow * 1024 + 768 + col) = w; } }
}

#ifndef PH_DUP2
#define PH_DUP2 0
#endif
#define REP_(k) for (int rep_ = 0; rep_ < 1 + ((PH_DUP2 >> (k)) & 1); ++rep_)
DEVI void ph_mix_local(const Ctx& cx, int l) {
    REP_(0) for (int u = cx.bid; u < NB * 4 * MLC; u += cx.G) ml_local_unit(cx, l, u / (4 * MLC), (u / MLC) % 4, u % MLC);
    REP_(1) { const int off = (NB * 4 * MLC) % cx.G; const int first = (cx.bid - off + cx.G) % cx.G;
      for (int u = first; u < NB * RGC * 6; u += cx.G) rg_unit(cx, l, u / (RGC * 6), (u / 6) % RGC, u % 6, 0); }
    REP_(2) { const int off = (NB * 4 * MLC + NB * RGC * 6) % cx.G; const int first = (cx.bid - off + cx.G) % cx.G;
      for (int wu = first * 8 + cx.wave; wu < 16 * 36; wu += cx.G * 8) s5_local_wave(cx, l, wu); }
}
DEVI void ph_mix_carry(const Ctx& cx, int l) { ml_carry(cx); rg_carry(cx); s5_carry(cx, l); }
DEVI void ph_mix_out(const Ctx& cx, int l) {
    const bool last = (l == DEPTH - 1);
    REP_(3) for (int u = cx.bid; u < NB * 4 * MLC; u += cx.G) { const int c = u % MLC; if (last && c < 2) continue; ml_out_unit(cx, l, u / (4 * MLC), (u / MLC) % 4, c); }
    REP_(4) { const int off = (NB * 4 * MLC) % cx.G; const int first = (cx.bid - off + cx.G) % cx.G;
      for (int u = first; u < NB * RGC * 6; u += cx.G) { const int ck = (u / 6) % RGC; if (last && ck < 4) continue; rg_unit(cx, l, u / (RGC * 6), ck, u % 6, 1); } }
    REP_(5) { const int off = (NB * 4 * MLC + NB * RGC * 6) % cx.G; const int first = (cx.bid - off + cx.G) % cx.G;
      for (int wu = first * 8 + cx.wave; wu < 16 * 72; wu += cx.G * 8) s5_out_wave(cx, l, wu); }
}
DEVI void ph_glu(const Ctx& cx, int l) {
    for (int wu = cx.bid * 8 + cx.wave; wu < (TT / 64) * 4; wu += cx.G * 8) s5_glu_wave(cx, l, wu);
}

DEVI unsigned st_launder(unsigned s_addr) { unsigned a; asm volatile("v_mov_b32 %0, %1" : "=v"(a) : "s"(s_addr)); return a; }
constexpr int N_STEPS = 3 + 10 * DEPTH + 1;
__global__ void __launch_bounds__(NTHR, 2) mk_fwd(Params p) {
    extern __shared__ __attribute__((aligned(16))) unsigned char lds_raw[];
    Ctx cx; cx.p = &p; cx.ws = p.ws; cx.lds = (LAS unsigned char*)lds_raw; cx.tid = threadIdx.x; cx.lane = cx.tid & 63;
    cx.wave = __builtin_amdgcn_readfirstlane((int)threadIdx.x >> 6); cx.G = gridDim.x; cx.bid = blockIdx.x;
    volatile LAS unsigned* st = (volatile LAS unsigned*)(cx.lds + LDS_BYTES - 16);
    const unsigned st_s = (unsigned)__builtin_amdgcn_readfirstlane((int)(unsigned)(size_t)(LAS unsigned*)(cx.lds + LDS_BYTES - 16));
#define ST_P ((volatile LAS unsigned*)(size_t)st_launder(st_s))
    if (cx.tid == 0) { st[0] = 0u; st[1] = 0u; st[2] = (unsigned)p.lo; st[3] = (unsigned)p.hi; }
    __syncthreads();
    (void)xcd_barrier_post((unsigned*)(p.ws + WS_CTL) + CW_BAR, st);
#define GRID_BAR() do { XcdBarrier b_; b_.bar = (unsigned*)(p.ws + WS_CTL) + CW_BAR; b_.x = (unsigned)__builtin_amdgcn_readfirstlane((int)xb_xcc_id()); b_.st = ST_P; xcd_barrier(b_); } while (0)
#ifndef PH_MASK
#define PH_MASK 0xFFFF
#endif
#ifndef PH_DUP
#define PH_DUP 0
#endif
#define STEP_(id, k, call) do { const int lo_ = __builtin_amdgcn_readfirstlane((int)ST_P[2]), hi_ = __builtin_amdgcn_readfirstlane((int)ST_P[3]); if (lo_ <= (k) && (k) < hi_) { if ((PH_MASK >> (id)) & 1) { const Ctx cl = relaunder(cx); call; } if ((PH_DUP >> (id)) & 1) { GRID_BAR(); const Ctx cl = relaunder(cx); call; } if ((k) + 1 < hi_) GRID_BAR(); } } while (0)
    STEP_(0, 0, ph_pro_a(cl));
    STEP_(1, 1, ph_pro_b(cl));
    STEP_(2, 2, ph_pro_c(cl));
#pragma unroll 1
    for (int l = 0; l < DEPTH; ++l) {
        const int s0 = 3 + 10 * l;
        STEP_(3, s0 + 0, ph_norm1(cl, l));
        STEP_(4, s0 + 1, ph_inproj(cl, l));
        STEP_(5, s0 + 2, ph_mix_local(cl, l));
        STEP_(6, s0 + 3, ph_mix_carry(cl, l));
        STEP_(7, s0 + 4, ph_mix_out(cl, l));
        STEP_(8, s0 + 5, ph_glu(cl, l));
        STEP_(9, s0 + 6, ph_outproj(cl, l));
        STEP_(10, s0 + 7, ph_norm2(cl, l));
        STEP_(11, s0 + 8, ph_moe_gu(cl, l));
        STEP_(12, s0 + 9, ph_moe_dn(cl, l));
    }
    STEP_(13, N_STEPS - 1, ph_norm1(cl, DEPTH));
#undef STEP_
}

extern "C" void kernel_launch(void* const* d_in, const int* in_sizes, int n_in, void* d_out, int out_size, void* d_ws, size_t ws_size, hipStream_t stream) {
    static int grid = 0;
    if (grid == 0) {
        if (n_in != 36 || out_size != TLAT * DM || ws_size < WS_END) { fprintf(stderr, "kernel_launch: unexpected problem (n_in %d, out %d, ws %zu < %zu)\n", n_in, out_size, ws_size, (size_t)WS_END); grid = -1; return; }
        int dev = 0, cus = 0, per_cu = 0;
        if (hipGetDevice(&dev) != hipSuccess || hipDeviceGetAttribute(&cus, hipDeviceAttributeMultiprocessorCount, dev) != hipSuccess) { grid = -1; return; }
        if (hipFuncSetAttribute((const void*)mk_fwd, hipFuncAttributeMaxDynamicSharedMemorySize, LDS_BYTES) != hipSuccess) { fprintf(stderr, "kernel_launch: hipFuncSetAttribute failed\n"); grid = -1; return; }
        if (hipOccupancyMaxActiveBlocksPerMultiprocessor(&per_cu, (const void*)mk_fwd, NTHR, LDS_BYTES) != hipSuccess || per_cu < 1) { fprintf(stderr, "kernel_launch: occupancy query says %d blocks per CU\n", per_cu); }
        (void)hipGetLastError();
        grid = cus;
    }
    if (grid < 0) return;
    (void)hipMemsetAsync((char*)d_ws + WS_CTL, 0, CTL_BYTES, stream);
    Params p{};
    for (int i = 0; i < 36; ++i) p.in[i] = (const float*)d_in[i];
    p.out = (float*)d_out; p.ws = (unsigned char*)d_ws;
#if MK_FUSED
    p.lo = 0; p.hi = N_STEPS;
    hipLaunchKernelGGL(mk_fwd, dim3(grid), dim3(NTHR), LDS_BYTES, stream, p);
#else
    for (int k = 0; k < N_STEPS; ++k) { p.lo = k; p.hi = k + 1; hipLaunchKernelGGL(mk_fwd, dim3(grid), dim3(NTHR), LDS_BYTES, stream, p); }
#endif
}
```

```cpp
#include <hip/hip_runtime.h>
#include <stdint.h>
#include <stdio.h>

#ifndef MK_FUSED
#define MK_FUSED 1
#endif

typedef unsigned short bf16_t;
typedef short bf16x8 __attribute__((ext_vector_type(8)));
typedef float f32x4 __attribute__((ext_vector_type(4)));
typedef float f32x2 __attribute__((ext_vector_type(2)));
typedef unsigned u32x4 __attribute__((ext_vector_type(4)));
typedef unsigned u32x2 __attribute__((ext_vector_type(2)));
typedef int i32x4 __attribute__((ext_vector_type(4)));
typedef int i32x8 __attribute__((ext_vector_type(8)));
#define LAS __attribute__((address_space(3)))
#define DEVI __device__ __forceinline__

constexpr int DM = 1024, NB = 8, SEQ = 2048, CTXL = 256, DEPTH = 4;
constexpr int TCTX = NB * CTXL, TLAT = NB * SEQ, TT = TCTX + TLAT;
constexpr int DIN = 2576, NP = 2560;
constexpr int NE = 32;
constexpr int PMAX = 81920;
constexpr int NTHR = 512;
constexpr int LDS_BYTES = 152 * 1024;
constexpr float EPS = 1e-6f;
constexpr float W8_SCALE = 32.0f, W8_INV = 0.03125f;
constexpr float Y8_SCALE = 8.0f, Y8_INV = 0.125f;
constexpr int PC_Q = 0, PC_K = 384, PC_V = 768, PC_O = 1152, PC_RX = 1536, PC_RG = 1920, PC_S5 = 2304;
constexpr int MLC = 18;
constexpr int RGC = 36;
constexpr int S5C = 72, S5R = NB * S5C;

constexpr size_t al256(size_t x) { return (x + 255) & ~(size_t)255; }
constexpr size_t WS_CTL   = 0;
constexpr size_t CTL_BYTES = 65536;
constexpr size_t CW_BAR = 0;
constexpr size_t CW_CNT = 4096;
constexpr size_t WS_WIN   = al256(WS_CTL + CTL_BYTES);
constexpr size_t WS_WOUT  = al256(WS_WIN + (size_t)DEPTH * NP * 1024 * 2);
constexpr size_t WS_WGU   = al256(WS_WOUT + (size_t)DEPTH * 1024 * 1024 * 2);
constexpr size_t WS_WD    = al256(WS_WGU + (size_t)DEPTH * NE * 2048 * 1024 * 2);
constexpr size_t WS_MOD   = al256(WS_WD + (size_t)DEPTH * NE * 1024 * 1024 * 2);
constexpr size_t WS_PW    = al256(WS_MOD + (size_t)DEPTH * 9 * 6144 * 4);
constexpr size_t WS_BB    = al256(WS_PW + (size_t)DEPTH * 16 * 2 * 64 * 33 * 8);
constexpr size_t WS_KT    = al256(WS_BB + (size_t)DEPTH * 16 * 2 * 64 * 16 * 8);
constexpr size_t WS_WY    = al256(WS_KT + (size_t)DEPTH * 16 * 2 * 32 * 256 * 4);
constexpr size_t WS_WE    = al256(WS_WY + (size_t)DEPTH * 16 * 512 * 768 * 2);
constexpr size_t WS_WRG   = al256(WS_WE + (size_t)DEPTH * 16 * 256 * 512 * 2);
constexpr size_t WS_WGLU  = al256(WS_WRG + (size_t)DEPTH * 6 * 256 * 64 * 2);
constexpr size_t WS_XS    = al256(WS_WGLU + (size_t)DEPTH * 256 * 256 * 2);
constexpr size_t WS_XMID  = al256(WS_XS + (size_t)TT * 1024 * 4);
constexpr size_t WS_H     = al256(WS_XMID + (size_t)TT * 1024 * 4);
constexpr size_t WS_GT    = al256(WS_H + (size_t)TT * 1024 * 2);
constexpr size_t WS_P     = al256(WS_GT + (size_t)TT * 16 * 4);
constexpr size_t WS_GB    = al256(WS_P + (size_t)TT * NP * 2);
constexpr size_t WS_GU    = al256(WS_GB + (size_t)TT * 8 * 4);
constexpr size_t WS_GCM   = al256(WS_GU + (size_t)TT * 8 * 4);
constexpr size_t WS_MSC   = al256(WS_GCM + (size_t)TT * 8 * 4);
constexpr size_t WS_CLOC  = al256(WS_MSC + (size_t)8 * 4 * 18 * 2 * 2 * 4);
constexpr size_t WS_NLOC  = al256(WS_CLOC + (size_t)8 * 4 * 18 * 2 * 9216 * 4);
constexpr size_t WS_C0    = al256(WS_NLOC + (size_t)8 * 4 * 18 * 2 * 96 * 4);
constexpr size_t WS_N0    = al256(WS_C0 + (size_t)8 * 4 * 18 * 2 * 9216 * 2);
constexpr size_t WS_M0    = al256(WS_N0 + (size_t)8 * 4 * 18 * 2 * 96 * 4);
constexpr size_t WS_RGA   = al256(WS_M0 + (size_t)8 * 4 * 18 * 2 * 4);
constexpr size_t WS_RGB   = al256(WS_RGA + (size_t)8 * 36 * 2 * 384 * 4);
constexpr size_t WS_RGC   = al256(WS_RGB + (size_t)8 * 36 * 2 * 384 * 4);
constexpr size_t WS_SLOC  = al256(WS_RGC + (size_t)8 * 36 * 2 * 384 * 4);
constexpr size_t WS_SIN   = al256(WS_SLOC + (size_t)16 * 576 * 256 * 4);
constexpr size_t WS_GS    = al256(WS_SIN + (size_t)16 * 576 * 256 * 2);
constexpr size_t WS_MRG   = al256(WS_GS + (size_t)TT * 256 * 2);
constexpr size_t WS_ELIST = al256(WS_MRG + (size_t)TT * 1024 * 2);
constexpr size_t WS_GLIST = al256(WS_ELIST + (size_t)NE * TT * 4);
constexpr size_t WS_TINFO = al256(WS_GLIST + (size_t)NE * TT * 4);
constexpr size_t WS_ACT   = al256(WS_TINFO + (size_t)TT * 4 * 4);
constexpr size_t WS_YPAD  = al256(WS_ACT + (size_t)PMAX * 1024 * 2);
constexpr size_t WS_BIN2  = al256(WS_YPAD + (size_t)PMAX * 1024 * 2);
constexpr size_t WS_HLO   = al256(WS_BIN2 + (size_t)DEPTH * NP * 4);
constexpr size_t WS_WGT   = al256(WS_HLO + (size_t)TT * 1024 * 2);
constexpr size_t WS_RWH   = al256(WS_WGT + (size_t)DEPTH * 16 * 1024 * 2);
constexpr size_t WS_RWL   = al256(WS_RWH + (size_t)DEPTH * 32 * 1024 * 2);
constexpr size_t WS_H8    = al256(WS_RWL + (size_t)DEPTH * 32 * 1024 * 2);
constexpr size_t WS_TGATE = al256(WS_H8 + (size_t)TT * 1024);
constexpr size_t WS_RGAB  = al256(WS_TGATE + (size_t)TT * 4 * 4);
constexpr size_t WS_HIN8  = al256(WS_RGAB + (size_t)NB * 36 * 6 * 16384 * 2);
constexpr size_t WS_END   = al256(WS_HIN8 + (size_t)TT * 1024);

struct Params { const float* in[36]; float* out; unsigned char* ws; int lo, hi; };

enum { I_X = 0, I_C, I_CTX, I_CCTX, I_ADAW, I_ADAB, I_N1W, I_WIN, I_BIN, I_RGCW, I_RGCB, I_RGWA, I_RGBA, I_RGWX, I_RGBX, I_RGLAM,
       I_S5LRE, I_S5LIM, I_S5LDT, I_S5BRE, I_S5BIM, I_S5CRE, I_S5CIM, I_S5D, I_S5GW, I_S5GB, I_MIXW, I_WOUT, I_N2W, I_RW, I_RB,
       I_WGU, I_BGU, I_WD, I_BD, I_FNW };

DEVI bf16_t f2bf(float f) { unsigned u = __float_as_uint(f); u += 0x7FFFu + ((u >> 16) & 1u); return (bf16_t)(u >> 16); }
DEVI float bf2f(bf16_t b) { return __uint_as_float(((unsigned)b) << 16); }
DEVI unsigned pk_bf16(float lo, float hi);
DEVI bf16_t f2bf_hw(float f);
DEVI unsigned pk_bf16(float lo, float hi) { unsigned r; asm("v_cvt_pk_bf16_f32 %0, %1, %2" : "=v"(r) : "v"(lo), "v"(hi)); return r; }
DEVI unsigned pk4_fp8(float a, float b, float c, float d) { int p = __builtin_amdgcn_cvt_pk_fp8_f32(a, b, 0, false); p = __builtin_amdgcn_cvt_pk_fp8_f32(c, d, p, true); return (unsigned)p; }
DEVI float q8(float x) { const int p = __builtin_amdgcn_cvt_pk_fp8_f32(x, x, 0, false); return __builtin_amdgcn_cvt_f32_fp8(p, 0); }
DEVI bf16_t f2bf_hw(float f) { return (bf16_t)(pk_bf16(f, f) & 0xFFFFu); }
DEVI f32x4 bf4_f32(u32x2 r) { return (f32x4){__uint_as_float(r.x << 16), __uint_as_float(r.x & 0xFFFF0000u), __uint_as_float(r.y << 16), __uint_as_float(r.y & 0xFFFF0000u)}; }
DEVI u32x2 f32_bf4(f32x4 v) { u32x2 w; w.x = pk_bf16(v[0], v[1]); w.y = pk_bf16(v[2], v[3]); return w; }
DEVI float frcp(float x) { return __builtin_amdgcn_rcpf(x); }
DEVI float sigmoidf_(float x) { return frcp(1.0f + __expf(-x)); }
DEVI float gelu_tanh(float x) { const float u = 0.7978845608f * (x + 0.044715f * x * x * x); return x * frcp(1.0f + __expf(-2.0f * u)); }
template <int M> DEVI float shx(float v, int lane) {
    if constexpr (M < 32) return __int_as_float(__builtin_amdgcn_ds_swizzle(__float_as_int(v), 0x1F | (M << 10)));
    else return __int_as_float(__builtin_amdgcn_ds_bpermute((lane ^ 32) << 2, __float_as_int(v)));
}
DEVI float shxr(float v, int m, int lane) {
    switch (m) { case 1: return shx<1>(v, lane); case 2: return shx<2>(v, lane); case 4: return shx<4>(v, lane); case 8: return shx<8>(v, lane); case 16: return shx<16>(v, lane); default: return shx<32>(v, lane); }
}
DEVI int shxri(int v, int m, int lane) { return __float_as_int(shxr(__int_as_float(v), m, lane)); }
template <int CTRL, int ROWMASK> DEVI float dpp_(float v) { return __int_as_float(__builtin_amdgcn_update_dpp(0, __float_as_int(v), CTRL, ROWMASK, 0xF, false)); }
DEVI f32x2 gelu_tanh2(f32x2 x) { const f32x2 u = (x + x * x * x * 0.044715f) * (-2.0f * 0.7978845608f * 1.44269504f); f32x2 e; e.x = __builtin_amdgcn_exp2f(u.x); e.y = __builtin_amdgcn_exp2f(u.y); e = e + 1.0f; f32x2 r; r.x = frcp(e.x); r.y = frcp(e.y); return x * r; }
DEVI float wave_sum(float v, int) {
    v += dpp_<0xB1, 0xF>(v); v += dpp_<0x4E, 0xF>(v); v += dpp_<0x141, 0xF>(v); v += dpp_<0x140, 0xF>(v);
    v += dpp_<0x142, 0xA>(v); v += dpp_<0x143, 0xC>(v);
    return __int_as_float(__builtin_amdgcn_readlane(__float_as_int(v), 63));
}
template <bool MAX> DEVI float wave_scan(float v, int lane) {
#pragma unroll
    for (int off = 1; off < 64; off <<= 1) { const float o = __int_as_float(__builtin_amdgcn_ds_bpermute((lane - off) << 2, __float_as_int(v))); if (lane >= off) v = MAX ? fmaxf(v, o) : v + o; }
    return v;
}
DEVI float log1p_(float e) { return e < 0.06f ? e * (1.0f - e * (0.5f - e * (0.33333334f - e * 0.25f))) : __logf(1.0f + e); }
#define LDS_SYNC() do { asm volatile("s_waitcnt lgkmcnt(0)" ::: "memory"); __builtin_amdgcn_s_barrier(); asm volatile("" ::: "memory"); } while (0)
DEVI int mod_row(int row) { return row < TCTX ? 8 : (row - TCTX) / SEQ; }

#define XB_TMO      128
#define XB_XCNT(j)  (256  + 64 * (j))
#define XB_XSUB(j)  (1280 + 64 * (j))
#define XB_XGEN(j)  (2304 + 64 * (j))
#define XB_TOP      3328
#define XB_TOPGEN   3392
#define XCD_BAR_WORDS 3456
#define XB_SPIN_CAP (1u << 18)
__device__ __forceinline__ unsigned xb_ld(unsigned* p)              { return __hip_atomic_load(p, __ATOMIC_RELAXED, __HIP_MEMORY_SCOPE_AGENT); }
__device__ __forceinline__ unsigned xb_add(unsigned* p, unsigned v) { return __hip_atomic_fetch_add(p, v, __ATOMIC_RELAXED, __HIP_MEMORY_SCOPE_AGENT); }
__device__ __forceinline__ unsigned xb_xcc_id() { return (unsigned)__builtin_amdgcn_s_getreg((3 << 11) | 20) & 0xFu; }
#define XB_SPIN(cond, bar) do { unsigned _sp = 0; while (cond) { __builtin_amdgcn_s_sleep(1); \
    if ((++_sp & 255u) == 0u) { if (xb_ld(&(bar)[XB_TMO])) break; if (_sp > XB_SPIN_CAP) { atomicAdd(&(bar)[XB_TMO], 1u); break; } } } } while (0)
struct XcdBarrier { unsigned* bar; unsigned x; volatile LAS unsigned* st; };
__device__ __forceinline__ XcdBarrier xcd_barrier_post(unsigned* bar, volatile LAS unsigned* st) {
    XcdBarrier b; b.bar = bar; b.x = xb_xcc_id(); b.st = st;
    if (threadIdx.x == 0) (void)xb_add(&bar[XB_XCNT(b.x)], 1u);
    return b;
}
__device__ __forceinline__ void xcd_barrier_complete(unsigned* bar, unsigned x, unsigned& nloc, unsigned& nx) {
    const unsigned G = gridDim.x * gridDim.y * gridDim.z;
    unsigned sum, cnt, mine, sp = 0u;
    for (;;) {
        sum = 0u; cnt = 0u; mine = 0u;
#pragma unroll
        for (unsigned j = 0; j < 16; ++j) { const unsigned c = xb_ld(&bar[XB_XCNT(j)]); sum += c; cnt += (c > 0u) ? 1u : 0u; mine = (j == x) ? c : mine; }
        if (sum == G) break;
        __builtin_amdgcn_s_sleep(1);
        if ((++sp & 255u) == 0u) { if (xb_ld(&bar[XB_TMO])) break; if (sp > XB_SPIN_CAP) { atomicAdd(&bar[XB_TMO], 1u); break; } }
    }
    nloc = mine > 0u ? mine : 1u; nx = cnt > 0u ? cnt : 1u;
}
__device__ __forceinline__ void xcd_barrier(const XcdBarrier& b) {
    asm volatile("s_waitcnt vmcnt(0)" ::: "memory");
    __syncthreads();
    if (threadIdx.x == 0) {
        unsigned* bar = b.bar;
        __builtin_amdgcn_s_waitcnt(0);
        unsigned nloc = b.st[0], nx = b.st[1];
        if (nloc == 0u) { xcd_barrier_complete(bar, b.x, nloc, nx); b.st[0] = nloc; b.st[1] = nx; }
        const unsigned old = xb_add(&bar[XB_XSUB(b.x)], 1u);
        const unsigned gen = old / nloc;
        if (old + 1u == (gen + 1u) * nloc) {
            __builtin_amdgcn_fence(__ATOMIC_RELEASE, "agent");
            asm volatile("s_waitcnt vmcnt(0)" ::: "memory");
            const unsigned og = xb_add(&bar[XB_TOP], 1u);
            const unsigned tg = og / nx;
            if (og + 1u == (tg + 1u) * nx) xb_add(&bar[XB_TOPGEN], 1u);
            else XB_SPIN(xb_ld(&bar[XB_TOPGEN]) == tg, bar);
            __builtin_amdgcn_fence(__ATOMIC_ACQUIRE, "agent");
            xb_add(&bar[XB_XGEN(b.x)], 1u);
            asm volatile("s_waitcnt vmcnt(0)" ::: "memory");
        } else {
            XB_SPIN(xb_ld(&bar[XB_XGEN(b.x)]) == gen, bar);
            __builtin_amdgcn_fence(__ATOMIC_ACQUIRE, "agent");
            asm volatile("s_waitcnt vmcnt(0)" ::: "memory");
        }
    }
    __syncthreads();
}

namespace g1 {
constexpr int BM = 256, BK = 64, HALF = 128, HTB = HALF * BK * 2, STAGE_BYTES = 8 * HTB, K = 1024, NT = K / BK;
DEVI int lds_byte(int r, int c) { const int st = (r >> 4) * 2 + (c >> 5), rr = r & 15, cc = c & 31, ob = rr * 64 + cc * 2; return st * 1024 + (ob ^ (((ob >> 9) & 1) << 5)); }
DEVI void stage_rc(int b, int& R, int& C) { const int st = b / 1024, sb = b % 1024, swz = sb ^ (((sb >> 9) & 1) << 5); R = (st >> 1) * 16 + swz / 64; C = (st & 1) * 32 + (swz % 64) / 2; }
DEVI int perm32(int rho) { const int n = rho >> 4, i = rho & 15; return 8 * (i >> 2) + 4 * n + (i & 3); }

struct Unit {
    const char* A;
    const int* list;
    int nvalid;
    const char* B;
    int pm, pn, e;
};

template <bool F8> struct FragT { typedef bf16x8 T; static constexpr int NK = 2; };
template <> struct FragT<true> { typedef i32x8 T; static constexpr int NK = 1; };
template <bool GATHER, int KB>
DEVI void a_offsets(const Unit& u, int tid, unsigned (&v)[2][2]) {
    int tz = tid; asm volatile("" : "+v"(tz));
#pragma unroll
    for (int i = 0; i < 2; ++i) {
        int R, C; stage_rc(tz * 16 + i * 8192, R, C);
#pragma unroll
        for (int h = 0; h < 2; ++h) {
            const int r = h * HALF + R;
            int src = r;
            if (GATHER) { const int nv = u.nvalid > 256 ? 256 : u.nvalid; const int ld_ = u.list[r < nv ? r : nv - 1]; src = (r < nv) ? ld_ : 0; }
            v[h][i] = (unsigned)src * (unsigned)KB + (unsigned)(C * 2);
        }
    }
}
DEVI void a_request(const Unit& u, int tid, int (&raw)[2][2]) {
    int tz = tid; asm volatile("" : "+v"(tz));
    const int nv = u.nvalid > 256 ? 256 : u.nvalid;
#pragma unroll
    for (int i = 0; i < 2; ++i) { int R, C; stage_rc(tz * 16 + i * 8192, R, C);
#pragma unroll
        for (int h = 0; h < 2; ++h) { const int r = h * HALF + R; raw[h][i] = u.list[r < nv ? r : nv - 1]; } }
}
template <int KB>
DEVI void a_finish(int nvalid, int tid, int (&raw)[2][2], unsigned (&v)[2][2]) {
    asm volatile("" : "+v"(raw[0][0]), "+v"(raw[0][1]), "+v"(raw[1][0]), "+v"(raw[1][1]));
    int tz = tid; asm volatile("" : "+v"(tz));
    const int nv = nvalid > 256 ? 256 : nvalid;
#pragma unroll
    for (int i = 0; i < 2; ++i) { int R, C; stage_rc(tz * 16 + i * 8192, R, C);
#pragma unroll
        for (int h = 0; h < 2; ++h) { const int r = h * HALF + R; const int src = (r < nv) ? raw[h][i] : 0; v[h][i] = (unsigned)src * (unsigned)KB + (unsigned)(C * 2); } }
}

template <class Sched, class Epi, bool GATHER, bool FP8 = false>
DEVI void gemm_phase(LAS unsigned char* lds, const int tid, const Sched& S, const Epi& E) {
    constexpr int KB = FP8 ? 1024 : 2048, NTK = KB / 128, NK = FragT<FP8>::NK;
    typedef typename FragT<FP8>::T frag_t;
    int sc1 = 0x7F7F7F7F; asm volatile("" : "+v"(sc1));
    const int wid = __builtin_amdgcn_readfirstlane(tid >> 6), lane = tid & 63, wr = wid >> 2, wc = wid & 3, fr = lane & 15, fq = lane >> 4;
    unsigned voffB[2];
#pragma unroll
    for (int i = 0; i < 2; ++i) { int R, C; stage_rc(tid * 16 + i * 8192, R, C); const int Rb = Epi::PERM ? ((R & ~31) + perm32(R & 31)) : R; voffB[i] = (unsigned)(Rb * KB + C * 2); }
    constexpr size_t kstep = (size_t)(BK * 2);
    constexpr size_t hstep = (size_t)HALF * KB;
    const unsigned ldsw = (unsigned)wid * 1024u;
    const int aoff = FP8 ? lds_byte(wr * 64 + fr, fq * 16) : lds_byte(wr * 64 + fr, fq * 8), boff = FP8 ? lds_byte(wc * 32 + fr, fq * 16) : lds_byte(wc * 32 + fr, fq * 8);
    const int sw16 = FP8 ? 16 * (fq & 1) : 0;
    unsigned pa_ = (unsigned)(size_t)(lds + aoff) + sw16, pb_ = (unsigned)(size_t)(lds + 65536 + boff) + sw16, pa2_ = (unsigned)(size_t)(lds + aoff) + (16 - sw16), pb2_ = (unsigned)(size_t)(lds + 65536 + boff) + (16 - sw16);
    asm volatile("" : "+v"(pa_), "+v"(pb_), "+v"(pa2_), "+v"(pb2_));
    LAS unsigned char* const pa = (LAS unsigned char*)(size_t)pa_; LAS unsigned char* const pb = (LAS unsigned char*)(size_t)pb_;
    LAS unsigned char* const pa2 = (LAS unsigned char*)(size_t)pa2_; LAS unsigned char* const pb2 = (LAS unsigned char*)(size_t)pb2_;
#define G1_SA(b, h) (((b) * 2 + (h)) * HTB)
#define G1_SB(b, h) ((4 + (b) * 2 + (h)) * HTB)
#define G1_STAGE2(bufoff, gbase, v0, v1) do { \
        __builtin_amdgcn_global_load_lds((const unsigned*)((const char*)(gbase) + (v0)), (LAS unsigned*)(lds + (bufoff) + ldsw), 16, 0, 0); \
        __builtin_amdgcn_global_load_lds((const unsigned*)((const char*)(gbase) + (v1)), (LAS unsigned*)(lds + (bufoff) + ldsw + 8192), 16, 0, 0); } while (0)
#define G1_LDFRAG(dst, ptr, ptr2) do { if constexpr (FP8) { const i32x4 lo_ = *(const LAS i32x4*)(ptr), hi_ = *(const LAS i32x4*)(ptr2); dst = __builtin_shufflevector(lo_, hi_, 0, 1, 2, 3, 4, 5, 6, 7); } \
        else { dst = *(const LAS frag_t*)(ptr); } } while (0)
#define G1_LDA(dst, b, h) do { _Pragma("unroll") for (int m = 0; m < 4; ++m) _Pragma("unroll") for (int k = 0; k < NK; ++k) G1_LDFRAG(dst[m][k], pa + (G1_SA(b, h) + m * 2048 + k * 1024), pa2 + (G1_SA(b, h) + m * 2048 + k * 1024)); } while (0)
#define G1_LDB(dst, b, h) do { _Pragma("unroll") for (int n = 0; n < 2; ++n) _Pragma("unroll") for (int k = 0; k < NK; ++k) G1_LDFRAG(dst[n][k], pb + (G1_SB(b, h) - 65536 + n * 2048 + k * 1024), pb2 + (G1_SB(b, h) - 65536 + n * 2048 + k * 1024)); } while (0)
#define G1_MFMA(c_, b_, a_) do { if constexpr (FP8) asm volatile("v_mfma_scale_f32_16x16x128_f8f6f4 %0, %1, %2, %0, %3, %3 op_sel_hi:[0,0,0]" : "+v"(c_) : "v"(b_), "v"(a_), "v"(sc1)); \
        else c_ = __builtin_amdgcn_mfma_f32_16x16x32_bf16(b_, a_, c_, 0, 0, 0); } while (0)
#define G1_MMA(ai, bj, At, Bt) do { __builtin_amdgcn_s_setprio(1); _Pragma("unroll") for (int m = 0; m < 4; ++m) _Pragma("unroll") for (int n = 0; n < 2; ++n) _Pragma("unroll") for (int k = 0; k < NK; ++k) \
        G1_MFMA(acc[ai][bj][m][n], Bt[n][k], At[m][k]); __builtin_amdgcn_s_setprio(0); } while (0)
#define G1_WAIT_V(n) asm volatile("s_waitcnt vmcnt(" #n ")" ::: "memory")
#define G1_WAIT_L(n) asm volatile("s_waitcnt lgkmcnt(" #n ")" ::: "memory")
#define G1_BAR __builtin_amdgcn_s_barrier()
#define G1_SCHED __builtin_amdgcn_sched_barrier(0)
    Unit cur, nxt; int ui = 0;
    if (!S.get(0, cur)) return;
    f32x4 acc[2][2][4][2];
#pragma unroll
    for (int a = 0; a < 2; ++a)
#pragma unroll
        for (int b = 0; b < 2; ++b)
#pragma unroll
            for (int m = 0; m < 4; ++m)
#pragma unroll
                for (int n = 0; n < 2; ++n) acc[a][b][m][n] = (f32x4){0.f, 0.f, 0.f, 0.f};
    frag_t At[4][NK], B0[2][NK], B1[2][NK];
    unsigned vc[2][2], vn[2][2];
    a_offsets<GATHER, KB>(cur, tid, vc);
    const char* cA = cur.A; const char* cB = cur.B;
    LAS unsigned char* const aux = lds + STAGE_BYTES + 2048;
    if constexpr (Epi::LDSC) { if (tid < 256) __builtin_amdgcn_global_load_lds((const unsigned*)(E.cptr(cur, tid)), (LAS unsigned*)(aux + ldsw / 4), 4, 0, 0); }
    G1_STAGE2(G1_SB(0, 0), cB, voffB[0], voffB[1]); G1_STAGE2(G1_SA(0, 0), cA, vc[0][0], vc[0][1]);
    G1_STAGE2(G1_SB(0, 1), cB + hstep, voffB[0], voffB[1]); G1_STAGE2(G1_SA(0, 1), cA, vc[1][0], vc[1][1]);
    if (wr == 1) G1_BAR;
    G1_WAIT_V(4); G1_BAR;
    G1_STAGE2(G1_SB(1, 0), cB + kstep, voffB[0], voffB[1]); G1_STAGE2(G1_SA(1, 0), cA + kstep, vc[0][0], vc[0][1]);
    G1_STAGE2(G1_SB(1, 1), cB + hstep + kstep, voffB[0], voffB[1]);
    G1_WAIT_V(6); G1_BAR;
    for (;;) {
        const bool has_next = S.get(ui + 1, nxt);
        if constexpr (Epi::LDSC) { if (has_next && tid < 256) __builtin_amdgcn_global_load_lds((const unsigned*)(E.cptr(nxt, tid)), (LAS unsigned*)(aux + ((ui + 1) % 3) * 1024 + ldsw / 4), 4, 0, 0); }
        int raw[2][2] = {{0, 0}, {0, 0}};
        if (has_next) { if constexpr (GATHER) a_request(nxt, tid, raw); else a_offsets<GATHER, KB>(nxt, tid, vn); }
        else {
#pragma unroll
            for (int h = 0; h < 2; ++h)
#pragma unroll
                for (int i = 0; i < 2; ++i) vn[h][i] = vc[h][i];
        }
        const char* nA = has_next ? nxt.A : cA; const char* nB = has_next ? nxt.B : cB;
#pragma unroll 1
        for (int t = 0; t < NTK; t += 2) {
            const bool last = (t == NTK - 2);
            const char* a1 = cA + (size_t)(t + 1) * kstep;
            const char* a2 = last ? nA : cA + (size_t)(t + 2) * kstep; const char* b2 = last ? nB : cB + (size_t)(t + 2) * kstep;
            const char* a3 = a2 + kstep; const char* b3 = b2 + kstep;
            unsigned w00 = vc[0][0], w01 = vc[0][1], w10 = vc[1][0], w11 = vc[1][1];
            if (last) { if constexpr (GATHER) { if (has_next) a_finish<KB>(nxt.nvalid, tid, raw, vn); }
                w00 = vn[0][0]; w01 = vn[0][1]; w10 = vn[1][0]; w11 = vn[1][1]; asm volatile("" : "+v"(w00), "+v"(w01), "+v"(w10), "+v"(w11)); }
            G1_LDB(B0, 0, 0); G1_SCHED; G1_LDA(At, 0, 0); G1_STAGE2(G1_SA(1, 1), a1, vc[1][0], vc[1][1]);
            G1_WAIT_L(8); G1_BAR; G1_WAIT_L(0); G1_MMA(0, 0, At, B0); G1_BAR; G1_SCHED;
            G1_LDB(B1, 0, 1); G1_STAGE2(G1_SB(0, 0), b2, voffB[0], voffB[1]);
            G1_BAR; G1_WAIT_L(0); G1_MMA(0, 1, At, B1); G1_BAR;
            G1_LDA(At, 0, 1); G1_STAGE2(G1_SA(0, 0), a2, w00, w01);
            G1_BAR; G1_WAIT_L(0); G1_MMA(1, 0, At, B0); G1_BAR; G1_SCHED;
            G1_STAGE2(G1_SB(0, 1), b2 + hstep, voffB[0], voffB[1]);
            G1_WAIT_V(6); G1_BAR; G1_MMA(1, 1, At, B1); G1_BAR;
            G1_LDB(B0, 1, 0); G1_SCHED; G1_LDA(At, 1, 0); G1_STAGE2(G1_SA(0, 1), a2, w10, w11);
            G1_WAIT_L(8); G1_BAR; G1_WAIT_L(0); G1_MMA(0, 0, At, B0); G1_BAR; G1_SCHED;
            G1_LDB(B1, 1, 1); G1_STAGE2(G1_SB(1, 0), b3, voffB[0], voffB[1]);
            G1_BAR; G1_WAIT_L(0); G1_MMA(0, 1, At, B1); G1_BAR;
            G1_LDA(At, 1, 1); G1_STAGE2(G1_SA(1, 0), a3, w00, w01);
            G1_BAR; G1_WAIT_L(0); G1_MMA(1, 0, At, B0); G1_BAR; G1_SCHED;
            G1_STAGE2(G1_SB(1, 1), b3 + hstep, voffB[0], voffB[1]);
            G1_WAIT_V(6); G1_BAR; G1_MMA(1, 1, At, B1); G1_BAR;
        }
        if constexpr (FP8) asm volatile("s_nop 15\n\ts_nop 15" ::: "memory");
        if constexpr (Epi::LDSC) E(acc, cur, wr, wc, fr, fq, (const LAS float*)(aux + (ui % 3) * 1024)); else E(acc, cur, wr, wc, fr, fq);
        if (!has_next) break;
#pragma unroll
        for (int a = 0; a < 2; ++a)
#pragma unroll
            for (int b = 0; b < 2; ++b)
#pragma unroll
                for (int m = 0; m < 4; ++m)
#pragma unroll
                    for (int n = 0; n < 2; ++n) acc[a][b][m][n] = (f32x4){0.f, 0.f, 0.f, 0.f};
        cur = nxt; cA = nA; cB = nB; ++ui;
#pragma unroll
        for (int h = 0; h < 2; ++h)
#pragma unroll
            for (int i = 0; i < 2; ++i) vc[h][i] = vn[h][i];
    }
    G1_WAIT_V(0);
    if (wr == 0) G1_BAR;
    G1_BAR;
}
}

DEVI int epi_src(int fr, int fq) { const int L = fq * 16 + fr; return (16 * (L & 3) + 4 * (L >> 4) + ((L >> 2) & 3)) << 2; }
DEVI unsigned bperm(int src, unsigned v) { return (unsigned)__builtin_amdgcn_ds_bpermute(src, (int)v); }
DEVI float bpermf(int src, float v) { return __int_as_float(__builtin_amdgcn_ds_bpermute(src, __float_as_int(v))); }
template <int MT, int NT_, class AF, class BF>
DEVI void wave_gemm(int KS, const AF& af, const BF& bf, f32x4 (&acc)[MT][NT_]) {
#pragma unroll
    for (int m = 0; m < MT; ++m)
#pragma unroll
        for (int n = 0; n < NT_; ++n) acc[m][n] = (f32x4){0.f, 0.f, 0.f, 0.f};
    bf16x8 fa[4][MT], fb[4][NT_];
#define WG_LOAD(S, KK) do { _Pragma("unroll") for (int m = 0; m < MT; ++m) fa[S][m] = af(m, (KK)); _Pragma("unroll") for (int n = 0; n < NT_; ++n) fb[S][n] = bf(n, (KK)); } while (0)
#define WG_MMA(S) do { _Pragma("unroll") for (int m = 0; m < MT; ++m) _Pragma("unroll") for (int n = 0; n < NT_; ++n) acc[m][n] = __builtin_amdgcn_mfma_f32_16x16x32_bf16(fb[S][n], fa[S][m], acc[m][n], 0, 0, 0); } while (0)
#define WG_SB() __builtin_amdgcn_sched_barrier(0)
    WG_LOAD(0, 0); WG_LOAD(1, 1); WG_LOAD(2, 2); WG_SB();
#pragma unroll 1
    for (int k0 = 0; k0 < KS - 4; k0 += 4) {
        WG_LOAD(3, k0 + 3); WG_SB(); WG_MMA(0); WG_SB();
        WG_LOAD(0, k0 + 4); WG_SB(); WG_MMA(1); WG_SB();
        WG_LOAD(1, k0 + 5); WG_SB(); WG_MMA(2); WG_SB();
        WG_LOAD(2, k0 + 6); WG_SB(); WG_MMA(3); WG_SB();
    }
    WG_LOAD(3, KS - 1); WG_SB(); WG_MMA(0); WG_SB(); WG_MMA(1); WG_SB(); WG_MMA(2); WG_SB(); WG_MMA(3);
#undef WG_SB
#undef WG_LOAD
#undef WG_MMA
}
DEVI bf16x8 ldg8(const bf16_t* p) { return *(const bf16x8*)p; }

template <int N> struct Log2 { static constexpr int v = 1 + Log2<N / 2>::v; };
template <> struct Log2<1> { static constexpr int v = 0; };
template <int N>
DEVI float reduce_scatter(const int lane, float (&v)[N]) {
    constexpr int LG = Log2<N>::v;
#pragma unroll
    for (int st = 0; st < LG; ++st) {
        const int s = (N / 2) >> st, mask = 32 >> st;
        const bool up = (lane & mask) != 0;
#pragma unroll
        for (int i = 0; i < N / 2; ++i) if (i < s) {
            const float send = up ? v[i] : v[i + s];
            const float keep = up ? v[i + s] : v[i];
            v[i] = keep + shxr(send, mask, lane);
        }
    }
    float r = v[0];
#pragma unroll
    for (int st = LG; st < 6; ++st) r += shxr(r, 32 >> st, lane);
    return r;
}
template <int N>
DEVI int rs_index(int lane) {
    constexpr int LG = Log2<N>::v;
    int idx = 0;
#pragma unroll
    for (int st = 0; st < LG; ++st) if (lane & (32 >> st)) idx += (N / 2) >> st;
    return idx;
}

struct Ctx {
    const Params* p; unsigned char* ws; LAS unsigned char* lds; int tid, lane, wave, G, bid;
};
#define WSP(T, off) ((T*)(cx.ws + (off)))
DEVI Ctx relaunder(const Ctx& c) { Ctx r = c; int ln, td;
    asm volatile("v_mbcnt_lo_u32_b32 %0, -1, 0\n\tv_mbcnt_hi_u32_b32 %0, -1, %0\n\tv_lshl_add_u32 %1, %2, 6, %0" : "=&v"(ln), "=v"(td) : "s"(c.wave));
    r.lane = ln; r.tid = td; return r; }

DEVI void cvt_tile(const Ctx& cx, const float* src, int ld, bf16_t* dst, int n0, int k0, int kind) {
    LAS bf16_t* tile = (LAS bf16_t*)cx.lds;
    const int n4 = (cx.tid & 63) * 4, w8 = (cx.tid >> 6) * 8, n = n0 + n4;
    int sc; float scale = 1.0f;
    if (kind == 0) { sc = n < 1536 ? n : n + 16; if (n >= 384 && n < 768) scale = 0.10206207261596577f; }
    else if (kind == 2) { const int pn = n >> 8, w = n & 255; sc = w < 128 ? pn * 128 + w : 1024 + pn * 128 + (w - 128); }
    else sc = n;
#pragma unroll 1
    for (int sub = 0; sub < 4; sub += 2) {
        f32x4 v[2][8];
#pragma unroll
        for (int s2 = 0; s2 < 2; ++s2)
#pragma unroll
            for (int p = 0; p < 8; ++p) v[s2][p] = __builtin_nontemporal_load((const f32x4*)(src + (size_t)(k0 + (sub + s2) * 64 + w8 + p) * ld + sc));
#pragma unroll
        for (int s2 = 0; s2 < 2; ++s2)
#pragma unroll
            for (int j = 0; j < 4; ++j) { u32x4 w;
                w.x = pk_bf16(v[s2][0][j] * scale, v[s2][1][j] * scale); w.y = pk_bf16(v[s2][2][j] * scale, v[s2][3][j] * scale);
                w.z = pk_bf16(v[s2][4][j] * scale, v[s2][5][j] * scale); w.w = pk_bf16(v[s2][6][j] * scale, v[s2][7][j] * scale);
                *(LAS u32x4*)(tile + (n4 + j) * 264 + (sub + s2) * 64 + w8) = w; }
    }
    LDS_SYNC();
#pragma unroll
    for (int i = 0; i < 16; ++i) { const int idx = cx.tid + NTHR * i, row = idx >> 5, ch = idx & 31;
        const u32x4 o = *(const LAS u32x4*)(tile + row * 264 + ch * 8);
        *(u32x4*)(dst + (size_t)(n0 + row) * 1024 + k0 + ch * 8) = o; }
    LDS_SYNC();
}

DEVI void cvt_tile8(const Ctx& cx, const float* src, int ld, unsigned char* dst, int n0, int k0, int kind) {
    LAS unsigned char* tile = cx.lds;
    const int n4 = (cx.tid & 63) * 4, w8 = (cx.tid >> 6) * 8, n = n0 + n4;
    int sc; float wsc = W8_SCALE;
    if (kind == 2) { const int pn = n >> 8, w = n & 255; sc = w < 128 ? pn * 128 + w : 1024 + pn * 128 + (w - 128); }
    else if (kind == 0) { sc = n < 1536 ? n : n + 16; }
    else sc = n;
#pragma unroll 1
    for (int sub = 0; sub < 4; sub += 2) {
        f32x4 v[2][8];
#pragma unroll
        for (int s2 = 0; s2 < 2; ++s2)
#pragma unroll
            for (int p = 0; p < 8; ++p) v[s2][p] = __builtin_nontemporal_load((const f32x4*)(src + (size_t)(k0 + (sub + s2) * 64 + w8 + p) * ld + sc));
#pragma unroll
        for (int s2 = 0; s2 < 2; ++s2)
#pragma unroll
            for (int j = 0; j < 4; ++j) { u32x2 w;
                w.x = pk4_fp8(v[s2][0][j] * wsc, v[s2][1][j] * wsc, v[s2][2][j] * wsc, v[s2][3][j] * wsc);
                w.y = pk4_fp8(v[s2][4][j] * wsc, v[s2][5][j] * wsc, v[s2][6][j] * wsc, v[s2][7][j] * wsc);
                *(LAS u32x2*)(tile + (n4 + j) * 272 + (sub + s2) * 64 + w8) = w; }
    }
    LDS_SYNC();
#pragma unroll
    for (int i = 0; i < 8; ++i) { const int idx = cx.tid + NTHR * i, row = idx >> 4, ch = idx & 15;
        const u32x4 o = *(const LAS u32x4*)(tile + row * 272 + ch * 16);
        *(u32x4*)(dst + (size_t)(n0 + row) * 1024 + k0 + ch * 16) = o; }
    LDS_SYNC();
}
DEVI void lds_fill16(LAS float* dst, const float* src, int n4, int tid) {
    for (int i0 = tid; i0 < n4; i0 += NTHR * 4) {
        f32x4 v[4];
#pragma unroll
        for (int j = 0; j < 4; ++j) { const int i = min(i0 + NTHR * j, n4 - 1); v[j] = *(const f32x4*)(src + (size_t)i * 4); }
        __builtin_amdgcn_sched_barrier(0);
#pragma unroll
        for (int j = 0; j < 4; ++j) { const int i = i0 + NTHR * j; if (i < n4) *(LAS f32x4*)(dst + i * 4) = v[j]; }
    }
}
DEVI void ph_pro_a(const Ctx& cx) {
    const Params& P = *cx.p;
    {
        constexpr int n_in = DEPTH * 10 * 4, n_out = DEPTH * 4 * 4, n_gu = DEPTH * NE * 8 * 4, n_dn = DEPTH * NE * 4 * 4;
        constexpr int total = n_in + n_out + n_gu + n_dn;
        for (int job = cx.bid; job < total; job += cx.G) {
            int j = job;
            if (j < n_in) { const int l = j / 40, r = j % 40, kt = r / 10, nt = r % 10;
                cvt_tile8(cx, P.in[I_WIN] + (size_t)l * 1024 * DIN, DIN, WSP(unsigned char, WS_WIN) + (size_t)l * NP * 1024, nt * 256, kt * 256, 0); continue; }
            j -= n_in;
            if (j < n_out) { const int l = j / 16, r = j % 16, kt = r / 4, nt = r % 4;
                cvt_tile(cx, P.in[I_WOUT] + (size_t)l * 1024 * 1024, 1024, WSP(bf16_t, WS_WOUT) + (size_t)l * 1024 * 1024, nt * 256, kt * 256, 1); continue; }
            j -= n_out;
            if (j < n_gu) { const int le = j / 32, r = j % 32, kt = r / 8, nt = r % 8;
                if (cx.G == 256 && le >= 32 && (le & 31) < 17) continue;
                cvt_tile8(cx, P.in[I_WGU] + (size_t)le * 1024 * 2048, 2048, WSP(unsigned char, WS_WGU) + (size_t)le * 2048 * 1024, nt * 256, kt * 256, 2); continue; }
            j -= n_gu;
            { const int le = j / 16, r = j % 16, kt = r / 4, nt = r % 4;
                if (cx.G == 256 && le >= 32 && (le & 31) < 3) continue;
                cvt_tile8(cx, P.in[I_WD] + (size_t)le * 1024 * 1024, 1024, WSP(unsigned char, WS_WD) + (size_t)le * 1024 * 1024, nt * 256, kt * 256, 1); }
        }
    }
    __syncthreads();
    {
        LAS float* sv = (LAS float*)cx.lds;
        LAS float* red = sv + 9 * 1024;
        constexpr int units = DEPTH * 6144 / 64;
        if (cx.bid < units) {
            for (int i = cx.tid; i < 9 * 1024; i += NTHR) { const int r = i >> 10, k = i & 1023; const float c = r < 8 ? P.in[I_C][r * 1024 + k] : P.in[I_CCTX][k]; sv[i] = c / (1.0f + __expf(-c)); }
            __syncthreads();
            for (int u = cx.bid; u < units; u += cx.G) {
                const int l = u / 96, n = (u % 96) * 64 + cx.lane;
                const float* w = P.in[I_ADAW] + (size_t)l * 1024 * 6144 + n;
                float acc[9];
#pragma unroll
                for (int r = 0; r < 9; ++r) acc[r] = 0.f;
                const int kb = cx.wave * 128;
#pragma unroll 16
                for (int k = 0; k < 128; ++k) { const float wv = w[(size_t)(kb + k) * 6144];
#pragma unroll
                    for (int r = 0; r < 9; ++r) acc[r] += sv[r * 1024 + kb + k] * wv; }
#pragma unroll
                for (int r = 0; r < 9; ++r) red[(cx.wave * 9 + r) * 64 + cx.lane] = acc[r];
                __syncthreads();
                for (int i = cx.tid; i < 9 * 64; i += NTHR) { const int r = i >> 6, ln = i & 63; float s = 0.f;
#pragma unroll
                    for (int w8 = 0; w8 < 8; ++w8) s += red[(w8 * 9 + r) * 64 + ln];
                    const int nn = (u % 96) * 64 + ln;
                    WSP(float, WS_MOD)[((size_t)l * 9 + r) * 6144 + nn] = s + P.in[I_ADAB][l * 6144 + nn]; }
                __syncthreads();
            }
        }
    }
    for (int it = cx.bid * NTHR + cx.tid; it < DEPTH * 16 * 2 * 64 * 33; it += cx.G * NTHR) {
        const int gt = it / 33, k = it % 33, n = gt & 63, d = (gt >> 6) & 1, g = (gt >> 7) & 15, l = gt >> 11;
        const float dt = expf(P.in[I_S5LDT][(l * 2 + d) * 16 + g]);
        const float lr = P.in[I_S5LRE][((l * 2 + d) * 16 + g) * 64 + n], li = P.in[I_S5LIM][((l * 2 + d) * 16 + g) * 64 + n];
        const float mag = expf(lr * dt * (float)k); float sn, cs; sincosf(li * dt * (float)k, &sn, &cs);
        WSP(f32x2, WS_PW)[it] = (f32x2){mag * cs, mag * sn};
    }
    for (int gt = cx.bid * NTHR + cx.tid; gt < DEPTH * 16 * 2 * 64; gt += cx.G * NTHR) {
        const int n = gt & 63, d = (gt >> 6) & 1, g = (gt >> 7) & 15, l = gt >> 11;
        const float dt = expf(P.in[I_S5LDT][(l * 2 + d) * 16 + g]);
        const float lr = P.in[I_S5LRE][((l * 2 + d) * 16 + g) * 64 + n], li = P.in[I_S5LIM][((l * 2 + d) * 16 + g) * 64 + n];
        float ar, ai; { const float mag = expf(lr * dt); float sn, cs; sincosf(li * dt, &sn, &cs); ar = mag * cs; ai = mag * sn; }
        const float den = lr * lr + li * li;
        const float cr = ((ar - 1.0f) * lr + ai * li) / den, ci = (ai * lr - (ar - 1.0f) * li) / den;
        f32x2* bb = WSP(f32x2, WS_BB) + (size_t)gt * 16;
        for (int q = 0; q < 16; ++q) { const float br = P.in[I_S5BRE][((l * 16 + g) * 64 + n) * 16 + q], bi = P.in[I_S5BIM][((l * 16 + g) * 64 + n) * 16 + q];
            bb[q] = (f32x2){cr * br - ci * bi, cr * bi + ci * br}; }
    }
    for (int i = cx.bid * NTHR + cx.tid; i < DEPTH * 6 * 256 * 64; i += cx.G * NTHR) {
        const int ln = (i & 511) >> 3, k = ((i >> 9) & 1) * 32 + (ln >> 4) * 8 + (i & 7), n = ((i >> 10) & 15) * 16 + (ln & 15), g = (i >> 14) % 6, l = (i >> 14) / 6;
        const int j = n & 63, type = (n >> 6) & 1, dir = n >> 7;
        const float* w = type ? P.in[I_RGWX] : P.in[I_RGWA];
        WSP(bf16_t, WS_WRG)[i] = f2bf(w[((((size_t)l * 2 + dir) * 6 + g) * 64 + k) * 64 + j]);
    }
    for (int i = cx.bid * NTHR + cx.tid; i < DEPTH * NP; i += cx.G * NTHR) {
        const int n = i % NP, l = i / NP; const int sc = n < 1536 ? n : n + 16;
        WSP(float, WS_BIN2)[i] = P.in[I_BIN][l * DIN + sc] * ((n >= 384 && n < 768) ? 0.10206207261596577f : 1.0f);
    }
    for (int i = cx.bid * NTHR + cx.tid; i < DEPTH * 16 * 1024; i += cx.G * NTHR) { const int l = i >> 14, ln = (i & 511) >> 3, k = ((i >> 9) & 31) * 32 + (ln >> 4) * 8 + (i & 7), n = ln & 15;
        WSP(bf16_t, WS_WGT)[i] = f2bf(P.in[I_WIN][((size_t)l * 1024 + k) * DIN + 1536 + n]); }
    for (int i = cx.bid * NTHR + cx.tid; i < DEPTH * 32 * 1024; i += cx.G * NTHR) { const int l = i >> 15, ln = (i & 511) >> 3, k = ((i >> 9) & 31) * 32 + (ln >> 4) * 8 + (i & 7), n = ((i >> 14) & 1) * 16 + (ln & 15);
        const float w = P.in[I_RW][((size_t)l * 1024 + k) * 32 + n]; const bf16_t hi = f2bf(w);
        WSP(bf16_t, WS_RWH)[i] = hi; WSP(bf16_t, WS_RWL)[i] = f2bf(w - bf2f(hi)); }
    for (int i = cx.bid * NTHR + cx.tid; i < DEPTH * 256 * 256; i += cx.G * NTHR) {
        const int l = i >> 16, rem = i & 4095, ln = (rem & 511) >> 3;
        const int k = (rem >> 9) * 32 + (ln >> 4) * 8 + (i & 7), n = ((i >> 12) & 15) * 16 + (ln & 15);
        WSP(bf16_t, WS_WGLU)[i] = f2bf(P.in[I_S5GW][((size_t)l * 256 + k) * 256 + n]);
    }
}

DEVI void ph_pro_b(const Ctx& cx) {
    const Params& P = *cx.p;
    LAS f32x2* pw = (LAS f32x2*)cx.lds;
    LAS f32x2* bb = pw + 64 * 33;
    LAS f32x2* cc = bb + 64 * 16;
    for (int uh = cx.bid; uh < DEPTH * 16 * 2 * 2; uh += cx.G) {
        const int u = uh >> 1, hf = uh & 1, lg = u >> 1;
        lds_fill16((LAS float*)pw, (const float*)(WSP(f32x2, WS_PW) + (size_t)u * 64 * 33), 64 * 33 / 2, cx.tid);
        lds_fill16((LAS float*)bb, (const float*)(WSP(f32x2, WS_BB) + (size_t)u * 64 * 16), 64 * 16 / 2, cx.tid);
        for (int i = cx.tid; i < 16 * 64; i += NTHR) cc[i] = (f32x2){P.in[I_S5CRE][(size_t)lg * 1024 + i], P.in[I_S5CIM][(size_t)lg * 1024 + i]};
        __syncthreads();
        const int q = cx.tid & 15, p = (cx.tid >> 4) & 15, tau0 = cx.tid >> 8;
        float acc[8];
#pragma unroll
        for (int i = 0; i < 8; ++i) acc[i] = 0.f;
#pragma unroll 2
        for (int n = 0; n < 64; ++n) { const f32x2 b = bb[n * 16 + q], c = cc[p * 64 + n];
#pragma unroll
            for (int i = 0; i < 8; ++i) { const f32x2 a = pw[n * 33 + tau0 + 2 * (8 * hf + i)]; const float xr = c.x * a.x - c.y * a.y, xi = c.x * a.y + c.y * a.x; acc[i] += xr * b.x - xi * b.y; } }
#pragma unroll
        for (int i = 0; i < 8; ++i) WSP(float, WS_KT)[(((size_t)u * 32 + tau0 + 2 * (8 * hf + i)) * 16 + p) * 16 + q] = acc[i];
        __syncthreads();
    }
}

DEVI void ph_pro_c(const Ctx& cx) {
    const Params& P = *cx.p;
    LAS float* kt = (LAS float*)cx.lds;
    LAS f32x2* pw = (LAS f32x2*)(kt + 2 * 32 * 256);
    LAS f32x2* bb = pw + 2 * 64 * 33;
    LAS f32x2* cc = bb + 2 * 64 * 16;
    LAS float* dsk = (LAS float*)(cc + 16 * 64);
    for (int u = cx.bid; u < DEPTH * 16 * 4; u += cx.G) {
        const int lg = u >> 2, qt = u & 3, l = lg >> 4, g = lg & 15;
        lds_fill16(kt, WSP(float, WS_KT) + (size_t)lg * 2 * 32 * 256, 2 * 32 * 256 / 4, cx.tid);
        lds_fill16((LAS float*)pw, (const float*)(WSP(f32x2, WS_PW) + (size_t)lg * 2 * 64 * 33), 2 * 64 * 33 / 2, cx.tid);
        lds_fill16((LAS float*)bb, (const float*)(WSP(f32x2, WS_BB) + (size_t)lg * 2 * 64 * 16), 2 * 64 * 16 / 2, cx.tid);
        for (int i = cx.tid; i < 16 * 64; i += NTHR) cc[i] = (f32x2){P.in[I_S5CRE][(size_t)lg * 1024 + i], P.in[I_S5CIM][(size_t)lg * 1024 + i]};
        if (cx.tid < 16) dsk[cx.tid] = P.in[I_S5D][l * 256 + g * 16 + cx.tid];
        __syncthreads();
        bf16_t* wy = WSP(bf16_t, WS_WY) + ((size_t)lg * 512 + qt * 128) * 768;
        for (int i8 = cx.tid; i8 < 128 * 768 / 8; i8 += NTHR) {
            const int rem8 = i8 % 1536, ln = rem8 & 63, k0 = (rem8 >> 6) * 32 + (ln >> 4) * 8, t = qt * 8 + i8 / 1536, p = ln & 15;
            float v[8];
            if (k0 < 512) { const int sI = k0 >> 4, q0 = k0 & 15;
                f32x4 f0 = (f32x4){0.f, 0.f, 0.f, 0.f}, f1 = f0;
                if (sI <= t) { const LAS float* kp = kt + (0 * 32 + (t - sI)) * 256 + p * 16 + q0; f0 += *(const LAS f32x4*)kp; f1 += *(const LAS f32x4*)(kp + 4); }
                if (sI >= t) { const LAS float* kp = kt + (1 * 32 + (sI - t)) * 256 + p * 16 + q0; f0 += *(const LAS f32x4*)kp; f1 += *(const LAS f32x4*)(kp + 4); }
#pragma unroll
                for (int j = 0; j < 8; ++j) { v[j] = j < 4 ? f0[j & 3] : f1[j & 3]; if (sI == t && p == q0 + j) v[j] += dsk[p]; }
            } else { const int kk = k0 - 512, d = kk >> 7, im = (kk >> 6) & 1, n0 = kk & 63;
                const int pwr = d == 0 ? t + 1 : 32 - t;
#pragma unroll
                for (int j = 0; j < 8; ++j) { const f32x2 a = pw[(d * 64 + n0 + j) * 33 + pwr], c = cc[p * 64 + n0 + j];
                    v[j] = im ? -(c.x * a.y + c.y * a.x) : (c.x * a.x - c.y * a.y); } }
            u32x4 w; w.x = pk_bf16(v[0], v[1]); w.y = pk_bf16(v[2], v[3]); w.z = pk_bf16(v[4], v[5]); w.w = pk_bf16(v[6], v[7]);
            *(u32x4*)(wy + (size_t)i8 * 8) = w;
        }
        bf16_t* we = WSP(bf16_t, WS_WE) + ((size_t)lg * 256 + qt * 64) * 512;
        for (int i8 = cx.tid; i8 < 64 * 512 / 8; i8 += NTHR) {
            const int rem8 = i8 & 1023, ln = rem8 & 63, k0 = (rem8 >> 6) * 32 + (ln >> 4) * 8, no = qt * 64 + (i8 >> 10) * 16 + (ln & 15);
            const int sI = k0 >> 4, q0 = k0 & 15, d = no >> 7, im = (no >> 6) & 1, n = no & 63;
            const int pwr = d == 0 ? 31 - sI : sI;
            const f32x2 a = pw[(d * 64 + n) * 33 + pwr];
            float v[8];
#pragma unroll
            for (int j = 0; j < 8; ++j) { const f32x2 b2 = bb[(d * 64 + n) * 16 + q0 + j]; v[j] = im ? (a.x * b2.y + a.y * b2.x) : (a.x * b2.x - a.y * b2.y); }
            u32x4 w; w.x = pk_bf16(v[0], v[1]); w.y = pk_bf16(v[2], v[3]); w.z = pk_bf16(v[4], v[5]); w.w = pk_bf16(v[6], v[7]);
            *(u32x4*)(we + (size_t)i8 * 8) = w;
        }
        __syncthreads();
    }
}

DEVI void moe_info(const Ctx& cx, int l, LAS int* info) {
    if (cx.tid < 64) {
        const unsigned* cnt = (const unsigned*)(cx.ws + WS_CTL) + CW_CNT + l * 32;
        const int c = cx.lane < 32 ? (int)__hip_atomic_load(cnt + (cx.lane & 31), __ATOMIC_RELAXED, __HIP_MEMORY_SCOPE_AGENT) : 0;
        const int nt = (c + 255) >> 8;
        if (cx.lane < 32) { info[72 + cx.lane] = nt; info[40 + cx.lane] = c; }
        const int run = (int)wave_scan<false>((float)nt, cx.lane);
        if (cx.lane == 0) info[0] = 0;
        if (cx.lane < 32) info[cx.lane + 1] = run;
    }
    __syncthreads();
    if (cx.tid < 32) { const int lo = info[cx.tid], hi = info[cx.tid + 1]; for (int t = lo; t < hi; ++t) info[112 + t] = cx.tid;
    }
    __syncthreads();
}

DEVI void block_rows_visible() {
    asm volatile("s_waitcnt vmcnt(0)" ::: "memory");
    __syncthreads();
}
DEVI void ph_norm1(const Ctx& cx, int l) {
    const Params& P = *cx.p;
    LAS int* info = (LAS int*)cx.lds;
    LAS float* part = (LAS float*)(cx.lds + 4096);
    if (l > 0) moe_info(cx, l - 1, info);
    const int rbeg = (l == DEPTH) ? TCTX : 0, nr = TT - rbeg;
    const int rpb = (nr + cx.G - 1) / cx.G, rb = rbeg + cx.bid * rpb, re = min(TT, rb + rpb);
    const float* modp = WSP(float, WS_MOD);
    const int c0 = 4 * cx.lane;
    LAS bf16_t* hl = (LAS bf16_t*)(cx.lds + 4096); const bool inlds = rpb <= 72;
    f32x4 nwv[4];
#pragma unroll
    for (int i = 0; i < 4; ++i) nwv[i] = *(const f32x4*)((l == DEPTH ? P.in[I_FNW] : P.in[I_N1W] + l * 1024) + c0 + 256 * i);
    i32x4 tiN[2] = {(i32x4){0, 0, 0, 0}, (i32x4){0, 0, 0, 0}}; f32x4 tgN[2] = {(f32x4){0.f, 0.f, 0.f, 0.f}, (f32x4){0.f, 0.f, 0.f, 0.f}};
#define N1_INFO(R2N) do { _Pragma("unroll") for (int u = 0; u < 2; ++u) { const int rn = min((R2N) + 8 * u, re - 1); \
        tiN[u] = *(const i32x4*)(WSP(int, WS_TINFO) + (size_t)rn * 4); tgN[u] = *(const f32x4*)(WSP(float, WS_TGATE) + (size_t)rn * 4); } } while (0)
    if (l > 0) N1_INFO(rb + cx.wave);
    const int mr0 = mod_row(min(rb, TT - 1));
    f32x4 scC[4], shC[4], g2C[4];
#pragma unroll
    for (int i = 0; i < 4; ++i) { const float* md0 = modp + ((size_t)min(l, DEPTH - 1) * 9 + mr0) * 6144; scC[i] = *(const f32x4*)(md0 + 1024 + c0 + 256 * i); shC[i] = *(const f32x4*)(md0 + c0 + 256 * i);
        g2C[i] = *(const f32x4*)(modp + ((size_t)max(l - 1, 0) * 9 + mr0) * 6144 + 5120 + c0 + 256 * i); }
    for (int r2 = rb + cx.wave; r2 < re; r2 += 16) {
        f32x4 x[2][4], scv[2][4], shv[2][4]; bool ok[2];
        const i32x4 tiC[2] = {tiN[0], tiN[1]}; const f32x4 tgC[2] = {tgN[0], tgN[1]};
        if (l > 0) N1_INFO(r2 + 16);
#pragma unroll
        for (int u = 0; u < 2; ++u) { const int row = r2 + 8 * u; ok[u] = row < re; const int rw_ = ok[u] ? row : r2;
            const bool sameb = mod_row(rw_) == mr0;
            if (l < DEPTH) { if (sameb) {
#pragma unroll
                    for (int i = 0; i < 4; ++i) { scv[u][i] = scC[i]; shv[u][i] = shC[i]; } }
                else { const float* md = modp + ((size_t)l * 9 + mod_row(rw_)) * 6144;
#pragma unroll
                    for (int i = 0; i < 4; ++i) { scv[u][i] = *(const f32x4*)(md + 1024 + c0 + 256 * i); shv[u][i] = *(const f32x4*)(md + c0 + 256 * i); } } }
            if (l == 0) { const float* src = rw_ < TCTX ? P.in[I_CTX] + (size_t)rw_ * 1024 : P.in[I_X] + (size_t)(rw_ - TCTX) * 1024;
#pragma unroll
                for (int i = 0; i < 4; ++i) x[u][i] = *(const f32x4*)(src + c0 + 256 * i);
            } else {
                const bf16_t* src = WSP(bf16_t, WS_XMID) + (size_t)rw_ * 1024;
                const float* g2 = modp + ((size_t)(l - 1) * 9 + mod_row(rw_)) * 6144 + 5120;
                const i32x4 ti = tiC[u]; const f32x4 tg = tgC[u];
                f32x4 y[4];
#pragma unroll
                for (int i = 0; i < 4; ++i) y[i] = (f32x4){0.f, 0.f, 0.f, 0.f};
#pragma unroll
                for (int k = 0; k < 4; ++k) { const int t = ti[k]; const int e = t >> 20, slot = t & 0xFFFFF;
                    const unsigned char* yp = WSP(unsigned char, WS_YPAD) + ((size_t)info[e] * 256 + slot) * 1024;
#pragma unroll
                    for (int i = 0; i < 4; ++i) { const int w = *(const int*)(yp + c0 + 256 * i);
                        const float gk_ = tg[k]; y[i][0] += gk_ * __builtin_amdgcn_cvt_f32_fp8(w, 0); y[i][1] += gk_ * __builtin_amdgcn_cvt_f32_fp8(w, 1); y[i][2] += gk_ * __builtin_amdgcn_cvt_f32_fp8(w, 2); y[i][3] += gk_ * __builtin_amdgcn_cvt_f32_fp8(w, 3); } }
#pragma unroll
                for (int i = 0; i < 4; ++i) { const f32x4 xv = bf4_f32(*(const u32x2*)(src + c0 + 256 * i)); f32x4 gv = g2C[i]; if (!sameb) gv = *(const f32x4*)(g2 + c0 + 256 * i); x[u][i] = xv + gv * (y[i] * Y8_INV); }
            }
        }
#pragma unroll
        for (int u = 0; u < 2; ++u) {
            const int row = r2 + 8 * u;
            float ss = 0.f;
#pragma unroll
            for (int i = 0; i < 4; ++i) ss += (x[u][i][0] * x[u][i][0] + x[u][i][1] * x[u][i][1]) + (x[u][i][2] * x[u][i][2] + x[u][i][3] * x[u][i][3]);
            ss = wave_sum(ss, 0);
            const float rstd = rsqrtf(ss * (1.0f / 1024.0f) + EPS);
            if (!ok[u]) continue;
            if (l == DEPTH) { float* o = P.out + (size_t)(row - TCTX) * 1024;
#pragma unroll
                for (int i = 0; i < 4; ++i) *(f32x4*)(o + c0 + 256 * i) = x[u][i] * rstd * nwv[i];
                continue; }
            bf16_t* xs = WSP(bf16_t, WS_XS) + (size_t)row * 1024;
            bf16_t* hp = WSP(bf16_t, WS_H) + (size_t)row * 1024;
#pragma unroll
            for (int i = 0; i < 4; ++i) { const int c = c0 + 256 * i;
                *(u32x2*)(xs + c) = f32_bf4(x[u][i]);
                const f32x4 h = x[u][i] * rstd * nwv[i] * (scv[u][i] + 1.0f) + shv[u][i];
                u32x2 w; w.x = pk_bf16(h[0], h[1]); w.y = pk_bf16(h[2], h[3]);
                if (inlds) *(LAS u32x2*)(hl + (row - rb) * 1032 + c) = w; else *(u32x2*)(hp + c) = w;
                *(int*)(WSP(unsigned char, WS_HIN8) + (size_t)row * 1024 + c) = (int)pk4_fp8(h[0], h[1], h[2], h[3]); }
        }
    }
    if (l == DEPTH) return;
    if (inlds) {
        __syncthreads();
        const int nrow_ = re - rb, ntile_ = (nrow_ + 15) / 16, fr = cx.lane & 15, fq = cx.lane >> 4;
        for (int t = cx.wave; t < ntile_; t += 8) {
            const LAS bf16_t* ap = hl + min(t * 16 + fr, nrow_ - 1) * 1032 + fq * 8;
            const bf16_t* wp = WSP(bf16_t, WS_WGT) + (size_t)l * 32 * 512 + cx.lane * 8;
            f32x4 acc0 = (f32x4){0.f, 0.f, 0.f, 0.f}, acc1 = acc0;
#pragma unroll
            for (int kb = 0; kb < 4; ++kb) { bf16x8 wf[8], af[8];
#pragma unroll
                for (int k = 0; k < 8; ++k) { wf[k] = ldg8(wp + 512 * (kb * 8 + k)); af[k] = *(const LAS bf16x8*)(ap + 32 * (kb * 8 + k)); }
#pragma unroll
                for (int k = 0; k < 8; k += 2) { acc0 = __builtin_amdgcn_mfma_f32_16x16x32_bf16(wf[k], af[k], acc0, 0, 0, 0); acc1 = __builtin_amdgcn_mfma_f32_16x16x32_bf16(wf[k + 1], af[k + 1], acc1, 0, 0, 0); } }
            if (t * 16 + fr < nrow_) { const f32x4 bias = *(const f32x4*)(P.in[I_BIN] + l * DIN + 1536 + 4 * fq);
                *(f32x4*)(WSP(float, WS_GT) + (size_t)(rb + t * 16 + fr) * 16 + 4 * fq) = acc0 + acc1 + bias; }
        }
        return;
    }
    block_rows_visible();
    const int nrow = re - rb, ntile = (nrow + 15) / 16;
    LAS bf16_t* stg = (LAS bf16_t*)(cx.lds + 40960 + cx.wave * 8448);
    for (int it = cx.wave; it < ntile * 4; it += 8) {
        const int t = it >> 2, kq = it & 3, fr = cx.lane & 15, fq = cx.lane >> 4, rr = cx.lane >> 5, pc = cx.lane & 31;
        const bf16_t* wp = WSP(bf16_t, WS_WGT) + ((size_t)l * 32 + kq * 8) * 512 + cx.lane * 8;
        f32x4 acc = (f32x4){0.f, 0.f, 0.f, 0.f};
        bf16x8 af[8], wf[8]; u32x4 sa[8];
#pragma unroll
        for (int i = 0; i < 8; ++i) { const int row = min(rb + t * 16 + 2 * i + rr, re - 1); sa[i] = *(const u32x4*)(WSP(bf16_t, WS_H) + (size_t)row * 1024 + kq * 256 + pc * 8); }
#pragma unroll
        for (int k = 0; k < 8; ++k) wf[k] = ldg8(wp + 512 * k);
        __builtin_amdgcn_sched_barrier(0);
#pragma unroll
        for (int i = 0; i < 8; ++i) *(LAS u32x4*)(stg + (2 * i + rr) * 264 + pc * 8) = sa[i];
#pragma unroll
        for (int k = 0; k < 8; ++k) af[k] = *(const LAS bf16x8*)(stg + fr * 264 + 32 * k + fq * 8);
#pragma unroll
        for (int k = 0; k < 8; ++k) acc = __builtin_amdgcn_mfma_f32_16x16x32_bf16(wf[k], af[k], acc, 0, 0, 0);
        __builtin_amdgcn_sched_barrier(0);
        *(LAS f32x4*)(part + ((kq * 128) + t * 16 + fr) * 16 + 4 * fq) = acc;
    }
    __syncthreads();
    for (int i = cx.tid; i < nrow * 16; i += NTHR) { const int rl = i >> 4, gi = i & 15;
        WSP(float, WS_GT)[(size_t)(rb + rl) * 16 + gi] = (part[(0 * 128 + rl) * 16 + gi] + part[(1 * 128 + rl) * 16 + gi]) + (part[(2 * 128 + rl) * 16 + gi] + part[(3 * 128 + rl) * 16 + gi]) + P.in[I_BIN][l * DIN + 1536 + gi]; }
}

DEVI void ph_norm2(const Ctx& cx, int l) {
    const Params& P = *cx.p;
    LAS float* lgs = (LAS float*)cx.lds;
    LAS int* hist = (LAS int*)(cx.lds + 4 * 128 * 33 * 4);
    LAS int* pend = hist + 64;
    if (cx.tid < 64) hist[cx.tid] = 0;
    const int r0 = (l == DEPTH - 1) ? TCTX : 0, nr = TT - r0;
    const int rpb = (nr + cx.G - 1) / cx.G;
    const int rb = r0 + cx.bid * rpb, re = min(TT, rb + rpb);
    const float* modp = WSP(float, WS_MOD);
    const int c0 = 4 * cx.lane;
    f32x4 nwv[4];
#pragma unroll
    for (int i = 0; i < 4; ++i) nwv[i] = *(const f32x4*)(P.in[I_N2W] + l * 1024 + c0 + 256 * i);
    const int mr0 = mod_row(min(rb, TT - 1));
    f32x4 scC[4], shC[4];
#pragma unroll
    for (int i = 0; i < 4; ++i) { const float* md0 = modp + ((size_t)l * 9 + mr0) * 6144; scC[i] = *(const f32x4*)(md0 + 4096 + c0 + 256 * i); shC[i] = *(const f32x4*)(md0 + 3072 + c0 + 256 * i); }
    const int nrow = re - rb, ntile = (nrow + 15) / 16;
    LAS bf16_t* hiT = (LAS bf16_t*)(cx.lds + 73728);
    LAS bf16_t* loT = hiT + 16 * 1032;
    const int nt = (cx.wave >> 2) & 1, kq = cx.wave & 3, fr = cx.lane & 15, fq = cx.lane >> 4;
    const size_t wo = (((size_t)l * 2 + nt) * 32 + kq * 8) * 512 + cx.lane * 8;
    const bf16_t* wh = WSP(bf16_t, WS_RWH) + wo; const bf16_t* wl = WSP(bf16_t, WS_RWL) + wo;
    u32x2 xr[2][4];
#define N2_LOADX(R2) do { _Pragma("unroll") for (int u = 0; u < 2; ++u) { const bf16_t* src = WSP(bf16_t, WS_XMID) + (size_t)min((R2) + 8 * u, re - 1) * 1024; \
        _Pragma("unroll") for (int i = 0; i < 4; ++i) xr[u][i] = *(const u32x2*)(src + c0 + 256 * i); } } while (0)
    N2_LOADX(rb + cx.wave);
    bf16x8 bh[8], bl[8];
#pragma unroll
    for (int k = 0; k < 8; ++k) { bh[k] = ldg8(wh + 512 * k); bl[k] = ldg8(wl + 512 * k); }
#pragma unroll 1
    for (int t = 0; t < ntile; ++t) {
        const int r2 = rb + 16 * t + cx.wave;
        u32x2 xc[2][4];
#pragma unroll
        for (int u = 0; u < 2; ++u)
#pragma unroll
            for (int i = 0; i < 4; ++i) xc[u][i] = xr[u][i];
        __builtin_amdgcn_sched_barrier(0);
        N2_LOADX(r2 + 16);
        __builtin_amdgcn_sched_barrier(0);
#pragma unroll
        for (int u = 0; u < 2; ++u) {
            const int row = r2 + 8 * u; const bool ok = row < re; const int rw_ = ok ? row : re - 1;
            f32x4 x[4];
#pragma unroll
            for (int i = 0; i < 4; ++i) x[i] = bf4_f32(xc[u][i]);
            float ss = 0.f;
#pragma unroll
            for (int i = 0; i < 4; ++i) ss += (x[i][0] * x[i][0] + x[i][1] * x[i][1]) + (x[i][2] * x[i][2] + x[i][3] * x[i][3]);
            ss = wave_sum(ss, 0);
            const float rstd = rsqrtf(ss * (1.0f / 1024.0f) + EPS);
            const bool sameb = mod_row(rw_) == mr0;
            const float* md = modp + ((size_t)l * 9 + mod_row(rw_)) * 6144;
            unsigned char* h8 = WSP(unsigned char, WS_H8) + (size_t)rw_ * 1024;
            LAS bf16_t* hrow = hiT + (cx.wave + 8 * u) * 1032; LAS bf16_t* lrow = loT + (cx.wave + 8 * u) * 1032;
#pragma unroll
            for (int i = 0; i < 4; ++i) { const int c = c0 + 256 * i;
                f32x4 sc = scC[i], sh = shC[i];
                if (!sameb) { sc = *(const f32x4*)(md + 4096 + c); sh = *(const f32x4*)(md + 3072 + c); }
                const f32x4 h = x[i] * rstd * nwv[i] * (sc + 1.0f) + sh;
                const int p8 = (int)pk4_fp8(h[0], h[1], h[2], h[3]);
                const float q0 = __builtin_amdgcn_cvt_f32_fp8(p8, 0), q1 = __builtin_amdgcn_cvt_f32_fp8(p8, 1), q2 = __builtin_amdgcn_cvt_f32_fp8(p8, 2), q3 = __builtin_amdgcn_cvt_f32_fp8(p8, 3);
                if (ok) *(int*)(h8 + c) = p8;
                u32x2 whi; whi.x = pk_bf16(q0, q1); whi.y = pk_bf16(q2, q3); *(LAS u32x2*)(hrow + c) = whi;
                u32x2 wlo; wlo.x = pk_bf16(h[0] - q0, h[1] - q1); wlo.y = pk_bf16(h[2] - q2, h[3] - q3); *(LAS u32x2*)(lrow + c) = wlo; }
        }
        LDS_SYNC();
        {
            f32x4 acc = (f32x4){0.f, 0.f, 0.f, 0.f}, acc2 = (f32x4){0.f, 0.f, 0.f, 0.f};
            bf16x8 af[8];
#pragma unroll
            for (int k = 0; k < 8; ++k) af[k] = *(const LAS bf16x8*)(hiT + fr * 1032 + kq * 256 + 32 * k + fq * 8);
#pragma unroll
            for (int k = 0; k < 8; ++k) { acc = __builtin_amdgcn_mfma_f32_16x16x32_bf16(bh[k], af[k], acc, 0, 0, 0); acc2 = __builtin_amdgcn_mfma_f32_16x16x32_bf16(bl[k], af[k], acc2, 0, 0, 0); }
#pragma unroll
            for (int k = 0; k < 8; ++k) af[k] = *(const LAS bf16x8*)(loT + fr * 1032 + kq * 256 + 32 * k + fq * 8);
#pragma unroll
            for (int k = 0; k < 8; ++k) acc2 = __builtin_amdgcn_mfma_f32_16x16x32_bf16(bh[k], af[k], acc2, 0, 0, 0);
            const int rl = t * 16 + fr;
#pragma unroll
            for (int j = 0; j < 4; ++j) lgs[(kq * 128 + rl) * 33 + nt * 16 + 4 * fq + j] = acc[j] + acc2[j];
        }
        LDS_SYNC();
    }
#undef N2_LOADX
    __syncthreads();
    if (cx.tid < nrow) {
        float lg[32];
#pragma unroll
        for (int e = 0; e < 32; ++e) lg[e] = (lgs[(0 * 128 + cx.tid) * 33 + e] + lgs[(1 * 128 + cx.tid) * 33 + e]) + (lgs[(2 * 128 + cx.tid) * 33 + e] + lgs[(3 * 128 + cx.tid) * 33 + e]) + P.in[I_RB][l * 32 + e];
        float tv[4]; int tix[4]; unsigned taken = 0u;
#pragma unroll
        for (int k = 0; k < 4; ++k) { float bv = -3.0e38f; int bi = 0;
#pragma unroll
            for (int e = 0; e < 32; ++e) { const bool better = (lg[e] > bv) && !((taken >> e) & 1u); bv = better ? lg[e] : bv; bi = better ? e : bi; }
            tv[k] = bv; tix[k] = bi; taken |= 1u << bi; }
        const float e1 = __expf(tv[1] - tv[0]), e2 = __expf(tv[2] - tv[0]), e3 = __expf(tv[3] - tv[0]);
        const float inv = 1.0f / (1.0f + e1 + e2 + e3);
        const float gk[4] = {inv, e1 * inv, e2 * inv, e3 * inv};
#pragma unroll
        for (int k = 0; k < 4; ++k) {
            const int ls = __hip_atomic_fetch_add((LAS int*)(hist + tix[k]), 1, __ATOMIC_RELAXED, __HIP_MEMORY_SCOPE_WORKGROUP);
            pend[(cx.tid * 4 + k) * 2 + 0] = (tix[k] << 20) | ls;
            pend[(cx.tid * 4 + k) * 2 + 1] = __float_as_int(gk[k]); }
    }
    __syncthreads();
    if (cx.tid < 32) { unsigned* cnt = (unsigned*)(cx.ws + WS_CTL) + CW_CNT + l * 32;
        hist[32 + cx.tid] = hist[cx.tid] > 0 ? (int)__hip_atomic_fetch_add(cnt + cx.tid, (unsigned)hist[cx.tid], __ATOMIC_RELAXED, __HIP_MEMORY_SCOPE_AGENT) : 0; }
    __syncthreads();
    for (int i = cx.tid; i < nrow * 4; i += NTHR) {
        const int t = pend[i * 2], e = t >> 20, slot = hist[32 + e] + (t & 0xFFFFF), row = rb + (i >> 2);
        WSP(int, WS_ELIST)[(size_t)e * TT + slot] = row;
        WSP(float, WS_TGATE)[(size_t)row * 4 + (i & 3)] = __int_as_float(pend[i * 2 + 1]);
        WSP(int, WS_TINFO)[(size_t)row * 4 + (i & 3)] = (e << 20) | slot;
    }
}

DEVI int xcd_contig(int bid, int G) { return (G % 8 == 0) ? (bid % 8) * (G / 8) + bid / 8 : bid; }

struct DenseSched {
    const char* A; const char* B; int nM, nN, pm0, G, bid, kb;
    DEVI bool get(int i, g1::Unit& u) const {
        int pm, pn;
        if (G % 8 == 0) { const int x = bid & 7, r = bid >> 3, nx = G >> 3, lo = (nM * x) >> 3, hi = (nM * (x + 1)) >> 3, nr = hi - lo;
            const int q = i * nx + r; if (nr <= 0 || q >= nr * nN) return false; pm = lo + q % nr; pn = q / nr; }
        else { const int L = i * G + bid; if (L >= nM * nN) return false; pm = L / nN; pn = L % nN; }
        u.A = A + (size_t)(pm0 + pm) * 256 * kb; u.list = nullptr; u.nvalid = 256; u.B = B + (size_t)pn * 256 * kb; u.pm = pm0 + pm; u.pn = pn; u.e = 0;
        return true;
    }
};
struct MoeSched {
    const char* A; const char* B; const int* elist; const LAS int* info; int NPN, gather, G, bid; size_t bstride; int kb;
    DEVI int rd(int i) const { return __builtin_amdgcn_readfirstlane(info[i]); }
    DEVI bool get(int i, g1::Unit& u) const {
        const int NTt = rd(32); int T, pn;
        if (G % 8 == 0 && (G >> 3) % NPN == 0) { const int x = bid & 7, r = bid >> 3, nx = G >> 3, RT = nx / NPN, lo = (NTt * x) >> 3, hi = (NTt * (x + 1)) >> 3;
            T = lo + i * RT + r % RT; pn = r / RT; if (T >= hi) return false; }
        else { const int L = i * G + bid; if (L >= NTt * NPN) return false; T = L / NPN; pn = L % NPN; }
        const int e = rd(112 + T), j = T - rd(e);
        u.pm = T; u.pn = pn; u.e = e;
        u.B = B + (size_t)e * bstride + (size_t)pn * 256 * kb;
        if (gather) { u.A = A; u.list = elist + (size_t)e * TT + j * 256; u.nvalid = rd(40 + e) - j * 256; }
        else { u.A = A + (size_t)T * 256 * kb; u.list = nullptr; u.nvalid = 256; }
        return true;
    }
};

struct EpiIn {
    static constexpr bool PERM = true, LDSC = true;
    bf16_t* Pout; const float* bias;
    DEVI const float* cptr(const g1::Unit& u, int tid) const { return bias + u.pn * 256 + tid; }
    DEVI void operator()(const f32x4 (&acc)[2][2][4][2], const g1::Unit& u, int wr, int wc, int fr, int fq, const LAS float* cb) const {
        const int src = epi_src(fr, fq), Ln = fq * 16 + fr, frn = (Ln >> 4) * 4 + ((Ln >> 2) & 3), fqn = Ln & 3;
        const int row0 = u.pm * 256 + wr * 64 + frn;
#pragma unroll
        for (int bj = 0; bj < 2; ++bj) {
            const int col0 = u.pn * 256 + bj * 128 + wc * 32 + 8 * fqn;
            const int seg = u.pn * 2 + bj; const bool gl = (seg >= 15 && seg < 18); const float wsc = (seg >= 3 && seg < 6) ? W8_INV * 0.10206207261596577f : W8_INV;
            const int cl = bj * 128 + wc * 32 + 8 * fq;
            const f32x4 b0 = *(const LAS f32x4*)(cb + cl), b1 = *(const LAS f32x4*)(cb + cl + 4);
#pragma unroll
            for (int ai = 0; ai < 2; ++ai)
#pragma unroll
                for (int m = 0; m < 4; ++m) {
                    f32x4 v0 = acc[ai][bj][m][0] * wsc + b0, v1 = acc[ai][bj][m][1] * wsc + b1;
                    if (gl) { const f32x2 a = gelu_tanh2((f32x2){v0[0], v0[1]}), b = gelu_tanh2((f32x2){v0[2], v0[3]}), c = gelu_tanh2((f32x2){v1[0], v1[1]}), d = gelu_tanh2((f32x2){v1[2], v1[3]});
                        v0 = (f32x4){a.x, a.y, b.x, b.y}; v1 = (f32x4){c.x, c.y, d.x, d.y}; }
                    u32x4 w; w.x = pk_bf16(v0[0], v0[1]); w.y = pk_bf16(v0[2], v0[3]); w.z = pk_bf16(v1[0], v1[1]); w.w = pk_bf16(v1[2], v1[3]);
                    w.x = bperm(src, w.x); w.y = bperm(src, w.y); w.z = bperm(src, w.z); w.w = bperm(src, w.w);
                    *(u32x4*)(Pout + (size_t)(row0 + ai * 128 + m * 16) * NP + col0) = w;
                }
        }
    }
};
struct EpiOut {
    static constexpr bool PERM = true, LDSC = true;
    const bf16_t* __restrict__ xs; bf16_t* __restrict__ xmid; const float* mod;
    DEVI const float* cptr(const g1::Unit& u, int tid) const { return mod + (size_t)mod_row(u.pm * 256) * 6144 + 2048 + u.pn * 256 + tid; }
    DEVI void operator()(const f32x4 (&acc)[2][2][4][2], const g1::Unit& u, int wr, int wc, int fr, int fq, const LAS float* cb) const {
        const int src = epi_src(fr, fq), Ln = fq * 16 + fr, frn = (Ln >> 4) * 4 + ((Ln >> 2) & 3), fqn = Ln & 3;
        const int row0 = u.pm * 256 + wr * 64 + frn;
#pragma unroll
        for (int bj = 0; bj < 2; ++bj) {
            const int col0 = u.pn * 256 + bj * 128 + wc * 32 + 8 * fqn, cl = bj * 128 + wc * 32 + 8 * fq;
            const f32x4 g0 = *(const LAS f32x4*)(cb + cl), g1v = *(const LAS f32x4*)(cb + cl + 4);
            u32x4 xv[8];
#pragma unroll
            for (int am = 0; am < 8; ++am) xv[am] = *(const u32x4*)(xs + (size_t)(row0 + (am >> 2) * 128 + (am & 3) * 16) * 1024 + col0);
            __builtin_amdgcn_sched_barrier(0);
#pragma unroll
            for (int am = 0; am < 8; ++am) {
                const f32x4 p0 = g0 * acc[am >> 2][bj][am & 3][0], p1 = g1v * acc[am >> 2][bj][am & 3][1];
                const f32x4 q0 = (f32x4){bpermf(src, p0[0]), bpermf(src, p0[1]), bpermf(src, p0[2]), bpermf(src, p0[3])}, q1 = (f32x4){bpermf(src, p1[0]), bpermf(src, p1[1]), bpermf(src, p1[2]), bpermf(src, p1[3])};
                const f32x4 o0 = bf4_f32((u32x2){xv[am].x, xv[am].y}) + q0, o1 = bf4_f32((u32x2){xv[am].z, xv[am].w}) + q1;
                u32x4 w; w.x = pk_bf16(o0[0], o0[1]); w.y = pk_bf16(o0[2], o0[3]); w.z = pk_bf16(o1[0], o1[1]); w.w = pk_bf16(o1[2], o1[3]);
                *(u32x4*)(xmid + (size_t)(row0 + (am >> 2) * 128 + (am & 3) * 16) * 1024 + col0) = w;
            }
        }
    }
};
struct EpiGU {
    static constexpr bool PERM = true, LDSC = true;
    unsigned char* act; const float* bgu;
    DEVI const float* cptr(const g1::Unit& u, int tid) const { return bgu + (size_t)u.e * 2048 + (tid < 128 ? u.pn * 128 + tid : 1024 + u.pn * 128 + (tid - 128)); }
    DEVI void operator()(const f32x4 (&acc)[2][2][4][2], const g1::Unit& u, int wr, int wc, int fr, int fq, const LAS float* cb) const {
        const int src = epi_src(fr, fq), Ln = fq * 16 + fr, frn = (Ln >> 4) * 4 + ((Ln >> 2) & 3), fqn = Ln & 3;
        const int row0 = u.pm * 256 + wr * 64 + frn, cl = wc * 32 + 8 * fq, colh = u.pn * 128 + wc * 32 + 8 * fqn;
        const f32x4 bg0 = *(const LAS f32x4*)(cb + cl), bg1 = *(const LAS f32x4*)(cb + cl + 4), bu0 = *(const LAS f32x4*)(cb + 128 + cl), bu1 = *(const LAS f32x4*)(cb + 128 + cl + 4);
#pragma unroll
        for (int ai = 0; ai < 2; ++ai)
#pragma unroll
            for (int m = 0; m < 4; ++m) {
                float o[8];
#pragma unroll
                for (int n = 0; n < 2; ++n)
#pragma unroll
                    for (int j2 = 0; j2 < 2; ++j2) {
                        const f32x4 ag = acc[ai][0][m][n], au = acc[ai][1][m][n], vbg = n ? bg1 : bg0, vbu = n ? bu1 : bu0;
                        f32x2 g = (f32x2){ag[2 * j2], ag[2 * j2 + 1]} * W8_INV + (f32x2){vbg[2 * j2], vbg[2 * j2 + 1]};
                        f32x2 up = (f32x2){au[2 * j2], au[2 * j2 + 1]} * W8_INV + (f32x2){vbu[2 * j2], vbu[2 * j2 + 1]};
                        g = __builtin_elementwise_min(g, (f32x2){7.0f, 7.0f});
                        up = __builtin_elementwise_min(__builtin_elementwise_max(up, (f32x2){-7.0f, -7.0f}), (f32x2){7.0f, 7.0f});
                        const f32x2 z = g * (-1.702f * 1.44269504f);
                        f32x2 den; den.x = __builtin_amdgcn_exp2f(z.x); den.y = __builtin_amdgcn_exp2f(z.y); den = den + 1.0f;
                        f32x2 rc; rc.x = frcp(den.x); rc.y = frcp(den.y);
                        const f32x2 r = (up + 1.0f) * g * rc;
                        o[n * 4 + 2 * j2] = r.x; o[n * 4 + 2 * j2 + 1] = r.y;
                    }
                u32x2 w; w.x = pk4_fp8(o[0], o[1], o[2], o[3]); w.y = pk4_fp8(o[4], o[5], o[6], o[7]);
                w.x = bperm(src, w.x); w.y = bperm(src, w.y);
                *(u32x2*)(act + (size_t)(row0 + ai * 128 + m * 16) * 1024 + colh) = w;
            }
    }
};
struct EpiDown {
    static constexpr bool PERM = true, LDSC = true;
    unsigned char* ypad; const float* bd;
    DEVI const float* cptr(const g1::Unit& u, int tid) const { return bd + (size_t)u.e * 1024 + u.pn * 256 + tid; }
    DEVI void operator()(const f32x4 (&acc)[2][2][4][2], const g1::Unit& u, int wr, int wc, int fr, int fq, const LAS float* cb) const {
        const int src = epi_src(fr, fq), Ln = fq * 16 + fr, frn = (Ln >> 4) * 4 + ((Ln >> 2) & 3), fqn = Ln & 3;
        const int rl0 = wr * 64 + frn;
#pragma unroll
        for (int bj = 0; bj < 2; ++bj) {
            const int cl = bj * 128 + wc * 32 + 8 * fq, col0 = u.pn * 256 + bj * 128 + wc * 32 + 8 * fqn;
            const f32x4 b0 = *(const LAS f32x4*)(cb + cl) * Y8_SCALE, b1 = *(const LAS f32x4*)(cb + cl + 4) * Y8_SCALE;
#pragma unroll
            for (int ai = 0; ai < 2; ++ai)
#pragma unroll
                for (int m = 0; m < 4; ++m) {
                    const int rl = rl0 + ai * 128 + m * 16;
                    const f32x4 v0 = acc[ai][bj][m][0] * (W8_INV * Y8_SCALE) + b0, v1 = acc[ai][bj][m][1] * (W8_INV * Y8_SCALE) + b1;
                    u32x2 w; w.x = pk4_fp8(v0[0], v0[1], v0[2], v0[3]); w.y = pk4_fp8(v1[0], v1[1], v1[2], v1[3]);
                    w.x = bperm(src, w.x); w.y = bperm(src, w.y);
                    *(u32x2*)(ypad + (size_t)(u.pm * 256 + rl) * 1024 + col0) = w;
                }
        }
    }
};

DEVI void ph_inproj(const Ctx& cx, int l) {
    DenseSched S{(const char*)WSP(unsigned char, WS_HIN8), (const char*)(WSP(unsigned char, WS_WIN) + (size_t)l * NP * 1024), TT / 256, NP / 256, 0, cx.G, cx.bid, 1024};
    EpiIn E{WSP(bf16_t, WS_P), WSP(float, WS_BIN2) + (size_t)l * NP};
    g1::gemm_phase<DenseSched, EpiIn, false, true>(cx.lds, cx.tid, S, E);
    if (l < DEPTH - 1 && cx.G == 256 && (cx.bid >> 3) >= 26) {
        for (int k2 = 0; k2 < 2; ++k2) { const int j2 = ((cx.bid >> 3) - 26) * 8 + (cx.bid & 7) + 48 * k2, le = (l + 1) * 32 + 14 + j2 / 32, r = j2 % 32, kt = r / 8, nt = r % 8;
            cvt_tile8(cx, cx.p->in[I_WGU] + (size_t)le * 1024 * 2048, 2048, WSP(unsigned char, WS_WGU) + (size_t)le * 2048 * 1024, nt * 256, kt * 256, 2); }
        { const int j3 = ((cx.bid >> 3) - 26) * 8 + (cx.bid & 7), le = (l + 1) * 32 + j3 / 16, r = j3 % 16, kt = r / 4, nt = r % 4;
            cvt_tile8(cx, cx.p->in[I_WD] + (size_t)le * 1024 * 1024, 1024, WSP(unsigned char, WS_WD) + (size_t)le * 1024 * 1024, nt * 256, kt * 256, 1); } }
}
DEVI void ph_outproj(const Ctx& cx, int l) {
    const int pm0 = (l == DEPTH - 1) ? TCTX / 256 : 0;
    DenseSched S{(const char*)WSP(bf16_t, WS_MRG), (const char*)(WSP(bf16_t, WS_WOUT) + (size_t)l * 1024 * 1024), TT / 256 - pm0, 4, pm0, cx.G, cx.bid, 2048};
    EpiOut E{WSP(bf16_t, WS_XS), WSP(bf16_t, WS_XMID), WSP(float, WS_MOD) + (size_t)l * 9 * 6144};
    g1::gemm_phase<DenseSched, EpiOut, false>(cx.lds, cx.tid, S, E);
    if (l < DEPTH - 1 && cx.G == 256 && cx.bid >= 32) {
        for (int k2 = 0; k2 < 2; ++k2) { const int j2 = cx.bid - 32 + 224 * k2, le = (l + 1) * 32 + j2 / 32, r = j2 % 32, kt = r / 8, nt = r % 8;
            cvt_tile8(cx, cx.p->in[I_WGU] + (size_t)le * 1024 * 2048, 2048, WSP(unsigned char, WS_WGU) + (size_t)le * 2048 * 1024, nt * 256, kt * 256, 2); } }
}
DEVI void ph_moe_gu(const Ctx& cx, int l) {
    LAS int* info = (LAS int*)(cx.lds + g1::STAGE_BYTES);
    moe_info(cx, l, info);
    MoeSched S{(const char*)WSP(unsigned char, WS_H8), (const char*)(WSP(unsigned char, WS_WGU) + (size_t)l * NE * 2048 * 1024), WSP(int, WS_ELIST), info, 8, 1, cx.G, cx.bid, (size_t)2048 * 1024, 1024};
    EpiGU E{WSP(unsigned char, WS_ACT), cx.p->in[I_BGU] + (size_t)l * NE * 2048};
    g1::gemm_phase<MoeSched, EpiGU, true, true>(cx.lds, cx.tid, S, E);
}
DEVI void ph_moe_dn(const Ctx& cx, int l) {
    LAS int* info = (LAS int*)(cx.lds + g1::STAGE_BYTES);
    moe_info(cx, l, info);
    MoeSched S{(const char*)WSP(unsigned char, WS_ACT), (const char*)(WSP(unsigned char, WS_WD) + (size_t)l * NE * 1024 * 1024), nullptr, info, 4, 0, cx.G, cx.bid, (size_t)1024 * 1024, 1024};
    EpiDown E{WSP(unsigned char, WS_YPAD), cx.p->in[I_BD] + (size_t)l * NE * 1024};
    g1::gemm_phase<MoeSched, EpiDown, false, true>(cx.lds, cx.tid, S, E);
}

DEVI int ml_row0(int b, int c) { return c < 2 ? b * CTXL + c * 128 : TCTX + b * SEQ + (c - 2) * 128; }
DEVI unsigned short lds_u16(const LAS bf16_t* p) { return *p; }
typedef short s16x4 __attribute__((ext_vector_type(4)));
DEVI bf16x8 tr8(const LAS bf16_t* tile, int stride, int r0, int r1, int c0, int lane) {
    const int q = (lane & 15) >> 2, p = lane & 3;
    const s16x4 a = __builtin_amdgcn_ds_read_tr16_b64_v4i16((LAS s16x4*)(tile + (r0 + q) * stride + c0 + 4 * p));
    const s16x4 b = __builtin_amdgcn_ds_read_tr16_b64_v4i16((LAS s16x4*)(tile + (r1 + q) * stride + c0 + 4 * p));
    return __builtin_shufflevector(a, b, 0, 1, 2, 3, 4, 5, 6, 7);
}

DEVI void ml_local_unit(const Ctx& cx, int l, int b, int h, int c) {
    LAS float* sg = (LAS float*)cx.lds;
    LAS float* se = sg + 256;
    LAS float* red = se + 256;
    LAS bf16_t* Ks = (LAS bf16_t*)(cx.lds + 4352);
    LAS bf16_t* Ve = Ks + 128 * 104;
    const int row0 = ml_row0(b, c), tid = cx.tid;
    const int dir = (tid >> 7) & 1, p = tid & 127, i = dir ? 127 - p : p;
    const bool act = tid < 256;
    float gi = 0.f, bval = 0.f, u = 0.f, cm = 0.f;
    const bf16_t* Pp = WSP(bf16_t, WS_P);
    u32x4 kvr[3], vvr[3];
#pragma unroll
    for (int it = 0; it < 3; ++it) { const int idx = tid + NTHR * it, r = idx / 12, ch = idx % 12;
        kvr[it] = *(const u32x4*)(Pp + (size_t)(row0 + r) * NP + PC_K + h * 96 + ch * 8); vvr[it] = *(const u32x4*)(Pp + (size_t)(row0 + r) * NP + PC_V + h * 96 + ch * 8); }
    if (act) { const float* gt = WSP(float, WS_GT) + (size_t)(row0 + i) * 16; gi = gt[dir * 4 + h]; const float gf = gt[8 + dir * 4 + h];
        bval = wave_scan<false>(fminf(gf, 0.f) - log1p_(__expf(-fabsf(gf))), cx.lane);
        if (cx.lane == 63) red[4 + cx.wave] = bval; }
    LDS_SYNC();
    if (act) { if (cx.wave & 1) bval += red[4 + cx.wave - 1];
        u = gi - bval; if (p == 127) red[dir] = bval;
        cm = wave_scan<true>(u, cx.lane);
        if (cx.lane == 63) red[8 + cx.wave] = cm; }
    LDS_SYNC();
    if (act) { if (cx.wave & 1) cm = fmaxf(cm, red[8 + cx.wave - 1]);
        if (p == 127) red[2 + dir] = cm;
        const size_t gix = (size_t)(row0 + i) * 8 + dir * 4 + h;
        WSP(float, WS_GB)[gix] = bval; WSP(float, WS_GU)[gix] = u; WSP(float, WS_GCM)[gix] = cm; }
    LDS_SYNC();
    if (act) se[dir * 128 + i] = expf(u - red[2 + dir]);
    if (tid < 2) { float* msc = WSP(float, WS_MSC) + ((size_t)((b * 4 + h) * MLC + c) * 2 + tid) * 2; msc[0] = red[tid]; msc[1] = red[tid] + red[2 + tid]; }
    LDS_SYNC();
#pragma unroll
    for (int it = 0; it < 3; ++it) { const int idx = tid + NTHR * it, r = idx / 12, ch = idx % 12;
        *(LAS u32x4*)(Ks + r * 104 + ch * 8) = kvr[it];
        const u32x4 vv = vvr[it];
        const float e0 = se[r], e1 = se[128 + r];
        u32x4 o0, o1;
#pragma unroll
        for (int q = 0; q < 4; ++q) { const float lo = __uint_as_float(vv[q] << 16), hi = __uint_as_float(vv[q] & 0xFFFF0000u);
            o0[q] = pk_bf16(lo * e0, hi * e0); o1[q] = pk_bf16(lo * e1, hi * e1); }
        *(LAS u32x4*)(Ve + r * 104 + ch * 8) = o0; *(LAS u32x4*)(Ve + (128 + r) * 104 + ch * 8) = o1; }
    LDS_SYNC();
    {
        const int wd = cx.wave >> 2, wq = cx.wave & 3, dt0 = (wq & 1) * 3, et0 = (wq >> 1) * 3, fr = cx.lane & 15, fq = cx.lane >> 4;
        float* cl = WSP(float, WS_CLOC) + ((size_t)((b * 4 + h) * MLC + c) * 2 + wd) * 9216;
        const LAS bf16_t* V = Ve + wd * 128 * 104;
        f32x4 acc[3][3];
#pragma unroll
        for (int i = 0; i < 3; ++i)
#pragma unroll
            for (int j = 0; j < 3; ++j) acc[i][j] = (f32x4){0.f, 0.f, 0.f, 0.f};
#pragma unroll
        for (int kk = 0; kk < 4; ++kk) { const int s0 = kk * 32 + fq * 8;
            bf16x8 a[3], bb[3];
#pragma unroll
            for (int i = 0; i < 3; ++i) { a[i] = tr8(V, 104, s0, s0 + 4, (dt0 + i) * 16, cx.lane); bb[i] = tr8(Ks, 104, s0, s0 + 4, (et0 + i) * 16, cx.lane); }
#pragma unroll
            for (int i = 0; i < 3; ++i)
#pragma unroll
                for (int j = 0; j < 3; ++j) acc[i][j] = __builtin_amdgcn_mfma_f32_16x16x32_bf16(a[i], bb[j], acc[i][j], 0, 0, 0); }
#pragma unroll
        for (int i = 0; i < 3; ++i)
#pragma unroll
            for (int j = 0; j < 3; ++j)
#pragma unroll
                for (int r = 0; r < 4; ++r) cl[((dt0 + i) * 16 + fq * 4 + r) * 96 + (et0 + j) * 16 + fr] = acc[i][j][r];
    }
    {
        LAS float* nred = (LAS float*)(cx.lds + 4352 + 3 * 128 * 104 * 2);
        for (int idx = tid; idx < 768; idx += NTHR) { const int qd = idx / 192, rem = idx % 192, d2 = rem / 96, e = rem % 96; float s = 0.f;
#pragma unroll 8
            for (int t = qd * 32; t < qd * 32 + 32; ++t) s += se[d2 * 128 + t] * bf2f(Ks[t * 104 + e]);
            nred[idx] = s; }
        LDS_SYNC();
        if (tid < 192) WSP(float, WS_NLOC)[((size_t)((b * 4 + h) * MLC + c) * 2 + tid / 96) * 96 + tid % 96] = (nred[tid] + nred[192 + tid]) + (nred[384 + tid] + nred[576 + tid]);
    }
    LDS_SYNC();
}

DEVI void ml_carry(const Ctx& cx) {
    const bool part = cx.G == 256; const int nb = part ? 212 : cx.G, b0 = part ? cx.bid - 32 : cx.bid;
    if (part && (cx.bid < 32 || cx.bid >= 244)) return;
    for (int idx = b0 * NTHR + cx.tid; idx < 64 * 9312; idx += nb * NTHR) {
        const int combo = idx / 9312, el = idx % 9312, dir = combo & 1, bh = combo >> 1;
        float loc[MLC], bl[MLC], ml[MLC];
#pragma unroll
        for (int s = 0; s < MLC; ++s) {
            const int c = dir == 0 ? s : (s < 2 ? 1 - s : 19 - s);
            const size_t cb = (size_t)(bh * MLC + c) * 2 + dir;
            bl[s] = WSP(float, WS_MSC)[cb * 2]; ml[s] = WSP(float, WS_MSC)[cb * 2 + 1];
            loc[s] = el < 9216 ? WSP(float, WS_CLOC)[cb * 9216 + el] : WSP(float, WS_NLOC)[cb * 96 + el - 9216];
        }
        float Cv = 0.f, m = -1e30f;
#pragma unroll
        for (int s = 0; s < MLC; ++s) {
            const int c = dir == 0 ? s : (s < 2 ? 1 - s : 19 - s);
            const size_t cb = (size_t)(bh * MLC + c) * 2 + dir;
            if (el < 9216) WSP(bf16_t, WS_C0)[cb * 9216 + el] = f2bf(Cv); else WSP(float, WS_N0)[cb * 96 + el - 9216] = Cv;
            if (el == 0) WSP(float, WS_M0)[cb] = m;
            const float mn = fmaxf(bl[s] + m, ml[s]), a = __expf(bl[s] + m - mn), sc = __expf(ml[s] - mn);
            Cv = a * Cv + sc * loc[s]; m = mn;
        }
    }
}

DEVI void ml_out_unit(const Ctx& cx, int l, int b, int h, int c) {
    LAS bf16_t* Qs = (LAS bf16_t*)cx.lds;
    LAS bf16_t* Ks = Qs + 128 * 104;
    LAS bf16_t* Vs = Ks + 128 * 104;
    LAS bf16_t* C0s = Vs + 128 * 104;
    LAS float* gb = (LAS float*)(cx.lds + 119808);
    LAS float* gu = gb + 256;
    LAS float* gM = gu + 256;
    LAS float* n0s = gM + 256;
    LAS float* m0s = n0s + 192;
    LAS float* mws = m0s + 4;
    const int row0 = ml_row0(b, c), tid = cx.tid;
    const bf16_t* Pp = WSP(bf16_t, WS_P);
    const size_t cb0 = (size_t)((b * 4 + h) * MLC + c) * 2;
    u32x4 tq[3], tk[3], tv[3], tc[5];
#pragma unroll
    for (int it = 0; it < 3; ++it) { const int idx = tid + NTHR * it, r = idx / 12, ch = idx % 12;
        const bf16_t* rp = Pp + (size_t)(row0 + r) * NP + h * 96 + ch * 8;
        tq[it] = *(const u32x4*)(rp + PC_Q); tk[it] = *(const u32x4*)(rp + PC_K); tv[it] = *(const u32x4*)(rp + PC_V); }
#pragma unroll
    for (int it = 0; it < 5; ++it) { const int idx = min(tid + NTHR * it, 2 * 96 * 12 - 1), d2 = idx / 1152, r = (idx % 1152) / 12, ch = idx % 12;
        tc[it] = *(const u32x4*)(WSP(bf16_t, WS_C0) + (cb0 + d2) * 9216 + r * 96 + ch * 8); }
    const int d2s = (tid >> 7) & 1, kN = min(max(tid - 256, 0), 191), kW = min(max(tid - 452, 0), 23);
    const size_t gixs = (size_t)(row0 + (tid & 127)) * 8 + d2s * 4 + h;
    const float s0 = WSP(float, WS_GB)[gixs], s1 = WSP(float, WS_GU)[gixs], s2 = WSP(float, WS_M0)[cb0 + d2s], s3 = WSP(float, WS_GCM)[gixs];
    const float sN = WSP(float, WS_N0)[(cb0 + kN / 96) * 96 + kN % 96], sM = WSP(float, WS_M0)[cb0 + (tid & 1)];
    const f32x4 smw = *(const f32x4*)(cx.p->in[I_MIXW] + l * 1024 + h * 96 + kW * 4);
    const int w = cx.wave, fr = cx.lane & 15, fq = cx.lane >> 4, t = 16 * w + fr;
    const int src = epi_src(fr, fq), frn = 4 * fq + (fr >> 2), fqn = fr & 3;
    const size_t prow = (size_t)(row0 + 16 * w + frn);
    u32x2 ovr[6];
#pragma unroll
    for (int n = 0; n < 6; ++n) ovr[n] = *(const u32x2*)(Pp + prow * NP + PC_O + h * 96 + 16 * n + 4 * fqn);
    __builtin_amdgcn_sched_barrier(0);
#pragma unroll
    for (int it = 0; it < 3; ++it) { const int idx = tid + NTHR * it, r = idx / 12, ch = idx % 12;
        *(LAS u32x4*)(Qs + r * 104 + ch * 8) = tq[it]; *(LAS u32x4*)(Ks + r * 104 + ch * 8) = tk[it]; *(LAS u32x4*)(Vs + r * 104 + ch * 8) = tv[it]; }
#pragma unroll
    for (int it = 0; it < 5; ++it) { const int idx = tid + NTHR * it, d2 = idx / 1152, r = (idx % 1152) / 12, ch = idx % 12;
        if (idx < 2 * 96 * 12) *(LAS u32x4*)(C0s + (d2 * 96 + r) * 104 + ch * 8) = tc[it]; }
    if (tid < 256) { gb[tid] = s0; gu[tid] = s1; gM[tid] = fmaxf(s2, s3); }
    else if (tid < 448) n0s[tid - 256] = sN;
    else if (tid < 450) m0s[tid - 448] = sM;
    if (tid >= 452 && tid < 476) *(LAS f32x4*)(mws + (tid - 452) * 4) = smw;
    LDS_SYNC();
    bf16x8 qf[3];
#pragma unroll
    for (int kk = 0; kk < 3; ++kk) qf[kk] = *(const LAS bf16x8*)(Qs + t * 104 + kk * 32 + fq * 8);
    f32x4 hs[6];
#pragma unroll
    for (int n = 0; n < 6; ++n) hs[n] = (f32x4){0.f, 0.f, 0.f, 0.f};
#pragma unroll
    for (int dir = 0; dir < 2; ++dir) {
        const float Mt = gM[dir * 128 + t], bt = gb[dir * 128 + t], inter = __expf(m0s[dir] - Mt);
        f32x4 an[6];
#pragma unroll
        for (int n = 0; n < 6; ++n) an[n] = (f32x4){0.f, 0.f, 0.f, 0.f};
        float den = 0.f;
        const int Jlo = dir == 0 ? 0 : (w >> 1), Jhi = dir == 0 ? (w >> 1) : 3;
#pragma unroll 1
        for (int J = Jlo; J <= Jhi; ++J) {
            bf16x8 pf;
#pragma unroll
            for (int half = 0; half < 2; ++half) {
                const int j = 2 * J + half;
                f32x4 D = (f32x4){0.f, 0.f, 0.f, 0.f};
                const bool need = dir == 0 ? (j <= w) : (j >= w);
                if (need) {
#pragma unroll
                    for (int kk = 0; kk < 3; ++kk) { const bf16x8 kf = *(const LAS bf16x8*)(Ks + (16 * j + fr) * 104 + kk * 32 + fq * 8);
                        D = __builtin_amdgcn_mfma_f32_16x16x32_bf16(kf, qf[kk], D, 0, 0, 0); }
                }
                const f32x4 us = *(const LAS f32x4*)(gu + dir * 128 + 16 * j + 4 * fq);
                float pv[4];
#pragma unroll
                for (int r = 0; r < 4; ++r) { const int s = 16 * j + 4 * fq + r; const bool valid = need && (dir == 0 ? (s <= t) : (s >= t));
                    pv[r] = valid ? D[r] * __expf(us[r] - Mt) : 0.f; den += pv[r]; }
                { const unsigned p01 = pk_bf16(pv[0], pv[1]), p23 = pk_bf16(pv[2], pv[3]); pf[half * 4 + 0] = (short)(p01 & 0xFFFFu); pf[half * 4 + 1] = (short)(p01 >> 16); pf[half * 4 + 2] = (short)(p23 & 0xFFFFu); pf[half * 4 + 3] = (short)(p23 >> 16); }
            }
#pragma unroll
            for (int n = 0; n < 6; ++n) { const bf16x8 vf = tr8(Vs, 104, 32 * J + 4 * fq, 32 * J + 16 + 4 * fq, 16 * n, cx.lane);
                an[n] = __builtin_amdgcn_mfma_f32_16x16x32_bf16(vf, pf, an[n], 0, 0, 0); }
        }
        float nq = 0.f;
#pragma unroll
        for (int kk = 0; kk < 3; ++kk)
#pragma unroll
            for (int j = 0; j < 8; ++j) nq += n0s[dir * 96 + kk * 32 + fq * 8 + j] * bf2f((bf16_t)qf[kk][j]);
        nq += shx<16>(nq, cx.lane); nq += shx<32>(nq, cx.lane);
        den += shx<16>(den, cx.lane); den += shx<32>(den, cx.lane);
        const float dtot = den + inter * nq;
        const float inv = frcp(fmaxf(fabsf(dtot), __expf(-(Mt + bt))));
#pragma unroll
        for (int n = 0; n < 6; ++n) { f32x4 ac = (f32x4){0.f, 0.f, 0.f, 0.f};
#pragma unroll
            for (int kk = 0; kk < 3; ++kk) { const bf16x8 cf = *(const LAS bf16x8*)(C0s + (dir * 96 + 16 * n + fr) * 104 + kk * 32 + fq * 8);
                ac = __builtin_amdgcn_mfma_f32_16x16x32_bf16(cf, qf[kk], ac, 0, 0, 0); }
            hs[n] += (an[n] + ac * inter) * inv; }
    }
    float ss = 0.f;
#pragma unroll
    for (int n = 0; n < 6; ++n) ss += hs[n][0] * hs[n][0] + hs[n][1] * hs[n][1] + hs[n][2] * hs[n][2] + hs[n][3] * hs[n][3];
    ss += shx<16>(ss, cx.lane); ss += shx<32>(ss, cx.lane);
    const float rstd = rsqrtf(ss * (1.0f / 96.0f) + EPS);
#pragma unroll
    for (int n = 0; n < 6; ++n) { const int d = 16 * n + 4 * fqn;
        const u32x2 ov = ovr[n];
        const f32x4 mw = *(const LAS f32x4*)(mws + d);
        const float o0 = __uint_as_float(ov.x << 16), o1 = __uint_as_float(ov.x & 0xFFFF0000u), o2 = __uint_as_float(ov.y << 16), o3 = __uint_as_float(ov.y & 0xFFFF0000u);
        const float h0 = bpermf(src, hs[n][0] * rstd), h1 = bpermf(src, hs[n][1] * rstd), h2 = bpermf(src, hs[n][2] * rstd), h3 = bpermf(src, hs[n][3] * rstd);
        u32x2 wv; wv.x = pk_bf16(sigmoidf_(o0) * h0 * mw[0], sigmoidf_(o1) * h1 * mw[1]);
        wv.y = pk_bf16(sigmoidf_(o2) * h2 * mw[2], sigmoidf_(o3) * h3 * mw[3]);
        *(u32x2*)(WSP(bf16_t, WS_MRG) + prow * 1024 + h * 96 + d) = wv; }
    LDS_SYNC();
}

struct RgPre { u32x4 xr2[2]; float cw[4]; float cbias; bf16x8 wbr[2], wbi[2]; f32x4 ba, bx, lam; float hc_in; u32x4 gv_in; f32x4 mw0, mw1; };
DEVI void rg_decode(int u, int& b, int& ck, int& g) { b = u / (RGC * 6); ck = (u / 6) % RGC; g = u % 6; }
DEVI void rg_issue(const Ctx& cx, int l, int u, int mode, RgPre& R) {
    const Params& P = *cx.p;
    int b, ck, g; rg_decode(u, b, ck, g);
    const int tid = cx.tid;
    const int t0 = ck < 4 ? ck * 64 : (ck - 4) * 64, seglen = ck < 4 ? CTXL : SEQ, rowbase = ck < 4 ? b * CTXL : TCTX + b * SEQ;
    const bf16_t* Pp = WSP(bf16_t, WS_P);
#pragma unroll
    for (int it = 0; it < 2; ++it) { const int idx = min(tid + NTHR * it, 67 * 8 - 1), r = idx >> 3, c8 = idx & 7, tt = min(max(t0 - 2 + r, 0), seglen - 1);
        R.xr2[it] = *(const u32x4*)(Pp + (size_t)(rowbase + tt) * NP + PC_RX + g * 64 + c8 * 8); }
    const int cgc = g * 64 + (tid & 63);
    R.cbias = P.in[I_RGCB][l * 384 + cgc];
#pragma unroll
    for (int j = 0; j < 4; ++j) R.cw[j] = P.in[I_RGCW][(l * 4 + j) * 384 + cgc];
    const int gdir = cx.wave >> 2, gcg4 = cx.wave & 3, gch0 = gcg4 * 16 + 4 * (cx.lane >> 4), gcgl = g * 64 + gch0;
    const bf16_t* wrg = WSP(bf16_t, WS_WRG) + (size_t)(l * 6 + g) * 256 * 64;
#pragma unroll
    for (int kk = 0; kk < 2; ++kk) { R.wbr[kk] = ldg8(wrg + ((((gdir * 2 + 0) * 4 + gcg4) * 2 + kk) << 9) + cx.lane * 8); R.wbi[kk] = ldg8(wrg + ((((gdir * 2 + 1) * 4 + gcg4) * 2 + kk) << 9) + cx.lane * 8); }
    R.ba = *(const f32x4*)(P.in[I_RGBA] + (l * 2 + gdir) * 384 + gcgl); R.bx = *(const f32x4*)(P.in[I_RGBX] + (l * 2 + gdir) * 384 + gcgl);
    R.lam = *(const f32x4*)(P.in[I_RGLAM] + (l * 2 + gdir) * 384 + gcgl);
    const size_t six = ((size_t)(b * RGC + ck) * 2 + ((tid >> 6) & 1)) * 384 + g * 64 + (tid & 63);
    R.hc_in = 0.f; R.gv_in = (u32x4){0u, 0u, 0u, 0u}; R.mw0 = (f32x4){0.f, 0.f, 0.f, 0.f}; R.mw1 = R.mw0;
    if (mode) { R.hc_in = WSP(float, WS_RGC)[six];
        R.gv_in = *(const u32x4*)(Pp + (size_t)(rowbase + t0 + (tid >> 3)) * NP + PC_RG + g * 64 + (tid & 7) * 8);
        const float* mwp = P.in[I_MIXW] + l * 1024 + 384 + g * 64 + (tid & 7) * 8; R.mw0 = *(const f32x4*)mwp; R.mw1 = *(const f32x4*)(mwp + 4); }
}
DEVI void rg_body(const Ctx& cx, int l, int u, int mode, const RgPre& R) {
    int b, ck, g; rg_decode(u, b, ck, g);
    LAS float* xraw = (LAS float*)cx.lds;
    LAS float* xc = (LAS float*)(cx.lds + 17408);
    LAS bf16_t* xcb = (LAS bf16_t*)(cx.lds + 34816);
    LAS float* ab = (LAS float*)(cx.lds + 44032);
    LAS float* hbuf = (LAS float*)(cx.lds + 44032 + 69632);
    const int tid = cx.tid;
    const int t0 = ck < 4 ? ck * 64 : (ck - 4) * 64, seglen = ck < 4 ? CTXL : SEQ, rowbase = ck < 4 ? b * CTXL : TCTX + b * SEQ;
    const bf16_t* Pp = WSP(bf16_t, WS_P);
#pragma unroll
    for (int it = 0; it < 2; ++it) { const int idx = tid + NTHR * it, r = idx >> 3, c8 = idx & 7, tt = t0 - 2 + r;
        if (idx >= 67 * 8) break;
        const u32x4 v = (tt >= 0 && tt < seglen) ? R.xr2[it] : (u32x4){0u, 0u, 0u, 0u};
#pragma unroll
        for (int q = 0; q < 4; ++q) { xraw[r * 64 + c8 * 8 + 2 * q] = __uint_as_float(v[q] << 16); xraw[r * 64 + c8 * 8 + 2 * q + 1] = __uint_as_float(v[q] & 0xFFFF0000u); } }
    const float cbias = R.cbias; const float cw[4] = {R.cw[0], R.cw[1], R.cw[2], R.cw[3]};
    const bf16x8 wbr[2] = {R.wbr[0], R.wbr[1]}, wbi[2] = {R.wbi[0], R.wbi[1]};
    const f32x4 ba = R.ba, bx = R.bx, lam = R.lam; const float hc_in = R.hc_in; const u32x4 gv_in = R.gv_in; const f32x4 mw0 = R.mw0, mw1 = R.mw1;
    LDS_SYNC();
#pragma unroll
    for (int it = 0; it < 8; ++it) { const int idx = tid + NTHR * it, t = idx >> 6, ch = idx & 63, cg = g * 64 + ch;
        float v = cbias;
#pragma unroll
        for (int j = 0; j < 4; ++j) v += cw[j] * xraw[(t + j) * 64 + ch];
        xc[t * 68 + ch] = v; xcb[t * 72 + ch] = f2bf_hw(v); }
    LDS_SYNC();
    {
        const int dir = cx.wave >> 2, cg4 = cx.wave & 3, fr = cx.lane & 15, fq = cx.lane >> 4;
        f32x4 ar[4], ai[4];
#pragma unroll
        for (int m = 0; m < 4; ++m) { ar[m] = (f32x4){0.f, 0.f, 0.f, 0.f}; ai[m] = (f32x4){0.f, 0.f, 0.f, 0.f}; }
#pragma unroll
        for (int kk = 0; kk < 2; ++kk) {
            const bf16x8 br = wbr[kk], bi = wbi[kk];
#pragma unroll
            for (int m = 0; m < 4; ++m) { const bf16x8 a = *(const LAS bf16x8*)(xcb + (m * 16 + fr) * 72 + kk * 32 + fq * 8);
                ar[m] = __builtin_amdgcn_mfma_f32_16x16x32_bf16(br, a, ar[m], 0, 0, 0); ai[m] = __builtin_amdgcn_mfma_f32_16x16x32_bf16(bi, a, ai[m], 0, 0, 0); }
        }
        const int ch0 = cg4 * 16 + 4 * fq, cgl = g * 64 + ch0;
        float sp[4];
#pragma unroll
        for (int j = 0; j < 4; ++j) sp[j] = lam[j] > 0.f ? log1p_(__expf(-lam[j])) : -lam[j] + log1p_(__expf(lam[j]));
#pragma unroll
        for (int m = 0; m < 4; ++m) { const int t = m * 16 + fr; const f32x4 xv = *(const LAS f32x4*)(xc + t * 68 + ch0);
            f32x4 av, bv;
#pragma unroll
            for (int j2 = 0; j2 < 2; ++j2) {
                const f32x2 xr = ((f32x2){ar[m][2 * j2], ar[m][2 * j2 + 1]} + (f32x2){ba[2 * j2], ba[2 * j2 + 1]}) * (-1.44269504f);
                const f32x2 xi = ((f32x2){ai[m][2 * j2], ai[m][2 * j2 + 1]} + (f32x2){bx[2 * j2], bx[2 * j2 + 1]}) * (-1.44269504f);
                f32x2 er, ei; er.x = __builtin_amdgcn_exp2f(xr.x); er.y = __builtin_amdgcn_exp2f(xr.y); ei.x = __builtin_amdgcn_exp2f(xi.x); ei.y = __builtin_amdgcn_exp2f(xi.y);
                er = er + 1.0f; ei = ei + 1.0f;
                f32x2 r, ii; r.x = frcp(er.x); r.y = frcp(er.y); ii.x = frcp(ei.x); ii.y = frcp(ei.y);
                const f32x2 la = r * (f32x2){sp[2 * j2], sp[2 * j2 + 1]} * (-8.0f), y = la * 2.0f, l2 = la * 1.44269504f;
                f32x2 a; a.x = __builtin_amdgcn_exp2f(l2.x); a.y = __builtin_amdgcn_exp2f(l2.y);
                const f32x2 ser = -y * (y * (y * 0.16666667f + 0.5f) + 1.0f), sq = -(a * a) + 1.0f;
                f32x2 nem; nem.x = y.x > -0.02f ? ser.x : sq.x; nem.y = y.y > -0.02f ? ser.y : sq.y;
                f32x2 rt; rt.x = __builtin_sqrtf(nem.x); rt.y = __builtin_sqrtf(nem.y);
                const f32x2 bb2 = rt * (ii * (f32x2){xv[2 * j2], xv[2 * j2 + 1]});
                av[2 * j2] = a.x; av[2 * j2 + 1] = a.y; bv[2 * j2] = bb2.x; bv[2 * j2 + 1] = bb2.y; }
            *(LAS f32x4*)(ab + ((dir * 2 + 0) * 64 + t) * 68 + ch0) = av; *(LAS f32x4*)(ab + ((dir * 2 + 1) * 64 + t) * 68 + ch0) = bv; }
    }
    LDS_SYNC();
    if (!mode) {
        bf16_t* gab = WSP(bf16_t, WS_RGAB) + (size_t)u * 16384;
#pragma unroll
        for (int it = 0; it < 4; ++it) { const LAS float* p = ab + (it * 64 + (tid >> 3)) * 68 + (tid & 7) * 8;
            f32x4 v0 = *(const LAS f32x4*)p, v1 = *(const LAS f32x4*)(p + 4);
            if ((it & 1) == 0) { v0 = 1.0f - v0; v1 = 1.0f - v1; }
            u32x4 w; w.x = pk_bf16(v0[0], v0[1]); w.y = pk_bf16(v0[2], v0[3]); w.z = pk_bf16(v1[0], v1[1]); w.w = pk_bf16(v1[2], v1[3]);
            *(u32x4*)(gab + (size_t)(it * 512 + tid) * 8) = w; }
    }
    {
        LAS float* segb = (LAS float*)(cx.lds + 44032 + 69632 + 32768);
        const int seg = tid >> 7, dir = (tid >> 6) & 1, ch = tid & 63; const size_t ix = ((size_t)(b * RGC + ck) * 2 + dir) * 384 + g * 64 + ch;
        const LAS float* __restrict__ A = ab + (dir * 2 + 0) * 4352 + ch; const LAS float* __restrict__ B = ab + (dir * 2 + 1) * 4352 + ch; LAS float* __restrict__ H = hbuf + dir * 4096 + ch;
        float av[16], bv[16];
#pragma unroll
        for (int j = 0; j < 16; ++j) { const int sI = seg * 16 + j, t = dir ? 63 - sI : sI; av[j] = A[t * 68]; bv[j] = B[t * 68]; }
        float hl = 0.f, pp = 1.0f;
#pragma unroll
        for (int j = 0; j < 16; ++j) { hl = av[j] * hl + bv[j]; pp *= av[j]; bv[j] = hl; av[j] = pp; }
        *(LAS f32x2*)(segb + ((seg * 128 + dir * 64 + ch) << 1)) = (f32x2){pp, hl};
        LDS_SYNC();
        float hin = hc_in, aptot = 1.0f;
#pragma unroll
        for (int q = 0; q < 3; ++q) if (q < seg) { const f32x2 sq = *(const LAS f32x2*)(segb + ((q * 128 + dir * 64 + ch) << 1)); hin = sq.x * hin + sq.y; aptot *= sq.x; }
        if (mode) {
#pragma unroll
            for (int j = 0; j < 16; ++j) { const int sI = seg * 16 + j, t = dir ? 63 - sI : sI; H[t * 64] = bv[j] + av[j] * hin; } }
        else if (seg == 3) { WSP(float, WS_RGA)[ix] = aptot * av[15]; WSP(float, WS_RGB)[ix] = av[15] * hin + bv[15]; }
    }
    LDS_SYNC();
    if (mode) { const int t = tid >> 3, ch0 = (tid & 7) * 8; float hv[8]; float ss = 0.f;
#pragma unroll
        for (int j = 0; j < 8; ++j) { hv[j] = hbuf[t * 64 + ch0 + j] + hbuf[4096 + t * 64 + ch0 + j]; ss += hv[j] * hv[j]; }
        ss += dpp_<0xB1, 0xF>(ss); ss += dpp_<0x4E, 0xF>(ss); ss += dpp_<0x141, 0xF>(ss);
        const float rstd = rsqrtf(ss * (1.0f / 64.0f) + EPS);
        const size_t row = (size_t)(rowbase + t0 + t);
        const u32x4 gv = gv_in; const float mw[8] = {mw0[0], mw0[1], mw0[2], mw0[3], mw1[0], mw1[1], mw1[2], mw1[3]};
        u32x4 o;
#pragma unroll
        for (int q = 0; q < 4; ++q) { const float g0 = __uint_as_float(gv[q] << 16), g1v = __uint_as_float(gv[q] & 0xFFFF0000u);
            o[q] = pk_bf16(g0 * hv[2 * q] * rstd * mw[2 * q], g1v * hv[2 * q + 1] * rstd * mw[2 * q + 1]); }
        *(u32x4*)(WSP(bf16_t, WS_MRG) + row * 1024 + 384 + g * 64 + ch0) = o;
        LDS_SYNC(); }
}
struct RgPre2 { u32x4 q[4]; float hc_in; u32x4 gv_in; f32x4 mw0, mw1; };
DEVI void rg2_issue(const Ctx& cx, int l, int u, RgPre2& R) {
    int b, ck, g; rg_decode(u, b, ck, g);
    const int tid = cx.tid;
    const int t0 = ck < 4 ? ck * 64 : (ck - 4) * 64, rowbase = ck < 4 ? b * CTXL : TCTX + b * SEQ;
    const bf16_t* gab = WSP(bf16_t, WS_RGAB) + (size_t)u * 16384;
#pragma unroll
    for (int it = 0; it < 4; ++it) R.q[it] = *(const u32x4*)(gab + (size_t)(it * 512 + tid) * 8);
    R.hc_in = WSP(float, WS_RGC)[((size_t)(b * RGC + ck) * 2 + ((tid >> 6) & 1)) * 384 + g * 64 + (tid & 63)];
    R.gv_in = *(const u32x4*)(WSP(bf16_t, WS_P) + (size_t)(rowbase + t0 + (tid >> 3)) * NP + PC_RG + g * 64 + (tid & 7) * 8);
    const float* mwp = cx.p->in[I_MIXW] + l * 1024 + 384 + g * 64 + (tid & 7) * 8; R.mw0 = *(const f32x4*)mwp; R.mw1 = *(const f32x4*)(mwp + 4);
}
DEVI void rg2_body(const Ctx& cx, int l, int u, const RgPre2& R) {
    int b, ck, g; rg_decode(u, b, ck, g);
    LAS float* ab = (LAS float*)(cx.lds + 44032);
    LAS float* hbuf = (LAS float*)(cx.lds + 44032 + 69632);
    LAS float* segb = (LAS float*)(cx.lds + 44032 + 69632 + 32768);
    const int tid = cx.tid;
    const int t0 = ck < 4 ? ck * 64 : (ck - 4) * 64, rowbase = ck < 4 ? b * CTXL : TCTX + b * SEQ;
#pragma unroll
    for (int it = 0; it < 4; ++it) { const u32x4 v = R.q[it]; LAS float* p = ab + (it * 64 + (tid >> 3)) * 68 + (tid & 7) * 8;
        f32x4 v0 = bf4_f32((u32x2){v.x, v.y}), v1 = bf4_f32((u32x2){v.z, v.w});
        if ((it & 1) == 0) { v0 = 1.0f - v0; v1 = 1.0f - v1; }
        *(LAS f32x4*)p = v0; *(LAS f32x4*)(p + 4) = v1; }
    const float hc_in = R.hc_in;
    LDS_SYNC();
    {   const int seg = tid >> 7, dir = (tid >> 6) & 1, ch = tid & 63;
        const LAS float* __restrict__ A = ab + (dir * 2 + 0) * 4352 + ch; const LAS float* __restrict__ B = ab + (dir * 2 + 1) * 4352 + ch; LAS float* __restrict__ H = hbuf + dir * 4096 + ch;
        float av[16], bv[16];
#pragma unroll
        for (int j = 0; j < 16; ++j) { const int sI = seg * 16 + j, t = dir ? 63 - sI : sI; av[j] = A[t * 68]; bv[j] = B[t * 68]; }
        float hl = 0.f, pp = 1.0f;
#pragma unroll
        for (int j = 0; j < 16; ++j) { hl = av[j] * hl + bv[j]; pp *= av[j]; bv[j] = hl; av[j] = pp; }
        *(LAS f32x2*)(segb + ((seg * 128 + dir * 64 + ch) << 1)) = (f32x2){pp, hl};
        LDS_SYNC();
        float hin = hc_in;
#pragma unroll
        for (int q = 0; q < 3; ++q) if (q < seg) { const f32x2 sq = *(const LAS f32x2*)(segb + ((q * 128 + dir * 64 + ch) << 1)); hin = sq.x * hin + sq.y; }
#pragma unroll
        for (int j = 0; j < 16; ++j) { const int sI = seg * 16 + j, t = dir ? 63 - sI : sI; H[t * 64] = bv[j] + av[j] * hin; }
    }
    LDS_SYNC();
    {   const int t = tid >> 3, ch0 = (tid & 7) * 8; float hv[8]; float ss = 0.f;
#pragma unroll
        for (int j = 0; j < 8; ++j) { hv[j] = hbuf[t * 64 + ch0 + j] + hbuf[4096 + t * 64 + ch0 + j]; ss += hv[j] * hv[j]; }
        ss += dpp_<0xB1, 0xF>(ss); ss += dpp_<0x4E, 0xF>(ss); ss += dpp_<0x141, 0xF>(ss);
        const float rstd = rsqrtf(ss * (1.0f / 64.0f) + EPS);
        const size_t row = (size_t)(rowbase + t0 + t);
        const u32x4 gv = R.gv_in; const float mw[8] = {R.mw0[0], R.mw0[1], R.mw0[2], R.mw0[3], R.mw1[0], R.mw1[1], R.mw1[2], R.mw1[3]};
        u32x4 o;
#pragma unroll
        for (int q = 0; q < 4; ++q) { const float g0 = __uint_as_float(gv[q] << 16), g1v = __uint_as_float(gv[q] & 0xFFFF0000u);
            o[q] = pk_bf16(g0 * hv[2 * q] * rstd * mw[2 * q], g1v * hv[2 * q + 1] * rstd * mw[2 * q + 1]); }
        *(u32x4*)(WSP(bf16_t, WS_MRG) + row * 1024 + 384 + g * 64 + ch0) = o;
    }
    LDS_SYNC();
}
DEVI void rg_carry(const Ctx& cx) {
    for (int idx = (cx.G - 1 - cx.bid) * NTHR + cx.tid; idx < NB * 2 * 384; idx += cx.G * NTHR) {
        const int ch = idx % 384, dir = (idx / 384) & 1, b = idx / 768;
        float A[RGC], B[RGC];
#pragma unroll
        for (int s = 0; s < RGC; ++s) { const int ck = dir == 0 ? s : (s < 4 ? 3 - s : 39 - s);
            const size_t ix = ((size_t)(b * RGC + ck) * 2 + dir) * 384 + ch; A[s] = WSP(float, WS_RGA)[ix]; B[s] = WSP(float, WS_RGB)[ix]; }
        float h = 0.f;
#pragma unroll
        for (int s = 0; s < RGC; ++s) { const int ck = dir == 0 ? s : (s < 4 ? 3 - s : 39 - s);
            const size_t ix = ((size_t)(b * RGC + ck) * 2 + dir) * 384 + ch; WSP(float, WS_RGC)[ix] = h; h = A[s] * h + B[s]; }
    }
}

DEVI int s5_trow(int rowi, int s) { const int b = rowi / S5C, c = rowi % S5C; return c < 8 ? b * CTXL + c * 32 + s : TCTX + b * SEQ + s * 64 + (c - 8); }
DEVI void s5_local_block(const Ctx& cx, int l, int bu) {
    const int g = bu / 9, mb = bu % 9, mh = cx.wave >> 2, nt = cx.wave & 3;
    const bf16_t* Pp = WSP(bf16_t, WS_P) + PC_S5 + g * 16;
    const bf16_t* we = WSP(bf16_t, WS_WE) + (size_t)(l * 16 + g) * 256 * 512 + (size_t)nt * 64 * 512;
    LAS bf16_t* As = (LAS bf16_t*)cx.lds;
    bf16x8 stg[8];
#pragma unroll
    for (int it = 0; it < 8; ++it) { const int r = (cx.tid >> 6) + 8 * it, pc = cx.tid & 63; stg[it] = ldg8(Pp + (size_t)s5_trow(mb * 64 + r, pc >> 1) * NP + (pc & 1) * 8); }
    __builtin_amdgcn_sched_barrier(0);
#pragma unroll
    for (int it = 0; it < 8; ++it) { const int r = (cx.tid >> 6) + 8 * it, pc = cx.tid & 63; *(LAS bf16x8*)(As + r * 520 + pc * 8) = stg[it]; }
    LDS_SYNC();
    f32x4 acc[2][4];
    const int fr = cx.lane & 15, fq = cx.lane >> 4;
    const LAS bf16_t* Al = As + (mh * 32 + fr) * 520 + fq * 8; const bf16_t* wl = we + cx.lane * 8;
    wave_gemm<2, 4>(16, [&](int m, int ks) { return *(const LAS bf16x8*)(Al + m * 16 * 520 + ks * 32); },
                        [&](int n, int ks) { return ldg8(wl + (n * 16 + ks) * 512); }, acc);
    const int src = epi_src(fr, fq), frn = 4 * fq + (fr >> 2), fqn = fr & 3;
#pragma unroll
    for (int m = 0; m < 2; ++m)
#pragma unroll
        for (int n = 0; n < 4; ++n) { const f32x4 a = acc[m][n];
            *(f32x4*)(WSP(float, WS_SLOC) + ((size_t)g * S5R + mb * 64 + mh * 32 + m * 16 + frn) * 256 + nt * 64 + n * 16 + 4 * fqn) = (f32x4){bpermf(src, a[0]), bpermf(src, a[1]), bpermf(src, a[2]), bpermf(src, a[3])}; }
    LDS_SYNC();
}
DEVI void s5_carry(const Ctx& cx, int l) {
    for (int idx = cx.bid * NTHR + cx.tid; idx < NB * 16 * 2 * 64; idx += cx.G * NTHR) {
        const int n = idx & 63, d = (idx >> 6) & 1, g = (idx >> 7) & 15, b = idx >> 11;
        const f32x2 a32 = WSP(f32x2, WS_PW)[(size_t)(((l * 16 + g) * 2 + d) * 64 + n) * 33 + 32];
        float sr = 0.f, si = 0.f;
#pragma unroll 1
        for (int s0 = 0; s0 < S5C; s0 += 24) {
            float lr[24], li[24];
#pragma unroll
            for (int j = 0; j < 24; ++j) { const int s = s0 + j, c = d == 0 ? s : (s < 8 ? 7 - s : 79 - s);
                const size_t ix = ((size_t)g * S5R + b * S5C + c) * 256 + d * 128 + n; lr[j] = WSP(float, WS_SLOC)[ix]; li[j] = WSP(float, WS_SLOC)[ix + 64]; }
#pragma unroll
            for (int j = 0; j < 24; ++j) { const int s = s0 + j, c = d == 0 ? s : (s < 8 ? 7 - s : 79 - s);
                const size_t ix = ((size_t)g * S5R + b * S5C + c) * 256 + d * 128 + n;
                WSP(bf16_t, WS_SIN)[ix] = f2bf(sr); WSP(bf16_t, WS_SIN)[ix + 64] = f2bf(si);
                const float nr = a32.x * sr - a32.y * si + lr[j], ni = a32.x * si + a32.y * sr + li[j]; sr = nr; si = ni; }
        }
    }
}
DEVI void s5_out_block(const Ctx& cx, int l, int bu) {
    const int g = bu / 12, mt = bu % 12, nt = cx.wave;
    const bf16_t* Pp = WSP(bf16_t, WS_P) + PC_S5 + g * 16;
    const bf16_t* sin_ = WSP(bf16_t, WS_SIN) + (size_t)g * S5R * 256;
    const bf16_t* wy = WSP(bf16_t, WS_WY) + (size_t)(l * 16 + g) * 512 * 768 + (size_t)nt * 64 * 768;
    LAS bf16_t* As = (LAS bf16_t*)cx.lds;
    bf16x8 stg[9];
#pragma unroll
    for (int it = 0; it < 6; ++it) { const int r = (cx.tid >> 6) + 8 * it, pc = cx.tid & 63; stg[it] = ldg8(Pp + (size_t)s5_trow(mt * 48 + r, pc >> 1) * NP + (pc & 1) * 8); }
#pragma unroll
    for (int it = 0; it < 3; ++it) { const int r = (cx.tid >> 5) + 16 * it, pc = cx.tid & 31; stg[6 + it] = ldg8(sin_ + (size_t)(mt * 48 + r) * 256 + pc * 8); }
    __builtin_amdgcn_sched_barrier(0);
#pragma unroll
    for (int it = 0; it < 6; ++it) { const int r = (cx.tid >> 6) + 8 * it, pc = cx.tid & 63; *(LAS bf16x8*)(As + r * 776 + pc * 8) = stg[it]; }
#pragma unroll
    for (int it = 0; it < 3; ++it) { const int r = (cx.tid >> 5) + 16 * it, pc = cx.tid & 31; *(LAS bf16x8*)(As + r * 776 + 512 + pc * 8) = stg[6 + it]; }
    LDS_SYNC();
    f32x4 acc[3][4];
    const int fr = cx.lane & 15, fq = cx.lane >> 4;
    const LAS bf16_t* Al = As + fr * 776 + fq * 8; const bf16_t* wl = wy + cx.lane * 8;
    wave_gemm<3, 4>(24, [&](int m, int ks) { return *(const LAS bf16x8*)(Al + m * 16 * 776 + ks * 32); },
                        [&](int n, int ks) { return ldg8(wl + (n * 24 + ks) * 512); }, acc);
    const int src = epi_src(fr, fq), frn = 4 * fq + (fr >> 2), fqn = fr & 3;
#pragma unroll
    for (int m = 0; m < 3; ++m)
#pragma unroll
        for (int n = 0; n < 4; ++n) { const int trow = s5_trow(mt * 48 + m * 16 + frn, nt * 4 + n);
            const f32x2 ga = gelu_tanh2((f32x2){acc[m][n][0], acc[m][n][1]}), gb2 = gelu_tanh2((f32x2){acc[m][n][2], acc[m][n][3]});
            u32x2 w; w.x = bperm(src, pk_bf16(ga.x, ga.y)); w.y = bperm(src, pk_bf16(gb2.x, gb2.y));
            *(u32x2*)(WSP(bf16_t, WS_GS) + (size_t)trow * 256 + g * 16 + 4 * fqn) = w; }
    LDS_SYNC();
}
DEVI void s5_glu_block(const Ctx& cx, int l, int bu) {
    const int mh = cx.wave >> 2, nt = cx.wave & 3;
    const bf16_t* gs = WSP(bf16_t, WS_GS) + (size_t)bu * 96 * 256;
    const bf16_t* wg = WSP(bf16_t, WS_WGLU) + (size_t)l * 65536 + (size_t)nt * 64 * 256;
    LAS bf16_t* As = (LAS bf16_t*)cx.lds;
    bf16x8 stg[6];
#pragma unroll
    for (int it = 0; it < 6; ++it) { const int r = (cx.tid >> 5) + 16 * it, pc = cx.tid & 31; stg[it] = ldg8(gs + (size_t)r * 256 + pc * 8); }
    __builtin_amdgcn_sched_barrier(0);
#pragma unroll
    for (int it = 0; it < 6; ++it) { const int r = (cx.tid >> 5) + 16 * it, pc = cx.tid & 31; *(LAS bf16x8*)(As + r * 264 + pc * 8) = stg[it]; }
    LDS_SYNC();
    f32x4 acc[3][4];
    const int fr = cx.lane & 15, fq = cx.lane >> 4;
    const LAS bf16_t* Al = As + (mh * 48 + fr) * 264 + fq * 8; const bf16_t* wl = wg + cx.lane * 8;
    wave_gemm<3, 4>(8, [&](int m, int ks) { return *(const LAS bf16x8*)(Al + m * 16 * 264 + ks * 32); },
                       [&](int n, int ks) { return ldg8(wl + (n * 8 + ks) * 512); }, acc);
    const int src = epi_src(fr, fq), frn = 4 * fq + (fr >> 2), fqn = fr & 3;
#pragma unroll
    for (int n = 0; n < 4; ++n) { const int col = nt * 64 + n * 16 + 4 * fq;
        const f32x4 gb = *(const f32x4*)(cx.p->in[I_S5GB] + l * 256 + col), mw = *(const f32x4*)(cx.p->in[I_MIXW] + l * 1024 + 768 + col);
#pragma unroll
        for (int m = 0; m < 3; ++m) { const int lr = mh * 48 + m * 16 + fr; const size_t trow = (size_t)bu * 96 + lr;
            const u32x2 gv = *(const LAS u32x2*)(As + lr * 264 + col);
            const float gq[4] = {__uint_as_float(gv.x << 16), __uint_as_float(gv.x & 0xFFFF0000u), __uint_as_float(gv.y << 16), __uint_as_float(gv.y & 0xFFFF0000u)};
            float o[4]; float ss = 0.f;
#pragma unroll
            for (int j = 0; j < 4; ++j) { o[j] = gq[j] * frcp(1.0f + __expf(-(acc[m][n][j] + gb[j]))); ss += o[j] * o[j]; }
            ss += shx<16>(ss, cx.lane); ss += shx<32>(ss, cx.lane);
            const float rstd = rsqrtf(ss * (1.0f / 16.0f) + EPS);
            u32x2 w; w.x = bperm(src, pk_bf16(o[0] * rstd * mw[0], o[1] * rstd * mw[1])); w.y = bperm(src, pk_bf16(o[2] * rstd * mw[2], o[3] * rstd * mw[3]));
            *(u32x2*)(WSP(bf16_t, WS_MRG) + ((size_t)bu * 96 + mh * 48 + m * 16 + frn) * 1024 + 768 + nt * 64 + n * 16 + 4 * fqn) = w; } }
    LDS_SYNC();
}

#ifndef PH_DUP2
#define PH_DUP2 0
#endif
#define REP_(k) for (int rep_ = 0; rep_ < 1 + ((PH_DUP2 >> (k)) & 1); ++rep_)
DEVI void ph_mix_local(const Ctx& cx, int l) {
    REP_(0) for (int u = cx.bid; u < NB * 4 * MLC; u += cx.G) ml_local_unit(cx, l, u / (4 * MLC), (u / MLC) % 4, u % MLC);
    REP_(1) { const int off = (NB * 4 * MLC) % cx.G; const int first = (cx.bid - off + cx.G) % cx.G;
      RgPre pa; int u = first < NB * RGC * 6 ? first : -1; if (u >= 0) rg_issue(cx, l, u, 0, pa);
      while (u >= 0) { const int un = u + cx.G < NB * RGC * 6 ? u + cx.G : -1; RgPre pb; rg_issue(cx, l, un >= 0 ? un : u, 0, pb);
          rg_body(cx, l, u, 0, pa); pa = pb; u = un; } }
    REP_(2) { if (cx.G == 256) { const int x = cx.bid & 7, j = (cx.bid >> 3) - 8;
                  if (j >= 0 && j < 18) s5_local_block(cx, l, (x + 8 * (j / 9)) * 9 + j % 9); }
              else for (int bu = cx.bid; bu < 16 * 9; bu += cx.G) s5_local_block(cx, l, bu); }
}
DEVI void ph_mix_carry(const Ctx& cx, int l) { ml_carry(cx); rg_carry(cx); s5_carry(cx, l); }
DEVI void ph_mix_out(const Ctx& cx, int l) {
    const bool last = (l == DEPTH - 1);
    REP_(3) for (int u = cx.bid; u < NB * 4 * MLC; u += cx.G) { const int c = u % MLC; if (last && c < 2) continue; ml_out_unit(cx, l, u / (4 * MLC), (u / MLC) % 4, c); }
    REP_(4) { const int off = (NB * 4 * MLC) % cx.G; const int first = (cx.bid - off + cx.G) % cx.G;
      auto nextu = [&](int u) { for (; u < NB * RGC * 6; u += cx.G) { if (last && (u / 6) % RGC < 4) continue; return u; } return -1; };
      RgPre2 pa; int u = nextu(first); if (u >= 0) rg2_issue(cx, l, u, pa);
      while (u >= 0) { const int un = nextu(u + cx.G); RgPre2 pb; rg2_issue(cx, l, un >= 0 ? un : u, pb);
          rg2_body(cx, l, u, pa); pa = pb; u = un; } }
    REP_(5) { if (cx.G == 256) { const int x = cx.bid & 7, j = (cx.bid >> 3) - 8;
                  if (j >= 0) s5_out_block(cx, l, (x + 8 * (j / 12)) * 12 + j % 12); }
              else for (int bu = cx.bid; bu < 16 * 12; bu += cx.G) s5_out_block(cx, l, bu); }
}
DEVI void ph_glu(const Ctx& cx, int l) {
    for (int bu = cx.bid; bu < TT / 96; bu += cx.G) s5_glu_block(cx, l, bu);
}

DEVI unsigned st_launder(unsigned s_addr) { unsigned a; asm volatile("v_mov_b32 %0, %1" : "=v"(a) : "s"(s_addr)); return a; }
constexpr int N_STEPS = 3 + 10 * DEPTH + 1;
__global__ void __launch_bounds__(NTHR, 2) mk_fwd(Params p) {
    extern __shared__ __attribute__((aligned(16))) unsigned char lds_raw[];
    Ctx cx; cx.p = &p; cx.ws = p.ws; cx.lds = (LAS unsigned char*)lds_raw; cx.tid = threadIdx.x; cx.lane = cx.tid & 63;
    cx.wave = __builtin_amdgcn_readfirstlane((int)threadIdx.x >> 6); cx.G = gridDim.x; cx.bid = blockIdx.x;
    volatile LAS unsigned* st = (volatile LAS unsigned*)(cx.lds + LDS_BYTES - 16);
    const unsigned st_s = (unsigned)__builtin_amdgcn_readfirstlane((int)(unsigned)(size_t)(LAS unsigned*)(cx.lds + LDS_BYTES - 16));
#define ST_P ((volatile LAS unsigned*)(size_t)st_launder(st_s))
    if (cx.tid == 0) { st[0] = 0u; st[1] = 0u; st[2] = (unsigned)p.lo; st[3] = (unsigned)p.hi; }
    __syncthreads();
    (void)xcd_barrier_post((unsigned*)(p.ws + WS_CTL) + CW_BAR, st);
#define GRID_BAR() do { XcdBarrier b_; b_.bar = (unsigned*)(p.ws + WS_CTL) + CW_BAR; b_.x = (unsigned)__builtin_amdgcn_readfirstlane((int)xb_xcc_id()); b_.st = ST_P; xcd_barrier(b_); } while (0)
#ifndef PH_MASK
#define PH_MASK 0xFFFF
#endif
#ifndef PH_DUP
#define PH_DUP 0
#endif
#define STEP_(id, k, call) do { const int lo_ = __builtin_amdgcn_readfirstlane((int)ST_P[2]), hi_ = __builtin_amdgcn_readfirstlane((int)ST_P[3]); if (lo_ <= (k) && (k) < hi_) { if ((PH_MASK >> (id)) & 1) { const Ctx cl = relaunder(cx); call; } if ((PH_DUP >> (id)) & 1) { GRID_BAR(); const Ctx cl = relaunder(cx); call; } if ((k) + 1 < hi_) GRID_BAR(); } } while (0)
    STEP_(0, 0, ph_pro_a(cl));
    STEP_(1, 1, ph_pro_b(cl));
    STEP_(2, 2, ph_pro_c(cl));
#pragma unroll 1
    for (int l = 0; l < DEPTH; ++l) {
        const int s0 = 3 + 10 * l;
        STEP_(3, s0 + 0, ph_norm1(cl, l));
        STEP_(4, s0 + 1, ph_inproj(cl, l));
        STEP_(5, s0 + 2, ph_mix_local(cl, l));
        STEP_(6, s0 + 3, ph_mix_carry(cl, l));
        STEP_(7, s0 + 4, ph_mix_out(cl, l));
        STEP_(8, s0 + 5, ph_glu(cl, l));
        STEP_(9, s0 + 6, ph_outproj(cl, l));
        STEP_(10, s0 + 7, ph_norm2(cl, l));
        STEP_(11, s0 + 8, ph_moe_gu(cl, l));
        STEP_(12, s0 + 9, ph_moe_dn(cl, l));
    }
    STEP_(13, N_STEPS - 1, ph_norm1(cl, DEPTH));
#undef STEP_
}

extern "C" void kernel_launch(void* const* d_in, const int* in_sizes, int n_in, void* d_out, int out_size, void* d_ws, size_t ws_size, hipStream_t stream) {
    static int grid = 0;
    if (grid == 0) {
        if (n_in != 36 || out_size != TLAT * DM || ws_size < WS_END) { fprintf(stderr, "kernel_launch: unexpected problem (n_in %d, out %d, ws %zu < %zu)\n", n_in, out_size, ws_size, (size_t)WS_END); grid = -1; return; }
        int dev = 0, cus = 0, per_cu = 0;
        if (hipGetDevice(&dev) != hipSuccess || hipDeviceGetAttribute(&cus, hipDeviceAttributeMultiprocessorCount, dev) != hipSuccess) { grid = -1; return; }
        if (hipFuncSetAttribute((const void*)mk_fwd, hipFuncAttributeMaxDynamicSharedMemorySize, LDS_BYTES) != hipSuccess) { fprintf(stderr, "kernel_launch: hipFuncSetAttribute failed\n"); grid = -1; return; }
        if (hipOccupancyMaxActiveBlocksPerMultiprocessor(&per_cu, (const void*)mk_fwd, NTHR, LDS_BYTES) != hipSuccess || per_cu < 1) { fprintf(stderr, "kernel_launch: occupancy query says %d blocks per CU\n", per_cu); }
        (void)hipGetLastError();
        grid = cus;
    }
    if (grid < 0) return;
    (void)hipMemsetAsync((char*)d_ws + WS_CTL, 0, CTL_BYTES, stream);
    Params p{};
    for (int i = 0; i < 36; ++i) p.in[i] = (const float*)d_in[i];
    p.out = (float*)d_out; p.ws = (unsigned char*)d_ws;
#if MK_FUSED
    p.lo = 0; p.hi = N_STEPS;
    hipLaunchKernelGGL(mk_fwd, dim3(grid), dim3(NTHR), LDS_BYTES, stream, p);
#else
    for (int k = 0; k < N_STEPS; ++k) { p.lo = k; p.hi = k + 1; hipLaunchKernelGGL(mk_fwd, dim3(grid), dim3(NTHR), LDS_BYTES, stream, p); }
#endif
}
```
